# Optimizing an MI355X kernel written in HIP

```python
import math
import jax
import jax.numpy as jnp
from jax import lax
import numpy as np

D_MODEL = 1024
BATCH = 16
SEQ = 2048
DEPTH = 4

GRID_W = 64
CTX_LEN = 256
N_BRANCH = 4
BR_W = 512
A_HEADS = 4
A_DQK = 64
A_DV = 2 * A_DQK
A_QBLOCK = 128
ROPE_BASE = 10000.0
HY_W = BR_W
HY_ORDER = 2
HY_SHORT = 3
HY_BANDS = 16
HY_EMB = 1 + 2 * HY_BANDS
HY_HID = 64
HY_MIN_DECAY = math.log(1e-2) / 1.5
HY_MAX_DECAY = math.log(1e-2) / 0.3
FN_W = BR_W
FN_GROUPS = 4
DN_HEADS = 4
DN_DK = 128
DN_DV = 128
DN_SHORT = 3
DN_CHUNK = 64
D_FF = 4 * D_MODEL
EPS = 1e-6

OFF_AQ = 0
OFF_AK = OFF_AQ + A_HEADS * 2 * A_DQK
OFF_AV = OFF_AK + A_HEADS * 2 * A_DQK
OFF_HY = OFF_AV + A_HEADS * A_DV
OFF_FN = OFF_HY + (HY_ORDER + 1) * HY_W
OFF_DN = OFF_FN + FN_W
OFF_DZ = OFF_DN + DN_HEADS * (2 * DN_DK + DN_DV)
OFF_DA = OFF_DZ + DN_HEADS * DN_DV
OFF_DB = OFF_DA + 2 * DN_HEADS
N_IN = OFF_DB + 2 * DN_HEADS

kernel_name = 'hybrid_diffattn_hyena_fnet_gdn_dit'

F32 = jnp.float32


def rmsnorm(x, w):
    xf = x.astype(F32)
    y = xf * lax.rsqrt(jnp.mean(xf * xf, axis=-1, keepdims=True) + EPS)
    return (y * w.astype(F32)).astype(x.dtype)


def l2norm(x):
    return x * lax.rsqrt(jnp.sum(x * x, axis=-1, keepdims=True) + EPS)


def centred_conv(u, w):
    k = w.shape[0]
    r = k // 2
    length = u.shape[1]
    up = jnp.pad(u, ((0, 0), (r, r), (0, 0)))
    out = up[:, 0:length] * w[0]
    for i in range(1, k):
        out = out + up[:, i:i + length] * w[i]
    return out


def axial_rope_tables(length):
    rows = length // GRID_W
    row = jnp.repeat(jnp.arange(rows, dtype=F32), GRID_W)
    col = jnp.tile(jnp.arange(GRID_W, dtype=F32), rows)
    n_freq = A_DQK // 4
    inv = ROPE_BASE ** (-jnp.arange(n_freq, dtype=F32) / n_freq)
    ang = jnp.stack([row[:, None] * inv, col[:, None] * inv], axis=1)
    return jnp.cos(ang), jnp.sin(ang)


def apply_axial_rope(x, cos, sin):
    sh = x.shape
    xr = x.astype(F32).reshape(sh[:-1] + (2, 2, A_DQK // 4))
    xa, xb = xr[..., 0, :], xr[..., 1, :]
    cs, sn = cos[:, None, None], sin[:, None, None]
    out = jnp.stack([xa * cs - xb * sn, xb * cs + xa * sn], axis=-2)
    return out.reshape(sh).astype(x.dtype)


def diff_softmax(q, k, v, lam):
    s = jnp.einsum('bhqcd,bhkcd->bhcqk', q.astype(F32), k.astype(F32)) * (A_DQK ** -0.5)
    p = jax.nn.softmax(s, axis=-1)
    a = p[:, :, 0] - lam * p[:, :, 1]
    return jnp.einsum('bhqk,bhkv->bhqv', a, v.astype(F32))


def diff_attention_branch(p, pc, qk_gain, lam_vec, subln_w, lambda_init, need_ctx):
    def split_heads(pp):
        b_, l_, _ = pp.shape
        q = pp[..., OFF_AQ:OFF_AK].reshape(b_, l_, A_HEADS, 2, A_DQK)
        k = pp[..., OFF_AK:OFF_AV].reshape(b_, l_, A_HEADS, 2, A_DQK)
        v = pp[..., OFF_AV:OFF_HY].reshape(b_, l_, A_HEADS, A_DV)
        return rmsnorm(q, qk_gain[0]), rmsnorm(k, qk_gain[1]), v

    b, l = p.shape[:2]
    q, k, v = split_heads(p)
    qc, kc, vc = split_heads(pc)
    cos, sin = axial_rope_tables(l)
    q = apply_axial_rope(q, cos, sin)
    k = apply_axial_rope(k, cos, sin)
    lf = lam_vec.astype(F32)
    lam = jnp.exp(jnp.sum(lf[0] * lf[1])) - jnp.exp(jnp.sum(lf[2] * lf[3])) + lambda_init
    kc_t = kc.transpose(0, 2, 1, 3, 4)
    vc_t = vc.transpose(0, 2, 1, 3)
    k_all = jnp.concatenate([kc_t, k.transpose(0, 2, 1, 3, 4)], axis=2)
    v_all = jnp.concatenate([vc_t, v.transpose(0, 2, 1, 3)], axis=2)
    n_blk = l // A_QBLOCK
    qb = q.reshape(b, n_blk, A_QBLOCK, A_HEADS, 2, A_DQK).transpose(1, 0, 3, 2, 4, 5)
    o = lax.map(lambda blk: diff_softmax(blk, k_all, v_all, lam), qb)
    o = o.transpose(1, 0, 3, 2, 4).reshape(b, l, A_HEADS, A_DV)

    def finish(oo):
        b_, l_ = oo.shape[:2]
        y = rmsnorm(oo, subln_w) * (1.0 - lambda_init)
        return y.reshape(b_, l_, A_HEADS * A_DV).astype(p.dtype)

    y = finish(o)
    yc = None
    if need_ctx:
        oc = diff_softmax(qc.transpose(0, 2, 1, 3, 4), kc_t, vc_t, lam).transpose(0, 2, 1, 3)
        yc = finish(oc)
    return y, yc


def hyena_filter_spectra(length, w1, b1, freq, w2, b2, w3):
    t = jnp.linspace(0.0, 1.0, length, dtype=F32)[:, None]
    w = 2.0 * math.pi * jnp.arange(length, dtype=F32)[:, None] / length
    bands = jnp.linspace(1e-4, HY_BANDS - 1, HY_BANDS, dtype=F32)[None]
    feats = jnp.concatenate([t, jnp.cos(bands * w), -jnp.sin(bands * w)], axis=-1)
    hdn = jnp.sin(freq[0].astype(F32) * (feats @ w1.astype(F32) + b1.astype(F32)))
    hdn = jnp.sin(freq[1].astype(F32) * (hdn @ w2.astype(F32) + b2.astype(F32)))
    h = (hdn @ w3.astype(F32)).reshape(length, HY_ORDER, 2, HY_W)
    deltas = jnp.abs(jnp.linspace(HY_MIN_DECAY, HY_MAX_DECAY, HY_W, dtype=F32))
    h = h * jnp.exp(-t[:, :, None, None] * deltas)
    taps = jnp.concatenate([h[:, :, 0], jnp.zeros((1, HY_ORDER, HY_W), F32), h[:0:-1, :, 1]], axis=0)
    taps = taps / jnp.sum(jnp.abs(taps), axis=0, keepdims=True)
    return jnp.fft.rfft(taps, n=2 * length, axis=0)


def long_conv(z, kf, bias):
    length = z.shape[1]
    zf = jnp.fft.rfft(z, n=2 * length, axis=1)
    return jnp.fft.irfft(zf * kf, n=2 * length, axis=1)[:, :length] + bias * z


def hyena_branch(pp, conv_w, w1, b1, freq, w2, b2, w3, bias):
    length = pp.shape[1]
    u = centred_conv(pp[..., OFF_HY:OFF_FN], conv_w).astype(F32)
    parts = jnp.split(u, HY_ORDER + 1, axis=-1)
    kf = hyena_filter_spectra(length, w1, b1, freq, w2, b2, w3)
    z = parts[-1]
    for n in range(HY_ORDER):
        z = parts[n] * long_conv(z, kf[:, n], bias[n].astype(F32))
    return z.astype(pp.dtype)


def fourier_branch(pp):
    b, l, _ = pp.shape
    u = pp[..., OFF_FN:OFF_DN].astype(F32).reshape(b, l, FN_GROUPS, FN_W // FN_GROUPS)
    y = jnp.fft.fft2(u, axes=(1, 3), norm='ortho').real
    return y.reshape(b, l, FN_W).astype(pp.dtype)


def gated_delta_chunked(q, k, v, g, beta, s0):
    b, h, l, dk = q.shape
    dv = v.shape[-1]
    cs = DN_CHUNK
    n = l // cs
    q = (q * dk ** -0.5).reshape(b, h, n, cs, dk)
    k = k.reshape(b, h, n, cs, dk)
    v = v.reshape(b, h, n, cs, dv)
    beta = beta.reshape(b, h, n, cs)
    gc = jnp.cumsum(g.reshape(b, h, n, cs), axis=-1)
    idx = jnp.arange(cs)
    incl = idx[:, None] >= idx[None, :]
    strict = idx[:, None] > idx[None, :]
    diff = gc[..., :, None] - gc[..., None, :]
    decay = jnp.where(incl, jnp.exp(jnp.where(incl, diff, 0.0)), 0.0)
    kb = k * beta[..., None]
    a_mat = jnp.where(strict, jnp.einsum('bhncd,bhnsd->bhncs', kb, k) * decay, 0.0)
    eye = jnp.eye(cs, dtype=q.dtype)
    t_mat = lax.linalg.triangular_solve(a_mat + eye, jnp.broadcast_to(eye, a_mat.shape),
                                        left_side=True, lower=True, unit_diagonal=True)
    u_c = t_mat @ (v * beta[..., None])
    w_c = t_mat @ (kb * jnp.exp(gc)[..., None])
    intra = jnp.where(incl, jnp.einsum('bhncd,bhnsd->bhncs', q, k) * decay, 0.0)
    q_dec = q * jnp.exp(gc)[..., None]
    k_dec = k * jnp.exp(gc[..., -1:] - gc)[..., None]
    g_last = jnp.exp(gc[..., -1])
    xs = (jnp.moveaxis(u_c, 2, 0), jnp.moveaxis(w_c, 2, 0), jnp.moveaxis(intra, 2, 0),
          jnp.moveaxis(q_dec, 2, 0), jnp.moveaxis(k_dec, 2, 0), jnp.moveaxis(g_last, 2, 0))

    def step(s, inp):
        u_i, w_i, a_i, qd_i, kd_i, gl_i = inp
        v_new = u_i - jnp.einsum('bhck,bhkv->bhcv', w_i, s)
        o_i = jnp.einsum('bhck,bhkv->bhcv', qd_i, s) + jnp.einsum('bhcs,bhsv->bhcv', a_i, v_new)
        s = s * gl_i[..., None, None] + jnp.einsum('bhck,bhcv->bhkv', kd_i, v_new)
        return s, o_i

    s_fin, o = lax.scan(step, s0, xs)
    o = jnp.moveaxis(o, 0, 2).reshape(b, h, l, dv)
    return o, s_fin


def _flip(t, rev):
    return jnp.flip(t, axis=2) if rev else t


def deltanet_branch(p, pc, conv_w, a_log, dt_bias, norm_w, need_ctx):
    def prep(pp):
        b_, l_, _ = pp.shape
        qkv = jax.nn.silu(centred_conv(pp[..., OFF_DN:OFF_DZ], conv_w).astype(F32))
        q, k, v = jnp.split(qkv, [DN_HEADS * DN_DK, 2 * DN_HEADS * DN_DK], axis=-1)
        q = l2norm(q.reshape(b_, l_, DN_HEADS, DN_DK)).transpose(0, 2, 1, 3)
        k = l2norm(k.reshape(b_, l_, DN_HEADS, DN_DK)).transpose(0, 2, 1, 3)
        v = v.reshape(b_, l_, DN_HEADS, DN_DV).transpose(0, 2, 1, 3)
        a = pp[..., OFF_DA:OFF_DB].astype(F32).reshape(b_, l_, 2, DN_HEADS)
        bt = pp[..., OFF_DB:N_IN].astype(F32).reshape(b_, l_, 2, DN_HEADS)
        g = -jnp.exp(a_log.astype(F32)) * jax.nn.softplus(a + dt_bias.astype(F32))
        return q, k, v, g.transpose(2, 0, 3, 1), jax.nn.sigmoid(bt).transpose(2, 0, 3, 1)

    def finish(o, pp):
        b_, l_ = pp.shape[:2]
        z = pp[..., OFF_DZ:OFF_DA].astype(F32).reshape(b_, l_, DN_HEADS, DN_DV)
        y = rmsnorm(o.transpose(0, 2, 1, 3), norm_w) * jax.nn.silu(z)
        return y.reshape(b_, l_, DN_HEADS * DN_DV).astype(pp.dtype)

    qx, kx, vx, gx, bx = prep(p)
    qc, kc, vc, gcc, bcc = prep(pc)
    s0 = jnp.zeros((p.shape[0], DN_HEADS, DN_DK, DN_DV), F32)
    ox = jnp.zeros_like(vx)
    oc = jnp.zeros_like(vc)
    for d in range(2):
        rev = d == 1
        o_c, s_c = gated_delta_chunked(_flip(qc, rev), _flip(kc, rev), _flip(vc, rev),
                                       _flip(gcc[d], rev), _flip(bcc[d], rev), s0)
        o_x, _ = gated_delta_chunked(_flip(qx, rev), _flip(kx, rev), _flip(vx, rev),
                                     _flip(gx[d], rev), _flip(bx[d], rev), s_c)
        ox = ox + _flip(o_x, rev)
        oc = oc + _flip(o_c, rev)
    y = finish(ox, p)
    yc = finish(oc, pc) if need_ctx else None
    return y, yc


def merge_branches(h, ys, w_gate, w_branch, w_o):
    acc = jax.nn.sigmoid(h @ w_gate[0]) * (ys[0] @ w_branch[0])
    for n in range(1, N_BRANCH):
        acc = acc + jax.nn.sigmoid(h @ w_gate[n]) * (ys[n] @ w_branch[n])
    return acc @ w_o


def sq_relu_mlp(h, w1, w2):
    return jnp.square(jax.nn.relu(h @ w1)) @ w2


def setup_inputs(seed: int = 0) -> dict:
    key = jax.random.key(seed)
    ks = jax.random.split(key, 32)

    def nrm(k, shape, scale):
        return jax.random.normal(k, shape, F32) * scale

    L = DEPTH
    dt = jnp.exp(jax.random.uniform(ks[22], (L, 2, DN_HEADS), F32, math.log(1e-3), math.log(1e-1)))
    return {
        'x': nrm(ks[0], (BATCH, SEQ, D_MODEL), 1.0),
        'c': nrm(ks[1], (BATCH, D_MODEL), 1.0),
        'ctx': nrm(ks[2], (BATCH, CTX_LEN, D_MODEL), 1.0),
        'c_ctx': nrm(ks[3], (D_MODEL,), 1.0),
        'w_ada': nrm(ks[4], (L, D_MODEL, 6 * D_MODEL), D_MODEL ** -0.5),
        'b_ada': nrm(ks[5], (L, 6 * D_MODEL), 0.02),
        'norm1': 1.0 + nrm(ks[6], (L, D_MODEL), 0.02),
        'norm2': 1.0 + nrm(ks[7], (L, D_MODEL), 0.02),
        'w_in': nrm(ks[8], (L, D_MODEL, N_IN), D_MODEL ** -0.5),
        'attn_qk_gain': 1.0 + nrm(ks[9], (L, 2, A_DQK), 0.02),
        'attn_lambda': nrm(ks[10], (L, 4, A_DQK), 0.1),
        'attn_subln': 1.0 + nrm(ks[11], (L, A_DV), 0.02),
        'hy_conv': nrm(ks[12], (L, HY_SHORT, (HY_ORDER + 1) * HY_W), HY_SHORT ** -0.5),
        'hy_w1': nrm(ks[13], (L, HY_EMB, HY_HID), HY_EMB ** -0.5),
        'hy_b1': nrm(ks[14], (L, HY_HID), 0.1),
        'hy_freq': 1.0 + nrm(ks[15], (L, 2, HY_HID), 0.05),
        'hy_w2': nrm(ks[16], (L, HY_HID, HY_HID), HY_HID ** -0.5),
        'hy_b2': nrm(ks[17], (L, HY_HID), 0.1),
        'hy_w3': nrm(ks[18], (L, HY_HID, HY_ORDER * 2 * HY_W), HY_HID ** -0.5),
        'hy_bias': nrm(ks[19], (L, HY_ORDER, HY_W), 0.1),
        'dn_conv': nrm(ks[20], (L, DN_SHORT, DN_HEADS * (2 * DN_DK + DN_DV)), DN_SHORT ** -0.5),
        'dn_a_log': jnp.log(jax.random.uniform(ks[21], (L, 2, DN_HEADS), F32, 1.0, 16.0)),
        'dn_dt_bias': dt + jnp.log(-jnp.expm1(-dt)),
        'dn_norm': 1.0 + nrm(ks[23], (L, DN_DV), 0.02),
        'w_gate': nrm(ks[24], (L, N_BRANCH, D_MODEL, D_MODEL), D_MODEL ** -0.5),
        'w_branch': nrm(ks[25], (L, N_BRANCH, BR_W, D_MODEL), BR_W ** -0.5),
        'w_o': nrm(ks[26], (L, D_MODEL, D_MODEL), D_MODEL ** -0.5),
        'w_mlp1': nrm(ks[27], (L, D_MODEL, D_FF), D_MODEL ** -0.5),
        'w_mlp2': nrm(ks[28], (L, D_FF, D_MODEL), D_FF ** -0.5),
    }


def reference(x, c, ctx, c_ctx, w_ada, b_ada, norm1, norm2, w_in, attn_qk_gain, attn_lambda,
              attn_subln, hy_conv, hy_w1, hy_b1, hy_freq, hy_w2, hy_b2, hy_w3, hy_bias,
              dn_conv, dn_a_log, dn_dt_bias, dn_norm, w_gate, w_branch, w_o, w_mlp1, w_mlp2):
    xc = ctx
    for li in range(DEPTH):
        need_ctx = li < DEPTH - 1
        lambda_init = 0.8 - 0.6 * math.exp(-0.3 * li)
        mod = (jax.nn.silu(c) @ w_ada[li] + b_ada[li])[:, None, :]
        mod_c = (jax.nn.silu(c_ctx) @ w_ada[li] + b_ada[li])[None, None, :]
        sh1, sc1, g1, sh2, sc2, g2 = jnp.split(mod, 6, axis=-1)
        sh1c, sc1c, g1c, sh2c, sc2c, g2c = jnp.split(mod_c, 6, axis=-1)

        h = rmsnorm(x, norm1[li]) * (1.0 + sc1) + sh1
        hc = rmsnorm(xc, norm1[li]) * (1.0 + sc1c) + sh1c
        p = h @ w_in[li]
        pc = hc @ w_in[li]

        ya, ya_c = diff_attention_branch(p, pc, attn_qk_gain[li], attn_lambda[li], attn_subln[li],
                                         lambda_init, need_ctx)
        yb = hyena_branch(p, hy_conv[li], hy_w1[li], hy_b1[li], hy_freq[li], hy_w2[li], hy_b2[li],
                          hy_w3[li], hy_bias[li])
        yf = fourier_branch(p)
        yd, yd_c = deltanet_branch(p, pc, dn_conv[li], dn_a_log[li], dn_dt_bias[li], dn_norm[li],
                                   need_ctx)

        x = x + g1 * merge_branches(h, (ya, yb, yf, yd), w_gate[li], w_branch[li], w_o[li])
        h2 = rmsnorm(x, norm2[li]) * (1.0 + sc2) + sh2
        x = x + g2 * sq_relu_mlp(h2, w_mlp1[li], w_mlp2[li])

        if need_ctx:
            yb_c = hyena_branch(pc, hy_conv[li], hy_w1[li], hy_b1[li], hy_freq[li], hy_w2[li],
                                hy_b2[li], hy_w3[li], hy_bias[li])
            yf_c = fourier_branch(pc)
            xc = xc + g1c * merge_branches(hc, (ya_c, yb_c, yf_c, yd_c), w_gate[li], w_branch[li], w_o[li])
            h2c = rmsnorm(xc, norm2[li]) * (1.0 + sc2c) + sh2c
            xc = xc + g2c * sq_relu_mlp(h2c, w_mlp1[li], w_mlp2[li])
    return x
```

```cpp
#include <hip/hip_runtime.h>
#include <hip/hip_cooperative_groups.h>
#include <stdint.h>
#include <stdio.h>
namespace cg = cooperative_groups;

typedef unsigned short u16;
typedef __attribute__((ext_vector_type(8))) short bf16x8;
typedef __attribute__((ext_vector_type(4))) float f32x4;
#define MFMA(a, b, c) __builtin_amdgcn_mfma_f32_16x16x32_bf16(a, b, c, 0, 0, 0)
#define DI __device__ __forceinline__

#ifndef MULTI
#define MULTI 0
#endif

constexpr int T_LAT = 32768, T_ALL = 36864;
constexpr int NIN = 5648;
constexpr long U38 = 37748736L;
constexpr long OFF_XC = 0;
constexpr long OFF_WB = OFF_XC + 16777216L;
constexpr long OFF_HBF = OFF_WB + 43024384L;
constexpr long OFF_MOD = OFF_HBF + 75497472L;
constexpr long OFF_TAPL = OFF_MOD + 1671168L;
constexpr long OFF_TAPC = OFF_TAPL + 8388608L;
constexpr long OFF_DL = OFF_TAPC + 1048576L;
constexpr long OFF_DLC = OFF_DL + 16777216L;
constexpr long OFF_DC = OFF_DLC + 262144L;
constexpr long OFF_PDAB = OFF_DC + 65536L;
constexpr long OFF_GC = OFF_PDAB + 2359296L;
constexpr long OFF_BETA = OFF_GC + 2359296L;
constexpr long OFF_Y = OFF_BETA + 2359296L;
constexpr long OFF_AR = OFF_Y + 4 * U38;
constexpr long OFF_ROPE = OFF_AR + 7 * U38;
constexpr long WS_TOTAL = OFF_ROPE + 2 * 262144L;
constexpr long WO_IN = 0, WO_G = 5783552L, WO_B = 9977856L, WO_O = 12075008L, WO_1 = 13123584L, WO_2 = 17317888L;
constexpr int LDS_BYTES = 139264;
constexpr int NPHASE = 1 + 4 * 13;

struct Prm {
  const float *x, *c, *ctx, *c_ctx, *w_ada, *b_ada, *norm1, *norm2, *w_in, *qk_gain, *lam, *subln, *hy_conv, *hy_w1,
      *hy_b1, *hy_freq, *hy_w2, *hy_b2, *hy_w3, *hy_bias, *dn_conv, *dn_a_log, *dn_dt_bias, *dn_norm, *w_gate,
      *w_branch, *w_o, *w_mlp1, *w_mlp2;
  float* out;
  char* ws;
};

DI int mytid() {
  int t = threadIdx.x;
  asm volatile("" : "+v"(t));
  return t;
}
DI int mybid() {
  int t = blockIdx.x;
  asm volatile("" : "+s"(t));
  return t;
}
DI void lds_barrier() {
  asm volatile("s_waitcnt lgkmcnt(0)" ::: "memory");
  __builtin_amdgcn_s_barrier();
  asm volatile("" ::: "memory");
}
typedef __bf16 bf16x2_t __attribute__((ext_vector_type(2)));
typedef float f32x2_t __attribute__((ext_vector_type(2)));
DI unsigned pk_bf16(float a, float b) {
  f32x2_t v = {a, b};
  bf16x2_t h = __builtin_convertvector(v, bf16x2_t);
  return *(unsigned*)&h;
}
DI u16 f2bf(float f) {
  __bf16 h = (__bf16)f;
  return *(u16*)&h;
}
DI float bf2f(u16 h) { return __uint_as_float(((unsigned)h) << 16); }
DI float wsum(float v) {
  for (int o = 32; o; o >>= 1) v += __shfl_xor(v, o);
  return v;
}
DI float wmax(float v) {
  for (int o = 32; o; o >>= 1) v = fmaxf(v, __shfl_xor(v, o));
  return v;
}
DI float siluf(float v) { return v / (1.f + __expf(-v)); }
DI float sigmf(float v) { return 1.f / (1.f + __expf(-v)); }
DI float* xrow(const Prm& p, int tok) {
  return tok < T_LAT ? p.out + (long)tok * 1024 : (float*)(p.ws + OFF_XC) + (long)(tok - T_LAT) * 1024;
}
DI int first_item(long base) {
  int G = gridDim.x;
  return (int)(((long)mybid() + G - (base % G)) % G);
}
DI int tokof(int b, int P) { return P < 256 ? T_LAT + b * 256 + P : b * 2048 + (P - 256); }

typedef __attribute__((ext_vector_type(4))) unsigned u32x4;
struct Stg { u32x4 a0, a1, a2, a3, b0, b1; };
template <int NA>
DI void g_load(Stg& r, const u16* Ap, long lda, const u16* Bp, long ldb, int k0) {
  r.a0 = *(const u32x4*)(Ap + k0);
  r.a1 = *(const u32x4*)(Ap + 64 * lda + k0);
  if constexpr (NA == 4) {
    r.a2 = *(const u32x4*)(Ap + 128 * lda + k0);
    r.a3 = *(const u32x4*)(Ap + 192 * lda + k0);
  }
  r.b0 = *(const u32x4*)(Bp + k0);
  r.b1 = *(const u32x4*)(Bp + 64 * ldb + k0);
}
template <int NA, int TM>
DI void s_store(const Stg& r, u16* ns_) {
  *(u32x4*)(ns_) = r.a0;
  *(u32x4*)(ns_ + 64 * 80) = r.a1;
  if constexpr (NA == 4) {
    *(u32x4*)(ns_ + 128 * 80) = r.a2;
    *(u32x4*)(ns_ + 192 * 80) = r.a3;
  }
  *(u32x4*)(ns_ + TM * 80) = r.b0;
  *(u32x4*)(ns_ + TM * 80 + 64 * 80) = r.b1;
}
template <int MI>
DI void t_compute(f32x4 (&acc)[MI][4], const u16* as, const u16* bs, int wm, int wn, int fr, int fq) {
#pragma unroll
  for (int ks = 0; ks < 2; ++ks) {
    bf16x8 a[MI], b[4];
#pragma unroll
    for (int mi = 0; mi < MI; ++mi) a[mi] = *(const bf16x8*)(as + (wm * MI * 16 + mi * 16 + fr) * 80 + ks * 32 + fq * 8);
#pragma unroll
    for (int ni = 0; ni < 4; ++ni) b[ni] = *(const bf16x8*)(bs + (wn * 64 + ni * 16 + fr) * 80 + ks * 32 + fq * 8);
#pragma unroll
    for (int mi = 0; mi < MI; ++mi)
#pragma unroll
      for (int ni = 0; ni < 4; ++ni) acc[mi][ni] = MFMA(b[ni], a[mi], acc[mi][ni]);
  }
}
template <int MI>
DI void gemm_tile(f32x4 (&acc)[MI][4], const u16* __restrict__ A, long lda, const u16* __restrict__ B, long ldb, int K,
                  char* smem, Stg& r0, Stg& r1, bool pre, const u16* nA, long nlda, const u16* nB, long nldb) {
  constexpr int TM = MI * 64;
  constexpr int STAGE = (TM + 128) * 80;
  constexpr int NA = TM * 8 / 512;
  u16* s = (u16*)smem;
  const int tid = mytid(), lane = tid & 63, wid = tid >> 6;
  const int wm = wid >> 1, wn = wid & 1, fr = lane & 15, fq = lane >> 4;
  const long to_a = (long)(tid >> 3), to_c = (tid & 7) * 8;
  const u16* Ap = A + to_a * lda + to_c;
  const u16* Bp = B + to_a * ldb + to_c;
  const u16* nAp = nA + to_a * nlda + to_c;
  const u16* nBp = nB + to_a * nldb + to_c;
  const int so = (tid >> 3) * 80 + (tid & 7) * 8;
#define GLOAD(r, k0) g_load<NA>(r, Ap, lda, Bp, ldb, (k0))
#define NLOAD(r, k0) g_load<NA>(r, nAp, nlda, nBp, nldb, (k0))
#define SSTORE(r, st) s_store<NA, TM>(r, s + (st) * STAGE + so)
#define COMPUTE(st) t_compute<MI>(acc, s + (st) * STAGE, s + (st) * STAGE + TM * 80, wm, wn, fr, fq)
#pragma unroll
  for (int mi = 0; mi < MI; ++mi)
#pragma unroll
    for (int ni = 0; ni < 4; ++ni) acc[mi][ni] = f32x4{0.f, 0.f, 0.f, 0.f};
  const int nk = K >> 6;
  if (!pre) {
    GLOAD(r0, 0);
    GLOAD(r1, 64);
  }
  SSTORE(r0, 0);
  lds_barrier();
  for (int kt = 0; kt < nk; kt += 2) {
    if (kt + 2 < nk) GLOAD(r0, (kt + 2) << 6);
    else if (nA) NLOAD(r0, 0);
    COMPUTE(0);
    SSTORE(r1, 1);
    lds_barrier();
    if (kt + 3 < nk) GLOAD(r1, (kt + 3) << 6);
    else if (nA) NLOAD(r1, 64);
    COMPUTE(1);
    if (kt + 2 < nk) SSTORE(r0, 0);
    lds_barrier();
  }
#undef GLOAD
#undef NLOAD
#undef SSTORE
#undef COMPUTE
}

struct TD {
  const u16* A;
  const u16* B;
  u16* C;
  long lda, ldb, ldc;
  int K;
  int mode;
  int split;
  float scale;
  int tok0, col0;
  const float* g;
};

DI void run_tile2(const Prm& p, const TD& d, char* smem, Stg& r0, Stg& r1, bool pre, const u16* nA, long nlda,
                 const u16* nB, long nldb);
DI void run_tile(const Prm& p, const TD& d, char* smem) {
  Stg r0, r1;
  run_tile2(p, d, smem, r0, r1, false, nullptr, 0, nullptr, 0);
}
DI void run_tile2(const Prm& p, const TD& d, char* smem, Stg& r0, Stg& r1, bool pre, const u16* nA, long nlda,
                 const u16* nB, long nldb) {
  f32x4 acc[4][4];
  gemm_tile<4>(acc, d.A, d.lda, d.B, d.ldb, d.K, smem, r0, r1, pre, nA, nlda, nB, nldb);
  const int tid = mytid(), lane = tid & 63, wid = tid >> 6;
  const int wm = wid >> 1, wn = wid & 1, fr = lane & 15, fq = lane >> 4;
  if (d.mode == 4) {
    const int which = d.col0 >> 2, h = d.col0 & 3;
    const float* gain = d.g + which * 64 + fq * 4;
    const float* RC = (const float*)(p.ws + OFF_ROPE);
    const float* RS = RC + 65536;
    u16* dstb = d.C + (which ? 18874368L : 0L);
    const float qs = which ? 1.f : 0.18033688011112042f;
#pragma unroll
    for (int mi = 0; mi < 4; ++mi) {
      const int tok = d.tok0 + wm * 64 + mi * 16 + fr;
      float ss = 0.f;
#pragma unroll
      for (int ni = 0; ni < 4; ++ni)
#pragma unroll
        for (int j = 0; j < 4; ++j) ss += acc[mi][ni][j] * acc[mi][ni][j];
      ss += __shfl_xor(ss, 16);
      ss += __shfl_xor(ss, 32);
      const float inv = rsqrtf(ss * (1.f / 64.f) + 1e-6f) * qs;
      int b, P;
      const bool lat = tok < T_LAT;
      if (lat) { b = tok >> 11; P = 256 + (tok & 2047); }
      else { b = (tok - T_LAT) >> 8; P = (tok - T_LAT) & 255; }
      float y[4][4];
#pragma unroll
      for (int ni = 0; ni < 4; ++ni) {
        float4 g4 = *(const float4*)(gain + ni * 16);
        y[ni][0] = acc[mi][ni][0] * inv * g4.x; y[ni][1] = acc[mi][ni][1] * inv * g4.y;
        y[ni][2] = acc[mi][ni][2] * inv * g4.z; y[ni][3] = acc[mi][ni][3] * inv * g4.w;
      }
      u16* dst = dstb + ((long)((b * 4 + h) * 2 + wn) * 2304 + P) * 64 + fq * 4;
#pragma unroll
      for (int ni = 0; ni < 4; ++ni) {
        float o0 = y[ni][0], o1 = y[ni][1], o2 = y[ni][2], o3 = y[ni][3];
        if (lat) {
          const int l = tok & 2047, a = ni >> 1;
          float4 c4 = *(const float4*)(RC + (l * 2 + a) * 16 + fq * 4);
          float4 s4 = *(const float4*)(RS + (l * 2 + a) * 16 + fq * 4);
          const float sg = (ni & 1) ? 1.f : -1.f;
          o0 = y[ni][0] * c4.x + sg * y[ni ^ 1][0] * s4.x;
          o1 = y[ni][1] * c4.y + sg * y[ni ^ 1][1] * s4.y;
          o2 = y[ni][2] * c4.z + sg * y[ni ^ 1][2] * s4.z;
          o3 = y[ni][3] * c4.w + sg * y[ni ^ 1][3] * s4.w;
        }
        uint2 o;
        o.x = pk_bf16(o0, o1);
        o.y = pk_bf16(o2, o3);
        *(uint2*)(dst + ni * 16) = o;
      }
    }
    return;
  }
#pragma unroll
  for (int mi = 0; mi < 4; ++mi)
#pragma unroll
    for (int ni = 0; ni < 4; ++ni) {
      int r = wm * 64 + mi * 16 + fr, c = wn * 64 + ni * 16 + fq * 4;
      f32x4 v = acc[mi][ni];
      if (d.mode == 0) {
        long ro = d.split ? ((long)(r & 127) * d.ldc + (long)(r >> 7) * d.split) : (long)r * d.ldc;
        ushort4 o;
        o.x = f2bf(v[0] * d.scale); o.y = f2bf(v[1] * d.scale); o.z = f2bf(v[2] * d.scale); o.w = f2bf(v[3] * d.scale);
        *(ushort4*)(d.C + ro + c) = o;
      } else if (d.mode == 1) {
        ushort4 o;
        float t0 = fmaxf(v[0], 0.f), t1 = fmaxf(v[1], 0.f), t2 = fmaxf(v[2], 0.f), t3 = fmaxf(v[3], 0.f);
        o.x = f2bf(t0 * t0); o.y = f2bf(t1 * t1); o.z = f2bf(t2 * t2); o.w = f2bf(t3 * t3);
        *(ushort4*)(d.C + (long)r * d.ldc + c) = o;
      } else if (d.mode == 3) {
        if (wn == 0 && ni == 0) *(float4*)((float*)d.C + (long)r * 16 + fq * 4) = float4{v[0], v[1], v[2], v[3]};
      } else {
        float4* xp = (float4*)(xrow(p, d.tok0 + r) + d.col0 + c);
        float4 g4 = *(const float4*)(d.g + d.col0 + c);
        float4 x4 = *xp;
        x4.x += g4.x * v[0]; x4.y += g4.y * v[1]; x4.z += g4.z * v[2]; x4.w += g4.w * v[3];
        *xp = x4;
      }
    }
}

DI void ph_init(const Prm& p, char* smem) {
  const long gt = (long)mybid() * 512 + mytid(), gn = (long)gridDim.x * 512;
  {
    const float4* s = (const float4*)p.x;
    float4* d = (float4*)p.out;
    for (long i = gt; i < 32768L * 256; i += gn) d[i] = s[i];
    const float4* s2 = (const float4*)p.ctx;
    float4* d2 = (float4*)(p.ws + OFF_XC);
    for (long i = gt; i < 4096L * 256; i += gn) d2[i] = s2[i];
  }
  {
    u16* DL = (u16*)(p.ws + OFF_DL);
    for (long i = gt; i < 2048L * 4096; i += gn) {
      int l = (int)(i >> 12), kk = (int)(i & 4095), lp = kk & 2047, part = kk >> 11;
      int m = (l * lp) & 2047;
      float ang = (float)m * (6.283185307179586f / 2048.f);
      DL[i] = f2bf(part ? -sinf(ang) : cosf(ang));
    }
    u16* DLC = (u16*)(p.ws + OFF_DLC);
    for (long i = gt; i < 256L * 512; i += gn) {
      int l = (int)(i >> 9), kk = (int)(i & 511), lp = kk & 255, part = kk >> 8;
      int m = (l * lp) & 255;
      float ang = (float)m * (6.283185307179586f / 256.f);
      DLC[i] = f2bf(part ? -sinf(ang) : cosf(ang));
    }
    {
      float* RC = (float*)(p.ws + OFF_ROPE);
      float* RS = RC + 65536;
      for (long i = gt; i < 65536; i += gn) {
        int l = (int)(i >> 5), a = (int)(i >> 4) & 1, f = (int)(i & 15);
        float pos = a ? (float)(l & 63) : (float)(l >> 6);
        float ang = pos * powf(10000.f, -(float)f / 16.f);
        RC[i] = cosf(ang);
        RS[i] = sinf(ang);
      }
    }
    u16* DC = (u16*)(p.ws + OFF_DC);
    for (long i = gt; i < 256L * 128; i += gn) {
      int j2 = (int)(i >> 7), ii = (int)(i & 127), part = j2 >> 7, j = j2 & 127;
      int m = (ii * j) & 127;
      float ang = (float)m * (6.283185307179586f / 128.f);
      DC[i] = f2bf(part ? sinf(ang) : cosf(ang));
    }
  }
  float* sc = (float*)smem;
  float* red = sc + 17 * 1024;
  const int tid = mytid();
  for (int e = tid; e < 17 * 1024; e += 512) {
    int bb = e >> 10, k = e & 1023;
    float v = bb < 16 ? p.c[bb * 1024 + k] : p.c_ctx[k];
    sc[e] = v / (1.f + expf(-v));
  }
  __syncthreads();
  float* MOD = (float*)(p.ws + OFF_MOD);
  for (int it = mybid(); it < 192; it += gridDim.x) {
    int li = it / 48, cgp = it % 48;
    int cl = tid & 127, kq = tid >> 7, n = cgp * 128 + cl;
    float a[17];
#pragma unroll
    for (int b = 0; b < 17; ++b) a[b] = 0.f;
    const float* w = p.w_ada + ((long)li * 1024 + kq * 256) * 6144 + n;
#pragma unroll 2
    for (int k = 0; k < 256; ++k) {
      float wv = w[(long)k * 6144];
#pragma unroll
      for (int b = 0; b < 17; ++b) a[b] += sc[b * 1024 + kq * 256 + k] * wv;
    }
#pragma unroll
    for (int b = 0; b < 17; ++b) red[(kq * 17 + b) * 128 + cl] = a[b];
    __syncthreads();
    for (int e = tid; e < 17 * 128; e += 512) {
      int b = e >> 7, c2 = e & 127, n2 = cgp * 128 + c2;
      float v = p.b_ada[li * 6144 + n2];
      for (int q = 0; q < 4; ++q) v += red[(q * 17 + b) * 128 + c2];
      MOD[((long)li * 17 + b) * 6144 + n2] = v;
    }
    __syncthreads();
  }
}

DI long tr_job(long base, const float* src, int K, int N, u16* dst, int nb, char* smem) {
  float* t = (float*)smem;
  const int tk = K >> 6, tn = (N + 63) >> 6, per = tk * tn, total = per * nb;
  const int tid = mytid();
  const int G = gridDim.x;
  float v[8];
  int it = first_item(base);
  if (it < total) {
    int b = it / per, r = it % per, kt = r / tn, nt = r % tn;
    const float* s = src + (long)b * K * N;
#pragma unroll
    for (int i = 0; i < 8; ++i) {
      int id = tid + i * 512, kk = id >> 6, nn = id & 63;
      v[i] = (nt * 64 + nn < N) ? s[(long)(kt * 64 + kk) * N + nt * 64 + nn] : 0.f;
    }
  }
  for (; it < total; it += G) {
    int b = it / per, r = it % per, kt = r / tn, nt = r % tn;
    u16* d = dst + (long)b * K * N;
    int k0 = kt * 64, n0 = nt * 64;
#pragma unroll
    for (int i = 0; i < 8; ++i) {
      int id = tid + i * 512, kk = id >> 6, nn = id & 63;
      t[kk * 65 + nn] = v[i];
    }
    __syncthreads();
    if (it + G < total) {
      int it2 = it + G, b2 = it2 / per, r2 = it2 % per, kt2 = r2 / tn, nt2 = r2 % tn;
      const float* s2 = src + (long)b2 * K * N;
#pragma unroll
      for (int i = 0; i < 8; ++i) {
        int id = tid + i * 512, kk = id >> 6, nn = id & 63;
        v[i] = (nt2 * 64 + nn < N) ? s2[(long)(kt2 * 64 + kk) * N + nt2 * 64 + nn] : 0.f;
      }
    }
#pragma unroll
    for (int i = 0; i < 8; ++i) {
      int id = tid + i * 512, nn = id >> 6, kk = id & 63;
      if (n0 + nn < N) d[(long)(n0 + nn) * K + k0 + kk] = f2bf(t[kk * 65 + nn]);
    }
    __syncthreads();
  }
  return base + total;
}

DI void ph_norm(const Prm& p, int li, int which) {
  const int lane = mytid() & 63;
  const int gw = mybid() * 8 + (mytid() >> 6), nw = gridDim.x * 8;
  const float* nwt = (which ? p.norm2 : p.norm1) + li * 1024;
  const float* MOD = (const float*)(p.ws + OFF_MOD);
  u16* H = (u16*)(p.ws + OFF_HBF);
  const int nrows = (which && li == 3) ? T_LAT : T_ALL;
  for (int row = gw; row < nrows; row += nw) {
    const float* xr = xrow(p, row);
    float4 v[4];
    float ss = 0.f;
#pragma unroll
    for (int i = 0; i < 4; ++i) {
      v[i] = *(const float4*)(xr + i * 256 + lane * 4);
      ss += v[i].x * v[i].x + v[i].y * v[i].y + v[i].z * v[i].z + v[i].w * v[i].w;
    }
    ss = wsum(ss);
    float inv = rsqrtf(ss * (1.f / 1024.f) + 1e-6f);
    int bb = row < T_LAT ? (row >> 11) : 16;
    const float* sh = MOD + ((long)li * 17 + bb) * 6144 + (which ? 3 : 0) * 1024;
    const float* scp = sh + 1024;
#pragma unroll
    for (int i = 0; i < 4; ++i) {
      int c = i * 256 + lane * 4;
      float4 w4 = *(const float4*)(nwt + c), s4 = *(const float4*)(scp + c), h4 = *(const float4*)(sh + c);
      ushort4 o;
      o.x = f2bf(v[i].x * inv * w4.x * (1.f + s4.x) + h4.x);
      o.y = f2bf(v[i].y * inv * w4.y * (1.f + s4.y) + h4.y);
      o.z = f2bf(v[i].z * inv * w4.z * (1.f + s4.z) + h4.z);
      o.w = f2bf(v[i].w * inv * w4.w * (1.f + s4.w) + h4.w);
      *(ushort4*)(H + (long)row * 1024 + c) = o;
    }
  }
}

DI void ph_taps1(const Prm& p, int li, long base, char* smem) {
  float* f = (float*)smem;
  float* hraw = (float*)(p.ws + OFF_AR + 5 * U38);
  const int tid = mytid();
  for (int it = first_item(base); it < 288; it += gridDim.x) {
    const int L = it < 256 ? 2048 : 256, j0 = it < 256 ? it * 8 : (it - 256) * 8;
    const int lg = tid >> 6, kk = tid & 63;
    if (tid < 8 * 33) {
      int l2 = tid / 33, e = tid % 33, j = j0 + l2;
      float t = (float)j / (float)(L - 1);
      float w = 6.283185307179586f * (float)j / (float)L;
      float v;
      if (e == 0) v = t;
      else {
        int bi = (e - 1) & 15;
        float band = 1e-4f + (float)bi * ((15.f - 1e-4f) / 15.f);
        v = (e <= 16) ? cosf(band * w) : -sinf(band * w);
      }
      f[l2 * 40 + e] = v;
    }
    __syncthreads();
    {
      float v = p.hy_b1[li * 64 + kk];
#pragma unroll 3
      for (int e = 0; e < 33; ++e) v += f[lg * 40 + e] * p.hy_w1[(li * 33 + e) * 64 + kk];
      f[320 + lg * 64 + kk] = sinf(p.hy_freq[(li * 2 + 0) * 64 + kk] * v);
    }
    __syncthreads();
    {
      float v = p.hy_b2[li * 64 + kk];
#pragma unroll 4
      for (int m = 0; m < 64; ++m) v += f[320 + lg * 64 + m] * p.hy_w2[(li * 64 + m) * 64 + kk];
      f[832 + lg * 64 + kk] = sinf(p.hy_freq[(li * 2 + 1) * 64 + kk] * v);
    }
    __syncthreads();
    {
      float h[4][8];
#pragma unroll
      for (int i = 0; i < 4; ++i)
#pragma unroll
        for (int l2 = 0; l2 < 8; ++l2) h[i][l2] = 0.f;
      const float* w3 = p.hy_w3 + (long)li * 64 * 2048 + tid;
#pragma unroll 2
      for (int k = 0; k < 64; ++k) {
        float wv[4];
#pragma unroll
        for (int i = 0; i < 4; ++i) wv[i] = w3[(long)k * 2048 + i * 512];
#pragma unroll
        for (int l2 = 0; l2 < 8; ++l2) {
          float hv = f[832 + l2 * 64 + k];
#pragma unroll
          for (int i = 0; i < 4; ++i) h[i][l2] += hv * wv[i];
        }
      }
#pragma unroll
      for (int i = 0; i < 4; ++i) {
        int n = tid + i * 512, ch = n & 511;
        float delta = fabsf(-3.0701134573253946f + (float)ch * ((-15.350567286626973f + 3.0701134573253946f) / 511.f));
#pragma unroll
        for (int l2 = 0; l2 < 8; ++l2) {
          int j = j0 + l2;
          float t = (float)j / (float)(L - 1);
          long row = (it < 256) ? j : 2048 + j;
          hraw[row * 2048 + n] = h[i][l2] * expf(-t * delta);
        }
      }
    }
    __syncthreads();
  }
}
DI void ph_taps2(const Prm& p, long base, char* smem) {
  float* red = (float*)smem;
  const float* hraw = (const float*)(p.ws + OFF_AR + 5 * U38);
  const int tid = mytid(), cl = tid & 3, dir = (tid >> 2) & 1, jg = tid >> 3;
  for (int it = first_item(base); it < 512; it += gridDim.x) {
    int ls = it >> 8, order = (it >> 7) & 1, cgp = it & 127;
    int L = ls ? 256 : 2048;
    const float* hr = hraw + (long)(ls ? 2048 : 0) * 2048;
    u16* G = (u16*)(p.ws + (ls ? OFF_TAPC : OFF_TAPL));
    int ch = cgp * 4 + cl, n = order * 1024 + dir * 512 + ch;
    float s = 0.f;
#pragma unroll 8
    for (int j = jg; j < L; j += 64) {
      float v = fabsf(hr[(long)j * 2048 + n]);
      s += (dir == 1 && j == 0) ? 0.f : v;
    }
    red[(tid >> 2) * 4 + cl] = s;
    __syncthreads();
    float tot = 0.f;
#pragma unroll 8
    for (int q = 0; q < 128; ++q) tot += red[q * 4 + cl];
    float inv = 1.f / tot;
    u16* g = G + (long)(order * 512 + ch) * (2 * L);
#pragma unroll 8
    for (int j = jg; j < L; j += 64) {
      float v = hr[(long)j * 2048 + n] * inv;
      if (dir == 0) g[L + j] = f2bf(v);
      else if (j > 0) g[L - j] = f2bf(v);
    }
    if (dir == 1 && jg == 0) g[0] = 0;
    __syncthreads();
  }
}

DI void ph_pdab(const Prm& p, int li, char* smem) {
  float* wl = (float*)smem;
  const int tid = mytid(), lane = tid & 63;
#pragma unroll 8
  for (int e = tid; e < 1024 * 16; e += 512) wl[e] = p.w_in[((long)li * 1024 + (e >> 4)) * NIN + 5632 + (e & 15)];
  __syncthreads();
  const u16* H = (const u16*)(p.ws + OFF_HBF);
  float* out = (float*)(p.ws + OFF_PDAB);
  const int gw = mybid() * 8 + (tid >> 6), nw = gridDim.x * 8;
  for (int tok = gw; tok < T_ALL; tok += nw) {
    float a[16];
#pragma unroll
    for (int j = 0; j < 16; ++j) a[j] = 0.f;
    float hv[16];
#pragma unroll
    for (int i = 0; i < 16; ++i) hv[i] = bf2f(H[(long)tok * 1024 + lane + i * 64]);
#pragma unroll
    for (int i = 0; i < 16; ++i) {
      float h = hv[i];
      const float4* wp = (const float4*)(wl + (lane + i * 64) * 16);
#pragma unroll
      for (int q = 0; q < 4; ++q) {
        float4 w4 = wp[q];
        a[q * 4 + 0] += h * w4.x;
        a[q * 4 + 1] += h * w4.y;
        a[q * 4 + 2] += h * w4.z;
        a[q * 4 + 3] += h * w4.w;
      }
      if ((i & 3) == 3) asm volatile("" ::: "memory");
    }
#pragma unroll
    for (int o = 32; o; o >>= 1)
#pragma unroll
      for (int j = 0; j < 16; ++j) a[j] += __shfl_xor(a[j], o);
    float v = a[0];
#pragma unroll
    for (int j = 1; j < 16; ++j) v = (lane == j) ? a[j] : v;
    if (lane < 16) out[(long)tok * 16 + lane] = v;
  }
  __syncthreads();
}

DI void ph_dncl(const Prm& p, int li, char* smem) {
  const int tid = mytid(), lane = tid & 63, wid = tid >> 6, fr = lane & 15, fq = lane >> 4;
  u16* qn = (u16*)smem;
  u16* kn = qn + 64 * 144;
  float* fb = (float*)(smem + 36864);
  float* KK = fb;
  float* QK = KK + 64 * 65;
  float* Am = QK + 64 * 65;
  float* Tm = Am + 2 * 64 * 65;
  float* gcs = Tm + 2 * 64 * 65;
  float* bts = gcs + 128;
  const u16* PD = (const u16*)(p.ws + OFF_AR);
  const float* AB = (const float*)(p.ws + OFF_PDAB);
  u16* DQ = (u16*)(p.ws + OFF_Y);
  u16* DK = DQ + 18874368L;
  u16* DV = DK + 18874368L;
  u16* CL = (u16*)(p.ws + OFF_AR + 3 * U38);
  float* GC = (float*)(p.ws + OFF_GC);
  float* BT = (float*)(p.ws + OFF_BETA);
  const float* cw = p.dn_conv + (long)li * 3 * 1536;
  for (int it = mybid(); it < 2304; it += gridDim.x) {
    const int b = it / 144, r0 = it % 144, oc = r0 >> 2, h = r0 & 3;
    const int pos0 = oc * 64, s0 = oc < 4 ? 0 : 256, e0 = oc < 4 ? 256 : 2304;
    if (tid < 384) {
      const int cgp = tid % 48, rs = tid / 48;
      const int part = cgp >> 4, d0 = (cgp & 15) * 8, col = part * 512 + h * 128 + d0;
      const u16* basep = PD + (long)tokof(b, pos0) * 1536 + col;
      float wt[3][8];
#pragma unroll
      for (int tp = 0; tp < 3; ++tp) {
        float4 wa = *(const float4*)(cw + tp * 1536 + col), wb = *(const float4*)(cw + tp * 1536 + col + 4);
        wt[tp][0] = wa.x; wt[tp][1] = wa.y; wt[tp][2] = wa.z; wt[tp][3] = wa.w;
        wt[tp][4] = wb.x; wt[tp][5] = wb.y; wt[tp][6] = wb.z; wt[tp][7] = wb.w;
      }
#pragma unroll 1
      for (int hf = 0; hf < 2; ++hf) {
        u32x4 rw[6];
#pragma unroll
        for (int i = 0; i < 6; ++i) {
          int j = rs * 8 + hf * 4 - 1 + i, P = pos0 + j;
          rw[i] = (P >= s0 && P < e0) ? *(const u32x4*)(basep + (long)j * 1536) : u32x4{0u, 0u, 0u, 0u};
        }
#pragma unroll
        for (int r = 0; r < 4; ++r) {
#pragma unroll
          for (int e = 0; e < 8; ++e) {
            unsigned w0_ = rw[r][e >> 1], w1_ = rw[r + 1][e >> 1], w2_ = rw[r + 2][e >> 1];
            float x0 = (e & 1) ? __uint_as_float(w0_ & 0xffff0000u) : __uint_as_float(w0_ << 16);
            float x1 = (e & 1) ? __uint_as_float(w1_ & 0xffff0000u) : __uint_as_float(w1_ << 16);
            float x2 = (e & 1) ? __uint_as_float(w2_ & 0xffff0000u) : __uint_as_float(w2_ << 16);
            float v = wt[0][e] * x0 + wt[1][e] * x1 + wt[2][e] * x2;
            fb[(rs * 8 + hf * 4 + r) * 385 + part * 128 + d0 + e] = v / (1.f + __expf(-v));
          }
        }
      }
    }
    __syncthreads();
    for (int jj = 0; jj < 8; ++jj) {
      int j = wid * 8 + jj, P = pos0 + j;
      long go = ((long)(b * 4 + h) * 2304 + P) * 128;
      float q0 = fb[j * 385 + lane], q1 = fb[j * 385 + 64 + lane];
      float k0 = fb[j * 385 + 128 + lane], k1 = fb[j * 385 + 192 + lane];
      float v0 = fb[j * 385 + 256 + lane], v1 = fb[j * 385 + 320 + lane];
      float iq = rsqrtf(wsum(q0 * q0 + q1 * q1) + 1e-6f), ik = rsqrtf(wsum(k0 * k0 + k1 * k1) + 1e-6f);
      u16 a0 = f2bf(q0 * iq), a1 = f2bf(q1 * iq), c0 = f2bf(k0 * ik), c1 = f2bf(k1 * ik);
      qn[j * 144 + lane] = a0; qn[j * 144 + 64 + lane] = a1;
      kn[j * 144 + lane] = c0; kn[j * 144 + 64 + lane] = c1;
      DQ[go + lane] = a0; DQ[go + 64 + lane] = a1;
      DK[go + lane] = c0; DK[go + 64 + lane] = c1;
      DV[go + lane] = f2bf(v0); DV[go + 64 + lane] = f2bf(v1);
    }
    __syncthreads();
#pragma unroll
    for (int u = 0; u < 4; ++u) {
      int tt = wid * 4 + u, which = tt >> 4, ti = (tt >> 2) & 3, tj = tt & 3;
      const u16* Ap = (which ? qn : kn) + (ti * 16 + fr) * 144 + fq * 8;
      const u16* Bp = kn + (tj * 16 + fr) * 144 + fq * 8;
      f32x4 a = {0.f, 0.f, 0.f, 0.f};
#pragma unroll
      for (int ks = 0; ks < 4; ++ks) a = MFMA(*(const bf16x8*)(Ap + ks * 32), *(const bf16x8*)(Bp + ks * 32), a);
      float* dst = which ? QK : KK;
#pragma unroll
      for (int j = 0; j < 4; ++j) dst[(ti * 16 + fq * 4 + j) * 65 + tj * 16 + fr] = a[j];
    }
    if (tid < 128) {
      int d = tid >> 6, r = tid & 63, j = d ? 63 - r : r;
      int tok = tokof(b, pos0 + j);
      float av = AB[(long)tok * 16 + d * 4 + h], bv = AB[(long)tok * 16 + 8 + d * 4 + h];
      float xx = av + p.dn_dt_bias[li * 8 + d * 4 + h];
      float sp = fmaxf(xx, 0.f) + __logf(1.f + __expf(-fabsf(xx)));
      float g = -expf(p.dn_a_log[li * 8 + d * 4 + h]) * sp;
      for (int o = 1; o < 64; o <<= 1) {
        float t = __shfl_up(g, o);
        if (r >= o) g += t;
      }
      float be = 1.f / (1.f + expf(-bv));
      gcs[d * 64 + r] = g;
      bts[d * 64 + r] = be;
      long ci = ((long)((b * 4 + h) * 2 + d) * 36 + oc) * 64 + r;
      GC[ci] = g;
      BT[ci] = be;
    }
    __syncthreads();
#pragma unroll 4
    for (int e = tid; e < 8192; e += 512) {
      int d = e >> 12, s = (e >> 6) & 63, r = e & 63;
      int j = d ? 63 - r : r, js = d ? 63 - s : s;
      float v = 0.f;
      if (r > s) v = bts[d * 64 + r] * KK[j * 65 + js] * expf(gcs[d * 64 + r] - gcs[d * 64 + s]);
      Am[(d * 64 + s) * 64 + r] = v;
    }
#pragma unroll 4
    for (int e = tid; e < 8192; e += 512) {
      int d = e >> 12, r = (e >> 6) & 63, s = e & 63;
      int j = d ? 63 - r : r, js = d ? 63 - s : s;
      float dec = (r >= s) ? expf(gcs[d * 64 + r] - gcs[d * 64 + s]) : 0.f;
      long ci = (long)((b * 4 + h) * 2 + d) * 36 + oc;
      CL[ci * 8192 + 4096 + r * 64 + s] = f2bf(QK[j * 65 + js] * dec * 0.08838834764831845f);
    }
    __syncthreads();
    {
      const int d = tid >> 8, c = (tid >> 2) & 63, q = tid & 3;
      const float* Atq = Am + d * 64 * 64 + q;
      float* T = Tm + d * 64 * 65;
      float t[16];
#pragma unroll
      for (int i = 0; i < 16; ++i) t[i] = (4 * i + q == c) ? 1.f : 0.f;
#pragma unroll
      for (int s2 = 0; s2 < 63; ++s2) {
        constexpr int dummy = 0;
        const int is = s2 >> 2, qs = s2 & 3;
        const int ctl = qs | (qs << 2) | (qs << 4) | (qs << 6);
        int tsb;
        if (qs == 0) tsb = __builtin_amdgcn_update_dpp(0, __float_as_int(t[is]), 0x00, 0xf, 0xf, false);
        else if (qs == 1) tsb = __builtin_amdgcn_update_dpp(0, __float_as_int(t[is]), 0x55, 0xf, 0xf, false);
        else if (qs == 2) tsb = __builtin_amdgcn_update_dpp(0, __float_as_int(t[is]), 0xAA, 0xf, 0xf, false);
        else tsb = __builtin_amdgcn_update_dpp(0, __float_as_int(t[is]), 0xFF, 0xf, 0xf, false);
        (void)ctl; (void)dummy;
        const float ts = __int_as_float(tsb);
#pragma unroll
        for (int i = is; i < 16; ++i) t[i] -= Atq[s2 * 64 + 4 * i] * ts;
        if ((s2 & 7) == 7) asm volatile("" ::: "memory");
      }
#pragma unroll
      for (int i = 0; i < 16; ++i) T[(4 * i + q) * 65 + c] = t[i];
    }
    __syncthreads();
    for (int e = tid; e < 8192; e += 512) {
      int d = e >> 12, rc = e & 4095;
      long ci = (long)((b * 4 + h) * 2 + d) * 36 + oc;
      CL[ci * 8192 + rc] = f2bf(Tm[(d * 64 + (rc >> 6)) * 65 + (rc & 63)]);
    }
    __syncthreads();
  }
}

DI void ph_dnscan(const Prm& p, char* smem) {
  const int tid = mytid(), lane = tid & 63, wid = tid >> 6, fr = lane & 15, fq = lane >> 4;
  u16* Kg = (u16*)smem;
  u16* Qg = Kg + 64 * 144;
  u16* KdT = Qg + 64 * 144;
  u16* Tl = KdT + 128 * 80;
  u16* Il = Tl + 64 * 80;
  u16* ST = Il + 64 * 80;
  u16* RT = ST + 64 * 144;
  u16* VN = RT + 64 * 80;
  const u16* DQ = (const u16*)(p.ws + OFF_Y);
  const u16* DK = DQ + 18874368L;
  const u16* DV = DK + 18874368L;
  const u16* CL = (const u16*)(p.ws + OFF_AR + 3 * U38);
  const float* GC = (const float*)(p.ws + OFF_GC);
  const float* BT = (const float*)(p.ws + OFF_BETA);
  const int vt = wid & 3, rp = wid >> 2;
  for (int it = mybid(); it < 256; it += gridDim.x) {
    const int b = it >> 4, h = (it >> 2) & 3, d = (it >> 1) & 1, vs = it & 1;
    u16* O = (u16*)(p.ws + OFF_AR + (d ? 1 : 0) * U38);
    f32x4 S[4];
#pragma unroll
    for (int i = 0; i < 4; ++i) S[i] = f32x4{0.f, 0.f, 0.f, 0.f};
    for (int e = tid; e < 64 * 144; e += 512) ST[e] = 0;
    const long seqb = (long)(b * 4 + h) * 2304;
    const long cib = (long)((b * 4 + h) * 2 + d) * 36;
    u32x4 rk0, rk1, rq0, rq1, rT, rI;
    float rg0, rg1, rgl;
    uint2 rv0, rv1;
    float rb0, rb1;
    const int lr0 = tid >> 4, lr1 = (tid + 512) >> 4, lch = tid & 15;
    const int lj0 = d ? 63 - lr0 : lr0, lj1 = d ? 63 - lr1 : lr1;
    const int vr0 = (rp * 2) * 16 + fr, vr1 = (rp * 2 + 1) * 16 + fr;
    const int vj0 = d ? 63 - vr0 : vr0, vj1 = d ? 63 - vr1 : vr1;
#define SCAN_LOAD_KQ(ocx)                                                                    \
  {                                                                                          \
    const long ci_ = cib + (ocx);                                                            \
    const long g0_ = (seqb + (ocx) * 64 + lj0) * 128 + lch * 8, g1_ = (seqb + (ocx) * 64 + lj1) * 128 + lch * 8; \
    rk0 = *(const u32x4*)(DK + g0_); rk1 = *(const u32x4*)(DK + g1_);                        \
    rq0 = *(const u32x4*)(DQ + g0_); rq1 = *(const u32x4*)(DQ + g1_);                        \
    rT = *(const u32x4*)(CL + ci_ * 8192 + (tid >> 3) * 64 + (tid & 7) * 8);                 \
    rI = *(const u32x4*)(CL + ci_ * 8192 + 4096 + (tid >> 3) * 64 + (tid & 7) * 8);          \
    rg0 = GC[ci_ * 64 + lr0]; rg1 = GC[ci_ * 64 + lr1]; rgl = GC[ci_ * 64 + 63];             \
  }
#define SCAN_LOAD_V(ocx)                                                                     \
  {                                                                                          \
    const long ci_ = cib + (ocx);                                                            \
    rv0 = *(const uint2*)(DV + (seqb + (ocx) * 64 + vj0) * 128 + vs * 64 + vt * 16 + fq * 4); \
    rv1 = *(const uint2*)(DV + (seqb + (ocx) * 64 + vj1) * 128 + vs * 64 + vt * 16 + fq * 4); \
    rb0 = BT[ci_ * 64 + vr0]; rb1 = BT[ci_ * 64 + vr1];                                      \
  }
    {
      const int oc0 = d ? 3 : 0;
      SCAN_LOAD_KQ(oc0);
      SCAN_LOAD_V(oc0);
    }
    for (int i = 0; i < 36; ++i) {
      const int oc = d ? (i < 4 ? 3 - i : 39 - i) : i;
      const int ocn = d ? (i + 1 < 4 ? 3 - (i + 1) : 39 - (i + 1)) : i + 1;
      const int pos0 = oc * 64;
      const float gl = rgl;
      {
        float eg0 = __expf(rg0), ed0 = __expf(gl - rg0), eg1 = __expf(rg1), ed1 = __expf(gl - rg1);
        u32x4 ko0, qo0, ko1, qo1;
#pragma unroll
        for (int w = 0; w < 4; ++w) {
          float k0l = __uint_as_float(rk0[w] << 16), k0h = __uint_as_float(rk0[w] & 0xffff0000u);
          float q0l = __uint_as_float(rq0[w] << 16), q0h = __uint_as_float(rq0[w] & 0xffff0000u);
          float k1l = __uint_as_float(rk1[w] << 16), k1h = __uint_as_float(rk1[w] & 0xffff0000u);
          float q1l = __uint_as_float(rq1[w] << 16), q1h = __uint_as_float(rq1[w] & 0xffff0000u);
          ko0[w] = (unsigned)f2bf(k0l * eg0) | ((unsigned)f2bf(k0h * eg0) << 16);
          qo0[w] = (unsigned)f2bf(q0l * eg0 * 0.08838834764831845f) | ((unsigned)f2bf(q0h * eg0 * 0.08838834764831845f) << 16);
          ko1[w] = (unsigned)f2bf(k1l * eg1) | ((unsigned)f2bf(k1h * eg1) << 16);
          qo1[w] = (unsigned)f2bf(q1l * eg1 * 0.08838834764831845f) | ((unsigned)f2bf(q1h * eg1 * 0.08838834764831845f) << 16);
          KdT[(lch * 8 + 2 * w) * 80 + lr0] = f2bf(k0l * ed0);
          KdT[(lch * 8 + 2 * w + 1) * 80 + lr0] = f2bf(k0h * ed0);
          KdT[(lch * 8 + 2 * w) * 80 + lr1] = f2bf(k1l * ed1);
          KdT[(lch * 8 + 2 * w + 1) * 80 + lr1] = f2bf(k1h * ed1);
        }
        *(u32x4*)(Kg + lr0 * 144 + lch * 8) = ko0;
        *(u32x4*)(Qg + lr0 * 144 + lch * 8) = qo0;
        *(u32x4*)(Kg + lr1 * 144 + lch * 8) = ko1;
        *(u32x4*)(Qg + lr1 * 144 + lch * 8) = qo1;
        *(u32x4*)(Tl + (tid >> 3) * 80 + (tid & 7) * 8) = rT;
        *(u32x4*)(Il + (tid >> 3) * 80 + (tid & 7) * 8) = rI;
      }
      lds_barrier();
      if (i + 1 < 36) SCAN_LOAD_KQ(ocn);
      f32x4 ks_[2], qs_[2];
#pragma unroll
      for (int u = 0; u < 2; ++u) { ks_[u] = f32x4{0.f, 0.f, 0.f, 0.f}; qs_[u] = f32x4{0.f, 0.f, 0.f, 0.f}; }
#pragma unroll
      for (int kk = 0; kk < 4; ++kk) {
        bf16x8 a = *(const bf16x8*)(ST + (vt * 16 + fr) * 144 + kk * 32 + fq * 8);
#pragma unroll
        for (int u = 0; u < 2; ++u) {
          int rt = rp * 2 + u;
          bf16x8 bk = *(const bf16x8*)(Kg + (rt * 16 + fr) * 144 + kk * 32 + fq * 8);
          bf16x8 bq = *(const bf16x8*)(Qg + (rt * 16 + fr) * 144 + kk * 32 + fq * 8);
          ks_[u] = MFMA(a, bk, ks_[u]);
          qs_[u] = MFMA(a, bq, qs_[u]);
        }
      }
      {
        int v0 = vt * 16 + fq * 4;
        RT[(v0 + 0) * 80 + vr0] = f2bf(rb0 * (__uint_as_float(rv0.x << 16) - ks_[0][0]));
        RT[(v0 + 1) * 80 + vr0] = f2bf(rb0 * (__uint_as_float(rv0.x & 0xffff0000u) - ks_[0][1]));
        RT[(v0 + 2) * 80 + vr0] = f2bf(rb0 * (__uint_as_float(rv0.y << 16) - ks_[0][2]));
        RT[(v0 + 3) * 80 + vr0] = f2bf(rb0 * (__uint_as_float(rv0.y & 0xffff0000u) - ks_[0][3]));
        RT[(v0 + 0) * 80 + vr1] = f2bf(rb1 * (__uint_as_float(rv1.x << 16) - ks_[1][0]));
        RT[(v0 + 1) * 80 + vr1] = f2bf(rb1 * (__uint_as_float(rv1.x & 0xffff0000u) - ks_[1][1]));
        RT[(v0 + 2) * 80 + vr1] = f2bf(rb1 * (__uint_as_float(rv1.y << 16) - ks_[1][2]));
        RT[(v0 + 3) * 80 + vr1] = f2bf(rb1 * (__uint_as_float(rv1.y & 0xffff0000u) - ks_[1][3]));
      }
      if (i + 1 < 36) SCAN_LOAD_V(ocn);
      lds_barrier();
      {
        f32x4 vn[2];
#pragma unroll
        for (int u = 0; u < 2; ++u) vn[u] = f32x4{0.f, 0.f, 0.f, 0.f};
#pragma unroll
        for (int kk = 0; kk < 2; ++kk) {
          bf16x8 a = *(const bf16x8*)(RT + (vt * 16 + fr) * 80 + kk * 32 + fq * 8);
#pragma unroll
          for (int u = 0; u < 2; ++u) {
            bf16x8 bb = *(const bf16x8*)(Tl + ((rp * 2 + u) * 16 + fr) * 80 + kk * 32 + fq * 8);
            vn[u] = MFMA(a, bb, vn[u]);
          }
        }
#pragma unroll
        for (int u = 0; u < 2; ++u) {
          int r = (rp * 2 + u) * 16 + fr, v0 = vt * 16 + fq * 4;
#pragma unroll
          for (int j = 0; j < 4; ++j) VN[(v0 + j) * 80 + r] = f2bf(vn[u][j]);
        }
      }
      lds_barrier();
#pragma unroll
      for (int kk = 0; kk < 2; ++kk) {
        bf16x8 a = *(const bf16x8*)(VN + (vt * 16 + fr) * 80 + kk * 32 + fq * 8);
#pragma unroll
        for (int u = 0; u < 2; ++u) {
          bf16x8 bb = *(const bf16x8*)(Il + ((rp * 2 + u) * 16 + fr) * 80 + kk * 32 + fq * 8);
          qs_[u] = MFMA(a, bb, qs_[u]);
        }
      }
#pragma unroll
      for (int u = 0; u < 2; ++u) {
        int r = (rp * 2 + u) * 16 + fr, j = d ? 63 - r : r;
        u16* op = O + (long)tokof(b, pos0 + j) * 512 + h * 128 + vs * 64 + vt * 16 + fq * 4;
        ushort4 ov4;
        ov4.x = f2bf(qs_[u][0]); ov4.y = f2bf(qs_[u][1]); ov4.z = f2bf(qs_[u][2]); ov4.w = f2bf(qs_[u][3]);
        *(ushort4*)op = ov4;
      }
      {
        float ge = __expf(gl);
#pragma unroll
        for (int u = 0; u < 4; ++u) S[u] *= ge;
#pragma unroll
        for (int kk = 0; kk < 2; ++kk) {
          bf16x8 a = *(const bf16x8*)(VN + (vt * 16 + fr) * 80 + kk * 32 + fq * 8);
#pragma unroll
          for (int u = 0; u < 4; ++u) {
            bf16x8 bb = *(const bf16x8*)(KdT + ((rp * 4 + u) * 16 + fr) * 80 + kk * 32 + fq * 8);
            S[u] = MFMA(a, bb, S[u]);
          }
        }
#pragma unroll
        for (int u = 0; u < 4; ++u) {
          int dd = (rp * 4 + u) * 16 + fr, v0 = vt * 16 + fq * 4;
#pragma unroll
          for (int j = 0; j < 4; ++j) ST[(v0 + j) * 144 + dd] = f2bf(S[u][j]);
        }
      }
      lds_barrier();
    }
#undef SCAN_LOAD_KQ
#undef SCAN_LOAD_V
  }
}

DI void ph_dnfin(const Prm& p, int li) {
  const int lane = mytid() & 63;
  const int gw = mybid() * 8 + (mytid() >> 6), nw = gridDim.x * 8;
  const u16* O = (const u16*)(p.ws + OFF_AR);
  const u16* O2 = (const u16*)(p.ws + OFF_AR + U38);
  u16* Z = (u16*)(p.ws + OFF_Y + 3 * U38);
  const float n0 = p.dn_norm[li * 128 + lane * 2], n1 = p.dn_norm[li * 128 + lane * 2 + 1];
#pragma unroll 2
  for (int tok = gw; tok < T_ALL; tok += nw) {
    ushort2 oa[4], ob[4], zz[4];
    float ox[4], oy[4], ss[4];
#pragma unroll
    for (int h = 0; h < 4; ++h) {
      long o = (long)tok * 512 + h * 128 + lane * 2;
      oa[h] = *(const ushort2*)(O + o);
      ob[h] = *(const ushort2*)(O2 + o);
      zz[h] = *(const ushort2*)(Z + o);
    }
#pragma unroll
    for (int h = 0; h < 4; ++h) {
      ox[h] = bf2f(oa[h].x) + bf2f(ob[h].x);
      oy[h] = bf2f(oa[h].y) + bf2f(ob[h].y);
      ss[h] = ox[h] * ox[h] + oy[h] * oy[h];
    }
#pragma unroll
    for (int o = 32; o; o >>= 1)
#pragma unroll
      for (int h = 0; h < 4; ++h) ss[h] += __shfl_xor(ss[h], o);
#pragma unroll
    for (int h = 0; h < 4; ++h) {
      float inv = rsqrtf(ss[h] * (1.f / 128.f) + 1e-6f);
      float z0 = bf2f(zz[h].x), z1 = bf2f(zz[h].y);
      ushort2 y;
      y.x = f2bf(ox[h] * inv * n0 * (z0 / (1.f + __expf(-z0))));
      y.y = f2bf(oy[h] * inv * n1 * (z1 / (1.f + __expf(-z1))));
      *(ushort2*)(Z + (long)tok * 512 + h * 128 + lane * 2) = y;
    }
  }
}

DI void ph_aprep(const Prm& p, int li) {
  const int lane = mytid() & 63;
  const int gw = mybid() * 8 + (mytid() >> 6), nw = gridDim.x * 8;
  const u16* PA = (const u16*)(p.ws + OFF_AR);
  u16* QH = (u16*)(p.ws + OFF_AR + 3 * U38);
  u16* KH = QH + 18874368L;
  const int f = lane & 15;
  const float inv_f = powf(10000.f, -(float)f / 16.f);
  for (int tok = gw; tok < T_ALL; tok += nw) {
    int b, P;
    float cs = 1.f, sn = 0.f;
    if (tok < T_LAT) {
      b = tok >> 11;
      int l = tok & 2047;
      P = 256 + l;
      float pos = (lane < 32) ? (float)(l >> 6) : (float)(l & 63);
      float ang = pos * inv_f;
      cs = cosf(ang);
      sn = sinf(ang);
    } else {
      b = (tok - T_LAT) >> 8;
      P = (tok - T_LAT) & 255;
    }
    float xv[16], ssq[16];
#pragma unroll
    for (int g = 0; g < 16; ++g) {
      xv[g] = bf2f(PA[(long)tok * 1024 + g * 64 + lane]);
      ssq[g] = xv[g] * xv[g];
    }
#pragma unroll
    for (int o = 32; o; o >>= 1)
#pragma unroll
      for (int g = 0; g < 16; ++g) ssq[g] += __shfl_xor(ssq[g], o);
#pragma unroll
    for (int g = 0; g < 16; ++g) {
      int which = g >> 3, h = (g >> 1) & 3, c = g & 1;
      float inv = rsqrtf(ssq[g] * (1.f / 64.f) + 1e-6f);
      float y = xv[g] * inv * p.qk_gain[(li * 2 + which) * 64 + lane];
      float pr = __shfl_xor(y, 16);
      float o = (lane & 16) ? (y * cs + pr * sn) : (y * cs - pr * sn);
      if (which == 0) o *= 0.18033688011112042f;
      u16* dst = (which ? KH : QH) + ((long)((b * 4 + h) * 2 + c) * 2304 + P) * 64 + lane;
      *dst = f2bf(o);
    }
  }
}

DI void ph_attn(const Prm& p, int li, long base, char* smem) {
  const int tid = mytid(), lane = tid & 63, wid = tid >> 6, fr = lane & 15, fq = lane >> 4;
  const u16* QH = (const u16*)(p.ws + OFF_AR + 3 * U38);
  const u16* KH = QH + 18874368L;
  const u16* VT = (const u16*)(p.ws + OFF_AR + 5 * U38);
  u16* YA = (u16*)(p.ws + OFF_Y);
  u16* s = (u16*)smem;
  constexpr int STG = 128 * 80 + 128 * 72;
  const float lambda_init = 0.8f - 0.6f * expf(-0.3f * (float)li);
  float lamv, mshift;
  {
    const float* lv = p.lam + li * 256;
    float a = wsum(lv[lane] * lv[64 + lane]), b2 = wsum(lv[128 + lane] * lv[192 + lane]);
    lamv = expf(a) - expf(b2) + lambda_init;
    float gq = wmax(fabsf(p.qk_gain[(li * 2) * 64 + lane])), gk = wmax(fabsf(p.qk_gain[(li * 2 + 1) * 64 + lane]));
    mshift = 8.f * gq * gk * 1.4426950408889634f;
  }
  for (int it = first_item(base); it < (li == 3 ? 1024 : 1152); it += gridDim.x) {
    int b, h, qp0, nkeys;
    if (it < 1024) { b = it >> 6; h = (it >> 4) & 3; qp0 = 256 + (it & 15) * 128; nkeys = 2304; }
    else { int i2 = it - 1024; b = i2 >> 3; h = (i2 >> 1) & 3; qp0 = (i2 & 1) * 128; nkeys = 256; }
    const long kb0 = (long)((b * 4 + h) * 2) * 2304;
    bf16x8 qf[2][2];
#pragma unroll
    for (int c = 0; c < 2; ++c)
#pragma unroll
      for (int ks = 0; ks < 2; ++ks)
        qf[c][ks] = *(const bf16x8*)(QH + (kb0 + (long)c * 2304 + qp0 + wid * 16 + fr) * 64 + ks * 32 + fq * 8);
    f32x4 O0[8], O1[8];
#pragma unroll
    for (int i = 0; i < 8; ++i) { O0[i] = f32x4{0.f, 0.f, 0.f, 0.f}; O1[i] = f32x4{0.f, 0.f, 0.f, 0.f}; }
    f32x4 L0 = {0.f, 0.f, 0.f, 0.f}, L1 = {0.f, 0.f, 0.f, 0.f};
    const bf16x8 ones = {0x3F80, 0x3F80, 0x3F80, 0x3F80, 0x3F80, 0x3F80, 0x3F80, 0x3F80};
    uint4 rk[2], rv[2];
    const int nt = nkeys >> 6;
#pragma unroll
    for (int u = 0; u < 2; ++u) {
      int id = tid + u * 512;
      int c = id >> 9, key = (id >> 3) & 63, ch = id & 7;
      rk[u] = *(const uint4*)(KH + (kb0 + (long)c * 2304 + key) * 64 + ch * 8);
      int dv = id >> 3;
      rv[u] = *(const uint4*)(VT + ((long)(b * 512 + h * 128 + dv)) * 2304 + ch * 8);
    }
#pragma unroll
    for (int u = 0; u < 2; ++u) {
      int id = tid + u * 512;
      *(uint4*)(s + (id >> 3) * 80 + (id & 7) * 8) = rk[u];
      *(uint4*)(s + 128 * 80 + (id >> 3) * 72 + (id & 7) * 8) = rv[u];
    }
    lds_barrier();
    for (int t = 0; t < nt; ++t) {
      const bool more = t + 1 < nt;
      if (more) {
        int kp0 = (t + 1) * 64;
#pragma unroll
        for (int u = 0; u < 2; ++u) {
          int id = tid + u * 512;
          int c = id >> 9, key = (id >> 3) & 63, ch = id & 7;
          rk[u] = *(const uint4*)(KH + (kb0 + (long)c * 2304 + kp0 + key) * 64 + ch * 8);
          int dv = id >> 3;
          rv[u] = *(const uint4*)(VT + ((long)(b * 512 + h * 128 + dv)) * 2304 + kp0 + ch * 8);
        }
      }
      const u16* ks_ = s + (t & 1) * STG;
      const u16* vs_ = ks_ + 128 * 80;
      bf16x8 pf[2][2];
#pragma unroll
      for (int c = 0; c < 2; ++c) {
#pragma unroll
        for (int kk2 = 0; kk2 < 2; ++kk2) {
          u32x4 pw;
#pragma unroll
          for (int hh = 0; hh < 2; ++hh) {
            const int k4 = kk2 * 2 + hh;
            f32x4 a = {-mshift, -mshift, -mshift, -mshift};
#pragma unroll
            for (int kk = 0; kk < 2; ++kk)
              a = MFMA(*(const bf16x8*)(ks_ + (c * 64 + k4 * 16 + fr) * 80 + kk * 32 + fq * 8), qf[c][kk], a);
            pw[hh * 2 + 0] = pk_bf16(__builtin_amdgcn_exp2f(a[0]), __builtin_amdgcn_exp2f(a[1]));
            pw[hh * 2 + 1] = pk_bf16(__builtin_amdgcn_exp2f(a[2]), __builtin_amdgcn_exp2f(a[3]));
          }
          pf[c][kk2] = *(bf16x8*)&pw;
        }
      }
#pragma unroll
      for (int kk = 0; kk < 2; ++kk) {
        L0 = MFMA(ones, pf[0][kk], L0);
        L1 = MFMA(ones, pf[1][kk], L1);
      }
#pragma unroll
      for (int dt = 0; dt < 8; ++dt) {
#pragma unroll
        for (int kk = 0; kk < 2; ++kk) {
          const u16* vp = vs_ + (dt * 16 + fr) * 72 + kk * 32 + fq * 4;
          uint2 lo = *(const uint2*)vp, hi = *(const uint2*)(vp + 16);
          uint4 av = {lo.x, lo.y, hi.x, hi.y};
          bf16x8 a = *(bf16x8*)&av;
          O0[dt] = MFMA(a, pf[0][kk], O0[dt]);
          O1[dt] = MFMA(a, pf[1][kk], O1[dt]);
        }
      }
      if (more) {
        u16* ns = s + ((t + 1) & 1) * STG;
#pragma unroll
        for (int u = 0; u < 2; ++u) {
          int id = tid + u * 512;
          *(uint4*)(ns + (id >> 3) * 80 + (id & 7) * 8) = rk[u];
          *(uint4*)(ns + 128 * 80 + (id >> 3) * 72 + (id & 7) * 8) = rv[u];
        }
      }
      lds_barrier();
    }
    float i0 = 1.f / L0[0], i1 = lamv / L1[0], ss = 0.f;
#pragma unroll
    for (int dt = 0; dt < 8; ++dt)
#pragma unroll
      for (int j = 0; j < 4; ++j) {
        float o = O0[dt][j] * i0 - O1[dt][j] * i1;
        O0[dt][j] = o;
        ss += o * o;
      }
    ss += __shfl_xor(ss, 16); ss += __shfl_xor(ss, 32);
    float inv = rsqrtf(ss * (1.f / 128.f) + 1e-6f) * (1.f - lambda_init);
    int tok = tokof(b, qp0 + wid * 16 + fr);
#pragma unroll
    for (int dt = 0; dt < 8; ++dt) {
      int dv = dt * 16 + fq * 4;
      const float* sw = p.subln + li * 128 + dv;
      ushort4 o;
      o.x = f2bf(O0[dt][0] * inv * sw[0]);
      o.y = f2bf(O0[dt][1] * inv * sw[1]);
      o.z = f2bf(O0[dt][2] * inv * sw[2]);
      o.w = f2bf(O0[dt][3] * inv * sw[3]);
      *(ushort4*)(YA + (long)tok * 512 + h * 128 + dv) = o;
    }
  }
}

template <int L>
DI void hyena_item(const Prm& p, int li, int ch, char* smem) {
  constexpr int CS = 2 * L + 8;
  constexpr int ZS = L + 8;
  constexpr int MT = L / 128;
  constexpr int MG = MT > 8 ? 8 : MT, NG = MT / MG;
  const int tid = mytid(), lane = tid & 63, wid = tid >> 6, fr = lane & 15, fq = lane >> 4;
  u16* cp = (u16*)smem;
  u16* zr = cp + 8 * CS;
  const u16* PH = (const u16*)(p.ws + OFF_AR) + (L == 2048 ? 0L : 32768L * 1536);
  const u16* G = (const u16*)(p.ws + (L == 2048 ? OFF_TAPL : OFF_TAPC));
  u16* YB = (u16*)(p.ws + OFF_Y + U38);
  const float* cw = p.hy_conv + (long)li * 3 * 1536;
  {
    float w0 = cw[1024 + ch], w1 = cw[1536 + 1024 + ch], w2 = cw[3072 + 1024 + ch];
#pragma unroll 8
    for (int e = tid; e < 16 * L; e += 512) {
      int b = e / L, sidx = e % L;
      const u16* row = PH + ((long)b * 1536 + 1024 + ch) * L;
      float v = w1 * bf2f(row[sidx]);
      if (sidx > 0) v += w0 * bf2f(row[sidx - 1]);
      if (sidx + 1 < L) v += w2 * bf2f(row[sidx + 1]);
      zr[b * ZS + L - 1 - sidx] = f2bf(v);
    }
  }
#pragma unroll
  for (int order = 0; order < 2; ++order) {
    {
      const u16* g = G + (long)(order * 512 + ch) * (2 * L);
#pragma unroll 8
      for (int e = tid; e < 8 * 2 * L; e += 512) {
        int c = e / (2 * L), i = e % (2 * L);
        cp[c * CS + i] = (i + c < 2 * L) ? g[i + c] : (u16)0;
      }
    }
    __syncthreads();
    const float bias = p.hy_bias[(li * 2 + order) * 512 + ch];
    const int gcol = order * 512 + ch;
    const float w0 = cw[gcol], w1 = cw[1536 + gcol], w2 = cw[3072 + gcol];
    const int tq = wid * (L / 8) + fq * 4;
    const u16* xb = PH + ((long)fr * 1536 + gcol) * L + tq;
    const u16* zb = zr + fr * ZS + L - 1 - tq;
    unsigned zp[NG][MG][2];
#pragma unroll
    for (int grp = 0; grp < NG; ++grp) {
      f32x4 acc[MG];
#pragma unroll
      for (int m = 0; m < MG; ++m) acc[m] = f32x4{0.f, 0.f, 0.f, 0.f};
      const int tb = wid * (L / 8) + grp * MG * 16 + fr;
#pragma unroll 2
      for (int s0 = 0; s0 < L; s0 += 32) {
        bf16x8 bfr = *(const bf16x8*)(zr + fr * ZS + (L - 8 - s0 - fq * 8));
#pragma unroll
        for (int m = 0; m < MG; ++m) {
          int i0 = tb + m * 16 - s0 - fq * 8 - 7 + L;
          int c = i0 & 7;
          bf16x8 afr = *(const bf16x8*)(cp + c * CS + (i0 - c));
          acc[m] = MFMA(afr, bfr, acc[m]);
        }
      }
#pragma unroll
      for (int m = 0; m < MG; ++m) {
        float r4[4];
#pragma unroll
        for (int j = 0; j < 4; ++j) {
          const int off = (grp * MG + m) * 16 + j;
          const int t = tq + off;
          float xa = bf2f(xb[off - 1]), xc = bf2f(xb[off]), xd = bf2f(xb[off + 1]);
          xa = (t > 0) ? xa : 0.f;
          xd = (t + 1 < L) ? xd : 0.f;
          float xg = w0 * xa + w1 * xc + w2 * xd;
          float zin = bf2f(zb[-off]);
          r4[j] = xg * (acc[m][j] + bias * zin);
        }
        zp[grp][m][0] = (unsigned)f2bf(r4[0]) | ((unsigned)f2bf(r4[1]) << 16);
        zp[grp][m][1] = (unsigned)f2bf(r4[2]) | ((unsigned)f2bf(r4[3]) << 16);
      }
    }
    __syncthreads();
#pragma unroll
    for (int grp = 0; grp < NG; ++grp)
#pragma unroll
      for (int m = 0; m < MG; ++m)
#pragma unroll
        for (int j = 0; j < 4; ++j) {
          int t = wid * (L / 8) + (grp * MG + m) * 16 + fq * 4 + j;
          u16 v = (u16)(zp[grp][m][j >> 1] >> ((j & 1) * 16));
          zr[fr * ZS + L - 1 - t] = v;
        }
  }
  __syncthreads();
#pragma unroll 4
  for (int e = tid; e < 16 * L; e += 512) {
    int b = e / L, t = e % L;
    long tok = (L == 2048) ? ((long)b * 2048 + t) : ((long)T_LAT + b * 256 + t);
    YB[tok * 512 + ch] = zr[b * ZS + L - 1 - t];
  }
  __syncthreads();
}

DI void ph_merge(const Prm& p, char* smem, bool lastl) {
  const int tid = mytid(), lane = tid & 63, wid = tid >> 6;
  const int wm = wid >> 1, wn = wid & 1, fr = lane & 15, fq = lane >> 4;
  const u16* H = (const u16*)(p.ws + OFF_HBF);
  const u16* Y = (const u16*)(p.ws + OFF_Y);
  const u16* WG = (const u16*)(p.ws + OFF_WB) + WO_G;
  const u16* WBr = (const u16*)(p.ws + OFF_WB) + WO_B;
  u16* MG = (u16*)(p.ws + OFF_AR);
  const int NT = (lastl ? 256 : 288) * 8, G = gridDim.x;
  Stg r0, r1;
  bool pre = false;
  for (int t = mybid(); t < NT; t += G) {
    const int mt = t >> 3, nt = t & 7;
    const bool hn = t + G < NT;
    const int mt2 = (t + G) >> 3, nt2 = (t + G) & 7;
    f32x4 acc[2][4], g[2][4], y[2][4];
#pragma unroll
    for (int a = 0; a < 2; ++a)
#pragma unroll
      for (int b = 0; b < 4; ++b) acc[a][b] = f32x4{0.f, 0.f, 0.f, 0.f};
    const u16* gA = H + (long)mt * 128 * 1024;
    for (int n = 0; n < 4; ++n) {
      const u16* gB = WG + ((long)n * 1024 + nt * 128) * 1024;
      const u16* yA = Y + (long)n * (T_ALL * 512L) + (long)mt * 128 * 512;
      const u16* yB = WBr + ((long)n * 1024 + nt * 128) * 512;
      gemm_tile<2>(g, gA, 1024, gB, 1024, 1024, smem, r0, r1, pre, yA, 512, yB, 512);
      const u16* nxA = (n < 3) ? gA : (hn ? H + (long)mt2 * 128 * 1024 : nullptr);
      const u16* nxB = (n < 3) ? WG + ((long)(n + 1) * 1024 + nt * 128) * 1024 : WG + ((long)nt2 * 128) * 1024;
      gemm_tile<2>(y, yA, 512, yB, 512, 512, smem, r0, r1, true, nxA, 1024, nxB, 1024);
      pre = true;
#pragma unroll
      for (int a = 0; a < 2; ++a)
#pragma unroll
        for (int b = 0; b < 4; ++b)
#pragma unroll
          for (int j = 0; j < 4; ++j) acc[a][b][j] += y[a][b][j] / (1.f + __expf(-g[a][b][j]));
    }
    pre = hn;
#pragma unroll
    for (int a = 0; a < 2; ++a)
#pragma unroll
      for (int b = 0; b < 4; ++b) {
        int r = wm * 32 + a * 16 + fr, c = wn * 64 + b * 16 + fq * 4;
        uint2 o;
        o.x = pk_bf16(acc[a][b][0], acc[a][b][1]);
        o.y = pk_bf16(acc[a][b][2], acc[a][b][3]);
        *(uint2*)(MG + ((long)mt * 128 + r) * 1024 + nt * 128 + c) = o;
      }
  }
}

DI void run_phase(const Prm& p, int ph, char* smem) {
  if (ph == 0) { ph_init(p, smem); return; }
  const int li = (ph - 1) / 13, kk = (ph - 1) % 13, k = kk < 5 ? kk : kk + 1;
  const u16* WB = (const u16*)(p.ws + OFF_WB);
  const u16* HB = (const u16*)(p.ws + OFF_HBF);
  const float* MOD = (const float*)(p.ws + OFF_MOD);
  u16* AR = (u16*)(p.ws + OFF_AR);
  u16* Yb = (u16*)(p.ws + OFF_Y);
  const int G = gridDim.x;
  TD d;
  d.split = 0; d.scale = 1.f; d.mode = 0; d.tok0 = 0; d.col0 = 0; d.g = MOD;
  switch (k) {
    case 0: {
      u16* W = (u16*)(p.ws + OFF_WB);
      long base = 0;
      base = tr_job(base, p.w_in + (long)li * 1024 * NIN, 1024, NIN, W + WO_IN, 1, smem);
      base = tr_job(base, p.w_gate + (long)li * 4 * 1048576, 1024, 1024, W + WO_G, 4, smem);
      base = tr_job(base, p.w_branch + (long)li * 4 * 524288, 512, 1024, W + WO_B, 4, smem);
      base = tr_job(base, p.w_o + (long)li * 1048576, 1024, 1024, W + WO_O, 1, smem);
      base = tr_job(base, p.w_mlp1 + (long)li * 4194304, 1024, 4096, W + WO_1, 1, smem);
      base = tr_job(base, p.w_mlp2 + (long)li * 4194304, 4096, 1024, W + WO_2, 1, smem);
      ph_taps1(p, li, base, smem);
      ph_norm(p, li, 0);
    } break;
    case 1: {
      auto dec = [&](int t, TD& o) {
        o.lda = 1024; o.ldb = 1024; o.K = 1024; o.mode = 0;
        if (t < 1728) {
          int mt = t / 12, nt = t % 12;
          o.A = HB + (long)mt * 256 * 1024; o.B = WB + WO_IN + (long)(3584 + nt * 128) * 1024;
          o.C = AR + (long)mt * 256 * 1536 + nt * 128; o.ldc = 1536;
        } else if (t < 2304) {
          int t2 = t - 1728, mt = t2 >> 2, nt = t2 & 3;
          o.A = HB + (long)mt * 256 * 1024; o.B = WB + WO_IN + (long)(5120 + nt * 128) * 1024;
          o.C = Yb + 3 * (U38 / 2) + (long)mt * 256 * 512 + nt * 128; o.ldc = 512;
        } else {
          int mt = t - 2304;
          o.A = HB + (long)mt * 256 * 1024; o.B = WB + WO_IN + (long)5632 * 1024;
          o.C = (u16*)((float*)(p.ws + OFF_PDAB) + (long)mt * 256 * 16); o.ldc = 16; o.mode = 3;
        }
      };
      {
        Stg r0, r1;
        bool pre = false;
        TD dn = d;
        int t = mybid();
        if (t < 2448) dec(t, d);
        for (; t < 2448; t += G) {
          const bool hn = t + G < 2448;
          if (hn) dec(t + G, dn);
          run_tile2(p, d, smem, r0, r1, pre, hn ? dn.A : nullptr, dn.lda, dn.B, dn.ldb);
          pre = hn;
          d = dn;
        }
      }
      ph_taps2(p, 2448, smem);
    } break;
    case 2: ph_dncl(p, li, smem); break;
    case 3: ph_dnscan(p, smem); break;
    case 4: {
      {
        Stg r0, r1;
        bool pre = false;
        for (int t = mybid(); t < 1152; t += G) {
          int mt = t >> 3, nt = t & 7;
          const bool hn = t + G < 1152;
          int mt2 = (t + G) >> 3, nt2 = (t + G) & 7;
          d.lda = 1024; d.ldb = 1024; d.K = 1024;
          d.A = HB + (long)mt * 256 * 1024; d.B = WB + WO_IN + (long)(nt * 128) * 1024;
          d.C = AR + 3 * (U38 / 2); d.ldc = 0; d.mode = 4; d.tok0 = mt * 256; d.col0 = nt;
          d.g = p.qk_gain + li * 128;
          run_tile2(p, d, smem, r0, r1, pre, hn ? HB + (long)mt2 * 256 * 1024 : nullptr, 1024,
                    WB + WO_IN + (long)(nt2 * 128) * 1024, 1024);
          pre = hn;
        }
      }
      d.mode = 0; d.split = 0; d.scale = 1.f;
      {
      u16* VT = AR + 5 * (U38 / 2);
      u16* PF = AR + 6 * (U38 / 2);
      auto dec = [&](int t, TD& o) {
        o.lda = 1024; o.ldb = 1024; o.K = 1024;
        if (t < 512) {
          int b = t >> 5, r = t & 31, mt = r >> 4, nt = r & 15;
          o.A = WB + WO_IN + (long)(1024 + mt * 256) * 1024; o.B = HB + ((long)b * 2048 + nt * 128) * 1024;
          o.C = VT + ((long)b * 512 + mt * 256) * 2304 + 256 + nt * 128; o.ldc = 2304;
        } else if (t < 576) {
          int t2 = t - 512, b = t2 >> 2, r = t2 & 3, mt = r >> 1, nt = r & 1;
          o.A = WB + WO_IN + (long)(1024 + mt * 256) * 1024; o.B = HB + ((long)T_LAT + b * 256 + nt * 128) * 1024;
          o.C = VT + ((long)b * 512 + mt * 256) * 2304 + nt * 128; o.ldc = 2304;
        } else {
          int t2 = t - 576, mt = t2 >> 2, nt = t2 & 3;
          o.A = HB + (long)mt * 256 * 1024; o.B = WB + WO_IN + (long)(3072 + nt * 128) * 1024;
          o.C = PF + (long)mt * 256 * 512 + nt * 128; o.ldc = 512;
        }
      };
      {
        Stg r0, r1;
        bool pre = false;
        TD dn = d;
        int t = mybid();
        if (t < 1152) dec(t, d);
        for (; t < 1152; t += G) {
          const bool hn = t + G < 1152;
          if (hn) dec(t + G, dn);
          run_tile2(p, d, smem, r0, r1, pre, hn ? dn.A : nullptr, dn.lda, dn.B, dn.ldb);
          pre = hn;
          d = dn;
        }
      }
      }
      ph_dnfin(p, li);
    } break;
    case 6: {
      ph_attn(p, li, 0, smem);
      auto dec = [&](int t, TD& o) {
        o.lda = 1024; o.ldb = 1024; o.K = 1024;
        if (t < 1536) {
          int b = t / 96, r = t % 96, mt = r >> 4, nt = r & 15;
          o.A = WB + WO_IN + (long)(1536 + mt * 256) * 1024; o.B = HB + ((long)b * 2048 + nt * 128) * 1024;
          o.C = AR + ((long)b * 1536 + mt * 256) * 2048 + nt * 128; o.ldc = 2048;
        } else {
          int t2 = t - 1536, b = t2 / 12, r = t2 % 12, mt = r >> 1, nt = r & 1;
          o.A = WB + WO_IN + (long)(1536 + mt * 256) * 1024; o.B = HB + ((long)T_LAT + b * 256 + nt * 128) * 1024;
          o.C = AR + 32768L * 1536 + ((long)b * 1536 + mt * 256) * 256 + nt * 128; o.ldc = 256;
        }
      };
      {
        Stg r0, r1;
        bool pre = false;
        TD dn = d;
        int t = first_item(1152);
        if (t < 1728) dec(t, d);
        for (; t < 1728; t += G) {
          const bool hn = t + G < 1728;
          if (hn) dec(t + G, dn);
          run_tile2(p, d, smem, r0, r1, pre, hn ? dn.A : nullptr, dn.lda, dn.B, dn.ldb);
          pre = hn;
          d = dn;
        }
      }
    } break;
    case 7: {
#if !defined(TESTSEL) || TESTSEL == 1
      for (int it = mybid(); it < 512; it += G) hyena_item<2048>(p, li, it, smem);
#endif
#if !defined(TESTSEL) || TESTSEL == 2
      if (li < 3)
        for (int it = mybid(); it < 512; it += G) hyena_item<256>(p, li, it, smem);
#endif
#if !defined(TESTSEL) || TESTSEL == 3
      const u16* PF = AR + 6 * (U38 / 2);
      u16* WF = AR + 3 * (U38 / 2);
      const u16* DCm = (const u16*)(p.ws + OFF_DC);
      auto dec = [&](int t, TD& o) {
        o.A = DCm; o.lda = 128; o.ldb = 512; o.K = 128;
        if (t < 1024) {
          int bg = t >> 4, nt = t & 15, b = bg >> 2, g = bg & 3;
          o.B = PF + ((long)b * 2048 + nt * 128) * 512 + g * 128;
          o.C = WF + ((long)b * 512 + g * 128) * 4096 + nt * 128; o.ldc = 4096; o.split = 2048;
        } else {
          int t2 = t - 1024, bg = t2 >> 1, nt = t2 & 1, b = bg >> 2, g = bg & 3;
          o.B = PF + ((long)T_LAT + b * 256 + nt * 128) * 512 + g * 128;
          o.C = WF + 16L * 512 * 4096 + ((long)b * 512 + g * 128) * 512 + nt * 128; o.ldc = 512; o.split = 256;
        }
      };
      {
        const int NT7 = (li == 3 ? 1024 : 1152);
        Stg r0, r1;
        bool pre = false;
        TD dn = d;
        int t = mybid();
        if (t < NT7) dec(t, d);
        for (; t < NT7; t += G) {
          const bool hn = t + G < NT7;
          if (hn) dec(t + G, dn);
          run_tile2(p, d, smem, r0, r1, pre, hn ? dn.A : nullptr, dn.lda, dn.B, dn.ldb);
          pre = hn;
          d = dn;
        }
      }
#endif
    } break;
    case 8: {
      const u16* WF = AR + 3 * (U38 / 2);
      u16* YF = Yb + 2 * (U38 / 2);
      d.scale = 1.f / 512.f;
      for (int t = mybid(); t < (li == 3 ? 512 : 576); t += G) {
        if (t < 512) {
          int b = t >> 5, r = t & 31, mt = r >> 2, nt = r & 3;
          d.A = (const u16*)(p.ws + OFF_DL) + (long)mt * 256 * 4096; d.lda = 4096;
          d.B = WF + ((long)b * 512 + nt * 128) * 4096; d.ldb = 4096; d.K = 4096;
          d.C = YF + ((long)b * 2048 + mt * 256) * 512 + nt * 128; d.ldc = 512;
        } else {
          int t2 = t - 512, b = t2 >> 2, nt = t2 & 3;
          d.A = (const u16*)(p.ws + OFF_DLC); d.lda = 512;
          d.B = WF + 16L * 512 * 4096 + ((long)b * 512 + nt * 128) * 512; d.ldb = 512; d.K = 512;
          d.C = YF + ((long)T_LAT + b * 256) * 512 + nt * 128; d.ldc = 512;
        }
        run_tile(p, d, smem);
      }
    } break;
    case 9: ph_merge(p, smem, li == 3); break;
    case 10: {
      d.mode = 2;
      const int NT10 = (li == 3 ? 1024 : 1152);
      Stg r0, r1;
      bool pre = false;
      for (int t = mybid(); t < NT10; t += G) {
        int mt = t >> 3, nt = t & 7;
        d.A = AR + (long)mt * 256 * 1024; d.lda = 1024; d.B = WB + WO_O + (long)nt * 128 * 1024; d.ldb = 1024; d.K = 1024;
        d.tok0 = mt * 256; d.col0 = nt * 128;
        int bb = d.tok0 < T_LAT ? (d.tok0 >> 11) : 16;
        d.g = MOD + ((long)li * 17 + bb) * 6144 + 2 * 1024;
        const bool hn = t + G < NT10;
        int mt2 = (t + G) >> 3, nt2 = (t + G) & 7;
        run_tile2(p, d, smem, r0, r1, pre, hn ? AR + (long)mt2 * 256 * 1024 : nullptr, 1024,
                  WB + WO_O + (long)nt2 * 128 * 1024, 1024);
        pre = hn;
      }
    } break;
    case 11: ph_norm(p, li, 1); break;
    case 12: {
      d.mode = 1;
      const int NT12 = (li == 3 ? 4096 : 4608);
      Stg r0, r1;
      bool pre = false;
      for (int t = mybid(); t < NT12; t += G) {
        int mt = t >> 5, nt = t & 31;
        d.A = HB + (long)mt * 256 * 1024; d.lda = 1024; d.B = WB + WO_1 + (long)nt * 128 * 1024; d.ldb = 1024; d.K = 1024;
        d.C = Yb + (long)mt * 256 * 4096 + nt * 128; d.ldc = 4096;
        const bool hn = t + G < NT12;
        int mt2 = (t + G) >> 5, nt2 = (t + G) & 31;
        run_tile2(p, d, smem, r0, r1, pre, hn ? HB + (long)mt2 * 256 * 1024 : nullptr, 1024,
                  WB + WO_1 + (long)nt2 * 128 * 1024, 1024);
        pre = hn;
      }
    } break;
    case 13: {
      d.mode = 2;
      for (int t = mybid(); t < (li == 3 ? 1024 : 1152); t += G) {
        int mt = t >> 3, nt = t & 7;
        d.A = Yb + (long)mt * 256 * 4096; d.lda = 4096; d.B = WB + WO_2 + (long)nt * 128 * 4096; d.ldb = 4096; d.K = 4096;
        d.tok0 = mt * 256; d.col0 = nt * 128;
        int bb = d.tok0 < T_LAT ? (d.tok0 >> 11) : 16;
        d.g = MOD + ((long)li * 17 + bb) * 6144 + 5 * 1024;
        run_tile(p, d, smem);
      }
    } break;
  }
}

extern __shared__ __attribute__((aligned(16))) char dyn_smem[];

__global__ void __launch_bounds__(512) mega(Prm p, int lo, int hi) {
#ifdef ONLYK
  run_phase(p, ONLYK, dyn_smem);
#else
  for (int ph = lo; ph <= hi; ++ph) {
    long z = 0;
    asm volatile("" : "+s"(z));
    Prm q;
#define LP(f) q.f = p.f + z
    LP(x); LP(c); LP(ctx); LP(c_ctx); LP(w_ada); LP(b_ada); LP(norm1); LP(norm2); LP(w_in); LP(qk_gain); LP(lam);
    LP(subln); LP(hy_conv); LP(hy_w1); LP(hy_b1); LP(hy_freq); LP(hy_w2); LP(hy_b2); LP(hy_w3); LP(hy_bias);
    LP(dn_conv); LP(dn_a_log); LP(dn_dt_bias); LP(dn_norm); LP(w_gate); LP(w_branch); LP(w_o); LP(w_mlp1); LP(w_mlp2);
    LP(out); LP(ws);
#undef LP
    run_phase(q, ph, dyn_smem);
#ifdef PROBEK
    if (ph > 0 && ((ph - 1) % 13 < 5 ? (ph - 1) % 13 : (ph - 1) % 13 + 1) == PROBEK) { cg::this_grid().sync(); run_phase(q, ph, dyn_smem); }
#endif
    if (ph < hi) cg::this_grid().sync();
  }
#endif
}

extern "C" void kernel_launch(void* const* d_in, const int* in_sizes, int n_in, void* d_out, int out_size, void* d_ws,
                              size_t ws_size, hipStream_t stream) {
  static int grid_blocks = 0;
  if (!grid_blocks) {
    hipFuncSetAttribute((const void*)mega, hipFuncAttributeMaxDynamicSharedMemorySize, LDS_BYTES);
    int dev = 0, cus = 0, per_cu = 0;
    hipGetDevice(&dev);
    hipDeviceGetAttribute(&cus, hipDeviceAttributeMultiprocessorCount, dev);
    hipOccupancyMaxActiveBlocksPerMultiprocessor(&per_cu, mega, 512, LDS_BYTES);
    if (per_cu < 1) per_cu = 1;
    grid_blocks = cus * per_cu;
    if (ws_size < (size_t)WS_TOTAL) fprintf(stderr, "workspace too small: %zu < %ld\n", ws_size, (long)WS_TOTAL);
  }
  Prm p;
  const float** pp = (const float**)&p;
  for (int i = 0; i < 29; ++i) pp[i] = (const float*)d_in[i];
  p.out = (float*)d_out;
  p.ws = (char*)d_ws;
#if MULTI
  for (int ph = 0; ph < NPHASE; ++ph) hipLaunchKernelGGL(mega, dim3(grid_blocks), dim3(512), LDS_BYTES, stream, p, ph, ph);
#else
  int lo = 0, hi = NPHASE - 1;
  void* args[] = {&p, &lo, &hi};
  hipError_t e = hipLaunchCooperativeKernel((void*)mega, dim3(grid_blocks), dim3(512), args, LDS_BYTES, stream);
  if (e != hipSuccess) fprintf(stderr, "cooperative launch failed: %s (grid %d)\n", hipGetErrorString(e), grid_blocks);
#endif
}
```

```cpp
#include <hip/hip_runtime.h>
#include <hip/hip_cooperative_groups.h>
#include <stdint.h>
#include <stdio.h>
namespace cg = cooperative_groups;

typedef unsigned short u16;
typedef __attribute__((ext_vector_type(8))) short bf16x8;
typedef __attribute__((ext_vector_type(4))) float f32x4;
#define MFMA(a, b, c) __builtin_amdgcn_mfma_f32_16x16x32_bf16(a, b, c, 0, 0, 0)
#define DI __device__ __forceinline__

#ifndef MULTI
#define MULTI 0
#endif

constexpr int T_LAT = 32768, T_ALL = 36864;
constexpr int NIN = 5648;
constexpr long U38 = 37748736L;
constexpr long OFF_XC = 0;
constexpr long OFF_WB = OFF_XC + 16777216L;
constexpr long OFF_HBF = OFF_WB + 43024384L;
constexpr long OFF_MOD = OFF_HBF + 75497472L;
constexpr long OFF_TAPL = OFF_MOD + 1671168L;
constexpr long OFF_TAPC = OFF_TAPL + 8388608L;
constexpr long OFF_DL = OFF_TAPC + 1048576L;
constexpr long OFF_DLC = OFF_DL + 16777216L;
constexpr long OFF_DC = OFF_DLC + 262144L;
constexpr long OFF_PDAB = OFF_DC + 65536L;
constexpr long OFF_GC = OFF_PDAB + 2359296L;
constexpr long OFF_BETA = OFF_GC + 2359296L;
constexpr long OFF_Y = OFF_BETA + 2359296L;
constexpr long OFF_AR = OFF_Y + 4 * U38;
constexpr long OFF_ROPE = OFF_AR + 7 * U38;
constexpr long WS_TOTAL = OFF_ROPE + 2 * 262144L;
constexpr long WO_IN = 0, WO_G = 5783552L, WO_B = 9977856L, WO_O = 12075008L, WO_1 = 13123584L, WO_2 = 17317888L;
constexpr int LDS_BYTES = 139264;
constexpr int NPHASE = 1 + 4 * 14;

struct Prm {
  const float *x, *c, *ctx, *c_ctx, *w_ada, *b_ada, *norm1, *norm2, *w_in, *qk_gain, *lam, *subln, *hy_conv, *hy_w1,
      *hy_b1, *hy_freq, *hy_w2, *hy_b2, *hy_w3, *hy_bias, *dn_conv, *dn_a_log, *dn_dt_bias, *dn_norm, *w_gate,
      *w_branch, *w_o, *w_mlp1, *w_mlp2;
  float* out;
  char* ws;
};

DI int mytid() {
  int t = threadIdx.x;
  asm volatile("" : "+v"(t));
  return t;
}
DI int mybid() {
  int t = blockIdx.x;
  asm volatile("" : "+s"(t));
  return t;
}
DI void lds_barrier() {
  asm volatile("s_waitcnt lgkmcnt(0)" ::: "memory");
  __builtin_amdgcn_s_barrier();
  asm volatile("" ::: "memory");
}
typedef __bf16 bf16x2_t __attribute__((ext_vector_type(2)));
typedef float f32x2_t __attribute__((ext_vector_type(2)));
DI unsigned pk_bf16(float a, float b) {
  f32x2_t v = {a, b};
  bf16x2_t h = __builtin_convertvector(v, bf16x2_t);
  return *(unsigned*)&h;
}
DI u16 f2bf(float f) {
  __bf16 h = (__bf16)f;
  return *(u16*)&h;
}
DI float bf2f(u16 h) { return __uint_as_float(((unsigned)h) << 16); }
DI float wsum(float v) {
  for (int o = 32; o; o >>= 1) v += __shfl_xor(v, o);
  return v;
}
DI float wmax(float v) {
  for (int o = 32; o; o >>= 1) v = fmaxf(v, __shfl_xor(v, o));
  return v;
}
DI float siluf(float v) { return v / (1.f + __expf(-v)); }
DI float sigmf(float v) { return 1.f / (1.f + __expf(-v)); }
DI float* xrow(const Prm& p, int tok) {
  return tok < T_LAT ? p.out + (long)tok * 1024 : (float*)(p.ws + OFF_XC) + (long)(tok - T_LAT) * 1024;
}
DI int first_item(long base) {
  int G = gridDim.x;
  return (int)(((long)mybid() + G - (base % G)) % G);
}
DI int tokof(int b, int P) { return P < 256 ? T_LAT + b * 256 + P : b * 2048 + (P - 256); }

typedef __attribute__((ext_vector_type(4))) unsigned u32x4;
struct Stg { u32x4 a0, a1, a2, a3, b0, b1; };
template <int NA>
DI void g_load(Stg& r, const u16* Ap, long lda, const u16* Bp, long ldb, int k0) {
  r.a0 = *(const u32x4*)(Ap + k0);
  r.a1 = *(const u32x4*)(Ap + 64 * lda + k0);
  if constexpr (NA == 4) {
    r.a2 = *(const u32x4*)(Ap + 128 * lda + k0);
    r.a3 = *(const u32x4*)(Ap + 192 * lda + k0);
  }
  r.b0 = *(const u32x4*)(Bp + k0);
  r.b1 = *(const u32x4*)(Bp + 64 * ldb + k0);
}
template <int NA, int TM>
DI void s_store(const Stg& r, u16* ns_) {
  *(u32x4*)(ns_) = r.a0;
  *(u32x4*)(ns_ + 64 * 80) = r.a1;
  if constexpr (NA == 4) {
    *(u32x4*)(ns_ + 128 * 80) = r.a2;
    *(u32x4*)(ns_ + 192 * 80) = r.a3;
  }
  *(u32x4*)(ns_ + TM * 80) = r.b0;
  *(u32x4*)(ns_ + TM * 80 + 64 * 80) = r.b1;
}
template <int MI>
DI void t_compute(f32x4 (&acc)[MI][4], const u16* as, const u16* bs, int wm, int wn, int fr, int fq) {
#pragma unroll
  for (int ks = 0; ks < 2; ++ks) {
    bf16x8 a[MI], b[4];
#pragma unroll
    for (int mi = 0; mi < MI; ++mi) a[mi] = *(const bf16x8*)(as + (wm * MI * 16 + mi * 16 + fr) * 80 + ks * 32 + fq * 8);
#pragma unroll
    for (int ni = 0; ni < 4; ++ni) b[ni] = *(const bf16x8*)(bs + (wn * 64 + ni * 16 + fr) * 80 + ks * 32 + fq * 8);
#pragma unroll
    for (int mi = 0; mi < MI; ++mi)
#pragma unroll
      for (int ni = 0; ni < 4; ++ni) acc[mi][ni] = MFMA(b[ni], a[mi], acc[mi][ni]);
  }
}
template <int MI>
DI void gemm_tile(f32x4 (&acc)[MI][4], const u16* __restrict__ A, long lda, const u16* __restrict__ B, long ldb, int K,
                  char* smem, Stg& r0, Stg& r1, bool pre, const u16* nA, long nlda, const u16* nB, long nldb) {
  constexpr int TM = MI * 64;
  constexpr int STAGE = (TM + 128) * 80;
  constexpr int NA = TM * 8 / 512;
  u16* s = (u16*)smem;
  const int tid = mytid(), lane = tid & 63, wid = tid >> 6;
  const int wm = wid >> 1, wn = wid & 1, fr = lane & 15, fq = lane >> 4;
  const long to_a = (long)(tid >> 3), to_c = (tid & 7) * 8;
  const u16* Ap = A + to_a * lda + to_c;
  const u16* Bp = B + to_a * ldb + to_c;
  const u16* nAp = nA + to_a * nlda + to_c;
  const u16* nBp = nB + to_a * nldb + to_c;
  const int so = (tid >> 3) * 80 + (tid & 7) * 8;
#define GLOAD(r, k0) g_load<NA>(r, Ap, lda, Bp, ldb, (k0))
#define NLOAD(r, k0) g_load<NA>(r, nAp, nlda, nBp, nldb, (k0))
#define SSTORE(r, st) s_store<NA, TM>(r, s + (st) * STAGE + so)
#define COMPUTE(st) t_compute<MI>(acc, s + (st) * STAGE, s + (st) * STAGE + TM * 80, wm, wn, fr, fq)
#pragma unroll
  for (int mi = 0; mi < MI; ++mi)
#pragma unroll
    for (int ni = 0; ni < 4; ++ni) acc[mi][ni] = f32x4{0.f, 0.f, 0.f, 0.f};
  const int nk = K >> 6;
  if (!pre) {
    GLOAD(r0, 0);
    GLOAD(r1, 64);
  }
  SSTORE(r0, 0);
  lds_barrier();
  for (int kt = 0; kt < nk; kt += 2) {
    if (kt + 2 < nk) GLOAD(r0, (kt + 2) << 6);
    else if (nA) NLOAD(r0, 0);
    COMPUTE(0);
    SSTORE(r1, 1);
    lds_barrier();
    if (kt + 3 < nk) GLOAD(r1, (kt + 3) << 6);
    else if (nA) NLOAD(r1, 64);
    COMPUTE(1);
    if (kt + 2 < nk) SSTORE(r0, 0);
    lds_barrier();
  }
#undef GLOAD
#undef NLOAD
#undef SSTORE
#undef COMPUTE
}

struct TD {
  const u16* A;
  const u16* B;
  u16* C;
  long lda, ldb, ldc;
  int K;
  int mode;
  int split;
  float scale;
  int tok0, col0;
  const float* g;
};

DI void run_tile2(const Prm& p, const TD& d, char* smem, Stg& r0, Stg& r1, bool pre, const u16* nA, long nlda,
                 const u16* nB, long nldb);
DI void run_tile(const Prm& p, const TD& d, char* smem) {
  Stg r0, r1;
  run_tile2(p, d, smem, r0, r1, false, nullptr, 0, nullptr, 0);
}
DI void run_tile2(const Prm& p, const TD& d, char* smem, Stg& r0, Stg& r1, bool pre, const u16* nA, long nlda,
                 const u16* nB, long nldb) {
  f32x4 acc[4][4];
  gemm_tile<4>(acc, d.A, d.lda, d.B, d.ldb, d.K, smem, r0, r1, pre, nA, nlda, nB, nldb);
  const int tid = mytid(), lane = tid & 63, wid = tid >> 6;
  const int wm = wid >> 1, wn = wid & 1, fr = lane & 15, fq = lane >> 4;
  if (d.mode == 4) {
    const int which = d.col0 >> 2, h = d.col0 & 3;
    const float* gain = d.g + which * 64 + fq * 4;
    const float* RC = (const float*)(p.ws + OFF_ROPE);
    const float* RS = RC + 65536;
    u16* dstb = d.C + (which ? 18874368L : 0L);
    const float qs = which ? 1.f : 0.18033688011112042f;
#pragma unroll
    for (int mi = 0; mi < 4; ++mi) {
      const int tok = d.tok0 + wm * 64 + mi * 16 + fr;
      float ss = 0.f;
#pragma unroll
      for (int ni = 0; ni < 4; ++ni)
#pragma unroll
        for (int j = 0; j < 4; ++j) ss += acc[mi][ni][j] * acc[mi][ni][j];
      ss += __shfl_xor(ss, 16);
      ss += __shfl_xor(ss, 32);
      const float inv = rsqrtf(ss * (1.f / 64.f) + 1e-6f) * qs;
      int b, P;
      const bool lat = tok < T_LAT;
      if (lat) { b = tok >> 11; P = 256 + (tok & 2047); }
      else { b = (tok - T_LAT) >> 8; P = (tok - T_LAT) & 255; }
      float y[4][4];
#pragma unroll
      for (int ni = 0; ni < 4; ++ni) {
        float4 g4 = *(const float4*)(gain + ni * 16);
        y[ni][0] = acc[mi][ni][0] * inv * g4.x; y[ni][1] = acc[mi][ni][1] * inv * g4.y;
        y[ni][2] = acc[mi][ni][2] * inv * g4.z; y[ni][3] = acc[mi][ni][3] * inv * g4.w;
      }
      u16* dst = dstb + ((long)((b * 4 + h) * 2 + wn) * 2304 + P) * 64 + fq * 4;
#pragma unroll
      for (int ni = 0; ni < 4; ++ni) {
        float o0 = y[ni][0], o1 = y[ni][1], o2 = y[ni][2], o3 = y[ni][3];
        if (lat) {
          const int l = tok & 2047, a = ni >> 1;
          float4 c4 = *(const float4*)(RC + (l * 2 + a) * 16 + fq * 4);
          float4 s4 = *(const float4*)(RS + (l * 2 + a) * 16 + fq * 4);
          const float sg = (ni & 1) ? 1.f : -1.f;
          o0 = y[ni][0] * c4.x + sg * y[ni ^ 1][0] * s4.x;
          o1 = y[ni][1] * c4.y + sg * y[ni ^ 1][1] * s4.y;
          o2 = y[ni][2] * c4.z + sg * y[ni ^ 1][2] * s4.z;
          o3 = y[ni][3] * c4.w + sg * y[ni ^ 1][3] * s4.w;
        }
        uint2 o;
        o.x = pk_bf16(o0, o1);
        o.y = pk_bf16(o2, o3);
        *(uint2*)(dst + ni * 16) = o;
      }
    }
    return;
  }
#pragma unroll
  for (int mi = 0; mi < 4; ++mi)
#pragma unroll
    for (int ni = 0; ni < 4; ++ni) {
      int r = wm * 64 + mi * 16 + fr, c = wn * 64 + ni * 16 + fq * 4;
      f32x4 v = acc[mi][ni];
      if (d.mode == 0) {
        long ro = d.split ? ((long)(r & 127) * d.ldc + (long)(r >> 7) * d.split) : (long)r * d.ldc;
        ushort4 o;
        o.x = f2bf(v[0] * d.scale); o.y = f2bf(v[1] * d.scale); o.z = f2bf(v[2] * d.scale); o.w = f2bf(v[3] * d.scale);
        *(ushort4*)(d.C + ro + c) = o;
      } else if (d.mode == 1) {
        ushort4 o;
        float t0 = fmaxf(v[0], 0.f), t1 = fmaxf(v[1], 0.f), t2 = fmaxf(v[2], 0.f), t3 = fmaxf(v[3], 0.f);
        o.x = f2bf(t0 * t0); o.y = f2bf(t1 * t1); o.z = f2bf(t2 * t2); o.w = f2bf(t3 * t3);
        *(ushort4*)(d.C + (long)r * d.ldc + c) = o;
      } else if (d.mode == 3) {
        if (wn == 0 && ni == 0) *(float4*)((float*)d.C + (long)r * 16 + fq * 4) = float4{v[0], v[1], v[2], v[3]};
      } else {
        float4* xp = (float4*)(xrow(p, d.tok0 + r) + d.col0 + c);
        float4 g4 = *(const float4*)(d.g + d.col0 + c);
        float4 x4 = *xp;
        x4.x += g4.x * v[0]; x4.y += g4.y * v[1]; x4.z += g4.z * v[2]; x4.w += g4.w * v[3];
        *xp = x4;
      }
    }
}

DI void ph_init(const Prm& p, char* smem) {
  const long gt = (long)mybid() * 512 + mytid(), gn = (long)gridDim.x * 512;
  {
    const float4* s = (const float4*)p.x;
    float4* d = (float4*)p.out;
    for (long i = gt; i < 32768L * 256; i += gn) d[i] = s[i];
    const float4* s2 = (const float4*)p.ctx;
    float4* d2 = (float4*)(p.ws + OFF_XC);
    for (long i = gt; i < 4096L * 256; i += gn) d2[i] = s2[i];
  }
  {
    u16* DL = (u16*)(p.ws + OFF_DL);
    for (long i = gt; i < 2048L * 4096; i += gn) {
      int l = (int)(i >> 12), kk = (int)(i & 4095), lp = kk & 2047, part = kk >> 11;
      int m = (l * lp) & 2047;
      float ang = (float)m * (6.283185307179586f / 2048.f);
      DL[i] = f2bf(part ? -sinf(ang) : cosf(ang));
    }
    u16* DLC = (u16*)(p.ws + OFF_DLC);
    for (long i = gt; i < 256L * 512; i += gn) {
      int l = (int)(i >> 9), kk = (int)(i & 511), lp = kk & 255, part = kk >> 8;
      int m = (l * lp) & 255;
      float ang = (float)m * (6.283185307179586f / 256.f);
      DLC[i] = f2bf(part ? -sinf(ang) : cosf(ang));
    }
    {
      float* RC = (float*)(p.ws + OFF_ROPE);
      float* RS = RC + 65536;
      for (long i = gt; i < 65536; i += gn) {
        int l = (int)(i >> 5), a = (int)(i >> 4) & 1, f = (int)(i & 15);
        float pos = a ? (float)(l & 63) : (float)(l >> 6);
        float ang = pos * powf(10000.f, -(float)f / 16.f);
        RC[i] = cosf(ang);
        RS[i] = sinf(ang);
      }
    }
    u16* DC = (u16*)(p.ws + OFF_DC);
    for (long i = gt; i < 256L * 128; i += gn) {
      int j2 = (int)(i >> 7), ii = (int)(i & 127), part = j2 >> 7, j = j2 & 127;
      int m = (ii * j) & 127;
      float ang = (float)m * (6.283185307179586f / 128.f);
      DC[i] = f2bf(part ? sinf(ang) : cosf(ang));
    }
  }
  float* sc = (float*)smem;
  float* red = sc + 17 * 1024;
  const int tid = mytid();
  for (int e = tid; e < 17 * 1024; e += 512) {
    int bb = e >> 10, k = e & 1023;
    float v = bb < 16 ? p.c[bb * 1024 + k] : p.c_ctx[k];
    sc[e] = v / (1.f + expf(-v));
  }
  __syncthreads();
  float* MOD = (float*)(p.ws + OFF_MOD);
  for (int it = mybid(); it < 192; it += gridDim.x) {
    int li = it / 48, cgp = it % 48;
    int cl = tid & 127, kq = tid >> 7, n = cgp * 128 + cl;
    float a[17];
#pragma unroll
    for (int b = 0; b < 17; ++b) a[b] = 0.f;
    const float* w = p.w_ada + ((long)li * 1024 + kq * 256) * 6144 + n;
#pragma unroll 2
    for (int k = 0; k < 256; ++k) {
      float wv = w[(long)k * 6144];
#pragma unroll
      for (int b = 0; b < 17; ++b) a[b] += sc[b * 1024 + kq * 256 + k] * wv;
    }
#pragma unroll
    for (int b = 0; b < 17; ++b) red[(kq * 17 + b) * 128 + cl] = a[b];
    __syncthreads();
    for (int e = tid; e < 17 * 128; e += 512) {
      int b = e >> 7, c2 = e & 127, n2 = cgp * 128 + c2;
      float v = p.b_ada[li * 6144 + n2];
      for (int q = 0; q < 4; ++q) v += red[(q * 17 + b) * 128 + c2];
      MOD[((long)li * 17 + b) * 6144 + n2] = v;
    }
    __syncthreads();
  }
}

DI long tr_job(long base, const float* src, int K, int N, u16* dst, int nb, char* smem) {
  float* t = (float*)smem;
  const int tk = K >> 6, tn = (N + 63) >> 6, per = tk * tn, total = per * nb;
  const int tid = mytid();
  for (int it = first_item(base); it < total; it += gridDim.x) {
    int b = it / per, r = it % per, kt = r / tn, nt = r % tn;
    const float* s = src + (long)b * K * N;
    u16* d = dst + (long)b * K * N;
    int k0 = kt * 64, n0 = nt * 64;
#pragma unroll
    for (int i = 0; i < 8; ++i) {
      int id = tid + i * 512, kk = id >> 6, nn = id & 63;
      t[kk * 65 + nn] = (n0 + nn < N) ? s[(long)(k0 + kk) * N + n0 + nn] : 0.f;
    }
    __syncthreads();
#pragma unroll
    for (int i = 0; i < 8; ++i) {
      int id = tid + i * 512, nn = id >> 6, kk = id & 63;
      if (n0 + nn < N) d[(long)(n0 + nn) * K + k0 + kk] = f2bf(t[kk * 65 + nn]);
    }
    __syncthreads();
  }
  return base + total;
}

DI void ph_norm(const Prm& p, int li, int which) {
  const int lane = mytid() & 63;
  const int gw = mybid() * 8 + (mytid() >> 6), nw = gridDim.x * 8;
  const float* nwt = (which ? p.norm2 : p.norm1) + li * 1024;
  const float* MOD = (const float*)(p.ws + OFF_MOD);
  u16* H = (u16*)(p.ws + OFF_HBF);
  const int nrows = (which && li == 3) ? T_LAT : T_ALL;
  for (int row = gw; row < nrows; row += nw) {
    const float* xr = xrow(p, row);
    float4 v[4];
    float ss = 0.f;
#pragma unroll
    for (int i = 0; i < 4; ++i) {
      v[i] = *(const float4*)(xr + i * 256 + lane * 4);
      ss += v[i].x * v[i].x + v[i].y * v[i].y + v[i].z * v[i].z + v[i].w * v[i].w;
    }
    ss = wsum(ss);
    float inv = rsqrtf(ss * (1.f / 1024.f) + 1e-6f);
    int bb = row < T_LAT ? (row >> 11) : 16;
    const float* sh = MOD + ((long)li * 17 + bb) * 6144 + (which ? 3 : 0) * 1024;
    const float* scp = sh + 1024;
#pragma unroll
    for (int i = 0; i < 4; ++i) {
      int c = i * 256 + lane * 4;
      float4 w4 = *(const float4*)(nwt + c), s4 = *(const float4*)(scp + c), h4 = *(const float4*)(sh + c);
      ushort4 o;
      o.x = f2bf(v[i].x * inv * w4.x * (1.f + s4.x) + h4.x);
      o.y = f2bf(v[i].y * inv * w4.y * (1.f + s4.y) + h4.y);
      o.z = f2bf(v[i].z * inv * w4.z * (1.f + s4.z) + h4.z);
      o.w = f2bf(v[i].w * inv * w4.w * (1.f + s4.w) + h4.w);
      *(ushort4*)(H + (long)row * 1024 + c) = o;
    }
  }
}

DI void ph_taps1(const Prm& p, int li, long base, char* smem) {
  float* f = (float*)smem;
  float* hraw = (float*)(p.ws + OFF_AR + 5 * U38);
  const int tid = mytid();
  for (int it = first_item(base); it < 288; it += gridDim.x) {
    const int L = it < 256 ? 2048 : 256, j0 = it < 256 ? it * 8 : (it - 256) * 8;
    const int lg = tid >> 6, kk = tid & 63;
    if (tid < 8 * 33) {
      int l2 = tid / 33, e = tid % 33, j = j0 + l2;
      float t = (float)j / (float)(L - 1);
      float w = 6.283185307179586f * (float)j / (float)L;
      float v;
      if (e == 0) v = t;
      else {
        int bi = (e - 1) & 15;
        float band = 1e-4f + (float)bi * ((15.f - 1e-4f) / 15.f);
        v = (e <= 16) ? cosf(band * w) : -sinf(band * w);
      }
      f[l2 * 40 + e] = v;
    }
    __syncthreads();
    {
      float v = p.hy_b1[li * 64 + kk];
#pragma unroll 3
      for (int e = 0; e < 33; ++e) v += f[lg * 40 + e] * p.hy_w1[(li * 33 + e) * 64 + kk];
      f[320 + lg * 64 + kk] = sinf(p.hy_freq[(li * 2 + 0) * 64 + kk] * v);
    }
    __syncthreads();
    {
      float v = p.hy_b2[li * 64 + kk];
#pragma unroll 4
      for (int m = 0; m < 64; ++m) v += f[320 + lg * 64 + m] * p.hy_w2[(li * 64 + m) * 64 + kk];
      f[832 + lg * 64 + kk] = sinf(p.hy_freq[(li * 2 + 1) * 64 + kk] * v);
    }
    __syncthreads();
    {
      float h[4][8];
#pragma unroll
      for (int i = 0; i < 4; ++i)
#pragma unroll
        for (int l2 = 0; l2 < 8; ++l2) h[i][l2] = 0.f;
      const float* w3 = p.hy_w3 + (long)li * 64 * 2048 + tid;
#pragma unroll 2
      for (int k = 0; k < 64; ++k) {
        float wv[4];
#pragma unroll
        for (int i = 0; i < 4; ++i) wv[i] = w3[(long)k * 2048 + i * 512];
#pragma unroll
        for (int l2 = 0; l2 < 8; ++l2) {
          float hv = f[832 + l2 * 64 + k];
#pragma unroll
          for (int i = 0; i < 4; ++i) h[i][l2] += hv * wv[i];
        }
      }
#pragma unroll
      for (int i = 0; i < 4; ++i) {
        int n = tid + i * 512, ch = n & 511;
        float delta = fabsf(-3.0701134573253946f + (float)ch * ((-15.350567286626973f + 3.0701134573253946f) / 511.f));
#pragma unroll
        for (int l2 = 0; l2 < 8; ++l2) {
          int j = j0 + l2;
          float t = (float)j / (float)(L - 1);
          long row = (it < 256) ? j : 2048 + j;
          hraw[row * 2048 + n] = h[i][l2] * expf(-t * delta);
        }
      }
    }
    __syncthreads();
  }
}
DI void ph_taps2(const Prm& p, long base, char* smem) {
  float* red = (float*)smem;
  const float* hraw = (const float*)(p.ws + OFF_AR + 5 * U38);
  const int tid = mytid(), cl = tid & 3, dir = (tid >> 2) & 1, jg = tid >> 3;
  for (int it = first_item(base); it < 512; it += gridDim.x) {
    int ls = it >> 8, order = (it >> 7) & 1, cgp = it & 127;
    int L = ls ? 256 : 2048;
    const float* hr = hraw + (long)(ls ? 2048 : 0) * 2048;
    u16* G = (u16*)(p.ws + (ls ? OFF_TAPC : OFF_TAPL));
    int ch = cgp * 4 + cl, n = order * 1024 + dir * 512 + ch;
    float s = 0.f;
#pragma unroll 8
    for (int j = jg; j < L; j += 64) {
      float v = fabsf(hr[(long)j * 2048 + n]);
      s += (dir == 1 && j == 0) ? 0.f : v;
    }
    red[(tid >> 2) * 4 + cl] = s;
    __syncthreads();
    float tot = 0.f;
#pragma unroll 8
    for (int q = 0; q < 128; ++q) tot += red[q * 4 + cl];
    float inv = 1.f / tot;
    u16* g = G + (long)(order * 512 + ch) * (2 * L);
#pragma unroll 8
    for (int j = jg; j < L; j += 64) {
      float v = hr[(long)j * 2048 + n] * inv;
      if (dir == 0) g[L + j] = f2bf(v);
      else if (j > 0) g[L - j] = f2bf(v);
    }
    if (dir == 1 && jg == 0) g[0] = 0;
    __syncthreads();
  }
}

DI void ph_pdab(const Prm& p, int li, char* smem) {
  float* wl = (float*)smem;
  const int tid = mytid(), lane = tid & 63;
#pragma unroll 8
  for (int e = tid; e < 1024 * 16; e += 512) wl[e] = p.w_in[((long)li * 1024 + (e >> 4)) * NIN + 5632 + (e & 15)];
  __syncthreads();
  const u16* H = (const u16*)(p.ws + OFF_HBF);
  float* out = (float*)(p.ws + OFF_PDAB);
  const int gw = mybid() * 8 + (tid >> 6), nw = gridDim.x * 8;
  for (int tok = gw; tok < T_ALL; tok += nw) {
    float a[16];
#pragma unroll
    for (int j = 0; j < 16; ++j) a[j] = 0.f;
    float hv[16];
#pragma unroll
    for (int i = 0; i < 16; ++i) hv[i] = bf2f(H[(long)tok * 1024 + lane + i * 64]);
#pragma unroll
    for (int i = 0; i < 16; ++i) {
      float h = hv[i];
      const float4* wp = (const float4*)(wl + (lane + i * 64) * 16);
#pragma unroll
      for (int q = 0; q < 4; ++q) {
        float4 w4 = wp[q];
        a[q * 4 + 0] += h * w4.x;
        a[q * 4 + 1] += h * w4.y;
        a[q * 4 + 2] += h * w4.z;
        a[q * 4 + 3] += h * w4.w;
      }
      if ((i & 3) == 3) asm volatile("" ::: "memory");
    }
#pragma unroll
    for (int o = 32; o; o >>= 1)
#pragma unroll
      for (int j = 0; j < 16; ++j) a[j] += __shfl_xor(a[j], o);
    float v = a[0];
#pragma unroll
    for (int j = 1; j < 16; ++j) v = (lane == j) ? a[j] : v;
    if (lane < 16) out[(long)tok * 16 + lane] = v;
  }
  __syncthreads();
}

DI void ph_dncl(const Prm& p, int li, char* smem) {
  const int tid = mytid(), lane = tid & 63, wid = tid >> 6, fr = lane & 15, fq = lane >> 4;
  u16* qn = (u16*)smem;
  u16* kn = qn + 64 * 144;
  float* fb = (float*)(smem + 36864);
  float* KK = fb;
  float* QK = KK + 64 * 65;
  float* Am = QK + 64 * 65;
  float* Tm = Am + 2 * 64 * 65;
  float* gcs = Tm + 2 * 64 * 65;
  float* bts = gcs + 128;
  const u16* PD = (const u16*)(p.ws + OFF_AR);
  const float* AB = (const float*)(p.ws + OFF_PDAB);
  u16* DQ = (u16*)(p.ws + OFF_Y);
  u16* DK = DQ + 18874368L;
  u16* DV = DK + 18874368L;
  u16* CL = (u16*)(p.ws + OFF_AR + 3 * U38);
  float* GC = (float*)(p.ws + OFF_GC);
  float* BT = (float*)(p.ws + OFF_BETA);
  const float* cw = p.dn_conv + (long)li * 3 * 1536;
  for (int it = mybid(); it < 2304; it += gridDim.x) {
    const int b = it / 144, r0 = it % 144, oc = r0 >> 2, h = r0 & 3;
    const int pos0 = oc * 64, s0 = oc < 4 ? 0 : 256, e0 = oc < 4 ? 256 : 2304;
    if (tid < 384) {
      const int cgp = tid % 48, rs = tid / 48;
      const int part = cgp >> 4, d0 = (cgp & 15) * 8, col = part * 512 + h * 128 + d0;
      const u16* basep = PD + (long)tokof(b, pos0) * 1536 + col;
      float wt[3][8];
#pragma unroll
      for (int tp = 0; tp < 3; ++tp) {
        float4 wa = *(const float4*)(cw + tp * 1536 + col), wb = *(const float4*)(cw + tp * 1536 + col + 4);
        wt[tp][0] = wa.x; wt[tp][1] = wa.y; wt[tp][2] = wa.z; wt[tp][3] = wa.w;
        wt[tp][4] = wb.x; wt[tp][5] = wb.y; wt[tp][6] = wb.z; wt[tp][7] = wb.w;
      }
#pragma unroll 1
      for (int hf = 0; hf < 2; ++hf) {
        u32x4 rw[6];
#pragma unroll
        for (int i = 0; i < 6; ++i) {
          int j = rs * 8 + hf * 4 - 1 + i, P = pos0 + j;
          rw[i] = (P >= s0 && P < e0) ? *(const u32x4*)(basep + (long)j * 1536) : u32x4{0u, 0u, 0u, 0u};
        }
#pragma unroll
        for (int r = 0; r < 4; ++r) {
#pragma unroll
          for (int e = 0; e < 8; ++e) {
            unsigned w0_ = rw[r][e >> 1], w1_ = rw[r + 1][e >> 1], w2_ = rw[r + 2][e >> 1];
            float x0 = (e & 1) ? __uint_as_float(w0_ & 0xffff0000u) : __uint_as_float(w0_ << 16);
            float x1 = (e & 1) ? __uint_as_float(w1_ & 0xffff0000u) : __uint_as_float(w1_ << 16);
            float x2 = (e & 1) ? __uint_as_float(w2_ & 0xffff0000u) : __uint_as_float(w2_ << 16);
            float v = wt[0][e] * x0 + wt[1][e] * x1 + wt[2][e] * x2;
            fb[(rs * 8 + hf * 4 + r) * 385 + part * 128 + d0 + e] = v / (1.f + __expf(-v));
          }
        }
      }
    }
    __syncthreads();
    for (int jj = 0; jj < 8; ++jj) {
      int j = wid * 8 + jj, P = pos0 + j;
      long go = ((long)(b * 4 + h) * 2304 + P) * 128;
      float q0 = fb[j * 385 + lane], q1 = fb[j * 385 + 64 + lane];
      float k0 = fb[j * 385 + 128 + lane], k1 = fb[j * 385 + 192 + lane];
      float v0 = fb[j * 385 + 256 + lane], v1 = fb[j * 385 + 320 + lane];
      float iq = rsqrtf(wsum(q0 * q0 + q1 * q1) + 1e-6f), ik = rsqrtf(wsum(k0 * k0 + k1 * k1) + 1e-6f);
      u16 a0 = f2bf(q0 * iq), a1 = f2bf(q1 * iq), c0 = f2bf(k0 * ik), c1 = f2bf(k1 * ik);
      qn[j * 144 + lane] = a0; qn[j * 144 + 64 + lane] = a1;
      kn[j * 144 + lane] = c0; kn[j * 144 + 64 + lane] = c1;
      DQ[go + lane] = a0; DQ[go + 64 + lane] = a1;
      DK[go + lane] = c0; DK[go + 64 + lane] = c1;
      DV[go + lane] = f2bf(v0); DV[go + 64 + lane] = f2bf(v1);
    }
    __syncthreads();
#pragma unroll
    for (int u = 0; u < 4; ++u) {
      int tt = wid * 4 + u, which = tt >> 4, ti = (tt >> 2) & 3, tj = tt & 3;
      const u16* Ap = (which ? qn : kn) + (ti * 16 + fr) * 144 + fq * 8;
      const u16* Bp = kn + (tj * 16 + fr) * 144 + fq * 8;
      f32x4 a = {0.f, 0.f, 0.f, 0.f};
#pragma unroll
      for (int ks = 0; ks < 4; ++ks) a = MFMA(*(const bf16x8*)(Ap + ks * 32), *(const bf16x8*)(Bp + ks * 32), a);
      float* dst = which ? QK : KK;
#pragma unroll
      for (int j = 0; j < 4; ++j) dst[(ti * 16 + fq * 4 + j) * 65 + tj * 16 + fr] = a[j];
    }
    if (tid < 128) {
      int d = tid >> 6, r = tid & 63, j = d ? 63 - r : r;
      int tok = tokof(b, pos0 + j);
      float av = AB[(long)tok * 16 + d * 4 + h], bv = AB[(long)tok * 16 + 8 + d * 4 + h];
      float xx = av + p.dn_dt_bias[li * 8 + d * 4 + h];
      float sp = fmaxf(xx, 0.f) + __logf(1.f + __expf(-fabsf(xx)));
      float g = -expf(p.dn_a_log[li * 8 + d * 4 + h]) * sp;
      for (int o = 1; o < 64; o <<= 1) {
        float t = __shfl_up(g, o);
        if (r >= o) g += t;
      }
      float be = 1.f / (1.f + expf(-bv));
      gcs[d * 64 + r] = g;
      bts[d * 64 + r] = be;
      long ci = ((long)((b * 4 + h) * 2 + d) * 36 + oc) * 64 + r;
      GC[ci] = g;
      BT[ci] = be;
    }
    __syncthreads();
#pragma unroll 4
    for (int e = tid; e < 8192; e += 512) {
      int d = e >> 12, s = (e >> 6) & 63, r = e & 63;
      int j = d ? 63 - r : r, js = d ? 63 - s : s;
      float v = 0.f;
      if (r > s) v = bts[d * 64 + r] * KK[j * 65 + js] * expf(gcs[d * 64 + r] - gcs[d * 64 + s]);
      Am[(d * 64 + s) * 64 + r] = v;
    }
#pragma unroll 4
    for (int e = tid; e < 8192; e += 512) {
      int d = e >> 12, r = (e >> 6) & 63, s = e & 63;
      int j = d ? 63 - r : r, js = d ? 63 - s : s;
      float dec = (r >= s) ? expf(gcs[d * 64 + r] - gcs[d * 64 + s]) : 0.f;
      long ci = (long)((b * 4 + h) * 2 + d) * 36 + oc;
      CL[ci * 8192 + 4096 + r * 64 + s] = f2bf(QK[j * 65 + js] * dec * 0.08838834764831845f);
    }
    __syncthreads();
    {
      const int d = tid >> 8, c = (tid >> 2) & 63, q = tid & 3;
      const float* Atq = Am + d * 64 * 64 + q;
      float* T = Tm + d * 64 * 65;
      float t[16];
#pragma unroll
      for (int i = 0; i < 16; ++i) t[i] = (4 * i + q == c) ? 1.f : 0.f;
#pragma unroll
      for (int s2 = 0; s2 < 63; ++s2) {
        constexpr int dummy = 0;
        const int is = s2 >> 2, qs = s2 & 3;
        const int ctl = qs | (qs << 2) | (qs << 4) | (qs << 6);
        int tsb;
        if (qs == 0) tsb = __builtin_amdgcn_update_dpp(0, __float_as_int(t[is]), 0x00, 0xf, 0xf, false);
        else if (qs == 1) tsb = __builtin_amdgcn_update_dpp(0, __float_as_int(t[is]), 0x55, 0xf, 0xf, false);
        else if (qs == 2) tsb = __builtin_amdgcn_update_dpp(0, __float_as_int(t[is]), 0xAA, 0xf, 0xf, false);
        else tsb = __builtin_amdgcn_update_dpp(0, __float_as_int(t[is]), 0xFF, 0xf, 0xf, false);
        (void)ctl; (void)dummy;
        const float ts = __int_as_float(tsb);
#pragma unroll
        for (int i = is; i < 16; ++i) t[i] -= Atq[s2 * 64 + 4 * i] * ts;
        if ((s2 & 7) == 7) asm volatile("" ::: "memory");
      }
#pragma unroll
      for (int i = 0; i < 16; ++i) T[(4 * i + q) * 65 + c] = t[i];
    }
    __syncthreads();
    for (int e = tid; e < 8192; e += 512) {
      int d = e >> 12, rc = e & 4095;
      long ci = (long)((b * 4 + h) * 2 + d) * 36 + oc;
      CL[ci * 8192 + rc] = f2bf(Tm[(d * 64 + (rc >> 6)) * 65 + (rc & 63)]);
    }
    __syncthreads();
  }
}

DI void ph_dnscan(const Prm& p, char* smem) {
  const int tid = mytid(), lane = tid & 63, wid = tid >> 6, fr = lane & 15, fq = lane >> 4;
  u16* Kg = (u16*)smem;
  u16* Qg = Kg + 64 * 144;
  u16* KdT = Qg + 64 * 144;
  u16* Tl = KdT + 128 * 80;
  u16* Il = Tl + 64 * 80;
  u16* ST = Il + 64 * 80;
  u16* RT = ST + 64 * 144;
  u16* VN = RT + 64 * 80;
  const u16* DQ = (const u16*)(p.ws + OFF_Y);
  const u16* DK = DQ + 18874368L;
  const u16* DV = DK + 18874368L;
  const u16* CL = (const u16*)(p.ws + OFF_AR + 3 * U38);
  const float* GC = (const float*)(p.ws + OFF_GC);
  const float* BT = (const float*)(p.ws + OFF_BETA);
  const int vt = wid & 3, rp = wid >> 2;
  for (int it = mybid(); it < 256; it += gridDim.x) {
    const int b = it >> 4, h = (it >> 2) & 3, d = (it >> 1) & 1, vs = it & 1;
    u16* O = (u16*)(p.ws + OFF_AR + (d ? 6 : 5) * U38);
    f32x4 S[4];
#pragma unroll
    for (int i = 0; i < 4; ++i) S[i] = f32x4{0.f, 0.f, 0.f, 0.f};
    for (int e = tid; e < 64 * 144; e += 512) ST[e] = 0;
    const long seqb = (long)(b * 4 + h) * 2304;
    const long cib = (long)((b * 4 + h) * 2 + d) * 36;
    u32x4 rk0, rk1, rq0, rq1, rT, rI;
    float rg0, rg1, rgl;
    uint2 rv0, rv1;
    float rb0, rb1;
    const int lr0 = tid >> 4, lr1 = (tid + 512) >> 4, lch = tid & 15;
    const int lj0 = d ? 63 - lr0 : lr0, lj1 = d ? 63 - lr1 : lr1;
    const int vr0 = (rp * 2) * 16 + fr, vr1 = (rp * 2 + 1) * 16 + fr;
    const int vj0 = d ? 63 - vr0 : vr0, vj1 = d ? 63 - vr1 : vr1;
#define SCAN_LOAD_KQ(ocx)                                                                    \
  {                                                                                          \
    const long ci_ = cib + (ocx);                                                            \
    const long g0_ = (seqb + (ocx) * 64 + lj0) * 128 + lch * 8, g1_ = (seqb + (ocx) * 64 + lj1) * 128 + lch * 8; \
    rk0 = *(const u32x4*)(DK + g0_); rk1 = *(const u32x4*)(DK + g1_);                        \
    rq0 = *(const u32x4*)(DQ + g0_); rq1 = *(const u32x4*)(DQ + g1_);                        \
    rT = *(const u32x4*)(CL + ci_ * 8192 + (tid >> 3) * 64 + (tid & 7) * 8);                 \
    rI = *(const u32x4*)(CL + ci_ * 8192 + 4096 + (tid >> 3) * 64 + (tid & 7) * 8);          \
    rg0 = GC[ci_ * 64 + lr0]; rg1 = GC[ci_ * 64 + lr1]; rgl = GC[ci_ * 64 + 63];             \
  }
#define SCAN_LOAD_V(ocx)                                                                     \
  {                                                                                          \
    const long ci_ = cib + (ocx);                                                            \
    rv0 = *(const uint2*)(DV + (seqb + (ocx) * 64 + vj0) * 128 + vs * 64 + vt * 16 + fq * 4); \
    rv1 = *(const uint2*)(DV + (seqb + (ocx) * 64 + vj1) * 128 + vs * 64 + vt * 16 + fq * 4); \
    rb0 = BT[ci_ * 64 + vr0]; rb1 = BT[ci_ * 64 + vr1];                                      \
  }
    {
      const int oc0 = d ? 3 : 0;
      SCAN_LOAD_KQ(oc0);
      SCAN_LOAD_V(oc0);
    }
    for (int i = 0; i < 36; ++i) {
      const int oc = d ? (i < 4 ? 3 - i : 39 - i) : i;
      const int ocn = d ? (i + 1 < 4 ? 3 - (i + 1) : 39 - (i + 1)) : i + 1;
      const int pos0 = oc * 64;
      const float gl = rgl;
      {
        float eg0 = __expf(rg0), ed0 = __expf(gl - rg0), eg1 = __expf(rg1), ed1 = __expf(gl - rg1);
        u32x4 ko0, qo0, ko1, qo1;
#pragma unroll
        for (int w = 0; w < 4; ++w) {
          float k0l = __uint_as_float(rk0[w] << 16), k0h = __uint_as_float(rk0[w] & 0xffff0000u);
          float q0l = __uint_as_float(rq0[w] << 16), q0h = __uint_as_float(rq0[w] & 0xffff0000u);
          float k1l = __uint_as_float(rk1[w] << 16), k1h = __uint_as_float(rk1[w] & 0xffff0000u);
          float q1l = __uint_as_float(rq1[w] << 16), q1h = __uint_as_float(rq1[w] & 0xffff0000u);
          ko0[w] = (unsigned)f2bf(k0l * eg0) | ((unsigned)f2bf(k0h * eg0) << 16);
          qo0[w] = (unsigned)f2bf(q0l * eg0 * 0.08838834764831845f) | ((unsigned)f2bf(q0h * eg0 * 0.08838834764831845f) << 16);
          ko1[w] = (unsigned)f2bf(k1l * eg1) | ((unsigned)f2bf(k1h * eg1) << 16);
          qo1[w] = (unsigned)f2bf(q1l * eg1 * 0.08838834764831845f) | ((unsigned)f2bf(q1h * eg1 * 0.08838834764831845f) << 16);
          KdT[(lch * 8 + 2 * w) * 80 + lr0] = f2bf(k0l * ed0);
          KdT[(lch * 8 + 2 * w + 1) * 80 + lr0] = f2bf(k0h * ed0);
          KdT[(lch * 8 + 2 * w) * 80 + lr1] = f2bf(k1l * ed1);
          KdT[(lch * 8 + 2 * w + 1) * 80 + lr1] = f2bf(k1h * ed1);
        }
        *(u32x4*)(Kg + lr0 * 144 + lch * 8) = ko0;
        *(u32x4*)(Qg + lr0 * 144 + lch * 8) = qo0;
        *(u32x4*)(Kg + lr1 * 144 + lch * 8) = ko1;
        *(u32x4*)(Qg + lr1 * 144 + lch * 8) = qo1;
        *(u32x4*)(Tl + (tid >> 3) * 80 + (tid & 7) * 8) = rT;
        *(u32x4*)(Il + (tid >> 3) * 80 + (tid & 7) * 8) = rI;
      }
      lds_barrier();
      if (i + 1 < 36) SCAN_LOAD_KQ(ocn);
      f32x4 ks_[2], qs_[2];
#pragma unroll
      for (int u = 0; u < 2; ++u) { ks_[u] = f32x4{0.f, 0.f, 0.f, 0.f}; qs_[u] = f32x4{0.f, 0.f, 0.f, 0.f}; }
#pragma unroll
      for (int kk = 0; kk < 4; ++kk) {
        bf16x8 a = *(const bf16x8*)(ST + (vt * 16 + fr) * 144 + kk * 32 + fq * 8);
#pragma unroll
        for (int u = 0; u < 2; ++u) {
          int rt = rp * 2 + u;
          bf16x8 bk = *(const bf16x8*)(Kg + (rt * 16 + fr) * 144 + kk * 32 + fq * 8);
          bf16x8 bq = *(const bf16x8*)(Qg + (rt * 16 + fr) * 144 + kk * 32 + fq * 8);
          ks_[u] = MFMA(a, bk, ks_[u]);
          qs_[u] = MFMA(a, bq, qs_[u]);
        }
      }
      {
        int v0 = vt * 16 + fq * 4;
        RT[(v0 + 0) * 80 + vr0] = f2bf(rb0 * (__uint_as_float(rv0.x << 16) - ks_[0][0]));
        RT[(v0 + 1) * 80 + vr0] = f2bf(rb0 * (__uint_as_float(rv0.x & 0xffff0000u) - ks_[0][1]));
        RT[(v0 + 2) * 80 + vr0] = f2bf(rb0 * (__uint_as_float(rv0.y << 16) - ks_[0][2]));
        RT[(v0 + 3) * 80 + vr0] = f2bf(rb0 * (__uint_as_float(rv0.y & 0xffff0000u) - ks_[0][3]));
        RT[(v0 + 0) * 80 + vr1] = f2bf(rb1 * (__uint_as_float(rv1.x << 16) - ks_[1][0]));
        RT[(v0 + 1) * 80 + vr1] = f2bf(rb1 * (__uint_as_float(rv1.x & 0xffff0000u) - ks_[1][1]));
        RT[(v0 + 2) * 80 + vr1] = f2bf(rb1 * (__uint_as_float(rv1.y << 16) - ks_[1][2]));
        RT[(v0 + 3) * 80 + vr1] = f2bf(rb1 * (__uint_as_float(rv1.y & 0xffff0000u) - ks_[1][3]));
      }
      if (i + 1 < 36) SCAN_LOAD_V(ocn);
      lds_barrier();
      {
        f32x4 vn[2];
#pragma unroll
        for (int u = 0; u < 2; ++u) vn[u] = f32x4{0.f, 0.f, 0.f, 0.f};
#pragma unroll
        for (int kk = 0; kk < 2; ++kk) {
          bf16x8 a = *(const bf16x8*)(RT + (vt * 16 + fr) * 80 + kk * 32 + fq * 8);
#pragma unroll
          for (int u = 0; u < 2; ++u) {
            bf16x8 bb = *(const bf16x8*)(Tl + ((rp * 2 + u) * 16 + fr) * 80 + kk * 32 + fq * 8);
            vn[u] = MFMA(a, bb, vn[u]);
          }
        }
#pragma unroll
        for (int u = 0; u < 2; ++u) {
          int r = (rp * 2 + u) * 16 + fr, v0 = vt * 16 + fq * 4;
#pragma unroll
          for (int j = 0; j < 4; ++j) VN[(v0 + j) * 80 + r] = f2bf(vn[u][j]);
        }
      }
      lds_barrier();
#pragma unroll
      for (int kk = 0; kk < 2; ++kk) {
        bf16x8 a = *(const bf16x8*)(VN + (vt * 16 + fr) * 80 + kk * 32 + fq * 8);
#pragma unroll
        for (int u = 0; u < 2; ++u) {
          bf16x8 bb = *(const bf16x8*)(Il + ((rp * 2 + u) * 16 + fr) * 80 + kk * 32 + fq * 8);
          qs_[u] = MFMA(a, bb, qs_[u]);
        }
      }
#pragma unroll
      for (int u = 0; u < 2; ++u) {
        int r = (rp * 2 + u) * 16 + fr, j = d ? 63 - r : r;
        u16* op = O + (long)tokof(b, pos0 + j) * 512 + h * 128 + vs * 64 + vt * 16 + fq * 4;
        ushort4 ov4;
        ov4.x = f2bf(qs_[u][0]); ov4.y = f2bf(qs_[u][1]); ov4.z = f2bf(qs_[u][2]); ov4.w = f2bf(qs_[u][3]);
        *(ushort4*)op = ov4;
      }
      {
        float ge = __expf(gl);
#pragma unroll
        for (int u = 0; u < 4; ++u) S[u] *= ge;
#pragma unroll
        for (int kk = 0; kk < 2; ++kk) {
          bf16x8 a = *(const bf16x8*)(VN + (vt * 16 + fr) * 80 + kk * 32 + fq * 8);
#pragma unroll
          for (int u = 0; u < 4; ++u) {
            bf16x8 bb = *(const bf16x8*)(KdT + ((rp * 4 + u) * 16 + fr) * 80 + kk * 32 + fq * 8);
            S[u] = MFMA(a, bb, S[u]);
          }
        }
#pragma unroll
        for (int u = 0; u < 4; ++u) {
          int dd = (rp * 4 + u) * 16 + fr, v0 = vt * 16 + fq * 4;
#pragma unroll
          for (int j = 0; j < 4; ++j) ST[(v0 + j) * 144 + dd] = f2bf(S[u][j]);
        }
      }
      lds_barrier();
    }
#undef SCAN_LOAD_KQ
#undef SCAN_LOAD_V
  }
}

DI void ph_dnfin(const Prm& p, int li) {
  const int lane = mytid() & 63;
  const int gw = mybid() * 8 + (mytid() >> 6), nw = gridDim.x * 8;
  const u16* O = (const u16*)(p.ws + OFF_AR + 5 * U38);
  const u16* O2 = (const u16*)(p.ws + OFF_AR + 6 * U38);
  u16* Z = (u16*)(p.ws + OFF_Y + 3 * U38);
  const float n0 = p.dn_norm[li * 128 + lane * 2], n1 = p.dn_norm[li * 128 + lane * 2 + 1];
#pragma unroll 2
  for (int tok = gw; tok < T_ALL; tok += nw) {
    ushort2 oa[4], ob[4], zz[4];
    float ox[4], oy[4], ss[4];
#pragma unroll
    for (int h = 0; h < 4; ++h) {
      long o = (long)tok * 512 + h * 128 + lane * 2;
      oa[h] = *(const ushort2*)(O + o);
      ob[h] = *(const ushort2*)(O2 + o);
      zz[h] = *(const ushort2*)(Z + o);
    }
#pragma unroll
    for (int h = 0; h < 4; ++h) {
      ox[h] = bf2f(oa[h].x) + bf2f(ob[h].x);
      oy[h] = bf2f(oa[h].y) + bf2f(ob[h].y);
      ss[h] = ox[h] * ox[h] + oy[h] * oy[h];
    }
#pragma unroll
    for (int o = 32; o; o >>= 1)
#pragma unroll
      for (int h = 0; h < 4; ++h) ss[h] += __shfl_xor(ss[h], o);
#pragma unroll
    for (int h = 0; h < 4; ++h) {
      float inv = rsqrtf(ss[h] * (1.f / 128.f) + 1e-6f);
      float z0 = bf2f(zz[h].x), z1 = bf2f(zz[h].y);
      ushort2 y;
      y.x = f2bf(ox[h] * inv * n0 * (z0 / (1.f + __expf(-z0))));
      y.y = f2bf(oy[h] * inv * n1 * (z1 / (1.f + __expf(-z1))));
      *(ushort2*)(Z + (long)tok * 512 + h * 128 + lane * 2) = y;
    }
  }
}

DI void ph_aprep(const Prm& p, int li) {
  const int lane = mytid() & 63;
  const int gw = mybid() * 8 + (mytid() >> 6), nw = gridDim.x * 8;
  const u16* PA = (const u16*)(p.ws + OFF_AR);
  u16* QH = (u16*)(p.ws + OFF_AR + 3 * U38);
  u16* KH = QH + 18874368L;
  const int f = lane & 15;
  const float inv_f = powf(10000.f, -(float)f / 16.f);
  for (int tok = gw; tok < T_ALL; tok += nw) {
    int b, P;
    float cs = 1.f, sn = 0.f;
    if (tok < T_LAT) {
      b = tok >> 11;
      int l = tok & 2047;
      P = 256 + l;
      float pos = (lane < 32) ? (float)(l >> 6) : (float)(l & 63);
      float ang = pos * inv_f;
      cs = cosf(ang);
      sn = sinf(ang);
    } else {
      b = (tok - T_LAT) >> 8;
      P = (tok - T_LAT) & 255;
    }
    float xv[16], ssq[16];
#pragma unroll
    for (int g = 0; g < 16; ++g) {
      xv[g] = bf2f(PA[(long)tok * 1024 + g * 64 + lane]);
      ssq[g] = xv[g] * xv[g];
    }
#pragma unroll
    for (int o = 32; o; o >>= 1)
#pragma unroll
      for (int g = 0; g < 16; ++g) ssq[g] += __shfl_xor(ssq[g], o);
#pragma unroll
    for (int g = 0; g < 16; ++g) {
      int which = g >> 3, h = (g >> 1) & 3, c = g & 1;
      float inv = rsqrtf(ssq[g] * (1.f / 64.f) + 1e-6f);
      float y = xv[g] * inv * p.qk_gain[(li * 2 + which) * 64 + lane];
      float pr = __shfl_xor(y, 16);
      float o = (lane & 16) ? (y * cs + pr * sn) : (y * cs - pr * sn);
      if (which == 0) o *= 0.18033688011112042f;
      u16* dst = (which ? KH : QH) + ((long)((b * 4 + h) * 2 + c) * 2304 + P) * 64 + lane;
      *dst = f2bf(o);
    }
  }
}

DI void ph_attn(const Prm& p, int li, long base, char* smem) {
  const int tid = mytid(), lane = tid & 63, wid = tid >> 6, fr = lane & 15, fq = lane >> 4;
  const u16* QH = (const u16*)(p.ws + OFF_AR + 3 * U38);
  const u16* KH = QH + 18874368L;
  const u16* VT = (const u16*)(p.ws + OFF_AR + 5 * U38);
  u16* YA = (u16*)(p.ws + OFF_Y);
  u16* s = (u16*)smem;
  constexpr int STG = 128 * 80 + 128 * 72;
  const float lambda_init = 0.8f - 0.6f * expf(-0.3f * (float)li);
  float lamv, mshift;
  {
    const float* lv = p.lam + li * 256;
    float a = wsum(lv[lane] * lv[64 + lane]), b2 = wsum(lv[128 + lane] * lv[192 + lane]);
    lamv = expf(a) - expf(b2) + lambda_init;
    float gq = wmax(fabsf(p.qk_gain[(li * 2) * 64 + lane])), gk = wmax(fabsf(p.qk_gain[(li * 2 + 1) * 64 + lane]));
    mshift = 8.f * gq * gk * 1.4426950408889634f;
  }
  for (int it = first_item(base); it < (li == 3 ? 1024 : 1152); it += gridDim.x) {
    int b, h, qp0, nkeys;
    if (it < 1024) { b = it >> 6; h = (it >> 4) & 3; qp0 = 256 + (it & 15) * 128; nkeys = 2304; }
    else { int i2 = it - 1024; b = i2 >> 3; h = (i2 >> 1) & 3; qp0 = (i2 & 1) * 128; nkeys = 256; }
    const long kb0 = (long)((b * 4 + h) * 2) * 2304;
    bf16x8 qf[2][2];
#pragma unroll
    for (int c = 0; c < 2; ++c)
#pragma unroll
      for (int ks = 0; ks < 2; ++ks)
        qf[c][ks] = *(const bf16x8*)(QH + (kb0 + (long)c * 2304 + qp0 + wid * 16 + fr) * 64 + ks * 32 + fq * 8);
    f32x4 O0[8], O1[8];
#pragma unroll
    for (int i = 0; i < 8; ++i) { O0[i] = f32x4{0.f, 0.f, 0.f, 0.f}; O1[i] = f32x4{0.f, 0.f, 0.f, 0.f}; }
    f32x4 L0 = {0.f, 0.f, 0.f, 0.f}, L1 = {0.f, 0.f, 0.f, 0.f};
    const bf16x8 ones = {0x3F80, 0x3F80, 0x3F80, 0x3F80, 0x3F80, 0x3F80, 0x3F80, 0x3F80};
    uint4 rk[2], rv[2];
    const int nt = nkeys >> 6;
#pragma unroll
    for (int u = 0; u < 2; ++u) {
      int id = tid + u * 512;
      int c = id >> 9, key = (id >> 3) & 63, ch = id & 7;
      rk[u] = *(const uint4*)(KH + (kb0 + (long)c * 2304 + key) * 64 + ch * 8);
      int dv = id >> 3;
      rv[u] = *(const uint4*)(VT + ((long)(b * 512 + h * 128 + dv)) * 2304 + ch * 8);
    }
#pragma unroll
    for (int u = 0; u < 2; ++u) {
      int id = tid + u * 512;
      *(uint4*)(s + (id >> 3) * 80 + (id & 7) * 8) = rk[u];
      *(uint4*)(s + 128 * 80 + (id >> 3) * 72 + (id & 7) * 8) = rv[u];
    }
    lds_barrier();
    for (int t = 0; t < nt; ++t) {
      const bool more = t + 1 < nt;
      if (more) {
        int kp0 = (t + 1) * 64;
#pragma unroll
        for (int u = 0; u < 2; ++u) {
          int id = tid + u * 512;
          int c = id >> 9, key = (id >> 3) & 63, ch = id & 7;
          rk[u] = *(const uint4*)(KH + (kb0 + (long)c * 2304 + kp0 + key) * 64 + ch * 8);
          int dv = id >> 3;
          rv[u] = *(const uint4*)(VT + ((long)(b * 512 + h * 128 + dv)) * 2304 + kp0 + ch * 8);
        }
      }
      const u16* ks_ = s + (t & 1) * STG;
      const u16* vs_ = ks_ + 128 * 80;
      bf16x8 pf[2][2];
#pragma unroll
      for (int c = 0; c < 2; ++c) {
#pragma unroll
        for (int kk2 = 0; kk2 < 2; ++kk2) {
          u32x4 pw;
#pragma unroll
          for (int hh = 0; hh < 2; ++hh) {
            const int k4 = kk2 * 2 + hh;
            f32x4 a = {-mshift, -mshift, -mshift, -mshift};
#pragma unroll
            for (int kk = 0; kk < 2; ++kk)
              a = MFMA(*(const bf16x8*)(ks_ + (c * 64 + k4 * 16 + fr) * 80 + kk * 32 + fq * 8), qf[c][kk], a);
            pw[hh * 2 + 0] = pk_bf16(__builtin_amdgcn_exp2f(a[0]), __builtin_amdgcn_exp2f(a[1]));
            pw[hh * 2 + 1] = pk_bf16(__builtin_amdgcn_exp2f(a[2]), __builtin_amdgcn_exp2f(a[3]));
          }
          pf[c][kk2] = *(bf16x8*)&pw;
        }
      }
#pragma unroll
      for (int kk = 0; kk < 2; ++kk) {
        L0 = MFMA(ones, pf[0][kk], L0);
        L1 = MFMA(ones, pf[1][kk], L1);
      }
#pragma unroll
      for (int dt = 0; dt < 8; ++dt) {
#pragma unroll
        for (int kk = 0; kk < 2; ++kk) {
          const u16* vp = vs_ + (dt * 16 + fr) * 72 + kk * 32 + fq * 4;
          uint2 lo = *(const uint2*)vp, hi = *(const uint2*)(vp + 16);
          uint4 av = {lo.x, lo.y, hi.x, hi.y};
          bf16x8 a = *(bf16x8*)&av;
          O0[dt] = MFMA(a, pf[0][kk], O0[dt]);
          O1[dt] = MFMA(a, pf[1][kk], O1[dt]);
        }
      }
      if (more) {
        u16* ns = s + ((t + 1) & 1) * STG;
#pragma unroll
        for (int u = 0; u < 2; ++u) {
          int id = tid + u * 512;
          *(uint4*)(ns + (id >> 3) * 80 + (id & 7) * 8) = rk[u];
          *(uint4*)(ns + 128 * 80 + (id >> 3) * 72 + (id & 7) * 8) = rv[u];
        }
      }
      lds_barrier();
    }
    float i0 = 1.f / L0[0], i1 = lamv / L1[0], ss = 0.f;
#pragma unroll
    for (int dt = 0; dt < 8; ++dt)
#pragma unroll
      for (int j = 0; j < 4; ++j) {
        float o = O0[dt][j] * i0 - O1[dt][j] * i1;
        O0[dt][j] = o;
        ss += o * o;
      }
    ss += __shfl_xor(ss, 16); ss += __shfl_xor(ss, 32);
    float inv = rsqrtf(ss * (1.f / 128.f) + 1e-6f) * (1.f - lambda_init);
    int tok = tokof(b, qp0 + wid * 16 + fr);
#pragma unroll
    for (int dt = 0; dt < 8; ++dt) {
      int dv = dt * 16 + fq * 4;
      const float* sw = p.subln + li * 128 + dv;
      ushort4 o;
      o.x = f2bf(O0[dt][0] * inv * sw[0]);
      o.y = f2bf(O0[dt][1] * inv * sw[1]);
      o.z = f2bf(O0[dt][2] * inv * sw[2]);
      o.w = f2bf(O0[dt][3] * inv * sw[3]);
      *(ushort4*)(YA + (long)tok * 512 + h * 128 + dv) = o;
    }
  }
}

template <int L>
DI void hyena_item(const Prm& p, int li, int ch, char* smem) {
  constexpr int CS = 2 * L + 8;
  constexpr int ZS = L + 8;
  constexpr int MT = L / 128;
  constexpr int MG = MT > 8 ? 8 : MT, NG = MT / MG;
  const int tid = mytid(), lane = tid & 63, wid = tid >> 6, fr = lane & 15, fq = lane >> 4;
  u16* cp = (u16*)smem;
  u16* zr = cp + 8 * CS;
  const u16* PH = (const u16*)(p.ws + OFF_AR) + (L == 2048 ? 0L : 32768L * 1536);
  const u16* G = (const u16*)(p.ws + (L == 2048 ? OFF_TAPL : OFF_TAPC));
  u16* YB = (u16*)(p.ws + OFF_Y + U38);
  const float* cw = p.hy_conv + (long)li * 3 * 1536;
  {
    float w0 = cw[1024 + ch], w1 = cw[1536 + 1024 + ch], w2 = cw[3072 + 1024 + ch];
#pragma unroll 8
    for (int e = tid; e < 16 * L; e += 512) {
      int b = e / L, sidx = e % L;
      const u16* row = PH + ((long)b * 1536 + 1024 + ch) * L;
      float v = w1 * bf2f(row[sidx]);
      if (sidx > 0) v += w0 * bf2f(row[sidx - 1]);
      if (sidx + 1 < L) v += w2 * bf2f(row[sidx + 1]);
      zr[b * ZS + L - 1 - sidx] = f2bf(v);
    }
  }
#pragma unroll
  for (int order = 0; order < 2; ++order) {
    {
      const u16* g = G + (long)(order * 512 + ch) * (2 * L);
#pragma unroll 8
      for (int e = tid; e < 8 * 2 * L; e += 512) {
        int c = e / (2 * L), i = e % (2 * L);
        cp[c * CS + i] = (i + c < 2 * L) ? g[i + c] : (u16)0;
      }
    }
    __syncthreads();
    const float bias = p.hy_bias[(li * 2 + order) * 512 + ch];
    const int gcol = order * 512 + ch;
    const float w0 = cw[gcol], w1 = cw[1536 + gcol], w2 = cw[3072 + gcol];
    const int tq = wid * (L / 8) + fq * 4;
    const u16* xb = PH + ((long)fr * 1536 + gcol) * L + tq;
    const u16* zb = zr + fr * ZS + L - 1 - tq;
    unsigned zp[NG][MG][2];
#pragma unroll
    for (int grp = 0; grp < NG; ++grp) {
      f32x4 acc[MG];
#pragma unroll
      for (int m = 0; m < MG; ++m) acc[m] = f32x4{0.f, 0.f, 0.f, 0.f};
      const int tb = wid * (L / 8) + grp * MG * 16 + fr;
      if constexpr (MG == 8) {
        const int i00 = tb - fq * 8 - 7 + L, c0 = i00 & 7;
        const u16* ab = cp + c0 * CS + (i00 - c0);
        const u16* zbp = zr + fr * ZS + (L - 8 - fq * 8);
        bf16x8 W[16];
#pragma unroll 1
        for (int s0 = 0; s0 < L; s0 += 256) {
#pragma unroll
          for (int k = 0; k < 8; ++k) {
            const int sk = s0 + 32 * k;
            if (k == 0) {
#pragma unroll
              for (int m = 0; m < 8; ++m) W[m] = *(const bf16x8*)(ab + m * 16 - sk);
            }
            if (k < 7) {
              W[(16 - 2 * k - 2) & 15] = *(const bf16x8*)(ab - sk - 32);
              W[(16 - 2 * k - 1) & 15] = *(const bf16x8*)(ab - sk - 32 + 16);
            }
            bf16x8 bk = *(const bf16x8*)(zbp - sk);
#pragma unroll
            for (int m = 0; m < 8; ++m) acc[m] = MFMA(W[(m + 16 - 2 * k) & 15], bk, acc[m]);
          }
        }
      } else {
#pragma unroll 2
        for (int s0 = 0; s0 < L; s0 += 32) {
          bf16x8 bfr = *(const bf16x8*)(zr + fr * ZS + (L - 8 - s0 - fq * 8));
#pragma unroll
          for (int m = 0; m < MG; ++m) {
            int i0 = tb + m * 16 - s0 - fq * 8 - 7 + L;
            int c = i0 & 7;
            bf16x8 afr = *(const bf16x8*)(cp + c * CS + (i0 - c));
            acc[m] = MFMA(afr, bfr, acc[m]);
          }
        }
      }
#pragma unroll
      for (int m = 0; m < MG; ++m) {
        float r4[4];
#pragma unroll
        for (int j = 0; j < 4; ++j) {
          const int off = (grp * MG + m) * 16 + j;
          const int t = tq + off;
          float xa = bf2f(xb[off - 1]), xc = bf2f(xb[off]), xd = bf2f(xb[off + 1]);
          xa = (t > 0) ? xa : 0.f;
          xd = (t + 1 < L) ? xd : 0.f;
          float xg = w0 * xa + w1 * xc + w2 * xd;
          float zin = bf2f(zb[-off]);
          r4[j] = xg * (acc[m][j] + bias * zin);
        }
        zp[grp][m][0] = (unsigned)f2bf(r4[0]) | ((unsigned)f2bf(r4[1]) << 16);
        zp[grp][m][1] = (unsigned)f2bf(r4[2]) | ((unsigned)f2bf(r4[3]) << 16);
      }
    }
    __syncthreads();
#pragma unroll
    for (int grp = 0; grp < NG; ++grp)
#pragma unroll
      for (int m = 0; m < MG; ++m)
#pragma unroll
        for (int j = 0; j < 4; ++j) {
          int t = wid * (L / 8) + (grp * MG + m) * 16 + fq * 4 + j;
          u16 v = (u16)(zp[grp][m][j >> 1] >> ((j & 1) * 16));
          zr[fr * ZS + L - 1 - t] = v;
        }
  }
  __syncthreads();
  {
    u16* YBT = (u16*)(p.ws + OFF_AR + 5 * U38) + (L == 2048 ? 0L : 16L * 512 * 2048);
#pragma unroll 4
    for (int e = tid; e < 16 * L; e += 512) {
      int b = e / L, t = e % L;
      YBT[((long)b * 512 + ch) * L + t] = zr[b * ZS + L - 1 - t];
    }
  }
  __syncthreads();
}

DI long ph_ytrans(const Prm& p, long base, bool lastl, char* smem) {
  u16* tl = (u16*)smem;
  const u16* YBT = (const u16*)(p.ws + OFF_AR + 5 * U38);
  u16* YB = (u16*)(p.ws + OFF_Y + U38);
  const int tid = mytid(), G = gridDim.x;
  const int total = lastl ? 4096 : 4608;
  auto srcp = [&](int it) -> const u16* {
    if (it < 4096) {
      int b = it >> 8, ct = (it >> 5) & 7, lt = it & 31;
      return YBT + ((long)b * 512 + ct * 64 + (tid >> 3)) * 2048 + lt * 64 + (tid & 7) * 8;
    } else {
      int i2 = it - 4096, b = i2 >> 5, ct = (i2 >> 2) & 7, lt = i2 & 3;
      return YBT + 16L * 512 * 2048 + ((long)b * 512 + ct * 64 + (tid >> 3)) * 256 + lt * 64 + (tid & 7) * 8;
    }
  };
  int it = first_item(base);
  u32x4 v = {0u, 0u, 0u, 0u};
  if (it < total) v = *(const u32x4*)srcp(it);
  for (; it < total; it += G) {
    *(u32x4*)(tl + (tid >> 3) * 72 + (tid & 7) * 8) = v;
    __syncthreads();
    if (it + G < total) v = *(const u32x4*)srcp(it + G);
    long tok0;
    int ct;
    if (it < 4096) { int b = it >> 8, lt = it & 31; ct = (it >> 5) & 7; tok0 = (long)b * 2048 + lt * 64; }
    else { int i2 = it - 4096, b = i2 >> 5, lt = i2 & 3; ct = (i2 >> 2) & 7; tok0 = (long)T_LAT + b * 256 + lt * 64; }
    const int lrow = tid >> 3, cc = tid & 7;
    u32x4 o;
#pragma unroll
    for (int w = 0; w < 4; ++w) {
      unsigned lo = tl[(cc * 8 + 2 * w) * 72 + lrow], hi = tl[(cc * 8 + 2 * w + 1) * 72 + lrow];
      o[w] = lo | (hi << 16);
    }
    *(u32x4*)(YB + (tok0 + lrow) * 512 + ct * 64 + cc * 8) = o;
    __syncthreads();
  }
  return base + total;
}

DI void ph_merge(const Prm& p, char* smem, bool lastl) {
  const int tid = mytid(), lane = tid & 63, wid = tid >> 6;
  const int wm = wid >> 1, wn = wid & 1, fr = lane & 15, fq = lane >> 4;
  const u16* H = (const u16*)(p.ws + OFF_HBF);
  const u16* Y = (const u16*)(p.ws + OFF_Y);
  const u16* WG = (const u16*)(p.ws + OFF_WB) + WO_G;
  const u16* WBr = (const u16*)(p.ws + OFF_WB) + WO_B;
  u16* MG = (u16*)(p.ws + OFF_AR);
  const int NT = (lastl ? 256 : 288) * 8, G = gridDim.x;
  Stg r0, r1;
  bool pre = false;
  for (int t = mybid(); t < NT; t += G) {
    const int mt = t >> 3, nt = t & 7;
    const bool hn = t + G < NT;
    const int mt2 = (t + G) >> 3, nt2 = (t + G) & 7;
    f32x4 acc[2][4], g[2][4], y[2][4];
#pragma unroll
    for (int a = 0; a < 2; ++a)
#pragma unroll
      for (int b = 0; b < 4; ++b) acc[a][b] = f32x4{0.f, 0.f, 0.f, 0.f};
    const u16* gA = H + (long)mt * 128 * 1024;
    for (int n = 0; n < 4; ++n) {
      const u16* gB = WG + ((long)n * 1024 + nt * 128) * 1024;
      const u16* yA = Y + (long)n * (T_ALL * 512L) + (long)mt * 128 * 512;
      const u16* yB = WBr + ((long)n * 1024 + nt * 128) * 512;
      gemm_tile<2>(g, gA, 1024, gB, 1024, 1024, smem, r0, r1, pre, yA, 512, yB, 512);
      const u16* nxA = (n < 3) ? gA : (hn ? H + (long)mt2 * 128 * 1024 : nullptr);
      const u16* nxB = (n < 3) ? WG + ((long)(n + 1) * 1024 + nt * 128) * 1024 : WG + ((long)nt2 * 128) * 1024;
      gemm_tile<2>(y, yA, 512, yB, 512, 512, smem, r0, r1, true, nxA, 1024, nxB, 1024);
      pre = true;
#pragma unroll
      for (int a = 0; a < 2; ++a)
#pragma unroll
        for (int b = 0; b < 4; ++b)
#pragma unroll
          for (int j = 0; j < 4; ++j) acc[a][b][j] += y[a][b][j] / (1.f + __expf(-g[a][b][j]));
    }
    pre = hn;
#pragma unroll
    for (int a = 0; a < 2; ++a)
#pragma unroll
      for (int b = 0; b < 4; ++b) {
        int r = wm * 32 + a * 16 + fr, c = wn * 64 + b * 16 + fq * 4;
        uint2 o;
        o.x = pk_bf16(acc[a][b][0], acc[a][b][1]);
        o.y = pk_bf16(acc[a][b][2], acc[a][b][3]);
        *(uint2*)(MG + ((long)mt * 128 + r) * 1024 + nt * 128 + c) = o;
      }
  }
}

DI void run_phase(const Prm& p, int ph, char* smem) {
  if (ph == 0) { ph_init(p, smem); return; }
  const int li = (ph - 1) / 14, k = (ph - 1) % 14;
  const u16* WB = (const u16*)(p.ws + OFF_WB);
  const u16* HB = (const u16*)(p.ws + OFF_HBF);
  const float* MOD = (const float*)(p.ws + OFF_MOD);
  u16* AR = (u16*)(p.ws + OFF_AR);
  u16* Yb = (u16*)(p.ws + OFF_Y);
  const int G = gridDim.x;
  TD d;
  d.split = 0; d.scale = 1.f; d.mode = 0; d.tok0 = 0; d.col0 = 0; d.g = MOD;
  switch (k) {
    case 0: {
      u16* W = (u16*)(p.ws + OFF_WB);
      long base = 0;
      base = tr_job(base, p.w_in + (long)li * 1024 * NIN, 1024, NIN, W + WO_IN, 1, smem);
      base = tr_job(base, p.w_gate + (long)li * 4 * 1048576, 1024, 1024, W + WO_G, 4, smem);
      base = tr_job(base, p.w_branch + (long)li * 4 * 524288, 512, 1024, W + WO_B, 4, smem);
      base = tr_job(base, p.w_o + (long)li * 1048576, 1024, 1024, W + WO_O, 1, smem);
      base = tr_job(base, p.w_mlp1 + (long)li * 4194304, 1024, 4096, W + WO_1, 1, smem);
      base = tr_job(base, p.w_mlp2 + (long)li * 4194304, 4096, 1024, W + WO_2, 1, smem);
      ph_taps1(p, li, base, smem);
      ph_norm(p, li, 0);
    } break;
    case 1: {
      auto dec = [&](int t, TD& o) {
        o.lda = 1024; o.ldb = 1024; o.K = 1024; o.mode = 0;
        if (t < 1728) {
          int mt = t / 12, nt = t % 12;
          o.A = HB + (long)mt * 256 * 1024; o.B = WB + WO_IN + (long)(3584 + nt * 128) * 1024;
          o.C = AR + (long)mt * 256 * 1536 + nt * 128; o.ldc = 1536;
        } else if (t < 2304) {
          int t2 = t - 1728, mt = t2 >> 2, nt = t2 & 3;
          o.A = HB + (long)mt * 256 * 1024; o.B = WB + WO_IN + (long)(5120 + nt * 128) * 1024;
          o.C = Yb + 3 * (U38 / 2) + (long)mt * 256 * 512 + nt * 128; o.ldc = 512;
        } else {
          int mt = t - 2304;
          o.A = HB + (long)mt * 256 * 1024; o.B = WB + WO_IN + (long)5632 * 1024;
          o.C = (u16*)((float*)(p.ws + OFF_PDAB) + (long)mt * 256 * 16); o.ldc = 16; o.mode = 3;
        }
      };
      {
        Stg r0, r1;
        bool pre = false;
        TD dn = d;
        int t = mybid();
        if (t < 2448) dec(t, d);
        for (; t < 2448; t += G) {
          const bool hn = t + G < 2448;
          if (hn) dec(t + G, dn);
          run_tile2(p, d, smem, r0, r1, pre, hn ? dn.A : nullptr, dn.lda, dn.B, dn.ldb);
          pre = hn;
          d = dn;
        }
      }
      ph_taps2(p, 2448, smem);
    } break;
    case 2: ph_dncl(p, li, smem); break;
    case 3: ph_dnscan(p, smem); break;
    case 4: {
      {
        Stg r0, r1;
        bool pre = false;
        for (int t = mybid(); t < 1152; t += G) {
          int mt = t >> 3, nt = t & 7;
          const bool hn = t + G < 1152;
          int mt2 = (t + G) >> 3, nt2 = (t + G) & 7;
          d.lda = 1024; d.ldb = 1024; d.K = 1024;
          d.A = HB + (long)mt * 256 * 1024; d.B = WB + WO_IN + (long)(nt * 128) * 1024;
          d.C = AR + 3 * (U38 / 2); d.ldc = 0; d.mode = 4; d.tok0 = mt * 256; d.col0 = nt;
          d.g = p.qk_gain + li * 128;
          run_tile2(p, d, smem, r0, r1, pre, hn ? HB + (long)mt2 * 256 * 1024 : nullptr, 1024,
                    WB + WO_IN + (long)(nt2 * 128) * 1024, 1024);
          pre = hn;
        }
      }
      ph_dnfin(p, li);
    } break;
    case 5: {
      u16* VT = AR + 5 * (U38 / 2);
      u16* PF = AR + 6 * (U38 / 2);
      auto dec = [&](int t, TD& o) {
        o.lda = 1024; o.ldb = 1024; o.K = 1024;
        if (t < 512) {
          int b = t >> 5, r = t & 31, mt = r >> 4, nt = r & 15;
          o.A = WB + WO_IN + (long)(1024 + mt * 256) * 1024; o.B = HB + ((long)b * 2048 + nt * 128) * 1024;
          o.C = VT + ((long)b * 512 + mt * 256) * 2304 + 256 + nt * 128; o.ldc = 2304;
        } else if (t < 576) {
          int t2 = t - 512, b = t2 >> 2, r = t2 & 3, mt = r >> 1, nt = r & 1;
          o.A = WB + WO_IN + (long)(1024 + mt * 256) * 1024; o.B = HB + ((long)T_LAT + b * 256 + nt * 128) * 1024;
          o.C = VT + ((long)b * 512 + mt * 256) * 2304 + nt * 128; o.ldc = 2304;
        } else {
          int t2 = t - 576, mt = t2 >> 2, nt = t2 & 3;
          o.A = HB + (long)mt * 256 * 1024; o.B = WB + WO_IN + (long)(3072 + nt * 128) * 1024;
          o.C = PF + (long)mt * 256 * 512 + nt * 128; o.ldc = 512;
        }
      };
      {
        Stg r0, r1;
        bool pre = false;
        TD dn = d;
        int t = mybid();
        if (t < 1152) dec(t, d);
        for (; t < 1152; t += G) {
          const bool hn = t + G < 1152;
          if (hn) dec(t + G, dn);
          run_tile2(p, d, smem, r0, r1, pre, hn ? dn.A : nullptr, dn.lda, dn.B, dn.ldb);
          pre = hn;
          d = dn;
        }
      }
    } break;
    case 6: {
      ph_attn(p, li, 0, smem);
      auto dec = [&](int t, TD& o) {
        o.lda = 1024; o.ldb = 1024; o.K = 1024;
        if (t < 1536) {
          int b = t / 96, r = t % 96, mt = r >> 4, nt = r & 15;
          o.A = WB + WO_IN + (long)(1536 + mt * 256) * 1024; o.B = HB + ((long)b * 2048 + nt * 128) * 1024;
          o.C = AR + ((long)b * 1536 + mt * 256) * 2048 + nt * 128; o.ldc = 2048;
        } else {
          int t2 = t - 1536, b = t2 / 12, r = t2 % 12, mt = r >> 1, nt = r & 1;
          o.A = WB + WO_IN + (long)(1536 + mt * 256) * 1024; o.B = HB + ((long)T_LAT + b * 256 + nt * 128) * 1024;
          o.C = AR + 32768L * 1536 + ((long)b * 1536 + mt * 256) * 256 + nt * 128; o.ldc = 256;
        }
      };
      {
        Stg r0, r1;
        bool pre = false;
        TD dn = d;
        int t = first_item(1152);
        if (t < 1728) dec(t, d);
        for (; t < 1728; t += G) {
          const bool hn = t + G < 1728;
          if (hn) dec(t + G, dn);
          run_tile2(p, d, smem, r0, r1, pre, hn ? dn.A : nullptr, dn.lda, dn.B, dn.ldb);
          pre = hn;
          d = dn;
        }
      }
    } break;
    case 7: {
#if !defined(TESTSEL) || TESTSEL == 1
      for (int it = mybid(); it < 512; it += G) hyena_item<2048>(p, li, it, smem);
#endif
#if !defined(TESTSEL) || TESTSEL == 2
      if (li < 3)
        for (int it = mybid(); it < 512; it += G) hyena_item<256>(p, li, it, smem);
#endif
#if !defined(TESTSEL) || TESTSEL == 3
      const u16* PF = AR + 6 * (U38 / 2);
      u16* WF = AR + 3 * (U38 / 2);
      const u16* DCm = (const u16*)(p.ws + OFF_DC);
      auto dec = [&](int t, TD& o) {
        o.A = DCm; o.lda = 128; o.ldb = 512; o.K = 128;
        if (t < 1024) {
          int bg = t >> 4, nt = t & 15, b = bg >> 2, g = bg & 3;
          o.B = PF + ((long)b * 2048 + nt * 128) * 512 + g * 128;
          o.C = WF + ((long)b * 512 + g * 128) * 4096 + nt * 128; o.ldc = 4096; o.split = 2048;
        } else {
          int t2 = t - 1024, bg = t2 >> 1, nt = t2 & 1, b = bg >> 2, g = bg & 3;
          o.B = PF + ((long)T_LAT + b * 256 + nt * 128) * 512 + g * 128;
          o.C = WF + 16L * 512 * 4096 + ((long)b * 512 + g * 128) * 512 + nt * 128; o.ldc = 512; o.split = 256;
        }
      };
      {
        const int NT7 = (li == 3 ? 1024 : 1152);
        Stg r0, r1;
        bool pre = false;
        TD dn = d;
        int t = mybid();
        if (t < NT7) dec(t, d);
        for (; t < NT7; t += G) {
          const bool hn = t + G < NT7;
          if (hn) dec(t + G, dn);
          run_tile2(p, d, smem, r0, r1, pre, hn ? dn.A : nullptr, dn.lda, dn.B, dn.ldb);
          pre = hn;
          d = dn;
        }
      }
#endif
    } break;
    case 8: {
      const u16* WF = AR + 3 * (U38 / 2);
      u16* YF = Yb + 2 * (U38 / 2);
      d.scale = 1.f / 512.f;
      for (int t = mybid(); t < (li == 3 ? 512 : 576); t += G) {
        if (t < 512) {
          int b = t >> 5, r = t & 31, mt = r >> 2, nt = r & 3;
          d.A = (const u16*)(p.ws + OFF_DL) + (long)mt * 256 * 4096; d.lda = 4096;
          d.B = WF + ((long)b * 512 + nt * 128) * 4096; d.ldb = 4096; d.K = 4096;
          d.C = YF + ((long)b * 2048 + mt * 256) * 512 + nt * 128; d.ldc = 512;
        } else {
          int t2 = t - 512, b = t2 >> 2, nt = t2 & 3;
          d.A = (const u16*)(p.ws + OFF_DLC); d.lda = 512;
          d.B = WF + 16L * 512 * 4096 + ((long)b * 512 + nt * 128) * 512; d.ldb = 512; d.K = 512;
          d.C = YF + ((long)T_LAT + b * 256) * 512 + nt * 128; d.ldc = 512;
        }
        run_tile(p, d, smem);
      }
      ph_ytrans(p, 576, li == 3, smem);
    } break;
    case 9: ph_merge(p, smem, li == 3); break;
    case 10: {
      d.mode = 2;
      const int NT10 = (li == 3 ? 1024 : 1152);
      Stg r0, r1;
      bool pre = false;
      for (int t = mybid(); t < NT10; t += G) {
        int mt = t >> 3, nt = t & 7;
        d.A = AR + (long)mt * 256 * 1024; d.lda = 1024; d.B = WB + WO_O + (long)nt * 128 * 1024; d.ldb = 1024; d.K = 1024;
        d.tok0 = mt * 256; d.col0 = nt * 128;
        int bb = d.tok0 < T_LAT ? (d.tok0 >> 11) : 16;
        d.g = MOD + ((long)li * 17 + bb) * 6144 + 2 * 1024;
        const bool hn = t + G < NT10;
        int mt2 = (t + G) >> 3, nt2 = (t + G) & 7;
        run_tile2(p, d, smem, r0, r1, pre, hn ? AR + (long)mt2 * 256 * 1024 : nullptr, 1024,
                  WB + WO_O + (long)nt2 * 128 * 1024, 1024);
        pre = hn;
      }
    } break;
    case 11: ph_norm(p, li, 1); break;
    case 12: {
      d.mode = 1;
      const int NT12 = (li == 3 ? 4096 : 4608);
      Stg r0, r1;
      bool pre = false;
      for (int t = mybid(); t < NT12; t += G) {
        int mt = t >> 5, nt = t & 31;
        d.A = HB + (long)mt * 256 * 1024; d.lda = 1024; d.B = WB + WO_1 + (long)nt * 128 * 1024; d.ldb = 1024; d.K = 1024;
        d.C = Yb + (long)mt * 256 * 4096 + nt * 128; d.ldc = 4096;
        const bool hn = t + G < NT12;
        int mt2 = (t + G) >> 5, nt2 = (t + G) & 31;
        run_tile2(p, d, smem, r0, r1, pre, hn ? HB + (long)mt2 * 256 * 1024 : nullptr, 1024,
                  WB + WO_1 + (long)nt2 * 128 * 1024, 1024);
        pre = hn;
      }
    } break;
    case 13: {
      d.mode = 2;
      for (int t = mybid(); t < (li == 3 ? 1024 : 1152); t += G) {
        int mt = t >> 3, nt = t & 7;
        d.A = Yb + (long)mt * 256 * 4096; d.lda = 4096; d.B = WB + WO_2 + (long)nt * 128 * 4096; d.ldb = 4096; d.K = 4096;
        d.tok0 = mt * 256; d.col0 = nt * 128;
        int bb = d.tok0 < T_LAT ? (d.tok0 >> 11) : 16;
        d.g = MOD + ((long)li * 17 + bb) * 6144 + 5 * 1024;
        run_tile(p, d, smem);
      }
    } break;
  }
}

extern __shared__ __attribute__((aligned(16))) char dyn_smem[];

__global__ void __launch_bounds__(512) mega(Prm p, int lo, int hi) {
#ifdef ONLYK
  run_phase(p, ONLYK, dyn_smem);
#else
  for (int ph = lo; ph <= hi; ++ph) {
    long z = 0;
    asm volatile("" : "+s"(z));
    Prm q;
#define LP(f) q.f = p.f + z
    LP(x); LP(c); LP(ctx); LP(c_ctx); LP(w_ada); LP(b_ada); LP(norm1); LP(norm2); LP(w_in); LP(qk_gain); LP(lam);
    LP(subln); LP(hy_conv); LP(hy_w1); LP(hy_b1); LP(hy_freq); LP(hy_w2); LP(hy_b2); LP(hy_w3); LP(hy_bias);
    LP(dn_conv); LP(dn_a_log); LP(dn_dt_bias); LP(dn_norm); LP(w_gate); LP(w_branch); LP(w_o); LP(w_mlp1); LP(w_mlp2);
    LP(out); LP(ws);
#undef LP
    run_phase(q, ph, dyn_smem);
#ifdef PROBEK
    if (ph > 0 && (ph - 1) % 14 == PROBEK) { cg::this_grid().sync(); run_phase(q, ph, dyn_smem); }
#endif
    if (ph < hi) cg::this_grid().sync();
  }
#endif
}

extern "C" void kernel_launch(void* const* d_in, const int* in_sizes, int n_in, void* d_out, int out_size, void* d_ws,
                              size_t ws_size, hipStream_t stream) {
  static int grid_blocks = 0;
  if (!grid_blocks) {
    hipFuncSetAttribute((const void*)mega, hipFuncAttributeMaxDynamicSharedMemorySize, LDS_BYTES);
    int dev = 0, cus = 0, per_cu = 0;
    hipGetDevice(&dev);
    hipDeviceGetAttribute(&cus, hipDeviceAttributeMultiprocessorCount, dev);
    hipOccupancyMaxActiveBlocksPerMultiprocessor(&per_cu, mega, 512, LDS_BYTES);
    if (per_cu < 1) per_cu = 1;
    grid_blocks = cus * per_cu;
    if (ws_size < (size_t)WS_TOTAL) fprintf(stderr, "workspace too small: %zu < %ld\n", ws_size, (long)WS_TOTAL);
  }
  Prm p;
  const float** pp = (const float**)&p;
  for (int i = 0; i < 29; ++i) pp[i] = (const float*)d_in[i];
  p.out = (float*)d_out;
  p.ws = (char*)d_ws;
#if MULTI
  for (int ph = 0; ph < NPHASE; ++ph) hipLaunchKernelGGL(mega, dim3(grid_blocks), dim3(512), LDS_BYTES, stream, p, ph, ph);
#else
  int lo = 0, hi = NPHASE - 1;
  void* args[] = {&p, &lo, &hi};
  hipError_t e = hipLaunchCooperativeKernel((void*)mega, dim3(grid_blocks), dim3(512), args, LDS_BYTES, stream);
  if (e != hipSuccess) fprintf(stderr, "cooperative launch failed: %s (grid %d)\n", hipGetErrorString(e), grid_blocks);
#endif
}
```

```cpp
#include <hip/hip_runtime.h>
#include <hip/hip_cooperative_groups.h>
#include <stdint.h>
#include <stdio.h>
namespace cg = cooperative_groups;

typedef unsigned short u16;
typedef __attribute__((ext_vector_type(8))) short bf16x8;
typedef __attribute__((ext_vector_type(4))) float f32x4;
#define MFMA(a, b, c) __builtin_amdgcn_mfma_f32_16x16x32_bf16(a, b, c, 0, 0, 0)
#define DI __device__ __forceinline__

#ifndef MULTI
#define MULTI 0
#endif

constexpr int T_LAT = 32768, T_ALL = 36864;
constexpr int NIN = 5648;
constexpr long U38 = 37748736L;
constexpr long OFF_XC = 0;
constexpr long OFF_WB = OFF_XC + 16777216L;
constexpr long OFF_HBF = OFF_WB + 43024384L;
constexpr long OFF_MOD = OFF_HBF + 75497472L;
constexpr long OFF_TAPL = OFF_MOD + 1671168L;
constexpr long OFF_TAPC = OFF_TAPL + 8388608L;
constexpr long OFF_DL = OFF_TAPC + 1048576L;
constexpr long OFF_DLC = OFF_DL + 16777216L;
constexpr long OFF_DC = OFF_DLC + 262144L;
constexpr long OFF_PDAB = OFF_DC + 65536L;
constexpr long OFF_GC = OFF_PDAB + 2359296L;
constexpr long OFF_BETA = OFF_GC + 2359296L;
constexpr long OFF_Y = OFF_BETA + 2359296L;
constexpr long OFF_AR = OFF_Y + 4 * U38;
constexpr long OFF_ROPE = OFF_AR + 7 * U38;
constexpr long WS_TOTAL = OFF_ROPE + 2 * 262144L;
constexpr long WO_IN = 0, WO_G = 5783552L, WO_B = 9977856L, WO_O = 12075008L, WO_1 = 13123584L, WO_2 = 17317888L;
constexpr int LDS_BYTES = 139264;
constexpr int NPHASE = 1 + 4 * 14;

struct Prm {
  const float *x, *c, *ctx, *c_ctx, *w_ada, *b_ada, *norm1, *norm2, *w_in, *qk_gain, *lam, *subln, *hy_conv, *hy_w1,
      *hy_b1, *hy_freq, *hy_w2, *hy_b2, *hy_w3, *hy_bias, *dn_conv, *dn_a_log, *dn_dt_bias, *dn_norm, *w_gate,
      *w_branch, *w_o, *w_mlp1, *w_mlp2;
  float* out;
  char* ws;
};

DI int mytid() {
  int t = threadIdx.x;
  asm volatile("" : "+v"(t));
  return t;
}
DI int mybid() {
  int t = blockIdx.x;
  asm volatile("" : "+s"(t));
  return t;
}
DI void lds_barrier() {
  asm volatile("s_waitcnt lgkmcnt(0)" ::: "memory");
  __builtin_amdgcn_s_barrier();
  asm volatile("" ::: "memory");
}
typedef __bf16 bf16x2_t __attribute__((ext_vector_type(2)));
typedef float f32x2_t __attribute__((ext_vector_type(2)));
DI unsigned pk_bf16(float a, float b) {
  f32x2_t v = {a, b};
  bf16x2_t h = __builtin_convertvector(v, bf16x2_t);
  return *(unsigned*)&h;
}
DI u16 f2bf(float f) {
  __bf16 h = (__bf16)f;
  return *(u16*)&h;
}
DI float bf2f(u16 h) { return __uint_as_float(((unsigned)h) << 16); }
DI float wsum(float v) {
  for (int o = 32; o; o >>= 1) v += __shfl_xor(v, o);
  return v;
}
DI float wmax(float v) {
  for (int o = 32; o; o >>= 1) v = fmaxf(v, __shfl_xor(v, o));
  return v;
}
DI float siluf(float v) { return v / (1.f + __expf(-v)); }
DI float sigmf(float v) { return 1.f / (1.f + __expf(-v)); }
DI float* xrow(const Prm& p, int tok) {
  return tok < T_LAT ? p.out + (long)tok * 1024 : (float*)(p.ws + OFF_XC) + (long)(tok - T_LAT) * 1024;
}
DI int first_item(long base) {
  int G = gridDim.x;
  return (int)(((long)mybid() + G - (base % G)) % G);
}
DI int tokof(int b, int P) { return P < 256 ? T_LAT + b * 256 + P : b * 2048 + (P - 256); }

typedef __attribute__((ext_vector_type(4))) unsigned u32x4;
struct Stg { u32x4 a0, a1, a2, a3, b0, b1; };
template <int NA>
DI void g_load(Stg& r, const u16* Ap, long lda, const u16* Bp, long ldb, int k0) {
  r.a0 = *(const u32x4*)(Ap + k0);
  r.a1 = *(const u32x4*)(Ap + 64 * lda + k0);
  if constexpr (NA == 4) {
    r.a2 = *(const u32x4*)(Ap + 128 * lda + k0);
    r.a3 = *(const u32x4*)(Ap + 192 * lda + k0);
  }
  r.b0 = *(const u32x4*)(Bp + k0);
  r.b1 = *(const u32x4*)(Bp + 64 * ldb + k0);
}
template <int NA, int TM>
DI void s_store(const Stg& r, u16* ns_) {
  *(u32x4*)(ns_) = r.a0;
  *(u32x4*)(ns_ + 64 * 80) = r.a1;
  if constexpr (NA == 4) {
    *(u32x4*)(ns_ + 128 * 80) = r.a2;
    *(u32x4*)(ns_ + 192 * 80) = r.a3;
  }
  *(u32x4*)(ns_ + TM * 80) = r.b0;
  *(u32x4*)(ns_ + TM * 80 + 64 * 80) = r.b1;
}
template <int MI>
DI void t_compute(f32x4 (&acc)[MI][4], const u16* as, const u16* bs, int wm, int wn, int fr, int fq) {
#pragma unroll
  for (int ks = 0; ks < 2; ++ks) {
    bf16x8 a[MI], b[4];
#pragma unroll
    for (int mi = 0; mi < MI; ++mi) a[mi] = *(const bf16x8*)(as + (wm * MI * 16 + mi * 16 + fr) * 80 + ks * 32 + fq * 8);
#pragma unroll
    for (int ni = 0; ni < 4; ++ni) b[ni] = *(const bf16x8*)(bs + (wn * 64 + ni * 16 + fr) * 80 + ks * 32 + fq * 8);
#pragma unroll
    for (int mi = 0; mi < MI; ++mi)
#pragma unroll
      for (int ni = 0; ni < 4; ++ni) acc[mi][ni] = MFMA(b[ni], a[mi], acc[mi][ni]);
  }
}
template <int MI>
DI void gemm_tile(f32x4 (&acc)[MI][4], const u16* __restrict__ A, long lda, const u16* __restrict__ B, long ldb, int K,
                  char* smem, Stg& r0, Stg& r1, bool pre, const u16* nA, long nlda, const u16* nB, long nldb) {
  constexpr int TM = MI * 64;
  constexpr int STAGE = (TM + 128) * 80;
  constexpr int NA = TM * 8 / 512;
  u16* s = (u16*)smem;
  const int tid = mytid(), lane = tid & 63, wid = tid >> 6;
  const int wm = wid >> 1, wn = wid & 1, fr = lane & 15, fq = lane >> 4;
  const long to_a = (long)(tid >> 3), to_c = (tid & 7) * 8;
  const u16* Ap = A + to_a * lda + to_c;
  const u16* Bp = B + to_a * ldb + to_c;
  const u16* nAp = nA + to_a * nlda + to_c;
  const u16* nBp = nB + to_a * nldb + to_c;
  const int so = (tid >> 3) * 80 + (tid & 7) * 8;
#define GLOAD(r, k0) g_load<NA>(r, Ap, lda, Bp, ldb, (k0))
#define NLOAD(r, k0) g_load<NA>(r, nAp, nlda, nBp, nldb, (k0))
#define SSTORE(r, st) s_store<NA, TM>(r, s + (st) * STAGE + so)
#define COMPUTE(st) t_compute<MI>(acc, s + (st) * STAGE, s + (st) * STAGE + TM * 80, wm, wn, fr, fq)
#pragma unroll
  for (int mi = 0; mi < MI; ++mi)
#pragma unroll
    for (int ni = 0; ni < 4; ++ni) acc[mi][ni] = f32x4{0.f, 0.f, 0.f, 0.f};
  const int nk = K >> 6;
  if (!pre) {
    GLOAD(r0, 0);
    GLOAD(r1, 64);
  }
  SSTORE(r0, 0);
  lds_barrier();
  for (int kt = 0; kt < nk; kt += 2) {
    if (kt + 2 < nk) GLOAD(r0, (kt + 2) << 6);
    else if (nA) NLOAD(r0, 0);
    COMPUTE(0);
    SSTORE(r1, 1);
    lds_barrier();
    if (kt + 3 < nk) GLOAD(r1, (kt + 3) << 6);
    else if (nA) NLOAD(r1, 64);
    COMPUTE(1);
    if (kt + 2 < nk) SSTORE(r0, 0);
    lds_barrier();
  }
#undef GLOAD
#undef NLOAD
#undef SSTORE
#undef COMPUTE
}

struct TD {
  const u16* A;
  const u16* B;
  u16* C;
  long lda, ldb, ldc;
  int K;
  int mode;
  int split;
  float scale;
  int tok0, col0;
  const float* g;
};

DI void run_tile2(const Prm& p, const TD& d, char* smem, Stg& r0, Stg& r1, bool pre, const u16* nA, long nlda,
                 const u16* nB, long nldb);
DI void run_tile(const Prm& p, const TD& d, char* smem) {
  Stg r0, r1;
  run_tile2(p, d, smem, r0, r1, false, nullptr, 0, nullptr, 0);
}
DI void run_tile2(const Prm& p, const TD& d, char* smem, Stg& r0, Stg& r1, bool pre, const u16* nA, long nlda,
                 const u16* nB, long nldb) {
  f32x4 acc[4][4];
  gemm_tile<4>(acc, d.A, d.lda, d.B, d.ldb, d.K, smem, r0, r1, pre, nA, nlda, nB, nldb);
  const int tid = mytid(), lane = tid & 63, wid = tid >> 6;
  const int wm = wid >> 1, wn = wid & 1, fr = lane & 15, fq = lane >> 4;
  if (d.mode == 4) {
    const int which = d.col0 >> 2, h = d.col0 & 3;
    const float* gain = d.g + which * 64 + fq * 4;
    const float* RC = (const float*)(p.ws + OFF_ROPE);
    const float* RS = RC + 65536;
    u16* dstb = d.C + (which ? 18874368L : 0L);
    const float qs = which ? 1.f : 0.18033688011112042f;
#pragma unroll
    for (int mi = 0; mi < 4; ++mi) {
      const int tok = d.tok0 + wm * 64 + mi * 16 + fr;
      float ss = 0.f;
#pragma unroll
      for (int ni = 0; ni < 4; ++ni)
#pragma unroll
        for (int j = 0; j < 4; ++j) ss += acc[mi][ni][j] * acc[mi][ni][j];
      ss += __shfl_xor(ss, 16);
      ss += __shfl_xor(ss, 32);
      const float inv = rsqrtf(ss * (1.f / 64.f) + 1e-6f) * qs;
      int b, P;
      const bool lat = tok < T_LAT;
      if (lat) { b = tok >> 11; P = 256 + (tok & 2047); }
      else { b = (tok - T_LAT) >> 8; P = (tok - T_LAT) & 255; }
      float y[4][4];
#pragma unroll
      for (int ni = 0; ni < 4; ++ni) {
        float4 g4 = *(const float4*)(gain + ni * 16);
        y[ni][0] = acc[mi][ni][0] * inv * g4.x; y[ni][1] = acc[mi][ni][1] * inv * g4.y;
        y[ni][2] = acc[mi][ni][2] * inv * g4.z; y[ni][3] = acc[mi][ni][3] * inv * g4.w;
      }
      u16* dst = dstb + ((long)((b * 4 + h) * 2 + wn) * 2304 + P) * 64 + fq * 4;
#pragma unroll
      for (int ni = 0; ni < 4; ++ni) {
        float o0 = y[ni][0], o1 = y[ni][1], o2 = y[ni][2], o3 = y[ni][3];
        if (lat) {
          const int l = tok & 2047, a = ni >> 1;
          float4 c4 = *(const float4*)(RC + (l * 2 + a) * 16 + fq * 4);
          float4 s4 = *(const float4*)(RS + (l * 2 + a) * 16 + fq * 4);
          const float sg = (ni & 1) ? 1.f : -1.f;
          o0 = y[ni][0] * c4.x + sg * y[ni ^ 1][0] * s4.x;
          o1 = y[ni][1] * c4.y + sg * y[ni ^ 1][1] * s4.y;
          o2 = y[ni][2] * c4.z + sg * y[ni ^ 1][2] * s4.z;
          o3 = y[ni][3] * c4.w + sg * y[ni ^ 1][3] * s4.w;
        }
        uint2 o;
        o.x = pk_bf16(o0, o1);
        o.y = pk_bf16(o2, o3);
        *(uint2*)(dst + ni * 16) = o;
      }
    }
    return;
  }
#pragma unroll
  for (int mi = 0; mi < 4; ++mi)
#pragma unroll
    for (int ni = 0; ni < 4; ++ni) {
      int r = wm * 64 + mi * 16 + fr, c = wn * 64 + ni * 16 + fq * 4;
      f32x4 v = acc[mi][ni];
      if (d.mode == 0) {
        long ro = d.split ? ((long)(r & 127) * d.ldc + (long)(r >> 7) * d.split) : (long)r * d.ldc;
        ushort4 o;
        o.x = f2bf(v[0] * d.scale); o.y = f2bf(v[1] * d.scale); o.z = f2bf(v[2] * d.scale); o.w = f2bf(v[3] * d.scale);
        *(ushort4*)(d.C + ro + c) = o;
      } else if (d.mode == 1) {
        ushort4 o;
        float t0 = fmaxf(v[0], 0.f), t1 = fmaxf(v[1], 0.f), t2 = fmaxf(v[2], 0.f), t3 = fmaxf(v[3], 0.f);
        o.x = f2bf(t0 * t0); o.y = f2bf(t1 * t1); o.z = f2bf(t2 * t2); o.w = f2bf(t3 * t3);
        *(ushort4*)(d.C + (long)r * d.ldc + c) = o;
      } else if (d.mode == 3) {
        if (wn == 0 && ni == 0) *(float4*)((float*)d.C + (long)r * 16 + fq * 4) = float4{v[0], v[1], v[2], v[3]};
      } else {
        float4* xp = (float4*)(xrow(p, d.tok0 + r) + d.col0 + c);
        float4 g4 = *(const float4*)(d.g + d.col0 + c);
        float4 x4 = *xp;
        x4.x += g4.x * v[0]; x4.y += g4.y * v[1]; x4.z += g4.z * v[2]; x4.w += g4.w * v[3];
        *xp = x4;
      }
    }
}

DI void ph_init(const Prm& p, char* smem) {
  const long gt = (long)mybid() * 512 + mytid(), gn = (long)gridDim.x * 512;
  {
    const float4* s = (const float4*)p.x;
    float4* d = (float4*)p.out;
    for (long i = gt; i < 32768L * 256; i += gn) d[i] = s[i];
    const float4* s2 = (const float4*)p.ctx;
    float4* d2 = (float4*)(p.ws + OFF_XC);
    for (long i = gt; i < 4096L * 256; i += gn) d2[i] = s2[i];
  }
  {
    u16* DL = (u16*)(p.ws + OFF_DL);
    for (long i = gt; i < 2048L * 4096; i += gn) {
      int l = (int)(i >> 12), kk = (int)(i & 4095), lp = kk & 2047, part = kk >> 11;
      int m = (l * lp) & 2047;
      float ang = (float)m * (6.283185307179586f / 2048.f);
      DL[i] = f2bf(part ? -sinf(ang) : cosf(ang));
    }
    u16* DLC = (u16*)(p.ws + OFF_DLC);
    for (long i = gt; i < 256L * 512; i += gn) {
      int l = (int)(i >> 9), kk = (int)(i & 511), lp = kk & 255, part = kk >> 8;
      int m = (l * lp) & 255;
      float ang = (float)m * (6.283185307179586f / 256.f);
      DLC[i] = f2bf(part ? -sinf(ang) : cosf(ang));
    }
    {
      float* RC = (float*)(p.ws + OFF_ROPE);
      float* RS = RC + 65536;
      for (long i = gt; i < 65536; i += gn) {
        int l = (int)(i >> 5), a = (int)(i >> 4) & 1, f = (int)(i & 15);
        float pos = a ? (float)(l & 63) : (float)(l >> 6);
        float ang = pos * powf(10000.f, -(float)f / 16.f);
        RC[i] = cosf(ang);
        RS[i] = sinf(ang);
      }
    }
    u16* DC = (u16*)(p.ws + OFF_DC);
    for (long i = gt; i < 256L * 128; i += gn) {
      int j2 = (int)(i >> 7), ii = (int)(i & 127), part = j2 >> 7, j = j2 & 127;
      int m = (ii * j) & 127;
      float ang = (float)m * (6.283185307179586f / 128.f);
      DC[i] = f2bf(part ? sinf(ang) : cosf(ang));
    }
  }
  float* sc = (float*)smem;
  float* red = sc + 17 * 1024;
  const int tid = mytid();
  for (int e = tid; e < 17 * 1024; e += 512) {
    int bb = e >> 10, k = e & 1023;
    float v = bb < 16 ? p.c[bb * 1024 + k] : p.c_ctx[k];
    sc[e] = v / (1.f + expf(-v));
  }
  __syncthreads();
  float* MOD = (float*)(p.ws + OFF_MOD);
  for (int it = mybid(); it < 192; it += gridDim.x) {
    int li = it / 48, cgp = it % 48;
    int cl = tid & 127, kq = tid >> 7, n = cgp * 128 + cl;
    float a[17];
#pragma unroll
    for (int b = 0; b < 17; ++b) a[b] = 0.f;
    const float* w = p.w_ada + ((long)li * 1024 + kq * 256) * 6144 + n;
#pragma unroll 2
    for (int k = 0; k < 256; ++k) {
      float wv = w[(long)k * 6144];
#pragma unroll
      for (int b = 0; b < 17; ++b) a[b] += sc[b * 1024 + kq * 256 + k] * wv;
    }
#pragma unroll
    for (int b = 0; b < 17; ++b) red[(kq * 17 + b) * 128 + cl] = a[b];
    __syncthreads();
    for (int e = tid; e < 17 * 128; e += 512) {
      int b = e >> 7, c2 = e & 127, n2 = cgp * 128 + c2;
      float v = p.b_ada[li * 6144 + n2];
      for (int q = 0; q < 4; ++q) v += red[(q * 17 + b) * 128 + c2];
      MOD[((long)li * 17 + b) * 6144 + n2] = v;
    }
    __syncthreads();
  }
}

DI long tr_job(long base, const float* src, int K, int N, u16* dst, int nb, char* smem) {
  float* t = (float*)smem;
  const int tk = K >> 6, tn = (N + 63) >> 6, per = tk * tn, total = per * nb;
  const int tid = mytid();
  const int G = gridDim.x;
  float v[8];
  int it = first_item(base);
  if (it < total) {
    int b = it / per, r = it % per, kt = r / tn, nt = r % tn;
    const float* s = src + (long)b * K * N;
#pragma unroll
    for (int i = 0; i < 8; ++i) {
      int id = tid + i * 512, kk = id >> 6, nn = id & 63;
      v[i] = (nt * 64 + nn < N) ? s[(long)(kt * 64 + kk) * N + nt * 64 + nn] : 0.f;
    }
  }
  for (; it < total; it += G) {
    int b = it / per, r = it % per, kt = r / tn, nt = r % tn;
    u16* d = dst + (long)b * K * N;
    int k0 = kt * 64, n0 = nt * 64;
#pragma unroll
    for (int i = 0; i < 8; ++i) {
      int id = tid + i * 512, kk = id >> 6, nn = id & 63;
      t[kk * 65 + nn] = v[i];
    }
    __syncthreads();
    if (it + G < total) {
      int it2 = it + G, b2 = it2 / per, r2 = it2 % per, kt2 = r2 / tn, nt2 = r2 % tn;
      const float* s2 = src + (long)b2 * K * N;
#pragma unroll
      for (int i = 0; i < 8; ++i) {
        int id = tid + i * 512, kk = id >> 6, nn = id & 63;
        v[i] = (nt2 * 64 + nn < N) ? s2[(long)(kt2 * 64 + kk) * N + nt2 * 64 + nn] : 0.f;
      }
    }
#pragma unroll
    for (int i = 0; i < 8; ++i) {
      int id = tid + i * 512, nn = id >> 6, kk = id & 63;
      if (n0 + nn < N) d[(long)(n0 + nn) * K + k0 + kk] = f2bf(t[kk * 65 + nn]);
    }
    __syncthreads();
  }
  return base + total;
}

DI void ph_norm(const Prm& p, int li, int which) {
  const int lane = mytid() & 63;
  const int gw = mybid() * 8 + (mytid() >> 6), nw = gridDim.x * 8;
  const float* nwt = (which ? p.norm2 : p.norm1) + li * 1024;
  const float* MOD = (const float*)(p.ws + OFF_MOD);
  u16* H = (u16*)(p.ws + OFF_HBF);
  const int nrows = (which && li == 3) ? T_LAT : T_ALL;
  for (int row = gw; row < nrows; row += 2 * nw) {
    const int row2 = row + nw;
    const bool has2 = row2 < nrows;
    const float* xr = xrow(p, row);
    const float* xr2 = xrow(p, has2 ? row2 : row);
    float4 v[4], u[4];
    float ss = 0.f, ss2 = 0.f;
#pragma unroll
    for (int i = 0; i < 4; ++i) {
      v[i] = *(const float4*)(xr + i * 256 + lane * 4);
      u[i] = *(const float4*)(xr2 + i * 256 + lane * 4);
    }
#pragma unroll
    for (int i = 0; i < 4; ++i) {
      ss += v[i].x * v[i].x + v[i].y * v[i].y + v[i].z * v[i].z + v[i].w * v[i].w;
      ss2 += u[i].x * u[i].x + u[i].y * u[i].y + u[i].z * u[i].z + u[i].w * u[i].w;
    }
#pragma unroll
    for (int o = 32; o; o >>= 1) {
      ss += __shfl_xor(ss, o);
      ss2 += __shfl_xor(ss2, o);
    }
    const float inv = rsqrtf(ss * (1.f / 1024.f) + 1e-6f), inv2 = rsqrtf(ss2 * (1.f / 1024.f) + 1e-6f);
    const int bb = row < T_LAT ? (row >> 11) : 16, bb2 = row2 < T_LAT ? (row2 >> 11) : 16;
    const float* sh = MOD + ((long)li * 17 + bb) * 6144 + (which ? 3 : 0) * 1024;
    const float* sh2 = MOD + ((long)li * 17 + (has2 ? bb2 : bb)) * 6144 + (which ? 3 : 0) * 1024;
#pragma unroll
    for (int i = 0; i < 4; ++i) {
      int c = i * 256 + lane * 4;
      float4 w4 = *(const float4*)(nwt + c);
      {
        float4 s4 = *(const float4*)(sh + 1024 + c), h4 = *(const float4*)(sh + c);
        uint2 o;
        o.x = pk_bf16(v[i].x * inv * w4.x * (1.f + s4.x) + h4.x, v[i].y * inv * w4.y * (1.f + s4.y) + h4.y);
        o.y = pk_bf16(v[i].z * inv * w4.z * (1.f + s4.z) + h4.z, v[i].w * inv * w4.w * (1.f + s4.w) + h4.w);
        *(uint2*)(H + (long)row * 1024 + c) = o;
      }
      if (has2) {
        float4 s4 = *(const float4*)(sh2 + 1024 + c), h4 = *(const float4*)(sh2 + c);
        uint2 o;
        o.x = pk_bf16(u[i].x * inv2 * w4.x * (1.f + s4.x) + h4.x, u[i].y * inv2 * w4.y * (1.f + s4.y) + h4.y);
        o.y = pk_bf16(u[i].z * inv2 * w4.z * (1.f + s4.z) + h4.z, u[i].w * inv2 * w4.w * (1.f + s4.w) + h4.w);
        *(uint2*)(H + (long)row2 * 1024 + c) = o;
      }
    }
  }
}

DI void ph_taps1(const Prm& p, int li, long base, char* smem) {
  float* f = (float*)smem;
  float* hraw = (float*)(p.ws + OFF_AR + 5 * U38);
  const int tid = mytid();
  for (int it = first_item(base); it < 288; it += gridDim.x) {
    const int L = it < 256 ? 2048 : 256, j0 = it < 256 ? it * 8 : (it - 256) * 8;
    const int lg = tid >> 6, kk = tid & 63;
    if (tid < 8 * 33) {
      int l2 = tid / 33, e = tid % 33, j = j0 + l2;
      float t = (float)j / (float)(L - 1);
      float w = 6.283185307179586f * (float)j / (float)L;
      float v;
      if (e == 0) v = t;
      else {
        int bi = (e - 1) & 15;
        float band = 1e-4f + (float)bi * ((15.f - 1e-4f) / 15.f);
        v = (e <= 16) ? cosf(band * w) : -sinf(band * w);
      }
      f[l2 * 40 + e] = v;
    }
    __syncthreads();
    {
      float v = p.hy_b1[li * 64 + kk];
#pragma unroll 3
      for (int e = 0; e < 33; ++e) v += f[lg * 40 + e] * p.hy_w1[(li * 33 + e) * 64 + kk];
      f[320 + lg * 64 + kk] = sinf(p.hy_freq[(li * 2 + 0) * 64 + kk] * v);
    }
    __syncthreads();
    {
      float v = p.hy_b2[li * 64 + kk];
#pragma unroll 4
      for (int m = 0; m < 64; ++m) v += f[320 + lg * 64 + m] * p.hy_w2[(li * 64 + m) * 64 + kk];
      f[832 + lg * 64 + kk] = sinf(p.hy_freq[(li * 2 + 1) * 64 + kk] * v);
    }
    __syncthreads();
    {
      float h[4][8];
#pragma unroll
      for (int i = 0; i < 4; ++i)
#pragma unroll
        for (int l2 = 0; l2 < 8; ++l2) h[i][l2] = 0.f;
      const float* w3 = p.hy_w3 + (long)li * 64 * 2048 + tid;
#pragma unroll 2
      for (int k = 0; k < 64; ++k) {
        float wv[4];
#pragma unroll
        for (int i = 0; i < 4; ++i) wv[i] = w3[(long)k * 2048 + i * 512];
#pragma unroll
        for (int l2 = 0; l2 < 8; ++l2) {
          float hv = f[832 + l2 * 64 + k];
#pragma unroll
          for (int i = 0; i < 4; ++i) h[i][l2] += hv * wv[i];
        }
      }
#pragma unroll
      for (int i = 0; i < 4; ++i) {
        int n = tid + i * 512, ch = n & 511;
        float delta = fabsf(-3.0701134573253946f + (float)ch * ((-15.350567286626973f + 3.0701134573253946f) / 511.f));
#pragma unroll
        for (int l2 = 0; l2 < 8; ++l2) {
          int j = j0 + l2;
          float t = (float)j / (float)(L - 1);
          long row = (it < 256) ? j : 2048 + j;
          hraw[row * 2048 + n] = h[i][l2] * expf(-t * delta);
        }
      }
    }
    __syncthreads();
  }
}
DI void ph_taps2(const Prm& p, long base, char* smem) {
  float* red = (float*)smem;
  const float* hraw = (const float*)(p.ws + OFF_AR + 5 * U38);
  const int tid = mytid(), cl = tid & 3, dir = (tid >> 2) & 1, jg = tid >> 3;
  for (int it = first_item(base); it < 512; it += gridDim.x) {
    int ls = it >> 8, order = (it >> 7) & 1, cgp = it & 127;
    int L = ls ? 256 : 2048;
    const float* hr = hraw + (long)(ls ? 2048 : 0) * 2048;
    u16* G = (u16*)(p.ws + (ls ? OFF_TAPC : OFF_TAPL));
    int ch = cgp * 4 + cl, n = order * 1024 + dir * 512 + ch;
    float s = 0.f;
#pragma unroll 8
    for (int j = jg; j < L; j += 64) {
      float v = fabsf(hr[(long)j * 2048 + n]);
      s += (dir == 1 && j == 0) ? 0.f : v;
    }
    red[(tid >> 2) * 4 + cl] = s;
    __syncthreads();
    float tot = 0.f;
#pragma unroll 8
    for (int q = 0; q < 128; ++q) tot += red[q * 4 + cl];
    float inv = 1.f / tot;
    u16* g = G + (long)(order * 512 + ch) * (2 * L);
#pragma unroll 8
    for (int j = jg; j < L; j += 64) {
      float v = hr[(long)j * 2048 + n] * inv;
      if (dir == 0) g[L + j] = f2bf(v);
      else if (j > 0) g[L - j] = f2bf(v);
    }
    if (dir == 1 && jg == 0) g[0] = 0;
    __syncthreads();
  }
}

DI void ph_pdab(const Prm& p, int li, char* smem) {
  float* wl = (float*)smem;
  const int tid = mytid(), lane = tid & 63;
#pragma unroll 8
  for (int e = tid; e < 1024 * 16; e += 512) wl[e] = p.w_in[((long)li * 1024 + (e >> 4)) * NIN + 5632 + (e & 15)];
  __syncthreads();
  const u16* H = (const u16*)(p.ws + OFF_HBF);
  float* out = (float*)(p.ws + OFF_PDAB);
  const int gw = mybid() * 8 + (tid >> 6), nw = gridDim.x * 8;
  for (int tok = gw; tok < T_ALL; tok += nw) {
    float a[16];
#pragma unroll
    for (int j = 0; j < 16; ++j) a[j] = 0.f;
    float hv[16];
#pragma unroll
    for (int i = 0; i < 16; ++i) hv[i] = bf2f(H[(long)tok * 1024 + lane + i * 64]);
#pragma unroll
    for (int i = 0; i < 16; ++i) {
      float h = hv[i];
      const float4* wp = (const float4*)(wl + (lane + i * 64) * 16);
#pragma unroll
      for (int q = 0; q < 4; ++q) {
        float4 w4 = wp[q];
        a[q * 4 + 0] += h * w4.x;
        a[q * 4 + 1] += h * w4.y;
        a[q * 4 + 2] += h * w4.z;
        a[q * 4 + 3] += h * w4.w;
      }
      if ((i & 3) == 3) asm volatile("" ::: "memory");
    }
#pragma unroll
    for (int o = 32; o; o >>= 1)
#pragma unroll
      for (int j = 0; j < 16; ++j) a[j] += __shfl_xor(a[j], o);
    float v = a[0];
#pragma unroll
    for (int j = 1; j < 16; ++j) v = (lane == j) ? a[j] : v;
    if (lane < 16) out[(long)tok * 16 + lane] = v;
  }
  __syncthreads();
}

DI void ph_dncl(const Prm& p, int li, char* smem) {
  const int tid = mytid(), lane = tid & 63, wid = tid >> 6, fr = lane & 15, fq = lane >> 4;
  u16* qn = (u16*)smem;
  u16* kn = qn + 64 * 144;
  float* fb = (float*)(smem + 36864);
  float* KK = fb;
  float* QK = KK + 64 * 65;
  float* Am = QK + 64 * 65;
  float* Tm = Am + 2 * 64 * 65;
  float* gcs = Tm + 2 * 64 * 65;
  float* bts = gcs + 128;
  const u16* PD = (const u16*)(p.ws + OFF_AR);
  const float* AB = (const float*)(p.ws + OFF_PDAB);
  u16* DQ = (u16*)(p.ws + OFF_Y);
  u16* DK = DQ + 18874368L;
  u16* DV = DK + 18874368L;
  u16* CL = (u16*)(p.ws + OFF_AR + 3 * U38);
  float* GC = (float*)(p.ws + OFF_GC);
  float* BT = (float*)(p.ws + OFF_BETA);
  const float* cw = p.dn_conv + (long)li * 3 * 1536;
  for (int it = mybid(); it < 2304; it += gridDim.x) {
    const int b = it / 144, r0 = it % 144, oc = r0 >> 2, h = r0 & 3;
    const int pos0 = oc * 64, s0 = oc < 4 ? 0 : 256, e0 = oc < 4 ? 256 : 2304;
    if (tid < 384) {
      const int cgp = tid % 48, rs = tid / 48;
      const int part = cgp >> 4, d0 = (cgp & 15) * 8, col = part * 512 + h * 128 + d0;
      const u16* basep = PD + (long)tokof(b, pos0) * 1536 + col;
      float wt[3][8];
#pragma unroll
      for (int tp = 0; tp < 3; ++tp) {
        float4 wa = *(const float4*)(cw + tp * 1536 + col), wb = *(const float4*)(cw + tp * 1536 + col + 4);
        wt[tp][0] = wa.x; wt[tp][1] = wa.y; wt[tp][2] = wa.z; wt[tp][3] = wa.w;
        wt[tp][4] = wb.x; wt[tp][5] = wb.y; wt[tp][6] = wb.z; wt[tp][7] = wb.w;
      }
#pragma unroll 1
      for (int hf = 0; hf < 2; ++hf) {
        u32x4 rw[6];
#pragma unroll
        for (int i = 0; i < 6; ++i) {
          int j = rs * 8 + hf * 4 - 1 + i, P = pos0 + j;
          rw[i] = (P >= s0 && P < e0) ? *(const u32x4*)(basep + (long)j * 1536) : u32x4{0u, 0u, 0u, 0u};
        }
#pragma unroll
        for (int r = 0; r < 4; ++r) {
#pragma unroll
          for (int e = 0; e < 8; ++e) {
            unsigned w0_ = rw[r][e >> 1], w1_ = rw[r + 1][e >> 1], w2_ = rw[r + 2][e >> 1];
            float x0 = (e & 1) ? __uint_as_float(w0_ & 0xffff0000u) : __uint_as_float(w0_ << 16);
            float x1 = (e & 1) ? __uint_as_float(w1_ & 0xffff0000u) : __uint_as_float(w1_ << 16);
            float x2 = (e & 1) ? __uint_as_float(w2_ & 0xffff0000u) : __uint_as_float(w2_ << 16);
            float v = wt[0][e] * x0 + wt[1][e] * x1 + wt[2][e] * x2;
            fb[(rs * 8 + hf * 4 + r) * 385 + part * 128 + d0 + e] = v / (1.f + __expf(-v));
          }
        }
      }
    }
    __syncthreads();
    for (int jj = 0; jj < 8; ++jj) {
      int j = wid * 8 + jj, P = pos0 + j;
      long go = ((long)(b * 4 + h) * 2304 + P) * 128;
      float q0 = fb[j * 385 + lane], q1 = fb[j * 385 + 64 + lane];
      float k0 = fb[j * 385 + 128 + lane], k1 = fb[j * 385 + 192 + lane];
      float v0 = fb[j * 385 + 256 + lane], v1 = fb[j * 385 + 320 + lane];
      float iq = rsqrtf(wsum(q0 * q0 + q1 * q1) + 1e-6f), ik = rsqrtf(wsum(k0 * k0 + k1 * k1) + 1e-6f);
      u16 a0 = f2bf(q0 * iq), a1 = f2bf(q1 * iq), c0 = f2bf(k0 * ik), c1 = f2bf(k1 * ik);
      qn[j * 144 + lane] = a0; qn[j * 144 + 64 + lane] = a1;
      kn[j * 144 + lane] = c0; kn[j * 144 + 64 + lane] = c1;
      DQ[go + lane] = a0; DQ[go + 64 + lane] = a1;
      DK[go + lane] = c0; DK[go + 64 + lane] = c1;
      DV[go + lane] = f2bf(v0); DV[go + 64 + lane] = f2bf(v1);
    }
    __syncthreads();
#pragma unroll
    for (int u = 0; u < 4; ++u) {
      int tt = wid * 4 + u, which = tt >> 4, ti = (tt >> 2) & 3, tj = tt & 3;
      const u16* Ap = (which ? qn : kn) + (ti * 16 + fr) * 144 + fq * 8;
      const u16* Bp = kn + (tj * 16 + fr) * 144 + fq * 8;
      f32x4 a = {0.f, 0.f, 0.f, 0.f};
#pragma unroll
      for (int ks = 0; ks < 4; ++ks) a = MFMA(*(const bf16x8*)(Ap + ks * 32), *(const bf16x8*)(Bp + ks * 32), a);
      float* dst = which ? QK : KK;
#pragma unroll
      for (int j = 0; j < 4; ++j) dst[(ti * 16 + fq * 4 + j) * 65 + tj * 16 + fr] = a[j];
    }
    if (tid < 128) {
      int d = tid >> 6, r = tid & 63, j = d ? 63 - r : r;
      int tok = tokof(b, pos0 + j);
      float av = AB[(long)tok * 16 + d * 4 + h], bv = AB[(long)tok * 16 + 8 + d * 4 + h];
      float xx = av + p.dn_dt_bias[li * 8 + d * 4 + h];
      float sp = fmaxf(xx, 0.f) + __logf(1.f + __expf(-fabsf(xx)));
      float g = -expf(p.dn_a_log[li * 8 + d * 4 + h]) * sp;
      for (int o = 1; o < 64; o <<= 1) {
        float t = __shfl_up(g, o);
        if (r >= o) g += t;
      }
      float be = 1.f / (1.f + expf(-bv));
      gcs[d * 64 + r] = g;
      bts[d * 64 + r] = be;
      long ci = ((long)((b * 4 + h) * 2 + d) * 36 + oc) * 64 + r;
      GC[ci] = g;
      BT[ci] = be;
    }
    __syncthreads();
#pragma unroll 4
    for (int e = tid; e < 8192; e += 512) {
      int d = e >> 12, s = (e >> 6) & 63, r = e & 63;
      int j = d ? 63 - r : r, js = d ? 63 - s : s;
      float v = 0.f;
      if (r > s) v = bts[d * 64 + r] * KK[j * 65 + js] * expf(gcs[d * 64 + r] - gcs[d * 64 + s]);
      Am[(d * 64 + s) * 64 + r] = v;
    }
#pragma unroll 4
    for (int e = tid; e < 8192; e += 512) {
      int d = e >> 12, r = (e >> 6) & 63, s = e & 63;
      int j = d ? 63 - r : r, js = d ? 63 - s : s;
      float dec = (r >= s) ? expf(gcs[d * 64 + r] - gcs[d * 64 + s]) : 0.f;
      long ci = (long)((b * 4 + h) * 2 + d) * 36 + oc;
      CL[ci * 8192 + 4096 + r * 64 + s] = f2bf(QK[j * 65 + js] * dec * 0.08838834764831845f);
    }
    __syncthreads();
    {
      const int d = tid >> 8, c = (tid >> 2) & 63, q = tid & 3;
      const float* Atq = Am + d * 64 * 64 + q;
      float* T = Tm + d * 64 * 65;
      float t[16];
#pragma unroll
      for (int i = 0; i < 16; ++i) t[i] = (4 * i + q == c) ? 1.f : 0.f;
#pragma unroll
      for (int s2 = 0; s2 < 63; ++s2) {
        constexpr int dummy = 0;
        const int is = s2 >> 2, qs = s2 & 3;
        const int ctl = qs | (qs << 2) | (qs << 4) | (qs << 6);
        int tsb;
        if (qs == 0) tsb = __builtin_amdgcn_update_dpp(0, __float_as_int(t[is]), 0x00, 0xf, 0xf, false);
        else if (qs == 1) tsb = __builtin_amdgcn_update_dpp(0, __float_as_int(t[is]), 0x55, 0xf, 0xf, false);
        else if (qs == 2) tsb = __builtin_amdgcn_update_dpp(0, __float_as_int(t[is]), 0xAA, 0xf, 0xf, false);
        else tsb = __builtin_amdgcn_update_dpp(0, __float_as_int(t[is]), 0xFF, 0xf, 0xf, false);
        (void)ctl; (void)dummy;
        const float ts = __int_as_float(tsb);
#pragma unroll
        for (int i = is; i < 16; ++i) t[i] -= Atq[s2 * 64 + 4 * i] * ts;
        if ((s2 & 7) == 7) asm volatile("" ::: "memory");
      }
#pragma unroll
      for (int i = 0; i < 16; ++i) T[(4 * i + q) * 65 + c] = t[i];
    }
    __syncthreads();
    for (int e = tid; e < 8192; e += 512) {
      int d = e >> 12, rc = e & 4095;
      long ci = (long)((b * 4 + h) * 2 + d) * 36 + oc;
      CL[ci * 8192 + rc] = f2bf(Tm[(d * 64 + (rc >> 6)) * 65 + (rc & 63)]);
    }
    __syncthreads();
  }
}

DI void ph_dnscan(const Prm& p, char* smem) {
  const int tid = mytid(), lane = tid & 63, wid = tid >> 6, fr = lane & 15, fq = lane >> 4;
  u16* Kg = (u16*)smem;
  u16* Qg = Kg + 64 * 144;
  u16* KdT = Qg + 64 * 144;
  u16* Tl = KdT + 128 * 80;
  u16* Il = Tl + 64 * 80;
  u16* ST = Il + 64 * 80;
  u16* RT = ST + 64 * 144;
  u16* VN = RT + 64 * 80;
  const u16* DQ = (const u16*)(p.ws + OFF_Y);
  const u16* DK = DQ + 18874368L;
  const u16* DV = DK + 18874368L;
  const u16* CL = (const u16*)(p.ws + OFF_AR + 3 * U38);
  const float* GC = (const float*)(p.ws + OFF_GC);
  const float* BT = (const float*)(p.ws + OFF_BETA);
  const int vt = wid & 3, rp = wid >> 2;
  for (int it = mybid(); it < 256; it += gridDim.x) {
    const int b = it >> 4, h = (it >> 2) & 3, d = (it >> 1) & 1, vs = it & 1;
    u16* O = (u16*)(p.ws + OFF_AR + (d ? 6 : 5) * U38);
    f32x4 S[4];
#pragma unroll
    for (int i = 0; i < 4; ++i) S[i] = f32x4{0.f, 0.f, 0.f, 0.f};
    for (int e = tid; e < 64 * 144; e += 512) ST[e] = 0;
    const long seqb = (long)(b * 4 + h) * 2304;
    const long cib = (long)((b * 4 + h) * 2 + d) * 36;
    u32x4 rk0, rk1, rq0, rq1, rT, rI;
    float rg0, rg1, rgl;
    uint2 rv0, rv1;
    float rb0, rb1;
    const int lr0 = tid >> 4, lr1 = (tid + 512) >> 4, lch = tid & 15;
    const int lj0 = d ? 63 - lr0 : lr0, lj1 = d ? 63 - lr1 : lr1;
    const int vr0 = (rp * 2) * 16 + fr, vr1 = (rp * 2 + 1) * 16 + fr;
    const int vj0 = d ? 63 - vr0 : vr0, vj1 = d ? 63 - vr1 : vr1;
#define SCAN_LOAD_KQ(ocx)                                                                    \
  {                                                                                          \
    const long ci_ = cib + (ocx);                                                            \
    const long g0_ = (seqb + (ocx) * 64 + lj0) * 128 + lch * 8, g1_ = (seqb + (ocx) * 64 + lj1) * 128 + lch * 8; \
    rk0 = *(const u32x4*)(DK + g0_); rk1 = *(const u32x4*)(DK + g1_);                        \
    rq0 = *(const u32x4*)(DQ + g0_); rq1 = *(const u32x4*)(DQ + g1_);                        \
    rT = *(const u32x4*)(CL + ci_ * 8192 + (tid >> 3) * 64 + (tid & 7) * 8);                 \
    rI = *(const u32x4*)(CL + ci_ * 8192 + 4096 + (tid >> 3) * 64 + (tid & 7) * 8);          \
    rg0 = GC[ci_ * 64 + lr0]; rg1 = GC[ci_ * 64 + lr1]; rgl = GC[ci_ * 64 + 63];             \
  }
#define SCAN_LOAD_V(ocx)                                                                     \
  {                                                                                          \
    const long ci_ = cib + (ocx);                                                            \
    rv0 = *(const uint2*)(DV + (seqb + (ocx) * 64 + vj0) * 128 + vs * 64 + vt * 16 + fq * 4); \
    rv1 = *(const uint2*)(DV + (seqb + (ocx) * 64 + vj1) * 128 + vs * 64 + vt * 16 + fq * 4); \
    rb0 = BT[ci_ * 64 + vr0]; rb1 = BT[ci_ * 64 + vr1];                                      \
  }
    {
      const int oc0 = d ? 3 : 0;
      SCAN_LOAD_KQ(oc0);
      SCAN_LOAD_V(oc0);
    }
    for (int i = 0; i < 36; ++i) {
      const int oc = d ? (i < 4 ? 3 - i : 39 - i) : i;
      const int ocn = d ? (i + 1 < 4 ? 3 - (i + 1) : 39 - (i + 1)) : i + 1;
      const int pos0 = oc * 64;
      const float gl = rgl;
      {
        float eg0 = __expf(rg0), ed0 = __expf(gl - rg0), eg1 = __expf(rg1), ed1 = __expf(gl - rg1);
        u32x4 ko0, qo0, ko1, qo1;
#pragma unroll
        for (int w = 0; w < 4; ++w) {
          float k0l = __uint_as_float(rk0[w] << 16), k0h = __uint_as_float(rk0[w] & 0xffff0000u);
          float q0l = __uint_as_float(rq0[w] << 16), q0h = __uint_as_float(rq0[w] & 0xffff0000u);
          float k1l = __uint_as_float(rk1[w] << 16), k1h = __uint_as_float(rk1[w] & 0xffff0000u);
          float q1l = __uint_as_float(rq1[w] << 16), q1h = __uint_as_float(rq1[w] & 0xffff0000u);
          ko0[w] = (unsigned)f2bf(k0l * eg0) | ((unsigned)f2bf(k0h * eg0) << 16);
          qo0[w] = (unsigned)f2bf(q0l * eg0 * 0.08838834764831845f) | ((unsigned)f2bf(q0h * eg0 * 0.08838834764831845f) << 16);
          ko1[w] = (unsigned)f2bf(k1l * eg1) | ((unsigned)f2bf(k1h * eg1) << 16);
          qo1[w] = (unsigned)f2bf(q1l * eg1 * 0.08838834764831845f) | ((unsigned)f2bf(q1h * eg1 * 0.08838834764831845f) << 16);
          KdT[(lch * 8 + 2 * w) * 80 + lr0] = f2bf(k0l * ed0);
          KdT[(lch * 8 + 2 * w + 1) * 80 + lr0] = f2bf(k0h * ed0);
          KdT[(lch * 8 + 2 * w) * 80 + lr1] = f2bf(k1l * ed1);
          KdT[(lch * 8 + 2 * w + 1) * 80 + lr1] = f2bf(k1h * ed1);
        }
        *(u32x4*)(Kg + lr0 * 144 + lch * 8) = ko0;
        *(u32x4*)(Qg + lr0 * 144 + lch * 8) = qo0;
        *(u32x4*)(Kg + lr1 * 144 + lch * 8) = ko1;
        *(u32x4*)(Qg + lr1 * 144 + lch * 8) = qo1;
        *(u32x4*)(Tl + (tid >> 3) * 80 + (tid & 7) * 8) = rT;
        *(u32x4*)(Il + (tid >> 3) * 80 + (tid & 7) * 8) = rI;
      }
      lds_barrier();
      if (i + 1 < 36) SCAN_LOAD_KQ(ocn);
      f32x4 ks_[2], qs_[2];
#pragma unroll
      for (int u = 0; u < 2; ++u) { ks_[u] = f32x4{0.f, 0.f, 0.f, 0.f}; qs_[u] = f32x4{0.f, 0.f, 0.f, 0.f}; }
#pragma unroll
      for (int kk = 0; kk < 4; ++kk) {
        bf16x8 a = *(const bf16x8*)(ST + (vt * 16 + fr) * 144 + kk * 32 + fq * 8);
#pragma unroll
        for (int u = 0; u < 2; ++u) {
          int rt = rp * 2 + u;
          bf16x8 bk = *(const bf16x8*)(Kg + (rt * 16 + fr) * 144 + kk * 32 + fq * 8);
          bf16x8 bq = *(const bf16x8*)(Qg + (rt * 16 + fr) * 144 + kk * 32 + fq * 8);
          ks_[u] = MFMA(a, bk, ks_[u]);
          qs_[u] = MFMA(a, bq, qs_[u]);
        }
      }
      {
        int v0 = vt * 16 + fq * 4;
        RT[(v0 + 0) * 80 + vr0] = f2bf(rb0 * (__uint_as_float(rv0.x << 16) - ks_[0][0]));
        RT[(v0 + 1) * 80 + vr0] = f2bf(rb0 * (__uint_as_float(rv0.x & 0xffff0000u) - ks_[0][1]));
        RT[(v0 + 2) * 80 + vr0] = f2bf(rb0 * (__uint_as_float(rv0.y << 16) - ks_[0][2]));
        RT[(v0 + 3) * 80 + vr0] = f2bf(rb0 * (__uint_as_float(rv0.y & 0xffff0000u) - ks_[0][3]));
        RT[(v0 + 0) * 80 + vr1] = f2bf(rb1 * (__uint_as_float(rv1.x << 16) - ks_[1][0]));
        RT[(v0 + 1) * 80 + vr1] = f2bf(rb1 * (__uint_as_float(rv1.x & 0xffff0000u) - ks_[1][1]));
        RT[(v0 + 2) * 80 + vr1] = f2bf(rb1 * (__uint_as_float(rv1.y << 16) - ks_[1][2]));
        RT[(v0 + 3) * 80 + vr1] = f2bf(rb1 * (__uint_as_float(rv1.y & 0xffff0000u) - ks_[1][3]));
      }
      if (i + 1 < 36) SCAN_LOAD_V(ocn);
      lds_barrier();
      {
        f32x4 vn[2];
#pragma unroll
        for (int u = 0; u < 2; ++u) vn[u] = f32x4{0.f, 0.f, 0.f, 0.f};
#pragma unroll
        for (int kk = 0; kk < 2; ++kk) {
          bf16x8 a = *(const bf16x8*)(RT + (vt * 16 + fr) * 80 + kk * 32 + fq * 8);
#pragma unroll
          for (int u = 0; u < 2; ++u) {
            bf16x8 bb = *(const bf16x8*)(Tl + ((rp * 2 + u) * 16 + fr) * 80 + kk * 32 + fq * 8);
            vn[u] = MFMA(a, bb, vn[u]);
          }
        }
#pragma unroll
        for (int u = 0; u < 2; ++u) {
          int r = (rp * 2 + u) * 16 + fr, v0 = vt * 16 + fq * 4;
#pragma unroll
          for (int j = 0; j < 4; ++j) VN[(v0 + j) * 80 + r] = f2bf(vn[u][j]);
        }
      }
      lds_barrier();
#pragma unroll
      for (int kk = 0; kk < 2; ++kk) {
        bf16x8 a = *(const bf16x8*)(VN + (vt * 16 + fr) * 80 + kk * 32 + fq * 8);
#pragma unroll
        for (int u = 0; u < 2; ++u) {
          bf16x8 bb = *(const bf16x8*)(Il + ((rp * 2 + u) * 16 + fr) * 80 + kk * 32 + fq * 8);
          qs_[u] = MFMA(a, bb, qs_[u]);
        }
      }
#pragma unroll
      for (int u = 0; u < 2; ++u) {
        int r = (rp * 2 + u) * 16 + fr, j = d ? 63 - r : r;
        u16* op = O + (long)tokof(b, pos0 + j) * 512 + h * 128 + vs * 64 + vt * 16 + fq * 4;
        ushort4 ov4;
        ov4.x = f2bf(qs_[u][0]); ov4.y = f2bf(qs_[u][1]); ov4.z = f2bf(qs_[u][2]); ov4.w = f2bf(qs_[u][3]);
        *(ushort4*)op = ov4;
      }
      {
        float ge = __expf(gl);
#pragma unroll
        for (int u = 0; u < 4; ++u) S[u] *= ge;
#pragma unroll
        for (int kk = 0; kk < 2; ++kk) {
          bf16x8 a = *(const bf16x8*)(VN + (vt * 16 + fr) * 80 + kk * 32 + fq * 8);
#pragma unroll
          for (int u = 0; u < 4; ++u) {
            bf16x8 bb = *(const bf16x8*)(KdT + ((rp * 4 + u) * 16 + fr) * 80 + kk * 32 + fq * 8);
            S[u] = MFMA(a, bb, S[u]);
          }
        }
#pragma unroll
        for (int u = 0; u < 4; ++u) {
          int dd = (rp * 4 + u) * 16 + fr, v0 = vt * 16 + fq * 4;
#pragma unroll
          for (int j = 0; j < 4; ++j) ST[(v0 + j) * 144 + dd] = f2bf(S[u][j]);
        }
      }
      lds_barrier();
    }
#undef SCAN_LOAD_KQ
#undef SCAN_LOAD_V
  }
}

DI void ph_dnfin(const Prm& p, int li) {
  const int lane = mytid() & 63;
  const int gw = mybid() * 8 + (mytid() >> 6), nw = gridDim.x * 8;
  const u16* O = (const u16*)(p.ws + OFF_AR + 5 * U38);
  const u16* O2 = (const u16*)(p.ws + OFF_AR + 6 * U38);
  u16* Z = (u16*)(p.ws + OFF_Y + 3 * U38);
  const float n0 = p.dn_norm[li * 128 + lane * 2], n1 = p.dn_norm[li * 128 + lane * 2 + 1];
#pragma unroll 2
  for (int tok = gw; tok < T_ALL; tok += nw) {
    ushort2 oa[4], ob[4], zz[4];
    float ox[4], oy[4], ss[4];
#pragma unroll
    for (int h = 0; h < 4; ++h) {
      long o = (long)tok * 512 + h * 128 + lane * 2;
      oa[h] = *(const ushort2*)(O + o);
      ob[h] = *(const ushort2*)(O2 + o);
      zz[h] = *(const ushort2*)(Z + o);
    }
#pragma unroll
    for (int h = 0; h < 4; ++h) {
      ox[h] = bf2f(oa[h].x) + bf2f(ob[h].x);
      oy[h] = bf2f(oa[h].y) + bf2f(ob[h].y);
      ss[h] = ox[h] * ox[h] + oy[h] * oy[h];
    }
#pragma unroll
    for (int o = 32; o; o >>= 1)
#pragma unroll
      for (int h = 0; h < 4; ++h) ss[h] += __shfl_xor(ss[h], o);
#pragma unroll
    for (int h = 0; h < 4; ++h) {
      float inv = rsqrtf(ss[h] * (1.f / 128.f) + 1e-6f);
      float z0 = bf2f(zz[h].x), z1 = bf2f(zz[h].y);
      ushort2 y;
      y.x = f2bf(ox[h] * inv * n0 * (z0 / (1.f + __expf(-z0))));
      y.y = f2bf(oy[h] * inv * n1 * (z1 / (1.f + __expf(-z1))));
      *(ushort2*)(Z + (long)tok * 512 + h * 128 + lane * 2) = y;
    }
  }
}

DI void ph_aprep(const Prm& p, int li) {
  const int lane = mytid() & 63;
  const int gw = mybid() * 8 + (mytid() >> 6), nw = gridDim.x * 8;
  const u16* PA = (const u16*)(p.ws + OFF_AR);
  u16* QH = (u16*)(p.ws + OFF_AR + 3 * U38);
  u16* KH = QH + 18874368L;
  const int f = lane & 15;
  const float inv_f = powf(10000.f, -(float)f / 16.f);
  for (int tok = gw; tok < T_ALL; tok += nw) {
    int b, P;
    float cs = 1.f, sn = 0.f;
    if (tok < T_LAT) {
      b = tok >> 11;
      int l = tok & 2047;
      P = 256 + l;
      float pos = (lane < 32) ? (float)(l >> 6) : (float)(l & 63);
      float ang = pos * inv_f;
      cs = cosf(ang);
      sn = sinf(ang);
    } else {
      b = (tok - T_LAT) >> 8;
      P = (tok - T_LAT) & 255;
    }
    float xv[16], ssq[16];
#pragma unroll
    for (int g = 0; g < 16; ++g) {
      xv[g] = bf2f(PA[(long)tok * 1024 + g * 64 + lane]);
      ssq[g] = xv[g] * xv[g];
    }
#pragma unroll
    for (int o = 32; o; o >>= 1)
#pragma unroll
      for (int g = 0; g < 16; ++g) ssq[g] += __shfl_xor(ssq[g], o);
#pragma unroll
    for (int g = 0; g < 16; ++g) {
      int which = g >> 3, h = (g >> 1) & 3, c = g & 1;
      float inv = rsqrtf(ssq[g] * (1.f / 64.f) + 1e-6f);
      float y = xv[g] * inv * p.qk_gain[(li * 2 + which) * 64 + lane];
      float pr = __shfl_xor(y, 16);
      float o = (lane & 16) ? (y * cs + pr * sn) : (y * cs - pr * sn);
      if (which == 0) o *= 0.18033688011112042f;
      u16* dst = (which ? KH : QH) + ((long)((b * 4 + h) * 2 + c) * 2304 + P) * 64 + lane;
      *dst = f2bf(o);
    }
  }
}

DI void ph_attn(const Prm& p, int li, long base, char* smem) {
  const int tid = mytid(), lane = tid & 63, wid = tid >> 6, fr = lane & 15, fq = lane >> 4;
  const u16* QH = (const u16*)(p.ws + OFF_AR + 3 * U38);
  const u16* KH = QH + 18874368L;
  const u16* VT = (const u16*)(p.ws + OFF_AR + 5 * U38);
  u16* YA = (u16*)(p.ws + OFF_Y);
  u16* s = (u16*)smem;
  constexpr int STG = 128 * 80 + 128 * 72;
  const float lambda_init = 0.8f - 0.6f * expf(-0.3f * (float)li);
  float lamv, mshift;
  {
    const float* lv = p.lam + li * 256;
    float a = wsum(lv[lane] * lv[64 + lane]), b2 = wsum(lv[128 + lane] * lv[192 + lane]);
    lamv = expf(a) - expf(b2) + lambda_init;
    float gq = wmax(fabsf(p.qk_gain[(li * 2) * 64 + lane])), gk = wmax(fabsf(p.qk_gain[(li * 2 + 1) * 64 + lane]));
    mshift = 8.f * gq * gk * 1.4426950408889634f;
  }
  for (int it = first_item(base); it < (li == 3 ? 1024 : 1152); it += gridDim.x) {
    int b, h, qp0, nkeys;
    if (it < 1024) { b = it >> 6; h = (it >> 4) & 3; qp0 = 256 + (it & 15) * 128; nkeys = 2304; }
    else { int i2 = it - 1024; b = i2 >> 3; h = (i2 >> 1) & 3; qp0 = (i2 & 1) * 128; nkeys = 256; }
    const long kb0 = (long)((b * 4 + h) * 2) * 2304;
    bf16x8 qf[2][2];
#pragma unroll
    for (int c = 0; c < 2; ++c)
#pragma unroll
      for (int ks = 0; ks < 2; ++ks)
        qf[c][ks] = *(const bf16x8*)(QH + (kb0 + (long)c * 2304 + qp0 + wid * 16 + fr) * 64 + ks * 32 + fq * 8);
    f32x4 O0[8], O1[8];
#pragma unroll
    for (int i = 0; i < 8; ++i) { O0[i] = f32x4{0.f, 0.f, 0.f, 0.f}; O1[i] = f32x4{0.f, 0.f, 0.f, 0.f}; }
    f32x4 L0 = {0.f, 0.f, 0.f, 0.f}, L1 = {0.f, 0.f, 0.f, 0.f};
    const bf16x8 ones = {0x3F80, 0x3F80, 0x3F80, 0x3F80, 0x3F80, 0x3F80, 0x3F80, 0x3F80};
    uint4 rk[2], rv[2];
    const int nt = nkeys >> 6;
#pragma unroll
    for (int u = 0; u < 2; ++u) {
      int id = tid + u * 512;
      int c = id >> 9, key = (id >> 3) & 63, ch = id & 7;
      rk[u] = *(const uint4*)(KH + (kb0 + (long)c * 2304 + key) * 64 + ch * 8);
      int dv = id >> 3;
      rv[u] = *(const uint4*)(VT + ((long)(b * 512 + h * 128 + dv)) * 2304 + ch * 8);
    }
#pragma unroll
    for (int u = 0; u < 2; ++u) {
      int id = tid + u * 512;
      *(uint4*)(s + (id >> 3) * 80 + (id & 7) * 8) = rk[u];
      *(uint4*)(s + 128 * 80 + (id >> 3) * 72 + (id & 7) * 8) = rv[u];
    }
    lds_barrier();
    for (int t = 0; t < nt; ++t) {
      const bool more = t + 1 < nt;
      if (more) {
        int kp0 = (t + 1) * 64;
#pragma unroll
        for (int u = 0; u < 2; ++u) {
          int id = tid + u * 512;
          int c = id >> 9, key = (id >> 3) & 63, ch = id & 7;
          rk[u] = *(const uint4*)(KH + (kb0 + (long)c * 2304 + kp0 + key) * 64 + ch * 8);
          int dv = id >> 3;
          rv[u] = *(const uint4*)(VT + ((long)(b * 512 + h * 128 + dv)) * 2304 + kp0 + ch * 8);
        }
      }
      const u16* ks_ = s + (t & 1) * STG;
      const u16* vs_ = ks_ + 128 * 80;
      bf16x8 pf[2][2];
#pragma unroll
      for (int c = 0; c < 2; ++c) {
#pragma unroll
        for (int kk2 = 0; kk2 < 2; ++kk2) {
          u32x4 pw;
#pragma unroll
          for (int hh = 0; hh < 2; ++hh) {
            const int k4 = kk2 * 2 + hh;
            f32x4 a = {-mshift, -mshift, -mshift, -mshift};
#pragma unroll
            for (int kk = 0; kk < 2; ++kk)
              a = MFMA(*(const bf16x8*)(ks_ + (c * 64 + k4 * 16 + fr) * 80 + kk * 32 + fq * 8), qf[c][kk], a);
            pw[hh * 2 + 0] = pk_bf16(__builtin_amdgcn_exp2f(a[0]), __builtin_amdgcn_exp2f(a[1]));
            pw[hh * 2 + 1] = pk_bf16(__builtin_amdgcn_exp2f(a[2]), __builtin_amdgcn_exp2f(a[3]));
          }
          pf[c][kk2] = *(bf16x8*)&pw;
        }
      }
#pragma unroll
      for (int kk = 0; kk < 2; ++kk) {
        L0 = MFMA(ones, pf[0][kk], L0);
        L1 = MFMA(ones, pf[1][kk], L1);
      }
#pragma unroll
      for (int dt = 0; dt < 8; ++dt) {
#pragma unroll
        for (int kk = 0; kk < 2; ++kk) {
          const u16* vp = vs_ + (dt * 16 + fr) * 72 + kk * 32 + fq * 4;
          uint2 lo = *(const uint2*)vp, hi = *(const uint2*)(vp + 16);
          uint4 av = {lo.x, lo.y, hi.x, hi.y};
          bf16x8 a = *(bf16x8*)&av;
          O0[dt] = MFMA(a, pf[0][kk], O0[dt]);
          O1[dt] = MFMA(a, pf[1][kk], O1[dt]);
        }
      }
      if (more) {
        u16* ns = s + ((t + 1) & 1) * STG;
#pragma unroll
        for (int u = 0; u < 2; ++u) {
          int id = tid + u * 512;
          *(uint4*)(ns + (id >> 3) * 80 + (id & 7) * 8) = rk[u];
          *(uint4*)(ns + 128 * 80 + (id >> 3) * 72 + (id & 7) * 8) = rv[u];
        }
      }
      lds_barrier();
    }
    float i0 = 1.f / L0[0], i1 = lamv / L1[0], ss = 0.f;
#pragma unroll
    for (int dt = 0; dt < 8; ++dt)
#pragma unroll
      for (int j = 0; j < 4; ++j) {
        float o = O0[dt][j] * i0 - O1[dt][j] * i1;
        O0[dt][j] = o;
        ss += o * o;
      }
    ss += __shfl_xor(ss, 16); ss += __shfl_xor(ss, 32);
    float inv = rsqrtf(ss * (1.f / 128.f) + 1e-6f) * (1.f - lambda_init);
    int tok = tokof(b, qp0 + wid * 16 + fr);
#pragma unroll
    for (int dt = 0; dt < 8; ++dt) {
      int dv = dt * 16 + fq * 4;
      const float* sw = p.subln + li * 128 + dv;
      ushort4 o;
      o.x = f2bf(O0[dt][0] * inv * sw[0]);
      o.y = f2bf(O0[dt][1] * inv * sw[1]);
      o.z = f2bf(O0[dt][2] * inv * sw[2]);
      o.w = f2bf(O0[dt][3] * inv * sw[3]);
      *(ushort4*)(YA + (long)tok * 512 + h * 128 + dv) = o;
    }
  }
}

template <int L>
DI void hyena_item(const Prm& p, int li, int ch, char* smem) {
  constexpr int CS = 2 * L + 8;
  constexpr int ZS = L + 8;
  constexpr int MT = L / 128;
  constexpr int MG = MT > 8 ? 8 : MT, NG = MT / MG;
  const int tid = mytid(), lane = tid & 63, wid = tid >> 6, fr = lane & 15, fq = lane >> 4;
  u16* cp = (u16*)smem;
  u16* zr = cp + 8 * CS;
  const u16* PH = (const u16*)(p.ws + OFF_AR) + (L == 2048 ? 0L : 32768L * 1536);
  const u16* G = (const u16*)(p.ws + (L == 2048 ? OFF_TAPL : OFF_TAPC));
  u16* YB = (u16*)(p.ws + OFF_Y + U38);
  const float* cw = p.hy_conv + (long)li * 3 * 1536;
  {
    float w0 = cw[1024 + ch], w1 = cw[1536 + 1024 + ch], w2 = cw[3072 + 1024 + ch];
#pragma unroll 8
    for (int e = tid; e < 16 * L; e += 512) {
      int b = e / L, sidx = e % L;
      const u16* row = PH + ((long)b * 1536 + 1024 + ch) * L;
      float v = w1 * bf2f(row[sidx]);
      if (sidx > 0) v += w0 * bf2f(row[sidx - 1]);
      if (sidx + 1 < L) v += w2 * bf2f(row[sidx + 1]);
      zr[b * ZS + L - 1 - sidx] = f2bf(v);
    }
  }
#pragma unroll
  for (int order = 0; order < 2; ++order) {
    {
      const u16* g = G + (long)(order * 512 + ch) * (2 * L);
#pragma unroll 8
      for (int e = tid; e < 8 * 2 * L; e += 512) {
        int c = e / (2 * L), i = e % (2 * L);
        cp[c * CS + i] = (i + c < 2 * L) ? g[i + c] : (u16)0;
      }
    }
    __syncthreads();
    const float bias = p.hy_bias[(li * 2 + order) * 512 + ch];
    const int gcol = order * 512 + ch;
    const float w0 = cw[gcol], w1 = cw[1536 + gcol], w2 = cw[3072 + gcol];
    const int tq = wid * (L / 8) + fq * 4;
    const u16* xb = PH + ((long)fr * 1536 + gcol) * L + tq;
    const u16* zb = zr + fr * ZS + L - 1 - tq;
    unsigned zp[NG][MG][2];
#pragma unroll
    for (int grp = 0; grp < NG; ++grp) {
      f32x4 acc[MG];
#pragma unroll
      for (int m = 0; m < MG; ++m) acc[m] = f32x4{0.f, 0.f, 0.f, 0.f};
      const int tb = wid * (L / 8) + grp * MG * 16 + fr;
      if constexpr (MG == 8) {
        const int i00 = tb - fq * 8 - 7 + L, c0 = i00 & 7;
        const u16* ab = cp + c0 * CS + (i00 - c0);
        const u16* zbp = zr + fr * ZS + (L - 8 - fq * 8);
        bf16x8 W[16];
#pragma unroll 1
        for (int s0 = 0; s0 < L; s0 += 256) {
#pragma unroll
          for (int k = 0; k < 8; ++k) {
            const int sk = s0 + 32 * k;
            if (k == 0) {
#pragma unroll
              for (int m = 0; m < 8; ++m) W[m] = *(const bf16x8*)(ab + m * 16 - sk);
            }
            if (k < 7) {
              W[(16 - 2 * k - 2) & 15] = *(const bf16x8*)(ab - sk - 32);
              W[(16 - 2 * k - 1) & 15] = *(const bf16x8*)(ab - sk - 32 + 16);
            }
            bf16x8 bk = *(const bf16x8*)(zbp - sk);
#pragma unroll
            for (int m = 0; m < 8; ++m) acc[m] = MFMA(W[(m + 16 - 2 * k) & 15], bk, acc[m]);
          }
        }
      } else {
#pragma unroll 2
        for (int s0 = 0; s0 < L; s0 += 32) {
          bf16x8 bfr = *(const bf16x8*)(zr + fr * ZS + (L - 8 - s0 - fq * 8));
#pragma unroll
          for (int m = 0; m < MG; ++m) {
            int i0 = tb + m * 16 - s0 - fq * 8 - 7 + L;
            int c = i0 & 7;
            bf16x8 afr = *(const bf16x8*)(cp + c * CS + (i0 - c));
            acc[m] = MFMA(afr, bfr, acc[m]);
          }
        }
      }
#pragma unroll
      for (int m = 0; m < MG; ++m) {
        float r4[4];
#pragma unroll
        for (int j = 0; j < 4; ++j) {
          const int off = (grp * MG + m) * 16 + j;
          const int t = tq + off;
          float xa = bf2f(xb[off - 1]), xc = bf2f(xb[off]), xd = bf2f(xb[off + 1]);
          xa = (t > 0) ? xa : 0.f;
          xd = (t + 1 < L) ? xd : 0.f;
          float xg = w0 * xa + w1 * xc + w2 * xd;
          float zin = bf2f(zb[-off]);
          r4[j] = xg * (acc[m][j] + bias * zin);
        }
        zp[grp][m][0] = (unsigned)f2bf(r4[0]) | ((unsigned)f2bf(r4[1]) << 16);
        zp[grp][m][1] = (unsigned)f2bf(r4[2]) | ((unsigned)f2bf(r4[3]) << 16);
      }
    }
    __syncthreads();
#pragma unroll
    for (int grp = 0; grp < NG; ++grp)
#pragma unroll
      for (int m = 0; m < MG; ++m)
#pragma unroll
        for (int j = 0; j < 4; ++j) {
          int t = wid * (L / 8) + (grp * MG + m) * 16 + fq * 4 + j;
          u16 v = (u16)(zp[grp][m][j >> 1] >> ((j & 1) * 16));
          zr[fr * ZS + L - 1 - t] = v;
        }
  }
  __syncthreads();
  {
    u16* YBT = (u16*)(p.ws + OFF_AR + 5 * U38) + (L == 2048 ? 0L : 16L * 512 * 2048);
#pragma unroll 4
    for (int e = tid; e < 16 * L; e += 512) {
      int b = e / L, t = e % L;
      YBT[((long)b * 512 + ch) * L + t] = zr[b * ZS + L - 1 - t];
    }
  }
  __syncthreads();
}

DI long ph_ytrans(const Prm& p, long base, bool lastl, char* smem) {
  u16* tl = (u16*)smem;
  const u16* YBT = (const u16*)(p.ws + OFF_AR + 5 * U38);
  u16* YB = (u16*)(p.ws + OFF_Y + U38);
  const int tid = mytid(), G = gridDim.x;
  const int total = lastl ? 4096 : 4608;
  auto srcp = [&](int it) -> const u16* {
    if (it < 4096) {
      int b = it >> 8, ct = (it >> 5) & 7, lt = it & 31;
      return YBT + ((long)b * 512 + ct * 64 + (tid >> 3)) * 2048 + lt * 64 + (tid & 7) * 8;
    } else {
      int i2 = it - 4096, b = i2 >> 5, ct = (i2 >> 2) & 7, lt = i2 & 3;
      return YBT + 16L * 512 * 2048 + ((long)b * 512 + ct * 64 + (tid >> 3)) * 256 + lt * 64 + (tid & 7) * 8;
    }
  };
  int it = first_item(base);
  u32x4 v = {0u, 0u, 0u, 0u};
  if (it < total) v = *(const u32x4*)srcp(it);
  for (; it < total; it += G) {
    *(u32x4*)(tl + (tid >> 3) * 72 + (tid & 7) * 8) = v;
    __syncthreads();
    if (it + G < total) v = *(const u32x4*)srcp(it + G);
    long tok0;
    int ct;
    if (it < 4096) { int b = it >> 8, lt = it & 31; ct = (it >> 5) & 7; tok0 = (long)b * 2048 + lt * 64; }
    else { int i2 = it - 4096, b = i2 >> 5, lt = i2 & 3; ct = (i2 >> 2) & 7; tok0 = (long)T_LAT + b * 256 + lt * 64; }
    const int lrow = tid >> 3, cc = tid & 7;
    u32x4 o;
#pragma unroll
    for (int w = 0; w < 4; ++w) {
      unsigned lo = tl[(cc * 8 + 2 * w) * 72 + lrow], hi = tl[(cc * 8 + 2 * w + 1) * 72 + lrow];
      o[w] = lo | (hi << 16);
    }
    *(u32x4*)(YB + (tok0 + lrow) * 512 + ct * 64 + cc * 8) = o;
    __syncthreads();
  }
  return base + total;
}

DI void ph_merge(const Prm& p, char* smem, bool lastl) {
  const int tid = mytid(), lane = tid & 63, wid = tid >> 6;
  const int wm = wid >> 1, wn = wid & 1, fr = lane & 15, fq = lane >> 4;
  const u16* H = (const u16*)(p.ws + OFF_HBF);
  const u16* Y = (const u16*)(p.ws + OFF_Y);
  const u16* WG = (const u16*)(p.ws + OFF_WB) + WO_G;
  const u16* WBr = (const u16*)(p.ws + OFF_WB) + WO_B;
  u16* MG = (u16*)(p.ws + OFF_AR);
  const int NT = (lastl ? 256 : 288) * 8, G = gridDim.x;
  Stg r0, r1;
  bool pre = false;
  for (int t = mybid(); t < NT; t += G) {
    const int mt = t >> 3, nt = t & 7;
    const bool hn = t + G < NT;
    const int mt2 = (t + G) >> 3, nt2 = (t + G) & 7;
    f32x4 acc[2][4], g[2][4], y[2][4];
#pragma unroll
    for (int a = 0; a < 2; ++a)
#pragma unroll
      for (int b = 0; b < 4; ++b) acc[a][b] = f32x4{0.f, 0.f, 0.f, 0.f};
    const u16* gA = H + (long)mt * 128 * 1024;
    for (int n = 0; n < 4; ++n) {
      const u16* gB = WG + ((long)n * 1024 + nt * 128) * 1024;
      const u16* yA = Y + (long)n * (T_ALL * 512L) + (long)mt * 128 * 512;
      const u16* yB = WBr + ((long)n * 1024 + nt * 128) * 512;
      gemm_tile<2>(g, gA, 1024, gB, 1024, 1024, smem, r0, r1, pre, yA, 512, yB, 512);
      const u16* nxA = (n < 3) ? gA : (hn ? H + (long)mt2 * 128 * 1024 : nullptr);
      const u16* nxB = (n < 3) ? WG + ((long)(n + 1) * 1024 + nt * 128) * 1024 : WG + ((long)nt2 * 128) * 1024;
      gemm_tile<2>(y, yA, 512, yB, 512, 512, smem, r0, r1, true, nxA, 1024, nxB, 1024);
      pre = true;
#pragma unroll
      for (int a = 0; a < 2; ++a)
#pragma unroll
        for (int b = 0; b < 4; ++b)
#pragma unroll
          for (int j = 0; j < 4; ++j) acc[a][b][j] += y[a][b][j] / (1.f + __expf(-g[a][b][j]));
    }
    pre = hn;
#pragma unroll
    for (int a = 0; a < 2; ++a)
#pragma unroll
      for (int b = 0; b < 4; ++b) {
        int r = wm * 32 + a * 16 + fr, c = wn * 64 + b * 16 + fq * 4;
        uint2 o;
        o.x = pk_bf16(acc[a][b][0], acc[a][b][1]);
        o.y = pk_bf16(acc[a][b][2], acc[a][b][3]);
        *(uint2*)(MG + ((long)mt * 128 + r) * 1024 + nt * 128 + c) = o;
      }
  }
}

DI void run_phase(const Prm& p, int ph, char* smem) {
  if (ph == 0) { ph_init(p, smem); return; }
  const int li = (ph - 1) / 14, k = (ph - 1) % 14;
  const u16* WB = (const u16*)(p.ws + OFF_WB);
  const u16* HB = (const u16*)(p.ws + OFF_HBF);
  const float* MOD = (const float*)(p.ws + OFF_MOD);
  u16* AR = (u16*)(p.ws + OFF_AR);
  u16* Yb = (u16*)(p.ws + OFF_Y);
  const int G = gridDim.x;
  TD d;
  d.split = 0; d.scale = 1.f; d.mode = 0; d.tok0 = 0; d.col0 = 0; d.g = MOD;
  switch (k) {
    case 0: {
      u16* W = (u16*)(p.ws + OFF_WB);
      long base = 0;
      base = tr_job(base, p.w_in + (long)li * 1024 * NIN, 1024, NIN, W + WO_IN, 1, smem);
      base = tr_job(base, p.w_gate + (long)li * 4 * 1048576, 1024, 1024, W + WO_G, 4, smem);
      base = tr_job(base, p.w_branch + (long)li * 4 * 524288, 512, 1024, W + WO_B, 4, smem);
      base = tr_job(base, p.w_o + (long)li * 1048576, 1024, 1024, W + WO_O, 1, smem);
      base = tr_job(base, p.w_mlp1 + (long)li * 4194304, 1024, 4096, W + WO_1, 1, smem);
      base = tr_job(base, p.w_mlp2 + (long)li * 4194304, 4096, 1024, W + WO_2, 1, smem);
      ph_taps1(p, li, base, smem);
      ph_norm(p, li, 0);
    } break;
    case 1: {
      auto dec = [&](int t, TD& o) {
        o.lda = 1024; o.ldb = 1024; o.K = 1024; o.mode = 0;
        if (t < 1728) {
          int mt = t / 12, nt = t % 12;
          o.A = HB + (long)mt * 256 * 1024; o.B = WB + WO_IN + (long)(3584 + nt * 128) * 1024;
          o.C = AR + (long)mt * 256 * 1536 + nt * 128; o.ldc = 1536;
        } else if (t < 2304) {
          int t2 = t - 1728, mt = t2 >> 2, nt = t2 & 3;
          o.A = HB + (long)mt * 256 * 1024; o.B = WB + WO_IN + (long)(5120 + nt * 128) * 1024;
          o.C = Yb + 3 * (U38 / 2) + (long)mt * 256 * 512 + nt * 128; o.ldc = 512;
        } else {
          int mt = t - 2304;
          o.A = HB + (long)mt * 256 * 1024; o.B = WB + WO_IN + (long)5632 * 1024;
          o.C = (u16*)((float*)(p.ws + OFF_PDAB) + (long)mt * 256 * 16); o.ldc = 16; o.mode = 3;
        }
      };
      {
        Stg r0, r1;
        bool pre = false;
        TD dn = d;
        int t = mybid();
        if (t < 2448) dec(t, d);
        for (; t < 2448; t += G) {
          const bool hn = t + G < 2448;
          if (hn) dec(t + G, dn);
          run_tile2(p, d, smem, r0, r1, pre, hn ? dn.A : nullptr, dn.lda, dn.B, dn.ldb);
          pre = hn;
          d = dn;
        }
      }
      ph_taps2(p, 2448, smem);
    } break;
    case 2: ph_dncl(p, li, smem); break;
    case 3: ph_dnscan(p, smem); break;
    case 4: {
      {
        Stg r0, r1;
        bool pre = false;
        for (int t = mybid(); t < 1152; t += G) {
          int mt = t >> 3, nt = t & 7;
          const bool hn = t + G < 1152;
          int mt2 = (t + G) >> 3, nt2 = (t + G) & 7;
          d.lda = 1024; d.ldb = 1024; d.K = 1024;
          d.A = HB + (long)mt * 256 * 1024; d.B = WB + WO_IN + (long)(nt * 128) * 1024;
          d.C = AR + 3 * (U38 / 2); d.ldc = 0; d.mode = 4; d.tok0 = mt * 256; d.col0 = nt;
          d.g = p.qk_gain + li * 128;
          run_tile2(p, d, smem, r0, r1, pre, hn ? HB + (long)mt2 * 256 * 1024 : nullptr, 1024,
                    WB + WO_IN + (long)(nt2 * 128) * 1024, 1024);
          pre = hn;
        }
      }
      ph_dnfin(p, li);
    } break;
    case 5: {
      u16* VT = AR + 5 * (U38 / 2);
      u16* PF = AR + 6 * (U38 / 2);
      auto dec = [&](int t, TD& o) {
        o.lda = 1024; o.ldb = 1024; o.K = 1024;
        if (t < 512) {
          int b = t >> 5, r = t & 31, mt = r >> 4, nt = r & 15;
          o.A = WB + WO_IN + (long)(1024 + mt * 256) * 1024; o.B = HB + ((long)b * 2048 + nt * 128) * 1024;
          o.C = VT + ((long)b * 512 + mt * 256) * 2304 + 256 + nt * 128; o.ldc = 2304;
        } else if (t < 576) {
          int t2 = t - 512, b = t2 >> 2, r = t2 & 3, mt = r >> 1, nt = r & 1;
          o.A = WB + WO_IN + (long)(1024 + mt * 256) * 1024; o.B = HB + ((long)T_LAT + b * 256 + nt * 128) * 1024;
          o.C = VT + ((long)b * 512 + mt * 256) * 2304 + nt * 128; o.ldc = 2304;
        } else {
          int t2 = t - 576, mt = t2 >> 2, nt = t2 & 3;
          o.A = HB + (long)mt * 256 * 1024; o.B = WB + WO_IN + (long)(3072 + nt * 128) * 1024;
          o.C = PF + (long)mt * 256 * 512 + nt * 128; o.ldc = 512;
        }
      };
      {
        Stg r0, r1;
        bool pre = false;
        TD dn = d;
        int t = mybid();
        if (t < 1152) dec(t, d);
        for (; t < 1152; t += G) {
          const bool hn = t + G < 1152;
          if (hn) dec(t + G, dn);
          run_tile2(p, d, smem, r0, r1, pre, hn ? dn.A : nullptr, dn.lda, dn.B, dn.ldb);
          pre = hn;
          d = dn;
        }
      }
    } break;
    case 6: {
      ph_attn(p, li, 0, smem);
      auto dec = [&](int t, TD& o) {
        o.lda = 1024; o.ldb = 1024; o.K = 1024;
        if (t < 1536) {
          int b = t / 96, r = t % 96, mt = r >> 4, nt = r & 15;
          o.A = WB + WO_IN + (long)(1536 + mt * 256) * 1024; o.B = HB + ((long)b * 2048 + nt * 128) * 1024;
          o.C = AR + ((long)b * 1536 + mt * 256) * 2048 + nt * 128; o.ldc = 2048;
        } else {
          int t2 = t - 1536, b = t2 / 12, r = t2 % 12, mt = r >> 1, nt = r & 1;
          o.A = WB + WO_IN + (long)(1536 + mt * 256) * 1024; o.B = HB + ((long)T_LAT + b * 256 + nt * 128) * 1024;
          o.C = AR + 32768L * 1536 + ((long)b * 1536 + mt * 256) * 256 + nt * 128; o.ldc = 256;
        }
      };
      {
        Stg r0, r1;
        bool pre = false;
        TD dn = d;
        int t = first_item(1152);
        if (t < 1728) dec(t, d);
        for (; t < 1728; t += G) {
          const bool hn = t + G < 1728;
          if (hn) dec(t + G, dn);
          run_tile2(p, d, smem, r0, r1, pre, hn ? dn.A : nullptr, dn.lda, dn.B, dn.ldb);
          pre = hn;
          d = dn;
        }
      }
    } break;
    case 7: {
#if !defined(TESTSEL) || TESTSEL == 1
      for (int it = mybid(); it < 512; it += G) hyena_item<2048>(p, li, it, smem);
#endif
#if !defined(TESTSEL) || TESTSEL == 2
      if (li < 3)
        for (int it = mybid(); it < 512; it += G) hyena_item<256>(p, li, it, smem);
#endif
#if !defined(TESTSEL) || TESTSEL == 3
      const u16* PF = AR + 6 * (U38 / 2);
      u16* WF = AR + 3 * (U38 / 2);
      const u16* DCm = (const u16*)(p.ws + OFF_DC);
      auto dec = [&](int t, TD& o) {
        o.A = DCm; o.lda = 128; o.ldb = 512; o.K = 128;
        if (t < 1024) {
          int bg = t >> 4, nt = t & 15, b = bg >> 2, g = bg & 3;
          o.B = PF + ((long)b * 2048 + nt * 128) * 512 + g * 128;
          o.C = WF + ((long)b * 512 + g * 128) * 4096 + nt * 128; o.ldc = 4096; o.split = 2048;
        } else {
          int t2 = t - 1024, bg = t2 >> 1, nt = t2 & 1, b = bg >> 2, g = bg & 3;
          o.B = PF + ((long)T_LAT + b * 256 + nt * 128) * 512 + g * 128;
          o.C = WF + 16L * 512 * 4096 + ((long)b * 512 + g * 128) * 512 + nt * 128; o.ldc = 512; o.split = 256;
        }
      };
      {
        const int NT7 = (li == 3 ? 1024 : 1152);
        Stg r0, r1;
        bool pre = false;
        TD dn = d;
        int t = mybid();
        if (t < NT7) dec(t, d);
        for (; t < NT7; t += G) {
          const bool hn = t + G < NT7;
          if (hn) dec(t + G, dn);
          run_tile2(p, d, smem, r0, r1, pre, hn ? dn.A : nullptr, dn.lda, dn.B, dn.ldb);
          pre = hn;
          d = dn;
        }
      }
#endif
    } break;
    case 8: {
      const u16* WF = AR + 3 * (U38 / 2);
      u16* YF = Yb + 2 * (U38 / 2);
      d.scale = 1.f / 512.f;
      for (int t = mybid(); t < (li == 3 ? 512 : 576); t += G) {
        if (t < 512) {
          int b = t >> 5, r = t & 31, mt = r >> 2, nt = r & 3;
          d.A = (const u16*)(p.ws + OFF_DL) + (long)mt * 256 * 4096; d.lda = 4096;
          d.B = WF + ((long)b * 512 + nt * 128) * 4096; d.ldb = 4096; d.K = 4096;
          d.C = YF + ((long)b * 2048 + mt * 256) * 512 + nt * 128; d.ldc = 512;
        } else {
          int t2 = t - 512, b = t2 >> 2, nt = t2 & 3;
          d.A = (const u16*)(p.ws + OFF_DLC); d.lda = 512;
          d.B = WF + 16L * 512 * 4096 + ((long)b * 512 + nt * 128) * 512; d.ldb = 512; d.K = 512;
          d.C = YF + ((long)T_LAT + b * 256) * 512 + nt * 128; d.ldc = 512;
        }
        run_tile(p, d, smem);
      }
      ph_ytrans(p, 576, li == 3, smem);
    } break;
    case 9: ph_merge(p, smem, li == 3); break;
    case 10: {
      d.mode = 2;
      const int NT10 = (li == 3 ? 1024 : 1152);
      Stg r0, r1;
      bool pre = false;
      for (int t = mybid(); t < NT10; t += G) {
        int mt = t >> 3, nt = t & 7;
        d.A = AR + (long)mt * 256 * 1024; d.lda = 1024; d.B = WB + WO_O + (long)nt * 128 * 1024; d.ldb = 1024; d.K = 1024;
        d.tok0 = mt * 256; d.col0 = nt * 128;
        int bb = d.tok0 < T_LAT ? (d.tok0 >> 11) : 16;
        d.g = MOD + ((long)li * 17 + bb) * 6144 + 2 * 1024;
        const bool hn = t + G < NT10;
        int mt2 = (t + G) >> 3, nt2 = (t + G) & 7;
        run_tile2(p, d, smem, r0, r1, pre, hn ? AR + (long)mt2 * 256 * 1024 : nullptr, 1024,
                  WB + WO_O + (long)nt2 * 128 * 1024, 1024);
        pre = hn;
      }
    } break;
    case 11: ph_norm(p, li, 1); break;
    case 12: {
      d.mode = 1;
      const int NT12 = (li == 3 ? 4096 : 4608);
      Stg r0, r1;
      bool pre = false;
      for (int t = mybid(); t < NT12; t += G) {
        int mt = t >> 5, nt = t & 31;
        d.A = HB + (long)mt * 256 * 1024; d.lda = 1024; d.B = WB + WO_1 + (long)nt * 128 * 1024; d.ldb = 1024; d.K = 1024;
        d.C = Yb + (long)mt * 256 * 4096 + nt * 128; d.ldc = 4096;
        const bool hn = t + G < NT12;
        int mt2 = (t + G) >> 5, nt2 = (t + G) & 31;
        run_tile2(p, d, smem, r0, r1, pre, hn ? HB + (long)mt2 * 256 * 1024 : nullptr, 1024,
                  WB + WO_1 + (long)nt2 * 128 * 1024, 1024);
        pre = hn;
      }
    } break;
    case 13: {
      d.mode = 2;
      for (int t = mybid(); t < (li == 3 ? 1024 : 1152); t += G) {
        int mt = t >> 3, nt = t & 7;
        d.A = Yb + (long)mt * 256 * 4096; d.lda = 4096; d.B = WB + WO_2 + (long)nt * 128 * 4096; d.ldb = 4096; d.K = 4096;
        d.tok0 = mt * 256; d.col0 = nt * 128;
        int bb = d.tok0 < T_LAT ? (d.tok0 >> 11) : 16;
        d.g = MOD + ((long)li * 17 + bb) * 6144 + 5 * 1024;
        run_tile(p, d, smem);
      }
    } break;
  }
}

extern __shared__ __attribute__((aligned(16))) char dyn_smem[];

__global__ void __launch_bounds__(512) mega(Prm p, int lo, int hi) {
#ifdef ONLYK
  run_phase(p, ONLYK, dyn_smem);
#else
  for (int ph = lo; ph <= hi; ++ph) {
    long z = 0;
    asm volatile("" : "+s"(z));
    Prm q;
#define LP(f) q.f = p.f + z
    LP(x); LP(c); LP(ctx); LP(c_ctx); LP(w_ada); LP(b_ada); LP(norm1); LP(norm2); LP(w_in); LP(qk_gain); LP(lam);
    LP(subln); LP(hy_conv); LP(hy_w1); LP(hy_b1); LP(hy_freq); LP(hy_w2); LP(hy_b2); LP(hy_w3); LP(hy_bias);
    LP(dn_conv); LP(dn_a_log); LP(dn_dt_bias); LP(dn_norm); LP(w_gate); LP(w_branch); LP(w_o); LP(w_mlp1); LP(w_mlp2);
    LP(out); LP(ws);
#undef LP
    run_phase(q, ph, dyn_smem);
#ifdef PROBEK
    if (ph > 0 && (ph - 1) % 14 == PROBEK) { cg::this_grid().sync(); run_phase(q, ph, dyn_smem); }
#endif
    if (ph < hi) cg::this_grid().sync();
  }
#endif
}

extern "C" void kernel_launch(void* const* d_in, const int* in_sizes, int n_in, void* d_out, int out_size, void* d_ws,
                              size_t ws_size, hipStream_t stream) {
  static int grid_blocks = 0;
  if (!grid_blocks) {
    hipFuncSetAttribute((const void*)mega, hipFuncAttributeMaxDynamicSharedMemorySize, LDS_BYTES);
    int dev = 0, cus = 0, per_cu = 0;
    hipGetDevice(&dev);
    hipDeviceGetAttribute(&cus, hipDeviceAttributeMultiprocessorCount, dev);
    hipOccupancyMaxActiveBlocksPerMultiprocessor(&per_cu, mega, 512, LDS_BYTES);
    if (per_cu < 1) per_cu = 1;
    grid_blocks = cus * per_cu;
    if (ws_size < (size_t)WS_TOTAL) fprintf(stderr, "workspace too small: %zu < %ld\n", ws_size, (long)WS_TOTAL);
  }
  Prm p;
  const float** pp = (const float**)&p;
  for (int i = 0; i < 29; ++i) pp[i] = (const float*)d_in[i];
  p.out = (float*)d_out;
  p.ws = (char*)d_ws;
#if MULTI
  for (int ph = 0; ph < NPHASE; ++ph) hipLaunchKernelGGL(mega, dim3(grid_blocks), dim3(512), LDS_BYTES, stream, p, ph, ph);
#else
  int lo = 0, hi = NPHASE - 1;
  void* args[] = {&p, &lo, &hi};
  hipError_t e = hipLaunchCooperativeKernel((void*)mega, dim3(grid_blocks), dim3(512), args, LDS_BYTES, stream);
  if (e != hipSuccess) fprintf(stderr, "cooperative launch failed: %s (grid %d)\n", hipGetErrorString(e), grid_blocks);
#endif
}
```

```cpp
#include <hip/hip_runtime.h>
#include <hip/hip_cooperative_groups.h>
#include <stdint.h>
#include <stdio.h>
namespace cg = cooperative_groups;

typedef unsigned short u16;
typedef __attribute__((ext_vector_type(8))) short bf16x8;
typedef __attribute__((ext_vector_type(4))) float f32x4;
#define MFMA(a, b, c) __builtin_amdgcn_mfma_f32_16x16x32_bf16(a, b, c, 0, 0, 0)
#define DI __device__ __forceinline__

#ifndef MULTI
#define MULTI 0
#endif

constexpr int T_LAT = 32768, T_ALL = 36864;
constexpr int NIN = 5648;
constexpr long U38 = 37748736L;
constexpr long OFF_XC = 0;
constexpr long OFF_WB = OFF_XC + 16777216L;
constexpr long OFF_HBF = OFF_WB + 43024384L;
constexpr long OFF_MOD = OFF_HBF + 75497472L;
constexpr long OFF_TAPL = OFF_MOD + 1671168L;
constexpr long OFF_TAPC = OFF_TAPL + 8388608L;
constexpr long OFF_DL = OFF_TAPC + 1048576L;
constexpr long OFF_DLC = OFF_DL + 16777216L;
constexpr long OFF_DC = OFF_DLC + 262144L;
constexpr long OFF_PDAB = OFF_DC + 65536L;
constexpr long OFF_GC = OFF_PDAB + 2359296L;
constexpr long OFF_BETA = OFF_GC + 2359296L;
constexpr long OFF_Y = OFF_BETA + 2359296L;
constexpr long OFF_AR = OFF_Y + 4 * U38;
constexpr long OFF_ROPE = OFF_AR + 7 * U38;
constexpr long WS_TOTAL = OFF_ROPE + 2 * 262144L;
constexpr long WO_IN = 0, WO_G = 5783552L, WO_B = 9977856L, WO_O = 12075008L, WO_1 = 13123584L, WO_2 = 17317888L;
constexpr int LDS_BYTES = 139264;
constexpr int NPHASE = 1 + 4 * 14;

struct Prm {
  const float *x, *c, *ctx, *c_ctx, *w_ada, *b_ada, *norm1, *norm2, *w_in, *qk_gain, *lam, *subln, *hy_conv, *hy_w1,
      *hy_b1, *hy_freq, *hy_w2, *hy_b2, *hy_w3, *hy_bias, *dn_conv, *dn_a_log, *dn_dt_bias, *dn_norm, *w_gate,
      *w_branch, *w_o, *w_mlp1, *w_mlp2;
  float* out;
  char* ws;
};

DI int mytid() {
  int t = threadIdx.x;
  asm volatile("" : "+v"(t));
  return t;
}
DI int mybid() {
  int t = blockIdx.x;
  asm volatile("" : "+s"(t));
  return t;
}
DI void lds_barrier() {
  asm volatile("s_waitcnt lgkmcnt(0)" ::: "memory");
  __builtin_amdgcn_s_barrier();
  asm volatile("" ::: "memory");
}
typedef __bf16 bf16x2_t __attribute__((ext_vector_type(2)));
typedef float f32x2_t __attribute__((ext_vector_type(2)));
DI unsigned pk_bf16(float a, float b) {
  f32x2_t v = {a, b};
  bf16x2_t h = __builtin_convertvector(v, bf16x2_t);
  return *(unsigned*)&h;
}
DI u16 f2bf(float f) {
  __bf16 h = (__bf16)f;
  return *(u16*)&h;
}
DI float bf2f(u16 h) { return __uint_as_float(((unsigned)h) << 16); }
DI float wsum(float v) {
  for (int o = 32; o; o >>= 1) v += __shfl_xor(v, o);
  return v;
}
DI float wmax(float v) {
  for (int o = 32; o; o >>= 1) v = fmaxf(v, __shfl_xor(v, o));
  return v;
}
DI float siluf(float v) { return v / (1.f + __expf(-v)); }
DI float sigmf(float v) { return 1.f / (1.f + __expf(-v)); }
DI float* xrow(const Prm& p, int tok) {
  return tok < T_LAT ? p.out + (long)tok * 1024 : (float*)(p.ws + OFF_XC) + (long)(tok - T_LAT) * 1024;
}
DI int first_item(long base) {
  int G = gridDim.x;
  return (int)(((long)mybid() + G - (base % G)) % G);
}
DI int tokof(int b, int P) { return P < 256 ? T_LAT + b * 256 + P : b * 2048 + (P - 256); }

typedef __attribute__((ext_vector_type(4))) unsigned u32x4;
struct Stg { u32x4 a0, a1, a2, a3, b0, b1; };
template <int NA>
DI void g_load(Stg& r, const u16* Ap, long lda, const u16* Bp, long ldb, int k0) {
  r.a0 = *(const u32x4*)(Ap + k0);
  r.a1 = *(const u32x4*)(Ap + 64 * lda + k0);
  if constexpr (NA == 4) {
    r.a2 = *(const u32x4*)(Ap + 128 * lda + k0);
    r.a3 = *(const u32x4*)(Ap + 192 * lda + k0);
  }
  r.b0 = *(const u32x4*)(Bp + k0);
  r.b1 = *(const u32x4*)(Bp + 64 * ldb + k0);
}
template <int NA, int TM>
DI void s_store(const Stg& r, u16* ns_) {
  *(u32x4*)(ns_) = r.a0;
  *(u32x4*)(ns_ + 64 * 80) = r.a1;
  if constexpr (NA == 4) {
    *(u32x4*)(ns_ + 128 * 80) = r.a2;
    *(u32x4*)(ns_ + 192 * 80) = r.a3;
  }
  *(u32x4*)(ns_ + TM * 80) = r.b0;
  *(u32x4*)(ns_ + TM * 80 + 64 * 80) = r.b1;
}
template <int MI>
DI void t_compute(f32x4 (&acc)[MI][4], const u16* as, const u16* bs, int wm, int wn, int fr, int fq) {
#pragma unroll
  for (int ks = 0; ks < 2; ++ks) {
    bf16x8 a[MI], b[4];
#pragma unroll
    for (int mi = 0; mi < MI; ++mi) a[mi] = *(const bf16x8*)(as + (wm * MI * 16 + mi * 16 + fr) * 80 + ks * 32 + fq * 8);
#pragma unroll
    for (int ni = 0; ni < 4; ++ni) b[ni] = *(const bf16x8*)(bs + (wn * 64 + ni * 16 + fr) * 80 + ks * 32 + fq * 8);
#pragma unroll
    for (int mi = 0; mi < MI; ++mi)
#pragma unroll
      for (int ni = 0; ni < 4; ++ni) acc[mi][ni] = MFMA(b[ni], a[mi], acc[mi][ni]);
  }
}
template <int MI>
DI void gemm_tile(f32x4 (&acc)[MI][4], const u16* __restrict__ A, long lda, const u16* __restrict__ B, long ldb, int K,
                  char* smem, Stg& r0, Stg& r1, bool pre, const u16* nA, long nlda, const u16* nB, long nldb) {
  constexpr int TM = MI * 64;
  constexpr int STAGE = (TM + 128) * 80;
  constexpr int NA = TM * 8 / 512;
  u16* s = (u16*)smem;
  const int tid = mytid(), lane = tid & 63, wid = tid >> 6;
  const int wm = wid >> 1, wn = wid & 1, fr = lane & 15, fq = lane >> 4;
  const long to_a = (long)(tid >> 3), to_c = (tid & 7) * 8;
  const u16* Ap = A + to_a * lda + to_c;
  const u16* Bp = B + to_a * ldb + to_c;
  const u16* nAp = nA + to_a * nlda + to_c;
  const u16* nBp = nB + to_a * nldb + to_c;
  const int so = (tid >> 3) * 80 + (tid & 7) * 8;
#define GLOAD(r, k0) g_load<NA>(r, Ap, lda, Bp, ldb, (k0))
#define NLOAD(r, k0) g_load<NA>(r, nAp, nlda, nBp, nldb, (k0))
#define SSTORE(r, st) s_store<NA, TM>(r, s + (st) * STAGE + so)
#define COMPUTE(st) t_compute<MI>(acc, s + (st) * STAGE, s + (st) * STAGE + TM * 80, wm, wn, fr, fq)
#pragma unroll
  for (int mi = 0; mi < MI; ++mi)
#pragma unroll
    for (int ni = 0; ni < 4; ++ni) acc[mi][ni] = f32x4{0.f, 0.f, 0.f, 0.f};
  const int nk = K >> 6;
  if (!pre) {
    GLOAD(r0, 0);
    GLOAD(r1, 64);
  }
  SSTORE(r0, 0);
  lds_barrier();
  for (int kt = 0; kt < nk; kt += 2) {
    if (kt + 2 < nk) GLOAD(r0, (kt + 2) << 6);
    else if (nA) NLOAD(r0, 0);
    COMPUTE(0);
    SSTORE(r1, 1);
    lds_barrier();
    if (kt + 3 < nk) GLOAD(r1, (kt + 3) << 6);
    else if (nA) NLOAD(r1, 64);
    COMPUTE(1);
    if (kt + 2 < nk) SSTORE(r0, 0);
    lds_barrier();
  }
#undef GLOAD
#undef NLOAD
#undef SSTORE
#undef COMPUTE
}

struct TD {
  const u16* A;
  const u16* B;
  u16* C;
  long lda, ldb, ldc;
  int K;
  int mode;
  int split;
  float scale;
  int tok0, col0;
  const float* g;
};

DI void run_tile2(const Prm& p, const TD& d, char* smem, Stg& r0, Stg& r1, bool pre, const u16* nA, long nlda,
                 const u16* nB, long nldb);
DI void run_tile(const Prm& p, const TD& d, char* smem) {
  Stg r0, r1;
  run_tile2(p, d, smem, r0, r1, false, nullptr, 0, nullptr, 0);
}
DI void run_tile2(const Prm& p, const TD& d, char* smem, Stg& r0, Stg& r1, bool pre, const u16* nA, long nlda,
                 const u16* nB, long nldb) {
  f32x4 acc[4][4];
  gemm_tile<4>(acc, d.A, d.lda, d.B, d.ldb, d.K, smem, r0, r1, pre, nA, nlda, nB, nldb);
  const int tid = mytid(), lane = tid & 63, wid = tid >> 6;
  const int wm = wid >> 1, wn = wid & 1, fr = lane & 15, fq = lane >> 4;
  if (d.mode == 4) {
    const int which = d.col0 >> 2, h = d.col0 & 3;
    const float* gain = d.g + which * 64 + fq * 4;
    const float* RC = (const float*)(p.ws + OFF_ROPE);
    const float* RS = RC + 65536;
    u16* dstb = d.C + (which ? 18874368L : 0L);
    const float qs = which ? 1.f : 0.18033688011112042f;
#pragma unroll
    for (int mi = 0; mi < 4; ++mi) {
      const int tok = d.tok0 + wm * 64 + mi * 16 + fr;
      float ss = 0.f;
#pragma unroll
      for (int ni = 0; ni < 4; ++ni)
#pragma unroll
        for (int j = 0; j < 4; ++j) ss += acc[mi][ni][j] * acc[mi][ni][j];
      ss += __shfl_xor(ss, 16);
      ss += __shfl_xor(ss, 32);
      const float inv = rsqrtf(ss * (1.f / 64.f) + 1e-6f) * qs;
      int b, P;
      const bool lat = tok < T_LAT;
      if (lat) { b = tok >> 11; P = 256 + (tok & 2047); }
      else { b = (tok - T_LAT) >> 8; P = (tok - T_LAT) & 255; }
      float y[4][4];
#pragma unroll
      for (int ni = 0; ni < 4; ++ni) {
        float4 g4 = *(const float4*)(gain + ni * 16);
        y[ni][0] = acc[mi][ni][0] * inv * g4.x; y[ni][1] = acc[mi][ni][1] * inv * g4.y;
        y[ni][2] = acc[mi][ni][2] * inv * g4.z; y[ni][3] = acc[mi][ni][3] * inv * g4.w;
      }
      u16* dst = dstb + ((long)((b * 4 + h) * 2 + wn) * 2304 + P) * 64 + fq * 4;
#pragma unroll
      for (int ni = 0; ni < 4; ++ni) {
        float o0 = y[ni][0], o1 = y[ni][1], o2 = y[ni][2], o3 = y[ni][3];
        if (lat) {
          const int l = tok & 2047, a = ni >> 1;
          float4 c4 = *(const float4*)(RC + (l * 2 + a) * 16 + fq * 4);
          float4 s4 = *(const float4*)(RS + (l * 2 + a) * 16 + fq * 4);
          const float sg = (ni & 1) ? 1.f : -1.f;
          o0 = y[ni][0] * c4.x + sg * y[ni ^ 1][0] * s4.x;
          o1 = y[ni][1] * c4.y + sg * y[ni ^ 1][1] * s4.y;
          o2 = y[ni][2] * c4.z + sg * y[ni ^ 1][2] * s4.z;
          o3 = y[ni][3] * c4.w + sg * y[ni ^ 1][3] * s4.w;
        }
        uint2 o;
        o.x = pk_bf16(o0, o1);
        o.y = pk_bf16(o2, o3);
        *(uint2*)(dst + ni * 16) = o;
      }
    }
    return;
  }
#pragma unroll
  for (int mi = 0; mi < 4; ++mi)
#pragma unroll
    for (int ni = 0; ni < 4; ++ni) {
      int r = wm * 64 + mi * 16 + fr, c = wn * 64 + ni * 16 + fq * 4;
      f32x4 v = acc[mi][ni];
      if (d.mode == 0) {
        long ro = d.split ? ((long)(r & 127) * d.ldc + (long)(r >> 7) * d.split) : (long)r * d.ldc;
        ushort4 o;
        o.x = f2bf(v[0] * d.scale); o.y = f2bf(v[1] * d.scale); o.z = f2bf(v[2] * d.scale); o.w = f2bf(v[3] * d.scale);
        *(ushort4*)(d.C + ro + c) = o;
      } else if (d.mode == 1) {
        ushort4 o;
        float t0 = fmaxf(v[0], 0.f), t1 = fmaxf(v[1], 0.f), t2 = fmaxf(v[2], 0.f), t3 = fmaxf(v[3], 0.f);
        o.x = f2bf(t0 * t0); o.y = f2bf(t1 * t1); o.z = f2bf(t2 * t2); o.w = f2bf(t3 * t3);
        *(ushort4*)(d.C + (long)r * d.ldc + c) = o;
      } else if (d.mode == 3) {
        if (wn == 0 && ni == 0) *(float4*)((float*)d.C + (long)r * 16 + fq * 4) = float4{v[0], v[1], v[2], v[3]};
      } else {
        float4* xp = (float4*)(xrow(p, d.tok0 + r) + d.col0 + c);
        float4 g4 = *(const float4*)(d.g + d.col0 + c);
        float4 x4 = *xp;
        x4.x += g4.x * v[0]; x4.y += g4.y * v[1]; x4.z += g4.z * v[2]; x4.w += g4.w * v[3];
        *xp = x4;
      }
    }
}

DI void ph_init(const Prm& p, char* smem) {
  const long gt = (long)mybid() * 512 + mytid(), gn = (long)gridDim.x * 512;
  {
    const float4* s = (const float4*)p.x;
    float4* d = (float4*)p.out;
    for (long i = gt; i < 32768L * 256; i += gn) d[i] = s[i];
    const float4* s2 = (const float4*)p.ctx;
    float4* d2 = (float4*)(p.ws + OFF_XC);
    for (long i = gt; i < 4096L * 256; i += gn) d2[i] = s2[i];
  }
  {
    u16* DL = (u16*)(p.ws + OFF_DL);
    for (long i = gt; i < 2048L * 4096; i += gn) {
      int l = (int)(i >> 12), kk = (int)(i & 4095), lp = kk & 2047, part = kk >> 11;
      int m = (l * lp) & 2047;
      float ang = (float)m * (6.283185307179586f / 2048.f);
      DL[i] = f2bf(part ? -sinf(ang) : cosf(ang));
    }
    u16* DLC = (u16*)(p.ws + OFF_DLC);
    for (long i = gt; i < 256L * 512; i += gn) {
      int l = (int)(i >> 9), kk = (int)(i & 511), lp = kk & 255, part = kk >> 8;
      int m = (l * lp) & 255;
      float ang = (float)m * (6.283185307179586f / 256.f);
      DLC[i] = f2bf(part ? -sinf(ang) : cosf(ang));
    }
    {
      float* RC = (float*)(p.ws + OFF_ROPE);
      float* RS = RC + 65536;
      for (long i = gt; i < 65536; i += gn) {
        int l = (int)(i >> 5), a = (int)(i >> 4) & 1, f = (int)(i & 15);
        float pos = a ? (float)(l & 63) : (float)(l >> 6);
        float ang = pos * powf(10000.f, -(float)f / 16.f);
        RC[i] = cosf(ang);
        RS[i] = sinf(ang);
      }
    }
    u16* DC = (u16*)(p.ws + OFF_DC);
    for (long i = gt; i < 256L * 128; i += gn) {
      int j2 = (int)(i >> 7), ii = (int)(i & 127), part = j2 >> 7, j = j2 & 127;
      int m = (ii * j) & 127;
      float ang = (float)m * (6.283185307179586f / 128.f);
      DC[i] = f2bf(part ? sinf(ang) : cosf(ang));
    }
  }
  float* sc = (float*)smem;
  float* red = sc + 17 * 1024;
  const int tid = mytid();
  for (int e = tid; e < 17 * 1024; e += 512) {
    int bb = e >> 10, k = e & 1023;
    float v = bb < 16 ? p.c[bb * 1024 + k] : p.c_ctx[k];
    sc[e] = v / (1.f + expf(-v));
  }
  __syncthreads();
  float* MOD = (float*)(p.ws + OFF_MOD);
  for (int it = mybid(); it < 192; it += gridDim.x) {
    int li = it / 48, cgp = it % 48;
    int cl = tid & 127, kq = tid >> 7, n = cgp * 128 + cl;
    float a[17];
#pragma unroll
    for (int b = 0; b < 17; ++b) a[b] = 0.f;
    const float* w = p.w_ada + ((long)li * 1024 + kq * 256) * 6144 + n;
#pragma unroll 2
    for (int k = 0; k < 256; ++k) {
      float wv = w[(long)k * 6144];
#pragma unroll
      for (int b = 0; b < 17; ++b) a[b] += sc[b * 1024 + kq * 256 + k] * wv;
    }
#pragma unroll
    for (int b = 0; b < 17; ++b) red[(kq * 17 + b) * 128 + cl] = a[b];
    __syncthreads();
    for (int e = tid; e < 17 * 128; e += 512) {
      int b = e >> 7, c2 = e & 127, n2 = cgp * 128 + c2;
      float v = p.b_ada[li * 6144 + n2];
      for (int q = 0; q < 4; ++q) v += red[(q * 17 + b) * 128 + c2];
      MOD[((long)li * 17 + b) * 6144 + n2] = v;
    }
    __syncthreads();
  }
}

DI long tr_job(long base, const float* src, int K, int N, u16* dst, int nb, char* smem) {
  float* t = (float*)smem;
  const int tk = K >> 6, tn = (N + 63) >> 6, per = tk * tn, total = per * nb;
  const int tid = mytid();
  const int G = gridDim.x;
  float v[8];
  int it = first_item(base);
  if (it < total) {
    int b = it / per, r = it % per, kt = r / tn, nt = r % tn;
    const float* s = src + (long)b * K * N;
#pragma unroll
    for (int i = 0; i < 8; ++i) {
      int id = tid + i * 512, kk = id >> 6, nn = id & 63;
      v[i] = (nt * 64 + nn < N) ? s[(long)(kt * 64 + kk) * N + nt * 64 + nn] : 0.f;
    }
  }
  for (; it < total; it += G) {
    int b = it / per, r = it % per, kt = r / tn, nt = r % tn;
    u16* d = dst + (long)b * K * N;
    int k0 = kt * 64, n0 = nt * 64;
#pragma unroll
    for (int i = 0; i < 8; ++i) {
      int id = tid + i * 512, kk = id >> 6, nn = id & 63;
      t[kk * 65 + nn] = v[i];
    }
    __syncthreads();
    if (it + G < total) {
      int it2 = it + G, b2 = it2 / per, r2 = it2 % per, kt2 = r2 / tn, nt2 = r2 % tn;
      const float* s2 = src + (long)b2 * K * N;
#pragma unroll
      for (int i = 0; i < 8; ++i) {
        int id = tid + i * 512, kk = id >> 6, nn = id & 63;
        v[i] = (nt2 * 64 + nn < N) ? s2[(long)(kt2 * 64 + kk) * N + nt2 * 64 + nn] : 0.f;
      }
    }
#pragma unroll
    for (int i = 0; i < 8; ++i) {
      int id = tid + i * 512, nn = id >> 6, kk = id & 63;
      if (n0 + nn < N) d[(long)(n0 + nn) * K + k0 + kk] = f2bf(t[kk * 65 + nn]);
    }
    __syncthreads();
  }
  return base + total;
}

DI void ph_norm(const Prm& p, int li, int which) {
  const int lane = mytid() & 63;
  const int gw = mybid() * 8 + (mytid() >> 6), nw = gridDim.x * 8;
  const float* nwt = (which ? p.norm2 : p.norm1) + li * 1024;
  const float* MOD = (const float*)(p.ws + OFF_MOD);
  u16* H = (u16*)(p.ws + OFF_HBF);
  const int nrows = (which && li == 3) ? T_LAT : T_ALL;
  for (int row = gw; row < nrows; row += 2 * nw) {
    const int row2 = row + nw;
    const bool has2 = row2 < nrows;
    const float* xr = xrow(p, row);
    const float* xr2 = xrow(p, has2 ? row2 : row);
    float4 v[4], u[4];
    float ss = 0.f, ss2 = 0.f;
#pragma unroll
    for (int i = 0; i < 4; ++i) {
      v[i] = *(const float4*)(xr + i * 256 + lane * 4);
      u[i] = *(const float4*)(xr2 + i * 256 + lane * 4);
    }
#pragma unroll
    for (int i = 0; i < 4; ++i) {
      ss += v[i].x * v[i].x + v[i].y * v[i].y + v[i].z * v[i].z + v[i].w * v[i].w;
      ss2 += u[i].x * u[i].x + u[i].y * u[i].y + u[i].z * u[i].z + u[i].w * u[i].w;
    }
#pragma unroll
    for (int o = 32; o; o >>= 1) {
      ss += __shfl_xor(ss, o);
      ss2 += __shfl_xor(ss2, o);
    }
    const float inv = rsqrtf(ss * (1.f / 1024.f) + 1e-6f), inv2 = rsqrtf(ss2 * (1.f / 1024.f) + 1e-6f);
    const int bb = row < T_LAT ? (row >> 11) : 16, bb2 = row2 < T_LAT ? (row2 >> 11) : 16;
    const float* sh = MOD + ((long)li * 17 + bb) * 6144 + (which ? 3 : 0) * 1024;
    const float* sh2 = MOD + ((long)li * 17 + (has2 ? bb2 : bb)) * 6144 + (which ? 3 : 0) * 1024;
#pragma unroll
    for (int i = 0; i < 4; ++i) {
      int c = i * 256 + lane * 4;
      float4 w4 = *(const float4*)(nwt + c);
      {
        float4 s4 = *(const float4*)(sh + 1024 + c), h4 = *(const float4*)(sh + c);
        uint2 o;
        o.x = pk_bf16(v[i].x * inv * w4.x * (1.f + s4.x) + h4.x, v[i].y * inv * w4.y * (1.f + s4.y) + h4.y);
        o.y = pk_bf16(v[i].z * inv * w4.z * (1.f + s4.z) + h4.z, v[i].w * inv * w4.w * (1.f + s4.w) + h4.w);
        *(uint2*)(H + (long)row * 1024 + c) = o;
      }
      if (has2) {
        float4 s4 = *(const float4*)(sh2 + 1024 + c), h4 = *(const float4*)(sh2 + c);
        uint2 o;
        o.x = pk_bf16(u[i].x * inv2 * w4.x * (1.f + s4.x) + h4.x, u[i].y * inv2 * w4.y * (1.f + s4.y) + h4.y);
        o.y = pk_bf16(u[i].z * inv2 * w4.z * (1.f + s4.z) + h4.z, u[i].w * inv2 * w4.w * (1.f + s4.w) + h4.w);
        *(uint2*)(H + (long)row2 * 1024 + c) = o;
      }
    }
  }
}

DI void ph_taps1(const Prm& p, int li, long base, char* smem) {
  float* f = (float*)smem;
  float* hraw = (float*)(p.ws + OFF_AR + 5 * U38);
  const int tid = mytid();
  for (int it = first_item(base); it < 288; it += gridDim.x) {
    const int L = it < 256 ? 2048 : 256, j0 = it < 256 ? it * 8 : (it - 256) * 8;
    const int lg = tid >> 6, kk = tid & 63;
    if (tid < 8 * 33) {
      int l2 = tid / 33, e = tid % 33, j = j0 + l2;
      float t = (float)j / (float)(L - 1);
      float w = 6.283185307179586f * (float)j / (float)L;
      float v;
      if (e == 0) v = t;
      else {
        int bi = (e - 1) & 15;
        float band = 1e-4f + (float)bi * ((15.f - 1e-4f) / 15.f);
        v = (e <= 16) ? cosf(band * w) : -sinf(band * w);
      }
      f[l2 * 40 + e] = v;
    }
    __syncthreads();
    {
      float v = p.hy_b1[li * 64 + kk];
#pragma unroll 3
      for (int e = 0; e < 33; ++e) v += f[lg * 40 + e] * p.hy_w1[(li * 33 + e) * 64 + kk];
      f[320 + lg * 64 + kk] = sinf(p.hy_freq[(li * 2 + 0) * 64 + kk] * v);
    }
    __syncthreads();
    {
      float v = p.hy_b2[li * 64 + kk];
#pragma unroll 4
      for (int m = 0; m < 64; ++m) v += f[320 + lg * 64 + m] * p.hy_w2[(li * 64 + m) * 64 + kk];
      f[832 + lg * 64 + kk] = sinf(p.hy_freq[(li * 2 + 1) * 64 + kk] * v);
    }
    __syncthreads();
    {
      float h[4][8];
#pragma unroll
      for (int i = 0; i < 4; ++i)
#pragma unroll
        for (int l2 = 0; l2 < 8; ++l2) h[i][l2] = 0.f;
      const float* w3 = p.hy_w3 + (long)li * 64 * 2048 + tid;
#pragma unroll 2
      for (int k = 0; k < 64; ++k) {
        float wv[4];
#pragma unroll
        for (int i = 0; i < 4; ++i) wv[i] = w3[(long)k * 2048 + i * 512];
#pragma unroll
        for (int l2 = 0; l2 < 8; ++l2) {
          float hv = f[832 + l2 * 64 + k];
#pragma unroll
          for (int i = 0; i < 4; ++i) h[i][l2] += hv * wv[i];
        }
      }
#pragma unroll
      for (int i = 0; i < 4; ++i) {
        int n = tid + i * 512, ch = n & 511;
        float delta = fabsf(-3.0701134573253946f + (float)ch * ((-15.350567286626973f + 3.0701134573253946f) / 511.f));
#pragma unroll
        for (int l2 = 0; l2 < 8; ++l2) {
          int j = j0 + l2;
          float t = (float)j / (float)(L - 1);
          long row = (it < 256) ? j : 2048 + j;
          hraw[row * 2048 + n] = h[i][l2] * expf(-t * delta);
        }
      }
    }
    __syncthreads();
  }
}
DI void ph_taps2(const Prm& p, long base, char* smem) {
  float* vals = (float*)smem;
  float* red = vals + 8 * 2048;
  const float* hraw = (const float*)(p.ws + OFF_AR + 5 * U38);
  const int tid = mytid(), cl = tid & 3, dir = (tid >> 2) & 1, jg = tid >> 3;
  for (int it = first_item(base); it < 512; it += gridDim.x) {
    int ls = it >> 8, order = (it >> 7) & 1, cgp = it & 127;
    int L = ls ? 256 : 2048;
    const float* hr = hraw + (long)(ls ? 2048 : 0) * 2048;
    u16* G = (u16*)(p.ws + (ls ? OFF_TAPC : OFF_TAPL));
    int ch = cgp * 4 + cl, n = order * 1024 + dir * 512 + ch;
    float s = 0.f;
#pragma unroll 8
    for (int j = jg; j < L; j += 64) {
      float v = hr[(long)j * 2048 + n];
      vals[(cl * 2 + dir) * L + j] = v;
      s += (dir == 1 && j == 0) ? 0.f : fabsf(v);
    }
    red[(tid >> 2) * 4 + cl] = s;
    __syncthreads();
    if (tid < 4) {
      float tot = 0.f;
#pragma unroll 8
      for (int r = 0; r < 128; ++r) tot += red[r * 4 + tid];
      red[512 + tid] = 1.f / tot;
    }
    __syncthreads();
    for (int idx = tid; idx < 8 * L; idx += 512) {
      int q = idx / L, j = idx % L, c2 = q >> 1, d2 = q & 1;
      float v = vals[idx] * red[512 + c2];
      u16* g = G + (long)(order * 512 + cgp * 4 + c2) * (2 * L);
      if (d2 == 0) g[L + j] = f2bf(v);
      else if (j > 0) g[L - j] = f2bf(v);
      else g[0] = 0;
    }
    __syncthreads();
  }
}

DI void ph_pdab(const Prm& p, int li, char* smem) {
  float* wl = (float*)smem;
  const int tid = mytid(), lane = tid & 63;
#pragma unroll 8
  for (int e = tid; e < 1024 * 16; e += 512) wl[e] = p.w_in[((long)li * 1024 + (e >> 4)) * NIN + 5632 + (e & 15)];
  __syncthreads();
  const u16* H = (const u16*)(p.ws + OFF_HBF);
  float* out = (float*)(p.ws + OFF_PDAB);
  const int gw = mybid() * 8 + (tid >> 6), nw = gridDim.x * 8;
  for (int tok = gw; tok < T_ALL; tok += nw) {
    float a[16];
#pragma unroll
    for (int j = 0; j < 16; ++j) a[j] = 0.f;
    float hv[16];
#pragma unroll
    for (int i = 0; i < 16; ++i) hv[i] = bf2f(H[(long)tok * 1024 + lane + i * 64]);
#pragma unroll
    for (int i = 0; i < 16; ++i) {
      float h = hv[i];
      const float4* wp = (const float4*)(wl + (lane + i * 64) * 16);
#pragma unroll
      for (int q = 0; q < 4; ++q) {
        float4 w4 = wp[q];
        a[q * 4 + 0] += h * w4.x;
        a[q * 4 + 1] += h * w4.y;
        a[q * 4 + 2] += h * w4.z;
        a[q * 4 + 3] += h * w4.w;
      }
      if ((i & 3) == 3) asm volatile("" ::: "memory");
    }
#pragma unroll
    for (int o = 32; o; o >>= 1)
#pragma unroll
      for (int j = 0; j < 16; ++j) a[j] += __shfl_xor(a[j], o);
    float v = a[0];
#pragma unroll
    for (int j = 1; j < 16; ++j) v = (lane == j) ? a[j] : v;
    if (lane < 16) out[(long)tok * 16 + lane] = v;
  }
  __syncthreads();
}

DI void ph_dncl(const Prm& p, int li, char* smem) {
  const int tid = mytid(), lane = tid & 63, wid = tid >> 6, fr = lane & 15, fq = lane >> 4;
  u16* qn = (u16*)smem;
  u16* kn = qn + 64 * 144;
  float* fb = (float*)(smem + 36864);
  float* KK = fb;
  float* QK = KK + 64 * 65;
  float* Am = QK + 64 * 65;
  float* Tm = Am + 2 * 64 * 65;
  float* gcs = Tm + 2 * 64 * 65;
  float* bts = gcs + 128;
  const u16* PD = (const u16*)(p.ws + OFF_AR);
  const float* AB = (const float*)(p.ws + OFF_PDAB);
  u16* DQ = (u16*)(p.ws + OFF_Y);
  u16* DK = DQ + 18874368L;
  u16* DV = DK + 18874368L;
  u16* CL = (u16*)(p.ws + OFF_AR + 3 * U38);
  float* GC = (float*)(p.ws + OFF_GC);
  float* BT = (float*)(p.ws + OFF_BETA);
  const float* cw = p.dn_conv + (long)li * 3 * 1536;
  for (int it = mybid(); it < 2304; it += gridDim.x) {
    const int b = it / 144, r0 = it % 144, oc = r0 >> 2, h = r0 & 3;
    const int pos0 = oc * 64, s0 = oc < 4 ? 0 : 256, e0 = oc < 4 ? 256 : 2304;
    if (tid < 384) {
      const int cgp = tid % 48, rs = tid / 48;
      const int part = cgp >> 4, d0 = (cgp & 15) * 8, col = part * 512 + h * 128 + d0;
      const u16* basep = PD + (long)tokof(b, pos0) * 1536 + col;
      float wt[3][8];
#pragma unroll
      for (int tp = 0; tp < 3; ++tp) {
        float4 wa = *(const float4*)(cw + tp * 1536 + col), wb = *(const float4*)(cw + tp * 1536 + col + 4);
        wt[tp][0] = wa.x; wt[tp][1] = wa.y; wt[tp][2] = wa.z; wt[tp][3] = wa.w;
        wt[tp][4] = wb.x; wt[tp][5] = wb.y; wt[tp][6] = wb.z; wt[tp][7] = wb.w;
      }
#pragma unroll 1
      for (int hf = 0; hf < 2; ++hf) {
        u32x4 rw[6];
#pragma unroll
        for (int i = 0; i < 6; ++i) {
          int j = rs * 8 + hf * 4 - 1 + i, P = pos0 + j;
          rw[i] = (P >= s0 && P < e0) ? *(const u32x4*)(basep + (long)j * 1536) : u32x4{0u, 0u, 0u, 0u};
        }
#pragma unroll
        for (int r = 0; r < 4; ++r) {
#pragma unroll
          for (int e = 0; e < 8; ++e) {
            unsigned w0_ = rw[r][e >> 1], w1_ = rw[r + 1][e >> 1], w2_ = rw[r + 2][e >> 1];
            float x0 = (e & 1) ? __uint_as_float(w0_ & 0xffff0000u) : __uint_as_float(w0_ << 16);
            float x1 = (e & 1) ? __uint_as_float(w1_ & 0xffff0000u) : __uint_as_float(w1_ << 16);
            float x2 = (e & 1) ? __uint_as_float(w2_ & 0xffff0000u) : __uint_as_float(w2_ << 16);
            float v = wt[0][e] * x0 + wt[1][e] * x1 + wt[2][e] * x2;
            fb[(rs * 8 + hf * 4 + r) * 385 + part * 128 + d0 + e] = v / (1.f + __expf(-v));
          }
        }
      }
    }
    __syncthreads();
    for (int jj = 0; jj < 8; ++jj) {
      int j = wid * 8 + jj, P = pos0 + j;
      long go = ((long)(b * 4 + h) * 2304 + P) * 128;
      float q0 = fb[j * 385 + lane], q1 = fb[j * 385 + 64 + lane];
      float k0 = fb[j * 385 + 128 + lane], k1 = fb[j * 385 + 192 + lane];
      float v0 = fb[j * 385 + 256 + lane], v1 = fb[j * 385 + 320 + lane];
      float iq = rsqrtf(wsum(q0 * q0 + q1 * q1) + 1e-6f), ik = rsqrtf(wsum(k0 * k0 + k1 * k1) + 1e-6f);
      u16 a0 = f2bf(q0 * iq), a1 = f2bf(q1 * iq), c0 = f2bf(k0 * ik), c1 = f2bf(k1 * ik);
      qn[j * 144 + lane] = a0; qn[j * 144 + 64 + lane] = a1;
      kn[j * 144 + lane] = c0; kn[j * 144 + 64 + lane] = c1;
      DQ[go + lane] = a0; DQ[go + 64 + lane] = a1;
      DK[go + lane] = c0; DK[go + 64 + lane] = c1;
      DV[go + lane] = f2bf(v0); DV[go + 64 + lane] = f2bf(v1);
    }
    __syncthreads();
#pragma unroll
    for (int u = 0; u < 4; ++u) {
      int tt = wid * 4 + u, which = tt >> 4, ti = (tt >> 2) & 3, tj = tt & 3;
      const u16* Ap = (which ? qn : kn) + (ti * 16 + fr) * 144 + fq * 8;
      const u16* Bp = kn + (tj * 16 + fr) * 144 + fq * 8;
      f32x4 a = {0.f, 0.f, 0.f, 0.f};
#pragma unroll
      for (int ks = 0; ks < 4; ++ks) a = MFMA(*(const bf16x8*)(Ap + ks * 32), *(const bf16x8*)(Bp + ks * 32), a);
      float* dst = which ? QK : KK;
#pragma unroll
      for (int j = 0; j < 4; ++j) dst[(ti * 16 + fq * 4 + j) * 65 + tj * 16 + fr] = a[j];
    }
    if (tid < 128) {
      int d = tid >> 6, r = tid & 63, j = d ? 63 - r : r;
      int tok = tokof(b, pos0 + j);
      float av = AB[(long)tok * 16 + d * 4 + h], bv = AB[(long)tok * 16 + 8 + d * 4 + h];
      float xx = av + p.dn_dt_bias[li * 8 + d * 4 + h];
      float sp = fmaxf(xx, 0.f) + __logf(1.f + __expf(-fabsf(xx)));
      float g = -expf(p.dn_a_log[li * 8 + d * 4 + h]) * sp;
      for (int o = 1; o < 64; o <<= 1) {
        float t = __shfl_up(g, o);
        if (r >= o) g += t;
      }
      float be = 1.f / (1.f + expf(-bv));
      gcs[d * 64 + r] = g;
      bts[d * 64 + r] = be;
      long ci = ((long)((b * 4 + h) * 2 + d) * 36 + oc) * 64 + r;
      GC[ci] = g;
      BT[ci] = be;
    }
    __syncthreads();
#pragma unroll 4
    for (int e = tid; e < 8192; e += 512) {
      int d = e >> 12, s = (e >> 6) & 63, r = e & 63;
      int j = d ? 63 - r : r, js = d ? 63 - s : s;
      float v = 0.f;
      if (r > s) v = bts[d * 64 + r] * KK[j * 65 + js] * expf(gcs[d * 64 + r] - gcs[d * 64 + s]);
      Am[(d * 64 + s) * 64 + r] = v;
    }
#pragma unroll 4
    for (int e = tid; e < 8192; e += 512) {
      int d = e >> 12, r = (e >> 6) & 63, s = e & 63;
      int j = d ? 63 - r : r, js = d ? 63 - s : s;
      float dec = (r >= s) ? expf(gcs[d * 64 + r] - gcs[d * 64 + s]) : 0.f;
      long ci = (long)((b * 4 + h) * 2 + d) * 36 + oc;
      CL[ci * 8192 + 4096 + r * 64 + s] = f2bf(QK[j * 65 + js] * dec * 0.08838834764831845f);
    }
    __syncthreads();
    {
      const int d = tid >> 8, c = (tid >> 2) & 63, q = tid & 3;
      const float* Atq = Am + d * 64 * 64 + q;
      float* T = Tm + d * 64 * 65;
      float t[16];
#pragma unroll
      for (int i = 0; i < 16; ++i) t[i] = (4 * i + q == c) ? 1.f : 0.f;
#pragma unroll
      for (int s2 = 0; s2 < 63; ++s2) {
        constexpr int dummy = 0;
        const int is = s2 >> 2, qs = s2 & 3;
        const int ctl = qs | (qs << 2) | (qs << 4) | (qs << 6);
        int tsb;
        if (qs == 0) tsb = __builtin_amdgcn_update_dpp(0, __float_as_int(t[is]), 0x00, 0xf, 0xf, false);
        else if (qs == 1) tsb = __builtin_amdgcn_update_dpp(0, __float_as_int(t[is]), 0x55, 0xf, 0xf, false);
        else if (qs == 2) tsb = __builtin_amdgcn_update_dpp(0, __float_as_int(t[is]), 0xAA, 0xf, 0xf, false);
        else tsb = __builtin_amdgcn_update_dpp(0, __float_as_int(t[is]), 0xFF, 0xf, 0xf, false);
        (void)ctl; (void)dummy;
        const float ts = __int_as_float(tsb);
#pragma unroll
        for (int i = is; i < 16; ++i) t[i] -= Atq[s2 * 64 + 4 * i] * ts;
        if ((s2 & 7) == 7) asm volatile("" ::: "memory");
      }
#pragma unroll
      for (int i = 0; i < 16; ++i) T[(4 * i + q) * 65 + c] = t[i];
    }
    __syncthreads();
    for (int e = tid; e < 8192; e += 512) {
      int d = e >> 12, rc = e & 4095;
      long ci = (long)((b * 4 + h) * 2 + d) * 36 + oc;
      CL[ci * 8192 + rc] = f2bf(Tm[(d * 64 + (rc >> 6)) * 65 + (rc & 63)]);
    }
    __syncthreads();
  }
}

DI void ph_dnscan(const Prm& p, char* smem) {
  const int tid = mytid(), lane = tid & 63, wid = tid >> 6, fr = lane & 15, fq = lane >> 4;
  u16* Kg = (u16*)smem;
  u16* Qg = Kg + 64 * 144;
  u16* KdT = Qg + 64 * 144;
  u16* Tl = KdT + 128 * 80;
  u16* Il = Tl + 64 * 80;
  u16* ST = Il + 64 * 80;
  u16* RT = ST + 64 * 144;
  u16* VN = RT + 64 * 80;
  const u16* DQ = (const u16*)(p.ws + OFF_Y);
  const u16* DK = DQ + 18874368L;
  const u16* DV = DK + 18874368L;
  const u16* CL = (const u16*)(p.ws + OFF_AR + 3 * U38);
  const float* GC = (const float*)(p.ws + OFF_GC);
  const float* BT = (const float*)(p.ws + OFF_BETA);
  const int vt = wid & 3, rp = wid >> 2;
  for (int it = mybid(); it < 256; it += gridDim.x) {
    const int b = it >> 4, h = (it >> 2) & 3, d = (it >> 1) & 1, vs = it & 1;
    u16* O = (u16*)(p.ws + OFF_AR + (d ? 6 : 5) * U38);
    f32x4 S[4];
#pragma unroll
    for (int i = 0; i < 4; ++i) S[i] = f32x4{0.f, 0.f, 0.f, 0.f};
    for (int e = tid; e < 64 * 144; e += 512) ST[e] = 0;
    const long seqb = (long)(b * 4 + h) * 2304;
    const long cib = (long)((b * 4 + h) * 2 + d) * 36;
    u32x4 rk0, rk1, rq0, rq1, rT, rI;
    float rg0, rg1, rgl;
    uint2 rv0, rv1;
    float rb0, rb1;
    const int lr0 = tid >> 4, lr1 = (tid + 512) >> 4, lch = tid & 15;
    const int lj0 = d ? 63 - lr0 : lr0, lj1 = d ? 63 - lr1 : lr1;
    const int vr0 = (rp * 2) * 16 + fr, vr1 = (rp * 2 + 1) * 16 + fr;
    const int vj0 = d ? 63 - vr0 : vr0, vj1 = d ? 63 - vr1 : vr1;
#define SCAN_LOAD_KQ(ocx)                                                                    \
  {                                                                                          \
    const long ci_ = cib + (ocx);                                                            \
    const long g0_ = (seqb + (ocx) * 64 + lj0) * 128 + lch * 8, g1_ = (seqb + (ocx) * 64 + lj1) * 128 + lch * 8; \
    rk0 = *(const u32x4*)(DK + g0_); rk1 = *(const u32x4*)(DK + g1_);                        \
    rq0 = *(const u32x4*)(DQ + g0_); rq1 = *(const u32x4*)(DQ + g1_);                        \
    rT = *(const u32x4*)(CL + ci_ * 8192 + (tid >> 3) * 64 + (tid & 7) * 8);                 \
    rI = *(const u32x4*)(CL + ci_ * 8192 + 4096 + (tid >> 3) * 64 + (tid & 7) * 8);          \
    rg0 = GC[ci_ * 64 + lr0]; rg1 = GC[ci_ * 64 + lr1]; rgl = GC[ci_ * 64 + 63];             \
  }
#define SCAN_LOAD_V(ocx)                                                                     \
  {                                                                                          \
    const long ci_ = cib + (ocx);                                                            \
    rv0 = *(const uint2*)(DV + (seqb + (ocx) * 64 + vj0) * 128 + vs * 64 + vt * 16 + fq * 4); \
    rv1 = *(const uint2*)(DV + (seqb + (ocx) * 64 + vj1) * 128 + vs * 64 + vt * 16 + fq * 4); \
    rb0 = BT[ci_ * 64 + vr0]; rb1 = BT[ci_ * 64 + vr1];                                      \
  }
    {
      const int oc0 = d ? 3 : 0;
      SCAN_LOAD_KQ(oc0);
      SCAN_LOAD_V(oc0);
    }
    for (int i = 0; i < 36; ++i) {
      const int oc = d ? (i < 4 ? 3 - i : 39 - i) : i;
      const int ocn = d ? (i + 1 < 4 ? 3 - (i + 1) : 39 - (i + 1)) : i + 1;
      const int pos0 = oc * 64;
      const float gl = rgl;
      {
        float eg0 = __expf(rg0), ed0 = __expf(gl - rg0), eg1 = __expf(rg1), ed1 = __expf(gl - rg1);
        u32x4 ko0, qo0, ko1, qo1;
#pragma unroll
        for (int w = 0; w < 4; ++w) {
          float k0l = __uint_as_float(rk0[w] << 16), k0h = __uint_as_float(rk0[w] & 0xffff0000u);
          float q0l = __uint_as_float(rq0[w] << 16), q0h = __uint_as_float(rq0[w] & 0xffff0000u);
          float k1l = __uint_as_float(rk1[w] << 16), k1h = __uint_as_float(rk1[w] & 0xffff0000u);
          float q1l = __uint_as_float(rq1[w] << 16), q1h = __uint_as_float(rq1[w] & 0xffff0000u);
          ko0[w] = (unsigned)f2bf(k0l * eg0) | ((unsigned)f2bf(k0h * eg0) << 16);
          qo0[w] = (unsigned)f2bf(q0l * eg0 * 0.08838834764831845f) | ((unsigned)f2bf(q0h * eg0 * 0.08838834764831845f) << 16);
          ko1[w] = (unsigned)f2bf(k1l * eg1) | ((unsigned)f2bf(k1h * eg1) << 16);
          qo1[w] = (unsigned)f2bf(q1l * eg1 * 0.08838834764831845f) | ((unsigned)f2bf(q1h * eg1 * 0.08838834764831845f) << 16);
          KdT[(lch * 8 + 2 * w) * 80 + lr0] = f2bf(k0l * ed0);
          KdT[(lch * 8 + 2 * w + 1) * 80 + lr0] = f2bf(k0h * ed0);
          KdT[(lch * 8 + 2 * w) * 80 + lr1] = f2bf(k1l * ed1);
          KdT[(lch * 8 + 2 * w + 1) * 80 + lr1] = f2bf(k1h * ed1);
        }
        *(u32x4*)(Kg + lr0 * 144 + lch * 8) = ko0;
        *(u32x4*)(Qg + lr0 * 144 + lch * 8) = qo0;
        *(u32x4*)(Kg + lr1 * 144 + lch * 8) = ko1;
        *(u32x4*)(Qg + lr1 * 144 + lch * 8) = qo1;
        *(u32x4*)(Tl + (tid >> 3) * 80 + (tid & 7) * 8) = rT;
        *(u32x4*)(Il + (tid >> 3) * 80 + (tid & 7) * 8) = rI;
      }
      lds_barrier();
      if (i + 1 < 36) SCAN_LOAD_KQ(ocn);
      f32x4 ks_[2], qs_[2];
#pragma unroll
      for (int u = 0; u < 2; ++u) { ks_[u] = f32x4{0.f, 0.f, 0.f, 0.f}; qs_[u] = f32x4{0.f, 0.f, 0.f, 0.f}; }
#pragma unroll
      for (int kk = 0; kk < 4; ++kk) {
        bf16x8 a = *(const bf16x8*)(ST + (vt * 16 + fr) * 144 + kk * 32 + fq * 8);
#pragma unroll
        for (int u = 0; u < 2; ++u) {
          int rt = rp * 2 + u;
          bf16x8 bk = *(const bf16x8*)(Kg + (rt * 16 + fr) * 144 + kk * 32 + fq * 8);
          bf16x8 bq = *(const bf16x8*)(Qg + (rt * 16 + fr) * 144 + kk * 32 + fq * 8);
          ks_[u] = MFMA(a, bk, ks_[u]);
          qs_[u] = MFMA(a, bq, qs_[u]);
        }
      }
      {
        int v0 = vt * 16 + fq * 4;
        RT[(v0 + 0) * 80 + vr0] = f2bf(rb0 * (__uint_as_float(rv0.x << 16) - ks_[0][0]));
        RT[(v0 + 1) * 80 + vr0] = f2bf(rb0 * (__uint_as_float(rv0.x & 0xffff0000u) - ks_[0][1]));
        RT[(v0 + 2) * 80 + vr0] = f2bf(rb0 * (__uint_as_float(rv0.y << 16) - ks_[0][2]));
        RT[(v0 + 3) * 80 + vr0] = f2bf(rb0 * (__uint_as_float(rv0.y & 0xffff0000u) - ks_[0][3]));
        RT[(v0 + 0) * 80 + vr1] = f2bf(rb1 * (__uint_as_float(rv1.x << 16) - ks_[1][0]));
        RT[(v0 + 1) * 80 + vr1] = f2bf(rb1 * (__uint_as_float(rv1.x & 0xffff0000u) - ks_[1][1]));
        RT[(v0 + 2) * 80 + vr1] = f2bf(rb1 * (__uint_as_float(rv1.y << 16) - ks_[1][2]));
        RT[(v0 + 3) * 80 + vr1] = f2bf(rb1 * (__uint_as_float(rv1.y & 0xffff0000u) - ks_[1][3]));
      }
      if (i + 1 < 36) SCAN_LOAD_V(ocn);
      lds_barrier();
      {
        f32x4 vn[2];
#pragma unroll
        for (int u = 0; u < 2; ++u) vn[u] = f32x4{0.f, 0.f, 0.f, 0.f};
#pragma unroll
        for (int kk = 0; kk < 2; ++kk) {
          bf16x8 a = *(const bf16x8*)(RT + (vt * 16 + fr) * 80 + kk * 32 + fq * 8);
#pragma unroll
          for (int u = 0; u < 2; ++u) {
            bf16x8 bb = *(const bf16x8*)(Tl + ((rp * 2 + u) * 16 + fr) * 80 + kk * 32 + fq * 8);
            vn[u] = MFMA(a, bb, vn[u]);
          }
        }
#pragma unroll
        for (int u = 0; u < 2; ++u) {
          int r = (rp * 2 + u) * 16 + fr, v0 = vt * 16 + fq * 4;
#pragma unroll
          for (int j = 0; j < 4; ++j) VN[(v0 + j) * 80 + r] = f2bf(vn[u][j]);
        }
      }
      lds_barrier();
#pragma unroll
      for (int kk = 0; kk < 2; ++kk) {
        bf16x8 a = *(const bf16x8*)(VN + (vt * 16 + fr) * 80 + kk * 32 + fq * 8);
#pragma unroll
        for (int u = 0; u < 2; ++u) {
          bf16x8 bb = *(const bf16x8*)(Il + ((rp * 2 + u) * 16 + fr) * 80 + kk * 32 + fq * 8);
          qs_[u] = MFMA(a, bb, qs_[u]);
        }
      }
#pragma unroll
      for (int u = 0; u < 2; ++u) {
        int r = (rp * 2 + u) * 16 + fr, j = d ? 63 - r : r;
        u16* op = O + (long)tokof(b, pos0 + j) * 512 + h * 128 + vs * 64 + vt * 16 + fq * 4;
        ushort4 ov4;
        ov4.x = f2bf(qs_[u][0]); ov4.y = f2bf(qs_[u][1]); ov4.z = f2bf(qs_[u][2]); ov4.w = f2bf(qs_[u][3]);
        *(ushort4*)op = ov4;
      }
      {
        float ge = __expf(gl);
#pragma unroll
        for (int u = 0; u < 4; ++u) S[u] *= ge;
#pragma unroll
        for (int kk = 0; kk < 2; ++kk) {
          bf16x8 a = *(const bf16x8*)(VN + (vt * 16 + fr) * 80 + kk * 32 + fq * 8);
#pragma unroll
          for (int u = 0; u < 4; ++u) {
            bf16x8 bb = *(const bf16x8*)(KdT + ((rp * 4 + u) * 16 + fr) * 80 + kk * 32 + fq * 8);
            S[u] = MFMA(a, bb, S[u]);
          }
        }
#pragma unroll
        for (int u = 0; u < 4; ++u) {
          int dd = (rp * 4 + u) * 16 + fr, v0 = vt * 16 + fq * 4;
#pragma unroll
          for (int j = 0; j < 4; ++j) ST[(v0 + j) * 144 + dd] = f2bf(S[u][j]);
        }
      }
      lds_barrier();
    }
#undef SCAN_LOAD_KQ
#undef SCAN_LOAD_V
  }
}

DI void ph_dnfin(const Prm& p, int li) {
  const int lane = mytid() & 63;
  const int gw = mybid() * 8 + (mytid() >> 6), nw = gridDim.x * 8;
  const u16* O = (const u16*)(p.ws + OFF_AR + 5 * U38);
  const u16* O2 = (const u16*)(p.ws + OFF_AR + 6 * U38);
  u16* Z = (u16*)(p.ws + OFF_Y + 3 * U38);
  const float n0 = p.dn_norm[li * 128 + lane * 2], n1 = p.dn_norm[li * 128 + lane * 2 + 1];
#pragma unroll 2
  for (int tok = gw; tok < T_ALL; tok += nw) {
    ushort2 oa[4], ob[4], zz[4];
    float ox[4], oy[4], ss[4];
#pragma unroll
    for (int h = 0; h < 4; ++h) {
      long o = (long)tok * 512 + h * 128 + lane * 2;
      oa[h] = *(const ushort2*)(O + o);
      ob[h] = *(const ushort2*)(O2 + o);
      zz[h] = *(const ushort2*)(Z + o);
    }
#pragma unroll
    for (int h = 0; h < 4; ++h) {
      ox[h] = bf2f(oa[h].x) + bf2f(ob[h].x);
      oy[h] = bf2f(oa[h].y) + bf2f(ob[h].y);
      ss[h] = ox[h] * ox[h] + oy[h] * oy[h];
    }
#pragma unroll
    for (int o = 32; o; o >>= 1)
#pragma unroll
      for (int h = 0; h < 4; ++h) ss[h] += __shfl_xor(ss[h], o);
#pragma unroll
    for (int h = 0; h < 4; ++h) {
      float inv = rsqrtf(ss[h] * (1.f / 128.f) + 1e-6f);
      float z0 = bf2f(zz[h].x), z1 = bf2f(zz[h].y);
      ushort2 y;
      y.x = f2bf(ox[h] * inv * n0 * (z0 / (1.f + __expf(-z0))));
      y.y = f2bf(oy[h] * inv * n1 * (z1 / (1.f + __expf(-z1))));
      *(ushort2*)(Z + (long)tok * 512 + h * 128 + lane * 2) = y;
    }
  }
}

DI void ph_aprep(const Prm& p, int li) {
  const int lane = mytid() & 63;
  const int gw = mybid() * 8 + (mytid() >> 6), nw = gridDim.x * 8;
  const u16* PA = (const u16*)(p.ws + OFF_AR);
  u16* QH = (u16*)(p.ws + OFF_AR + 3 * U38);
  u16* KH = QH + 18874368L;
  const int f = lane & 15;
  const float inv_f = powf(10000.f, -(float)f / 16.f);
  for (int tok = gw; tok < T_ALL; tok += nw) {
    int b, P;
    float cs = 1.f, sn = 0.f;
    if (tok < T_LAT) {
      b = tok >> 11;
      int l = tok & 2047;
      P = 256 + l;
      float pos = (lane < 32) ? (float)(l >> 6) : (float)(l & 63);
      float ang = pos * inv_f;
      cs = cosf(ang);
      sn = sinf(ang);
    } else {
      b = (tok - T_LAT) >> 8;
      P = (tok - T_LAT) & 255;
    }
    float xv[16], ssq[16];
#pragma unroll
    for (int g = 0; g < 16; ++g) {
      xv[g] = bf2f(PA[(long)tok * 1024 + g * 64 + lane]);
      ssq[g] = xv[g] * xv[g];
    }
#pragma unroll
    for (int o = 32; o; o >>= 1)
#pragma unroll
      for (int g = 0; g < 16; ++g) ssq[g] += __shfl_xor(ssq[g], o);
#pragma unroll
    for (int g = 0; g < 16; ++g) {
      int which = g >> 3, h = (g >> 1) & 3, c = g & 1;
      float inv = rsqrtf(ssq[g] * (1.f / 64.f) + 1e-6f);
      float y = xv[g] * inv * p.qk_gain[(li * 2 + which) * 64 + lane];
      float pr = __shfl_xor(y, 16);
      float o = (lane & 16) ? (y * cs + pr * sn) : (y * cs - pr * sn);
      if (which == 0) o *= 0.18033688011112042f;
      u16* dst = (which ? KH : QH) + ((long)((b * 4 + h) * 2 + c) * 2304 + P) * 64 + lane;
      *dst = f2bf(o);
    }
  }
}

DI void ph_attn(const Prm& p, int li, long base, char* smem) {
  const int tid = mytid(), lane = tid & 63, wid = tid >> 6, fr = lane & 15, fq = lane >> 4;
  const u16* QH = (const u16*)(p.ws + OFF_AR + 3 * U38);
  const u16* KH = QH + 18874368L;
  const u16* VT = (const u16*)(p.ws + OFF_AR + 5 * U38);
  u16* YA = (u16*)(p.ws + OFF_Y);
  u16* s = (u16*)smem;
  constexpr int STG = 128 * 80 + 128 * 72;
  const float lambda_init = 0.8f - 0.6f * expf(-0.3f * (float)li);
  float lamv, mshift;
  {
    const float* lv = p.lam + li * 256;
    float a = wsum(lv[lane] * lv[64 + lane]), b2 = wsum(lv[128 + lane] * lv[192 + lane]);
    lamv = expf(a) - expf(b2) + lambda_init;
    float gq = wmax(fabsf(p.qk_gain[(li * 2) * 64 + lane])), gk = wmax(fabsf(p.qk_gain[(li * 2 + 1) * 64 + lane]));
    mshift = 8.f * gq * gk * 1.4426950408889634f;
  }
  for (int it = first_item(base); it < (li == 3 ? 1024 : 1152); it += gridDim.x) {
    int b, h, qp0, nkeys;
    if (it < 1024) { b = it >> 6; h = (it >> 4) & 3; qp0 = 256 + (it & 15) * 128; nkeys = 2304; }
    else { int i2 = it - 1024; b = i2 >> 3; h = (i2 >> 1) & 3; qp0 = (i2 & 1) * 128; nkeys = 256; }
    const long kb0 = (long)((b * 4 + h) * 2) * 2304;
    bf16x8 qf[2][2];
#pragma unroll
    for (int c = 0; c < 2; ++c)
#pragma unroll
      for (int ks = 0; ks < 2; ++ks)
        qf[c][ks] = *(const bf16x8*)(QH + (kb0 + (long)c * 2304 + qp0 + wid * 16 + fr) * 64 + ks * 32 + fq * 8);
    f32x4 O0[8], O1[8];
#pragma unroll
    for (int i = 0; i < 8; ++i) { O0[i] = f32x4{0.f, 0.f, 0.f, 0.f}; O1[i] = f32x4{0.f, 0.f, 0.f, 0.f}; }
    f32x4 L0 = {0.f, 0.f, 0.f, 0.f}, L1 = {0.f, 0.f, 0.f, 0.f};
    const bf16x8 ones = {0x3F80, 0x3F80, 0x3F80, 0x3F80, 0x3F80, 0x3F80, 0x3F80, 0x3F80};
    uint4 rk[2], rv[2];
    const int nt = nkeys >> 6;
#pragma unroll
    for (int u = 0; u < 2; ++u) {
      int id = tid + u * 512;
      int c = id >> 9, key = (id >> 3) & 63, ch = id & 7;
      rk[u] = *(const uint4*)(KH + (kb0 + (long)c * 2304 + key) * 64 + ch * 8);
      int dv = id >> 3;
      rv[u] = *(const uint4*)(VT + ((long)(b * 512 + h * 128 + dv)) * 2304 + ch * 8);
    }
#pragma unroll
    for (int u = 0; u < 2; ++u) {
      int id = tid + u * 512;
      *(uint4*)(s + (id >> 3) * 80 + (id & 7) * 8) = rk[u];
      *(uint4*)(s + 128 * 80 + (id >> 3) * 72 + (id & 7) * 8) = rv[u];
    }
    lds_barrier();
    for (int t = 0; t < nt; ++t) {
      const bool more = t + 1 < nt;
      if (more) {
        int kp0 = (t + 1) * 64;
#pragma unroll
        for (int u = 0; u < 2; ++u) {
          int id = tid + u * 512;
          int c = id >> 9, key = (id >> 3) & 63, ch = id & 7;
          rk[u] = *(const uint4*)(KH + (kb0 + (long)c * 2304 + kp0 + key) * 64 + ch * 8);
          int dv = id >> 3;
          rv[u] = *(const uint4*)(VT + ((long)(b * 512 + h * 128 + dv)) * 2304 + kp0 + ch * 8);
        }
      }
      const u16* ks_ = s + (t & 1) * STG;
      const u16* vs_ = ks_ + 128 * 80;
      bf16x8 pf[2][2];
#pragma unroll
      for (int c = 0; c < 2; ++c) {
#pragma unroll
        for (int kk2 = 0; kk2 < 2; ++kk2) {
          u32x4 pw;
#pragma unroll
          for (int hh = 0; hh < 2; ++hh) {
            const int k4 = kk2 * 2 + hh;
            f32x4 a = {-mshift, -mshift, -mshift, -mshift};
#pragma unroll
            for (int kk = 0; kk < 2; ++kk)
              a = MFMA(*(const bf16x8*)(ks_ + (c * 64 + k4 * 16 + fr) * 80 + kk * 32 + fq * 8), qf[c][kk], a);
            pw[hh * 2 + 0] = pk_bf16(__builtin_amdgcn_exp2f(a[0]), __builtin_amdgcn_exp2f(a[1]));
            pw[hh * 2 + 1] = pk_bf16(__builtin_amdgcn_exp2f(a[2]), __builtin_amdgcn_exp2f(a[3]));
          }
          pf[c][kk2] = *(bf16x8*)&pw;
        }
      }
#pragma unroll
      for (int kk = 0; kk < 2; ++kk) {
        L0 = MFMA(ones, pf[0][kk], L0);
        L1 = MFMA(ones, pf[1][kk], L1);
      }
#pragma unroll
      for (int dt = 0; dt < 8; ++dt) {
#pragma unroll
        for (int kk = 0; kk < 2; ++kk) {
          const u16* vp = vs_ + (dt * 16 + fr) * 72 + kk * 32 + fq * 4;
          uint2 lo = *(const uint2*)vp, hi = *(const uint2*)(vp + 16);
          uint4 av = {lo.x, lo.y, hi.x, hi.y};
          bf16x8 a = *(bf16x8*)&av;
          O0[dt] = MFMA(a, pf[0][kk], O0[dt]);
          O1[dt] = MFMA(a, pf[1][kk], O1[dt]);
        }
      }
      if (more) {
        u16* ns = s + ((t + 1) & 1) * STG;
#pragma unroll
        for (int u = 0; u < 2; ++u) {
          int id = tid + u * 512;
          *(uint4*)(ns + (id >> 3) * 80 + (id & 7) * 8) = rk[u];
          *(uint4*)(ns + 128 * 80 + (id >> 3) * 72 + (id & 7) * 8) = rv[u];
        }
      }
      lds_barrier();
    }
    float i0 = 1.f / L0[0], i1 = lamv / L1[0], ss = 0.f;
#pragma unroll
    for (int dt = 0; dt < 8; ++dt)
#pragma unroll
      for (int j = 0; j < 4; ++j) {
        float o = O0[dt][j] * i0 - O1[dt][j] * i1;
        O0[dt][j] = o;
        ss += o * o;
      }
    ss += __shfl_xor(ss, 16); ss += __shfl_xor(ss, 32);
    float inv = rsqrtf(ss * (1.f / 128.f) + 1e-6f) * (1.f - lambda_init);
    int tok = tokof(b, qp0 + wid * 16 + fr);
#pragma unroll
    for (int dt = 0; dt < 8; ++dt) {
      int dv = dt * 16 + fq * 4;
      const float* sw = p.subln + li * 128 + dv;
      ushort4 o;
      o.x = f2bf(O0[dt][0] * inv * sw[0]);
      o.y = f2bf(O0[dt][1] * inv * sw[1]);
      o.z = f2bf(O0[dt][2] * inv * sw[2]);
      o.w = f2bf(O0[dt][3] * inv * sw[3]);
      *(ushort4*)(YA + (long)tok * 512 + h * 128 + dv) = o;
    }
  }
}

template <int L>
DI void hyena_item(const Prm& p, int li, int ch, char* smem) {
  constexpr int CS = 2 * L + 8;
  constexpr int ZS = L + 8;
  constexpr int MT = L / 128;
  constexpr int MG = MT > 8 ? 8 : MT, NG = MT / MG;
  const int tid = mytid(), lane = tid & 63, wid = tid >> 6, fr = lane & 15, fq = lane >> 4;
  u16* cp = (u16*)smem;
  u16* zr = cp + 8 * CS;
  const u16* PH = (const u16*)(p.ws + OFF_AR) + (L == 2048 ? 0L : 32768L * 1536);
  const u16* G = (const u16*)(p.ws + (L == 2048 ? OFF_TAPL : OFF_TAPC));
  u16* YB = (u16*)(p.ws + OFF_Y + U38);
  const float* cw = p.hy_conv + (long)li * 3 * 1536;
  {
    float w0 = cw[1024 + ch], w1 = cw[1536 + 1024 + ch], w2 = cw[3072 + 1024 + ch];
#pragma unroll 8
    for (int e = tid; e < 16 * L; e += 512) {
      int b = e / L, sidx = e % L;
      const u16* row = PH + ((long)b * 1536 + 1024 + ch) * L;
      float v = w1 * bf2f(row[sidx]);
      if (sidx > 0) v += w0 * bf2f(row[sidx - 1]);
      if (sidx + 1 < L) v += w2 * bf2f(row[sidx + 1]);
      zr[b * ZS + L - 1 - sidx] = f2bf(v);
    }
  }
#pragma unroll
  for (int order = 0; order < 2; ++order) {
    {
      const u16* g = G + (long)(order * 512 + ch) * (2 * L);
#pragma unroll 8
      for (int e = tid; e < 8 * 2 * L; e += 512) {
        int c = e / (2 * L), i = e % (2 * L);
        cp[c * CS + i] = (i + c < 2 * L) ? g[i + c] : (u16)0;
      }
    }
    __syncthreads();
    const float bias = p.hy_bias[(li * 2 + order) * 512 + ch];
    const int gcol = order * 512 + ch;
    const float w0 = cw[gcol], w1 = cw[1536 + gcol], w2 = cw[3072 + gcol];
    const int tq = wid * (L / 8) + fq * 4;
    const u16* xb = PH + ((long)fr * 1536 + gcol) * L + tq;
    const u16* zb = zr + fr * ZS + L - 1 - tq;
    unsigned zp[NG][MG][2];
#pragma unroll
    for (int grp = 0; grp < NG; ++grp) {
      f32x4 acc[MG];
#pragma unroll
      for (int m = 0; m < MG; ++m) acc[m] = f32x4{0.f, 0.f, 0.f, 0.f};
      const int tb = wid * (L / 8) + grp * MG * 16 + fr;
      if constexpr (MG == 8) {
        const int i00 = tb - fq * 8 - 7 + L, c0 = i00 & 7;
        const u16* ab = cp + c0 * CS + (i00 - c0);
        const u16* zbp = zr + fr * ZS + (L - 8 - fq * 8);
        bf16x8 W[16];
#pragma unroll 1
        for (int s0 = 0; s0 < L; s0 += 256) {
#pragma unroll
          for (int k = 0; k < 8; ++k) {
            const int sk = s0 + 32 * k;
            if (k == 0) {
#pragma unroll
              for (int m = 0; m < 8; ++m) W[m] = *(const bf16x8*)(ab + m * 16 - sk);
            }
            if (k < 7) {
              W[(16 - 2 * k - 2) & 15] = *(const bf16x8*)(ab - sk - 32);
              W[(16 - 2 * k - 1) & 15] = *(const bf16x8*)(ab - sk - 32 + 16);
            }
            bf16x8 bk = *(const bf16x8*)(zbp - sk);
#pragma unroll
            for (int m = 0; m < 8; ++m) acc[m] = MFMA(W[(m + 16 - 2 * k) & 15], bk, acc[m]);
          }
        }
      } else {
#pragma unroll 2
        for (int s0 = 0; s0 < L; s0 += 32) {
          bf16x8 bfr = *(const bf16x8*)(zr + fr * ZS + (L - 8 - s0 - fq * 8));
#pragma unroll
          for (int m = 0; m < MG; ++m) {
            int i0 = tb + m * 16 - s0 - fq * 8 - 7 + L;
            int c = i0 & 7;
            bf16x8 afr = *(const bf16x8*)(cp + c * CS + (i0 - c));
            acc[m] = MFMA(afr, bfr, acc[m]);
          }
        }
      }
#pragma unroll
      for (int m = 0; m < MG; ++m) {
        float r4[4];
#pragma unroll
        for (int j = 0; j < 4; ++j) {
          const int off = (grp * MG + m) * 16 + j;
          const int t = tq + off;
          float xa = bf2f(xb[off - 1]), xc = bf2f(xb[off]), xd = bf2f(xb[off + 1]);
          xa = (t > 0) ? xa : 0.f;
          xd = (t + 1 < L) ? xd : 0.f;
          float xg = w0 * xa + w1 * xc + w2 * xd;
          float zin = bf2f(zb[-off]);
          r4[j] = xg * (acc[m][j] + bias * zin);
        }
        zp[grp][m][0] = (unsigned)f2bf(r4[0]) | ((unsigned)f2bf(r4[1]) << 16);
        zp[grp][m][1] = (unsigned)f2bf(r4[2]) | ((unsigned)f2bf(r4[3]) << 16);
      }
    }
    __syncthreads();
#pragma unroll
    for (int grp = 0; grp < NG; ++grp)
#pragma unroll
      for (int m = 0; m < MG; ++m)
#pragma unroll
        for (int j = 0; j < 4; ++j) {
          int t = wid * (L / 8) + (grp * MG + m) * 16 + fq * 4 + j;
          u16 v = (u16)(zp[grp][m][j >> 1] >> ((j & 1) * 16));
          zr[fr * ZS + L - 1 - t] = v;
        }
  }
  __syncthreads();
  {
    u16* YBT = (u16*)(p.ws + OFF_AR + 5 * U38) + (L == 2048 ? 0L : 16L * 512 * 2048);
#pragma unroll 4
    for (int e = tid; e < 16 * L; e += 512) {
      int b = e / L, t = e % L;
      YBT[((long)b * 512 + ch) * L + t] = zr[b * ZS + L - 1 - t];
    }
  }
  __syncthreads();
}

DI long ph_ytrans(const Prm& p, long base, bool lastl, char* smem) {
  u16* tl = (u16*)smem;
  const u16* YBT = (const u16*)(p.ws + OFF_AR + 5 * U38);
  u16* YB = (u16*)(p.ws + OFF_Y + U38);
  const int tid = mytid(), G = gridDim.x;
  const int total = lastl ? 4096 : 4608;
  auto srcp = [&](int it) -> const u16* {
    if (it < 4096) {
      int b = it >> 8, ct = (it >> 5) & 7, lt = it & 31;
      return YBT + ((long)b * 512 + ct * 64 + (tid >> 3)) * 2048 + lt * 64 + (tid & 7) * 8;
    } else {
      int i2 = it - 4096, b = i2 >> 5, ct = (i2 >> 2) & 7, lt = i2 & 3;
      return YBT + 16L * 512 * 2048 + ((long)b * 512 + ct * 64 + (tid >> 3)) * 256 + lt * 64 + (tid & 7) * 8;
    }
  };
  int it = first_item(base);
  u32x4 v = {0u, 0u, 0u, 0u};
  if (it < total) v = *(const u32x4*)srcp(it);
  for (; it < total; it += G) {
    *(u32x4*)(tl + (tid >> 3) * 72 + (tid & 7) * 8) = v;
    __syncthreads();
    if (it + G < total) v = *(const u32x4*)srcp(it + G);
    long tok0;
    int ct;
    if (it < 4096) { int b = it >> 8, lt = it & 31; ct = (it >> 5) & 7; tok0 = (long)b * 2048 + lt * 64; }
    else { int i2 = it - 4096, b = i2 >> 5, lt = i2 & 3; ct = (i2 >> 2) & 7; tok0 = (long)T_LAT + b * 256 + lt * 64; }
    const int lrow = tid >> 3, cc = tid & 7;
    u32x4 o;
#pragma unroll
    for (int w = 0; w < 4; ++w) {
      unsigned lo = tl[(cc * 8 + 2 * w) * 72 + lrow], hi = tl[(cc * 8 + 2 * w + 1) * 72 + lrow];
      o[w] = lo | (hi << 16);
    }
    *(u32x4*)(YB + (tok0 + lrow) * 512 + ct * 64 + cc * 8) = o;
    __syncthreads();
  }
  return base + total;
}

DI void ph_merge(const Prm& p, char* smem, bool lastl) {
  const int tid = mytid(), lane = tid & 63, wid = tid >> 6;
  const int wm = wid >> 1, wn = wid & 1, fr = lane & 15, fq = lane >> 4;
  const u16* H = (const u16*)(p.ws + OFF_HBF);
  const u16* Y = (const u16*)(p.ws + OFF_Y);
  const u16* WG = (const u16*)(p.ws + OFF_WB) + WO_G;
  const u16* WBr = (const u16*)(p.ws + OFF_WB) + WO_B;
  u16* MG = (u16*)(p.ws + OFF_AR);
  const int NT = (lastl ? 256 : 288) * 8, G = gridDim.x;
  Stg r0, r1;
  bool pre = false;
  for (int t = mybid(); t < NT; t += G) {
    const int mt = t >> 3, nt = t & 7;
    const bool hn = t + G < NT;
    const int mt2 = (t + G) >> 3, nt2 = (t + G) & 7;
    f32x4 acc[2][4], g[2][4], y[2][4];
#pragma unroll
    for (int a = 0; a < 2; ++a)
#pragma unroll
      for (int b = 0; b < 4; ++b) acc[a][b] = f32x4{0.f, 0.f, 0.f, 0.f};
    const u16* gA = H + (long)mt * 128 * 1024;
    for (int n = 0; n < 4; ++n) {
      const u16* gB = WG + ((long)n * 1024 + nt * 128) * 1024;
      const u16* yA = Y + (long)n * (T_ALL * 512L) + (long)mt * 128 * 512;
      const u16* yB = WBr + ((long)n * 1024 + nt * 128) * 512;
      gemm_tile<2>(g, gA, 1024, gB, 1024, 1024, smem, r0, r1, pre, yA, 512, yB, 512);
      const u16* nxA = (n < 3) ? gA : (hn ? H + (long)mt2 * 128 * 1024 : nullptr);
      const u16* nxB = (n < 3) ? WG + ((long)(n + 1) * 1024 + nt * 128) * 1024 : WG + ((long)nt2 * 128) * 1024;
      gemm_tile<2>(y, yA, 512, yB, 512, 512, smem, r0, r1, true, nxA, 1024, nxB, 1024);
      pre = true;
#pragma unroll
      for (int a = 0; a < 2; ++a)
#pragma unroll
        for (int b = 0; b < 4; ++b)
#pragma unroll
          for (int j = 0; j < 4; ++j) acc[a][b][j] += y[a][b][j] / (1.f + __expf(-g[a][b][j]));
    }
    pre = hn;
#pragma unroll
    for (int a = 0; a < 2; ++a)
#pragma unroll
      for (int b = 0; b < 4; ++b) {
        int r = wm * 32 + a * 16 + fr, c = wn * 64 + b * 16 + fq * 4;
        uint2 o;
        o.x = pk_bf16(acc[a][b][0], acc[a][b][1]);
        o.y = pk_bf16(acc[a][b][2], acc[a][b][3]);
        *(uint2*)(MG + ((long)mt * 128 + r) * 1024 + nt * 128 + c) = o;
      }
  }
}

DI void run_phase(const Prm& p, int ph, char* smem) {
  if (ph == 0) { ph_init(p, smem); return; }
  const int li = (ph - 1) / 14, k = (ph - 1) % 14;
  const u16* WB = (const u16*)(p.ws + OFF_WB);
  const u16* HB = (const u16*)(p.ws + OFF_HBF);
  const float* MOD = (const float*)(p.ws + OFF_MOD);
  u16* AR = (u16*)(p.ws + OFF_AR);
  u16* Yb = (u16*)(p.ws + OFF_Y);
  const int G = gridDim.x;
  TD d;
  d.split = 0; d.scale = 1.f; d.mode = 0; d.tok0 = 0; d.col0 = 0; d.g = MOD;
  switch (k) {
    case 0: {
      u16* W = (u16*)(p.ws + OFF_WB);
      long base = 0;
      base = tr_job(base, p.w_in + (long)li * 1024 * NIN, 1024, NIN, W + WO_IN, 1, smem);
      base = tr_job(base, p.w_gate + (long)li * 4 * 1048576, 1024, 1024, W + WO_G, 4, smem);
      base = tr_job(base, p.w_branch + (long)li * 4 * 524288, 512, 1024, W + WO_B, 4, smem);
      base = tr_job(base, p.w_o + (long)li * 1048576, 1024, 1024, W + WO_O, 1, smem);
      base = tr_job(base, p.w_mlp1 + (long)li * 4194304, 1024, 4096, W + WO_1, 1, smem);
      base = tr_job(base, p.w_mlp2 + (long)li * 4194304, 4096, 1024, W + WO_2, 1, smem);
      ph_taps1(p, li, base, smem);
      ph_norm(p, li, 0);
    } break;
    case 1: {
      auto dec = [&](int t, TD& o) {
        o.lda = 1024; o.ldb = 1024; o.K = 1024; o.mode = 0;
        if (t < 1728) {
          int mt = t / 12, nt = t % 12;
          o.A = HB + (long)mt * 256 * 1024; o.B = WB + WO_IN + (long)(3584 + nt * 128) * 1024;
          o.C = AR + (long)mt * 256 * 1536 + nt * 128; o.ldc = 1536;
        } else if (t < 2304) {
          int t2 = t - 1728, mt = t2 >> 2, nt = t2 & 3;
          o.A = HB + (long)mt * 256 * 1024; o.B = WB + WO_IN + (long)(5120 + nt * 128) * 1024;
          o.C = Yb + 3 * (U38 / 2) + (long)mt * 256 * 512 + nt * 128; o.ldc = 512;
        } else {
          int mt = t - 2304;
          o.A = HB + (long)mt * 256 * 1024; o.B = WB + WO_IN + (long)5632 * 1024;
          o.C = (u16*)((float*)(p.ws + OFF_PDAB) + (long)mt * 256 * 16); o.ldc = 16; o.mode = 3;
        }
      };
      {
        Stg r0, r1;
        bool pre = false;
        TD dn = d;
        int t = mybid();
        if (t < 2448) dec(t, d);
        for (; t < 2448; t += G) {
          const bool hn = t + G < 2448;
          if (hn) dec(t + G, dn);
          run_tile2(p, d, smem, r0, r1, pre, hn ? dn.A : nullptr, dn.lda, dn.B, dn.ldb);
          pre = hn;
          d = dn;
        }
      }
      ph_taps2(p, 2448, smem);
    } break;
    case 2: ph_dncl(p, li, smem); break;
    case 3: ph_dnscan(p, smem); break;
    case 4: {
      {
        Stg r0, r1;
        bool pre = false;
        for (int t = mybid(); t < 1152; t += G) {
          int mt = t >> 3, nt = t & 7;
          const bool hn = t + G < 1152;
          int mt2 = (t + G) >> 3, nt2 = (t + G) & 7;
          d.lda = 1024; d.ldb = 1024; d.K = 1024;
          d.A = HB + (long)mt * 256 * 1024; d.B = WB + WO_IN + (long)(nt * 128) * 1024;
          d.C = AR + 3 * (U38 / 2); d.ldc = 0; d.mode = 4; d.tok0 = mt * 256; d.col0 = nt;
          d.g = p.qk_gain + li * 128;
          run_tile2(p, d, smem, r0, r1, pre, hn ? HB + (long)mt2 * 256 * 1024 : nullptr, 1024,
                    WB + WO_IN + (long)(nt2 * 128) * 1024, 1024);
          pre = hn;
        }
      }
      ph_dnfin(p, li);
    } break;
    case 5: {
      u16* VT = AR + 5 * (U38 / 2);
      u16* PF = AR + 6 * (U38 / 2);
      auto dec = [&](int t, TD& o) {
        o.lda = 1024; o.ldb = 1024; o.K = 1024;
        if (t < 512) {
          int b = t >> 5, r = t & 31, mt = r >> 4, nt = r & 15;
          o.A = WB + WO_IN + (long)(1024 + mt * 256) * 1024; o.B = HB + ((long)b * 2048 + nt * 128) * 1024;
          o.C = VT + ((long)b * 512 + mt * 256) * 2304 + 256 + nt * 128; o.ldc = 2304;
        } else if (t < 576) {
          int t2 = t - 512, b = t2 >> 2, r = t2 & 3, mt = r >> 1, nt = r & 1;
          o.A = WB + WO_IN + (long)(1024 + mt * 256) * 1024; o.B = HB + ((long)T_LAT + b * 256 + nt * 128) * 1024;
          o.C = VT + ((long)b * 512 + mt * 256) * 2304 + nt * 128; o.ldc = 2304;
        } else {
          int t2 = t - 576, mt = t2 >> 2, nt = t2 & 3;
          o.A = HB + (long)mt * 256 * 1024; o.B = WB + WO_IN + (long)(3072 + nt * 128) * 1024;
          o.C = PF + (long)mt * 256 * 512 + nt * 128; o.ldc = 512;
        }
      };
      {
        Stg r0, r1;
        bool pre = false;
        TD dn = d;
        int t = mybid();
        if (t < 1152) dec(t, d);
        for (; t < 1152; t += G) {
          const bool hn = t + G < 1152;
          if (hn) dec(t + G, dn);
          run_tile2(p, d, smem, r0, r1, pre, hn ? dn.A : nullptr, dn.lda, dn.B, dn.ldb);
          pre = hn;
          d = dn;
        }
      }
    } break;
    case 6: {
      ph_attn(p, li, 0, smem);
      auto dec = [&](int t, TD& o) {
        o.lda = 1024; o.ldb = 1024; o.K = 1024;
        if (t < 1536) {
          int b = t / 96, r = t % 96, mt = r >> 4, nt = r & 15;
          o.A = WB + WO_IN + (long)(1536 + mt * 256) * 1024; o.B = HB + ((long)b * 2048 + nt * 128) * 1024;
          o.C = AR + ((long)b * 1536 + mt * 256) * 2048 + nt * 128; o.ldc = 2048;
        } else {
          int t2 = t - 1536, b = t2 / 12, r = t2 % 12, mt = r >> 1, nt = r & 1;
          o.A = WB + WO_IN + (long)(1536 + mt * 256) * 1024; o.B = HB + ((long)T_LAT + b * 256 + nt * 128) * 1024;
          o.C = AR + 32768L * 1536 + ((long)b * 1536 + mt * 256) * 256 + nt * 128; o.ldc = 256;
        }
      };
      {
        Stg r0, r1;
        bool pre = false;
        TD dn = d;
        int t = first_item(1152);
        if (t < 1728) dec(t, d);
        for (; t < 1728; t += G) {
          const bool hn = t + G < 1728;
          if (hn) dec(t + G, dn);
          run_tile2(p, d, smem, r0, r1, pre, hn ? dn.A : nullptr, dn.lda, dn.B, dn.ldb);
          pre = hn;
          d = dn;
        }
      }
    } break;
    case 7: {
#if !defined(TESTSEL) || TESTSEL == 1
      for (int it = mybid(); it < 512; it += G) hyena_item<2048>(p, li, it, smem);
#endif
#if !defined(TESTSEL) || TESTSEL == 2
      if (li < 3)
        for (int it = mybid(); it < 512; it += G) hyena_item<256>(p, li, it, smem);
#endif
#if !defined(TESTSEL) || TESTSEL == 3
      const u16* PF = AR + 6 * (U38 / 2);
      u16* WF = AR + 3 * (U38 / 2);
      const u16* DCm = (const u16*)(p.ws + OFF_DC);
      auto dec = [&](int t, TD& o) {
        o.A = DCm; o.lda = 128; o.ldb = 512; o.K = 128;
        if (t < 1024) {
          int bg = t >> 4, nt = t & 15, b = bg >> 2, g = bg & 3;
          o.B = PF + ((long)b * 2048 + nt * 128) * 512 + g * 128;
          o.C = WF + ((long)b * 512 + g * 128) * 4096 + nt * 128; o.ldc = 4096; o.split = 2048;
        } else {
          int t2 = t - 1024, bg = t2 >> 1, nt = t2 & 1, b = bg >> 2, g = bg & 3;
          o.B = PF + ((long)T_LAT + b * 256 + nt * 128) * 512 + g * 128;
          o.C = WF + 16L * 512 * 4096 + ((long)b * 512 + g * 128) * 512 + nt * 128; o.ldc = 512; o.split = 256;
        }
      };
      {
        const int NT7 = (li == 3 ? 1024 : 1152);
        Stg r0, r1;
        bool pre = false;
        TD dn = d;
        int t = mybid();
        if (t < NT7) dec(t, d);
        for (; t < NT7; t += G) {
          const bool hn = t + G < NT7;
          if (hn) dec(t + G, dn);
          run_tile2(p, d, smem, r0, r1, pre, hn ? dn.A : nullptr, dn.lda, dn.B, dn.ldb);
          pre = hn;
          d = dn;
        }
      }
#endif
    } break;
    case 8: {
      const u16* WF = AR + 3 * (U38 / 2);
      u16* YF = Yb + 2 * (U38 / 2);
      d.scale = 1.f / 512.f;
      for (int t = mybid(); t < (li == 3 ? 512 : 576); t += G) {
        if (t < 512) {
          int b = t >> 5, r = t & 31, mt = r >> 2, nt = r & 3;
          d.A = (const u16*)(p.ws + OFF_DL) + (long)mt * 256 * 4096; d.lda = 4096;
          d.B = WF + ((long)b * 512 + nt * 128) * 4096; d.ldb = 4096; d.K = 4096;
          d.C = YF + ((long)b * 2048 + mt * 256) * 512 + nt * 128; d.ldc = 512;
        } else {
          int t2 = t - 512, b = t2 >> 2, nt = t2 & 3;
          d.A = (const u16*)(p.ws + OFF_DLC); d.lda = 512;
          d.B = WF + 16L * 512 * 4096 + ((long)b * 512 + nt * 128) * 512; d.ldb = 512; d.K = 512;
          d.C = YF + ((long)T_LAT + b * 256) * 512 + nt * 128; d.ldc = 512;
        }
        run_tile(p, d, smem);
      }
      ph_ytrans(p, 576, li == 3, smem);
    } break;
    case 9: ph_merge(p, smem, li == 3); break;
    case 10: {
      d.mode = 2;
      const int NT10 = (li == 3 ? 1024 : 1152);
      Stg r0, r1;
      bool pre = false;
      for (int t = mybid(); t < NT10; t += G) {
        int mt = t >> 3, nt = t & 7;
        d.A = AR + (long)mt * 256 * 1024; d.lda = 1024; d.B = WB + WO_O + (long)nt * 128 * 1024; d.ldb = 1024; d.K = 1024;
        d.tok0 = mt * 256; d.col0 = nt * 128;
        int bb = d.tok0 < T_LAT ? (d.tok0 >> 11) : 16;
        d.g = MOD + ((long)li * 17 + bb) * 6144 + 2 * 1024;
        const bool hn = t + G < NT10;
        int mt2 = (t + G) >> 3, nt2 = (t + G) & 7;
        run_tile2(p, d, smem, r0, r1, pre, hn ? AR + (long)mt2 * 256 * 1024 : nullptr, 1024,
                  WB + WO_O + (long)nt2 * 128 * 1024, 1024);
        pre = hn;
      }
    } break;
    case 11: ph_norm(p, li, 1); break;
    case 12: {
      d.mode = 1;
      const int NT12 = (li == 3 ? 4096 : 4608);
      Stg r0, r1;
      bool pre = false;
      for (int t = mybid(); t < NT12; t += G) {
        int mt = t >> 5, nt = t & 31;
        d.A = HB + (long)mt * 256 * 1024; d.lda = 1024; d.B = WB + WO_1 + (long)nt * 128 * 1024; d.ldb = 1024; d.K = 1024;
        d.C = Yb + (long)mt * 256 * 4096 + nt * 128; d.ldc = 4096;
        const bool hn = t + G < NT12;
        int mt2 = (t + G) >> 5, nt2 = (t + G) & 31;
        run_tile2(p, d, smem, r0, r1, pre, hn ? HB + (long)mt2 * 256 * 1024 : nullptr, 1024,
                  WB + WO_1 + (long)nt2 * 128 * 1024, 1024);
        pre = hn;
      }
    } break;
    case 13: {
      d.mode = 2;
      for (int t = mybid(); t < (li == 3 ? 1024 : 1152); t += G) {
        int mt = t >> 3, nt = t & 7;
        d.A = Yb + (long)mt * 256 * 4096; d.lda = 4096; d.B = WB + WO_2 + (long)nt * 128 * 4096; d.ldb = 4096; d.K = 4096;
        d.tok0 = mt * 256; d.col0 = nt * 128;
        int bb = d.tok0 < T_LAT ? (d.tok0 >> 11) : 16;
        d.g = MOD + ((long)li * 17 + bb) * 6144 + 5 * 1024;
        run_tile(p, d, smem);
      }
    } break;
  }
}

extern __shared__ __attribute__((aligned(16))) char dyn_smem[];

__global__ void __launch_bounds__(512) mega(Prm p, int lo, int hi) {
#ifdef ONLYK
  run_phase(p, ONLYK, dyn_smem);
#else
  for (int ph = lo; ph <= hi; ++ph) {
    long z = 0;
    asm volatile("" : "+s"(z));
    Prm q;
#define LP(f) q.f = p.f + z
    LP(x); LP(c); LP(ctx); LP(c_ctx); LP(w_ada); LP(b_ada); LP(norm1); LP(norm2); LP(w_in); LP(qk_gain); LP(lam);
    LP(subln); LP(hy_conv); LP(hy_w1); LP(hy_b1); LP(hy_freq); LP(hy_w2); LP(hy_b2); LP(hy_w3); LP(hy_bias);
    LP(dn_conv); LP(dn_a_log); LP(dn_dt_bias); LP(dn_norm); LP(w_gate); LP(w_branch); LP(w_o); LP(w_mlp1); LP(w_mlp2);
    LP(out); LP(ws);
#undef LP
    run_phase(q, ph, dyn_smem);
#ifdef PROBEK
    if (ph > 0 && (ph - 1) % 14 == PROBEK) { cg::this_grid().sync(); run_phase(q, ph, dyn_smem); }
#endif
    if (ph < hi) cg::this_grid().sync();
  }
#endif
}

extern "C" void kernel_launch(void* const* d_in, const int* in_sizes, int n_in, void* d_out, int out_size, void* d_ws,
                              size_t ws_size, hipStream_t stream) {
  static int grid_blocks = 0;
  if (!grid_blocks) {
    hipFuncSetAttribute((const void*)mega, hipFuncAttributeMaxDynamicSharedMemorySize, LDS_BYTES);
    int dev = 0, cus = 0, per_cu = 0;
    hipGetDevice(&dev);
    hipDeviceGetAttribute(&cus, hipDeviceAttributeMultiprocessorCount, dev);
    hipOccupancyMaxActiveBlocksPerMultiprocessor(&per_cu, mega, 512, LDS_BYTES);
    if (per_cu < 1) per_cu = 1;
    grid_blocks = cus * per_cu;
    if (ws_size < (size_t)WS_TOTAL) fprintf(stderr, "workspace too small: %zu < %ld\n", ws_size, (long)WS_TOTAL);
  }
  Prm p;
  const float** pp = (const float**)&p;
  for (int i = 0; i < 29; ++i) pp[i] = (const float*)d_in[i];
  p.out = (float*)d_out;
  p.ws = (char*)d_ws;
#if MULTI
  for (int ph = 0; ph < NPHASE; ++ph) hipLaunchKernelGGL(mega, dim3(grid_blocks), dim3(512), LDS_BYTES, stream, p, ph, ph);
#else
  int lo = 0, hi = NPHASE - 1;
  void* args[] = {&p, &lo, &hi};
  hipError_t e = hipLaunchCooperativeKernel((void*)mega, dim3(grid_blocks), dim3(512), args, LDS_BYTES, stream);
  if (e != hipSuccess) fprintf(stderr, "cooperative launch failed: %s (grid %d)\n", hipGetErrorString(e), grid_blocks);
#endif
}
```

```cpp
#include <hip/hip_runtime.h>
#include <hip/hip_cooperative_groups.h>
#include <stdint.h>
#include <stdio.h>
namespace cg = cooperative_groups;

typedef unsigned short u16;
typedef __attribute__((ext_vector_type(8))) short bf16x8;
typedef __attribute__((ext_vector_type(4))) float f32x4;
#define MFMA(a, b, c) __builtin_amdgcn_mfma_f32_16x16x32_bf16(a, b, c, 0, 0, 0)
#define DI __device__ __forceinline__

#ifndef MULTI
#define MULTI 0
#endif

constexpr int T_LAT = 32768, T_ALL = 36864;
constexpr int NIN = 5648;
constexpr long U38 = 37748736L;
constexpr long OFF_XC = 0;
constexpr long OFF_WB = OFF_XC + 16777216L;
constexpr long OFF_HBF = OFF_WB + 43024384L;
constexpr long OFF_MOD = OFF_HBF + 75497472L;
constexpr long OFF_TAPL = OFF_MOD + 1671168L;
constexpr long OFF_TAPC = OFF_TAPL + 8388608L;
constexpr long OFF_DL = OFF_TAPC + 1048576L;
constexpr long OFF_DLC = OFF_DL + 16777216L;
constexpr long OFF_DC = OFF_DLC + 262144L;
constexpr long OFF_PDAB = OFF_DC + 65536L;
constexpr long OFF_GC = OFF_PDAB + 2359296L;
constexpr long OFF_BETA = OFF_GC + 2359296L;
constexpr long OFF_Y = OFF_BETA + 2359296L;
constexpr long OFF_AR = OFF_Y + 4 * U38;
constexpr long OFF_ROPE = OFF_AR + 7 * U38;
constexpr long OFF_BAR = OFF_ROPE + 2 * 262144L;
constexpr long WS_TOTAL = OFF_BAR + 16384L;
constexpr long WO_IN = 0, WO_G = 5783552L, WO_B = 9977856L, WO_O = 12075008L, WO_1 = 13123584L, WO_2 = 17317888L;
constexpr int LDS_BYTES = 139264;
constexpr int NPHASE = 1 + 4 * 14;

struct Prm {
  const float *x, *c, *ctx, *c_ctx, *w_ada, *b_ada, *norm1, *norm2, *w_in, *qk_gain, *lam, *subln, *hy_conv, *hy_w1,
      *hy_b1, *hy_freq, *hy_w2, *hy_b2, *hy_w3, *hy_bias, *dn_conv, *dn_a_log, *dn_dt_bias, *dn_norm, *w_gate,
      *w_branch, *w_o, *w_mlp1, *w_mlp2;
  float* out;
  char* ws;
};

DI int mytid() {
  int t = threadIdx.x;
  asm volatile("" : "+v"(t));
  return t;
}
DI int mybid() {
  int t = blockIdx.x;
  asm volatile("" : "+s"(t));
  return t;
}
DI void lds_barrier() {
  asm volatile("s_waitcnt lgkmcnt(0)" ::: "memory");
  __builtin_amdgcn_s_barrier();
  asm volatile("" ::: "memory");
}
typedef __bf16 bf16x2_t __attribute__((ext_vector_type(2)));
typedef float f32x2_t __attribute__((ext_vector_type(2)));
DI unsigned pk_bf16(float a, float b) {
  f32x2_t v = {a, b};
  bf16x2_t h = __builtin_convertvector(v, bf16x2_t);
  return *(unsigned*)&h;
}
DI u16 f2bf(float f) {
  __bf16 h = (__bf16)f;
  return *(u16*)&h;
}
DI float bf2f(u16 h) { return __uint_as_float(((unsigned)h) << 16); }
DI float wsum(float v) {
  for (int o = 32; o; o >>= 1) v += __shfl_xor(v, o);
  return v;
}
DI float wmax(float v) {
  for (int o = 32; o; o >>= 1) v = fmaxf(v, __shfl_xor(v, o));
  return v;
}
DI float siluf(float v) { return v / (1.f + __expf(-v)); }
DI float sigmf(float v) { return 1.f / (1.f + __expf(-v)); }
DI float* xrow(const Prm& p, int tok) {
  return tok < T_LAT ? p.out + (long)tok * 1024 : (float*)(p.ws + OFF_XC) + (long)(tok - T_LAT) * 1024;
}
DI int first_item(long base) {
  int G = gridDim.x;
  return (int)(((long)mybid() + G - (base % G)) % G);
}
DI int tokof(int b, int P) { return P < 256 ? T_LAT + b * 256 + P : b * 2048 + (P - 256); }

typedef __attribute__((ext_vector_type(4))) unsigned u32x4;
struct Stg { u32x4 a0, a1, a2, a3, b0, b1; };
template <int NA>
DI void g_load(Stg& r, const u16* Ap, long lda, const u16* Bp, long ldb, int k0) {
  r.a0 = *(const u32x4*)(Ap + k0);
  r.a1 = *(const u32x4*)(Ap + 64 * lda + k0);
  if constexpr (NA == 4) {
    r.a2 = *(const u32x4*)(Ap + 128 * lda + k0);
    r.a3 = *(const u32x4*)(Ap + 192 * lda + k0);
  }
  r.b0 = *(const u32x4*)(Bp + k0);
  r.b1 = *(const u32x4*)(Bp + 64 * ldb + k0);
}
template <int NA, int TM>
DI void s_store(const Stg& r, u16* ns_) {
  *(u32x4*)(ns_) = r.a0;
  *(u32x4*)(ns_ + 64 * 80) = r.a1;
  if constexpr (NA == 4) {
    *(u32x4*)(ns_ + 128 * 80) = r.a2;
    *(u32x4*)(ns_ + 192 * 80) = r.a3;
  }
  *(u32x4*)(ns_ + TM * 80) = r.b0;
  *(u32x4*)(ns_ + TM * 80 + 64 * 80) = r.b1;
}
template <int MI>
DI void t_compute(f32x4 (&acc)[MI][4], const u16* as, const u16* bs, int wm, int wn, int fr, int fq) {
#pragma unroll
  for (int ks = 0; ks < 2; ++ks) {
    bf16x8 a[MI], b[4];
#pragma unroll
    for (int mi = 0; mi < MI; ++mi) a[mi] = *(const bf16x8*)(as + (wm * MI * 16 + mi * 16 + fr) * 80 + ks * 32 + fq * 8);
#pragma unroll
    for (int ni = 0; ni < 4; ++ni) b[ni] = *(const bf16x8*)(bs + (wn * 64 + ni * 16 + fr) * 80 + ks * 32 + fq * 8);
#pragma unroll
    for (int mi = 0; mi < MI; ++mi)
#pragma unroll
      for (int ni = 0; ni < 4; ++ni) acc[mi][ni] = MFMA(b[ni], a[mi], acc[mi][ni]);
  }
}
template <int MI>
DI void gemm_tile(f32x4 (&acc)[MI][4], const u16* __restrict__ A, long lda, const u16* __restrict__ B, long ldb, int K,
                  char* smem, Stg& r0, Stg& r1, bool pre, const u16* nA, long nlda, const u16* nB, long nldb) {
  constexpr int TM = MI * 64;
  constexpr int STAGE = (TM + 128) * 80;
  constexpr int NA = TM * 8 / 512;
  u16* s = (u16*)smem;
  const int tid = mytid(), lane = tid & 63, wid = tid >> 6;
  const int wm = wid >> 1, wn = wid & 1, fr = lane & 15, fq = lane >> 4;
  const long to_a = (long)(tid >> 3), to_c = (tid & 7) * 8;
  const u16* Ap = A + to_a * lda + to_c;
  const u16* Bp = B + to_a * ldb + to_c;
  const u16* nAp = nA + to_a * nlda + to_c;
  const u16* nBp = nB + to_a * nldb + to_c;
  const int so = (tid >> 3) * 80 + (tid & 7) * 8;
#define GLOAD(r, k0) g_load<NA>(r, Ap, lda, Bp, ldb, (k0))
#define NLOAD(r, k0) g_load<NA>(r, nAp, nlda, nBp, nldb, (k0))
#define SSTORE(r, st) s_store<NA, TM>(r, s + (st) * STAGE + so)
#define COMPUTE(st) t_compute<MI>(acc, s + (st) * STAGE, s + (st) * STAGE + TM * 80, wm, wn, fr, fq)
#pragma unroll
  for (int mi = 0; mi < MI; ++mi)
#pragma unroll
    for (int ni = 0; ni < 4; ++ni) acc[mi][ni] = f32x4{0.f, 0.f, 0.f, 0.f};
  const int nk = K >> 6;
  if (!pre) {
    GLOAD(r0, 0);
    GLOAD(r1, 64);
  }
  SSTORE(r0, 0);
  lds_barrier();
  for (int kt = 0; kt < nk; kt += 2) {
    if (kt + 2 < nk) GLOAD(r0, (kt + 2) << 6);
    else if (nA) NLOAD(r0, 0);
    COMPUTE(0);
    SSTORE(r1, 1);
    lds_barrier();
    if (kt + 3 < nk) GLOAD(r1, (kt + 3) << 6);
    else if (nA) NLOAD(r1, 64);
    COMPUTE(1);
    if (kt + 2 < nk) SSTORE(r0, 0);
    lds_barrier();
  }
#undef GLOAD
#undef NLOAD
#undef SSTORE
#undef COMPUTE
}

struct TD {
  const u16* A;
  const u16* B;
  u16* C;
  long lda, ldb, ldc;
  int K;
  int mode;
  int split;
  float scale;
  int tok0, col0;
  const float* g;
};

DI void run_tile2(const Prm& p, const TD& d, char* smem, Stg& r0, Stg& r1, bool pre, const u16* nA, long nlda,
                 const u16* nB, long nldb);
DI void run_tile(const Prm& p, const TD& d, char* smem) {
  Stg r0, r1;
  run_tile2(p, d, smem, r0, r1, false, nullptr, 0, nullptr, 0);
}
DI void run_tile2(const Prm& p, const TD& d, char* smem, Stg& r0, Stg& r1, bool pre, const u16* nA, long nlda,
                 const u16* nB, long nldb) {
  f32x4 acc[4][4];
  gemm_tile<4>(acc, d.A, d.lda, d.B, d.ldb, d.K, smem, r0, r1, pre, nA, nlda, nB, nldb);
  const int tid = mytid(), lane = tid & 63, wid = tid >> 6;
  const int wm = wid >> 1, wn = wid & 1, fr = lane & 15, fq = lane >> 4;
  if (d.mode == 4) {
    const int which = d.col0 >> 2, h = d.col0 & 3;
    const float* gain = d.g + which * 64 + fq * 4;
    const float* RC = (const float*)(p.ws + OFF_ROPE);
    const float* RS = RC + 65536;
    u16* dstb = d.C + (which ? 18874368L : 0L);
    const float qs = which ? 1.f : 0.18033688011112042f;
#pragma unroll
    for (int mi = 0; mi < 4; ++mi) {
      const int tok = d.tok0 + wm * 64 + mi * 16 + fr;
      float ss = 0.f;
#pragma unroll
      for (int ni = 0; ni < 4; ++ni)
#pragma unroll
        for (int j = 0; j < 4; ++j) ss += acc[mi][ni][j] * acc[mi][ni][j];
      ss += __shfl_xor(ss, 16);
      ss += __shfl_xor(ss, 32);
      const float inv = rsqrtf(ss * (1.f / 64.f) + 1e-6f) * qs;
      int b, P;
      const bool lat = tok < T_LAT;
      if (lat) { b = tok >> 11; P = 256 + (tok & 2047); }
      else { b = (tok - T_LAT) >> 8; P = (tok - T_LAT) & 255; }
      float y[4][4];
#pragma unroll
      for (int ni = 0; ni < 4; ++ni) {
        float4 g4 = *(const float4*)(gain + ni * 16);
        y[ni][0] = acc[mi][ni][0] * inv * g4.x; y[ni][1] = acc[mi][ni][1] * inv * g4.y;
        y[ni][2] = acc[mi][ni][2] * inv * g4.z; y[ni][3] = acc[mi][ni][3] * inv * g4.w;
      }
      u16* dst = dstb + ((long)((b * 4 + h) * 2 + wn) * 2304 + P) * 64 + fq * 4;
#pragma unroll
      for (int ni = 0; ni < 4; ++ni) {
        float o0 = y[ni][0], o1 = y[ni][1], o2 = y[ni][2], o3 = y[ni][3];
        if (lat) {
          const int l = tok & 2047, a = ni >> 1;
          float4 c4 = *(const float4*)(RC + (l * 2 + a) * 16 + fq * 4);
          float4 s4 = *(const float4*)(RS + (l * 2 + a) * 16 + fq * 4);
          const float sg = (ni & 1) ? 1.f : -1.f;
          o0 = y[ni][0] * c4.x + sg * y[ni ^ 1][0] * s4.x;
          o1 = y[ni][1] * c4.y + sg * y[ni ^ 1][1] * s4.y;
          o2 = y[ni][2] * c4.z + sg * y[ni ^ 1][2] * s4.z;
          o3 = y[ni][3] * c4.w + sg * y[ni ^ 1][3] * s4.w;
        }
        uint2 o;
        o.x = pk_bf16(o0, o1);
        o.y = pk_bf16(o2, o3);
        *(uint2*)(dst + ni * 16) = o;
      }
    }
    return;
  }
#pragma unroll
  for (int mi = 0; mi < 4; ++mi)
#pragma unroll
    for (int ni = 0; ni < 4; ++ni) {
      int r = wm * 64 + mi * 16 + fr, c = wn * 64 + ni * 16 + fq * 4;
      f32x4 v = acc[mi][ni];
      if (d.mode == 0) {
        long ro = d.split ? ((long)(r & 127) * d.ldc + (long)(r >> 7) * d.split) : (long)r * d.ldc;
        ushort4 o;
        o.x = f2bf(v[0] * d.scale); o.y = f2bf(v[1] * d.scale); o.z = f2bf(v[2] * d.scale); o.w = f2bf(v[3] * d.scale);
        *(ushort4*)(d.C + ro + c) = o;
      } else if (d.mode == 1) {
        ushort4 o;
        float t0 = fmaxf(v[0], 0.f), t1 = fmaxf(v[1], 0.f), t2 = fmaxf(v[2], 0.f), t3 = fmaxf(v[3], 0.f);
        o.x = f2bf(t0 * t0); o.y = f2bf(t1 * t1); o.z = f2bf(t2 * t2); o.w = f2bf(t3 * t3);
        *(ushort4*)(d.C + (long)r * d.ldc + c) = o;
      } else if (d.mode == 3) {
        if (wn == 0 && ni == 0) *(float4*)((float*)d.C + (long)r * 16 + fq * 4) = float4{v[0], v[1], v[2], v[3]};
      } else {
        float4* xp = (float4*)(xrow(p, d.tok0 + r) + d.col0 + c);
        float4 g4 = *(const float4*)(d.g + d.col0 + c);
        float4 x4 = *xp;
        x4.x += g4.x * v[0]; x4.y += g4.y * v[1]; x4.z += g4.z * v[2]; x4.w += g4.w * v[3];
        *xp = x4;
      }
    }
}

DI void ph_init(const Prm& p, char* smem) {
  const long gt = (long)mybid() * 512 + mytid(), gn = (long)gridDim.x * 512;
  {
    const float4* s = (const float4*)p.x;
    float4* d = (float4*)p.out;
    for (long i = gt; i < 32768L * 256; i += gn) d[i] = s[i];
    const float4* s2 = (const float4*)p.ctx;
    float4* d2 = (float4*)(p.ws + OFF_XC);
    for (long i = gt; i < 4096L * 256; i += gn) d2[i] = s2[i];
  }
  {
    u16* DL = (u16*)(p.ws + OFF_DL);
    for (long i = gt; i < 2048L * 4096; i += gn) {
      int l = (int)(i >> 12), kk = (int)(i & 4095), lp = kk & 2047, part = kk >> 11;
      int m = (l * lp) & 2047;
      float ang = (float)m * (6.283185307179586f / 2048.f);
      DL[i] = f2bf(part ? -sinf(ang) : cosf(ang));
    }
    u16* DLC = (u16*)(p.ws + OFF_DLC);
    for (long i = gt; i < 256L * 512; i += gn) {
      int l = (int)(i >> 9), kk = (int)(i & 511), lp = kk & 255, part = kk >> 8;
      int m = (l * lp) & 255;
      float ang = (float)m * (6.283185307179586f / 256.f);
      DLC[i] = f2bf(part ? -sinf(ang) : cosf(ang));
    }
    {
      float* RC = (float*)(p.ws + OFF_ROPE);
      float* RS = RC + 65536;
      for (long i = gt; i < 65536; i += gn) {
        int l = (int)(i >> 5), a = (int)(i >> 4) & 1, f = (int)(i & 15);
        float pos = a ? (float)(l & 63) : (float)(l >> 6);
        float ang = pos * powf(10000.f, -(float)f / 16.f);
        RC[i] = cosf(ang);
        RS[i] = sinf(ang);
      }
    }
    u16* DC = (u16*)(p.ws + OFF_DC);
    for (long i = gt; i < 256L * 128; i += gn) {
      int j2 = (int)(i >> 7), ii = (int)(i & 127), part = j2 >> 7, j = j2 & 127;
      int m = (ii * j) & 127;
      float ang = (float)m * (6.283185307179586f / 128.f);
      DC[i] = f2bf(part ? sinf(ang) : cosf(ang));
    }
  }
  float* sc = (float*)smem;
  float* red = sc + 17 * 1024;
  const int tid = mytid();
  for (int e = tid; e < 17 * 1024; e += 512) {
    int bb = e >> 10, k = e & 1023;
    float v = bb < 16 ? p.c[bb * 1024 + k] : p.c_ctx[k];
    sc[e] = v / (1.f + expf(-v));
  }
  __syncthreads();
  float* MOD = (float*)(p.ws + OFF_MOD);
  for (int it = mybid(); it < 192; it += gridDim.x) {
    int li = it / 48, cgp = it % 48;
    int cl = tid & 127, kq = tid >> 7, n = cgp * 128 + cl;
    float a[17];
#pragma unroll
    for (int b = 0; b < 17; ++b) a[b] = 0.f;
    const float* w = p.w_ada + ((long)li * 1024 + kq * 256) * 6144 + n;
#pragma unroll 2
    for (int k = 0; k < 256; ++k) {
      float wv = w[(long)k * 6144];
#pragma unroll
      for (int b = 0; b < 17; ++b) a[b] += sc[b * 1024 + kq * 256 + k] * wv;
    }
#pragma unroll
    for (int b = 0; b < 17; ++b) red[(kq * 17 + b) * 128 + cl] = a[b];
    __syncthreads();
    for (int e = tid; e < 17 * 128; e += 512) {
      int b = e >> 7, c2 = e & 127, n2 = cgp * 128 + c2;
      float v = p.b_ada[li * 6144 + n2];
      for (int q = 0; q < 4; ++q) v += red[(q * 17 + b) * 128 + c2];
      MOD[((long)li * 17 + b) * 6144 + n2] = v;
    }
    __syncthreads();
  }
}

DI long tr_job(long base, const float* src, int K, int N, u16* dst, int nb, char* smem) {
  float* t = (float*)smem;
  const int tk = K >> 6, tn = (N + 63) >> 6, per = tk * tn, total = per * nb;
  const int tid = mytid();
  const int G = gridDim.x;
  float v[8];
  int it = first_item(base);
  if (it < total) {
    int b = it / per, r = it % per, kt = r / tn, nt = r % tn;
    const float* s = src + (long)b * K * N;
#pragma unroll
    for (int i = 0; i < 8; ++i) {
      int id = tid + i * 512, kk = id >> 6, nn = id & 63;
      v[i] = (nt * 64 + nn < N) ? s[(long)(kt * 64 + kk) * N + nt * 64 + nn] : 0.f;
    }
  }
  for (; it < total; it += G) {
    int b = it / per, r = it % per, kt = r / tn, nt = r % tn;
    u16* d = dst + (long)b * K * N;
    int k0 = kt * 64, n0 = nt * 64;
#pragma unroll
    for (int i = 0; i < 8; ++i) {
      int id = tid + i * 512, kk = id >> 6, nn = id & 63;
      t[kk * 65 + nn] = v[i];
    }
    __syncthreads();
    if (it + G < total) {
      int it2 = it + G, b2 = it2 / per, r2 = it2 % per, kt2 = r2 / tn, nt2 = r2 % tn;
      const float* s2 = src + (long)b2 * K * N;
#pragma unroll
      for (int i = 0; i < 8; ++i) {
        int id = tid + i * 512, kk = id >> 6, nn = id & 63;
        v[i] = (nt2 * 64 + nn < N) ? s2[(long)(kt2 * 64 + kk) * N + nt2 * 64 + nn] : 0.f;
      }
    }
#pragma unroll
    for (int i = 0; i < 8; ++i) {
      int id = tid + i * 512, nn = id >> 6, kk = id & 63;
      if (n0 + nn < N) d[(long)(n0 + nn) * K + k0 + kk] = f2bf(t[kk * 65 + nn]);
    }
    __syncthreads();
  }
  return base + total;
}

DI void ph_norm(const Prm& p, int li, int which) {
  const int lane = mytid() & 63;
  const int gw = mybid() * 8 + (mytid() >> 6), nw = gridDim.x * 8;
  const float* nwt = (which ? p.norm2 : p.norm1) + li * 1024;
  const float* MOD = (const float*)(p.ws + OFF_MOD);
  u16* H = (u16*)(p.ws + OFF_HBF);
  const int nrows = (which && li == 3) ? T_LAT : T_ALL;
  for (int row = gw; row < nrows; row += 2 * nw) {
    const int row2 = row + nw;
    const bool has2 = row2 < nrows;
    const float* xr = xrow(p, row);
    const float* xr2 = xrow(p, has2 ? row2 : row);
    float4 v[4], u[4];
    float ss = 0.f, ss2 = 0.f;
#pragma unroll
    for (int i = 0; i < 4; ++i) {
      v[i] = *(const float4*)(xr + i * 256 + lane * 4);
      u[i] = *(const float4*)(xr2 + i * 256 + lane * 4);
    }
#pragma unroll
    for (int i = 0; i < 4; ++i) {
      ss += v[i].x * v[i].x + v[i].y * v[i].y + v[i].z * v[i].z + v[i].w * v[i].w;
      ss2 += u[i].x * u[i].x + u[i].y * u[i].y + u[i].z * u[i].z + u[i].w * u[i].w;
    }
#pragma unroll
    for (int o = 32; o; o >>= 1) {
      ss += __shfl_xor(ss, o);
      ss2 += __shfl_xor(ss2, o);
    }
    const float inv = rsqrtf(ss * (1.f / 1024.f) + 1e-6f), inv2 = rsqrtf(ss2 * (1.f / 1024.f) + 1e-6f);
    const int bb = row < T_LAT ? (row >> 11) : 16, bb2 = row2 < T_LAT ? (row2 >> 11) : 16;
    const float* sh = MOD + ((long)li * 17 + bb) * 6144 + (which ? 3 : 0) * 1024;
    const float* sh2 = MOD + ((long)li * 17 + (has2 ? bb2 : bb)) * 6144 + (which ? 3 : 0) * 1024;
#pragma unroll
    for (int i = 0; i < 4; ++i) {
      int c = i * 256 + lane * 4;
      float4 w4 = *(const float4*)(nwt + c);
      {
        float4 s4 = *(const float4*)(sh + 1024 + c), h4 = *(const float4*)(sh + c);
        uint2 o;
        o.x = pk_bf16(v[i].x * inv * w4.x * (1.f + s4.x) + h4.x, v[i].y * inv * w4.y * (1.f + s4.y) + h4.y);
        o.y = pk_bf16(v[i].z * inv * w4.z * (1.f + s4.z) + h4.z, v[i].w * inv * w4.w * (1.f + s4.w) + h4.w);
        *(uint2*)(H + (long)row * 1024 + c) = o;
      }
      if (has2) {
        float4 s4 = *(const float4*)(sh2 + 1024 + c), h4 = *(const float4*)(sh2 + c);
        uint2 o;
        o.x = pk_bf16(u[i].x * inv2 * w4.x * (1.f + s4.x) + h4.x, u[i].y * inv2 * w4.y * (1.f + s4.y) + h4.y);
        o.y = pk_bf16(u[i].z * inv2 * w4.z * (1.f + s4.z) + h4.z, u[i].w * inv2 * w4.w * (1.f + s4.w) + h4.w);
        *(uint2*)(H + (long)row2 * 1024 + c) = o;
      }
    }
  }
}

DI void ph_taps1(const Prm& p, int li, long base, char* smem) {
  float* f = (float*)smem;
  float* hraw = (float*)(p.ws + OFF_AR + 5 * U38);
  const int tid = mytid();
  for (int it = first_item(base); it < 288; it += gridDim.x) {
    const int L = it < 256 ? 2048 : 256, j0 = it < 256 ? it * 8 : (it - 256) * 8;
    const int lg = tid >> 6, kk = tid & 63;
    if (tid < 8 * 33) {
      int l2 = tid / 33, e = tid % 33, j = j0 + l2;
      float t = (float)j / (float)(L - 1);
      float w = 6.283185307179586f * (float)j / (float)L;
      float v;
      if (e == 0) v = t;
      else {
        int bi = (e - 1) & 15;
        float band = 1e-4f + (float)bi * ((15.f - 1e-4f) / 15.f);
        v = (e <= 16) ? cosf(band * w) : -sinf(band * w);
      }
      f[l2 * 40 + e] = v;
    }
    __syncthreads();
    {
      float v = p.hy_b1[li * 64 + kk];
#pragma unroll 3
      for (int e = 0; e < 33; ++e) v += f[lg * 40 + e] * p.hy_w1[(li * 33 + e) * 64 + kk];
      f[320 + lg * 64 + kk] = sinf(p.hy_freq[(li * 2 + 0) * 64 + kk] * v);
    }
    __syncthreads();
    {
      float v = p.hy_b2[li * 64 + kk];
#pragma unroll 4
      for (int m = 0; m < 64; ++m) v += f[320 + lg * 64 + m] * p.hy_w2[(li * 64 + m) * 64 + kk];
      f[832 + lg * 64 + kk] = sinf(p.hy_freq[(li * 2 + 1) * 64 + kk] * v);
    }
    __syncthreads();
    {
      float h[4][8];
#pragma unroll
      for (int i = 0; i < 4; ++i)
#pragma unroll
        for (int l2 = 0; l2 < 8; ++l2) h[i][l2] = 0.f;
      const float* w3 = p.hy_w3 + (long)li * 64 * 2048 + tid;
#pragma unroll 2
      for (int k = 0; k < 64; ++k) {
        float wv[4];
#pragma unroll
        for (int i = 0; i < 4; ++i) wv[i] = w3[(long)k * 2048 + i * 512];
#pragma unroll
        for (int l2 = 0; l2 < 8; ++l2) {
          float hv = f[832 + l2 * 64 + k];
#pragma unroll
          for (int i = 0; i < 4; ++i) h[i][l2] += hv * wv[i];
        }
      }
#pragma unroll
      for (int i = 0; i < 4; ++i) {
        int n = tid + i * 512, ch = n & 511;
        float delta = fabsf(-3.0701134573253946f + (float)ch * ((-15.350567286626973f + 3.0701134573253946f) / 511.f));
#pragma unroll
        for (int l2 = 0; l2 < 8; ++l2) {
          int j = j0 + l2;
          float t = (float)j / (float)(L - 1);
          long row = (it < 256) ? j : 2048 + j;
          hraw[row * 2048 + n] = h[i][l2] * expf(-t * delta);
        }
      }
    }
    __syncthreads();
  }
}
DI void ph_taps2(const Prm& p, long base, char* smem) {
  float* vals = (float*)smem;
  float* red = vals + 8 * 2048;
  const float* hraw = (const float*)(p.ws + OFF_AR + 5 * U38);
  const int tid = mytid(), cl = tid & 3, dir = (tid >> 2) & 1, jg = tid >> 3;
  for (int it = first_item(base); it < 512; it += gridDim.x) {
    int ls = it >> 8, order = (it >> 7) & 1, cgp = it & 127;
    int L = ls ? 256 : 2048;
    const float* hr = hraw + (long)(ls ? 2048 : 0) * 2048;
    u16* G = (u16*)(p.ws + (ls ? OFF_TAPC : OFF_TAPL));
    int ch = cgp * 4 + cl, n = order * 1024 + dir * 512 + ch;
    float s = 0.f;
#pragma unroll 8
    for (int j = jg; j < L; j += 64) {
      float v = hr[(long)j * 2048 + n];
      vals[(cl * 2 + dir) * L + j] = v;
      s += (dir == 1 && j == 0) ? 0.f : fabsf(v);
    }
    red[(tid >> 2) * 4 + cl] = s;
    __syncthreads();
    if (tid < 4) {
      float tot = 0.f;
#pragma unroll 8
      for (int r = 0; r < 128; ++r) tot += red[r * 4 + tid];
      red[512 + tid] = 1.f / tot;
    }
    __syncthreads();
    for (int idx = tid; idx < 8 * L; idx += 512) {
      int q = idx / L, j = idx % L, c2 = q >> 1, d2 = q & 1;
      float v = vals[idx] * red[512 + c2];
      u16* g = G + (long)(order * 512 + cgp * 4 + c2) * (2 * L);
      if (d2 == 0) g[L + j] = f2bf(v);
      else if (j > 0) g[L - j] = f2bf(v);
      else g[0] = 0;
    }
    __syncthreads();
  }
}

DI void ph_pdab(const Prm& p, int li, char* smem) {
  float* wl = (float*)smem;
  const int tid = mytid(), lane = tid & 63;
#pragma unroll 8
  for (int e = tid; e < 1024 * 16; e += 512) wl[e] = p.w_in[((long)li * 1024 + (e >> 4)) * NIN + 5632 + (e & 15)];
  __syncthreads();
  const u16* H = (const u16*)(p.ws + OFF_HBF);
  float* out = (float*)(p.ws + OFF_PDAB);
  const int gw = mybid() * 8 + (tid >> 6), nw = gridDim.x * 8;
  for (int tok = gw; tok < T_ALL; tok += nw) {
    float a[16];
#pragma unroll
    for (int j = 0; j < 16; ++j) a[j] = 0.f;
    float hv[16];
#pragma unroll
    for (int i = 0; i < 16; ++i) hv[i] = bf2f(H[(long)tok * 1024 + lane + i * 64]);
#pragma unroll
    for (int i = 0; i < 16; ++i) {
      float h = hv[i];
      const float4* wp = (const float4*)(wl + (lane + i * 64) * 16);
#pragma unroll
      for (int q = 0; q < 4; ++q) {
        float4 w4 = wp[q];
        a[q * 4 + 0] += h * w4.x;
        a[q * 4 + 1] += h * w4.y;
        a[q * 4 + 2] += h * w4.z;
        a[q * 4 + 3] += h * w4.w;
      }
      if ((i & 3) == 3) asm volatile("" ::: "memory");
    }
#pragma unroll
    for (int o = 32; o; o >>= 1)
#pragma unroll
      for (int j = 0; j < 16; ++j) a[j] += __shfl_xor(a[j], o);
    float v = a[0];
#pragma unroll
    for (int j = 1; j < 16; ++j) v = (lane == j) ? a[j] : v;
    if (lane < 16) out[(long)tok * 16 + lane] = v;
  }
  __syncthreads();
}

DI void ph_dncl(const Prm& p, int li, char* smem) {
  const int tid = mytid(), lane = tid & 63, wid = tid >> 6, fr = lane & 15, fq = lane >> 4;
  u16* qn = (u16*)smem;
  u16* kn = qn + 64 * 144;
  float* fb = (float*)(smem + 36864);
  float* KK = fb;
  float* QK = KK + 64 * 65;
  float* Am = QK + 64 * 65;
  float* Tm = Am + 2 * 64 * 65;
  float* gcs = Tm + 2 * 64 * 65;
  float* bts = gcs + 128;
  const u16* PD = (const u16*)(p.ws + OFF_AR);
  const float* AB = (const float*)(p.ws + OFF_PDAB);
  u16* DQ = (u16*)(p.ws + OFF_Y);
  u16* DK = DQ + 18874368L;
  u16* DV = DK + 18874368L;
  u16* CL = (u16*)(p.ws + OFF_AR + 3 * U38);
  float* GC = (float*)(p.ws + OFF_GC);
  float* BT = (float*)(p.ws + OFF_BETA);
  const float* cw = p.dn_conv + (long)li * 3 * 1536;
  for (int it = mybid(); it < 2304; it += gridDim.x) {
    const int b = it / 144, r0 = it % 144, oc = r0 >> 2, h = r0 & 3;
    const int pos0 = oc * 64, s0 = oc < 4 ? 0 : 256, e0 = oc < 4 ? 256 : 2304;
    if (tid < 384) {
      const int cgp = tid % 48, rs = tid / 48;
      const int part = cgp >> 4, d0 = (cgp & 15) * 8, col = part * 512 + h * 128 + d0;
      const u16* basep = PD + (long)tokof(b, pos0) * 1536 + col;
      float wt[3][8];
#pragma unroll
      for (int tp = 0; tp < 3; ++tp) {
        float4 wa = *(const float4*)(cw + tp * 1536 + col), wb = *(const float4*)(cw + tp * 1536 + col + 4);
        wt[tp][0] = wa.x; wt[tp][1] = wa.y; wt[tp][2] = wa.z; wt[tp][3] = wa.w;
        wt[tp][4] = wb.x; wt[tp][5] = wb.y; wt[tp][6] = wb.z; wt[tp][7] = wb.w;
      }
#pragma unroll 1
      for (int hf = 0; hf < 2; ++hf) {
        u32x4 rw[6];
#pragma unroll
        for (int i = 0; i < 6; ++i) {
          int j = rs * 8 + hf * 4 - 1 + i, P = pos0 + j;
          rw[i] = (P >= s0 && P < e0) ? *(const u32x4*)(basep + (long)j * 1536) : u32x4{0u, 0u, 0u, 0u};
        }
#pragma unroll
        for (int r = 0; r < 4; ++r) {
#pragma unroll
          for (int e = 0; e < 8; ++e) {
            unsigned w0_ = rw[r][e >> 1], w1_ = rw[r + 1][e >> 1], w2_ = rw[r + 2][e >> 1];
            float x0 = (e & 1) ? __uint_as_float(w0_ & 0xffff0000u) : __uint_as_float(w0_ << 16);
            float x1 = (e & 1) ? __uint_as_float(w1_ & 0xffff0000u) : __uint_as_float(w1_ << 16);
            float x2 = (e & 1) ? __uint_as_float(w2_ & 0xffff0000u) : __uint_as_float(w2_ << 16);
            float v = wt[0][e] * x0 + wt[1][e] * x1 + wt[2][e] * x2;
            fb[(rs * 8 + hf * 4 + r) * 385 + part * 128 + d0 + e] = v / (1.f + __expf(-v));
          }
        }
      }
    }
    __syncthreads();
    for (int jj = 0; jj < 8; ++jj) {
      int j = wid * 8 + jj, P = pos0 + j;
      long go = ((long)(b * 4 + h) * 2304 + P) * 128;
      float q0 = fb[j * 385 + lane], q1 = fb[j * 385 + 64 + lane];
      float k0 = fb[j * 385 + 128 + lane], k1 = fb[j * 385 + 192 + lane];
      float v0 = fb[j * 385 + 256 + lane], v1 = fb[j * 385 + 320 + lane];
      float iq = rsqrtf(wsum(q0 * q0 + q1 * q1) + 1e-6f), ik = rsqrtf(wsum(k0 * k0 + k1 * k1) + 1e-6f);
      u16 a0 = f2bf(q0 * iq), a1 = f2bf(q1 * iq), c0 = f2bf(k0 * ik), c1 = f2bf(k1 * ik);
      qn[j * 144 + lane] = a0; qn[j * 144 + 64 + lane] = a1;
      kn[j * 144 + lane] = c0; kn[j * 144 + 64 + lane] = c1;
      DQ[go + lane] = a0; DQ[go + 64 + lane] = a1;
      DK[go + lane] = c0; DK[go + 64 + lane] = c1;
      DV[go + lane] = f2bf(v0); DV[go + 64 + lane] = f2bf(v1);
    }
    __syncthreads();
#pragma unroll
    for (int u = 0; u < 4; ++u) {
      int tt = wid * 4 + u, which = tt >> 4, ti = (tt >> 2) & 3, tj = tt & 3;
      const u16* Ap = (which ? qn : kn) + (ti * 16 + fr) * 144 + fq * 8;
      const u16* Bp = kn + (tj * 16 + fr) * 144 + fq * 8;
      f32x4 a = {0.f, 0.f, 0.f, 0.f};
#pragma unroll
      for (int ks = 0; ks < 4; ++ks) a = MFMA(*(const bf16x8*)(Ap + ks * 32), *(const bf16x8*)(Bp + ks * 32), a);
      float* dst = which ? QK : KK;
#pragma unroll
      for (int j = 0; j < 4; ++j) dst[(ti * 16 + fq * 4 + j) * 65 + tj * 16 + fr] = a[j];
    }
    if (tid < 128) {
      int d = tid >> 6, r = tid & 63, j = d ? 63 - r : r;
      int tok = tokof(b, pos0 + j);
      float av = AB[(long)tok * 16 + d * 4 + h], bv = AB[(long)tok * 16 + 8 + d * 4 + h];
      float xx = av + p.dn_dt_bias[li * 8 + d * 4 + h];
      float sp = fmaxf(xx, 0.f) + __logf(1.f + __expf(-fabsf(xx)));
      float g = -expf(p.dn_a_log[li * 8 + d * 4 + h]) * sp;
      for (int o = 1; o < 64; o <<= 1) {
        float t = __shfl_up(g, o);
        if (r >= o) g += t;
      }
      float be = 1.f / (1.f + expf(-bv));
      gcs[d * 64 + r] = g;
      bts[d * 64 + r] = be;
      long ci = ((long)((b * 4 + h) * 2 + d) * 36 + oc) * 64 + r;
      GC[ci] = g;
      BT[ci] = be;
    }
    __syncthreads();
#pragma unroll 4
    for (int e = tid; e < 8192; e += 512) {
      int d = e >> 12, s = (e >> 6) & 63, r = e & 63;
      int j = d ? 63 - r : r, js = d ? 63 - s : s;
      float v = 0.f;
      if (r > s) v = bts[d * 64 + r] * KK[j * 65 + js] * expf(gcs[d * 64 + r] - gcs[d * 64 + s]);
      Am[(d * 64 + s) * 64 + r] = v;
    }
#pragma unroll 4
    for (int e = tid; e < 8192; e += 512) {
      int d = e >> 12, r = (e >> 6) & 63, s = e & 63;
      int j = d ? 63 - r : r, js = d ? 63 - s : s;
      float dec = (r >= s) ? expf(gcs[d * 64 + r] - gcs[d * 64 + s]) : 0.f;
      long ci = (long)((b * 4 + h) * 2 + d) * 36 + oc;
      CL[ci * 8192 + 4096 + r * 64 + s] = f2bf(QK[j * 65 + js] * dec * 0.08838834764831845f);
    }
    __syncthreads();
    {
      const int d = tid >> 8, c = (tid >> 2) & 63, q = tid & 3;
      const float* Atq = Am + d * 64 * 64 + q;
      float* T = Tm + d * 64 * 65;
      float t[16];
#pragma unroll
      for (int i = 0; i < 16; ++i) t[i] = (4 * i + q == c) ? 1.f : 0.f;
#pragma unroll
      for (int s2 = 0; s2 < 63; ++s2) {
        constexpr int dummy = 0;
        const int is = s2 >> 2, qs = s2 & 3;
        const int ctl = qs | (qs << 2) | (qs << 4) | (qs << 6);
        int tsb;
        if (qs == 0) tsb = __builtin_amdgcn_update_dpp(0, __float_as_int(t[is]), 0x00, 0xf, 0xf, false);
        else if (qs == 1) tsb = __builtin_amdgcn_update_dpp(0, __float_as_int(t[is]), 0x55, 0xf, 0xf, false);
        else if (qs == 2) tsb = __builtin_amdgcn_update_dpp(0, __float_as_int(t[is]), 0xAA, 0xf, 0xf, false);
        else tsb = __builtin_amdgcn_update_dpp(0, __float_as_int(t[is]), 0xFF, 0xf, 0xf, false);
        (void)ctl; (void)dummy;
        const float ts = __int_as_float(tsb);
#pragma unroll
        for (int i = is; i < 16; ++i) t[i] -= Atq[s2 * 64 + 4 * i] * ts;
        if ((s2 & 7) == 7) asm volatile("" ::: "memory");
      }
#pragma unroll
      for (int i = 0; i < 16; ++i) T[(4 * i + q) * 65 + c] = t[i];
    }
    __syncthreads();
    for (int e = tid; e < 8192; e += 512) {
      int d = e >> 12, rc = e & 4095;
      long ci = (long)((b * 4 + h) * 2 + d) * 36 + oc;
      CL[ci * 8192 + rc] = f2bf(Tm[(d * 64 + (rc >> 6)) * 65 + (rc & 63)]);
    }
    __syncthreads();
  }
}

DI void ph_dnscan(const Prm& p, char* smem) {
  const int tid = mytid(), lane = tid & 63, wid = tid >> 6, fr = lane & 15, fq = lane >> 4;
  u16* Kg = (u16*)smem;
  u16* Qg = Kg + 64 * 144;
  u16* KdT = Qg + 64 * 144;
  u16* Tl = KdT + 128 * 80;
  u16* Il = Tl + 64 * 80;
  u16* ST = Il + 64 * 80;
  u16* RT = ST + 64 * 144;
  u16* VN = RT + 64 * 80;
  const u16* DQ = (const u16*)(p.ws + OFF_Y);
  const u16* DK = DQ + 18874368L;
  const u16* DV = DK + 18874368L;
  const u16* CL = (const u16*)(p.ws + OFF_AR + 3 * U38);
  const float* GC = (const float*)(p.ws + OFF_GC);
  const float* BT = (const float*)(p.ws + OFF_BETA);
  const int vt = wid & 3, rp = wid >> 2;
  for (int it = mybid(); it < 256; it += gridDim.x) {
    const int b = it >> 4, h = (it >> 2) & 3, d = (it >> 1) & 1, vs = it & 1;
    u16* O = (u16*)(p.ws + OFF_AR + (d ? 6 : 5) * U38);
    f32x4 S[4];
#pragma unroll
    for (int i = 0; i < 4; ++i) S[i] = f32x4{0.f, 0.f, 0.f, 0.f};
    for (int e = tid; e < 64 * 144; e += 512) ST[e] = 0;
    const long seqb = (long)(b * 4 + h) * 2304;
    const long cib = (long)((b * 4 + h) * 2 + d) * 36;
    u32x4 rk0, rk1, rq0, rq1, rT, rI;
    float rg0, rg1, rgl;
    uint2 rv0, rv1;
    float rb0, rb1;
    const int lr0 = tid >> 4, lr1 = (tid + 512) >> 4, lch = tid & 15;
    const int lj0 = d ? 63 - lr0 : lr0, lj1 = d ? 63 - lr1 : lr1;
    const int vr0 = (rp * 2) * 16 + fr, vr1 = (rp * 2 + 1) * 16 + fr;
    const int vj0 = d ? 63 - vr0 : vr0, vj1 = d ? 63 - vr1 : vr1;
#define SCAN_LOAD_KQ(ocx)                                                                    \
  {                                                                                          \
    const long ci_ = cib + (ocx);                                                            \
    const long g0_ = (seqb + (ocx) * 64 + lj0) * 128 + lch * 8, g1_ = (seqb + (ocx) * 64 + lj1) * 128 + lch * 8; \
    rk0 = *(const u32x4*)(DK + g0_); rk1 = *(const u32x4*)(DK + g1_);                        \
    rq0 = *(const u32x4*)(DQ + g0_); rq1 = *(const u32x4*)(DQ + g1_);                        \
    rT = *(const u32x4*)(CL + ci_ * 8192 + (tid >> 3) * 64 + (tid & 7) * 8);                 \
    rI = *(const u32x4*)(CL + ci_ * 8192 + 4096 + (tid >> 3) * 64 + (tid & 7) * 8);          \
    rg0 = GC[ci_ * 64 + lr0]; rg1 = GC[ci_ * 64 + lr1]; rgl = GC[ci_ * 64 + 63];             \
  }
#define SCAN_LOAD_V(ocx)                                                                     \
  {                                                                                          \
    const long ci_ = cib + (ocx);                                                            \
    rv0 = *(const uint2*)(DV + (seqb + (ocx) * 64 + vj0) * 128 + vs * 64 + vt * 16 + fq * 4); \
    rv1 = *(const uint2*)(DV + (seqb + (ocx) * 64 + vj1) * 128 + vs * 64 + vt * 16 + fq * 4); \
    rb0 = BT[ci_ * 64 + vr0]; rb1 = BT[ci_ * 64 + vr1];                                      \
  }
    {
      const int oc0 = d ? 3 : 0;
      SCAN_LOAD_KQ(oc0);
      SCAN_LOAD_V(oc0);
    }
    for (int i = 0; i < 36; ++i) {
      const int oc = d ? (i < 4 ? 3 - i : 39 - i) : i;
      const int ocn = d ? (i + 1 < 4 ? 3 - (i + 1) : 39 - (i + 1)) : i + 1;
      const int pos0 = oc * 64;
      const float gl = rgl;
      {
        float eg0 = __expf(rg0), ed0 = __expf(gl - rg0), eg1 = __expf(rg1), ed1 = __expf(gl - rg1);
        u32x4 ko0, qo0, ko1, qo1;
#pragma unroll
        for (int w = 0; w < 4; ++w) {
          float k0l = __uint_as_float(rk0[w] << 16), k0h = __uint_as_float(rk0[w] & 0xffff0000u);
          float q0l = __uint_as_float(rq0[w] << 16), q0h = __uint_as_float(rq0[w] & 0xffff0000u);
          float k1l = __uint_as_float(rk1[w] << 16), k1h = __uint_as_float(rk1[w] & 0xffff0000u);
          float q1l = __uint_as_float(rq1[w] << 16), q1h = __uint_as_float(rq1[w] & 0xffff0000u);
          ko0[w] = (unsigned)f2bf(k0l * eg0) | ((unsigned)f2bf(k0h * eg0) << 16);
          qo0[w] = (unsigned)f2bf(q0l * eg0 * 0.08838834764831845f) | ((unsigned)f2bf(q0h * eg0 * 0.08838834764831845f) << 16);
          ko1[w] = (unsigned)f2bf(k1l * eg1) | ((unsigned)f2bf(k1h * eg1) << 16);
          qo1[w] = (unsigned)f2bf(q1l * eg1 * 0.08838834764831845f) | ((unsigned)f2bf(q1h * eg1 * 0.08838834764831845f) << 16);
          KdT[(lch * 8 + 2 * w) * 80 + lr0] = f2bf(k0l * ed0);
          KdT[(lch * 8 + 2 * w + 1) * 80 + lr0] = f2bf(k0h * ed0);
          KdT[(lch * 8 + 2 * w) * 80 + lr1] = f2bf(k1l * ed1);
          KdT[(lch * 8 + 2 * w + 1) * 80 + lr1] = f2bf(k1h * ed1);
        }
        *(u32x4*)(Kg + lr0 * 144 + lch * 8) = ko0;
        *(u32x4*)(Qg + lr0 * 144 + lch * 8) = qo0;
        *(u32x4*)(Kg + lr1 * 144 + lch * 8) = ko1;
        *(u32x4*)(Qg + lr1 * 144 + lch * 8) = qo1;
        *(u32x4*)(Tl + (tid >> 3) * 80 + (tid & 7) * 8) = rT;
        *(u32x4*)(Il + (tid >> 3) * 80 + (tid & 7) * 8) = rI;
      }
      lds_barrier();
      if (i + 1 < 36) SCAN_LOAD_KQ(ocn);
      f32x4 ks_[2], qs_[2];
#pragma unroll
      for (int u = 0; u < 2; ++u) { ks_[u] = f32x4{0.f, 0.f, 0.f, 0.f}; qs_[u] = f32x4{0.f, 0.f, 0.f, 0.f}; }
#pragma unroll
      for (int kk = 0; kk < 4; ++kk) {
        bf16x8 a = *(const bf16x8*)(ST + (vt * 16 + fr) * 144 + kk * 32 + fq * 8);
#pragma unroll
        for (int u = 0; u < 2; ++u) {
          int rt = rp * 2 + u;
          bf16x8 bk = *(const bf16x8*)(Kg + (rt * 16 + fr) * 144 + kk * 32 + fq * 8);
          bf16x8 bq = *(const bf16x8*)(Qg + (rt * 16 + fr) * 144 + kk * 32 + fq * 8);
          ks_[u] = MFMA(a, bk, ks_[u]);
          qs_[u] = MFMA(a, bq, qs_[u]);
        }
      }
      {
        int v0 = vt * 16 + fq * 4;
        RT[(v0 + 0) * 80 + vr0] = f2bf(rb0 * (__uint_as_float(rv0.x << 16) - ks_[0][0]));
        RT[(v0 + 1) * 80 + vr0] = f2bf(rb0 * (__uint_as_float(rv0.x & 0xffff0000u) - ks_[0][1]));
        RT[(v0 + 2) * 80 + vr0] = f2bf(rb0 * (__uint_as_float(rv0.y << 16) - ks_[0][2]));
        RT[(v0 + 3) * 80 + vr0] = f2bf(rb0 * (__uint_as_float(rv0.y & 0xffff0000u) - ks_[0][3]));
        RT[(v0 + 0) * 80 + vr1] = f2bf(rb1 * (__uint_as_float(rv1.x << 16) - ks_[1][0]));
        RT[(v0 + 1) * 80 + vr1] = f2bf(rb1 * (__uint_as_float(rv1.x & 0xffff0000u) - ks_[1][1]));
        RT[(v0 + 2) * 80 + vr1] = f2bf(rb1 * (__uint_as_float(rv1.y << 16) - ks_[1][2]));
        RT[(v0 + 3) * 80 + vr1] = f2bf(rb1 * (__uint_as_float(rv1.y & 0xffff0000u) - ks_[1][3]));
      }
      if (i + 1 < 36) SCAN_LOAD_V(ocn);
      lds_barrier();
      {
        f32x4 vn[2];
#pragma unroll
        for (int u = 0; u < 2; ++u) vn[u] = f32x4{0.f, 0.f, 0.f, 0.f};
#pragma unroll
        for (int kk = 0; kk < 2; ++kk) {
          bf16x8 a = *(const bf16x8*)(RT + (vt * 16 + fr) * 80 + kk * 32 + fq * 8);
#pragma unroll
          for (int u = 0; u < 2; ++u) {
            bf16x8 bb = *(const bf16x8*)(Tl + ((rp * 2 + u) * 16 + fr) * 80 + kk * 32 + fq * 8);
            vn[u] = MFMA(a, bb, vn[u]);
          }
        }
#pragma unroll
        for (int u = 0; u < 2; ++u) {
          int r = (rp * 2 + u) * 16 + fr, v0 = vt * 16 + fq * 4;
#pragma unroll
          for (int j = 0; j < 4; ++j) VN[(v0 + j) * 80 + r] = f2bf(vn[u][j]);
        }
      }
      lds_barrier();
#pragma unroll
      for (int kk = 0; kk < 2; ++kk) {
        bf16x8 a = *(const bf16x8*)(VN + (vt * 16 + fr) * 80 + kk * 32 + fq * 8);
#pragma unroll
        for (int u = 0; u < 2; ++u) {
          bf16x8 bb = *(const bf16x8*)(Il + ((rp * 2 + u) * 16 + fr) * 80 + kk * 32 + fq * 8);
          qs_[u] = MFMA(a, bb, qs_[u]);
        }
      }
#pragma unroll
      for (int u = 0; u < 2; ++u) {
        int r = (rp * 2 + u) * 16 + fr, j = d ? 63 - r : r;
        u16* op = O + (long)tokof(b, pos0 + j) * 512 + h * 128 + vs * 64 + vt * 16 + fq * 4;
        ushort4 ov4;
        ov4.x = f2bf(qs_[u][0]); ov4.y = f2bf(qs_[u][1]); ov4.z = f2bf(qs_[u][2]); ov4.w = f2bf(qs_[u][3]);
        *(ushort4*)op = ov4;
      }
      {
        float ge = __expf(gl);
#pragma unroll
        for (int u = 0; u < 4; ++u) S[u] *= ge;
#pragma unroll
        for (int kk = 0; kk < 2; ++kk) {
          bf16x8 a = *(const bf16x8*)(VN + (vt * 16 + fr) * 80 + kk * 32 + fq * 8);
#pragma unroll
          for (int u = 0; u < 4; ++u) {
            bf16x8 bb = *(const bf16x8*)(KdT + ((rp * 4 + u) * 16 + fr) * 80 + kk * 32 + fq * 8);
            S[u] = MFMA(a, bb, S[u]);
          }
        }
#pragma unroll
        for (int u = 0; u < 4; ++u) {
          int dd = (rp * 4 + u) * 16 + fr, v0 = vt * 16 + fq * 4;
#pragma unroll
          for (int j = 0; j < 4; ++j) ST[(v0 + j) * 144 + dd] = f2bf(S[u][j]);
        }
      }
      lds_barrier();
    }
#undef SCAN_LOAD_KQ
#undef SCAN_LOAD_V
  }
}

DI void ph_dnfin(const Prm& p, int li) {
  const int lane = mytid() & 63;
  const int gw = mybid() * 8 + (mytid() >> 6), nw = gridDim.x * 8;
  const u16* O = (const u16*)(p.ws + OFF_AR + 5 * U38);
  const u16* O2 = (const u16*)(p.ws + OFF_AR + 6 * U38);
  u16* Z = (u16*)(p.ws + OFF_Y + 3 * U38);
  const float n0 = p.dn_norm[li * 128 + lane * 2], n1 = p.dn_norm[li * 128 + lane * 2 + 1];
#pragma unroll 2
  for (int tok = gw; tok < T_ALL; tok += nw) {
    ushort2 oa[4], ob[4], zz[4];
    float ox[4], oy[4], ss[4];
#pragma unroll
    for (int h = 0; h < 4; ++h) {
      long o = (long)tok * 512 + h * 128 + lane * 2;
      oa[h] = *(const ushort2*)(O + o);
      ob[h] = *(const ushort2*)(O2 + o);
      zz[h] = *(const ushort2*)(Z + o);
    }
#pragma unroll
    for (int h = 0; h < 4; ++h) {
      ox[h] = bf2f(oa[h].x) + bf2f(ob[h].x);
      oy[h] = bf2f(oa[h].y) + bf2f(ob[h].y);
      ss[h] = ox[h] * ox[h] + oy[h] * oy[h];
    }
#pragma unroll
    for (int o = 32; o; o >>= 1)
#pragma unroll
      for (int h = 0; h < 4; ++h) ss[h] += __shfl_xor(ss[h], o);
#pragma unroll
    for (int h = 0; h < 4; ++h) {
      float inv = rsqrtf(ss[h] * (1.f / 128.f) + 1e-6f);
      float z0 = bf2f(zz[h].x), z1 = bf2f(zz[h].y);
      ushort2 y;
      y.x = f2bf(ox[h] * inv * n0 * (z0 / (1.f + __expf(-z0))));
      y.y = f2bf(oy[h] * inv * n1 * (z1 / (1.f + __expf(-z1))));
      *(ushort2*)(Z + (long)tok * 512 + h * 128 + lane * 2) = y;
    }
  }
}

DI void ph_aprep(const Prm& p, int li) {
  const int lane = mytid() & 63;
  const int gw = mybid() * 8 + (mytid() >> 6), nw = gridDim.x * 8;
  const u16* PA = (const u16*)(p.ws + OFF_AR);
  u16* QH = (u16*)(p.ws + OFF_AR + 3 * U38);
  u16* KH = QH + 18874368L;
  const int f = lane & 15;
  const float inv_f = powf(10000.f, -(float)f / 16.f);
  for (int tok = gw; tok < T_ALL; tok += nw) {
    int b, P;
    float cs = 1.f, sn = 0.f;
    if (tok < T_LAT) {
      b = tok >> 11;
      int l = tok & 2047;
      P = 256 + l;
      float pos = (lane < 32) ? (float)(l >> 6) : (float)(l & 63);
      float ang = pos * inv_f;
      cs = cosf(ang);
      sn = sinf(ang);
    } else {
      b = (tok - T_LAT) >> 8;
      P = (tok - T_LAT) & 255;
    }
    float xv[16], ssq[16];
#pragma unroll
    for (int g = 0; g < 16; ++g) {
      xv[g] = bf2f(PA[(long)tok * 1024 + g * 64 + lane]);
      ssq[g] = xv[g] * xv[g];
    }
#pragma unroll
    for (int o = 32; o; o >>= 1)
#pragma unroll
      for (int g = 0; g < 16; ++g) ssq[g] += __shfl_xor(ssq[g], o);
#pragma unroll
    for (int g = 0; g < 16; ++g) {
      int which = g >> 3, h = (g >> 1) & 3, c = g & 1;
      float inv = rsqrtf(ssq[g] * (1.f / 64.f) + 1e-6f);
      float y = xv[g] * inv * p.qk_gain[(li * 2 + which) * 64 + lane];
      float pr = __shfl_xor(y, 16);
      float o = (lane & 16) ? (y * cs + pr * sn) : (y * cs - pr * sn);
      if (which == 0) o *= 0.18033688011112042f;
      u16* dst = (which ? KH : QH) + ((long)((b * 4 + h) * 2 + c) * 2304 + P) * 64 + lane;
      *dst = f2bf(o);
    }
  }
}

DI void ph_attn(const Prm& p, int li, long base, char* smem) {
  const int tid = mytid(), lane = tid & 63, wid = tid >> 6, fr = lane & 15, fq = lane >> 4;
  const u16* QH = (const u16*)(p.ws + OFF_AR + 3 * U38);
  const u16* KH = QH + 18874368L;
  const u16* VT = (const u16*)(p.ws + OFF_AR + 5 * U38);
  u16* YA = (u16*)(p.ws + OFF_Y);
  u16* s = (u16*)smem;
  constexpr int STG = 128 * 80 + 128 * 72;
  const float lambda_init = 0.8f - 0.6f * expf(-0.3f * (float)li);
  float lamv, mshift;
  {
    const float* lv = p.lam + li * 256;
    float a = wsum(lv[lane] * lv[64 + lane]), b2 = wsum(lv[128 + lane] * lv[192 + lane]);
    lamv = expf(a) - expf(b2) + lambda_init;
    float gq = wmax(fabsf(p.qk_gain[(li * 2) * 64 + lane])), gk = wmax(fabsf(p.qk_gain[(li * 2 + 1) * 64 + lane]));
    mshift = 8.f * gq * gk * 1.4426950408889634f;
  }
  for (int it = first_item(base); it < (li == 3 ? 1024 : 1152); it += gridDim.x) {
    int b, h, qp0, nkeys;
    if (it < 1024) { b = it >> 6; h = (it >> 4) & 3; qp0 = 256 + (it & 15) * 128; nkeys = 2304; }
    else { int i2 = it - 1024; b = i2 >> 3; h = (i2 >> 1) & 3; qp0 = (i2 & 1) * 128; nkeys = 256; }
    const long kb0 = (long)((b * 4 + h) * 2) * 2304;
    bf16x8 qf[2][2];
#pragma unroll
    for (int c = 0; c < 2; ++c)
#pragma unroll
      for (int ks = 0; ks < 2; ++ks)
        qf[c][ks] = *(const bf16x8*)(QH + (kb0 + (long)c * 2304 + qp0 + wid * 16 + fr) * 64 + ks * 32 + fq * 8);
    f32x4 O0[8], O1[8];
#pragma unroll
    for (int i = 0; i < 8; ++i) { O0[i] = f32x4{0.f, 0.f, 0.f, 0.f}; O1[i] = f32x4{0.f, 0.f, 0.f, 0.f}; }
    f32x4 L0 = {0.f, 0.f, 0.f, 0.f}, L1 = {0.f, 0.f, 0.f, 0.f};
    const bf16x8 ones = {0x3F80, 0x3F80, 0x3F80, 0x3F80, 0x3F80, 0x3F80, 0x3F80, 0x3F80};
    uint4 rk[2], rv[2];
    const int nt = nkeys >> 6;
#pragma unroll
    for (int u = 0; u < 2; ++u) {
      int id = tid + u * 512;
      int c = id >> 9, key = (id >> 3) & 63, ch = id & 7;
      rk[u] = *(const uint4*)(KH + (kb0 + (long)c * 2304 + key) * 64 + ch * 8);
      int dv = id >> 3;
      rv[u] = *(const uint4*)(VT + ((long)(b * 512 + h * 128 + dv)) * 2304 + ch * 8);
    }
#pragma unroll
    for (int u = 0; u < 2; ++u) {
      int id = tid + u * 512;
      *(uint4*)(s + (id >> 3) * 80 + (id & 7) * 8) = rk[u];
      *(uint4*)(s + 128 * 80 + (id >> 3) * 72 + (id & 7) * 8) = rv[u];
    }
    lds_barrier();
    for (int t = 0; t < nt; ++t) {
      const bool more = t + 1 < nt;
      if (more) {
        int kp0 = (t + 1) * 64;
#pragma unroll
        for (int u = 0; u < 2; ++u) {
          int id = tid + u * 512;
          int c = id >> 9, key = (id >> 3) & 63, ch = id & 7;
          rk[u] = *(const uint4*)(KH + (kb0 + (long)c * 2304 + kp0 + key) * 64 + ch * 8);
          int dv = id >> 3;
          rv[u] = *(const uint4*)(VT + ((long)(b * 512 + h * 128 + dv)) * 2304 + kp0 + ch * 8);
        }
      }
      const u16* ks_ = s + (t & 1) * STG;
      const u16* vs_ = ks_ + 128 * 80;
      bf16x8 pf[2][2];
#pragma unroll
      for (int c = 0; c < 2; ++c) {
#pragma unroll
        for (int kk2 = 0; kk2 < 2; ++kk2) {
          u32x4 pw;
#pragma unroll
          for (int hh = 0; hh < 2; ++hh) {
            const int k4 = kk2 * 2 + hh;
            f32x4 a = {-mshift, -mshift, -mshift, -mshift};
#pragma unroll
            for (int kk = 0; kk < 2; ++kk)
              a = MFMA(*(const bf16x8*)(ks_ + (c * 64 + k4 * 16 + fr) * 80 + kk * 32 + fq * 8), qf[c][kk], a);
            pw[hh * 2 + 0] = pk_bf16(__builtin_amdgcn_exp2f(a[0]), __builtin_amdgcn_exp2f(a[1]));
            pw[hh * 2 + 1] = pk_bf16(__builtin_amdgcn_exp2f(a[2]), __builtin_amdgcn_exp2f(a[3]));
          }
          pf[c][kk2] = *(bf16x8*)&pw;
        }
      }
#pragma unroll
      for (int kk = 0; kk < 2; ++kk) {
        L0 = MFMA(ones, pf[0][kk], L0);
        L1 = MFMA(ones, pf[1][kk], L1);
      }
#pragma unroll
      for (int dt = 0; dt < 8; ++dt) {
#pragma unroll
        for (int kk = 0; kk < 2; ++kk) {
          const u16* vp = vs_ + (dt * 16 + fr) * 72 + kk * 32 + fq * 4;
          uint2 lo = *(const uint2*)vp, hi = *(const uint2*)(vp + 16);
          uint4 av = {lo.x, lo.y, hi.x, hi.y};
          bf16x8 a = *(bf16x8*)&av;
          O0[dt] = MFMA(a, pf[0][kk], O0[dt]);
          O1[dt] = MFMA(a, pf[1][kk], O1[dt]);
        }
      }
      if (more) {
        u16* ns = s + ((t + 1) & 1) * STG;
#pragma unroll
        for (int u = 0; u < 2; ++u) {
          int id = tid + u * 512;
          *(uint4*)(ns + (id >> 3) * 80 + (id & 7) * 8) = rk[u];
          *(uint4*)(ns + 128 * 80 + (id >> 3) * 72 + (id & 7) * 8) = rv[u];
        }
      }
      lds_barrier();
    }
    float i0 = 1.f / L0[0], i1 = lamv / L1[0], ss = 0.f;
#pragma unroll
    for (int dt = 0; dt < 8; ++dt)
#pragma unroll
      for (int j = 0; j < 4; ++j) {
        float o = O0[dt][j] * i0 - O1[dt][j] * i1;
        O0[dt][j] = o;
        ss += o * o;
      }
    ss += __shfl_xor(ss, 16); ss += __shfl_xor(ss, 32);
    float inv = rsqrtf(ss * (1.f / 128.f) + 1e-6f) * (1.f - lambda_init);
    int tok = tokof(b, qp0 + wid * 16 + fr);
#pragma unroll
    for (int dt = 0; dt < 8; ++dt) {
      int dv = dt * 16 + fq * 4;
      const float* sw = p.subln + li * 128 + dv;
      ushort4 o;
      o.x = f2bf(O0[dt][0] * inv * sw[0]);
      o.y = f2bf(O0[dt][1] * inv * sw[1]);
      o.z = f2bf(O0[dt][2] * inv * sw[2]);
      o.w = f2bf(O0[dt][3] * inv * sw[3]);
      *(ushort4*)(YA + (long)tok * 512 + h * 128 + dv) = o;
    }
  }
}

template <int L>
DI void hyena_item(const Prm& p, int li, int ch, char* smem) {
  constexpr int CS = 2 * L + 8;
  constexpr int ZS = L + 8;
  constexpr int MT = L / 128;
  constexpr int MG = MT > 8 ? 8 : MT, NG = MT / MG;
  const int tid = mytid(), lane = tid & 63, wid = tid >> 6, fr = lane & 15, fq = lane >> 4;
  u16* cp = (u16*)smem;
  u16* zr = cp + 8 * CS;
  const u16* PH = (const u16*)(p.ws + OFF_AR) + (L == 2048 ? 0L : 32768L * 1536);
  const u16* G = (const u16*)(p.ws + (L == 2048 ? OFF_TAPL : OFF_TAPC));
  u16* YB = (u16*)(p.ws + OFF_Y + U38);
  const float* cw = p.hy_conv + (long)li * 3 * 1536;
  {
    float w0 = cw[1024 + ch], w1 = cw[1536 + 1024 + ch], w2 = cw[3072 + 1024 + ch];
#pragma unroll 8
    for (int e = tid; e < 16 * L; e += 512) {
      int b = e / L, sidx = e % L;
      const u16* row = PH + ((long)b * 1536 + 1024 + ch) * L;
      float v = w1 * bf2f(row[sidx]);
      if (sidx > 0) v += w0 * bf2f(row[sidx - 1]);
      if (sidx + 1 < L) v += w2 * bf2f(row[sidx + 1]);
      zr[b * ZS + L - 1 - sidx] = f2bf(v);
    }
  }
#pragma unroll
  for (int order = 0; order < 2; ++order) {
    {
      const u16* g = G + (long)(order * 512 + ch) * (2 * L);
#pragma unroll 8
      for (int e = tid; e < 8 * 2 * L; e += 512) {
        int c = e / (2 * L), i = e % (2 * L);
        cp[c * CS + i] = (i + c < 2 * L) ? g[i + c] : (u16)0;
      }
    }
    __syncthreads();
    const float bias = p.hy_bias[(li * 2 + order) * 512 + ch];
    const int gcol = order * 512 + ch;
    const float w0 = cw[gcol], w1 = cw[1536 + gcol], w2 = cw[3072 + gcol];
    const int tq = wid * (L / 8) + fq * 4;
    const u16* xb = PH + ((long)fr * 1536 + gcol) * L + tq;
    const u16* zb = zr + fr * ZS + L - 1 - tq;
    unsigned zp[NG][MG][2];
#pragma unroll
    for (int grp = 0; grp < NG; ++grp) {
      f32x4 acc[MG];
#pragma unroll
      for (int m = 0; m < MG; ++m) acc[m] = f32x4{0.f, 0.f, 0.f, 0.f};
      const int tb = wid * (L / 8) + grp * MG * 16 + fr;
      if constexpr (MG == 8) {
        const int i00 = tb - fq * 8 - 7 + L, c0 = i00 & 7;
        const u16* ab = cp + c0 * CS + (i00 - c0);
        const u16* zbp = zr + fr * ZS + (L - 8 - fq * 8);
        bf16x8 W[16];
#pragma unroll 1
        for (int s0 = 0; s0 < L; s0 += 256) {
#pragma unroll
          for (int k = 0; k < 8; ++k) {
            const int sk = s0 + 32 * k;
            if (k == 0) {
#pragma unroll
              for (int m = 0; m < 8; ++m) W[m] = *(const bf16x8*)(ab + m * 16 - sk);
            }
            if (k < 7) {
              W[(16 - 2 * k - 2) & 15] = *(const bf16x8*)(ab - sk - 32);
              W[(16 - 2 * k - 1) & 15] = *(const bf16x8*)(ab - sk - 32 + 16);
            }
            bf16x8 bk = *(const bf16x8*)(zbp - sk);
#pragma unroll
            for (int m = 0; m < 8; ++m) acc[m] = MFMA(W[(m + 16 - 2 * k) & 15], bk, acc[m]);
          }
        }
      } else {
#pragma unroll 2
        for (int s0 = 0; s0 < L; s0 += 32) {
          bf16x8 bfr = *(const bf16x8*)(zr + fr * ZS + (L - 8 - s0 - fq * 8));
#pragma unroll
          for (int m = 0; m < MG; ++m) {
            int i0 = tb + m * 16 - s0 - fq * 8 - 7 + L;
            int c = i0 & 7;
            bf16x8 afr = *(const bf16x8*)(cp + c * CS + (i0 - c));
            acc[m] = MFMA(afr, bfr, acc[m]);
          }
        }
      }
#pragma unroll
      for (int m = 0; m < MG; ++m) {
        float r4[4];
#pragma unroll
        for (int j = 0; j < 4; ++j) {
          const int off = (grp * MG + m) * 16 + j;
          const int t = tq + off;
          float xa = bf2f(xb[off - 1]), xc = bf2f(xb[off]), xd = bf2f(xb[off + 1]);
          xa = (t > 0) ? xa : 0.f;
          xd = (t + 1 < L) ? xd : 0.f;
          float xg = w0 * xa + w1 * xc + w2 * xd;
          float zin = bf2f(zb[-off]);
          r4[j] = xg * (acc[m][j] + bias * zin);
        }
        zp[grp][m][0] = (unsigned)f2bf(r4[0]) | ((unsigned)f2bf(r4[1]) << 16);
        zp[grp][m][1] = (unsigned)f2bf(r4[2]) | ((unsigned)f2bf(r4[3]) << 16);
      }
    }
    __syncthreads();
#pragma unroll
    for (int grp = 0; grp < NG; ++grp)
#pragma unroll
      for (int m = 0; m < MG; ++m)
#pragma unroll
        for (int j = 0; j < 4; ++j) {
          int t = wid * (L / 8) + (grp * MG + m) * 16 + fq * 4 + j;
          u16 v = (u16)(zp[grp][m][j >> 1] >> ((j & 1) * 16));
          zr[fr * ZS + L - 1 - t] = v;
        }
  }
  __syncthreads();
  {
    u16* YBT = (u16*)(p.ws + OFF_AR + 5 * U38) + (L == 2048 ? 0L : 16L * 512 * 2048);
#pragma unroll 4
    for (int e = tid; e < 16 * L; e += 512) {
      int b = e / L, t = e % L;
      YBT[((long)b * 512 + ch) * L + t] = zr[b * ZS + L - 1 - t];
    }
  }
  __syncthreads();
}

DI long ph_ytrans(const Prm& p, long base, bool lastl, char* smem) {
  u16* tl = (u16*)smem;
  const u16* YBT = (const u16*)(p.ws + OFF_AR + 5 * U38);
  u16* YB = (u16*)(p.ws + OFF_Y + U38);
  const int tid = mytid(), G = gridDim.x;
  const int total = lastl ? 4096 : 4608;
  auto srcp = [&](int it) -> const u16* {
    if (it < 4096) {
      int b = it >> 8, ct = (it >> 5) & 7, lt = it & 31;
      return YBT + ((long)b * 512 + ct * 64 + (tid >> 3)) * 2048 + lt * 64 + (tid & 7) * 8;
    } else {
      int i2 = it - 4096, b = i2 >> 5, ct = (i2 >> 2) & 7, lt = i2 & 3;
      return YBT + 16L * 512 * 2048 + ((long)b * 512 + ct * 64 + (tid >> 3)) * 256 + lt * 64 + (tid & 7) * 8;
    }
  };
  int it = first_item(base);
  u32x4 v = {0u, 0u, 0u, 0u};
  if (it < total) v = *(const u32x4*)srcp(it);
  for (; it < total; it += G) {
    *(u32x4*)(tl + (tid >> 3) * 72 + (tid & 7) * 8) = v;
    __syncthreads();
    if (it + G < total) v = *(const u32x4*)srcp(it + G);
    long tok0;
    int ct;
    if (it < 4096) { int b = it >> 8, lt = it & 31; ct = (it >> 5) & 7; tok0 = (long)b * 2048 + lt * 64; }
    else { int i2 = it - 4096, b = i2 >> 5, lt = i2 & 3; ct = (i2 >> 2) & 7; tok0 = (long)T_LAT + b * 256 + lt * 64; }
    const int lrow = tid >> 3, cc = tid & 7;
    u32x4 o;
#pragma unroll
    for (int w = 0; w < 4; ++w) {
      unsigned lo = tl[(cc * 8 + 2 * w) * 72 + lrow], hi = tl[(cc * 8 + 2 * w + 1) * 72 + lrow];
      o[w] = lo | (hi << 16);
    }
    *(u32x4*)(YB + (tok0 + lrow) * 512 + ct * 64 + cc * 8) = o;
    __syncthreads();
  }
  return base + total;
}

DI void ph_merge(const Prm& p, char* smem, bool lastl) {
  const int tid = mytid(), lane = tid & 63, wid = tid >> 6;
  const int wm = wid >> 1, wn = wid & 1, fr = lane & 15, fq = lane >> 4;
  const u16* H = (const u16*)(p.ws + OFF_HBF);
  const u16* Y = (const u16*)(p.ws + OFF_Y);
  const u16* WG = (const u16*)(p.ws + OFF_WB) + WO_G;
  const u16* WBr = (const u16*)(p.ws + OFF_WB) + WO_B;
  u16* MG = (u16*)(p.ws + OFF_AR);
  const int NT = (lastl ? 256 : 288) * 8, G = gridDim.x;
  Stg r0, r1;
  bool pre = false;
  for (int t = mybid(); t < NT; t += G) {
    const int mt = t >> 3, nt = t & 7;
    const bool hn = t + G < NT;
    const int mt2 = (t + G) >> 3, nt2 = (t + G) & 7;
    f32x4 acc[2][4], g[2][4], y[2][4];
#pragma unroll
    for (int a = 0; a < 2; ++a)
#pragma unroll
      for (int b = 0; b < 4; ++b) acc[a][b] = f32x4{0.f, 0.f, 0.f, 0.f};
    const u16* gA = H + (long)mt * 128 * 1024;
    for (int n = 0; n < 4; ++n) {
      const u16* gB = WG + ((long)n * 1024 + nt * 128) * 1024;
      const u16* yA = Y + (long)n * (T_ALL * 512L) + (long)mt * 128 * 512;
      const u16* yB = WBr + ((long)n * 1024 + nt * 128) * 512;
      gemm_tile<2>(g, gA, 1024, gB, 1024, 1024, smem, r0, r1, pre, yA, 512, yB, 512);
      const u16* nxA = (n < 3) ? gA : (hn ? H + (long)mt2 * 128 * 1024 : nullptr);
      const u16* nxB = (n < 3) ? WG + ((long)(n + 1) * 1024 + nt * 128) * 1024 : WG + ((long)nt2 * 128) * 1024;
      gemm_tile<2>(y, yA, 512, yB, 512, 512, smem, r0, r1, true, nxA, 1024, nxB, 1024);
      pre = true;
#pragma unroll
      for (int a = 0; a < 2; ++a)
#pragma unroll
        for (int b = 0; b < 4; ++b)
#pragma unroll
          for (int j = 0; j < 4; ++j) acc[a][b][j] += y[a][b][j] / (1.f + __expf(-g[a][b][j]));
    }
    pre = hn;
#pragma unroll
    for (int a = 0; a < 2; ++a)
#pragma unroll
      for (int b = 0; b < 4; ++b) {
        int r = wm * 32 + a * 16 + fr, c = wn * 64 + b * 16 + fq * 4;
        uint2 o;
        o.x = pk_bf16(acc[a][b][0], acc[a][b][1]);
        o.y = pk_bf16(acc[a][b][2], acc[a][b][3]);
        *(uint2*)(MG + ((long)mt * 128 + r) * 1024 + nt * 128 + c) = o;
      }
  }
}

DI void run_phase(const Prm& p, int ph, char* smem) {
  if (ph == 0) { ph_init(p, smem); return; }
  const int li = (ph - 1) / 14, k = (ph - 1) % 14;
  const u16* WB = (const u16*)(p.ws + OFF_WB);
  const u16* HB = (const u16*)(p.ws + OFF_HBF);
  const float* MOD = (const float*)(p.ws + OFF_MOD);
  u16* AR = (u16*)(p.ws + OFF_AR);
  u16* Yb = (u16*)(p.ws + OFF_Y);
  const int G = gridDim.x;
  TD d;
  d.split = 0; d.scale = 1.f; d.mode = 0; d.tok0 = 0; d.col0 = 0; d.g = MOD;
  switch (k) {
    case 0: {
      u16* W = (u16*)(p.ws + OFF_WB);
      long base = 0;
      base = tr_job(base, p.w_in + (long)li * 1024 * NIN, 1024, NIN, W + WO_IN, 1, smem);
      base = tr_job(base, p.w_gate + (long)li * 4 * 1048576, 1024, 1024, W + WO_G, 4, smem);
      base = tr_job(base, p.w_branch + (long)li * 4 * 524288, 512, 1024, W + WO_B, 4, smem);
      base = tr_job(base, p.w_o + (long)li * 1048576, 1024, 1024, W + WO_O, 1, smem);
      base = tr_job(base, p.w_mlp1 + (long)li * 4194304, 1024, 4096, W + WO_1, 1, smem);
      base = tr_job(base, p.w_mlp2 + (long)li * 4194304, 4096, 1024, W + WO_2, 1, smem);
      ph_taps1(p, li, base, smem);
      ph_norm(p, li, 0);
    } break;
    case 1: {
      auto dec = [&](int t, TD& o) {
        o.lda = 1024; o.ldb = 1024; o.K = 1024; o.mode = 0;
        if (t < 1728) {
          int mt = t / 12, nt = t % 12;
          o.A = HB + (long)mt * 256 * 1024; o.B = WB + WO_IN + (long)(3584 + nt * 128) * 1024;
          o.C = AR + (long)mt * 256 * 1536 + nt * 128; o.ldc = 1536;
        } else if (t < 2304) {
          int t2 = t - 1728, mt = t2 >> 2, nt = t2 & 3;
          o.A = HB + (long)mt * 256 * 1024; o.B = WB + WO_IN + (long)(5120 + nt * 128) * 1024;
          o.C = Yb + 3 * (U38 / 2) + (long)mt * 256 * 512 + nt * 128; o.ldc = 512;
        } else {
          int mt = t - 2304;
          o.A = HB + (long)mt * 256 * 1024; o.B = WB + WO_IN + (long)5632 * 1024;
          o.C = (u16*)((float*)(p.ws + OFF_PDAB) + (long)mt * 256 * 16); o.ldc = 16; o.mode = 3;
        }
      };
      {
        Stg r0, r1;
        bool pre = false;
        TD dn = d;
        int t = mybid();
        if (t < 2448) dec(t, d);
        for (; t < 2448; t += G) {
          const bool hn = t + G < 2448;
          if (hn) dec(t + G, dn);
          run_tile2(p, d, smem, r0, r1, pre, hn ? dn.A : nullptr, dn.lda, dn.B, dn.ldb);
          pre = hn;
          d = dn;
        }
      }
      ph_taps2(p, 2448, smem);
    } break;
    case 2: ph_dncl(p, li, smem); break;
    case 3: ph_dnscan(p, smem); break;
    case 4: {
      {
        Stg r0, r1;
        bool pre = false;
        for (int t = mybid(); t < 1152; t += G) {
          int mt = t >> 3, nt = t & 7;
          const bool hn = t + G < 1152;
          int mt2 = (t + G) >> 3, nt2 = (t + G) & 7;
          d.lda = 1024; d.ldb = 1024; d.K = 1024;
          d.A = HB + (long)mt * 256 * 1024; d.B = WB + WO_IN + (long)(nt * 128) * 1024;
          d.C = AR + 3 * (U38 / 2); d.ldc = 0; d.mode = 4; d.tok0 = mt * 256; d.col0 = nt;
          d.g = p.qk_gain + li * 128;
          run_tile2(p, d, smem, r0, r1, pre, hn ? HB + (long)mt2 * 256 * 1024 : nullptr, 1024,
                    WB + WO_IN + (long)(nt2 * 128) * 1024, 1024);
          pre = hn;
        }
      }
      ph_dnfin(p, li);
    } break;
    case 5: {
      u16* VT = AR + 5 * (U38 / 2);
      u16* PF = AR + 6 * (U38 / 2);
      auto dec = [&](int t, TD& o) {
        o.lda = 1024; o.ldb = 1024; o.K = 1024;
        if (t < 512) {
          int b = t >> 5, r = t & 31, mt = r >> 4, nt = r & 15;
          o.A = WB + WO_IN + (long)(1024 + mt * 256) * 1024; o.B = HB + ((long)b * 2048 + nt * 128) * 1024;
          o.C = VT + ((long)b * 512 + mt * 256) * 2304 + 256 + nt * 128; o.ldc = 2304;
        } else if (t < 576) {
          int t2 = t - 512, b = t2 >> 2, r = t2 & 3, mt = r >> 1, nt = r & 1;
          o.A = WB + WO_IN + (long)(1024 + mt * 256) * 1024; o.B = HB + ((long)T_LAT + b * 256 + nt * 128) * 1024;
          o.C = VT + ((long)b * 512 + mt * 256) * 2304 + nt * 128; o.ldc = 2304;
        } else {
          int t2 = t - 576, mt = t2 >> 2, nt = t2 & 3;
          o.A = HB + (long)mt * 256 * 1024; o.B = WB + WO_IN + (long)(3072 + nt * 128) * 1024;
          o.C = PF + (long)mt * 256 * 512 + nt * 128; o.ldc = 512;
        }
      };
      {
        Stg r0, r1;
        bool pre = false;
        TD dn = d;
        int t = mybid();
        if (t < 1152) dec(t, d);
        for (; t < 1152; t += G) {
          const bool hn = t + G < 1152;
          if (hn) dec(t + G, dn);
          run_tile2(p, d, smem, r0, r1, pre, hn ? dn.A : nullptr, dn.lda, dn.B, dn.ldb);
          pre = hn;
          d = dn;
        }
      }
    } break;
    case 6: {
      ph_attn(p, li, 0, smem);
      auto dec = [&](int t, TD& o) {
        o.lda = 1024; o.ldb = 1024; o.K = 1024;
        if (t < 1536) {
          int b = t / 96, r = t % 96, mt = r >> 4, nt = r & 15;
          o.A = WB + WO_IN + (long)(1536 + mt * 256) * 1024; o.B = HB + ((long)b * 2048 + nt * 128) * 1024;
          o.C = AR + ((long)b * 1536 + mt * 256) * 2048 + nt * 128; o.ldc = 2048;
        } else {
          int t2 = t - 1536, b = t2 / 12, r = t2 % 12, mt = r >> 1, nt = r & 1;
          o.A = WB + WO_IN + (long)(1536 + mt * 256) * 1024; o.B = HB + ((long)T_LAT + b * 256 + nt * 128) * 1024;
          o.C = AR + 32768L * 1536 + ((long)b * 1536 + mt * 256) * 256 + nt * 128; o.ldc = 256;
        }
      };
      {
        Stg r0, r1;
        bool pre = false;
        TD dn = d;
        int t = first_item(1152);
        if (t < 1728) dec(t, d);
        for (; t < 1728; t += G) {
          const bool hn = t + G < 1728;
          if (hn) dec(t + G, dn);
          run_tile2(p, d, smem, r0, r1, pre, hn ? dn.A : nullptr, dn.lda, dn.B, dn.ldb);
          pre = hn;
          d = dn;
        }
      }
    } break;
    case 7: {
#if !defined(TESTSEL) || TESTSEL == 1
      for (int it = mybid(); it < 512; it += G) hyena_item<2048>(p, li, it, smem);
#endif
#if !defined(TESTSEL) || TESTSEL == 2
      if (li < 3)
        for (int it = mybid(); it < 512; it += G) hyena_item<256>(p, li, it, smem);
#endif
#if !defined(TESTSEL) || TESTSEL == 3
      const u16* PF = AR + 6 * (U38 / 2);
      u16* WF = AR + 3 * (U38 / 2);
      const u16* DCm = (const u16*)(p.ws + OFF_DC);
      auto dec = [&](int t, TD& o) {
        o.A = DCm; o.lda = 128; o.ldb = 512; o.K = 128;
        if (t < 1024) {
          int bg = t >> 4, nt = t & 15, b = bg >> 2, g = bg & 3;
          o.B = PF + ((long)b * 2048 + nt * 128) * 512 + g * 128;
          o.C = WF + ((long)b * 512 + g * 128) * 4096 + nt * 128; o.ldc = 4096; o.split = 2048;
        } else {
          int t2 = t - 1024, bg = t2 >> 1, nt = t2 & 1, b = bg >> 2, g = bg & 3;
          o.B = PF + ((long)T_LAT + b * 256 + nt * 128) * 512 + g * 128;
          o.C = WF + 16L * 512 * 4096 + ((long)b * 512 + g * 128) * 512 + nt * 128; o.ldc = 512; o.split = 256;
        }
      };
      {
        const int NT7 = (li == 3 ? 1024 : 1152);
        Stg r0, r1;
        bool pre = false;
        TD dn = d;
        int t = mybid();
        if (t < NT7) dec(t, d);
        for (; t < NT7; t += G) {
          const bool hn = t + G < NT7;
          if (hn) dec(t + G, dn);
          run_tile2(p, d, smem, r0, r1, pre, hn ? dn.A : nullptr, dn.lda, dn.B, dn.ldb);
          pre = hn;
          d = dn;
        }
      }
#endif
    } break;
    case 8: {
      const u16* WF = AR + 3 * (U38 / 2);
      u16* YF = Yb + 2 * (U38 / 2);
      d.scale = 1.f / 512.f;
      for (int t = mybid(); t < (li == 3 ? 512 : 576); t += G) {
        if (t < 512) {
          int b = t >> 5, r = t & 31, mt = r >> 2, nt = r & 3;
          d.A = (const u16*)(p.ws + OFF_DL) + (long)mt * 256 * 4096; d.lda = 4096;
          d.B = WF + ((long)b * 512 + nt * 128) * 4096; d.ldb = 4096; d.K = 4096;
          d.C = YF + ((long)b * 2048 + mt * 256) * 512 + nt * 128; d.ldc = 512;
        } else {
          int t2 = t - 512, b = t2 >> 2, nt = t2 & 3;
          d.A = (const u16*)(p.ws + OFF_DLC); d.lda = 512;
          d.B = WF + 16L * 512 * 4096 + ((long)b * 512 + nt * 128) * 512; d.ldb = 512; d.K = 512;
          d.C = YF + ((long)T_LAT + b * 256) * 512 + nt * 128; d.ldc = 512;
        }
        run_tile(p, d, smem);
      }
      ph_ytrans(p, 576, li == 3, smem);
    } break;
    case 9: ph_merge(p, smem, li == 3); break;
    case 10: {
      d.mode = 2;
      const int NT10 = (li == 3 ? 1024 : 1152);
      Stg r0, r1;
      bool pre = false;
      for (int t = mybid(); t < NT10; t += G) {
        int mt = t >> 3, nt = t & 7;
        d.A = AR + (long)mt * 256 * 1024; d.lda = 1024; d.B = WB + WO_O + (long)nt * 128 * 1024; d.ldb = 1024; d.K = 1024;
        d.tok0 = mt * 256; d.col0 = nt * 128;
        int bb = d.tok0 < T_LAT ? (d.tok0 >> 11) : 16;
        d.g = MOD + ((long)li * 17 + bb) * 6144 + 2 * 1024;
        const bool hn = t + G < NT10;
        int mt2 = (t + G) >> 3, nt2 = (t + G) & 7;
        run_tile2(p, d, smem, r0, r1, pre, hn ? AR + (long)mt2 * 256 * 1024 : nullptr, 1024,
                  WB + WO_O + (long)nt2 * 128 * 1024, 1024);
        pre = hn;
      }
    } break;
    case 11: ph_norm(p, li, 1); break;
    case 12: {
      d.mode = 1;
      const int NT12 = (li == 3 ? 4096 : 4608);
      Stg r0, r1;
      bool pre = false;
      for (int t = mybid(); t < NT12; t += G) {
        int mt = t >> 5, nt = t & 31;
        d.A = HB + (long)mt * 256 * 1024; d.lda = 1024; d.B = WB + WO_1 + (long)nt * 128 * 1024; d.ldb = 1024; d.K = 1024;
        d.C = Yb + (long)mt * 256 * 4096 + nt * 128; d.ldc = 4096;
        const bool hn = t + G < NT12;
        int mt2 = (t + G) >> 5, nt2 = (t + G) & 31;
        run_tile2(p, d, smem, r0, r1, pre, hn ? HB + (long)mt2 * 256 * 1024 : nullptr, 1024,
                  WB + WO_1 + (long)nt2 * 128 * 1024, 1024);
        pre = hn;
      }
    } break;
    case 13: {
      d.mode = 2;
      for (int t = mybid(); t < (li == 3 ? 1024 : 1152); t += G) {
        int mt = t >> 3, nt = t & 7;
        d.A = Yb + (long)mt * 256 * 4096; d.lda = 4096; d.B = WB + WO_2 + (long)nt * 128 * 4096; d.ldb = 4096; d.K = 4096;
        d.tok0 = mt * 256; d.col0 = nt * 128;
        int bb = d.tok0 < T_LAT ? (d.tok0 >> 11) : 16;
        d.g = MOD + ((long)li * 17 + bb) * 6144 + 5 * 1024;
        run_tile(p, d, smem);
      }
    } break;
  }
}


#define XB_TMO      128
#define XB_XCNT(j)  (256  + 64 * (j))
#define XB_XSUB(j)  (1280 + 64 * (j))
#define XB_XGEN(j)  (2304 + 64 * (j))
#define XB_TOP      3328
#define XB_TOPGEN   3392
#define XCD_BAR_WORDS 3456
#define XB_SPIN_CAP (1u << 20)
#define LAS __attribute__((address_space(3)))
DI unsigned xb_ld(unsigned* p) { return __hip_atomic_load(p, __ATOMIC_RELAXED, __HIP_MEMORY_SCOPE_AGENT); }
DI unsigned xb_add(unsigned* p, unsigned v) { return __hip_atomic_fetch_add(p, v, __ATOMIC_RELAXED, __HIP_MEMORY_SCOPE_AGENT); }
DI unsigned xb_xcc_id() { return (unsigned)__builtin_amdgcn_s_getreg((3 << 11) | 20) & 0xFu; }
#define XB_SPIN(cond, bar) do { unsigned _sp = 0; while (cond) { __builtin_amdgcn_s_sleep(1); \
    if ((++_sp & 255u) == 0u) { if (xb_ld(&(bar)[XB_TMO])) break; if (_sp > XB_SPIN_CAP) { atomicAdd(&(bar)[XB_TMO], 1u); break; } } } } while (0)
struct XcdBarrier { unsigned* bar; unsigned x; volatile LAS unsigned* st; };
DI XcdBarrier xcd_barrier_post(unsigned* bar, volatile LAS unsigned* st) {
  XcdBarrier b; b.bar = bar; b.x = xb_xcc_id(); b.st = st;
  if (threadIdx.x == 0) (void)xb_add(&bar[XB_XCNT(b.x)], 1u);
  return b;
}
DI void xcd_barrier_complete(unsigned* bar, unsigned x, unsigned& nloc, unsigned& nx) {
  const unsigned G = gridDim.x * gridDim.y * gridDim.z;
  unsigned sum, cnt, mine, sp = 0u;
  for (;;) {
    sum = 0u; cnt = 0u; mine = 0u;
#pragma unroll
    for (unsigned j = 0; j < 16; ++j) { const unsigned c = xb_ld(&bar[XB_XCNT(j)]); sum += c; cnt += (c > 0u) ? 1u : 0u; mine = (j == x) ? c : mine; }
    if (sum == G) break;
    __builtin_amdgcn_s_sleep(1);
    if ((++sp & 255u) == 0u) { if (xb_ld(&bar[XB_TMO])) break; if (sp > XB_SPIN_CAP) { atomicAdd(&bar[XB_TMO], 1u); break; } }
  }
  nloc = mine > 0u ? mine : 1u; nx = cnt > 0u ? cnt : 1u;
}
DI void xcd_barrier(const XcdBarrier& b) {
  asm volatile("s_waitcnt vmcnt(0)" ::: "memory");
  __syncthreads();
  if (threadIdx.x == 0) {
    unsigned* bar = b.bar;
    __builtin_amdgcn_s_waitcnt(0);
    unsigned nloc = b.st[0], nx = b.st[1];
    if (nloc == 0u) { xcd_barrier_complete(bar, b.x, nloc, nx); b.st[0] = nloc; b.st[1] = nx; }
    const unsigned old = xb_add(&bar[XB_XSUB(b.x)], 1u);
    const unsigned gen = old / nloc;
    if (old + 1u == (gen + 1u) * nloc) {
      __builtin_amdgcn_fence(__ATOMIC_RELEASE, "agent");
      asm volatile("s_waitcnt vmcnt(0)" ::: "memory");
      const unsigned og = xb_add(&bar[XB_TOP], 1u);
      const unsigned tg = og / nx;
      if (og + 1u == (tg + 1u) * nx) xb_add(&bar[XB_TOPGEN], 1u);
      else XB_SPIN(xb_ld(&bar[XB_TOPGEN]) == tg, bar);
      __builtin_amdgcn_fence(__ATOMIC_ACQUIRE, "agent");
      xb_add(&bar[XB_XGEN(b.x)], 1u);
      asm volatile("s_waitcnt vmcnt(0)" ::: "memory");
    } else {
      XB_SPIN(xb_ld(&bar[XB_XGEN(b.x)]) == gen, bar);
      __builtin_amdgcn_fence(__ATOMIC_ACQUIRE, "agent");
      asm volatile("s_waitcnt vmcnt(0)" ::: "memory");
    }
  }
  __syncthreads();
}

extern __shared__ __attribute__((aligned(16))) char dyn_smem[];

__global__ void __launch_bounds__(512) mega(Prm p, int lo, int hi) {
  __shared__ uint4 xb_words;
  if (threadIdx.x == 0) xb_words = make_uint4(0u, 0u, 0u, 0u);
  __syncthreads();
  XcdBarrier xb = xcd_barrier_post((unsigned*)(p.ws + OFF_BAR), (volatile LAS unsigned*)&xb_words);
#ifdef ONLYK
  run_phase(p, ONLYK, dyn_smem);
#else
  for (int ph = lo; ph <= hi; ++ph) {
    long z = 0;
    asm volatile("" : "+s"(z));
    Prm q;
#define LP(f) q.f = p.f + z
    LP(x); LP(c); LP(ctx); LP(c_ctx); LP(w_ada); LP(b_ada); LP(norm1); LP(norm2); LP(w_in); LP(qk_gain); LP(lam);
    LP(subln); LP(hy_conv); LP(hy_w1); LP(hy_b1); LP(hy_freq); LP(hy_w2); LP(hy_b2); LP(hy_w3); LP(hy_bias);
    LP(dn_conv); LP(dn_a_log); LP(dn_dt_bias); LP(dn_norm); LP(w_gate); LP(w_branch); LP(w_o); LP(w_mlp1); LP(w_mlp2);
    LP(out); LP(ws);
#undef LP
    run_phase(q, ph, dyn_smem);
#ifdef PROBEK
    if (ph > 0 && (ph - 1) % 14 == PROBEK) { cg::this_grid().sync(); run_phase(q, ph, dyn_smem); }
#endif
    if (ph < hi) {
      if (ph == lo) cg::this_grid().sync();
      else xcd_barrier(xb);
    }
  }
#endif
}

extern "C" void kernel_launch(void* const* d_in, const int* in_sizes, int n_in, void* d_out, int out_size, void* d_ws,
                              size_t ws_size, hipStream_t stream) {
  static int grid_blocks = 0;
  if (!grid_blocks) {
    hipFuncSetAttribute((const void*)mega, hipFuncAttributeMaxDynamicSharedMemorySize, LDS_BYTES);
    int dev = 0, cus = 0, per_cu = 0;
    hipGetDevice(&dev);
    hipDeviceGetAttribute(&cus, hipDeviceAttributeMultiprocessorCount, dev);
    hipOccupancyMaxActiveBlocksPerMultiprocessor(&per_cu, mega, 512, LDS_BYTES);
    if (per_cu < 1) per_cu = 1;
    grid_blocks = cus * per_cu;
    if (ws_size < (size_t)WS_TOTAL) fprintf(stderr, "workspace too small: %zu < %ld\n", ws_size, (long)WS_TOTAL);
  }
  Prm p;
  const float** pp = (const float**)&p;
  for (int i = 0; i < 29; ++i) pp[i] = (const float*)d_in[i];
  p.out = (float*)d_out;
  p.ws = (char*)d_ws;
#if MULTI
  for (int ph = 0; ph < NPHASE; ++ph) hipLaunchKernelGGL(mega, dim3(grid_blocks), dim3(512), LDS_BYTES, stream, p, ph, ph);
#else
  int lo = 0, hi = NPHASE - 1;
  hipMemsetAsync((char*)d_ws + OFF_BAR, 0, XCD_BAR_WORDS * 4, stream);
  void* args[] = {&p, &lo, &hi};
  hipError_t e = hipLaunchCooperativeKernel((void*)mega, dim3(grid_blocks), dim3(512), args, LDS_BYTES, stream);
  if (e != hipSuccess) fprintf(stderr, "cooperative launch failed: %s (grid %d)\n", hipGetErrorString(e), grid_blocks);
#endif
}
```

```cpp
#include <hip/hip_runtime.h>
#include <hip/hip_cooperative_groups.h>
#include <stdint.h>
#include <stdio.h>
namespace cg = cooperative_groups;

typedef unsigned short u16;
typedef __attribute__((ext_vector_type(8))) short bf16x8;
typedef __attribute__((ext_vector_type(4))) float f32x4;
#define MFMA(a, b, c) __builtin_amdgcn_mfma_f32_16x16x32_bf16(a, b, c, 0, 0, 0)
#define DI __device__ __forceinline__

#ifndef MULTI
#define MULTI 0
#endif

constexpr int T_LAT = 32768, T_ALL = 36864;
constexpr int NIN = 5648;
constexpr long U38 = 37748736L;
constexpr long OFF_XC = 0;
constexpr long OFF_WB = OFF_XC + 16777216L;
constexpr long OFF_HBF = OFF_WB + 43024384L;
constexpr long OFF_MOD = OFF_HBF + 75497472L;
constexpr long OFF_TAPL = OFF_MOD + 1671168L;
constexpr long OFF_TAPC = OFF_TAPL + 8388608L;
constexpr long OFF_DL = OFF_TAPC + 1048576L;
constexpr long OFF_DLC = OFF_DL + 16777216L;
constexpr long OFF_DC = OFF_DLC + 262144L;
constexpr long OFF_PDAB = OFF_DC + 65536L;
constexpr long OFF_GC = OFF_PDAB + 2359296L;
constexpr long OFF_BETA = OFF_GC + 2359296L;
constexpr long OFF_Y = OFF_BETA + 2359296L;
constexpr long OFF_AR = OFF_Y + 4 * U38;
constexpr long OFF_ROPE = OFF_AR + 7 * U38;
constexpr long OFF_BAR = OFF_ROPE + 2 * 262144L;
constexpr long WS_TOTAL = OFF_BAR + 16384L;
constexpr long WO_IN = 0, WO_G = 5783552L, WO_B = 9977856L, WO_O = 12075008L, WO_1 = 13123584L, WO_2 = 17317888L;
constexpr int LDS_BYTES = 139264;
constexpr int NPHASE = 1 + 4 * 14;

struct Prm {
  const float *x, *c, *ctx, *c_ctx, *w_ada, *b_ada, *norm1, *norm2, *w_in, *qk_gain, *lam, *subln, *hy_conv, *hy_w1,
      *hy_b1, *hy_freq, *hy_w2, *hy_b2, *hy_w3, *hy_bias, *dn_conv, *dn_a_log, *dn_dt_bias, *dn_norm, *w_gate,
      *w_branch, *w_o, *w_mlp1, *w_mlp2;
  float* out;
  char* ws;
};

DI int mytid() {
  int t = threadIdx.x;
  asm volatile("" : "+v"(t));
  return t;
}
DI int mybid() {
  int t = blockIdx.x;
  asm volatile("" : "+s"(t));
  return t;
}
DI void lds_barrier() {
  asm volatile("s_waitcnt lgkmcnt(0)" ::: "memory");
  __builtin_amdgcn_s_barrier();
  asm volatile("" ::: "memory");
}
typedef __bf16 bf16x2_t __attribute__((ext_vector_type(2)));
typedef float f32x2_t __attribute__((ext_vector_type(2)));
DI unsigned pk_bf16(float a, float b) {
  f32x2_t v = {a, b};
  bf16x2_t h = __builtin_convertvector(v, bf16x2_t);
  return *(unsigned*)&h;
}
DI u16 f2bf(float f) {
  __bf16 h = (__bf16)f;
  return *(u16*)&h;
}
DI float bf2f(u16 h) { return __uint_as_float(((unsigned)h) << 16); }
DI float wsum(float v) {
  for (int o = 32; o; o >>= 1) v += __shfl_xor(v, o);
  return v;
}
DI float wmax(float v) {
  for (int o = 32; o; o >>= 1) v = fmaxf(v, __shfl_xor(v, o));
  return v;
}
DI float siluf(float v) { return v / (1.f + __expf(-v)); }
DI float sigmf(float v) { return 1.f / (1.f + __expf(-v)); }
DI float* xrow(const Prm& p, int tok) {
  return tok < T_LAT ? p.out + (long)tok * 1024 : (float*)(p.ws + OFF_XC) + (long)(tok - T_LAT) * 1024;
}
DI int first_item(long base) {
  int G = gridDim.x;
  return (int)(((long)mybid() + G - (base % G)) % G);
}
DI int tokof(int b, int P) { return P < 256 ? T_LAT + b * 256 + P : b * 2048 + (P - 256); }

typedef __attribute__((ext_vector_type(4))) unsigned u32x4;
struct Stg { u32x4 a0, a1, a2, a3, b0, b1; };
template <int NA>
DI void g_load(Stg& r, const u16* Ap, long lda, const u16* Bp, long ldb, int k0) {
  r.a0 = *(const u32x4*)(Ap + k0);
  r.a1 = *(const u32x4*)(Ap + 64 * lda + k0);
  if constexpr (NA == 4) {
    r.a2 = *(const u32x4*)(Ap + 128 * lda + k0);
    r.a3 = *(const u32x4*)(Ap + 192 * lda + k0);
  }
  r.b0 = *(const u32x4*)(Bp + k0);
  r.b1 = *(const u32x4*)(Bp + 64 * ldb + k0);
}
template <int NA, int TM>
DI void s_store(const Stg& r, u16* ns_) {
  *(u32x4*)(ns_) = r.a0;
  *(u32x4*)(ns_ + 64 * 80) = r.a1;
  if constexpr (NA == 4) {
    *(u32x4*)(ns_ + 128 * 80) = r.a2;
    *(u32x4*)(ns_ + 192 * 80) = r.a3;
  }
  *(u32x4*)(ns_ + TM * 80) = r.b0;
  *(u32x4*)(ns_ + TM * 80 + 64 * 80) = r.b1;
}
template <int MI>
DI void t_compute(f32x4 (&acc)[MI][4], const u16* as, const u16* bs, int wm, int wn, int fr, int fq) {
#pragma unroll
  for (int ks = 0; ks < 2; ++ks) {
    bf16x8 a[MI], b[4];
#pragma unroll
    for (int mi = 0; mi < MI; ++mi) a[mi] = *(const bf16x8*)(as + (wm * MI * 16 + mi * 16 + fr) * 80 + ks * 32 + fq * 8);
#pragma unroll
    for (int ni = 0; ni < 4; ++ni) b[ni] = *(const bf16x8*)(bs + (wn * 64 + ni * 16 + fr) * 80 + ks * 32 + fq * 8);
#pragma unroll
    for (int mi = 0; mi < MI; ++mi)
#pragma unroll
      for (int ni = 0; ni < 4; ++ni) acc[mi][ni] = MFMA(b[ni], a[mi], acc[mi][ni]);
  }
}
template <int MI>
DI void gemm_tile(f32x4 (&acc)[MI][4], const u16* __restrict__ A, long lda, const u16* __restrict__ B, long ldb, int K,
                  char* smem, Stg& r0, Stg& r1, bool pre, const u16* nA, long nlda, const u16* nB, long nldb) {
  constexpr int TM = MI * 64;
  constexpr int STAGE = (TM + 128) * 80;
  constexpr int NA = TM * 8 / 512;
  u16* s = (u16*)smem;
  const int tid = mytid(), lane = tid & 63, wid = tid >> 6;
  const int wm = wid >> 1, wn = wid & 1, fr = lane & 15, fq = lane >> 4;
  const long to_a = (long)(tid >> 3), to_c = (tid & 7) * 8;
  const u16* Ap = A + to_a * lda + to_c;
  const u16* Bp = B + to_a * ldb + to_c;
  const u16* nAp = nA + to_a * nlda + to_c;
  const u16* nBp = nB + to_a * nldb + to_c;
  const int so = (tid >> 3) * 80 + (tid & 7) * 8;
#define GLOAD(r, k0) g_load<NA>(r, Ap, lda, Bp, ldb, (k0))
#define NLOAD(r, k0) g_load<NA>(r, nAp, nlda, nBp, nldb, (k0))
#define SSTORE(r, st) s_store<NA, TM>(r, s + (st) * STAGE + so)
#define COMPUTE(st) t_compute<MI>(acc, s + (st) * STAGE, s + (st) * STAGE + TM * 80, wm, wn, fr, fq)
#pragma unroll
  for (int mi = 0; mi < MI; ++mi)
#pragma unroll
    for (int ni = 0; ni < 4; ++ni) acc[mi][ni] = f32x4{0.f, 0.f, 0.f, 0.f};
  const int nk = K >> 6;
  if (!pre) {
    GLOAD(r0, 0);
    GLOAD(r1, 64);
  }
  SSTORE(r0, 0);
  lds_barrier();
  for (int kt = 0; kt < nk; kt += 2) {
    if (kt + 2 < nk) GLOAD(r0, (kt + 2) << 6);
    else if (nA) NLOAD(r0, 0);
    COMPUTE(0);
    SSTORE(r1, 1);
    lds_barrier();
    if (kt + 3 < nk) GLOAD(r1, (kt + 3) << 6);
    else if (nA) NLOAD(r1, 64);
    COMPUTE(1);
    if (kt + 2 < nk) SSTORE(r0, 0);
    lds_barrier();
  }
#undef GLOAD
#undef NLOAD
#undef SSTORE
#undef COMPUTE
}

struct TD {
  const u16* A;
  const u16* B;
  u16* C;
  long lda, ldb, ldc;
  int K;
  int mode;
  int split;
  float scale;
  int tok0, col0;
  const float* g;
};

DI void run_tile2(const Prm& p, const TD& d, char* smem, Stg& r0, Stg& r1, bool pre, const u16* nA, long nlda,
                 const u16* nB, long nldb);
DI void run_tile(const Prm& p, const TD& d, char* smem) {
  Stg r0, r1;
  run_tile2(p, d, smem, r0, r1, false, nullptr, 0, nullptr, 0);
}
DI void run_tile2(const Prm& p, const TD& d, char* smem, Stg& r0, Stg& r1, bool pre, const u16* nA, long nlda,
                 const u16* nB, long nldb) {
  f32x4 acc[4][4];
  gemm_tile<4>(acc, d.A, d.lda, d.B, d.ldb, d.K, smem, r0, r1, pre, nA, nlda, nB, nldb);
  const int tid = mytid(), lane = tid & 63, wid = tid >> 6;
  const int wm = wid >> 1, wn = wid & 1, fr = lane & 15, fq = lane >> 4;
  if (d.mode == 4) {
    const int which = d.col0 >> 2, h = d.col0 & 3;
    const float* gain = d.g + which * 64 + fq * 4;
    const float* RC = (const float*)(p.ws + OFF_ROPE);
    const float* RS = RC + 65536;
    u16* dstb = d.C + (which ? 18874368L : 0L);
    const float qs = which ? 1.f : 0.18033688011112042f;
#pragma unroll
    for (int mi = 0; mi < 4; ++mi) {
      const int tok = d.tok0 + wm * 64 + mi * 16 + fr;
      float ss = 0.f;
#pragma unroll
      for (int ni = 0; ni < 4; ++ni)
#pragma unroll
        for (int j = 0; j < 4; ++j) ss += acc[mi][ni][j] * acc[mi][ni][j];
      ss += __shfl_xor(ss, 16);
      ss += __shfl_xor(ss, 32);
      const float inv = rsqrtf(ss * (1.f / 64.f) + 1e-6f) * qs;
      int b, P;
      const bool lat = tok < T_LAT;
      if (lat) { b = tok >> 11; P = 256 + (tok & 2047); }
      else { b = (tok - T_LAT) >> 8; P = (tok - T_LAT) & 255; }
      float y[4][4];
#pragma unroll
      for (int ni = 0; ni < 4; ++ni) {
        float4 g4 = *(const float4*)(gain + ni * 16);
        y[ni][0] = acc[mi][ni][0] * inv * g4.x; y[ni][1] = acc[mi][ni][1] * inv * g4.y;
        y[ni][2] = acc[mi][ni][2] * inv * g4.z; y[ni][3] = acc[mi][ni][3] * inv * g4.w;
      }
      u16* dst = dstb + ((long)((b * 4 + h) * 2 + wn) * 2304 + P) * 64 + fq * 4;
#pragma unroll
      for (int ni = 0; ni < 4; ++ni) {
        float o0 = y[ni][0], o1 = y[ni][1], o2 = y[ni][2], o3 = y[ni][3];
        if (lat) {
          const int l = tok & 2047, a = ni >> 1;
          float4 c4 = *(const float4*)(RC + (l * 2 + a) * 16 + fq * 4);
          float4 s4 = *(const float4*)(RS + (l * 2 + a) * 16 + fq * 4);
          const float sg = (ni & 1) ? 1.f : -1.f;
          o0 = y[ni][0] * c4.x + sg * y[ni ^ 1][0] * s4.x;
          o1 = y[ni][1] * c4.y + sg * y[ni ^ 1][1] * s4.y;
          o2 = y[ni][2] * c4.z + sg * y[ni ^ 1][2] * s4.z;
          o3 = y[ni][3] * c4.w + sg * y[ni ^ 1][3] * s4.w;
        }
        uint2 o;
        o.x = pk_bf16(o0, o1);
        o.y = pk_bf16(o2, o3);
        *(uint2*)(dst + ni * 16) = o;
      }
    }
    return;
  }
#pragma unroll
  for (int mi = 0; mi < 4; ++mi)
#pragma unroll
    for (int ni = 0; ni < 4; ++ni) {
      int r = wm * 64 + mi * 16 + fr, c = wn * 64 + ni * 16 + fq * 4;
      f32x4 v = acc[mi][ni];
      if (d.mode == 0) {
        long ro = d.split ? ((long)(r & 127) * d.ldc + (long)(r >> 7) * d.split) : (long)r * d.ldc;
        ushort4 o;
        o.x = f2bf(v[0] * d.scale); o.y = f2bf(v[1] * d.scale); o.z = f2bf(v[2] * d.scale); o.w = f2bf(v[3] * d.scale);
        *(ushort4*)(d.C + ro + c) = o;
      } else if (d.mode == 1) {
        ushort4 o;
        float t0 = fmaxf(v[0], 0.f), t1 = fmaxf(v[1], 0.f), t2 = fmaxf(v[2], 0.f), t3 = fmaxf(v[3], 0.f);
        o.x = f2bf(t0 * t0); o.y = f2bf(t1 * t1); o.z = f2bf(t2 * t2); o.w = f2bf(t3 * t3);
        *(ushort4*)(d.C + (long)r * d.ldc + c) = o;
      } else if (d.mode == 3) {
        if (wn == 0 && ni == 0) *(float4*)((float*)d.C + (long)r * 16 + fq * 4) = float4{v[0], v[1], v[2], v[3]};
      } else {
        float4* xp = (float4*)(xrow(p, d.tok0 + r) + d.col0 + c);
        float4 g4 = *(const float4*)(d.g + d.col0 + c);
        float4 x4 = *xp;
        x4.x += g4.x * v[0]; x4.y += g4.y * v[1]; x4.z += g4.z * v[2]; x4.w += g4.w * v[3];
        *xp = x4;
      }
    }
}

DI void ph_init(const Prm& p, char* smem) {
  const long gt = (long)mybid() * 512 + mytid(), gn = (long)gridDim.x * 512;
  {
    const float4* s = (const float4*)p.x;
    float4* d = (float4*)p.out;
    for (long i = gt; i < 32768L * 256; i += gn) d[i] = s[i];
    const float4* s2 = (const float4*)p.ctx;
    float4* d2 = (float4*)(p.ws + OFF_XC);
    for (long i = gt; i < 4096L * 256; i += gn) d2[i] = s2[i];
  }
  {
    u16* DL = (u16*)(p.ws + OFF_DL);
    for (long i = gt; i < 2048L * 4096; i += gn) {
      int l = (int)(i >> 12), kk = (int)(i & 4095), lp = kk & 2047, part = kk >> 11;
      int m = (l * lp) & 2047;
      float ang = (float)m * (6.283185307179586f / 2048.f);
      DL[i] = f2bf(part ? -sinf(ang) : cosf(ang));
    }
    u16* DLC = (u16*)(p.ws + OFF_DLC);
    for (long i = gt; i < 256L * 512; i += gn) {
      int l = (int)(i >> 9), kk = (int)(i & 511), lp = kk & 255, part = kk >> 8;
      int m = (l * lp) & 255;
      float ang = (float)m * (6.283185307179586f / 256.f);
      DLC[i] = f2bf(part ? -sinf(ang) : cosf(ang));
    }
    {
      float* RC = (float*)(p.ws + OFF_ROPE);
      float* RS = RC + 65536;
      for (long i = gt; i < 65536; i += gn) {
        int l = (int)(i >> 5), a = (int)(i >> 4) & 1, f = (int)(i & 15);
        float pos = a ? (float)(l & 63) : (float)(l >> 6);
        float ang = pos * powf(10000.f, -(float)f / 16.f);
        RC[i] = cosf(ang);
        RS[i] = sinf(ang);
      }
    }
    u16* DC = (u16*)(p.ws + OFF_DC);
    for (long i = gt; i < 256L * 128; i += gn) {
      int j2 = (int)(i >> 7), ii = (int)(i & 127), part = j2 >> 7, j = j2 & 127;
      int m = (ii * j) & 127;
      float ang = (float)m * (6.283185307179586f / 128.f);
      DC[i] = f2bf(part ? sinf(ang) : cosf(ang));
    }
  }
  float* sc = (float*)smem;
  float* red = sc + 17 * 1024;
  const int tid = mytid();
  for (int e = tid; e < 17 * 1024; e += 512) {
    int bb = e >> 10, k = e & 1023;
    float v = bb < 16 ? p.c[bb * 1024 + k] : p.c_ctx[k];
    sc[e] = v / (1.f + expf(-v));
  }
  __syncthreads();
  float* MOD = (float*)(p.ws + OFF_MOD);
  for (int it = mybid(); it < 192; it += gridDim.x) {
    int li = it / 48, cgp = it % 48;
    int cl = tid & 127, kq = tid >> 7, n = cgp * 128 + cl;
    float a[17];
#pragma unroll
    for (int b = 0; b < 17; ++b) a[b] = 0.f;
    const float* w = p.w_ada + ((long)li * 1024 + kq * 256) * 6144 + n;
#pragma unroll 2
    for (int k = 0; k < 256; ++k) {
      float wv = w[(long)k * 6144];
#pragma unroll
      for (int b = 0; b < 17; ++b) a[b] += sc[b * 1024 + kq * 256 + k] * wv;
    }
#pragma unroll
    for (int b = 0; b < 17; ++b) red[(kq * 17 + b) * 128 + cl] = a[b];
    __syncthreads();
    for (int e = tid; e < 17 * 128; e += 512) {
      int b = e >> 7, c2 = e & 127, n2 = cgp * 128 + c2;
      float v = p.b_ada[li * 6144 + n2];
      for (int q = 0; q < 4; ++q) v += red[(q * 17 + b) * 128 + c2];
      MOD[((long)li * 17 + b) * 6144 + n2] = v;
    }
    __syncthreads();
  }
}

DI long tr_job(long base, const float* src, int K, int N, u16* dst, int nb, char* smem) {
  float* t = (float*)smem;
  const int tk = K >> 6, tn = (N + 63) >> 6, per = tk * tn, total = per * nb;
  const int tid = mytid();
  const int G = gridDim.x;
  float v[8];
  int it = first_item(base);
  if (it < total) {
    int b = it / per, r = it % per, kt = r / tn, nt = r % tn;
    const float* s = src + (long)b * K * N;
#pragma unroll
    for (int i = 0; i < 8; ++i) {
      int id = tid + i * 512, kk = id >> 6, nn = id & 63;
      v[i] = (nt * 64 + nn < N) ? s[(long)(kt * 64 + kk) * N + nt * 64 + nn] : 0.f;
    }
  }
  for (; it < total; it += G) {
    int b = it / per, r = it % per, kt = r / tn, nt = r % tn;
    u16* d = dst + (long)b * K * N;
    int k0 = kt * 64, n0 = nt * 64;
#pragma unroll
    for (int i = 0; i < 8; ++i) {
      int id = tid + i * 512, kk = id >> 6, nn = id & 63;
      t[kk * 65 + nn] = v[i];
    }
    __syncthreads();
    if (it + G < total) {
      int it2 = it + G, b2 = it2 / per, r2 = it2 % per, kt2 = r2 / tn, nt2 = r2 % tn;
      const float* s2 = src + (long)b2 * K * N;
#pragma unroll
      for (int i = 0; i < 8; ++i) {
        int id = tid + i * 512, kk = id >> 6, nn = id & 63;
        v[i] = (nt2 * 64 + nn < N) ? s2[(long)(kt2 * 64 + kk) * N + nt2 * 64 + nn] : 0.f;
      }
    }
#pragma unroll
    for (int i = 0; i < 8; ++i) {
      int id = tid + i * 512, nn = id >> 6, kk = id & 63;
      if (n0 + nn < N) d[(long)(n0 + nn) * K + k0 + kk] = f2bf(t[kk * 65 + nn]);
    }
    __syncthreads();
  }
  return base + total;
}

DI void ph_norm(const Prm& p, int li, int which) {
  const int lane = mytid() & 63;
  const int gw = mybid() * 8 + (mytid() >> 6), nw = gridDim.x * 8;
  const float* nwt = (which ? p.norm2 : p.norm1) + li * 1024;
  const float* MOD = (const float*)(p.ws + OFF_MOD);
  u16* H = (u16*)(p.ws + OFF_HBF);
  const int nrows = (which && li == 3) ? T_LAT : T_ALL;
  for (int row = gw; row < nrows; row += 2 * nw) {
    const int row2 = row + nw;
    const bool has2 = row2 < nrows;
    const float* xr = xrow(p, row);
    const float* xr2 = xrow(p, has2 ? row2 : row);
    float4 v[4], u[4];
    float ss = 0.f, ss2 = 0.f;
#pragma unroll
    for (int i = 0; i < 4; ++i) {
      v[i] = *(const float4*)(xr + i * 256 + lane * 4);
      u[i] = *(const float4*)(xr2 + i * 256 + lane * 4);
    }
#pragma unroll
    for (int i = 0; i < 4; ++i) {
      ss += v[i].x * v[i].x + v[i].y * v[i].y + v[i].z * v[i].z + v[i].w * v[i].w;
      ss2 += u[i].x * u[i].x + u[i].y * u[i].y + u[i].z * u[i].z + u[i].w * u[i].w;
    }
#pragma unroll
    for (int o = 32; o; o >>= 1) {
      ss += __shfl_xor(ss, o);
      ss2 += __shfl_xor(ss2, o);
    }
    const float inv = rsqrtf(ss * (1.f / 1024.f) + 1e-6f), inv2 = rsqrtf(ss2 * (1.f / 1024.f) + 1e-6f);
    const int bb = row < T_LAT ? (row >> 11) : 16, bb2 = row2 < T_LAT ? (row2 >> 11) : 16;
    const float* sh = MOD + ((long)li * 17 + bb) * 6144 + (which ? 3 : 0) * 1024;
    const float* sh2 = MOD + ((long)li * 17 + (has2 ? bb2 : bb)) * 6144 + (which ? 3 : 0) * 1024;
#pragma unroll
    for (int i = 0; i < 4; ++i) {
      int c = i * 256 + lane * 4;
      float4 w4 = *(const float4*)(nwt + c);
      {
        float4 s4 = *(const float4*)(sh + 1024 + c), h4 = *(const float4*)(sh + c);
        uint2 o;
        o.x = pk_bf16(v[i].x * inv * w4.x * (1.f + s4.x) + h4.x, v[i].y * inv * w4.y * (1.f + s4.y) + h4.y);
        o.y = pk_bf16(v[i].z * inv * w4.z * (1.f + s4.z) + h4.z, v[i].w * inv * w4.w * (1.f + s4.w) + h4.w);
        *(uint2*)(H + (long)row * 1024 + c) = o;
      }
      if (has2) {
        float4 s4 = *(const float4*)(sh2 + 1024 + c), h4 = *(const float4*)(sh2 + c);
        uint2 o;
        o.x = pk_bf16(u[i].x * inv2 * w4.x * (1.f + s4.x) + h4.x, u[i].y * inv2 * w4.y * (1.f + s4.y) + h4.y);
        o.y = pk_bf16(u[i].z * inv2 * w4.z * (1.f + s4.z) + h4.z, u[i].w * inv2 * w4.w * (1.f + s4.w) + h4.w);
        *(uint2*)(H + (long)row2 * 1024 + c) = o;
      }
    }
  }
}

DI void ph_taps1(const Prm& p, int li, long base, char* smem) {
  float* f = (float*)smem;
  float* hraw = (float*)(p.ws + OFF_AR + 5 * U38);
  const int tid = mytid();
  for (int it = first_item(base); it < 288; it += gridDim.x) {
    const int L = it < 256 ? 2048 : 256, j0 = it < 256 ? it * 8 : (it - 256) * 8;
    const int lg = tid >> 6, kk = tid & 63;
    if (tid < 8 * 33) {
      int l2 = tid / 33, e = tid % 33, j = j0 + l2;
      float t = (float)j / (float)(L - 1);
      float w = 6.283185307179586f * (float)j / (float)L;
      float v;
      if (e == 0) v = t;
      else {
        int bi = (e - 1) & 15;
        float band = 1e-4f + (float)bi * ((15.f - 1e-4f) / 15.f);
        v = (e <= 16) ? cosf(band * w) : -sinf(band * w);
      }
      f[l2 * 40 + e] = v;
    }
    __syncthreads();
    {
      float v = p.hy_b1[li * 64 + kk];
#pragma unroll 3
      for (int e = 0; e < 33; ++e) v += f[lg * 40 + e] * p.hy_w1[(li * 33 + e) * 64 + kk];
      f[320 + lg * 64 + kk] = sinf(p.hy_freq[(li * 2 + 0) * 64 + kk] * v);
    }
    __syncthreads();
    {
      float v = p.hy_b2[li * 64 + kk];
#pragma unroll 4
      for (int m = 0; m < 64; ++m) v += f[320 + lg * 64 + m] * p.hy_w2[(li * 64 + m) * 64 + kk];
      f[832 + lg * 64 + kk] = sinf(p.hy_freq[(li * 2 + 1) * 64 + kk] * v);
    }
    __syncthreads();
    {
      float h[4][8];
#pragma unroll
      for (int i = 0; i < 4; ++i)
#pragma unroll
        for (int l2 = 0; l2 < 8; ++l2) h[i][l2] = 0.f;
      const float* w3 = p.hy_w3 + (long)li * 64 * 2048 + tid;
#pragma unroll 2
      for (int k = 0; k < 64; ++k) {
        float wv[4];
#pragma unroll
        for (int i = 0; i < 4; ++i) wv[i] = w3[(long)k * 2048 + i * 512];
#pragma unroll
        for (int l2 = 0; l2 < 8; ++l2) {
          float hv = f[832 + l2 * 64 + k];
#pragma unroll
          for (int i = 0; i < 4; ++i) h[i][l2] += hv * wv[i];
        }
      }
#pragma unroll
      for (int i = 0; i < 4; ++i) {
        int n = tid + i * 512, ch = n & 511;
        float delta = fabsf(-3.0701134573253946f + (float)ch * ((-15.350567286626973f + 3.0701134573253946f) / 511.f));
#pragma unroll
        for (int l2 = 0; l2 < 8; ++l2) {
          int j = j0 + l2;
          float t = (float)j / (float)(L - 1);
          long row = (it < 256) ? j : 2048 + j;
          hraw[row * 2048 + n] = h[i][l2] * expf(-t * delta);
        }
      }
    }
    __syncthreads();
  }
}
DI void ph_taps2(const Prm& p, long base, char* smem) {
  float* vals = (float*)smem;
  float* red = vals + 8 * 2048;
  const float* hraw = (const float*)(p.ws + OFF_AR + 5 * U38);
  const int tid = mytid(), cl = tid & 3, dir = (tid >> 2) & 1, jg = tid >> 3;
  for (int it = first_item(base); it < 512; it += gridDim.x) {
    int ls = it >> 8, order = (it >> 7) & 1, cgp = it & 127;
    int L = ls ? 256 : 2048;
    const float* hr = hraw + (long)(ls ? 2048 : 0) * 2048;
    u16* G = (u16*)(p.ws + (ls ? OFF_TAPC : OFF_TAPL));
    int ch = cgp * 4 + cl, n = order * 1024 + dir * 512 + ch;
    float s = 0.f;
#pragma unroll 8
    for (int j = jg; j < L; j += 64) {
      float v = hr[(long)j * 2048 + n];
      vals[(cl * 2 + dir) * L + j] = v;
      s += (dir == 1 && j == 0) ? 0.f : fabsf(v);
    }
    red[(tid >> 2) * 4 + cl] = s;
    __syncthreads();
    if (tid < 4) {
      float tot = 0.f;
#pragma unroll 8
      for (int r = 0; r < 128; ++r) tot += red[r * 4 + tid];
      red[512 + tid] = 1.f / tot;
    }
    __syncthreads();
    for (int idx = tid; idx < 8 * L; idx += 512) {
      int q = idx / L, j = idx % L, c2 = q >> 1, d2 = q & 1;
      float v = vals[idx] * red[512 + c2];
      u16* g = G + (long)(order * 512 + cgp * 4 + c2) * (2 * L);
      if (d2 == 0) g[L + j] = f2bf(v);
      else if (j > 0) g[L - j] = f2bf(v);
      else g[0] = 0;
    }
    __syncthreads();
  }
}

DI void ph_pdab(const Prm& p, int li, char* smem) {
  float* wl = (float*)smem;
  const int tid = mytid(), lane = tid & 63;
#pragma unroll 8
  for (int e = tid; e < 1024 * 16; e += 512) wl[e] = p.w_in[((long)li * 1024 + (e >> 4)) * NIN + 5632 + (e & 15)];
  __syncthreads();
  const u16* H = (const u16*)(p.ws + OFF_HBF);
  float* out = (float*)(p.ws + OFF_PDAB);
  const int gw = mybid() * 8 + (tid >> 6), nw = gridDim.x * 8;
  for (int tok = gw; tok < T_ALL; tok += nw) {
    float a[16];
#pragma unroll
    for (int j = 0; j < 16; ++j) a[j] = 0.f;
    float hv[16];
#pragma unroll
    for (int i = 0; i < 16; ++i) hv[i] = bf2f(H[(long)tok * 1024 + lane + i * 64]);
#pragma unroll
    for (int i = 0; i < 16; ++i) {
      float h = hv[i];
      const float4* wp = (const float4*)(wl + (lane + i * 64) * 16);
#pragma unroll
      for (int q = 0; q < 4; ++q) {
        float4 w4 = wp[q];
        a[q * 4 + 0] += h * w4.x;
        a[q * 4 + 1] += h * w4.y;
        a[q * 4 + 2] += h * w4.z;
        a[q * 4 + 3] += h * w4.w;
      }
      if ((i & 3) == 3) asm volatile("" ::: "memory");
    }
#pragma unroll
    for (int o = 32; o; o >>= 1)
#pragma unroll
      for (int j = 0; j < 16; ++j) a[j] += __shfl_xor(a[j], o);
    float v = a[0];
#pragma unroll
    for (int j = 1; j < 16; ++j) v = (lane == j) ? a[j] : v;
    if (lane < 16) out[(long)tok * 16 + lane] = v;
  }
  __syncthreads();
}

DI void ph_dncl(const Prm& p, int li, char* smem) {
  const int tid = mytid(), lane = tid & 63, wid = tid >> 6, fr = lane & 15, fq = lane >> 4;
  u16* qn = (u16*)smem;
  u16* kn = qn + 64 * 144;
  float* fb = (float*)(smem + 36864);
  float* KK = fb;
  float* QK = KK + 64 * 65;
  float* Am = QK + 64 * 65;
  float* Tm = Am + 2 * 64 * 65;
  float* gcs = Tm + 2 * 64 * 65;
  float* bts = gcs + 128;
  const u16* PD = (const u16*)(p.ws + OFF_AR);
  const float* AB = (const float*)(p.ws + OFF_PDAB);
  u16* DQ = (u16*)(p.ws + OFF_Y);
  u16* DK = DQ + 18874368L;
  u16* DV = DK + 18874368L;
  u16* CL = (u16*)(p.ws + OFF_AR + 3 * U38);
  float* GC = (float*)(p.ws + OFF_GC);
  float* BT = (float*)(p.ws + OFF_BETA);
  const float* cw = p.dn_conv + (long)li * 3 * 1536;
  for (int it = mybid(); it < 2304; it += gridDim.x) {
    const int b = it / 144, r0 = it % 144, oc = r0 >> 2, h = r0 & 3;
    const int pos0 = oc * 64, s0 = oc < 4 ? 0 : 256, e0 = oc < 4 ? 256 : 2304;
    if (tid < 384) {
      const int cgp = tid % 48, rs = tid / 48;
      const int part = cgp >> 4, d0 = (cgp & 15) * 8, col = part * 512 + h * 128 + d0;
      const u16* basep = PD + (long)tokof(b, pos0) * 1536 + col;
      float wt[3][8];
#pragma unroll
      for (int tp = 0; tp < 3; ++tp) {
        float4 wa = *(const float4*)(cw + tp * 1536 + col), wb = *(const float4*)(cw + tp * 1536 + col + 4);
        wt[tp][0] = wa.x; wt[tp][1] = wa.y; wt[tp][2] = wa.z; wt[tp][3] = wa.w;
        wt[tp][4] = wb.x; wt[tp][5] = wb.y; wt[tp][6] = wb.z; wt[tp][7] = wb.w;
      }
#pragma unroll 1
      for (int hf = 0; hf < 2; ++hf) {
        u32x4 rw[6];
#pragma unroll
        for (int i = 0; i < 6; ++i) {
          int j = rs * 8 + hf * 4 - 1 + i, P = pos0 + j;
          rw[i] = (P >= s0 && P < e0) ? *(const u32x4*)(basep + (long)j * 1536) : u32x4{0u, 0u, 0u, 0u};
        }
#pragma unroll
        for (int r = 0; r < 4; ++r) {
#pragma unroll
          for (int e = 0; e < 8; ++e) {
            unsigned w0_ = rw[r][e >> 1], w1_ = rw[r + 1][e >> 1], w2_ = rw[r + 2][e >> 1];
            float x0 = (e & 1) ? __uint_as_float(w0_ & 0xffff0000u) : __uint_as_float(w0_ << 16);
            float x1 = (e & 1) ? __uint_as_float(w1_ & 0xffff0000u) : __uint_as_float(w1_ << 16);
            float x2 = (e & 1) ? __uint_as_float(w2_ & 0xffff0000u) : __uint_as_float(w2_ << 16);
            float v = wt[0][e] * x0 + wt[1][e] * x1 + wt[2][e] * x2;
            fb[(rs * 8 + hf * 4 + r) * 385 + part * 128 + d0 + e] = v / (1.f + __expf(-v));
          }
        }
      }
    }
    __syncthreads();
    for (int jj = 0; jj < 8; ++jj) {
      int j = wid * 8 + jj, P = pos0 + j;
      long go = ((long)(b * 4 + h) * 2304 + P) * 128;
      float q0 = fb[j * 385 + lane], q1 = fb[j * 385 + 64 + lane];
      float k0 = fb[j * 385 + 128 + lane], k1 = fb[j * 385 + 192 + lane];
      float v0 = fb[j * 385 + 256 + lane], v1 = fb[j * 385 + 320 + lane];
      float iq = rsqrtf(wsum(q0 * q0 + q1 * q1) + 1e-6f), ik = rsqrtf(wsum(k0 * k0 + k1 * k1) + 1e-6f);
      u16 a0 = f2bf(q0 * iq), a1 = f2bf(q1 * iq), c0 = f2bf(k0 * ik), c1 = f2bf(k1 * ik);
      qn[j * 144 + lane] = a0; qn[j * 144 + 64 + lane] = a1;
      kn[j * 144 + lane] = c0; kn[j * 144 + 64 + lane] = c1;
      DQ[go + lane] = a0; DQ[go + 64 + lane] = a1;
      DK[go + lane] = c0; DK[go + 64 + lane] = c1;
      DV[go + lane] = f2bf(v0); DV[go + 64 + lane] = f2bf(v1);
    }
    __syncthreads();
#pragma unroll
    for (int u = 0; u < 4; ++u) {
      int tt = wid * 4 + u, which = tt >> 4, ti = (tt >> 2) & 3, tj = tt & 3;
      const u16* Ap = (which ? qn : kn) + (ti * 16 + fr) * 144 + fq * 8;
      const u16* Bp = kn + (tj * 16 + fr) * 144 + fq * 8;
      f32x4 a = {0.f, 0.f, 0.f, 0.f};
#pragma unroll
      for (int ks = 0; ks < 4; ++ks) a = MFMA(*(const bf16x8*)(Ap + ks * 32), *(const bf16x8*)(Bp + ks * 32), a);
      float* dst = which ? QK : KK;
#pragma unroll
      for (int j = 0; j < 4; ++j) dst[(ti * 16 + fq * 4 + j) * 65 + tj * 16 + fr] = a[j];
    }
    if (tid < 128) {
      int d = tid >> 6, r = tid & 63, j = d ? 63 - r : r;
      int tok = tokof(b, pos0 + j);
      float av = AB[(long)tok * 16 + d * 4 + h], bv = AB[(long)tok * 16 + 8 + d * 4 + h];
      float xx = av + p.dn_dt_bias[li * 8 + d * 4 + h];
      float sp = fmaxf(xx, 0.f) + __logf(1.f + __expf(-fabsf(xx)));
      float g = -expf(p.dn_a_log[li * 8 + d * 4 + h]) * sp;
      for (int o = 1; o < 64; o <<= 1) {
        float t = __shfl_up(g, o);
        if (r >= o) g += t;
      }
      float be = 1.f / (1.f + expf(-bv));
      gcs[d * 64 + r] = g;
      bts[d * 64 + r] = be;
      long ci = ((long)((b * 4 + h) * 2 + d) * 36 + oc) * 64 + r;
      GC[ci] = g;
      BT[ci] = be;
    }
    __syncthreads();
#pragma unroll 4
    for (int e = tid; e < 8192; e += 512) {
      int d = e >> 12, s = (e >> 6) & 63, r = e & 63;
      int j = d ? 63 - r : r, js = d ? 63 - s : s;
      float v = 0.f;
      if (r > s) v = bts[d * 64 + r] * KK[j * 65 + js] * expf(gcs[d * 64 + r] - gcs[d * 64 + s]);
      Am[(d * 64 + s) * 64 + r] = v;
    }
#pragma unroll 4
    for (int e = tid; e < 8192; e += 512) {
      int d = e >> 12, r = (e >> 6) & 63, s = e & 63;
      int j = d ? 63 - r : r, js = d ? 63 - s : s;
      float dec = (r >= s) ? expf(gcs[d * 64 + r] - gcs[d * 64 + s]) : 0.f;
      long ci = (long)((b * 4 + h) * 2 + d) * 36 + oc;
      CL[ci * 8192 + 4096 + r * 64 + s] = f2bf(QK[j * 65 + js] * dec * 0.08838834764831845f);
    }
    __syncthreads();
    {
      const int d = tid >> 8, c = (tid >> 2) & 63, q = tid & 3;
      const float* Atq = Am + d * 64 * 64 + q;
      float* T = Tm + d * 64 * 65;
      float t[16];
#pragma unroll
      for (int i = 0; i < 16; ++i) t[i] = (4 * i + q == c) ? 1.f : 0.f;
#pragma unroll
      for (int s2 = 0; s2 < 63; ++s2) {
        constexpr int dummy = 0;
        const int is = s2 >> 2, qs = s2 & 3;
        const int ctl = qs | (qs << 2) | (qs << 4) | (qs << 6);
        int tsb;
        if (qs == 0) tsb = __builtin_amdgcn_update_dpp(0, __float_as_int(t[is]), 0x00, 0xf, 0xf, false);
        else if (qs == 1) tsb = __builtin_amdgcn_update_dpp(0, __float_as_int(t[is]), 0x55, 0xf, 0xf, false);
        else if (qs == 2) tsb = __builtin_amdgcn_update_dpp(0, __float_as_int(t[is]), 0xAA, 0xf, 0xf, false);
        else tsb = __builtin_amdgcn_update_dpp(0, __float_as_int(t[is]), 0xFF, 0xf, 0xf, false);
        (void)ctl; (void)dummy;
        const float ts = __int_as_float(tsb);
#pragma unroll
        for (int i = is; i < 16; ++i) t[i] -= Atq[s2 * 64 + 4 * i] * ts;
        if ((s2 & 7) == 7) asm volatile("" ::: "memory");
      }
#pragma unroll
      for (int i = 0; i < 16; ++i) T[(4 * i + q) * 65 + c] = t[i];
    }
    __syncthreads();
    for (int e = tid; e < 8192; e += 512) {
      int d = e >> 12, rc = e & 4095;
      long ci = (long)((b * 4 + h) * 2 + d) * 36 + oc;
      CL[ci * 8192 + rc] = f2bf(Tm[(d * 64 + (rc >> 6)) * 65 + (rc & 63)]);
    }
    __syncthreads();
  }
}

DI void ph_dnscan(const Prm& p, char* smem) {
  const int tid = mytid(), lane = tid & 63, wid = tid >> 6, fr = lane & 15, fq = lane >> 4;
  u16* Kg = (u16*)smem;
  u16* Qg = Kg + 64 * 144;
  u16* KdT = Qg + 64 * 144;
  u16* Tl = KdT + 128 * 80;
  u16* Il = Tl + 64 * 80;
  u16* ST = Il + 64 * 80;
  u16* RT = ST + 64 * 144;
  u16* VN = RT + 64 * 80;
  const u16* DQ = (const u16*)(p.ws + OFF_Y);
  const u16* DK = DQ + 18874368L;
  const u16* DV = DK + 18874368L;
  const u16* CL = (const u16*)(p.ws + OFF_AR + 3 * U38);
  const float* GC = (const float*)(p.ws + OFF_GC);
  const float* BT = (const float*)(p.ws + OFF_BETA);
  const int vt = wid & 3, rp = wid >> 2;
  for (int it = mybid(); it < 256; it += gridDim.x) {
    const int b = it >> 4, h = (it >> 2) & 3, d = (it >> 1) & 1, vs = it & 1;
    u16* O = (u16*)(p.ws + OFF_AR + (d ? 6 : 5) * U38);
    f32x4 S[4];
#pragma unroll
    for (int i = 0; i < 4; ++i) S[i] = f32x4{0.f, 0.f, 0.f, 0.f};
    for (int e = tid; e < 64 * 144; e += 512) ST[e] = 0;
    const long seqb = (long)(b * 4 + h) * 2304;
    const long cib = (long)((b * 4 + h) * 2 + d) * 36;
    u32x4 rk0, rk1, rq0, rq1, rT, rI;
    float rg0, rg1, rgl;
    uint2 rv0, rv1;
    float rb0, rb1;
    const int lr0 = tid >> 4, lr1 = (tid + 512) >> 4, lch = tid & 15;
    const int lj0 = d ? 63 - lr0 : lr0, lj1 = d ? 63 - lr1 : lr1;
    const int vr0 = (rp * 2) * 16 + fr, vr1 = (rp * 2 + 1) * 16 + fr;
    const int vj0 = d ? 63 - vr0 : vr0, vj1 = d ? 63 - vr1 : vr1;
#define SCAN_LOAD_KQ(ocx)                                                                    \
  {                                                                                          \
    const long ci_ = cib + (ocx);                                                            \
    const long g0_ = (seqb + (ocx) * 64 + lj0) * 128 + lch * 8, g1_ = (seqb + (ocx) * 64 + lj1) * 128 + lch * 8; \
    rk0 = *(const u32x4*)(DK + g0_); rk1 = *(const u32x4*)(DK + g1_);                        \
    rq0 = *(const u32x4*)(DQ + g0_); rq1 = *(const u32x4*)(DQ + g1_);                        \
    rT = *(const u32x4*)(CL + ci_ * 8192 + (tid >> 3) * 64 + (tid & 7) * 8);                 \
    rI = *(const u32x4*)(CL + ci_ * 8192 + 4096 + (tid >> 3) * 64 + (tid & 7) * 8);          \
    rg0 = GC[ci_ * 64 + lr0]; rg1 = GC[ci_ * 64 + lr1]; rgl = GC[ci_ * 64 + 63];             \
  }
#define SCAN_LOAD_V(ocx)                                                                     \
  {                                                                                          \
    const long ci_ = cib + (ocx);                                                            \
    rv0 = *(const uint2*)(DV + (seqb + (ocx) * 64 + vj0) * 128 + vs * 64 + vt * 16 + fq * 4); \
    rv1 = *(const uint2*)(DV + (seqb + (ocx) * 64 + vj1) * 128 + vs * 64 + vt * 16 + fq * 4); \
    rb0 = BT[ci_ * 64 + vr0]; rb1 = BT[ci_ * 64 + vr1];                                      \
  }
    {
      const int oc0 = d ? 3 : 0;
      SCAN_LOAD_KQ(oc0);
      SCAN_LOAD_V(oc0);
    }
    for (int i = 0; i < 36; ++i) {
      const int oc = d ? (i < 4 ? 3 - i : 39 - i) : i;
      const int ocn = d ? (i + 1 < 4 ? 3 - (i + 1) : 39 - (i + 1)) : i + 1;
      const int pos0 = oc * 64;
      const float gl = rgl;
      {
        float eg0 = __expf(rg0), ed0 = __expf(gl - rg0), eg1 = __expf(rg1), ed1 = __expf(gl - rg1);
        u32x4 ko0, qo0, ko1, qo1;
#pragma unroll
        for (int w = 0; w < 4; ++w) {
          float k0l = __uint_as_float(rk0[w] << 16), k0h = __uint_as_float(rk0[w] & 0xffff0000u);
          float q0l = __uint_as_float(rq0[w] << 16), q0h = __uint_as_float(rq0[w] & 0xffff0000u);
          float k1l = __uint_as_float(rk1[w] << 16), k1h = __uint_as_float(rk1[w] & 0xffff0000u);
          float q1l = __uint_as_float(rq1[w] << 16), q1h = __uint_as_float(rq1[w] & 0xffff0000u);
          ko0[w] = (unsigned)f2bf(k0l * eg0) | ((unsigned)f2bf(k0h * eg0) << 16);
          qo0[w] = (unsigned)f2bf(q0l * eg0 * 0.08838834764831845f) | ((unsigned)f2bf(q0h * eg0 * 0.08838834764831845f) << 16);
          ko1[w] = (unsigned)f2bf(k1l * eg1) | ((unsigned)f2bf(k1h * eg1) << 16);
          qo1[w] = (unsigned)f2bf(q1l * eg1 * 0.08838834764831845f) | ((unsigned)f2bf(q1h * eg1 * 0.08838834764831845f) << 16);
          KdT[(lch * 8 + 2 * w) * 80 + lr0] = f2bf(k0l * ed0);
          KdT[(lch * 8 + 2 * w + 1) * 80 + lr0] = f2bf(k0h * ed0);
          KdT[(lch * 8 + 2 * w) * 80 + lr1] = f2bf(k1l * ed1);
          KdT[(lch * 8 + 2 * w + 1) * 80 + lr1] = f2bf(k1h * ed1);
        }
        *(u32x4*)(Kg + lr0 * 144 + lch * 8) = ko0;
        *(u32x4*)(Qg + lr0 * 144 + lch * 8) = qo0;
        *(u32x4*)(Kg + lr1 * 144 + lch * 8) = ko1;
        *(u32x4*)(Qg + lr1 * 144 + lch * 8) = qo1;
        *(u32x4*)(Tl + (tid >> 3) * 80 + (tid & 7) * 8) = rT;
        *(u32x4*)(Il + (tid >> 3) * 80 + (tid & 7) * 8) = rI;
      }
      lds_barrier();
      if (i + 1 < 36) SCAN_LOAD_KQ(ocn);
      f32x4 ks_[2], qs_[2];
#pragma unroll
      for (int u = 0; u < 2; ++u) { ks_[u] = f32x4{0.f, 0.f, 0.f, 0.f}; qs_[u] = f32x4{0.f, 0.f, 0.f, 0.f}; }
#pragma unroll
      for (int kk = 0; kk < 4; ++kk) {
        bf16x8 a = *(const bf16x8*)(ST + (vt * 16 + fr) * 144 + kk * 32 + fq * 8);
#pragma unroll
        for (int u = 0; u < 2; ++u) {
          int rt = rp * 2 + u;
          bf16x8 bk = *(const bf16x8*)(Kg + (rt * 16 + fr) * 144 + kk * 32 + fq * 8);
          bf16x8 bq = *(const bf16x8*)(Qg + (rt * 16 + fr) * 144 + kk * 32 + fq * 8);
          ks_[u] = MFMA(a, bk, ks_[u]);
          qs_[u] = MFMA(a, bq, qs_[u]);
        }
      }
      {
        int v0 = vt * 16 + fq * 4;
        RT[(v0 + 0) * 80 + vr0] = f2bf(rb0 * (__uint_as_float(rv0.x << 16) - ks_[0][0]));
        RT[(v0 + 1) * 80 + vr0] = f2bf(rb0 * (__uint_as_float(rv0.x & 0xffff0000u) - ks_[0][1]));
        RT[(v0 + 2) * 80 + vr0] = f2bf(rb0 * (__uint_as_float(rv0.y << 16) - ks_[0][2]));
        RT[(v0 + 3) * 80 + vr0] = f2bf(rb0 * (__uint_as_float(rv0.y & 0xffff0000u) - ks_[0][3]));
        RT[(v0 + 0) * 80 + vr1] = f2bf(rb1 * (__uint_as_float(rv1.x << 16) - ks_[1][0]));
        RT[(v0 + 1) * 80 + vr1] = f2bf(rb1 * (__uint_as_float(rv1.x & 0xffff0000u) - ks_[1][1]));
        RT[(v0 + 2) * 80 + vr1] = f2bf(rb1 * (__uint_as_float(rv1.y << 16) - ks_[1][2]));
        RT[(v0 + 3) * 80 + vr1] = f2bf(rb1 * (__uint_as_float(rv1.y & 0xffff0000u) - ks_[1][3]));
      }
      if (i + 1 < 36) SCAN_LOAD_V(ocn);
      lds_barrier();
      {
        f32x4 vn[2];
#pragma unroll
        for (int u = 0; u < 2; ++u) vn[u] = f32x4{0.f, 0.f, 0.f, 0.f};
#pragma unroll
        for (int kk = 0; kk < 2; ++kk) {
          bf16x8 a = *(const bf16x8*)(RT + (vt * 16 + fr) * 80 + kk * 32 + fq * 8);
#pragma unroll
          for (int u = 0; u < 2; ++u) {
            bf16x8 bb = *(const bf16x8*)(Tl + ((rp * 2 + u) * 16 + fr) * 80 + kk * 32 + fq * 8);
            vn[u] = MFMA(a, bb, vn[u]);
          }
        }
#pragma unroll
        for (int u = 0; u < 2; ++u) {
          int r = (rp * 2 + u) * 16 + fr, v0 = vt * 16 + fq * 4;
#pragma unroll
          for (int j = 0; j < 4; ++j) VN[(v0 + j) * 80 + r] = f2bf(vn[u][j]);
        }
      }
      lds_barrier();
#pragma unroll
      for (int kk = 0; kk < 2; ++kk) {
        bf16x8 a = *(const bf16x8*)(VN + (vt * 16 + fr) * 80 + kk * 32 + fq * 8);
#pragma unroll
        for (int u = 0; u < 2; ++u) {
          bf16x8 bb = *(const bf16x8*)(Il + ((rp * 2 + u) * 16 + fr) * 80 + kk * 32 + fq * 8);
          qs_[u] = MFMA(a, bb, qs_[u]);
        }
      }
#pragma unroll
      for (int u = 0; u < 2; ++u) {
        int r = (rp * 2 + u) * 16 + fr, j = d ? 63 - r : r;
        u16* op = O + (long)tokof(b, pos0 + j) * 512 + h * 128 + vs * 64 + vt * 16 + fq * 4;
        ushort4 ov4;
        ov4.x = f2bf(qs_[u][0]); ov4.y = f2bf(qs_[u][1]); ov4.z = f2bf(qs_[u][2]); ov4.w = f2bf(qs_[u][3]);
        *(ushort4*)op = ov4;
      }
      {
        float ge = __expf(gl);
#pragma unroll
        for (int u = 0; u < 4; ++u) S[u] *= ge;
#pragma unroll
        for (int kk = 0; kk < 2; ++kk) {
          bf16x8 a = *(const bf16x8*)(VN + (vt * 16 + fr) * 80 + kk * 32 + fq * 8);
#pragma unroll
          for (int u = 0; u < 4; ++u) {
            bf16x8 bb = *(const bf16x8*)(KdT + ((rp * 4 + u) * 16 + fr) * 80 + kk * 32 + fq * 8);
            S[u] = MFMA(a, bb, S[u]);
          }
        }
#pragma unroll
        for (int u = 0; u < 4; ++u) {
          int dd = (rp * 4 + u) * 16 + fr, v0 = vt * 16 + fq * 4;
#pragma unroll
          for (int j = 0; j < 4; ++j) ST[(v0 + j) * 144 + dd] = f2bf(S[u][j]);
        }
      }
      lds_barrier();
    }
#undef SCAN_LOAD_KQ
#undef SCAN_LOAD_V
  }
}

DI void ph_dnfin(const Prm& p, int li) {
  const int lane = mytid() & 63;
  const int gw = mybid() * 8 + (mytid() >> 6), nw = gridDim.x * 8;
  const u16* O = (const u16*)(p.ws + OFF_AR + 5 * U38);
  const u16* O2 = (const u16*)(p.ws + OFF_AR + 6 * U38);
  u16* Z = (u16*)(p.ws + OFF_Y + 3 * U38);
  const float n0 = p.dn_norm[li * 128 + lane * 2], n1 = p.dn_norm[li * 128 + lane * 2 + 1];
#pragma unroll 2
  for (int tok = gw; tok < T_ALL; tok += nw) {
    ushort2 oa[4], ob[4], zz[4];
    float ox[4], oy[4], ss[4];
#pragma unroll
    for (int h = 0; h < 4; ++h) {
      long o = (long)tok * 512 + h * 128 + lane * 2;
      oa[h] = *(const ushort2*)(O + o);
      ob[h] = *(const ushort2*)(O2 + o);
      zz[h] = *(const ushort2*)(Z + o);
    }
#pragma unroll
    for (int h = 0; h < 4; ++h) {
      ox[h] = bf2f(oa[h].x) + bf2f(ob[h].x);
      oy[h] = bf2f(oa[h].y) + bf2f(ob[h].y);
      ss[h] = ox[h] * ox[h] + oy[h] * oy[h];
    }
#pragma unroll
    for (int o = 32; o; o >>= 1)
#pragma unroll
      for (int h = 0; h < 4; ++h) ss[h] += __shfl_xor(ss[h], o);
#pragma unroll
    for (int h = 0; h < 4; ++h) {
      float inv = rsqrtf(ss[h] * (1.f / 128.f) + 1e-6f);
      float z0 = bf2f(zz[h].x), z1 = bf2f(zz[h].y);
      ushort2 y;
      y.x = f2bf(ox[h] * inv * n0 * (z0 / (1.f + __expf(-z0))));
      y.y = f2bf(oy[h] * inv * n1 * (z1 / (1.f + __expf(-z1))));
      *(ushort2*)(Z + (long)tok * 512 + h * 128 + lane * 2) = y;
    }
  }
}

DI void ph_aprep(const Prm& p, int li) {
  const int lane = mytid() & 63;
  const int gw = mybid() * 8 + (mytid() >> 6), nw = gridDim.x * 8;
  const u16* PA = (const u16*)(p.ws + OFF_AR);
  u16* QH = (u16*)(p.ws + OFF_AR + 3 * U38);
  u16* KH = QH + 18874368L;
  const int f = lane & 15;
  const float inv_f = powf(10000.f, -(float)f / 16.f);
  for (int tok = gw; tok < T_ALL; tok += nw) {
    int b, P;
    float cs = 1.f, sn = 0.f;
    if (tok < T_LAT) {
      b = tok >> 11;
      int l = tok & 2047;
      P = 256 + l;
      float pos = (lane < 32) ? (float)(l >> 6) : (float)(l & 63);
      float ang = pos * inv_f;
      cs = cosf(ang);
      sn = sinf(ang);
    } else {
      b = (tok - T_LAT) >> 8;
      P = (tok - T_LAT) & 255;
    }
    float xv[16], ssq[16];
#pragma unroll
    for (int g = 0; g < 16; ++g) {
      xv[g] = bf2f(PA[(long)tok * 1024 + g * 64 + lane]);
      ssq[g] = xv[g] * xv[g];
    }
#pragma unroll
    for (int o = 32; o; o >>= 1)
#pragma unroll
      for (int g = 0; g < 16; ++g) ssq[g] += __shfl_xor(ssq[g], o);
#pragma unroll
    for (int g = 0; g < 16; ++g) {
      int which = g >> 3, h = (g >> 1) & 3, c = g & 1;
      float inv = rsqrtf(ssq[g] * (1.f / 64.f) + 1e-6f);
      float y = xv[g] * inv * p.qk_gain[(li * 2 + which) * 64 + lane];
      float pr = __shfl_xor(y, 16);
      float o = (lane & 16) ? (y * cs + pr * sn) : (y * cs - pr * sn);
      if (which == 0) o *= 0.18033688011112042f;
      u16* dst = (which ? KH : QH) + ((long)((b * 4 + h) * 2 + c) * 2304 + P) * 64 + lane;
      *dst = f2bf(o);
    }
  }
}

DI void ph_attn(const Prm& p, int li, long base, char* smem) {
  const int tid = mytid(), lane = tid & 63, wid = tid >> 6, fr = lane & 15, fq = lane >> 4;
  const u16* QH = (const u16*)(p.ws + OFF_AR + 3 * U38);
  const u16* KH = QH + 18874368L;
  const u16* VT = (const u16*)(p.ws + OFF_AR + 5 * U38);
  u16* YA = (u16*)(p.ws + OFF_Y);
  u16* s = (u16*)smem;
  constexpr int STG = 128 * 80 + 128 * 72;
  const float lambda_init = 0.8f - 0.6f * expf(-0.3f * (float)li);
  float lamv, mshift;
  {
    const float* lv = p.lam + li * 256;
    float a = wsum(lv[lane] * lv[64 + lane]), b2 = wsum(lv[128 + lane] * lv[192 + lane]);
    lamv = expf(a) - expf(b2) + lambda_init;
    float gq = wmax(fabsf(p.qk_gain[(li * 2) * 64 + lane])), gk = wmax(fabsf(p.qk_gain[(li * 2 + 1) * 64 + lane]));
    mshift = 8.f * gq * gk * 1.4426950408889634f;
  }
  for (int it = first_item(base); it < (li == 3 ? 1024 : 1152); it += gridDim.x) {
    int b, h, qp0, nkeys;
    if (it < 1024) { b = it >> 6; h = (it >> 4) & 3; qp0 = 256 + (it & 15) * 128; nkeys = 2304; }
    else { int i2 = it - 1024; b = i2 >> 3; h = (i2 >> 1) & 3; qp0 = (i2 & 1) * 128; nkeys = 256; }
    const long kb0 = (long)((b * 4 + h) * 2) * 2304;
    bf16x8 qf[2][2];
#pragma unroll
    for (int c = 0; c < 2; ++c)
#pragma unroll
      for (int ks = 0; ks < 2; ++ks)
        qf[c][ks] = *(const bf16x8*)(QH + (kb0 + (long)c * 2304 + qp0 + wid * 16 + fr) * 64 + ks * 32 + fq * 8);
    f32x4 O0[8], O1[8];
#pragma unroll
    for (int i = 0; i < 8; ++i) { O0[i] = f32x4{0.f, 0.f, 0.f, 0.f}; O1[i] = f32x4{0.f, 0.f, 0.f, 0.f}; }
    f32x4 L0 = {0.f, 0.f, 0.f, 0.f}, L1 = {0.f, 0.f, 0.f, 0.f};
    const bf16x8 ones = {0x3F80, 0x3F80, 0x3F80, 0x3F80, 0x3F80, 0x3F80, 0x3F80, 0x3F80};
    uint4 rk[2], rv[2];
    const int nt = nkeys >> 6;
#pragma unroll
    for (int u = 0; u < 2; ++u) {
      int id = tid + u * 512;
      int c = id >> 9, key = (id >> 3) & 63, ch = id & 7;
      rk[u] = *(const uint4*)(KH + (kb0 + (long)c * 2304 + key) * 64 + ch * 8);
      int dv = id >> 3;
      rv[u] = *(const uint4*)(VT + ((long)(b * 512 + h * 128 + dv)) * 2304 + ch * 8);
    }
#pragma unroll
    for (int u = 0; u < 2; ++u) {
      int id = tid + u * 512;
      *(uint4*)(s + (id >> 3) * 80 + (id & 7) * 8) = rk[u];
      *(uint4*)(s + 128 * 80 + (id >> 3) * 72 + (id & 7) * 8) = rv[u];
    }
    lds_barrier();
    for (int t = 0; t < nt; ++t) {
      const bool more = t + 1 < nt;
      if (more) {
        int kp0 = (t + 1) * 64;
#pragma unroll
        for (int u = 0; u < 2; ++u) {
          int id = tid + u * 512;
          int c = id >> 9, key = (id >> 3) & 63, ch = id & 7;
          rk[u] = *(const uint4*)(KH + (kb0 + (long)c * 2304 + kp0 + key) * 64 + ch * 8);
          int dv = id >> 3;
          rv[u] = *(const uint4*)(VT + ((long)(b * 512 + h * 128 + dv)) * 2304 + kp0 + ch * 8);
        }
      }
      const u16* ks_ = s + (t & 1) * STG;
      const u16* vs_ = ks_ + 128 * 80;
      bf16x8 pf[2][2];
#pragma unroll
      for (int c = 0; c < 2; ++c) {
#pragma unroll
        for (int kk2 = 0; kk2 < 2; ++kk2) {
          u32x4 pw;
#pragma unroll
          for (int hh = 0; hh < 2; ++hh) {
            const int k4 = kk2 * 2 + hh;
            f32x4 a = {-mshift, -mshift, -mshift, -mshift};
#pragma unroll
            for (int kk = 0; kk < 2; ++kk)
              a = MFMA(*(const bf16x8*)(ks_ + (c * 64 + k4 * 16 + fr) * 80 + kk * 32 + fq * 8), qf[c][kk], a);
            pw[hh * 2 + 0] = pk_bf16(__builtin_amdgcn_exp2f(a[0]), __builtin_amdgcn_exp2f(a[1]));
            pw[hh * 2 + 1] = pk_bf16(__builtin_amdgcn_exp2f(a[2]), __builtin_amdgcn_exp2f(a[3]));
          }
          pf[c][kk2] = *(bf16x8*)&pw;
        }
      }
#pragma unroll
      for (int kk = 0; kk < 2; ++kk) {
        L0 = MFMA(ones, pf[0][kk], L0);
        L1 = MFMA(ones, pf[1][kk], L1);
      }
#pragma unroll
      for (int dt = 0; dt < 8; ++dt) {
#pragma unroll
        for (int kk = 0; kk < 2; ++kk) {
          const u16* vp = vs_ + (dt * 16 + fr) * 72 + kk * 32 + fq * 4;
          uint2 lo = *(const uint2*)vp, hi = *(const uint2*)(vp + 16);
          uint4 av = {lo.x, lo.y, hi.x, hi.y};
          bf16x8 a = *(bf16x8*)&av;
          O0[dt] = MFMA(a, pf[0][kk], O0[dt]);
          O1[dt] = MFMA(a, pf[1][kk], O1[dt]);
        }
      }
      if (more) {
        u16* ns = s + ((t + 1) & 1) * STG;
#pragma unroll
        for (int u = 0; u < 2; ++u) {
          int id = tid + u * 512;
          *(uint4*)(ns + (id >> 3) * 80 + (id & 7) * 8) = rk[u];
          *(uint4*)(ns + 128 * 80 + (id >> 3) * 72 + (id & 7) * 8) = rv[u];
        }
      }
      lds_barrier();
    }
    float i0 = 1.f / L0[0], i1 = lamv / L1[0], ss = 0.f;
#pragma unroll
    for (int dt = 0; dt < 8; ++dt)
#pragma unroll
      for (int j = 0; j < 4; ++j) {
        float o = O0[dt][j] * i0 - O1[dt][j] * i1;
        O0[dt][j] = o;
        ss += o * o;
      }
    ss += __shfl_xor(ss, 16); ss += __shfl_xor(ss, 32);
    float inv = rsqrtf(ss * (1.f / 128.f) + 1e-6f) * (1.f - lambda_init);
    int tok = tokof(b, qp0 + wid * 16 + fr);
#pragma unroll
    for (int dt = 0; dt < 8; ++dt) {
      int dv = dt * 16 + fq * 4;
      const float* sw = p.subln + li * 128 + dv;
      ushort4 o;
      o.x = f2bf(O0[dt][0] * inv * sw[0]);
      o.y = f2bf(O0[dt][1] * inv * sw[1]);
      o.z = f2bf(O0[dt][2] * inv * sw[2]);
      o.w = f2bf(O0[dt][3] * inv * sw[3]);
      *(ushort4*)(YA + (long)tok * 512 + h * 128 + dv) = o;
    }
  }
}

template <int L>
DI void hyena_item(const Prm& p, int li, int ch, char* smem) {
  constexpr int CS = 2 * L + 8;
  constexpr int ZS = L + 8;
  constexpr int MT = L / 128;
  constexpr int MG = MT > 8 ? 8 : MT, NG = MT / MG;
  const int tid = mytid(), lane = tid & 63, wid = tid >> 6, fr = lane & 15, fq = lane >> 4;
  u16* cp = (u16*)smem;
  u16* zr = cp + 8 * CS;
  const u16* PH = (const u16*)(p.ws + OFF_AR) + (L == 2048 ? 0L : 32768L * 1536);
  const u16* G = (const u16*)(p.ws + (L == 2048 ? OFF_TAPL : OFF_TAPC));
  u16* YB = (u16*)(p.ws + OFF_Y + U38);
  const float* cw = p.hy_conv + (long)li * 3 * 1536;
  {
    float w0 = cw[1024 + ch], w1 = cw[1536 + 1024 + ch], w2 = cw[3072 + 1024 + ch];
    constexpr int NCH = (16 * L / 8) / 512;
    u32x4 cv[NCH];
    u16 pv[NCH], nv[NCH];
#pragma unroll
    for (int i = 0; i < NCH; ++i) {
      int id = tid + i * 512, b = id / (L / 8), s0 = (id % (L / 8)) * 8;
      const u16* row = PH + ((long)b * 1536 + 1024 + ch) * L + s0;
      cv[i] = *(const u32x4*)row;
      pv[i] = (s0 > 0) ? row[-1] : (u16)0;
      nv[i] = (s0 + 8 < L) ? row[8] : (u16)0;
    }
#pragma unroll
    for (int i = 0; i < NCH; ++i) {
      int id = tid + i * 512, b = id / (L / 8), s0 = (id % (L / 8)) * 8;
      float x[10];
      x[0] = bf2f(pv[i]);
      x[9] = bf2f(nv[i]);
#pragma unroll
      for (int w = 0; w < 4; ++w) {
        x[1 + 2 * w] = __uint_as_float(cv[i][w] << 16);
        x[2 + 2 * w] = __uint_as_float(cv[i][w] & 0xffff0000u);
      }
      float o[8];
#pragma unroll
      for (int e = 0; e < 8; ++e) o[e] = w0 * x[e] + w1 * x[e + 1] + w2 * x[e + 2];
      u32x4 r;
      r[0] = pk_bf16(o[7], o[6]); r[1] = pk_bf16(o[5], o[4]); r[2] = pk_bf16(o[3], o[2]); r[3] = pk_bf16(o[1], o[0]);
      *(u32x4*)(zr + b * ZS + L - 8 - s0) = r;
    }
  }
#pragma unroll
  for (int order = 0; order < 2; ++order) {
    {
      const u16* g = G + (long)(order * 512 + ch) * (2 * L);
      if (tid < 2 * L / 8) {
        const int i0 = tid * 8;
        u32x4 lo = *(const u32x4*)(g + i0);
        u32x4 hi = (i0 + 8 < 2 * L) ? *(const u32x4*)(g + i0 + 8) : u32x4{0u, 0u, 0u, 0u};
        unsigned D[8] = {lo[0], lo[1], lo[2], lo[3], hi[0], hi[1], hi[2], hi[3]};
#pragma unroll
        for (int c = 0; c < 8; ++c) {
          u32x4 o;
#pragma unroll
          for (int w = 0; w < 4; ++w) {
            if (c & 1) o[w] = (D[w + (c - 1) / 2] >> 16) | (D[w + (c + 1) / 2] << 16);
            else o[w] = D[w + c / 2];
          }
          *(u32x4*)(cp + c * CS + i0) = o;
        }
      }
    }
    __syncthreads();
    const float bias = p.hy_bias[(li * 2 + order) * 512 + ch];
    const int gcol = order * 512 + ch;
    const float w0 = cw[gcol], w1 = cw[1536 + gcol], w2 = cw[3072 + gcol];
    const int tq = wid * (L / 8) + fq * 4;
    const u16* xb = PH + ((long)fr * 1536 + gcol) * L + tq;
    const u16* zb = zr + fr * ZS + L - 1 - tq;
    unsigned zp[NG][MG][2];
#pragma unroll
    for (int grp = 0; grp < NG; ++grp) {
      f32x4 acc[MG];
#pragma unroll
      for (int m = 0; m < MG; ++m) acc[m] = f32x4{0.f, 0.f, 0.f, 0.f};
      const int tb = wid * (L / 8) + grp * MG * 16 + fr;
      if constexpr (MG == 8) {
        const int i00 = tb - fq * 8 - 7 + L, c0 = i00 & 7;
        const u16* ab = cp + c0 * CS + (i00 - c0);
        const u16* zbp = zr + fr * ZS + (L - 8 - fq * 8);
        bf16x8 W[16];
#pragma unroll 1
        for (int s0 = 0; s0 < L; s0 += 256) {
#pragma unroll
          for (int k = 0; k < 8; ++k) {
            const int sk = s0 + 32 * k;
            if (k == 0) {
#pragma unroll
              for (int m = 0; m < 8; ++m) W[m] = *(const bf16x8*)(ab + m * 16 - sk);
            }
            if (k < 7) {
              W[(16 - 2 * k - 2) & 15] = *(const bf16x8*)(ab - sk - 32);
              W[(16 - 2 * k - 1) & 15] = *(const bf16x8*)(ab - sk - 32 + 16);
            }
            bf16x8 bk = *(const bf16x8*)(zbp - sk);
#pragma unroll
            for (int m = 0; m < 8; ++m) acc[m] = MFMA(W[(m + 16 - 2 * k) & 15], bk, acc[m]);
          }
        }
      } else {
#pragma unroll 2
        for (int s0 = 0; s0 < L; s0 += 32) {
          bf16x8 bfr = *(const bf16x8*)(zr + fr * ZS + (L - 8 - s0 - fq * 8));
#pragma unroll
          for (int m = 0; m < MG; ++m) {
            int i0 = tb + m * 16 - s0 - fq * 8 - 7 + L;
            int c = i0 & 7;
            bf16x8 afr = *(const bf16x8*)(cp + c * CS + (i0 - c));
            acc[m] = MFMA(afr, bfr, acc[m]);
          }
        }
      }
#pragma unroll
      for (int m = 0; m < MG; ++m) {
        float r4[4];
#pragma unroll
        for (int j = 0; j < 4; ++j) {
          const int off = (grp * MG + m) * 16 + j;
          const int t = tq + off;
          float xa = bf2f(xb[off - 1]), xc = bf2f(xb[off]), xd = bf2f(xb[off + 1]);
          xa = (t > 0) ? xa : 0.f;
          xd = (t + 1 < L) ? xd : 0.f;
          float xg = w0 * xa + w1 * xc + w2 * xd;
          float zin = bf2f(zb[-off]);
          r4[j] = xg * (acc[m][j] + bias * zin);
        }
        zp[grp][m][0] = (unsigned)f2bf(r4[0]) | ((unsigned)f2bf(r4[1]) << 16);
        zp[grp][m][1] = (unsigned)f2bf(r4[2]) | ((unsigned)f2bf(r4[3]) << 16);
      }
    }
    __syncthreads();
#pragma unroll
    for (int grp = 0; grp < NG; ++grp)
#pragma unroll
      for (int m = 0; m < MG; ++m)
#pragma unroll
        for (int j = 0; j < 4; ++j) {
          int t = wid * (L / 8) + (grp * MG + m) * 16 + fq * 4 + j;
          u16 v = (u16)(zp[grp][m][j >> 1] >> ((j & 1) * 16));
          zr[fr * ZS + L - 1 - t] = v;
        }
  }
  __syncthreads();
  {
    u16* YBT = (u16*)(p.ws + OFF_AR + 5 * U38) + (L == 2048 ? 0L : 16L * 512 * 2048);
#pragma unroll 4
    for (int e = tid; e < 16 * L; e += 512) {
      int b = e / L, t = e % L;
      YBT[((long)b * 512 + ch) * L + t] = zr[b * ZS + L - 1 - t];
    }
  }
  __syncthreads();
}

DI long ph_ytrans(const Prm& p, long base, bool lastl, char* smem) {
  u16* tl = (u16*)smem;
  const u16* YBT = (const u16*)(p.ws + OFF_AR + 5 * U38);
  u16* YB = (u16*)(p.ws + OFF_Y + U38);
  const int tid = mytid(), G = gridDim.x;
  const int total = lastl ? 4096 : 4608;
  auto srcp = [&](int it) -> const u16* {
    if (it < 4096) {
      int b = it >> 8, ct = (it >> 5) & 7, lt = it & 31;
      return YBT + ((long)b * 512 + ct * 64 + (tid >> 3)) * 2048 + lt * 64 + (tid & 7) * 8;
    } else {
      int i2 = it - 4096, b = i2 >> 5, ct = (i2 >> 2) & 7, lt = i2 & 3;
      return YBT + 16L * 512 * 2048 + ((long)b * 512 + ct * 64 + (tid >> 3)) * 256 + lt * 64 + (tid & 7) * 8;
    }
  };
  int it = first_item(base);
  u32x4 v = {0u, 0u, 0u, 0u};
  if (it < total) v = *(const u32x4*)srcp(it);
  for (; it < total; it += G) {
    *(u32x4*)(tl + (tid >> 3) * 72 + (tid & 7) * 8) = v;
    __syncthreads();
    if (it + G < total) v = *(const u32x4*)srcp(it + G);
    long tok0;
    int ct;
    if (it < 4096) { int b = it >> 8, lt = it & 31; ct = (it >> 5) & 7; tok0 = (long)b * 2048 + lt * 64; }
    else { int i2 = it - 4096, b = i2 >> 5, lt = i2 & 3; ct = (i2 >> 2) & 7; tok0 = (long)T_LAT + b * 256 + lt * 64; }
    const int lrow = tid >> 3, cc = tid & 7;
    u32x4 o;
#pragma unroll
    for (int w = 0; w < 4; ++w) {
      unsigned lo = tl[(cc * 8 + 2 * w) * 72 + lrow], hi = tl[(cc * 8 + 2 * w + 1) * 72 + lrow];
      o[w] = lo | (hi << 16);
    }
    *(u32x4*)(YB + (tok0 + lrow) * 512 + ct * 64 + cc * 8) = o;
    __syncthreads();
  }
  return base + total;
}

DI void ph_merge(const Prm& p, char* smem, bool lastl) {
  const int tid = mytid(), lane = tid & 63, wid = tid >> 6;
  const int wm = wid >> 1, wn = wid & 1, fr = lane & 15, fq = lane >> 4;
  const u16* H = (const u16*)(p.ws + OFF_HBF);
  const u16* Y = (const u16*)(p.ws + OFF_Y);
  const u16* WG = (const u16*)(p.ws + OFF_WB) + WO_G;
  const u16* WBr = (const u16*)(p.ws + OFF_WB) + WO_B;
  u16* MG = (u16*)(p.ws + OFF_AR);
  const int NT = (lastl ? 256 : 288) * 8, G = gridDim.x;
  Stg r0, r1;
  bool pre = false;
  for (int t = mybid(); t < NT; t += G) {
    const int mt = t >> 3, nt = t & 7;
    const bool hn = t + G < NT;
    const int mt2 = (t + G) >> 3, nt2 = (t + G) & 7;
    f32x4 acc[2][4], g[2][4], y[2][4];
#pragma unroll
    for (int a = 0; a < 2; ++a)
#pragma unroll
      for (int b = 0; b < 4; ++b) acc[a][b] = f32x4{0.f, 0.f, 0.f, 0.f};
    const u16* gA = H + (long)mt * 128 * 1024;
    for (int n = 0; n < 4; ++n) {
      const u16* gB = WG + ((long)n * 1024 + nt * 128) * 1024;
      const u16* yA = Y + (long)n * (T_ALL * 512L) + (long)mt * 128 * 512;
      const u16* yB = WBr + ((long)n * 1024 + nt * 128) * 512;
      gemm_tile<2>(g, gA, 1024, gB, 1024, 1024, smem, r0, r1, pre, yA, 512, yB, 512);
      const u16* nxA = (n < 3) ? gA : (hn ? H + (long)mt2 * 128 * 1024 : nullptr);
      const u16* nxB = (n < 3) ? WG + ((long)(n + 1) * 1024 + nt * 128) * 1024 : WG + ((long)nt2 * 128) * 1024;
      gemm_tile<2>(y, yA, 512, yB, 512, 512, smem, r0, r1, true, nxA, 1024, nxB, 1024);
      pre = true;
#pragma unroll
      for (int a = 0; a < 2; ++a)
#pragma unroll
        for (int b = 0; b < 4; ++b)
#pragma unroll
          for (int j = 0; j < 4; ++j) acc[a][b][j] += y[a][b][j] / (1.f + __expf(-g[a][b][j]));
    }
    pre = hn;
#pragma unroll
    for (int a = 0; a < 2; ++a)
#pragma unroll
      for (int b = 0; b < 4; ++b) {
        int r = wm * 32 + a * 16 + fr, c = wn * 64 + b * 16 + fq * 4;
        uint2 o;
        o.x = pk_bf16(acc[a][b][0], acc[a][b][1]);
        o.y = pk_bf16(acc[a][b][2], acc[a][b][3]);
        *(uint2*)(MG + ((long)mt * 128 + r) * 1024 + nt * 128 + c) = o;
      }
  }
}

DI void run_phase(const Prm& p, int ph, char* smem) {
  if (ph == 0) { ph_init(p, smem); return; }
  const int li = (ph - 1) / 14, k = (ph - 1) % 14;
  const u16* WB = (const u16*)(p.ws + OFF_WB);
  const u16* HB = (const u16*)(p.ws + OFF_HBF);
  const float* MOD = (const float*)(p.ws + OFF_MOD);
  u16* AR = (u16*)(p.ws + OFF_AR);
  u16* Yb = (u16*)(p.ws + OFF_Y);
  const int G = gridDim.x;
  TD d;
  d.split = 0; d.scale = 1.f; d.mode = 0; d.tok0 = 0; d.col0 = 0; d.g = MOD;
  switch (k) {
    case 0: {
      u16* W = (u16*)(p.ws + OFF_WB);
      long base = 0;
      base = tr_job(base, p.w_in + (long)li * 1024 * NIN, 1024, NIN, W + WO_IN, 1, smem);
      base = tr_job(base, p.w_gate + (long)li * 4 * 1048576, 1024, 1024, W + WO_G, 4, smem);
      base = tr_job(base, p.w_branch + (long)li * 4 * 524288, 512, 1024, W + WO_B, 4, smem);
      base = tr_job(base, p.w_o + (long)li * 1048576, 1024, 1024, W + WO_O, 1, smem);
      base = tr_job(base, p.w_mlp1 + (long)li * 4194304, 1024, 4096, W + WO_1, 1, smem);
      base = tr_job(base, p.w_mlp2 + (long)li * 4194304, 4096, 1024, W + WO_2, 1, smem);
      ph_taps1(p, li, base, smem);
      ph_norm(p, li, 0);
    } break;
    case 1: {
      auto dec = [&](int t, TD& o) {
        o.lda = 1024; o.ldb = 1024; o.K = 1024; o.mode = 0;
        if (t < 1728) {
          int mt = t / 12, nt = t % 12;
          o.A = HB + (long)mt * 256 * 1024; o.B = WB + WO_IN + (long)(3584 + nt * 128) * 1024;
          o.C = AR + (long)mt * 256 * 1536 + nt * 128; o.ldc = 1536;
        } else if (t < 2304) {
          int t2 = t - 1728, mt = t2 >> 2, nt = t2 & 3;
          o.A = HB + (long)mt * 256 * 1024; o.B = WB + WO_IN + (long)(5120 + nt * 128) * 1024;
          o.C = Yb + 3 * (U38 / 2) + (long)mt * 256 * 512 + nt * 128; o.ldc = 512;
        } else {
          int mt = t - 2304;
          o.A = HB + (long)mt * 256 * 1024; o.B = WB + WO_IN + (long)5632 * 1024;
          o.C = (u16*)((float*)(p.ws + OFF_PDAB) + (long)mt * 256 * 16); o.ldc = 16; o.mode = 3;
        }
      };
      {
        Stg r0, r1;
        bool pre = false;
        TD dn = d;
        int t = mybid();
        if (t < 2448) dec(t, d);
        for (; t < 2448; t += G) {
          const bool hn = t + G < 2448;
          if (hn) dec(t + G, dn);
          run_tile2(p, d, smem, r0, r1, pre, hn ? dn.A : nullptr, dn.lda, dn.B, dn.ldb);
          pre = hn;
          d = dn;
        }
      }
      ph_taps2(p, 2448, smem);
    } break;
    case 2: ph_dncl(p, li, smem); break;
    case 3: ph_dnscan(p, smem); break;
    case 4: {
      {
        Stg r0, r1;
        bool pre = false;
        for (int t = mybid(); t < 1152; t += G) {
          int mt = t >> 3, nt = t & 7;
          const bool hn = t + G < 1152;
          int mt2 = (t + G) >> 3, nt2 = (t + G) & 7;
          d.lda = 1024; d.ldb = 1024; d.K = 1024;
          d.A = HB + (long)mt * 256 * 1024; d.B = WB + WO_IN + (long)(nt * 128) * 1024;
          d.C = AR + 3 * (U38 / 2); d.ldc = 0; d.mode = 4; d.tok0 = mt * 256; d.col0 = nt;
          d.g = p.qk_gain + li * 128;
          run_tile2(p, d, smem, r0, r1, pre, hn ? HB + (long)mt2 * 256 * 1024 : nullptr, 1024,
                    WB + WO_IN + (long)(nt2 * 128) * 1024, 1024);
          pre = hn;
        }
      }
      ph_dnfin(p, li);
    } break;
    case 5: {
      u16* VT = AR + 5 * (U38 / 2);
      u16* PF = AR + 6 * (U38 / 2);
      auto dec = [&](int t, TD& o) {
        o.lda = 1024; o.ldb = 1024; o.K = 1024;
        if (t < 512) {
          int b = t >> 5, r = t & 31, mt = r >> 4, nt = r & 15;
          o.A = WB + WO_IN + (long)(1024 + mt * 256) * 1024; o.B = HB + ((long)b * 2048 + nt * 128) * 1024;
          o.C = VT + ((long)b * 512 + mt * 256) * 2304 + 256 + nt * 128; o.ldc = 2304;
        } else if (t < 576) {
          int t2 = t - 512, b = t2 >> 2, r = t2 & 3, mt = r >> 1, nt = r & 1;
          o.A = WB + WO_IN + (long)(1024 + mt * 256) * 1024; o.B = HB + ((long)T_LAT + b * 256 + nt * 128) * 1024;
          o.C = VT + ((long)b * 512 + mt * 256) * 2304 + nt * 128; o.ldc = 2304;
        } else {
          int t2 = t - 576, mt = t2 >> 2, nt = t2 & 3;
          o.A = HB + (long)mt * 256 * 1024; o.B = WB + WO_IN + (long)(3072 + nt * 128) * 1024;
          o.C = PF + (long)mt * 256 * 512 + nt * 128; o.ldc = 512;
        }
      };
      {
        Stg r0, r1;
        bool pre = false;
        TD dn = d;
        int t = mybid();
        if (t < 1152) dec(t, d);
        for (; t < 1152; t += G) {
          const bool hn = t + G < 1152;
          if (hn) dec(t + G, dn);
          run_tile2(p, d, smem, r0, r1, pre, hn ? dn.A : nullptr, dn.lda, dn.B, dn.ldb);
          pre = hn;
          d = dn;
        }
      }
    } break;
    case 6: {
      ph_attn(p, li, 0, smem);
      auto dec = [&](int t, TD& o) {
        o.lda = 1024; o.ldb = 1024; o.K = 1024;
        if (t < 1536) {
          int b = t / 96, r = t % 96, mt = r >> 4, nt = r & 15;
          o.A = WB + WO_IN + (long)(1536 + mt * 256) * 1024; o.B = HB + ((long)b * 2048 + nt * 128) * 1024;
          o.C = AR + ((long)b * 1536 + mt * 256) * 2048 + nt * 128; o.ldc = 2048;
        } else {
          int t2 = t - 1536, b = t2 / 12, r = t2 % 12, mt = r >> 1, nt = r & 1;
          o.A = WB + WO_IN + (long)(1536 + mt * 256) * 1024; o.B = HB + ((long)T_LAT + b * 256 + nt * 128) * 1024;
          o.C = AR + 32768L * 1536 + ((long)b * 1536 + mt * 256) * 256 + nt * 128; o.ldc = 256;
        }
      };
      {
        Stg r0, r1;
        bool pre = false;
        TD dn = d;
        int t = first_item(1152);
        if (t < 1728) dec(t, d);
        for (; t < 1728; t += G) {
          const bool hn = t + G < 1728;
          if (hn) dec(t + G, dn);
          run_tile2(p, d, smem, r0, r1, pre, hn ? dn.A : nullptr, dn.lda, dn.B, dn.ldb);
          pre = hn;
          d = dn;
        }
      }
    } break;
    case 7: {
#if !defined(TESTSEL) || TESTSEL == 1
      for (int it = mybid(); it < 512; it += G) hyena_item<2048>(p, li, it, smem);
#endif
#if !defined(TESTSEL) || TESTSEL == 2
      if (li < 3)
        for (int it = mybid(); it < 512; it += G) hyena_item<256>(p, li, it, smem);
#endif
#if !defined(TESTSEL) || TESTSEL == 3
      const u16* PF = AR + 6 * (U38 / 2);
      u16* WF = AR + 3 * (U38 / 2);
      const u16* DCm = (const u16*)(p.ws + OFF_DC);
      auto dec = [&](int t, TD& o) {
        o.A = DCm; o.lda = 128; o.ldb = 512; o.K = 128;
        if (t < 1024) {
          int bg = t >> 4, nt = t & 15, b = bg >> 2, g = bg & 3;
          o.B = PF + ((long)b * 2048 + nt * 128) * 512 + g * 128;
          o.C = WF + ((long)b * 512 + g * 128) * 4096 + nt * 128; o.ldc = 4096; o.split = 2048;
        } else {
          int t2 = t - 1024, bg = t2 >> 1, nt = t2 & 1, b = bg >> 2, g = bg & 3;
          o.B = PF + ((long)T_LAT + b * 256 + nt * 128) * 512 + g * 128;
          o.C = WF + 16L * 512 * 4096 + ((long)b * 512 + g * 128) * 512 + nt * 128; o.ldc = 512; o.split = 256;
        }
      };
      {
        const int NT7 = (li == 3 ? 1024 : 1152);
        Stg r0, r1;
        bool pre = false;
        TD dn = d;
        int t = mybid();
        if (t < NT7) dec(t, d);
        for (; t < NT7; t += G) {
          const bool hn = t + G < NT7;
          if (hn) dec(t + G, dn);
          run_tile2(p, d, smem, r0, r1, pre, hn ? dn.A : nullptr, dn.lda, dn.B, dn.ldb);
          pre = hn;
          d = dn;
        }
      }
#endif
    } break;
    case 8: {
      const u16* WF = AR + 3 * (U38 / 2);
      u16* YF = Yb + 2 * (U38 / 2);
      d.scale = 1.f / 512.f;
      for (int t = mybid(); t < (li == 3 ? 512 : 576); t += G) {
        if (t < 512) {
          int b = t >> 5, r = t & 31, mt = r >> 2, nt = r & 3;
          d.A = (const u16*)(p.ws + OFF_DL) + (long)mt * 256 * 4096; d.lda = 4096;
          d.B = WF + ((long)b * 512 + nt * 128) * 4096; d.ldb = 4096; d.K = 4096;
          d.C = YF + ((long)b * 2048 + mt * 256) * 512 + nt * 128; d.ldc = 512;
        } else {
          int t2 = t - 512, b = t2 >> 2, nt = t2 & 3;
          d.A = (const u16*)(p.ws + OFF_DLC); d.lda = 512;
          d.B = WF + 16L * 512 * 4096 + ((long)b * 512 + nt * 128) * 512; d.ldb = 512; d.K = 512;
          d.C = YF + ((long)T_LAT + b * 256) * 512 + nt * 128; d.ldc = 512;
        }
        run_tile(p, d, smem);
      }
      ph_ytrans(p, 576, li == 3, smem);
    } break;
    case 9: ph_merge(p, smem, li == 3); break;
    case 10: {
      d.mode = 2;
      const int NT10 = (li == 3 ? 1024 : 1152);
      Stg r0, r1;
      bool pre = false;
      for (int t = mybid(); t < NT10; t += G) {
        int mt = t >> 3, nt = t & 7;
        d.A = AR + (long)mt * 256 * 1024; d.lda = 1024; d.B = WB + WO_O + (long)nt * 128 * 1024; d.ldb = 1024; d.K = 1024;
        d.tok0 = mt * 256; d.col0 = nt * 128;
        int bb = d.tok0 < T_LAT ? (d.tok0 >> 11) : 16;
        d.g = MOD + ((long)li * 17 + bb) * 6144 + 2 * 1024;
        const bool hn = t + G < NT10;
        int mt2 = (t + G) >> 3, nt2 = (t + G) & 7;
        run_tile2(p, d, smem, r0, r1, pre, hn ? AR + (long)mt2 * 256 * 1024 : nullptr, 1024,
                  WB + WO_O + (long)nt2 * 128 * 1024, 1024);
        pre = hn;
      }
    } break;
    case 11: ph_norm(p, li, 1); break;
    case 12: {
      d.mode = 1;
      const int NT12 = (li == 3 ? 4096 : 4608);
      Stg r0, r1;
      bool pre = false;
      for (int t = mybid(); t < NT12; t += G) {
        int mt = t >> 5, nt = t & 31;
        d.A = HB + (long)mt * 256 * 1024; d.lda = 1024; d.B = WB + WO_1 + (long)nt * 128 * 1024; d.ldb = 1024; d.K = 1024;
        d.C = Yb + (long)mt * 256 * 4096 + nt * 128; d.ldc = 4096;
        const bool hn = t + G < NT12;
        int mt2 = (t + G) >> 5, nt2 = (t + G) & 31;
        run_tile2(p, d, smem, r0, r1, pre, hn ? HB + (long)mt2 * 256 * 1024 : nullptr, 1024,
                  WB + WO_1 + (long)nt2 * 128 * 1024, 1024);
        pre = hn;
      }
    } break;
    case 13: {
      d.mode = 2;
      for (int t = mybid(); t < (li == 3 ? 1024 : 1152); t += G) {
        int mt = t >> 3, nt = t & 7;
        d.A = Yb + (long)mt * 256 * 4096; d.lda = 4096; d.B = WB + WO_2 + (long)nt * 128 * 4096; d.ldb = 4096; d.K = 4096;
        d.tok0 = mt * 256; d.col0 = nt * 128;
        int bb = d.tok0 < T_LAT ? (d.tok0 >> 11) : 16;
        d.g = MOD + ((long)li * 17 + bb) * 6144 + 5 * 1024;
        run_tile(p, d, smem);
      }
    } break;
  }
}


#define XB_TMO      128
#define XB_XCNT(j)  (256  + 64 * (j))
#define XB_XSUB(j)  (1280 + 64 * (j))
#define XB_XGEN(j)  (2304 + 64 * (j))
#define XB_TOP      3328
#define XB_TOPGEN   3392
#define XCD_BAR_WORDS 3456
#define XB_SPIN_CAP (1u << 20)
#define LAS __attribute__((address_space(3)))
DI unsigned xb_ld(unsigned* p) { return __hip_atomic_load(p, __ATOMIC_RELAXED, __HIP_MEMORY_SCOPE_AGENT); }
DI unsigned xb_add(unsigned* p, unsigned v) { return __hip_atomic_fetch_add(p, v, __ATOMIC_RELAXED, __HIP_MEMORY_SCOPE_AGENT); }
DI unsigned xb_xcc_id() { return (unsigned)__builtin_amdgcn_s_getreg((3 << 11) | 20) & 0xFu; }
#define XB_SPIN(cond, bar) do { unsigned _sp = 0; while (cond) { __builtin_amdgcn_s_sleep(1); \
    if ((++_sp & 255u) == 0u) { if (xb_ld(&(bar)[XB_TMO])) break; if (_sp > XB_SPIN_CAP) { atomicAdd(&(bar)[XB_TMO], 1u); break; } } } } while (0)
struct XcdBarrier { unsigned* bar; unsigned x; volatile LAS unsigned* st; };
DI XcdBarrier xcd_barrier_post(unsigned* bar, volatile LAS unsigned* st) {
  XcdBarrier b; b.bar = bar; b.x = xb_xcc_id(); b.st = st;
  if (threadIdx.x == 0) (void)xb_add(&bar[XB_XCNT(b.x)], 1u);
  return b;
}
DI void xcd_barrier_complete(unsigned* bar, unsigned x, unsigned& nloc, unsigned& nx) {
  const unsigned G = gridDim.x * gridDim.y * gridDim.z;
  unsigned sum, cnt, mine, sp = 0u;
  for (;;) {
    sum = 0u; cnt = 0u; mine = 0u;
#pragma unroll
    for (unsigned j = 0; j < 16; ++j) { const unsigned c = xb_ld(&bar[XB_XCNT(j)]); sum += c; cnt += (c > 0u) ? 1u : 0u; mine = (j == x) ? c : mine; }
    if (sum == G) break;
    __builtin_amdgcn_s_sleep(1);
    if ((++sp & 255u) == 0u) { if (xb_ld(&bar[XB_TMO])) break; if (sp > XB_SPIN_CAP) { atomicAdd(&bar[XB_TMO], 1u); break; } }
  }
  nloc = mine > 0u ? mine : 1u; nx = cnt > 0u ? cnt : 1u;
}
DI void xcd_barrier(const XcdBarrier& b) {
  asm volatile("s_waitcnt vmcnt(0)" ::: "memory");
  __syncthreads();
  if (threadIdx.x == 0) {
    unsigned* bar = b.bar;
    __builtin_amdgcn_s_waitcnt(0);
    unsigned nloc = b.st[0], nx = b.st[1];
    if (nloc == 0u) { xcd_barrier_complete(bar, b.x, nloc, nx); b.st[0] = nloc; b.st[1] = nx; }
    const unsigned old = xb_add(&bar[XB_XSUB(b.x)], 1u);
    const unsigned gen = old / nloc;
    if (old + 1u == (gen + 1u) * nloc) {
      __builtin_amdgcn_fence(__ATOMIC_RELEASE, "agent");
      asm volatile("s_waitcnt vmcnt(0)" ::: "memory");
      const unsigned og = xb_add(&bar[XB_TOP], 1u);
      const unsigned tg = og / nx;
      if (og + 1u == (tg + 1u) * nx) xb_add(&bar[XB_TOPGEN], 1u);
      else XB_SPIN(xb_ld(&bar[XB_TOPGEN]) == tg, bar);
      __builtin_amdgcn_fence(__ATOMIC_ACQUIRE, "agent");
      xb_add(&bar[XB_XGEN(b.x)], 1u);
      asm volatile("s_waitcnt vmcnt(0)" ::: "memory");
    } else {
      XB_SPIN(xb_ld(&bar[XB_XGEN(b.x)]) == gen, bar);
      __builtin_amdgcn_fence(__ATOMIC_ACQUIRE, "agent");
      asm volatile("s_waitcnt vmcnt(0)" ::: "memory");
    }
  }
  __syncthreads();
}

extern __shared__ __attribute__((aligned(16))) char dyn_smem[];

__global__ void __launch_bounds__(512) mega(Prm p, int lo, int hi) {
  __shared__ uint4 xb_words;
  if (threadIdx.x == 0) xb_words = make_uint4(0u, 0u, 0u, 0u);
  __syncthreads();
  XcdBarrier xb = xcd_barrier_post((unsigned*)(p.ws + OFF_BAR), (volatile LAS unsigned*)&xb_words);
#ifdef ONLYK
  run_phase(p, ONLYK, dyn_smem);
#else
  for (int ph = lo; ph <= hi; ++ph) {
    long z = 0;
    asm volatile("" : "+s"(z));
    Prm q;
#define LP(f) q.f = p.f + z
    LP(x); LP(c); LP(ctx); LP(c_ctx); LP(w_ada); LP(b_ada); LP(norm1); LP(norm2); LP(w_in); LP(qk_gain); LP(lam);
    LP(subln); LP(hy_conv); LP(hy_w1); LP(hy_b1); LP(hy_freq); LP(hy_w2); LP(hy_b2); LP(hy_w3); LP(hy_bias);
    LP(dn_conv); LP(dn_a_log); LP(dn_dt_bias); LP(dn_norm); LP(w_gate); LP(w_branch); LP(w_o); LP(w_mlp1); LP(w_mlp2);
    LP(out); LP(ws);
#undef LP
    run_phase(q, ph, dyn_smem);
#ifdef PROBEK
    if (ph > 0 && (ph - 1) % 14 == PROBEK) { cg::this_grid().sync(); run_phase(q, ph, dyn_smem); }
#endif
    if (ph < hi) {
      if (ph == lo) cg::this_grid().sync();
      else xcd_barrier(xb);
    }
  }
#endif
}

extern "C" void kernel_launch(void* const* d_in, const int* in_sizes, int n_in, void* d_out, int out_size, void* d_ws,
                              size_t ws_size, hipStream_t stream) {
  static int grid_blocks = 0;
  if (!grid_blocks) {
    hipFuncSetAttribute((const void*)mega, hipFuncAttributeMaxDynamicSharedMemorySize, LDS_BYTES);
    int dev = 0, cus = 0, per_cu = 0;
    hipGetDevice(&dev);
    hipDeviceGetAttribute(&cus, hipDeviceAttributeMultiprocessorCount, dev);
    hipOccupancyMaxActiveBlocksPerMultiprocessor(&per_cu, mega, 512, LDS_BYTES);
    if (per_cu < 1) per_cu = 1;
    grid_blocks = cus * per_cu;
    if (ws_size < (size_t)WS_TOTAL) fprintf(stderr, "workspace too small: %zu < %ld\n", ws_size, (long)WS_TOTAL);
  }
  Prm p;
  const float** pp = (const float**)&p;
  for (int i = 0; i < 29; ++i) pp[i] = (const float*)d_in[i];
  p.out = (float*)d_out;
  p.ws = (char*)d_ws;
#if MULTI
  for (int ph = 0; ph < NPHASE; ++ph) hipLaunchKernelGGL(mega, dim3(grid_blocks), dim3(512), LDS_BYTES, stream, p, ph, ph);
#else
  int lo = 0, hi = NPHASE - 1;
  hipMemsetAsync((char*)d_ws + OFF_BAR, 0, XCD_BAR_WORDS * 4, stream);
  void* args[] = {&p, &lo, &hi};
  hipError_t e = hipLaunchCooperativeKernel((void*)mega, dim3(grid_blocks), dim3(512), args, LDS_BYTES, stream);
  if (e != hipSuccess) fprintf(stderr, "cooperative launch failed: %s (grid %d)\n", hipGetErrorString(e), grid_blocks);
#endif
}
```

```cpp
#include <hip/hip_runtime.h>
#include <hip/hip_cooperative_groups.h>
#include <stdint.h>
#include <stdio.h>
namespace cg = cooperative_groups;

typedef unsigned short u16;
typedef __attribute__((ext_vector_type(8))) short bf16x8;
typedef __attribute__((ext_vector_type(4))) float f32x4;
#define MFMA(a, b, c) __builtin_amdgcn_mfma_f32_16x16x32_bf16(a, b, c, 0, 0, 0)
#define DI __device__ __forceinline__

#ifndef MULTI
#define MULTI 0
#endif

constexpr int T_LAT = 32768, T_ALL = 36864;
constexpr int NIN = 5648;
constexpr long U38 = 37748736L;
constexpr long OFF_XC = 0;
constexpr long OFF_WB = OFF_XC + 16777216L;
constexpr long OFF_HBF = OFF_WB + 43024384L;
constexpr long OFF_MOD = OFF_HBF + 75497472L;
constexpr long OFF_TAPL = OFF_MOD + 1671168L;
constexpr long OFF_TAPC = OFF_TAPL + 8388608L;
constexpr long OFF_DL = OFF_TAPC + 1048576L;
constexpr long OFF_DLC = OFF_DL + 16777216L;
constexpr long OFF_DC = OFF_DLC + 262144L;
constexpr long OFF_PDAB = OFF_DC + 65536L;
constexpr long OFF_GC = OFF_PDAB + 2359296L;
constexpr long OFF_BETA = OFF_GC + 2359296L;
constexpr long OFF_Y = OFF_BETA + 2359296L;
constexpr long OFF_AR = OFF_Y + 4 * U38;
constexpr long OFF_ROPE = OFF_AR + 7 * U38;
constexpr long OFF_BAR = OFF_ROPE + 2 * 262144L;
constexpr long WS_TOTAL = OFF_BAR + 16384L;
constexpr long WO_IN = 0, WO_G = 5783552L, WO_B = 9977856L, WO_O = 12075008L, WO_1 = 13123584L, WO_2 = 17317888L;
constexpr int LDS_BYTES = 139264;
constexpr int NPHASE = 1 + 4 * 14;

struct Prm {
  const float *x, *c, *ctx, *c_ctx, *w_ada, *b_ada, *norm1, *norm2, *w_in, *qk_gain, *lam, *subln, *hy_conv, *hy_w1,
      *hy_b1, *hy_freq, *hy_w2, *hy_b2, *hy_w3, *hy_bias, *dn_conv, *dn_a_log, *dn_dt_bias, *dn_norm, *w_gate,
      *w_branch, *w_o, *w_mlp1, *w_mlp2;
  float* out;
  char* ws;
};

DI int mytid() {
  int t = threadIdx.x;
  asm volatile("" : "+v"(t));
  return t;
}
DI int mybid() {
  int t = blockIdx.x;
  asm volatile("" : "+s"(t));
  return t;
}
DI void lds_barrier() {
  asm volatile("s_waitcnt lgkmcnt(0)" ::: "memory");
  __builtin_amdgcn_s_barrier();
  asm volatile("" ::: "memory");
}
typedef __bf16 bf16x2_t __attribute__((ext_vector_type(2)));
typedef float f32x2_t __attribute__((ext_vector_type(2)));
DI unsigned pk_bf16(float a, float b) {
  f32x2_t v = {a, b};
  bf16x2_t h = __builtin_convertvector(v, bf16x2_t);
  return *(unsigned*)&h;
}
DI u16 f2bf(float f) {
  __bf16 h = (__bf16)f;
  return *(u16*)&h;
}
DI float bf2f(u16 h) { return __uint_as_float(((unsigned)h) << 16); }
DI float wsum(float v) {
  for (int o = 32; o; o >>= 1) v += __shfl_xor(v, o);
  return v;
}
DI float wmax(float v) {
  for (int o = 32; o; o >>= 1) v = fmaxf(v, __shfl_xor(v, o));
  return v;
}
DI float siluf(float v) { return v / (1.f + __expf(-v)); }
DI float sigmf(float v) { return 1.f / (1.f + __expf(-v)); }
DI float* xrow(const Prm& p, int tok) {
  return tok < T_LAT ? p.out + (long)tok * 1024 : (float*)(p.ws + OFF_XC) + (long)(tok - T_LAT) * 1024;
}
DI int first_item(long base) {
  int G = gridDim.x;
  return (int)(((long)mybid() + G - (base % G)) % G);
}
DI int tokof(int b, int P) { return P < 256 ? T_LAT + b * 256 + P : b * 2048 + (P - 256); }

typedef __attribute__((ext_vector_type(4))) unsigned u32x4;
struct Stg { u32x4 a0, a1, a2, a3, b0, b1; };
template <int NA>
DI void g_load(Stg& r, const u16* Ap, long lda, const u16* Bp, long ldb, int k0) {
  r.a0 = *(const u32x4*)(Ap + k0);
  r.a1 = *(const u32x4*)(Ap + 64 * lda + k0);
  if constexpr (NA == 4) {
    r.a2 = *(const u32x4*)(Ap + 128 * lda + k0);
    r.a3 = *(const u32x4*)(Ap + 192 * lda + k0);
  }
  r.b0 = *(const u32x4*)(Bp + k0);
  r.b1 = *(const u32x4*)(Bp + 64 * ldb + k0);
}
template <int NA, int TM>
DI void s_store(const Stg& r, u16* ns_) {
  *(u32x4*)(ns_) = r.a0;
  *(u32x4*)(ns_ + 64 * 80) = r.a1;
  if constexpr (NA == 4) {
    *(u32x4*)(ns_ + 128 * 80) = r.a2;
    *(u32x4*)(ns_ + 192 * 80) = r.a3;
  }
  *(u32x4*)(ns_ + TM * 80) = r.b0;
  *(u32x4*)(ns_ + TM * 80 + 64 * 80) = r.b1;
}
template <int MI>
DI void t_compute(f32x4 (&acc)[MI][4], const u16* as, const u16* bs, int wm, int wn, int fr, int fq) {
#pragma unroll
  for (int ks = 0; ks < 2; ++ks) {
    bf16x8 a[MI], b[4];
#pragma unroll
    for (int mi = 0; mi < MI; ++mi) a[mi] = *(const bf16x8*)(as + (wm * MI * 16 + mi * 16 + fr) * 80 + ks * 32 + fq * 8);
#pragma unroll
    for (int ni = 0; ni < 4; ++ni) b[ni] = *(const bf16x8*)(bs + (wn * 64 + ni * 16 + fr) * 80 + ks * 32 + fq * 8);
#pragma unroll
    for (int mi = 0; mi < MI; ++mi)
#pragma unroll
      for (int ni = 0; ni < 4; ++ni) acc[mi][ni] = MFMA(b[ni], a[mi], acc[mi][ni]);
  }
}
template <int MI>
DI void gemm_tile(f32x4 (&acc)[MI][4], const u16* __restrict__ A, long lda, const u16* __restrict__ B, long ldb, int K,
                  char* smem, Stg& r0, Stg& r1, bool pre, const u16* nA, long nlda, const u16* nB, long nldb) {
  constexpr int TM = MI * 64;
  constexpr int STAGE = (TM + 128) * 80;
  constexpr int NA = TM * 8 / 512;
  u16* s = (u16*)smem;
  const int tid = mytid(), lane = tid & 63, wid = tid >> 6;
  const int wm = wid >> 1, wn = wid & 1, fr = lane & 15, fq = lane >> 4;
  const long to_a = (long)(tid >> 3), to_c = (tid & 7) * 8;
  const u16* Ap = A + to_a * lda + to_c;
  const u16* Bp = B + to_a * ldb + to_c;
  const u16* nAp = nA + to_a * nlda + to_c;
  const u16* nBp = nB + to_a * nldb + to_c;
  const int so = (tid >> 3) * 80 + (tid & 7) * 8;
#define GLOAD(r, k0) g_load<NA>(r, Ap, lda, Bp, ldb, (k0))
#define NLOAD(r, k0) g_load<NA>(r, nAp, nlda, nBp, nldb, (k0))
#define SSTORE(r, st) s_store<NA, TM>(r, s + (st) * STAGE + so)
#define COMPUTE(st) t_compute<MI>(acc, s + (st) * STAGE, s + (st) * STAGE + TM * 80, wm, wn, fr, fq)
#pragma unroll
  for (int mi = 0; mi < MI; ++mi)
#pragma unroll
    for (int ni = 0; ni < 4; ++ni) acc[mi][ni] = f32x4{0.f, 0.f, 0.f, 0.f};
  const int nk = K >> 6;
  if (!pre) {
    GLOAD(r0, 0);
    GLOAD(r1, 64);
  }
  SSTORE(r0, 0);
  lds_barrier();
  for (int kt = 0; kt < nk; kt += 2) {
    if (kt + 2 < nk) GLOAD(r0, (kt + 2) << 6);
    else if (nA) NLOAD(r0, 0);
    COMPUTE(0);
    SSTORE(r1, 1);
    lds_barrier();
    if (kt + 3 < nk) GLOAD(r1, (kt + 3) << 6);
    else if (nA) NLOAD(r1, 64);
    COMPUTE(1);
    if (kt + 2 < nk) SSTORE(r0, 0);
    lds_barrier();
  }
#undef GLOAD
#undef NLOAD
#undef SSTORE
#undef COMPUTE
}

struct TD {
  const u16* A;
  const u16* B;
  u16* C;
  long lda, ldb, ldc;
  int K;
  int mode;
  int split;
  float scale;
  int tok0, col0;
  const float* g;
};

DI void run_tile2(const Prm& p, const TD& d, char* smem, Stg& r0, Stg& r1, bool pre, const u16* nA, long nlda,
                 const u16* nB, long nldb);
DI void run_tile(const Prm& p, const TD& d, char* smem) {
  Stg r0, r1;
  run_tile2(p, d, smem, r0, r1, false, nullptr, 0, nullptr, 0);
}
DI void run_tile2(const Prm& p, const TD& d, char* smem, Stg& r0, Stg& r1, bool pre, const u16* nA, long nlda,
                 const u16* nB, long nldb) {
  f32x4 acc[4][4];
  gemm_tile<4>(acc, d.A, d.lda, d.B, d.ldb, d.K, smem, r0, r1, pre, nA, nlda, nB, nldb);
  const int tid = mytid(), lane = tid & 63, wid = tid >> 6;
  const int wm = wid >> 1, wn = wid & 1, fr = lane & 15, fq = lane >> 4;
  if (d.mode == 4) {
    const int which = d.col0 >> 2, h = d.col0 & 3;
    const float* gain = d.g + which * 64 + fq * 4;
    const float* RC = (const float*)(p.ws + OFF_ROPE);
    const float* RS = RC + 65536;
    u16* dstb = d.C + (which ? 18874368L : 0L);
    const float qs = which ? 1.f : 0.18033688011112042f;
#pragma unroll
    for (int mi = 0; mi < 4; ++mi) {
      const int tok = d.tok0 + wm * 64 + mi * 16 + fr;
      float ss = 0.f;
#pragma unroll
      for (int ni = 0; ni < 4; ++ni)
#pragma unroll
        for (int j = 0; j < 4; ++j) ss += acc[mi][ni][j] * acc[mi][ni][j];
      ss += __shfl_xor(ss, 16);
      ss += __shfl_xor(ss, 32);
      const float inv = rsqrtf(ss * (1.f / 64.f) + 1e-6f) * qs;
      int b, P;
      const bool lat = tok < T_LAT;
      if (lat) { b = tok >> 11; P = 256 + (tok & 2047); }
      else { b = (tok - T_LAT) >> 8; P = (tok - T_LAT) & 255; }
      float y[4][4];
#pragma unroll
      for (int ni = 0; ni < 4; ++ni) {
        float4 g4 = *(const float4*)(gain + ni * 16);
        y[ni][0] = acc[mi][ni][0] * inv * g4.x; y[ni][1] = acc[mi][ni][1] * inv * g4.y;
        y[ni][2] = acc[mi][ni][2] * inv * g4.z; y[ni][3] = acc[mi][ni][3] * inv * g4.w;
      }
      u16* dst = dstb + ((long)((b * 4 + h) * 2 + wn) * 2304 + P) * 64 + fq * 4;
#pragma unroll
      for (int ni = 0; ni < 4; ++ni) {
        float o0 = y[ni][0], o1 = y[ni][1], o2 = y[ni][2], o3 = y[ni][3];
        if (lat) {
          const int l = tok & 2047, a = ni >> 1;
          float4 c4 = *(const float4*)(RC + (l * 2 + a) * 16 + fq * 4);
          float4 s4 = *(const float4*)(RS + (l * 2 + a) * 16 + fq * 4);
          const float sg = (ni & 1) ? 1.f : -1.f;
          o0 = y[ni][0] * c4.x + sg * y[ni ^ 1][0] * s4.x;
          o1 = y[ni][1] * c4.y + sg * y[ni ^ 1][1] * s4.y;
          o2 = y[ni][2] * c4.z + sg * y[ni ^ 1][2] * s4.z;
          o3 = y[ni][3] * c4.w + sg * y[ni ^ 1][3] * s4.w;
        }
        uint2 o;
        o.x = pk_bf16(o0, o1);
        o.y = pk_bf16(o2, o3);
        *(uint2*)(dst + ni * 16) = o;
      }
    }
    return;
  }
#pragma unroll
  for (int mi = 0; mi < 4; ++mi)
#pragma unroll
    for (int ni = 0; ni < 4; ++ni) {
      int r = wm * 64 + mi * 16 + fr, c = wn * 64 + ni * 16 + fq * 4;
      f32x4 v = acc[mi][ni];
      if (d.mode == 0) {
        long ro = d.split ? ((long)(r & 127) * d.ldc + (long)(r >> 7) * d.split) : (long)r * d.ldc;
        ushort4 o;
        o.x = f2bf(v[0] * d.scale); o.y = f2bf(v[1] * d.scale); o.z = f2bf(v[2] * d.scale); o.w = f2bf(v[3] * d.scale);
        *(ushort4*)(d.C + ro + c) = o;
      } else if (d.mode == 1) {
        ushort4 o;
        float t0 = fmaxf(v[0], 0.f), t1 = fmaxf(v[1], 0.f), t2 = fmaxf(v[2], 0.f), t3 = fmaxf(v[3], 0.f);
        o.x = f2bf(t0 * t0); o.y = f2bf(t1 * t1); o.z = f2bf(t2 * t2); o.w = f2bf(t3 * t3);
        *(ushort4*)(d.C + (long)r * d.ldc + c) = o;
      } else if (d.mode == 3) {
        if (wn == 0 && ni == 0) *(float4*)((float*)d.C + (long)r * 16 + fq * 4) = float4{v[0], v[1], v[2], v[3]};
      } else {
        float4* xp = (float4*)(xrow(p, d.tok0 + r) + d.col0 + c);
        float4 g4 = *(const float4*)(d.g + d.col0 + c);
        float4 x4 = *xp;
        x4.x += g4.x * v[0]; x4.y += g4.y * v[1]; x4.z += g4.z * v[2]; x4.w += g4.w * v[3];
        *xp = x4;
      }
    }
}

DI void ph_init(const Prm& p, char* smem) {
  const long gt = (long)mybid() * 512 + mytid(), gn = (long)gridDim.x * 512;
  {
    const float4* s = (const float4*)p.x;
    float4* d = (float4*)p.out;
    for (long i = gt; i < 32768L * 256; i += gn) d[i] = s[i];
    const float4* s2 = (const float4*)p.ctx;
    float4* d2 = (float4*)(p.ws + OFF_XC);
    for (long i = gt; i < 4096L * 256; i += gn) d2[i] = s2[i];
  }
  {
    u16* DL = (u16*)(p.ws + OFF_DL);
    for (long i = gt; i < 2048L * 4096; i += gn) {
      int l = (int)(i >> 12), kk = (int)(i & 4095), lp = kk & 2047, part = kk >> 11;
      int m = (l * lp) & 2047;
      float ang = (float)m * (6.283185307179586f / 2048.f);
      DL[i] = f2bf(part ? -sinf(ang) : cosf(ang));
    }
    u16* DLC = (u16*)(p.ws + OFF_DLC);
    for (long i = gt; i < 256L * 512; i += gn) {
      int l = (int)(i >> 9), kk = (int)(i & 511), lp = kk & 255, part = kk >> 8;
      int m = (l * lp) & 255;
      float ang = (float)m * (6.283185307179586f / 256.f);
      DLC[i] = f2bf(part ? -sinf(ang) : cosf(ang));
    }
    {
      float* RC = (float*)(p.ws + OFF_ROPE);
      float* RS = RC + 65536;
      for (long i = gt; i < 65536; i += gn) {
        int l = (int)(i >> 5), a = (int)(i >> 4) & 1, f = (int)(i & 15);
        float pos = a ? (float)(l & 63) : (float)(l >> 6);
        float ang = pos * powf(10000.f, -(float)f / 16.f);
        RC[i] = cosf(ang);
        RS[i] = sinf(ang);
      }
    }
    u16* DC = (u16*)(p.ws + OFF_DC);
    for (long i = gt; i < 256L * 128; i += gn) {
      int j2 = (int)(i >> 7), ii = (int)(i & 127), part = j2 >> 7, j = j2 & 127;
      int m = (ii * j) & 127;
      float ang = (float)m * (6.283185307179586f / 128.f);
      DC[i] = f2bf(part ? sinf(ang) : cosf(ang));
    }
  }
  float* sc = (float*)smem;
  float* red = sc + 17 * 1024;
  const int tid = mytid();
  for (int e = tid; e < 17 * 1024; e += 512) {
    int bb = e >> 10, k = e & 1023;
    float v = bb < 16 ? p.c[bb * 1024 + k] : p.c_ctx[k];
    sc[e] = v / (1.f + expf(-v));
  }
  __syncthreads();
  float* MOD = (float*)(p.ws + OFF_MOD);
  for (int it = mybid(); it < 192; it += gridDim.x) {
    int li = it / 48, cgp = it % 48;
    int cl = tid & 127, kq = tid >> 7, n = cgp * 128 + cl;
    float a[17];
#pragma unroll
    for (int b = 0; b < 17; ++b) a[b] = 0.f;
    const float* w = p.w_ada + ((long)li * 1024 + kq * 256) * 6144 + n;
#pragma unroll 2
    for (int k = 0; k < 256; ++k) {
      float wv = w[(long)k * 6144];
#pragma unroll
      for (int b = 0; b < 17; ++b) a[b] += sc[b * 1024 + kq * 256 + k] * wv;
    }
#pragma unroll
    for (int b = 0; b < 17; ++b) red[(kq * 17 + b) * 128 + cl] = a[b];
    __syncthreads();
    for (int e = tid; e < 17 * 128; e += 512) {
      int b = e >> 7, c2 = e & 127, n2 = cgp * 128 + c2;
      float v = p.b_ada[li * 6144 + n2];
      for (int q = 0; q < 4; ++q) v += red[(q * 17 + b) * 128 + c2];
      MOD[((long)li * 17 + b) * 6144 + n2] = v;
    }
    __syncthreads();
  }
}

DI long tr_job(long base, const float* src, int K, int N, u16* dst, int nb, char* smem) {
  float* t = (float*)smem;
  const int tk = K >> 6, tn = (N + 63) >> 6, per = tk * tn, total = per * nb;
  const int tid = mytid();
  const int G = gridDim.x;
  float v[8];
  int it = first_item(base);
  if (it < total) {
    int b = it / per, r = it % per, kt = r / tn, nt = r % tn;
    const float* s = src + (long)b * K * N;
#pragma unroll
    for (int i = 0; i < 8; ++i) {
      int id = tid + i * 512, kk = id >> 6, nn = id & 63;
      v[i] = (nt * 64 + nn < N) ? s[(long)(kt * 64 + kk) * N + nt * 64 + nn] : 0.f;
    }
  }
  for (; it < total; it += G) {
    int b = it / per, r = it % per, kt = r / tn, nt = r % tn;
    u16* d = dst + (long)b * K * N;
    int k0 = kt * 64, n0 = nt * 64;
#pragma unroll
    for (int i = 0; i < 8; ++i) {
      int id = tid + i * 512, kk = id >> 6, nn = id & 63;
      t[kk * 65 + nn] = v[i];
    }
    __syncthreads();
    if (it + G < total) {
      int it2 = it + G, b2 = it2 / per, r2 = it2 % per, kt2 = r2 / tn, nt2 = r2 % tn;
      const float* s2 = src + (long)b2 * K * N;
#pragma unroll
      for (int i = 0; i < 8; ++i) {
        int id = tid + i * 512, kk = id >> 6, nn = id & 63;
        v[i] = (nt2 * 64 + nn < N) ? s2[(long)(kt2 * 64 + kk) * N + nt2 * 64 + nn] : 0.f;
      }
    }
#pragma unroll
    for (int i = 0; i < 8; ++i) {
      int id = tid + i * 512, nn = id >> 6, kk = id & 63;
      if (n0 + nn < N) d[(long)(n0 + nn) * K + k0 + kk] = f2bf(t[kk * 65 + nn]);
    }
    __syncthreads();
  }
  return base + total;
}

DI void ph_norm(const Prm& p, int li, int which) {
  const int lane = mytid() & 63;
  const int gw = mybid() * 8 + (mytid() >> 6), nw = gridDim.x * 8;
  const float* nwt = (which ? p.norm2 : p.norm1) + li * 1024;
  const float* MOD = (const float*)(p.ws + OFF_MOD);
  u16* H = (u16*)(p.ws + OFF_HBF);
  const int nrows = (which && li == 3) ? T_LAT : T_ALL;
  for (int row = gw; row < nrows; row += 2 * nw) {
    const int row2 = row + nw;
    const bool has2 = row2 < nrows;
    const float* xr = xrow(p, row);
    const float* xr2 = xrow(p, has2 ? row2 : row);
    float4 v[4], u[4];
    float ss = 0.f, ss2 = 0.f;
#pragma unroll
    for (int i = 0; i < 4; ++i) {
      v[i] = *(const float4*)(xr + i * 256 + lane * 4);
      u[i] = *(const float4*)(xr2 + i * 256 + lane * 4);
    }
#pragma unroll
    for (int i = 0; i < 4; ++i) {
      ss += v[i].x * v[i].x + v[i].y * v[i].y + v[i].z * v[i].z + v[i].w * v[i].w;
      ss2 += u[i].x * u[i].x + u[i].y * u[i].y + u[i].z * u[i].z + u[i].w * u[i].w;
    }
#pragma unroll
    for (int o = 32; o; o >>= 1) {
      ss += __shfl_xor(ss, o);
      ss2 += __shfl_xor(ss2, o);
    }
    const float inv = rsqrtf(ss * (1.f / 1024.f) + 1e-6f), inv2 = rsqrtf(ss2 * (1.f / 1024.f) + 1e-6f);
    const int bb = row < T_LAT ? (row >> 11) : 16, bb2 = row2 < T_LAT ? (row2 >> 11) : 16;
    const float* sh = MOD + ((long)li * 17 + bb) * 6144 + (which ? 3 : 0) * 1024;
    const float* sh2 = MOD + ((long)li * 17 + (has2 ? bb2 : bb)) * 6144 + (which ? 3 : 0) * 1024;
#pragma unroll
    for (int i = 0; i < 4; ++i) {
      int c = i * 256 + lane * 4;
      float4 w4 = *(const float4*)(nwt + c);
      {
        float4 s4 = *(const float4*)(sh + 1024 + c), h4 = *(const float4*)(sh + c);
        uint2 o;
        o.x = pk_bf16(v[i].x * inv * w4.x * (1.f + s4.x) + h4.x, v[i].y * inv * w4.y * (1.f + s4.y) + h4.y);
        o.y = pk_bf16(v[i].z * inv * w4.z * (1.f + s4.z) + h4.z, v[i].w * inv * w4.w * (1.f + s4.w) + h4.w);
        *(uint2*)(H + (long)row * 1024 + c) = o;
      }
      if (has2) {
        float4 s4 = *(const float4*)(sh2 + 1024 + c), h4 = *(const float4*)(sh2 + c);
        uint2 o;
        o.x = pk_bf16(u[i].x * inv2 * w4.x * (1.f + s4.x) + h4.x, u[i].y * inv2 * w4.y * (1.f + s4.y) + h4.y);
        o.y = pk_bf16(u[i].z * inv2 * w4.z * (1.f + s4.z) + h4.z, u[i].w * inv2 * w4.w * (1.f + s4.w) + h4.w);
        *(uint2*)(H + (long)row2 * 1024 + c) = o;
      }
    }
  }
}

DI void ph_taps1(const Prm& p, int li, long base, char* smem) {
  float* f = (float*)smem;
  float* hraw = (float*)(p.ws + OFF_AR + 5 * U38);
  const int tid = mytid();
  for (int it = first_item(base); it < 288; it += gridDim.x) {
    const int L = it < 256 ? 2048 : 256, j0 = it < 256 ? it * 8 : (it - 256) * 8;
    const int lg = tid >> 6, kk = tid & 63;
    if (tid < 8 * 33) {
      int l2 = tid / 33, e = tid % 33, j = j0 + l2;
      float t = (float)j / (float)(L - 1);
      float w = 6.283185307179586f * (float)j / (float)L;
      float v;
      if (e == 0) v = t;
      else {
        int bi = (e - 1) & 15;
        float band = 1e-4f + (float)bi * ((15.f - 1e-4f) / 15.f);
        v = (e <= 16) ? cosf(band * w) : -sinf(band * w);
      }
      f[l2 * 40 + e] = v;
    }
    __syncthreads();
    {
      float v = p.hy_b1[li * 64 + kk];
#pragma unroll 3
      for (int e = 0; e < 33; ++e) v += f[lg * 40 + e] * p.hy_w1[(li * 33 + e) * 64 + kk];
      f[320 + lg * 64 + kk] = sinf(p.hy_freq[(li * 2 + 0) * 64 + kk] * v);
    }
    __syncthreads();
    {
      float v = p.hy_b2[li * 64 + kk];
#pragma unroll 4
      for (int m = 0; m < 64; ++m) v += f[320 + lg * 64 + m] * p.hy_w2[(li * 64 + m) * 64 + kk];
      f[832 + lg * 64 + kk] = sinf(p.hy_freq[(li * 2 + 1) * 64 + kk] * v);
    }
    __syncthreads();
    {
      float h[4][8];
#pragma unroll
      for (int i = 0; i < 4; ++i)
#pragma unroll
        for (int l2 = 0; l2 < 8; ++l2) h[i][l2] = 0.f;
      const float* w3 = p.hy_w3 + (long)li * 64 * 2048 + tid;
#pragma unroll 2
      for (int k = 0; k < 64; ++k) {
        float wv[4];
#pragma unroll
        for (int i = 0; i < 4; ++i) wv[i] = w3[(long)k * 2048 + i * 512];
#pragma unroll
        for (int l2 = 0; l2 < 8; ++l2) {
          float hv = f[832 + l2 * 64 + k];
#pragma unroll
          for (int i = 0; i < 4; ++i) h[i][l2] += hv * wv[i];
        }
      }
#pragma unroll
      for (int i = 0; i < 4; ++i) {
        int n = tid + i * 512, ch = n & 511;
        float delta = fabsf(-3.0701134573253946f + (float)ch * ((-15.350567286626973f + 3.0701134573253946f) / 511.f));
#pragma unroll
        for (int l2 = 0; l2 < 8; ++l2) {
          int j = j0 + l2;
          float t = (float)j / (float)(L - 1);
          long row = (it < 256) ? j : 2048 + j;
          hraw[row * 2048 + n] = h[i][l2] * expf(-t * delta);
        }
      }
    }
    __syncthreads();
  }
}
DI void ph_taps2(const Prm& p, long base, char* smem) {
  float* vals = (float*)smem;
  float* red = vals + 8 * 2048;
  const float* hraw = (const float*)(p.ws + OFF_AR + 5 * U38);
  const int tid = mytid(), cl = tid & 3, dir = (tid >> 2) & 1, jg = tid >> 3;
  for (int it = first_item(base); it < 512; it += gridDim.x) {
    int ls = it >> 8, order = (it >> 7) & 1, cgp = it & 127;
    int L = ls ? 256 : 2048;
    const float* hr = hraw + (long)(ls ? 2048 : 0) * 2048;
    u16* G = (u16*)(p.ws + (ls ? OFF_TAPC : OFF_TAPL));
    int ch = cgp * 4 + cl, n = order * 1024 + dir * 512 + ch;
    float s = 0.f;
#pragma unroll 8
    for (int j = jg; j < L; j += 64) {
      float v = hr[(long)j * 2048 + n];
      vals[(cl * 2 + dir) * L + j] = v;
      s += (dir == 1 && j == 0) ? 0.f : fabsf(v);
    }
    red[(tid >> 2) * 4 + cl] = s;
    __syncthreads();
    if (tid < 4) {
      float tot = 0.f;
#pragma unroll 8
      for (int r = 0; r < 128; ++r) tot += red[r * 4 + tid];
      red[512 + tid] = 1.f / tot;
    }
    __syncthreads();
    for (int idx = tid; idx < 8 * L; idx += 512) {
      int q = idx / L, j = idx % L, c2 = q >> 1, d2 = q & 1;
      float v = vals[idx] * red[512 + c2];
      u16* g = G + (long)(order * 512 + cgp * 4 + c2) * (2 * L);
      if (d2 == 0) g[L + j] = f2bf(v);
      else if (j > 0) g[L - j] = f2bf(v);
      else g[0] = 0;
    }
    __syncthreads();
  }
}

DI void ph_pdab(const Prm& p, int li, char* smem) {
  float* wl = (float*)smem;
  const int tid = mytid(), lane = tid & 63;
#pragma unroll 8
  for (int e = tid; e < 1024 * 16; e += 512) wl[e] = p.w_in[((long)li * 1024 + (e >> 4)) * NIN + 5632 + (e & 15)];
  __syncthreads();
  const u16* H = (const u16*)(p.ws + OFF_HBF);
  float* out = (float*)(p.ws + OFF_PDAB);
  const int gw = mybid() * 8 + (tid >> 6), nw = gridDim.x * 8;
  for (int tok = gw; tok < T_ALL; tok += nw) {
    float a[16];
#pragma unroll
    for (int j = 0; j < 16; ++j) a[j] = 0.f;
    float hv[16];
#pragma unroll
    for (int i = 0; i < 16; ++i) hv[i] = bf2f(H[(long)tok * 1024 + lane + i * 64]);
#pragma unroll
    for (int i = 0; i < 16; ++i) {
      float h = hv[i];
      const float4* wp = (const float4*)(wl + (lane + i * 64) * 16);
#pragma unroll
      for (int q = 0; q < 4; ++q) {
        float4 w4 = wp[q];
        a[q * 4 + 0] += h * w4.x;
        a[q * 4 + 1] += h * w4.y;
        a[q * 4 + 2] += h * w4.z;
        a[q * 4 + 3] += h * w4.w;
      }
      if ((i & 3) == 3) asm volatile("" ::: "memory");
    }
#pragma unroll
    for (int o = 32; o; o >>= 1)
#pragma unroll
      for (int j = 0; j < 16; ++j) a[j] += __shfl_xor(a[j], o);
    float v = a[0];
#pragma unroll
    for (int j = 1; j < 16; ++j) v = (lane == j) ? a[j] : v;
    if (lane < 16) out[(long)tok * 16 + lane] = v;
  }
  __syncthreads();
}

DI void ph_dncl(const Prm& p, int li, char* smem) {
  const int tid = mytid(), lane = tid & 63, wid = tid >> 6, fr = lane & 15, fq = lane >> 4;
  u16* qn = (u16*)smem;
  u16* kn = qn + 64 * 144;
  float* fb = (float*)(smem + 36864);
  float* KK = fb;
  float* QK = KK + 64 * 65;
  float* Am = QK + 64 * 65;
  float* Tm = Am + 2 * 64 * 65;
  float* gcs = Tm + 2 * 64 * 65;
  float* bts = gcs + 128;
  const u16* PD = (const u16*)(p.ws + OFF_AR);
  const float* AB = (const float*)(p.ws + OFF_PDAB);
  u16* DQ = (u16*)(p.ws + OFF_Y);
  u16* DK = DQ + 18874368L;
  u16* DV = DK + 18874368L;
  u16* CL = (u16*)(p.ws + OFF_AR + 3 * U38);
  float* GC = (float*)(p.ws + OFF_GC);
  float* BT = (float*)(p.ws + OFF_BETA);
  const float* cw = p.dn_conv + (long)li * 3 * 1536;
  for (int it = mybid(); it < 2304; it += gridDim.x) {
    const int b = it / 144, r0 = it % 144, oc = r0 >> 2, h = r0 & 3;
    const int pos0 = oc * 64, s0 = oc < 4 ? 0 : 256, e0 = oc < 4 ? 256 : 2304;
    if (tid < 384) {
      const int cgp = tid % 48, rs = tid / 48;
      const int part = cgp >> 4, d0 = (cgp & 15) * 8, col = part * 512 + h * 128 + d0;
      const u16* basep = PD + (long)tokof(b, pos0) * 1536 + col;
      float wt[3][8];
#pragma unroll
      for (int tp = 0; tp < 3; ++tp) {
        float4 wa = *(const float4*)(cw + tp * 1536 + col), wb = *(const float4*)(cw + tp * 1536 + col + 4);
        wt[tp][0] = wa.x; wt[tp][1] = wa.y; wt[tp][2] = wa.z; wt[tp][3] = wa.w;
        wt[tp][4] = wb.x; wt[tp][5] = wb.y; wt[tp][6] = wb.z; wt[tp][7] = wb.w;
      }
#pragma unroll 1
      for (int hf = 0; hf < 2; ++hf) {
        u32x4 rw[6];
#pragma unroll
        for (int i = 0; i < 6; ++i) {
          int j = rs * 8 + hf * 4 - 1 + i, P = pos0 + j;
          rw[i] = (P >= s0 && P < e0) ? *(const u32x4*)(basep + (long)j * 1536) : u32x4{0u, 0u, 0u, 0u};
        }
#pragma unroll
        for (int r = 0; r < 4; ++r) {
#pragma unroll
          for (int e = 0; e < 8; ++e) {
            unsigned w0_ = rw[r][e >> 1], w1_ = rw[r + 1][e >> 1], w2_ = rw[r + 2][e >> 1];
            float x0 = (e & 1) ? __uint_as_float(w0_ & 0xffff0000u) : __uint_as_float(w0_ << 16);
            float x1 = (e & 1) ? __uint_as_float(w1_ & 0xffff0000u) : __uint_as_float(w1_ << 16);
            float x2 = (e & 1) ? __uint_as_float(w2_ & 0xffff0000u) : __uint_as_float(w2_ << 16);
            float v = wt[0][e] * x0 + wt[1][e] * x1 + wt[2][e] * x2;
            fb[(rs * 8 + hf * 4 + r) * 385 + part * 128 + d0 + e] = v / (1.f + __expf(-v));
          }
        }
      }
    }
    __syncthreads();
    for (int jj = 0; jj < 8; ++jj) {
      int j = wid * 8 + jj, P = pos0 + j;
      long go = ((long)(b * 4 + h) * 2304 + P) * 128;
      float q0 = fb[j * 385 + lane], q1 = fb[j * 385 + 64 + lane];
      float k0 = fb[j * 385 + 128 + lane], k1 = fb[j * 385 + 192 + lane];
      float v0 = fb[j * 385 + 256 + lane], v1 = fb[j * 385 + 320 + lane];
      float iq = rsqrtf(wsum(q0 * q0 + q1 * q1) + 1e-6f), ik = rsqrtf(wsum(k0 * k0 + k1 * k1) + 1e-6f);
      u16 a0 = f2bf(q0 * iq), a1 = f2bf(q1 * iq), c0 = f2bf(k0 * ik), c1 = f2bf(k1 * ik);
      qn[j * 144 + lane] = a0; qn[j * 144 + 64 + lane] = a1;
      kn[j * 144 + lane] = c0; kn[j * 144 + 64 + lane] = c1;
      DQ[go + lane] = a0; DQ[go + 64 + lane] = a1;
      DK[go + lane] = c0; DK[go + 64 + lane] = c1;
      DV[go + lane] = f2bf(v0); DV[go + 64 + lane] = f2bf(v1);
    }
    __syncthreads();
#pragma unroll
    for (int u = 0; u < 4; ++u) {
      int tt = wid * 4 + u, which = tt >> 4, ti = (tt >> 2) & 3, tj = tt & 3;
      const u16* Ap = (which ? qn : kn) + (ti * 16 + fr) * 144 + fq * 8;
      const u16* Bp = kn + (tj * 16 + fr) * 144 + fq * 8;
      f32x4 a = {0.f, 0.f, 0.f, 0.f};
#pragma unroll
      for (int ks = 0; ks < 4; ++ks) a = MFMA(*(const bf16x8*)(Ap + ks * 32), *(const bf16x8*)(Bp + ks * 32), a);
      float* dst = which ? QK : KK;
#pragma unroll
      for (int j = 0; j < 4; ++j) dst[(ti * 16 + fq * 4 + j) * 65 + tj * 16 + fr] = a[j];
    }
    if (tid < 128) {
      int d = tid >> 6, r = tid & 63, j = d ? 63 - r : r;
      int tok = tokof(b, pos0 + j);
      float av = AB[(long)tok * 16 + d * 4 + h], bv = AB[(long)tok * 16 + 8 + d * 4 + h];
      float xx = av + p.dn_dt_bias[li * 8 + d * 4 + h];
      float sp = fmaxf(xx, 0.f) + __logf(1.f + __expf(-fabsf(xx)));
      float g = -expf(p.dn_a_log[li * 8 + d * 4 + h]) * sp;
      for (int o = 1; o < 64; o <<= 1) {
        float t = __shfl_up(g, o);
        if (r >= o) g += t;
      }
      float be = 1.f / (1.f + expf(-bv));
      gcs[d * 64 + r] = g;
      bts[d * 64 + r] = be;
      long ci = ((long)((b * 4 + h) * 2 + d) * 36 + oc) * 64 + r;
      GC[ci] = g;
      BT[ci] = be;
    }
    __syncthreads();
#pragma unroll 4
    for (int e = tid; e < 8192; e += 512) {
      int d = e >> 12, s = (e >> 6) & 63, r = e & 63;
      int j = d ? 63 - r : r, js = d ? 63 - s : s;
      float v = 0.f;
      if (r > s) v = bts[d * 64 + r] * KK[j * 65 + js] * expf(gcs[d * 64 + r] - gcs[d * 64 + s]);
      Am[(d * 64 + s) * 64 + r] = v;
    }
#pragma unroll 4
    for (int e = tid; e < 8192; e += 512) {
      int d = e >> 12, r = (e >> 6) & 63, s = e & 63;
      int j = d ? 63 - r : r, js = d ? 63 - s : s;
      float dec = (r >= s) ? expf(gcs[d * 64 + r] - gcs[d * 64 + s]) : 0.f;
      long ci = (long)((b * 4 + h) * 2 + d) * 36 + oc;
      CL[ci * 8192 + 4096 + r * 64 + s] = f2bf(QK[j * 65 + js] * dec * 0.08838834764831845f);
    }
    __syncthreads();
    {
      const int d = tid >> 8, c = (tid >> 2) & 63, q = tid & 3;
      const float* Atq = Am + d * 64 * 64 + q;
      float* T = Tm + d * 64 * 65;
      float t[16];
#pragma unroll
      for (int i = 0; i < 16; ++i) t[i] = (4 * i + q == c) ? 1.f : 0.f;
#pragma unroll
      for (int s2 = 0; s2 < 63; ++s2) {
        constexpr int dummy = 0;
        const int is = s2 >> 2, qs = s2 & 3;
        const int ctl = qs | (qs << 2) | (qs << 4) | (qs << 6);
        int tsb;
        if (qs == 0) tsb = __builtin_amdgcn_update_dpp(0, __float_as_int(t[is]), 0x00, 0xf, 0xf, false);
        else if (qs == 1) tsb = __builtin_amdgcn_update_dpp(0, __float_as_int(t[is]), 0x55, 0xf, 0xf, false);
        else if (qs == 2) tsb = __builtin_amdgcn_update_dpp(0, __float_as_int(t[is]), 0xAA, 0xf, 0xf, false);
        else tsb = __builtin_amdgcn_update_dpp(0, __float_as_int(t[is]), 0xFF, 0xf, 0xf, false);
        (void)ctl; (void)dummy;
        const float ts = __int_as_float(tsb);
#pragma unroll
        for (int i = is; i < 16; ++i) t[i] -= Atq[s2 * 64 + 4 * i] * ts;
        if ((s2 & 7) == 7) asm volatile("" ::: "memory");
      }
#pragma unroll
      for (int i = 0; i < 16; ++i) T[(4 * i + q) * 65 + c] = t[i];
    }
    __syncthreads();
    for (int e = tid; e < 8192; e += 512) {
      int d = e >> 12, rc = e & 4095;
      long ci = (long)((b * 4 + h) * 2 + d) * 36 + oc;
      CL[ci * 8192 + rc] = f2bf(Tm[(d * 64 + (rc >> 6)) * 65 + (rc & 63)]);
    }
    __syncthreads();
  }
}

DI void ph_dnscan(const Prm& p, char* smem) {
  const int tid = mytid(), lane = tid & 63, wid = tid >> 6, fr = lane & 15, fq = lane >> 4;
  u16* Kg = (u16*)smem;
  u16* Qg = Kg + 64 * 144;
  u16* KdT = Qg + 64 * 144;
  u16* Tl = KdT + 128 * 80;
  u16* Il = Tl + 64 * 80;
  u16* ST = Il + 64 * 80;
  u16* RT = ST + 64 * 144;
  u16* VN = RT + 64 * 80;
  const u16* DQ = (const u16*)(p.ws + OFF_Y);
  const u16* DK = DQ + 18874368L;
  const u16* DV = DK + 18874368L;
  const u16* CL = (const u16*)(p.ws + OFF_AR + 3 * U38);
  const float* GC = (const float*)(p.ws + OFF_GC);
  const float* BT = (const float*)(p.ws + OFF_BETA);
  const int vt = wid & 3, rp = wid >> 2;
  for (int it = mybid(); it < 256; it += gridDim.x) {
    const int b = it >> 4, h = (it >> 2) & 3, d = (it >> 1) & 1, vs = it & 1;
    u16* O = (u16*)(p.ws + OFF_AR + (d ? 6 : 5) * U38);
    f32x4 S[4];
#pragma unroll
    for (int i = 0; i < 4; ++i) S[i] = f32x4{0.f, 0.f, 0.f, 0.f};
    for (int e = tid; e < 64 * 144; e += 512) ST[e] = 0;
    const long seqb = (long)(b * 4 + h) * 2304;
    const long cib = (long)((b * 4 + h) * 2 + d) * 36;
    u32x4 rk0, rk1, rq0, rq1, rT, rI;
    float rg0, rg1, rgl;
    uint2 rv0, rv1;
    float rb0, rb1;
    const int lr0 = tid >> 4, lr1 = (tid + 512) >> 4, lch = tid & 15;
    const int lj0 = d ? 63 - lr0 : lr0, lj1 = d ? 63 - lr1 : lr1;
    const int vr0 = (rp * 2) * 16 + fr, vr1 = (rp * 2 + 1) * 16 + fr;
    const int vj0 = d ? 63 - vr0 : vr0, vj1 = d ? 63 - vr1 : vr1;
#define SCAN_LOAD_KQ(ocx)                                                                    \
  {                                                                                          \
    const long ci_ = cib + (ocx);                                                            \
    const long g0_ = (seqb + (ocx) * 64 + lj0) * 128 + lch * 8, g1_ = (seqb + (ocx) * 64 + lj1) * 128 + lch * 8; \
    rk0 = *(const u32x4*)(DK + g0_); rk1 = *(const u32x4*)(DK + g1_);                        \
    rq0 = *(const u32x4*)(DQ + g0_); rq1 = *(const u32x4*)(DQ + g1_);                        \
    rT = *(const u32x4*)(CL + ci_ * 8192 + (tid >> 3) * 64 + (tid & 7) * 8);                 \
    rI = *(const u32x4*)(CL + ci_ * 8192 + 4096 + (tid >> 3) * 64 + (tid & 7) * 8);          \
    rg0 = GC[ci_ * 64 + lr0]; rg1 = GC[ci_ * 64 + lr1]; rgl = GC[ci_ * 64 + 63];             \
  }
#define SCAN_LOAD_V(ocx)                                                                     \
  {                                                                                          \
    const long ci_ = cib + (ocx);                                                            \
    rv0 = *(const uint2*)(DV + (seqb + (ocx) * 64 + vj0) * 128 + vs * 64 + vt * 16 + fq * 4); \
    rv1 = *(const uint2*)(DV + (seqb + (ocx) * 64 + vj1) * 128 + vs * 64 + vt * 16 + fq * 4); \
    rb0 = BT[ci_ * 64 + vr0]; rb1 = BT[ci_ * 64 + vr1];                                      \
  }
    {
      const int oc0 = d ? 3 : 0;
      SCAN_LOAD_KQ(oc0);
      SCAN_LOAD_V(oc0);
    }
    for (int i = 0; i < 36; ++i) {
      const int oc = d ? (i < 4 ? 3 - i : 39 - i) : i;
      const int ocn = d ? (i + 1 < 4 ? 3 - (i + 1) : 39 - (i + 1)) : i + 1;
      const int pos0 = oc * 64;
      const float gl = rgl;
      {
        float eg0 = __expf(rg0), ed0 = __expf(gl - rg0), eg1 = __expf(rg1), ed1 = __expf(gl - rg1);
        u32x4 ko0, qo0, ko1, qo1;
#pragma unroll
        for (int w = 0; w < 4; ++w) {
          float k0l = __uint_as_float(rk0[w] << 16), k0h = __uint_as_float(rk0[w] & 0xffff0000u);
          float q0l = __uint_as_float(rq0[w] << 16), q0h = __uint_as_float(rq0[w] & 0xffff0000u);
          float k1l = __uint_as_float(rk1[w] << 16), k1h = __uint_as_float(rk1[w] & 0xffff0000u);
          float q1l = __uint_as_float(rq1[w] << 16), q1h = __uint_as_float(rq1[w] & 0xffff0000u);
          ko0[w] = (unsigned)f2bf(k0l * eg0) | ((unsigned)f2bf(k0h * eg0) << 16);
          qo0[w] = (unsigned)f2bf(q0l * eg0 * 0.08838834764831845f) | ((unsigned)f2bf(q0h * eg0 * 0.08838834764831845f) << 16);
          ko1[w] = (unsigned)f2bf(k1l * eg1) | ((unsigned)f2bf(k1h * eg1) << 16);
          qo1[w] = (unsigned)f2bf(q1l * eg1 * 0.08838834764831845f) | ((unsigned)f2bf(q1h * eg1 * 0.08838834764831845f) << 16);
          KdT[(lch * 8 + 2 * w) * 80 + lr0] = f2bf(k0l * ed0);
          KdT[(lch * 8 + 2 * w + 1) * 80 + lr0] = f2bf(k0h * ed0);
          KdT[(lch * 8 + 2 * w) * 80 + lr1] = f2bf(k1l * ed1);
          KdT[(lch * 8 + 2 * w + 1) * 80 + lr1] = f2bf(k1h * ed1);
        }
        *(u32x4*)(Kg + lr0 * 144 + lch * 8) = ko0;
        *(u32x4*)(Qg + lr0 * 144 + lch * 8) = qo0;
        *(u32x4*)(Kg + lr1 * 144 + lch * 8) = ko1;
        *(u32x4*)(Qg + lr1 * 144 + lch * 8) = qo1;
        *(u32x4*)(Tl + (tid >> 3) * 80 + (tid & 7) * 8) = rT;
        *(u32x4*)(Il + (tid >> 3) * 80 + (tid & 7) * 8) = rI;
      }
      lds_barrier();
      if (i + 1 < 36) SCAN_LOAD_KQ(ocn);
      f32x4 ks_[2], qs_[2];
#pragma unroll
      for (int u = 0; u < 2; ++u) { ks_[u] = f32x4{0.f, 0.f, 0.f, 0.f}; qs_[u] = f32x4{0.f, 0.f, 0.f, 0.f}; }
#pragma unroll
      for (int kk = 0; kk < 4; ++kk) {
        bf16x8 a = *(const bf16x8*)(ST + (vt * 16 + fr) * 144 + kk * 32 + fq * 8);
#pragma unroll
        for (int u = 0; u < 2; ++u) {
          int rt = rp * 2 + u;
          bf16x8 bk = *(const bf16x8*)(Kg + (rt * 16 + fr) * 144 + kk * 32 + fq * 8);
          bf16x8 bq = *(const bf16x8*)(Qg + (rt * 16 + fr) * 144 + kk * 32 + fq * 8);
          ks_[u] = MFMA(a, bk, ks_[u]);
          qs_[u] = MFMA(a, bq, qs_[u]);
        }
      }
      {
        int v0 = vt * 16 + fq * 4;
        RT[(v0 + 0) * 80 + vr0] = f2bf(rb0 * (__uint_as_float(rv0.x << 16) - ks_[0][0]));
        RT[(v0 + 1) * 80 + vr0] = f2bf(rb0 * (__uint_as_float(rv0.x & 0xffff0000u) - ks_[0][1]));
        RT[(v0 + 2) * 80 + vr0] = f2bf(rb0 * (__uint_as_float(rv0.y << 16) - ks_[0][2]));
        RT[(v0 + 3) * 80 + vr0] = f2bf(rb0 * (__uint_as_float(rv0.y & 0xffff0000u) - ks_[0][3]));
        RT[(v0 + 0) * 80 + vr1] = f2bf(rb1 * (__uint_as_float(rv1.x << 16) - ks_[1][0]));
        RT[(v0 + 1) * 80 + vr1] = f2bf(rb1 * (__uint_as_float(rv1.x & 0xffff0000u) - ks_[1][1]));
        RT[(v0 + 2) * 80 + vr1] = f2bf(rb1 * (__uint_as_float(rv1.y << 16) - ks_[1][2]));
        RT[(v0 + 3) * 80 + vr1] = f2bf(rb1 * (__uint_as_float(rv1.y & 0xffff0000u) - ks_[1][3]));
      }
      if (i + 1 < 36) SCAN_LOAD_V(ocn);
      lds_barrier();
      {
        f32x4 vn[2];
#pragma unroll
        for (int u = 0; u < 2; ++u) vn[u] = f32x4{0.f, 0.f, 0.f, 0.f};
#pragma unroll
        for (int kk = 0; kk < 2; ++kk) {
          bf16x8 a = *(const bf16x8*)(RT + (vt * 16 + fr) * 80 + kk * 32 + fq * 8);
#pragma unroll
          for (int u = 0; u < 2; ++u) {
            bf16x8 bb = *(const bf16x8*)(Tl + ((rp * 2 + u) * 16 + fr) * 80 + kk * 32 + fq * 8);
            vn[u] = MFMA(a, bb, vn[u]);
          }
        }
#pragma unroll
        for (int u = 0; u < 2; ++u) {
          int r = (rp * 2 + u) * 16 + fr, v0 = vt * 16 + fq * 4;
#pragma unroll
          for (int j = 0; j < 4; ++j) VN[(v0 + j) * 80 + r] = f2bf(vn[u][j]);
        }
      }
      lds_barrier();
#pragma unroll
      for (int kk = 0; kk < 2; ++kk) {
        bf16x8 a = *(const bf16x8*)(VN + (vt * 16 + fr) * 80 + kk * 32 + fq * 8);
#pragma unroll
        for (int u = 0; u < 2; ++u) {
          bf16x8 bb = *(const bf16x8*)(Il + ((rp * 2 + u) * 16 + fr) * 80 + kk * 32 + fq * 8);
          qs_[u] = MFMA(a, bb, qs_[u]);
        }
      }
#pragma unroll
      for (int u = 0; u < 2; ++u) {
        int r = (rp * 2 + u) * 16 + fr, j = d ? 63 - r : r;
        u16* op = O + (long)tokof(b, pos0 + j) * 512 + h * 128 + vs * 64 + vt * 16 + fq * 4;
        ushort4 ov4;
        ov4.x = f2bf(qs_[u][0]); ov4.y = f2bf(qs_[u][1]); ov4.z = f2bf(qs_[u][2]); ov4.w = f2bf(qs_[u][3]);
        *(ushort4*)op = ov4;
      }
      {
        float ge = __expf(gl);
#pragma unroll
        for (int u = 0; u < 4; ++u) S[u] *= ge;
#pragma unroll
        for (int kk = 0; kk < 2; ++kk) {
          bf16x8 a = *(const bf16x8*)(VN + (vt * 16 + fr) * 80 + kk * 32 + fq * 8);
#pragma unroll
          for (int u = 0; u < 4; ++u) {
            bf16x8 bb = *(const bf16x8*)(KdT + ((rp * 4 + u) * 16 + fr) * 80 + kk * 32 + fq * 8);
            S[u] = MFMA(a, bb, S[u]);
          }
        }
#pragma unroll
        for (int u = 0; u < 4; ++u) {
          int dd = (rp * 4 + u) * 16 + fr, v0 = vt * 16 + fq * 4;
#pragma unroll
          for (int j = 0; j < 4; ++j) ST[(v0 + j) * 144 + dd] = f2bf(S[u][j]);
        }
      }
      lds_barrier();
    }
#undef SCAN_LOAD_KQ
#undef SCAN_LOAD_V
  }
}

DI void ph_dnfin(const Prm& p, int li) {
  const int lane = mytid() & 63;
  const int gw = mybid() * 8 + (mytid() >> 6), nw = gridDim.x * 8;
  const u16* O = (const u16*)(p.ws + OFF_AR + 5 * U38);
  const u16* O2 = (const u16*)(p.ws + OFF_AR + 6 * U38);
  u16* Z = (u16*)(p.ws + OFF_Y + 3 * U38);
  const float n0 = p.dn_norm[li * 128 + lane * 2], n1 = p.dn_norm[li * 128 + lane * 2 + 1];
#pragma unroll 2
  for (int tok = gw; tok < T_ALL; tok += nw) {
    ushort2 oa[4], ob[4], zz[4];
    float ox[4], oy[4], ss[4];
#pragma unroll
    for (int h = 0; h < 4; ++h) {
      long o = (long)tok * 512 + h * 128 + lane * 2;
      oa[h] = *(const ushort2*)(O + o);
      ob[h] = *(const ushort2*)(O2 + o);
      zz[h] = *(const ushort2*)(Z + o);
    }
#pragma unroll
    for (int h = 0; h < 4; ++h) {
      ox[h] = bf2f(oa[h].x) + bf2f(ob[h].x);
      oy[h] = bf2f(oa[h].y) + bf2f(ob[h].y);
      ss[h] = ox[h] * ox[h] + oy[h] * oy[h];
    }
#pragma unroll
    for (int o = 32; o; o >>= 1)
#pragma unroll
      for (int h = 0; h < 4; ++h) ss[h] += __shfl_xor(ss[h], o);
#pragma unroll
    for (int h = 0; h < 4; ++h) {
      float inv = rsqrtf(ss[h] * (1.f / 128.f) + 1e-6f);
      float z0 = bf2f(zz[h].x), z1 = bf2f(zz[h].y);
      ushort2 y;
      y.x = f2bf(ox[h] * inv * n0 * (z0 / (1.f + __expf(-z0))));
      y.y = f2bf(oy[h] * inv * n1 * (z1 / (1.f + __expf(-z1))));
      *(ushort2*)(Z + (long)tok * 512 + h * 128 + lane * 2) = y;
    }
  }
}

DI void ph_aprep(const Prm& p, int li) {
  const int lane = mytid() & 63;
  const int gw = mybid() * 8 + (mytid() >> 6), nw = gridDim.x * 8;
  const u16* PA = (const u16*)(p.ws + OFF_AR);
  u16* QH = (u16*)(p.ws + OFF_AR + 3 * U38);
  u16* KH = QH + 18874368L;
  const int f = lane & 15;
  const float inv_f = powf(10000.f, -(float)f / 16.f);
  for (int tok = gw; tok < T_ALL; tok += nw) {
    int b, P;
    float cs = 1.f, sn = 0.f;
    if (tok < T_LAT) {
      b = tok >> 11;
      int l = tok & 2047;
      P = 256 + l;
      float pos = (lane < 32) ? (float)(l >> 6) : (float)(l & 63);
      float ang = pos * inv_f;
      cs = cosf(ang);
      sn = sinf(ang);
    } else {
      b = (tok - T_LAT) >> 8;
      P = (tok - T_LAT) & 255;
    }
    float xv[16], ssq[16];
#pragma unroll
    for (int g = 0; g < 16; ++g) {
      xv[g] = bf2f(PA[(long)tok * 1024 + g * 64 + lane]);
      ssq[g] = xv[g] * xv[g];
    }
#pragma unroll
    for (int o = 32; o; o >>= 1)
#pragma unroll
      for (int g = 0; g < 16; ++g) ssq[g] += __shfl_xor(ssq[g], o);
#pragma unroll
    for (int g = 0; g < 16; ++g) {
      int which = g >> 3, h = (g >> 1) & 3, c = g & 1;
      float inv = rsqrtf(ssq[g] * (1.f / 64.f) + 1e-6f);
      float y = xv[g] * inv * p.qk_gain[(li * 2 + which) * 64 + lane];
      float pr = __shfl_xor(y, 16);
      float o = (lane & 16) ? (y * cs + pr * sn) : (y * cs - pr * sn);
      if (which == 0) o *= 0.18033688011112042f;
      u16* dst = (which ? KH : QH) + ((long)((b * 4 + h) * 2 + c) * 2304 + P) * 64 + lane;
      *dst = f2bf(o);
    }
  }
}

DI void ph_attn(const Prm& p, int li, long base, char* smem) {
  const int tid = mytid(), lane = tid & 63, wid = tid >> 6, fr = lane & 15, fq = lane >> 4;
  const u16* QH = (const u16*)(p.ws + OFF_AR + 3 * U38);
  const u16* KH = QH + 18874368L;
  const u16* VT = (const u16*)(p.ws + OFF_AR + 5 * U38);
  u16* YA = (u16*)(p.ws + OFF_Y);
  u16* s = (u16*)smem;
  constexpr int STG = 128 * 80 + 128 * 72;
  const float lambda_init = 0.8f - 0.6f * expf(-0.3f * (float)li);
  float lamv, mshift;
  {
    const float* lv = p.lam + li * 256;
    float a = wsum(lv[lane] * lv[64 + lane]), b2 = wsum(lv[128 + lane] * lv[192 + lane]);
    lamv = expf(a) - expf(b2) + lambda_init;
    float gq = wmax(fabsf(p.qk_gain[(li * 2) * 64 + lane])), gk = wmax(fabsf(p.qk_gain[(li * 2 + 1) * 64 + lane]));
    mshift = 8.f * gq * gk * 1.4426950408889634f;
  }
  for (int it = first_item(base); it < (li == 3 ? 1024 : 1152); it += gridDim.x) {
    int b, h, qp0, nkeys;
    if (it < 1024) { b = it >> 6; h = (it >> 4) & 3; qp0 = 256 + (it & 15) * 128; nkeys = 2304; }
    else { int i2 = it - 1024; b = i2 >> 3; h = (i2 >> 1) & 3; qp0 = (i2 & 1) * 128; nkeys = 256; }
    const long kb0 = (long)((b * 4 + h) * 2) * 2304;
    bf16x8 qf[2][2];
#pragma unroll
    for (int c = 0; c < 2; ++c)
#pragma unroll
      for (int ks = 0; ks < 2; ++ks)
        qf[c][ks] = *(const bf16x8*)(QH + (kb0 + (long)c * 2304 + qp0 + wid * 16 + fr) * 64 + ks * 32 + fq * 8);
    f32x4 O0[8], O1[8];
#pragma unroll
    for (int i = 0; i < 8; ++i) { O0[i] = f32x4{0.f, 0.f, 0.f, 0.f}; O1[i] = f32x4{0.f, 0.f, 0.f, 0.f}; }
    f32x4 L0 = {0.f, 0.f, 0.f, 0.f}, L1 = {0.f, 0.f, 0.f, 0.f};
    const bf16x8 ones = {0x3F80, 0x3F80, 0x3F80, 0x3F80, 0x3F80, 0x3F80, 0x3F80, 0x3F80};
    uint4 rk[2], rv[2];
    const int nt = nkeys >> 6;
#pragma unroll
    for (int u = 0; u < 2; ++u) {
      int id = tid + u * 512;
      int c = id >> 9, key = (id >> 3) & 63, ch = id & 7;
      rk[u] = *(const uint4*)(KH + (kb0 + (long)c * 2304 + key) * 64 + ch * 8);
      int dv = id >> 3;
      rv[u] = *(const uint4*)(VT + ((long)(b * 512 + h * 128 + dv)) * 2304 + ch * 8);
    }
#pragma unroll
    for (int u = 0; u < 2; ++u) {
      int id = tid + u * 512;
      *(uint4*)(s + (id >> 3) * 80 + (id & 7) * 8) = rk[u];
      *(uint4*)(s + 128 * 80 + (id >> 3) * 72 + (id & 7) * 8) = rv[u];
    }
    lds_barrier();
    for (int t = 0; t < nt; ++t) {
      const bool more = t + 1 < nt;
      if (more) {
        int kp0 = (t + 1) * 64;
#pragma unroll
        for (int u = 0; u < 2; ++u) {
          int id = tid + u * 512;
          int c = id >> 9, key = (id >> 3) & 63, ch = id & 7;
          rk[u] = *(const uint4*)(KH + (kb0 + (long)c * 2304 + kp0 + key) * 64 + ch * 8);
          int dv = id >> 3;
          rv[u] = *(const uint4*)(VT + ((long)(b * 512 + h * 128 + dv)) * 2304 + kp0 + ch * 8);
        }
      }
      const u16* ks_ = s + (t & 1) * STG;
      const u16* vs_ = ks_ + 128 * 80;
      bf16x8 pf[2][2];
#pragma unroll
      for (int c = 0; c < 2; ++c) {
#pragma unroll
        for (int kk2 = 0; kk2 < 2; ++kk2) {
          u32x4 pw;
#pragma unroll
          for (int hh = 0; hh < 2; ++hh) {
            const int k4 = kk2 * 2 + hh;
            f32x4 a = {-mshift, -mshift, -mshift, -mshift};
#pragma unroll
            for (int kk = 0; kk < 2; ++kk)
              a = MFMA(*(const bf16x8*)(ks_ + (c * 64 + k4 * 16 + fr) * 80 + kk * 32 + fq * 8), qf[c][kk], a);
            pw[hh * 2 + 0] = pk_bf16(__builtin_amdgcn_exp2f(a[0]), __builtin_amdgcn_exp2f(a[1]));
            pw[hh * 2 + 1] = pk_bf16(__builtin_amdgcn_exp2f(a[2]), __builtin_amdgcn_exp2f(a[3]));
          }
          pf[c][kk2] = *(bf16x8*)&pw;
        }
      }
#pragma unroll
      for (int kk = 0; kk < 2; ++kk) {
        L0 = MFMA(ones, pf[0][kk], L0);
        L1 = MFMA(ones, pf[1][kk], L1);
      }
#pragma unroll
      for (int dt = 0; dt < 8; ++dt) {
#pragma unroll
        for (int kk = 0; kk < 2; ++kk) {
          const u16* vp = vs_ + (dt * 16 + fr) * 72 + kk * 32 + fq * 4;
          uint2 lo = *(const uint2*)vp, hi = *(const uint2*)(vp + 16);
          uint4 av = {lo.x, lo.y, hi.x, hi.y};
          bf16x8 a = *(bf16x8*)&av;
          O0[dt] = MFMA(a, pf[0][kk], O0[dt]);
          O1[dt] = MFMA(a, pf[1][kk], O1[dt]);
        }
      }
      if (more) {
        u16* ns = s + ((t + 1) & 1) * STG;
#pragma unroll
        for (int u = 0; u < 2; ++u) {
          int id = tid + u * 512;
          *(uint4*)(ns + (id >> 3) * 80 + (id & 7) * 8) = rk[u];
          *(uint4*)(ns + 128 * 80 + (id >> 3) * 72 + (id & 7) * 8) = rv[u];
        }
      }
      lds_barrier();
    }
    float i0 = 1.f / L0[0], i1 = lamv / L1[0], ss = 0.f;
#pragma unroll
    for (int dt = 0; dt < 8; ++dt)
#pragma unroll
      for (int j = 0; j < 4; ++j) {
        float o = O0[dt][j] * i0 - O1[dt][j] * i1;
        O0[dt][j] = o;
        ss += o * o;
      }
    ss += __shfl_xor(ss, 16); ss += __shfl_xor(ss, 32);
    float inv = rsqrtf(ss * (1.f / 128.f) + 1e-6f) * (1.f - lambda_init);
    int tok = tokof(b, qp0 + wid * 16 + fr);
#pragma unroll
    for (int dt = 0; dt < 8; ++dt) {
      int dv = dt * 16 + fq * 4;
      const float* sw = p.subln + li * 128 + dv;
      ushort4 o;
      o.x = f2bf(O0[dt][0] * inv * sw[0]);
      o.y = f2bf(O0[dt][1] * inv * sw[1]);
      o.z = f2bf(O0[dt][2] * inv * sw[2]);
      o.w = f2bf(O0[dt][3] * inv * sw[3]);
      *(ushort4*)(YA + (long)tok * 512 + h * 128 + dv) = o;
    }
  }
}

template <int L>
DI void hyena_item(const Prm& p, int li, int ch, char* smem) {
  constexpr int CS = 2 * L + 8;
  constexpr int ZS = L + 8;
  constexpr int MT = L / 128;
  constexpr int MG = MT > 8 ? 8 : MT, NG = MT / MG;
  const int tid = mytid(), lane = tid & 63, wid = tid >> 6, fr = lane & 15, fq = lane >> 4;
  u16* cp = (u16*)smem;
  u16* zr = cp + 8 * CS;
  const u16* PH = (const u16*)(p.ws + OFF_AR) + (L == 2048 ? 0L : 32768L * 1536);
  const u16* G = (const u16*)(p.ws + (L == 2048 ? OFF_TAPL : OFF_TAPC));
  u16* YB = (u16*)(p.ws + OFF_Y + U38);
  const float* cw = p.hy_conv + (long)li * 3 * 1536;
  {
    float w0 = cw[1024 + ch], w1 = cw[1536 + 1024 + ch], w2 = cw[3072 + 1024 + ch];
    constexpr int NCH = (16 * L / 8) / 512;
    u32x4 cv[NCH];
    u16 pv[NCH], nv[NCH];
#pragma unroll
    for (int i = 0; i < NCH; ++i) {
      int id = tid + i * 512, b = id / (L / 8), s0 = (id % (L / 8)) * 8;
      const u16* row = PH + ((long)b * 1536 + 1024 + ch) * L + s0;
      cv[i] = *(const u32x4*)row;
      pv[i] = (s0 > 0) ? row[-1] : (u16)0;
      nv[i] = (s0 + 8 < L) ? row[8] : (u16)0;
    }
#pragma unroll
    for (int i = 0; i < NCH; ++i) {
      int id = tid + i * 512, b = id / (L / 8), s0 = (id % (L / 8)) * 8;
      float x[10];
      x[0] = bf2f(pv[i]);
      x[9] = bf2f(nv[i]);
#pragma unroll
      for (int w = 0; w < 4; ++w) {
        x[1 + 2 * w] = __uint_as_float(cv[i][w] << 16);
        x[2 + 2 * w] = __uint_as_float(cv[i][w] & 0xffff0000u);
      }
      float o[8];
#pragma unroll
      for (int e = 0; e < 8; ++e) o[e] = w0 * x[e] + w1 * x[e + 1] + w2 * x[e + 2];
      u32x4 r;
      r[0] = pk_bf16(o[7], o[6]); r[1] = pk_bf16(o[5], o[4]); r[2] = pk_bf16(o[3], o[2]); r[3] = pk_bf16(o[1], o[0]);
      *(u32x4*)(zr + b * ZS + L - 8 - s0) = r;
    }
  }
#pragma unroll
  for (int order = 0; order < 2; ++order) {
    {
      const u16* g = G + (long)(order * 512 + ch) * (2 * L);
      if (tid < 2 * L / 8) {
        const int i0 = tid * 8;
        u32x4 lo = *(const u32x4*)(g + i0);
        u32x4 hi = (i0 + 8 < 2 * L) ? *(const u32x4*)(g + i0 + 8) : u32x4{0u, 0u, 0u, 0u};
        unsigned D[8] = {lo[0], lo[1], lo[2], lo[3], hi[0], hi[1], hi[2], hi[3]};
#pragma unroll
        for (int c = 0; c < 8; ++c) {
          u32x4 o;
#pragma unroll
          for (int w = 0; w < 4; ++w) {
            if (c & 1) o[w] = (D[w + (c - 1) / 2] >> 16) | (D[w + (c + 1) / 2] << 16);
            else o[w] = D[w + c / 2];
          }
          *(u32x4*)(cp + c * CS + i0) = o;
        }
      }
    }
    __syncthreads();
    const float bias = p.hy_bias[(li * 2 + order) * 512 + ch];
    const int gcol = order * 512 + ch;
    const float w0 = cw[gcol], w1 = cw[1536 + gcol], w2 = cw[3072 + gcol];
    const int tq = wid * (L / 8) + fq * 4;
    const u16* xb = PH + ((long)fr * 1536 + gcol) * L + tq;
    const u16* zb = zr + fr * ZS + L - 1 - tq;
    unsigned zp[NG][MG][2];
#pragma unroll
    for (int grp = 0; grp < NG; ++grp) {
      f32x4 acc[MG];
#pragma unroll
      for (int m = 0; m < MG; ++m) acc[m] = f32x4{0.f, 0.f, 0.f, 0.f};
      const int tb = wid * (L / 8) + grp * MG * 16 + fr;
      if constexpr (MG == 8) {
        const int i00 = tb - fq * 8 - 7 + L, c0 = i00 & 7;
        const u16* ab = cp + c0 * CS + (i00 - c0);
        const u16* zbp = zr + fr * ZS + (L - 8 - fq * 8);
        bf16x8 W[16];
#pragma unroll 1
        for (int s0 = 0; s0 < L; s0 += 256) {
#pragma unroll
          for (int k = 0; k < 8; ++k) {
            const int sk = s0 + 32 * k;
            if (k == 0) {
#pragma unroll
              for (int m = 0; m < 8; ++m) W[m] = *(const bf16x8*)(ab + m * 16 - sk);
            }
            if (k < 7) {
              W[(16 - 2 * k - 2) & 15] = *(const bf16x8*)(ab - sk - 32);
              W[(16 - 2 * k - 1) & 15] = *(const bf16x8*)(ab - sk - 32 + 16);
            }
            bf16x8 bk = *(const bf16x8*)(zbp - sk);
#pragma unroll
            for (int m = 0; m < 8; ++m) acc[m] = MFMA(W[(m + 16 - 2 * k) & 15], bk, acc[m]);
          }
        }
      } else {
#pragma unroll 2
        for (int s0 = 0; s0 < L; s0 += 32) {
          bf16x8 bfr = *(const bf16x8*)(zr + fr * ZS + (L - 8 - s0 - fq * 8));
#pragma unroll
          for (int m = 0; m < MG; ++m) {
            int i0 = tb + m * 16 - s0 - fq * 8 - 7 + L;
            int c = i0 & 7;
            bf16x8 afr = *(const bf16x8*)(cp + c * CS + (i0 - c));
            acc[m] = MFMA(afr, bfr, acc[m]);
          }
        }
      }
#pragma unroll
      for (int m = 0; m < MG; ++m) {
        float r4[4];
#pragma unroll
        for (int j = 0; j < 4; ++j) {
          const int off = (grp * MG + m) * 16 + j;
          const int t = tq + off;
          float xa = bf2f(xb[off - 1]), xc = bf2f(xb[off]), xd = bf2f(xb[off + 1]);
          xa = (t > 0) ? xa : 0.f;
          xd = (t + 1 < L) ? xd : 0.f;
          float xg = w0 * xa + w1 * xc + w2 * xd;
          float zin = bf2f(zb[-off]);
          r4[j] = xg * (acc[m][j] + bias * zin);
        }
        zp[grp][m][0] = (unsigned)f2bf(r4[0]) | ((unsigned)f2bf(r4[1]) << 16);
        zp[grp][m][1] = (unsigned)f2bf(r4[2]) | ((unsigned)f2bf(r4[3]) << 16);
      }
    }
    __syncthreads();
#pragma unroll
    for (int grp = 0; grp < NG; ++grp)
#pragma unroll
      for (int m = 0; m < MG; ++m) {
        int t0 = wid * (L / 8) + (grp * MG + m) * 16 + fq * 4;
        uint2 w;
        w.x = (zp[grp][m][1] >> 16) | (zp[grp][m][1] << 16);
        w.y = (zp[grp][m][0] >> 16) | (zp[grp][m][0] << 16);
        *(uint2*)(zr + fr * ZS + L - 4 - t0) = w;
      }
  }
  __syncthreads();
  {
    u16* YBT = (u16*)(p.ws + OFF_AR + 5 * U38) + (L == 2048 ? 0L : 16L * 512 * 2048);
    constexpr int NCH = (16 * L / 8) / 512;
#pragma unroll
    for (int i = 0; i < NCH; ++i) {
      int id = tid + i * 512, b = id / (L / 8), t0 = (id % (L / 8)) * 8;
      u32x4 r = *(const u32x4*)(zr + b * ZS + L - 8 - t0);
      u32x4 o;
      o[0] = (r[3] >> 16) | (r[3] << 16);
      o[1] = (r[2] >> 16) | (r[2] << 16);
      o[2] = (r[1] >> 16) | (r[1] << 16);
      o[3] = (r[0] >> 16) | (r[0] << 16);
      *(u32x4*)(YBT + ((long)b * 512 + ch) * L + t0) = o;
    }
  }
  __syncthreads();
}

DI long ph_ytrans(const Prm& p, long base, bool lastl, char* smem) {
  u16* tl = (u16*)smem;
  const u16* YBT = (const u16*)(p.ws + OFF_AR + 5 * U38);
  u16* YB = (u16*)(p.ws + OFF_Y + U38);
  const int tid = mytid(), G = gridDim.x;
  const int total = lastl ? 4096 : 4608;
  auto srcp = [&](int it) -> const u16* {
    if (it < 4096) {
      int b = it >> 8, ct = (it >> 5) & 7, lt = it & 31;
      return YBT + ((long)b * 512 + ct * 64 + (tid >> 3)) * 2048 + lt * 64 + (tid & 7) * 8;
    } else {
      int i2 = it - 4096, b = i2 >> 5, ct = (i2 >> 2) & 7, lt = i2 & 3;
      return YBT + 16L * 512 * 2048 + ((long)b * 512 + ct * 64 + (tid >> 3)) * 256 + lt * 64 + (tid & 7) * 8;
    }
  };
  int it = first_item(base);
  u32x4 v = {0u, 0u, 0u, 0u};
  if (it < total) v = *(const u32x4*)srcp(it);
  for (; it < total; it += G) {
    *(u32x4*)(tl + (tid >> 3) * 72 + (tid & 7) * 8) = v;
    __syncthreads();
    if (it + G < total) v = *(const u32x4*)srcp(it + G);
    long tok0;
    int ct;
    if (it < 4096) { int b = it >> 8, lt = it & 31; ct = (it >> 5) & 7; tok0 = (long)b * 2048 + lt * 64; }
    else { int i2 = it - 4096, b = i2 >> 5, lt = i2 & 3; ct = (i2 >> 2) & 7; tok0 = (long)T_LAT + b * 256 + lt * 64; }
    const int lrow = tid >> 3, cc = tid & 7;
    u32x4 o;
#pragma unroll
    for (int w = 0; w < 4; ++w) {
      unsigned lo = tl[(cc * 8 + 2 * w) * 72 + lrow], hi = tl[(cc * 8 + 2 * w + 1) * 72 + lrow];
      o[w] = lo | (hi << 16);
    }
    *(u32x4*)(YB + (tok0 + lrow) * 512 + ct * 64 + cc * 8) = o;
    __syncthreads();
  }
  return base + total;
}

DI void ph_merge(const Prm& p, char* smem, bool lastl) {
  const int tid = mytid(), lane = tid & 63, wid = tid >> 6;
  const int wm = wid >> 1, wn = wid & 1, fr = lane & 15, fq = lane >> 4;
  const u16* H = (const u16*)(p.ws + OFF_HBF);
  const u16* Y = (const u16*)(p.ws + OFF_Y);
  const u16* WG = (const u16*)(p.ws + OFF_WB) + WO_G;
  const u16* WBr = (const u16*)(p.ws + OFF_WB) + WO_B;
  u16* MG = (u16*)(p.ws + OFF_AR);
  const int NT = (lastl ? 256 : 288) * 8, G = gridDim.x;
  Stg r0, r1;
  bool pre = false;
  for (int t = mybid(); t < NT; t += G) {
    const int mt = t >> 3, nt = t & 7;
    const bool hn = t + G < NT;
    const int mt2 = (t + G) >> 3, nt2 = (t + G) & 7;
    f32x4 acc[2][4], g[2][4], y[2][4];
#pragma unroll
    for (int a = 0; a < 2; ++a)
#pragma unroll
      for (int b = 0; b < 4; ++b) acc[a][b] = f32x4{0.f, 0.f, 0.f, 0.f};
    const u16* gA = H + (long)mt * 128 * 1024;
    for (int n = 0; n < 4; ++n) {
      const u16* gB = WG + ((long)n * 1024 + nt * 128) * 1024;
      const u16* yA = Y + (long)n * (T_ALL * 512L) + (long)mt * 128 * 512;
      const u16* yB = WBr + ((long)n * 1024 + nt * 128) * 512;
      gemm_tile<2>(g, gA, 1024, gB, 1024, 1024, smem, r0, r1, pre, yA, 512, yB, 512);
      const u16* nxA = (n < 3) ? gA : (hn ? H + (long)mt2 * 128 * 1024 : nullptr);
      const u16* nxB = (n < 3) ? WG + ((long)(n + 1) * 1024 + nt * 128) * 1024 : WG + ((long)nt2 * 128) * 1024;
      gemm_tile<2>(y, yA, 512, yB, 512, 512, smem, r0, r1, true, nxA, 1024, nxB, 1024);
      pre = true;
#pragma unroll
      for (int a = 0; a < 2; ++a)
#pragma unroll
        for (int b = 0; b < 4; ++b)
#pragma unroll
          for (int j = 0; j < 4; ++j) acc[a][b][j] += y[a][b][j] / (1.f + __expf(-g[a][b][j]));
    }
    pre = hn;
#pragma unroll
    for (int a = 0; a < 2; ++a)
#pragma unroll
      for (int b = 0; b < 4; ++b) {
        int r = wm * 32 + a * 16 + fr, c = wn * 64 + b * 16 + fq * 4;
        uint2 o;
        o.x = pk_bf16(acc[a][b][0], acc[a][b][1]);
        o.y = pk_bf16(acc[a][b][2], acc[a][b][3]);
        *(uint2*)(MG + ((long)mt * 128 + r) * 1024 + nt * 128 + c) = o;
      }
  }
}

DI void run_phase(const Prm& p, int ph, char* smem) {
  if (ph == 0) { ph_init(p, smem); return; }
  const int li = (ph - 1) / 14, k = (ph - 1) % 14;
  const u16* WB = (const u16*)(p.ws + OFF_WB);
  const u16* HB = (const u16*)(p.ws + OFF_HBF);
  const float* MOD = (const float*)(p.ws + OFF_MOD);
  u16* AR = (u16*)(p.ws + OFF_AR);
  u16* Yb = (u16*)(p.ws + OFF_Y);
  const int G = gridDim.x;
  TD d;
  d.split = 0; d.scale = 1.f; d.mode = 0; d.tok0 = 0; d.col0 = 0; d.g = MOD;
  switch (k) {
    case 0: {
      u16* W = (u16*)(p.ws + OFF_WB);
      long base = 0;
      base = tr_job(base, p.w_in + (long)li * 1024 * NIN, 1024, NIN, W + WO_IN, 1, smem);
      base = tr_job(base, p.w_gate + (long)li * 4 * 1048576, 1024, 1024, W + WO_G, 4, smem);
      base = tr_job(base, p.w_branch + (long)li * 4 * 524288, 512, 1024, W + WO_B, 4, smem);
      base = tr_job(base, p.w_o + (long)li * 1048576, 1024, 1024, W + WO_O, 1, smem);
      base = tr_job(base, p.w_mlp1 + (long)li * 4194304, 1024, 4096, W + WO_1, 1, smem);
      base = tr_job(base, p.w_mlp2 + (long)li * 4194304, 4096, 1024, W + WO_2, 1, smem);
      ph_taps1(p, li, base, smem);
      ph_norm(p, li, 0);
    } break;
    case 1: {
      auto dec = [&](int t, TD& o) {
        o.lda = 1024; o.ldb = 1024; o.K = 1024; o.mode = 0;
        if (t < 1728) {
          int mt = t / 12, nt = t % 12;
          o.A = HB + (long)mt * 256 * 1024; o.B = WB + WO_IN + (long)(3584 + nt * 128) * 1024;
          o.C = AR + (long)mt * 256 * 1536 + nt * 128; o.ldc = 1536;
        } else if (t < 2304) {
          int t2 = t - 1728, mt = t2 >> 2, nt = t2 & 3;
          o.A = HB + (long)mt * 256 * 1024; o.B = WB + WO_IN + (long)(5120 + nt * 128) * 1024;
          o.C = Yb + 3 * (U38 / 2) + (long)mt * 256 * 512 + nt * 128; o.ldc = 512;
        } else {
          int mt = t - 2304;
          o.A = HB + (long)mt * 256 * 1024; o.B = WB + WO_IN + (long)5632 * 1024;
          o.C = (u16*)((float*)(p.ws + OFF_PDAB) + (long)mt * 256 * 16); o.ldc = 16; o.mode = 3;
        }
      };
      {
        Stg r0, r1;
        bool pre = false;
        TD dn = d;
        int t = mybid();
        if (t < 2448) dec(t, d);
        for (; t < 2448; t += G) {
          const bool hn = t + G < 2448;
          if (hn) dec(t + G, dn);
          run_tile2(p, d, smem, r0, r1, pre, hn ? dn.A : nullptr, dn.lda, dn.B, dn.ldb);
          pre = hn;
          d = dn;
        }
      }
      ph_taps2(p, 2448, smem);
    } break;
    case 2: ph_dncl(p, li, smem); break;
    case 3: ph_dnscan(p, smem); break;
    case 4: {
      {
        Stg r0, r1;
        bool pre = false;
        for (int t = mybid(); t < 1152; t += G) {
          int mt = t >> 3, nt = t & 7;
          const bool hn = t + G < 1152;
          int mt2 = (t + G) >> 3, nt2 = (t + G) & 7;
          d.lda = 1024; d.ldb = 1024; d.K = 1024;
          d.A = HB + (long)mt * 256 * 1024; d.B = WB + WO_IN + (long)(nt * 128) * 1024;
          d.C = AR + 3 * (U38 / 2); d.ldc = 0; d.mode = 4; d.tok0 = mt * 256; d.col0 = nt;
          d.g = p.qk_gain + li * 128;
          run_tile2(p, d, smem, r0, r1, pre, hn ? HB + (long)mt2 * 256 * 1024 : nullptr, 1024,
                    WB + WO_IN + (long)(nt2 * 128) * 1024, 1024);
          pre = hn;
        }
      }
      ph_dnfin(p, li);
    } break;
    case 5: {
      u16* VT = AR + 5 * (U38 / 2);
      u16* PF = AR + 6 * (U38 / 2);
      auto dec = [&](int t, TD& o) {
        o.lda = 1024; o.ldb = 1024; o.K = 1024;
        if (t < 512) {
          int b = t >> 5, r = t & 31, mt = r >> 4, nt = r & 15;
          o.A = WB + WO_IN + (long)(1024 + mt * 256) * 1024; o.B = HB + ((long)b * 2048 + nt * 128) * 1024;
          o.C = VT + ((long)b * 512 + mt * 256) * 2304 + 256 + nt * 128; o.ldc = 2304;
        } else if (t < 576) {
          int t2 = t - 512, b = t2 >> 2, r = t2 & 3, mt = r >> 1, nt = r & 1;
          o.A = WB + WO_IN + (long)(1024 + mt * 256) * 1024; o.B = HB + ((long)T_LAT + b * 256 + nt * 128) * 1024;
          o.C = VT + ((long)b * 512 + mt * 256) * 2304 + nt * 128; o.ldc = 2304;
        } else {
          int t2 = t - 576, mt = t2 >> 2, nt = t2 & 3;
          o.A = HB + (long)mt * 256 * 1024; o.B = WB + WO_IN + (long)(3072 + nt * 128) * 1024;
          o.C = PF + (long)mt * 256 * 512 + nt * 128; o.ldc = 512;
        }
      };
      {
        Stg r0, r1;
        bool pre = false;
        TD dn = d;
        int t = mybid();
        if (t < 1152) dec(t, d);
        for (; t < 1152; t += G) {
          const bool hn = t + G < 1152;
          if (hn) dec(t + G, dn);
          run_tile2(p, d, smem, r0, r1, pre, hn ? dn.A : nullptr, dn.lda, dn.B, dn.ldb);
          pre = hn;
          d = dn;
        }
      }
    } break;
    case 6: {
      ph_attn(p, li, 0, smem);
      auto dec = [&](int t, TD& o) {
        o.lda = 1024; o.ldb = 1024; o.K = 1024;
        if (t < 1536) {
          int b = t / 96, r = t % 96, mt = r >> 4, nt = r & 15;
          o.A = WB + WO_IN + (long)(1536 + mt * 256) * 1024; o.B = HB + ((long)b * 2048 + nt * 128) * 1024;
          o.C = AR + ((long)b * 1536 + mt * 256) * 2048 + nt * 128; o.ldc = 2048;
        } else {
          int t2 = t - 1536, b = t2 / 12, r = t2 % 12, mt = r >> 1, nt = r & 1;
          o.A = WB + WO_IN + (long)(1536 + mt * 256) * 1024; o.B = HB + ((long)T_LAT + b * 256 + nt * 128) * 1024;
          o.C = AR + 32768L * 1536 + ((long)b * 1536 + mt * 256) * 256 + nt * 128; o.ldc = 256;
        }
      };
      {
        Stg r0, r1;
        bool pre = false;
        TD dn = d;
        int t = first_item(1152);
        if (t < 1728) dec(t, d);
        for (; t < 1728; t += G) {
          const bool hn = t + G < 1728;
          if (hn) dec(t + G, dn);
          run_tile2(p, d, smem, r0, r1, pre, hn ? dn.A : nullptr, dn.lda, dn.B, dn.ldb);
          pre = hn;
          d = dn;
        }
      }
    } break;
    case 7: {
#if !defined(TESTSEL) || TESTSEL == 1
      for (int it = mybid(); it < 512; it += G) hyena_item<2048>(p, li, it, smem);
#endif
#if !defined(TESTSEL) || TESTSEL == 2
      if (li < 3)
        for (int it = mybid(); it < 512; it += G) hyena_item<256>(p, li, it, smem);
#endif
#if !defined(TESTSEL) || TESTSEL == 3
      const u16* PF = AR + 6 * (U38 / 2);
      u16* WF = AR + 3 * (U38 / 2);
      const u16* DCm = (const u16*)(p.ws + OFF_DC);
      auto dec = [&](int t, TD& o) {
        o.A = DCm; o.lda = 128; o.ldb = 512; o.K = 128;
        if (t < 1024) {
          int bg = t >> 4, nt = t & 15, b = bg >> 2, g = bg & 3;
          o.B = PF + ((long)b * 2048 + nt * 128) * 512 + g * 128;
          o.C = WF + ((long)b * 512 + g * 128) * 4096 + nt * 128; o.ldc = 4096; o.split = 2048;
        } else {
          int t2 = t - 1024, bg = t2 >> 1, nt = t2 & 1, b = bg >> 2, g = bg & 3;
          o.B = PF + ((long)T_LAT + b * 256 + nt * 128) * 512 + g * 128;
          o.C = WF + 16L * 512 * 4096 + ((long)b * 512 + g * 128) * 512 + nt * 128; o.ldc = 512; o.split = 256;
        }
      };
      {
        const int NT7 = (li == 3 ? 1024 : 1152);
        Stg r0, r1;
        bool pre = false;
        TD dn = d;
        int t = mybid();
        if (t < NT7) dec(t, d);
        for (; t < NT7; t += G) {
          const bool hn = t + G < NT7;
          if (hn) dec(t + G, dn);
          run_tile2(p, d, smem, r0, r1, pre, hn ? dn.A : nullptr, dn.lda, dn.B, dn.ldb);
          pre = hn;
          d = dn;
        }
      }
#endif
    } break;
    case 8: {
      const u16* WF = AR + 3 * (U38 / 2);
      u16* YF = Yb + 2 * (U38 / 2);
      d.scale = 1.f / 512.f;
      for (int t = mybid(); t < (li == 3 ? 512 : 576); t += G) {
        if (t < 512) {
          int b = t >> 5, r = t & 31, mt = r >> 2, nt = r & 3;
          d.A = (const u16*)(p.ws + OFF_DL) + (long)mt * 256 * 4096; d.lda = 4096;
          d.B = WF + ((long)b * 512 + nt * 128) * 4096; d.ldb = 4096; d.K = 4096;
          d.C = YF + ((long)b * 2048 + mt * 256) * 512 + nt * 128; d.ldc = 512;
        } else {
          int t2 = t - 512, b = t2 >> 2, nt = t2 & 3;
          d.A = (const u16*)(p.ws + OFF_DLC); d.lda = 512;
          d.B = WF + 16L * 512 * 4096 + ((long)b * 512 + nt * 128) * 512; d.ldb = 512; d.K = 512;
          d.C = YF + ((long)T_LAT + b * 256) * 512 + nt * 128; d.ldc = 512;
        }
        run_tile(p, d, smem);
      }
      ph_ytrans(p, 576, li == 3, smem);
    } break;
    case 9: ph_merge(p, smem, li == 3); break;
    case 10: {
      d.mode = 2;
      const int NT10 = (li == 3 ? 1024 : 1152);
      Stg r0, r1;
      bool pre = false;
      for (int t = mybid(); t < NT10; t += G) {
        int mt = t >> 3, nt = t & 7;
        d.A = AR + (long)mt * 256 * 1024; d.lda = 1024; d.B = WB + WO_O + (long)nt * 128 * 1024; d.ldb = 1024; d.K = 1024;
        d.tok0 = mt * 256; d.col0 = nt * 128;
        int bb = d.tok0 < T_LAT ? (d.tok0 >> 11) : 16;
        d.g = MOD + ((long)li * 17 + bb) * 6144 + 2 * 1024;
        const bool hn = t + G < NT10;
        int mt2 = (t + G) >> 3, nt2 = (t + G) & 7;
        run_tile2(p, d, smem, r0, r1, pre, hn ? AR + (long)mt2 * 256 * 1024 : nullptr, 1024,
                  WB + WO_O + (long)nt2 * 128 * 1024, 1024);
        pre = hn;
      }
    } break;
    case 11: ph_norm(p, li, 1); break;
    case 12: {
      d.mode = 1;
      const int NT12 = (li == 3 ? 4096 : 4608);
      Stg r0, r1;
      bool pre = false;
      for (int t = mybid(); t < NT12; t += G) {
        int mt = t >> 5, nt = t & 31;
        d.A = HB + (long)mt * 256 * 1024; d.lda = 1024; d.B = WB + WO_1 + (long)nt * 128 * 1024; d.ldb = 1024; d.K = 1024;
        d.C = Yb + (long)mt * 256 * 4096 + nt * 128; d.ldc = 4096;
        const bool hn = t + G < NT12;
        int mt2 = (t + G) >> 5, nt2 = (t + G) & 31;
        run_tile2(p, d, smem, r0, r1, pre, hn ? HB + (long)mt2 * 256 * 1024 : nullptr, 1024,
                  WB + WO_1 + (long)nt2 * 128 * 1024, 1024);
        pre = hn;
      }
    } break;
    case 13: {
      d.mode = 2;
      for (int t = mybid(); t < (li == 3 ? 1024 : 1152); t += G) {
        int mt = t >> 3, nt = t & 7;
        d.A = Yb + (long)mt * 256 * 4096; d.lda = 4096; d.B = WB + WO_2 + (long)nt * 128 * 4096; d.ldb = 4096; d.K = 4096;
        d.tok0 = mt * 256; d.col0 = nt * 128;
        int bb = d.tok0 < T_LAT ? (d.tok0 >> 11) : 16;
        d.g = MOD + ((long)li * 17 + bb) * 6144 + 5 * 1024;
        run_tile(p, d, smem);
      }
    } break;
  }
}


#define XB_TMO      128
#define XB_XCNT(j)  (256  + 64 * (j))
#define XB_XSUB(j)  (1280 + 64 * (j))
#define XB_XGEN(j)  (2304 + 64 * (j))
#define XB_TOP      3328
#define XB_TOPGEN   3392
#define XCD_BAR_WORDS 3456
#define XB_SPIN_CAP (1u << 20)
#define LAS __attribute__((address_space(3)))
DI unsigned xb_ld(unsigned* p) { return __hip_atomic_load(p, __ATOMIC_RELAXED, __HIP_MEMORY_SCOPE_AGENT); }
DI unsigned xb_add(unsigned* p, unsigned v) { return __hip_atomic_fetch_add(p, v, __ATOMIC_RELAXED, __HIP_MEMORY_SCOPE_AGENT); }
DI unsigned xb_xcc_id() { return (unsigned)__builtin_amdgcn_s_getreg((3 << 11) | 20) & 0xFu; }
#define XB_SPIN(cond, bar) do { unsigned _sp = 0; while (cond) { __builtin_amdgcn_s_sleep(1); \
    if ((++_sp & 255u) == 0u) { if (xb_ld(&(bar)[XB_TMO])) break; if (_sp > XB_SPIN_CAP) { atomicAdd(&(bar)[XB_TMO], 1u); break; } } } } while (0)
struct XcdBarrier { unsigned* bar; unsigned x; volatile LAS unsigned* st; };
DI XcdBarrier xcd_barrier_post(unsigned* bar, volatile LAS unsigned* st) {
  XcdBarrier b; b.bar = bar; b.x = xb_xcc_id(); b.st = st;
  if (threadIdx.x == 0) (void)xb_add(&bar[XB_XCNT(b.x)], 1u);
  return b;
}
DI void xcd_barrier_complete(unsigned* bar, unsigned x, unsigned& nloc, unsigned& nx) {
  const unsigned G = gridDim.x * gridDim.y * gridDim.z;
  unsigned sum, cnt, mine, sp = 0u;
  for (;;) {
    sum = 0u; cnt = 0u; mine = 0u;
#pragma unroll
    for (unsigned j = 0; j < 16; ++j) { const unsigned c = xb_ld(&bar[XB_XCNT(j)]); sum += c; cnt += (c > 0u) ? 1u : 0u; mine = (j == x) ? c : mine; }
    if (sum == G) break;
    __builtin_amdgcn_s_sleep(1);
    if ((++sp & 255u) == 0u) { if (xb_ld(&bar[XB_TMO])) break; if (sp > XB_SPIN_CAP) { atomicAdd(&bar[XB_TMO], 1u); break; } }
  }
  nloc = mine > 0u ? mine : 1u; nx = cnt > 0u ? cnt : 1u;
}
DI void xcd_barrier(const XcdBarrier& b) {
  asm volatile("s_waitcnt vmcnt(0)" ::: "memory");
  __syncthreads();
  if (threadIdx.x == 0) {
    unsigned* bar = b.bar;
    __builtin_amdgcn_s_waitcnt(0);
    unsigned nloc = b.st[0], nx = b.st[1];
    if (nloc == 0u) { xcd_barrier_complete(bar, b.x, nloc, nx); b.st[0] = nloc; b.st[1] = nx; }
    const unsigned old = xb_add(&bar[XB_XSUB(b.x)], 1u);
    const unsigned gen = old / nloc;
    if (old + 1u == (gen + 1u) * nloc) {
      __builtin_amdgcn_fence(__ATOMIC_RELEASE, "agent");
      asm volatile("s_waitcnt vmcnt(0)" ::: "memory");
      const unsigned og = xb_add(&bar[XB_TOP], 1u);
      const unsigned tg = og / nx;
      if (og + 1u == (tg + 1u) * nx) xb_add(&bar[XB_TOPGEN], 1u);
      else XB_SPIN(xb_ld(&bar[XB_TOPGEN]) == tg, bar);
      __builtin_amdgcn_fence(__ATOMIC_ACQUIRE, "agent");
      xb_add(&bar[XB_XGEN(b.x)], 1u);
      asm volatile("s_waitcnt vmcnt(0)" ::: "memory");
    } else {
      XB_SPIN(xb_ld(&bar[XB_XGEN(b.x)]) == gen, bar);
      __builtin_amdgcn_fence(__ATOMIC_ACQUIRE, "agent");
      asm volatile("s_waitcnt vmcnt(0)" ::: "memory");
    }
  }
  __syncthreads();
}

extern __shared__ __attribute__((aligned(16))) char dyn_smem[];

__global__ void __launch_bounds__(512) mega(Prm p, int lo, int hi) {
  __shared__ uint4 xb_words;
  if (threadIdx.x == 0) xb_words = make_uint4(0u, 0u, 0u, 0u);
  __syncthreads();
  XcdBarrier xb = xcd_barrier_post((unsigned*)(p.ws + OFF_BAR), (volatile LAS unsigned*)&xb_words);
#ifdef ONLYK
  run_phase(p, ONLYK, dyn_smem);
#else
  for (int ph = lo; ph <= hi; ++ph) {
    long z = 0;
    asm volatile("" : "+s"(z));
    Prm q;
#define LP(f) q.f = p.f + z
    LP(x); LP(c); LP(ctx); LP(c_ctx); LP(w_ada); LP(b_ada); LP(norm1); LP(norm2); LP(w_in); LP(qk_gain); LP(lam);
    LP(subln); LP(hy_conv); LP(hy_w1); LP(hy_b1); LP(hy_freq); LP(hy_w2); LP(hy_b2); LP(hy_w3); LP(hy_bias);
    LP(dn_conv); LP(dn_a_log); LP(dn_dt_bias); LP(dn_norm); LP(w_gate); LP(w_branch); LP(w_o); LP(w_mlp1); LP(w_mlp2);
    LP(out); LP(ws);
#undef LP
    run_phase(q, ph, dyn_smem);
#ifdef PROBEK
    if (ph > 0 && (ph - 1) % 14 == PROBEK) { cg::this_grid().sync(); run_phase(q, ph, dyn_smem); }
#endif
    if (ph < hi) {
      if (ph == lo) cg::this_grid().sync();
      else xcd_barrier(xb);
    }
  }
#endif
}

extern "C" void kernel_launch(void* const* d_in, const int* in_sizes, int n_in, void* d_out, int out_size, void* d_ws,
                              size_t ws_size, hipStream_t stream) {
  static int grid_blocks = 0;
  if (!grid_blocks) {
    hipFuncSetAttribute((const void*)mega, hipFuncAttributeMaxDynamicSharedMemorySize, LDS_BYTES);
    int dev = 0, cus = 0, per_cu = 0;
    hipGetDevice(&dev);
    hipDeviceGetAttribute(&cus, hipDeviceAttributeMultiprocessorCount, dev);
    hipOccupancyMaxActiveBlocksPerMultiprocessor(&per_cu, mega, 512, LDS_BYTES);
    if (per_cu < 1) per_cu = 1;
    grid_blocks = cus * per_cu;
    if (ws_size < (size_t)WS_TOTAL) fprintf(stderr, "workspace too small: %zu < %ld\n", ws_size, (long)WS_TOTAL);
  }
  Prm p;
  const float** pp = (const float**)&p;
  for (int i = 0; i < 29; ++i) pp[i] = (const float*)d_in[i];
  p.out = (float*)d_out;
  p.ws = (char*)d_ws;
#if MULTI
  for (int ph = 0; ph < NPHASE; ++ph) hipLaunchKernelGGL(mega, dim3(grid_blocks), dim3(512), LDS_BYTES, stream, p, ph, ph);
#else
  int lo = 0, hi = NPHASE - 1;
  hipMemsetAsync((char*)d_ws + OFF_BAR, 0, XCD_BAR_WORDS * 4, stream);
  void* args[] = {&p, &lo, &hi};
  hipError_t e = hipLaunchCooperativeKernel((void*)mega, dim3(grid_blocks), dim3(512), args, LDS_BYTES, stream);
  if (e != hipSuccess) fprintf(stderr, "cooperative launch failed: %s (grid %d)\n", hipGetErrorString(e), grid_blocks);
#endif
}
```

```cpp
#include <hip/hip_runtime.h>
#include <hip/hip_cooperative_groups.h>
#include <stdint.h>
#include <stdio.h>
namespace cg = cooperative_groups;

typedef unsigned short u16;
typedef __attribute__((ext_vector_type(8))) short bf16x8;
typedef __attribute__((ext_vector_type(4))) float f32x4;
#define MFMA(a, b, c) __builtin_amdgcn_mfma_f32_16x16x32_bf16(a, b, c, 0, 0, 0)
#define DI __device__ __forceinline__

#ifndef MULTI
#define MULTI 0
#endif

constexpr int T_LAT = 32768, T_ALL = 36864;
constexpr int NIN = 5648;
constexpr long U38 = 37748736L;
constexpr long OFF_XC = 0;
constexpr long OFF_WB = OFF_XC + 16777216L;
constexpr long OFF_HBF = OFF_WB + 43024384L;
constexpr long OFF_MOD = OFF_HBF + 75497472L;
constexpr long OFF_TAPL = OFF_MOD + 1671168L;
constexpr long OFF_TAPC = OFF_TAPL + 8388608L;
constexpr long OFF_DL = OFF_TAPC + 1048576L;
constexpr long OFF_DLC = OFF_DL + 16777216L;
constexpr long OFF_DC = OFF_DLC + 262144L;
constexpr long OFF_PDAB = OFF_DC + 65536L;
constexpr long OFF_GC = OFF_PDAB + 2359296L;
constexpr long OFF_BETA = OFF_GC + 2359296L;
constexpr long OFF_Y = OFF_BETA + 2359296L;
constexpr long OFF_AR = OFF_Y + 4 * U38;
constexpr long OFF_ROPE = OFF_AR + 7 * U38;
constexpr long OFF_BAR = OFF_ROPE + 2 * 262144L;
constexpr long WS_TOTAL = OFF_BAR + 16384L;
constexpr long WO_IN = 0, WO_G = 5783552L, WO_B = 9977856L, WO_O = 12075008L, WO_1 = 13123584L, WO_2 = 17317888L;
constexpr int LDS_BYTES = 139264;
constexpr int NPHASE = 1 + 4 * 14;

struct Prm {
  const float *x, *c, *ctx, *c_ctx, *w_ada, *b_ada, *norm1, *norm2, *w_in, *qk_gain, *lam, *subln, *hy_conv, *hy_w1,
      *hy_b1, *hy_freq, *hy_w2, *hy_b2, *hy_w3, *hy_bias, *dn_conv, *dn_a_log, *dn_dt_bias, *dn_norm, *w_gate,
      *w_branch, *w_o, *w_mlp1, *w_mlp2;
  float* out;
  char* ws;
};

DI int mytid() {
  int t = threadIdx.x;
  asm volatile("" : "+v"(t));
  return t;
}
DI int mybid() {
  int t = blockIdx.x;
  asm volatile("" : "+s"(t));
  return t;
}
DI void lds_barrier() {
  asm volatile("s_waitcnt lgkmcnt(0)" ::: "memory");
  __builtin_amdgcn_s_barrier();
  asm volatile("" ::: "memory");
}
typedef __bf16 bf16x2_t __attribute__((ext_vector_type(2)));
typedef float f32x2_t __attribute__((ext_vector_type(2)));
DI unsigned pk_bf16(float a, float b) {
  f32x2_t v = {a, b};
  bf16x2_t h = __builtin_convertvector(v, bf16x2_t);
  return *(unsigned*)&h;
}
DI u16 f2bf(float f) {
  __bf16 h = (__bf16)f;
  return *(u16*)&h;
}
DI float bf2f(u16 h) { return __uint_as_float(((unsigned)h) << 16); }
DI float wsum(float v) {
  for (int o = 32; o; o >>= 1) v += __shfl_xor(v, o);
  return v;
}
DI float wmax(float v) {
  for (int o = 32; o; o >>= 1) v = fmaxf(v, __shfl_xor(v, o));
  return v;
}
DI float siluf(float v) { return v / (1.f + __expf(-v)); }
DI float sigmf(float v) { return 1.f / (1.f + __expf(-v)); }
DI float* xrow(const Prm& p, int tok) {
  return tok < T_LAT ? p.out + (long)tok * 1024 : (float*)(p.ws + OFF_XC) + (long)(tok - T_LAT) * 1024;
}
DI int first_item(long base) {
  int G = gridDim.x;
  return (int)(((long)mybid() + G - (base % G)) % G);
}
DI int tokof(int b, int P) { return P < 256 ? T_LAT + b * 256 + P : b * 2048 + (P - 256); }

typedef __attribute__((ext_vector_type(4))) unsigned u32x4;
struct Stg { u32x4 a0, a1, a2, a3, b0, b1; };
template <int NA>
DI void g_load(Stg& r, const u16* Ap, long lda, const u16* Bp, long ldb, int k0) {
  r.a0 = *(const u32x4*)(Ap + k0);
  r.a1 = *(const u32x4*)(Ap + 64 * lda + k0);
  if constexpr (NA == 4) {
    r.a2 = *(const u32x4*)(Ap + 128 * lda + k0);
    r.a3 = *(const u32x4*)(Ap + 192 * lda + k0);
  }
  r.b0 = *(const u32x4*)(Bp + k0);
  r.b1 = *(const u32x4*)(Bp + 64 * ldb + k0);
}
template <int NA, int TM>
DI void s_store(const Stg& r, u16* ns_) {
  *(u32x4*)(ns_) = r.a0;
  *(u32x4*)(ns_ + 64 * 80) = r.a1;
  if constexpr (NA == 4) {
    *(u32x4*)(ns_ + 128 * 80) = r.a2;
    *(u32x4*)(ns_ + 192 * 80) = r.a3;
  }
  *(u32x4*)(ns_ + TM * 80) = r.b0;
  *(u32x4*)(ns_ + TM * 80 + 64 * 80) = r.b1;
}
template <int MI>
DI void t_compute(f32x4 (&acc)[MI][4], const u16* as, const u16* bs, int wm, int wn, int fr, int fq) {
#pragma unroll
  for (int ks = 0; ks < 2; ++ks) {
    bf16x8 a[MI], b[4];
#pragma unroll
    for (int mi = 0; mi < MI; ++mi) a[mi] = *(const bf16x8*)(as + (wm * MI * 16 + mi * 16 + fr) * 80 + ks * 32 + fq * 8);
#pragma unroll
    for (int ni = 0; ni < 4; ++ni) b[ni] = *(const bf16x8*)(bs + (wn * 64 + ni * 16 + fr) * 80 + ks * 32 + fq * 8);
#pragma unroll
    for (int mi = 0; mi < MI; ++mi)
#pragma unroll
      for (int ni = 0; ni < 4; ++ni) acc[mi][ni] = MFMA(b[ni], a[mi], acc[mi][ni]);
  }
}
template <int MI>
DI void gemm_tile(f32x4 (&acc)[MI][4], const u16* __restrict__ A, long lda, const u16* __restrict__ B, long ldb, int K,
                  char* smem, Stg& r0, Stg& r1, bool pre, const u16* nA, long nlda, const u16* nB, long nldb) {
  constexpr int TM = MI * 64;
  constexpr int STAGE = (TM + 128) * 80;
  constexpr int NA = TM * 8 / 512;
  u16* s = (u16*)smem;
  const int tid = mytid(), lane = tid & 63, wid = tid >> 6;
  const int wm = wid >> 1, wn = wid & 1, fr = lane & 15, fq = lane >> 4;
  const long to_a = (long)(tid >> 3), to_c = (tid & 7) * 8;
  const u16* Ap = A + to_a * lda + to_c;
  const u16* Bp = B + to_a * ldb + to_c;
  const u16* nAp = nA + to_a * nlda + to_c;
  const u16* nBp = nB + to_a * nldb + to_c;
  const int so = (tid >> 3) * 80 + (tid & 7) * 8;
#define GLOAD(r, k0) g_load<NA>(r, Ap, lda, Bp, ldb, (k0))
#define NLOAD(r, k0) g_load<NA>(r, nAp, nlda, nBp, nldb, (k0))
#define SSTORE(r, st) s_store<NA, TM>(r, s + (st) * STAGE + so)
#define COMPUTE(st) t_compute<MI>(acc, s + (st) * STAGE, s + (st) * STAGE + TM * 80, wm, wn, fr, fq)
#pragma unroll
  for (int mi = 0; mi < MI; ++mi)
#pragma unroll
    for (int ni = 0; ni < 4; ++ni) acc[mi][ni] = f32x4{0.f, 0.f, 0.f, 0.f};
  const int nk = K >> 6;
  if (!pre) {
    GLOAD(r0, 0);
    GLOAD(r1, 64);
  }
  SSTORE(r0, 0);
  lds_barrier();
  for (int kt = 0; kt < nk; kt += 2) {
    if (kt + 2 < nk) GLOAD(r0, (kt + 2) << 6);
    else if (nA) NLOAD(r0, 0);
    COMPUTE(0);
    SSTORE(r1, 1);
    lds_barrier();
    if (kt + 3 < nk) GLOAD(r1, (kt + 3) << 6);
    else if (nA) NLOAD(r1, 64);
    COMPUTE(1);
    if (kt + 2 < nk) SSTORE(r0, 0);
    lds_barrier();
  }
#undef GLOAD
#undef NLOAD
#undef SSTORE
#undef COMPUTE
}

struct TD {
  const u16* A;
  const u16* B;
  u16* C;
  long lda, ldb, ldc;
  int K;
  int mode;
  int split;
  float scale;
  int tok0, col0;
  const float* g;
};

template <int MI = 4>
DI void run_tile2(const Prm& p, const TD& d, char* smem, Stg& r0, Stg& r1, bool pre, const u16* nA, long nlda,
                 const u16* nB, long nldb);
DI void run_tile(const Prm& p, const TD& d, char* smem) {
  Stg r0, r1;
  run_tile2<4>(p, d, smem, r0, r1, false, nullptr, 0, nullptr, 0);
}
template <int MI>
DI void run_tile2(const Prm& p, const TD& d, char* smem, Stg& r0, Stg& r1, bool pre, const u16* nA, long nlda,
                 const u16* nB, long nldb) {
  f32x4 acc[MI][4];
  gemm_tile<MI>(acc, d.A, d.lda, d.B, d.ldb, d.K, smem, r0, r1, pre, nA, nlda, nB, nldb);
  const int tid = mytid(), lane = tid & 63, wid = tid >> 6;
  const int wm = wid >> 1, wn = wid & 1, fr = lane & 15, fq = lane >> 4;
  if (d.mode == 4) {
    const int which = d.col0 >> 2, h = d.col0 & 3;
    const float* gain = d.g + which * 64 + fq * 4;
    const float* RC = (const float*)(p.ws + OFF_ROPE);
    const float* RS = RC + 65536;
    u16* dstb = d.C + (which ? 18874368L : 0L);
    const float qs = which ? 1.f : 0.18033688011112042f;
#pragma unroll
    for (int mi = 0; mi < MI; ++mi) {
      const int tok = d.tok0 + wm * (MI * 16) + mi * 16 + fr;
      float ss = 0.f;
#pragma unroll
      for (int ni = 0; ni < 4; ++ni)
#pragma unroll
        for (int j = 0; j < 4; ++j) ss += acc[mi][ni][j] * acc[mi][ni][j];
      ss += __shfl_xor(ss, 16);
      ss += __shfl_xor(ss, 32);
      const float inv = rsqrtf(ss * (1.f / 64.f) + 1e-6f) * qs;
      int b, P;
      const bool lat = tok < T_LAT;
      if (lat) { b = tok >> 11; P = 256 + (tok & 2047); }
      else { b = (tok - T_LAT) >> 8; P = (tok - T_LAT) & 255; }
      float y[4][4];
#pragma unroll
      for (int ni = 0; ni < 4; ++ni) {
        float4 g4 = *(const float4*)(gain + ni * 16);
        y[ni][0] = acc[mi][ni][0] * inv * g4.x; y[ni][1] = acc[mi][ni][1] * inv * g4.y;
        y[ni][2] = acc[mi][ni][2] * inv * g4.z; y[ni][3] = acc[mi][ni][3] * inv * g4.w;
      }
      u16* dst = dstb + ((long)((b * 4 + h) * 2 + wn) * 2304 + P) * 64 + fq * 4;
#pragma unroll
      for (int ni = 0; ni < 4; ++ni) {
        float o0 = y[ni][0], o1 = y[ni][1], o2 = y[ni][2], o3 = y[ni][3];
        if (lat) {
          const int l = tok & 2047, a = ni >> 1;
          float4 c4 = *(const float4*)(RC + (l * 2 + a) * 16 + fq * 4);
          float4 s4 = *(const float4*)(RS + (l * 2 + a) * 16 + fq * 4);
          const float sg = (ni & 1) ? 1.f : -1.f;
          o0 = y[ni][0] * c4.x + sg * y[ni ^ 1][0] * s4.x;
          o1 = y[ni][1] * c4.y + sg * y[ni ^ 1][1] * s4.y;
          o2 = y[ni][2] * c4.z + sg * y[ni ^ 1][2] * s4.z;
          o3 = y[ni][3] * c4.w + sg * y[ni ^ 1][3] * s4.w;
        }
        uint2 o;
        o.x = pk_bf16(o0, o1);
        o.y = pk_bf16(o2, o3);
        *(uint2*)(dst + ni * 16) = o;
      }
    }
    return;
  }
#pragma unroll
  for (int mi = 0; mi < MI; ++mi)
#pragma unroll
    for (int ni = 0; ni < 4; ++ni) {
      int r = wm * (MI * 16) + mi * 16 + fr, c = wn * 64 + ni * 16 + fq * 4;
      f32x4 v = acc[mi][ni];
      if (d.mode == 0) {
        long ro = d.split ? ((long)(r & 127) * d.ldc + (long)(r >> 7) * d.split) : (long)r * d.ldc;
        ushort4 o;
        o.x = f2bf(v[0] * d.scale); o.y = f2bf(v[1] * d.scale); o.z = f2bf(v[2] * d.scale); o.w = f2bf(v[3] * d.scale);
        *(ushort4*)(d.C + ro + c) = o;
      } else if (d.mode == 1) {
        ushort4 o;
        float t0 = fmaxf(v[0], 0.f), t1 = fmaxf(v[1], 0.f), t2 = fmaxf(v[2], 0.f), t3 = fmaxf(v[3], 0.f);
        o.x = f2bf(t0 * t0); o.y = f2bf(t1 * t1); o.z = f2bf(t2 * t2); o.w = f2bf(t3 * t3);
        *(ushort4*)(d.C + (long)r * d.ldc + c) = o;
      } else if (d.mode == 3) {
        if (wn == 0 && ni == 0) *(float4*)((float*)d.C + (long)r * 16 + fq * 4) = float4{v[0], v[1], v[2], v[3]};
      } else {
        float4* xp = (float4*)(xrow(p, d.tok0 + r) + d.col0 + c);
        float4 g4 = *(const float4*)(d.g + d.col0 + c);
        float4 x4 = *xp;
        x4.x += g4.x * v[0]; x4.y += g4.y * v[1]; x4.z += g4.z * v[2]; x4.w += g4.w * v[3];
        *xp = x4;
      }
    }
}

DI void ph_init(const Prm& p, char* smem) {
  const long gt = (long)mybid() * 512 + mytid(), gn = (long)gridDim.x * 512;
  {
    const float4* s = (const float4*)p.x;
    float4* d = (float4*)p.out;
    for (long i = gt; i < 32768L * 256; i += gn) d[i] = s[i];
    const float4* s2 = (const float4*)p.ctx;
    float4* d2 = (float4*)(p.ws + OFF_XC);
    for (long i = gt; i < 4096L * 256; i += gn) d2[i] = s2[i];
  }
  {
    u16* DL = (u16*)(p.ws + OFF_DL);
    for (long i = gt; i < 2048L * 4096; i += gn) {
      int l = (int)(i >> 12), kk = (int)(i & 4095), lp = kk & 2047, part = kk >> 11;
      int m = (l * lp) & 2047;
      float ang = (float)m * (6.283185307179586f / 2048.f);
      DL[i] = f2bf(part ? -sinf(ang) : cosf(ang));
    }
    u16* DLC = (u16*)(p.ws + OFF_DLC);
    for (long i = gt; i < 256L * 512; i += gn) {
      int l = (int)(i >> 9), kk = (int)(i & 511), lp = kk & 255, part = kk >> 8;
      int m = (l * lp) & 255;
      float ang = (float)m * (6.283185307179586f / 256.f);
      DLC[i] = f2bf(part ? -sinf(ang) : cosf(ang));
    }
    {
      float* RC = (float*)(p.ws + OFF_ROPE);
      float* RS = RC + 65536;
      for (long i = gt; i < 65536; i += gn) {
        int l = (int)(i >> 5), a = (int)(i >> 4) & 1, f = (int)(i & 15);
        float pos = a ? (float)(l & 63) : (float)(l >> 6);
        float ang = pos * powf(10000.f, -(float)f / 16.f);
        RC[i] = cosf(ang);
        RS[i] = sinf(ang);
      }
    }
    u16* DC = (u16*)(p.ws + OFF_DC);
    for (long i = gt; i < 256L * 128; i += gn) {
      int j2 = (int)(i >> 7), ii = (int)(i & 127), part = j2 >> 7, j = j2 & 127;
      int m = (ii * j) & 127;
      float ang = (float)m * (6.283185307179586f / 128.f);
      DC[i] = f2bf(part ? sinf(ang) : cosf(ang));
    }
  }
  float* sc = (float*)smem;
  float* red = sc + 17 * 1024;
  const int tid = mytid();
  for (int e = tid; e < 17 * 1024; e += 512) {
    int bb = e >> 10, k = e & 1023;
    float v = bb < 16 ? p.c[bb * 1024 + k] : p.c_ctx[k];
    sc[e] = v / (1.f + expf(-v));
  }
  __syncthreads();
  float* MOD = (float*)(p.ws + OFF_MOD);
  for (int it = mybid(); it < 192; it += gridDim.x) {
    int li = it / 48, cgp = it % 48;
    int cl = tid & 127, kq = tid >> 7, n = cgp * 128 + cl;
    float a[17];
#pragma unroll
    for (int b = 0; b < 17; ++b) a[b] = 0.f;
    const float* w = p.w_ada + ((long)li * 1024 + kq * 256) * 6144 + n;
#pragma unroll 2
    for (int k = 0; k < 256; ++k) {
      float wv = w[(long)k * 6144];
#pragma unroll
      for (int b = 0; b < 17; ++b) a[b] += sc[b * 1024 + kq * 256 + k] * wv;
    }
#pragma unroll
    for (int b = 0; b < 17; ++b) red[(kq * 17 + b) * 128 + cl] = a[b];
    __syncthreads();
    for (int e = tid; e < 17 * 128; e += 512) {
      int b = e >> 7, c2 = e & 127, n2 = cgp * 128 + c2;
      float v = p.b_ada[li * 6144 + n2];
      for (int q = 0; q < 4; ++q) v += red[(q * 17 + b) * 128 + c2];
      MOD[((long)li * 17 + b) * 6144 + n2] = v;
    }
    __syncthreads();
  }
}

DI long tr_job(long base, const float* src, int K, int N, u16* dst, int nb, char* smem) {
  float* t = (float*)smem;
  const int tk = K >> 6, tn = (N + 63) >> 6, per = tk * tn, total = per * nb;
  const int tid = mytid();
  const int G = gridDim.x;
  float v[8];
  int it = first_item(base);
  if (it < total) {
    int b = it / per, r = it % per, kt = r / tn, nt = r % tn;
    const float* s = src + (long)b * K * N;
#pragma unroll
    for (int i = 0; i < 8; ++i) {
      int id = tid + i * 512, kk = id >> 6, nn = id & 63;
      v[i] = (nt * 64 + nn < N) ? s[(long)(kt * 64 + kk) * N + nt * 64 + nn] : 0.f;
    }
  }
  for (; it < total; it += G) {
    int b = it / per, r = it % per, kt = r / tn, nt = r % tn;
    u16* d = dst + (long)b * K * N;
    int k0 = kt * 64, n0 = nt * 64;
#pragma unroll
    for (int i = 0; i < 8; ++i) {
      int id = tid + i * 512, kk = id >> 6, nn = id & 63;
      t[kk * 65 + nn] = v[i];
    }
    __syncthreads();
    if (it + G < total) {
      int it2 = it + G, b2 = it2 / per, r2 = it2 % per, kt2 = r2 / tn, nt2 = r2 % tn;
      const float* s2 = src + (long)b2 * K * N;
#pragma unroll
      for (int i = 0; i < 8; ++i) {
        int id = tid + i * 512, kk = id >> 6, nn = id & 63;
        v[i] = (nt2 * 64 + nn < N) ? s2[(long)(kt2 * 64 + kk) * N + nt2 * 64 + nn] : 0.f;
      }
    }
#pragma unroll
    for (int i = 0; i < 8; ++i) {
      int id = tid + i * 512, nn = id >> 6, kk = id & 63;
      if (n0 + nn < N) d[(long)(n0 + nn) * K + k0 + kk] = f2bf(t[kk * 65 + nn]);
    }
    __syncthreads();
  }
  return base + total;
}

DI void ph_norm(const Prm& p, int li, int which) {
  const int lane = mytid() & 63;
  const int gw = mybid() * 8 + (mytid() >> 6), nw = gridDim.x * 8;
  const float* nwt = (which ? p.norm2 : p.norm1) + li * 1024;
  const float* MOD = (const float*)(p.ws + OFF_MOD);
  u16* H = (u16*)(p.ws + OFF_HBF);
  const int nrows = (which && li == 3) ? T_LAT : T_ALL;
  for (int row = gw; row < nrows; row += 2 * nw) {
    const int row2 = row + nw;
    const bool has2 = row2 < nrows;
    const float* xr = xrow(p, row);
    const float* xr2 = xrow(p, has2 ? row2 : row);
    float4 v[4], u[4];
    float ss = 0.f, ss2 = 0.f;
#pragma unroll
    for (int i = 0; i < 4; ++i) {
      v[i] = *(const float4*)(xr + i * 256 + lane * 4);
      u[i] = *(const float4*)(xr2 + i * 256 + lane * 4);
    }
#pragma unroll
    for (int i = 0; i < 4; ++i) {
      ss += v[i].x * v[i].x + v[i].y * v[i].y + v[i].z * v[i].z + v[i].w * v[i].w;
      ss2 += u[i].x * u[i].x + u[i].y * u[i].y + u[i].z * u[i].z + u[i].w * u[i].w;
    }
#pragma unroll
    for (int o = 32; o; o >>= 1) {
      ss += __shfl_xor(ss, o);
      ss2 += __shfl_xor(ss2, o);
    }
    const float inv = rsqrtf(ss * (1.f / 1024.f) + 1e-6f), inv2 = rsqrtf(ss2 * (1.f / 1024.f) + 1e-6f);
    const int bb = row < T_LAT ? (row >> 11) : 16, bb2 = row2 < T_LAT ? (row2 >> 11) : 16;
    const float* sh = MOD + ((long)li * 17 + bb) * 6144 + (which ? 3 : 0) * 1024;
    const float* sh2 = MOD + ((long)li * 17 + (has2 ? bb2 : bb)) * 6144 + (which ? 3 : 0) * 1024;
#pragma unroll
    for (int i = 0; i < 4; ++i) {
      int c = i * 256 + lane * 4;
      float4 w4 = *(const float4*)(nwt + c);
      {
        float4 s4 = *(const float4*)(sh + 1024 + c), h4 = *(const float4*)(sh + c);
        uint2 o;
        o.x = pk_bf16(v[i].x * inv * w4.x * (1.f + s4.x) + h4.x, v[i].y * inv * w4.y * (1.f + s4.y) + h4.y);
        o.y = pk_bf16(v[i].z * inv * w4.z * (1.f + s4.z) + h4.z, v[i].w * inv * w4.w * (1.f + s4.w) + h4.w);
        *(uint2*)(H + (long)row * 1024 + c) = o;
      }
      if (has2) {
        float4 s4 = *(const float4*)(sh2 + 1024 + c), h4 = *(const float4*)(sh2 + c);
        uint2 o;
        o.x = pk_bf16(u[i].x * inv2 * w4.x * (1.f + s4.x) + h4.x, u[i].y * inv2 * w4.y * (1.f + s4.y) + h4.y);
        o.y = pk_bf16(u[i].z * inv2 * w4.z * (1.f + s4.z) + h4.z, u[i].w * inv2 * w4.w * (1.f + s4.w) + h4.w);
        *(uint2*)(H + (long)row2 * 1024 + c) = o;
      }
    }
  }
}

DI void ph_taps1(const Prm& p, int li, long base, char* smem) {
  float* f = (float*)smem;
  float* hraw = (float*)(p.ws + OFF_AR + 5 * U38);
  const int tid = mytid();
  for (int it = first_item(base); it < 288; it += gridDim.x) {
    const int L = it < 256 ? 2048 : 256, j0 = it < 256 ? it * 8 : (it - 256) * 8;
    const int lg = tid >> 6, kk = tid & 63;
    if (tid < 8 * 33) {
      int l2 = tid / 33, e = tid % 33, j = j0 + l2;
      float t = (float)j / (float)(L - 1);
      float w = 6.283185307179586f * (float)j / (float)L;
      float v;
      if (e == 0) v = t;
      else {
        int bi = (e - 1) & 15;
        float band = 1e-4f + (float)bi * ((15.f - 1e-4f) / 15.f);
        v = (e <= 16) ? cosf(band * w) : -sinf(band * w);
      }
      f[l2 * 40 + e] = v;
    }
    __syncthreads();
    {
      float v = p.hy_b1[li * 64 + kk];
#pragma unroll 3
      for (int e = 0; e < 33; ++e) v += f[lg * 40 + e] * p.hy_w1[(li * 33 + e) * 64 + kk];
      f[320 + lg * 64 + kk] = sinf(p.hy_freq[(li * 2 + 0) * 64 + kk] * v);
    }
    __syncthreads();
    {
      float v = p.hy_b2[li * 64 + kk];
#pragma unroll 4
      for (int m = 0; m < 64; ++m) v += f[320 + lg * 64 + m] * p.hy_w2[(li * 64 + m) * 64 + kk];
      f[832 + lg * 64 + kk] = sinf(p.hy_freq[(li * 2 + 1) * 64 + kk] * v);
    }
    __syncthreads();
    {
      float h[4][8];
#pragma unroll
      for (int i = 0; i < 4; ++i)
#pragma unroll
        for (int l2 = 0; l2 < 8; ++l2) h[i][l2] = 0.f;
      const float* w3 = p.hy_w3 + (long)li * 64 * 2048 + tid;
#pragma unroll 2
      for (int k = 0; k < 64; ++k) {
        float wv[4];
#pragma unroll
        for (int i = 0; i < 4; ++i) wv[i] = w3[(long)k * 2048 + i * 512];
#pragma unroll
        for (int l2 = 0; l2 < 8; ++l2) {
          float hv = f[832 + l2 * 64 + k];
#pragma unroll
          for (int i = 0; i < 4; ++i) h[i][l2] += hv * wv[i];
        }
      }
#pragma unroll
      for (int i = 0; i < 4; ++i) {
        int n = tid + i * 512, ch = n & 511;
        float delta = fabsf(-3.0701134573253946f + (float)ch * ((-15.350567286626973f + 3.0701134573253946f) / 511.f));
#pragma unroll
        for (int l2 = 0; l2 < 8; ++l2) {
          int j = j0 + l2;
          float t = (float)j / (float)(L - 1);
          long row = (it < 256) ? j : 2048 + j;
          hraw[row * 2048 + n] = h[i][l2] * expf(-t * delta);
        }
      }
    }
    __syncthreads();
  }
}
DI void ph_taps2(const Prm& p, long base, char* smem) {
  float* vals = (float*)smem;
  float* red = vals + 8 * 2048;
  const float* hraw = (const float*)(p.ws + OFF_AR + 5 * U38);
  const int tid = mytid(), cl = tid & 3, dir = (tid >> 2) & 1, jg = tid >> 3;
  for (int it = first_item(base); it < 512; it += gridDim.x) {
    int ls = it >> 8, order = (it >> 7) & 1, cgp = it & 127;
    int L = ls ? 256 : 2048;
    const float* hr = hraw + (long)(ls ? 2048 : 0) * 2048;
    u16* G = (u16*)(p.ws + (ls ? OFF_TAPC : OFF_TAPL));
    int ch = cgp * 4 + cl, n = order * 1024 + dir * 512 + ch;
    float s = 0.f;
#pragma unroll 8
    for (int j = jg; j < L; j += 64) {
      float v = hr[(long)j * 2048 + n];
      vals[(cl * 2 + dir) * L + j] = v;
      s += (dir == 1 && j == 0) ? 0.f : fabsf(v);
    }
    red[(tid >> 2) * 4 + cl] = s;
    __syncthreads();
    if (tid < 4) {
      float tot = 0.f;
#pragma unroll 8
      for (int r = 0; r < 128; ++r) tot += red[r * 4 + tid];
      red[512 + tid] = 1.f / tot;
    }
    __syncthreads();
    for (int idx = tid; idx < 8 * L; idx += 512) {
      int q = idx / L, j = idx % L, c2 = q >> 1, d2 = q & 1;
      float v = vals[idx] * red[512 + c2];
      u16* g = G + (long)(order * 512 + cgp * 4 + c2) * (2 * L);
      if (d2 == 0) g[L + j] = f2bf(v);
      else if (j > 0) g[L - j] = f2bf(v);
      else g[0] = 0;
    }
    __syncthreads();
  }
}

DI void ph_pdab(const Prm& p, int li, char* smem) {
  float* wl = (float*)smem;
  const int tid = mytid(), lane = tid & 63;
#pragma unroll 8
  for (int e = tid; e < 1024 * 16; e += 512) wl[e] = p.w_in[((long)li * 1024 + (e >> 4)) * NIN + 5632 + (e & 15)];
  __syncthreads();
  const u16* H = (const u16*)(p.ws + OFF_HBF);
  float* out = (float*)(p.ws + OFF_PDAB);
  const int gw = mybid() * 8 + (tid >> 6), nw = gridDim.x * 8;
  for (int tok = gw; tok < T_ALL; tok += nw) {
    float a[16];
#pragma unroll
    for (int j = 0; j < 16; ++j) a[j] = 0.f;
    float hv[16];
#pragma unroll
    for (int i = 0; i < 16; ++i) hv[i] = bf2f(H[(long)tok * 1024 + lane + i * 64]);
#pragma unroll
    for (int i = 0; i < 16; ++i) {
      float h = hv[i];
      const float4* wp = (const float4*)(wl + (lane + i * 64) * 16);
#pragma unroll
      for (int q = 0; q < 4; ++q) {
        float4 w4 = wp[q];
        a[q * 4 + 0] += h * w4.x;
        a[q * 4 + 1] += h * w4.y;
        a[q * 4 + 2] += h * w4.z;
        a[q * 4 + 3] += h * w4.w;
      }
      if ((i & 3) == 3) asm volatile("" ::: "memory");
    }
#pragma unroll
    for (int o = 32; o; o >>= 1)
#pragma unroll
      for (int j = 0; j < 16; ++j) a[j] += __shfl_xor(a[j], o);
    float v = a[0];
#pragma unroll
    for (int j = 1; j < 16; ++j) v = (lane == j) ? a[j] : v;
    if (lane < 16) out[(long)tok * 16 + lane] = v;
  }
  __syncthreads();
}

DI void ph_dncl(const Prm& p, int li, char* smem) {
  const int tid = mytid(), lane = tid & 63, wid = tid >> 6, fr = lane & 15, fq = lane >> 4;
  u16* qn = (u16*)smem;
  u16* kn = qn + 64 * 144;
  float* fb = (float*)(smem + 36864);
  float* KK = fb;
  float* QK = KK + 64 * 65;
  float* Am = QK + 64 * 65;
  float* Tm = Am + 2 * 64 * 65;
  float* gcs = Tm + 2 * 64 * 65;
  float* bts = gcs + 128;
  const u16* PD = (const u16*)(p.ws + OFF_AR);
  const float* AB = (const float*)(p.ws + OFF_PDAB);
  u16* DQ = (u16*)(p.ws + OFF_Y);
  u16* DK = DQ + 18874368L;
  u16* DV = DK + 18874368L;
  u16* CL = (u16*)(p.ws + OFF_AR + 3 * U38);
  float* GC = (float*)(p.ws + OFF_GC);
  float* BT = (float*)(p.ws + OFF_BETA);
  const float* cw = p.dn_conv + (long)li * 3 * 1536;
  for (int it = mybid(); it < 2304; it += gridDim.x) {
    const int b = it / 144, r0 = it % 144, oc = r0 >> 2, h = r0 & 3;
    const int pos0 = oc * 64, s0 = oc < 4 ? 0 : 256, e0 = oc < 4 ? 256 : 2304;
    if (tid < 384) {
      const int cgp = tid % 48, rs = tid / 48;
      const int part = cgp >> 4, d0 = (cgp & 15) * 8, col = part * 512 + h * 128 + d0;
      const u16* basep = PD + (long)tokof(b, pos0) * 1536 + col;
      float wt[3][8];
#pragma unroll
      for (int tp = 0; tp < 3; ++tp) {
        float4 wa = *(const float4*)(cw + tp * 1536 + col), wb = *(const float4*)(cw + tp * 1536 + col + 4);
        wt[tp][0] = wa.x; wt[tp][1] = wa.y; wt[tp][2] = wa.z; wt[tp][3] = wa.w;
        wt[tp][4] = wb.x; wt[tp][5] = wb.y; wt[tp][6] = wb.z; wt[tp][7] = wb.w;
      }
#pragma unroll 1
      for (int hf = 0; hf < 2; ++hf) {
        u32x4 rw[6];
#pragma unroll
        for (int i = 0; i < 6; ++i) {
          int j = rs * 8 + hf * 4 - 1 + i, P = pos0 + j;
          rw[i] = (P >= s0 && P < e0) ? *(const u32x4*)(basep + (long)j * 1536) : u32x4{0u, 0u, 0u, 0u};
        }
#pragma unroll
        for (int r = 0; r < 4; ++r) {
#pragma unroll
          for (int e = 0; e < 8; ++e) {
            unsigned w0_ = rw[r][e >> 1], w1_ = rw[r + 1][e >> 1], w2_ = rw[r + 2][e >> 1];
            float x0 = (e & 1) ? __uint_as_float(w0_ & 0xffff0000u) : __uint_as_float(w0_ << 16);
            float x1 = (e & 1) ? __uint_as_float(w1_ & 0xffff0000u) : __uint_as_float(w1_ << 16);
            float x2 = (e & 1) ? __uint_as_float(w2_ & 0xffff0000u) : __uint_as_float(w2_ << 16);
            float v = wt[0][e] * x0 + wt[1][e] * x1 + wt[2][e] * x2;
            fb[(rs * 8 + hf * 4 + r) * 385 + part * 128 + d0 + e] = v / (1.f + __expf(-v));
          }
        }
      }
    }
    __syncthreads();
    for (int jj = 0; jj < 8; ++jj) {
      int j = wid * 8 + jj, P = pos0 + j;
      long go = ((long)(b * 4 + h) * 2304 + P) * 128;
      float q0 = fb[j * 385 + lane], q1 = fb[j * 385 + 64 + lane];
      float k0 = fb[j * 385 + 128 + lane], k1 = fb[j * 385 + 192 + lane];
      float v0 = fb[j * 385 + 256 + lane], v1 = fb[j * 385 + 320 + lane];
      float iq = rsqrtf(wsum(q0 * q0 + q1 * q1) + 1e-6f), ik = rsqrtf(wsum(k0 * k0 + k1 * k1) + 1e-6f);
      u16 a0 = f2bf(q0 * iq), a1 = f2bf(q1 * iq), c0 = f2bf(k0 * ik), c1 = f2bf(k1 * ik);
      qn[j * 144 + lane] = a0; qn[j * 144 + 64 + lane] = a1;
      kn[j * 144 + lane] = c0; kn[j * 144 + 64 + lane] = c1;
      DQ[go + lane] = a0; DQ[go + 64 + lane] = a1;
      DK[go + lane] = c0; DK[go + 64 + lane] = c1;
      DV[go + lane] = f2bf(v0); DV[go + 64 + lane] = f2bf(v1);
    }
    __syncthreads();
#pragma unroll
    for (int u = 0; u < 4; ++u) {
      int tt = wid * 4 + u, which = tt >> 4, ti = (tt >> 2) & 3, tj = tt & 3;
      const u16* Ap = (which ? qn : kn) + (ti * 16 + fr) * 144 + fq * 8;
      const u16* Bp = kn + (tj * 16 + fr) * 144 + fq * 8;
      f32x4 a = {0.f, 0.f, 0.f, 0.f};
#pragma unroll
      for (int ks = 0; ks < 4; ++ks) a = MFMA(*(const bf16x8*)(Ap + ks * 32), *(const bf16x8*)(Bp + ks * 32), a);
      float* dst = which ? QK : KK;
#pragma unroll
      for (int j = 0; j < 4; ++j) dst[(ti * 16 + fq * 4 + j) * 65 + tj * 16 + fr] = a[j];
    }
    if (tid < 128) {
      int d = tid >> 6, r = tid & 63, j = d ? 63 - r : r;
      int tok = tokof(b, pos0 + j);
      float av = AB[(long)tok * 16 + d * 4 + h], bv = AB[(long)tok * 16 + 8 + d * 4 + h];
      float xx = av + p.dn_dt_bias[li * 8 + d * 4 + h];
      float sp = fmaxf(xx, 0.f) + __logf(1.f + __expf(-fabsf(xx)));
      float g = -expf(p.dn_a_log[li * 8 + d * 4 + h]) * sp;
      for (int o = 1; o < 64; o <<= 1) {
        float t = __shfl_up(g, o);
        if (r >= o) g += t;
      }
      float be = 1.f / (1.f + expf(-bv));
      gcs[d * 64 + r] = g;
      bts[d * 64 + r] = be;
      long ci = ((long)((b * 4 + h) * 2 + d) * 36 + oc) * 64 + r;
      GC[ci] = g;
      BT[ci] = be;
    }
    __syncthreads();
#pragma unroll 4
    for (int e = tid; e < 8192; e += 512) {
      int d = e >> 12, s = (e >> 6) & 63, r = e & 63;
      int j = d ? 63 - r : r, js = d ? 63 - s : s;
      float v = 0.f;
      if (r > s) v = bts[d * 64 + r] * KK[j * 65 + js] * expf(gcs[d * 64 + r] - gcs[d * 64 + s]);
      Am[(d * 64 + s) * 64 + r] = v;
    }
#pragma unroll 4
    for (int e = tid; e < 8192; e += 512) {
      int d = e >> 12, r = (e >> 6) & 63, s = e & 63;
      int j = d ? 63 - r : r, js = d ? 63 - s : s;
      float dec = (r >= s) ? expf(gcs[d * 64 + r] - gcs[d * 64 + s]) : 0.f;
      long ci = (long)((b * 4 + h) * 2 + d) * 36 + oc;
      CL[ci * 8192 + 4096 + r * 64 + s] = f2bf(QK[j * 65 + js] * dec * 0.08838834764831845f);
    }
    __syncthreads();
    {
      const int d = tid >> 8, c = (tid >> 2) & 63, q = tid & 3;
      const float* Atq = Am + d * 64 * 64 + q;
      float* T = Tm + d * 64 * 65;
      float t[16];
#pragma unroll
      for (int i = 0; i < 16; ++i) t[i] = (4 * i + q == c) ? 1.f : 0.f;
#pragma unroll
      for (int s2 = 0; s2 < 63; ++s2) {
        constexpr int dummy = 0;
        const int is = s2 >> 2, qs = s2 & 3;
        const int ctl = qs | (qs << 2) | (qs << 4) | (qs << 6);
        int tsb;
        if (qs == 0) tsb = __builtin_amdgcn_update_dpp(0, __float_as_int(t[is]), 0x00, 0xf, 0xf, false);
        else if (qs == 1) tsb = __builtin_amdgcn_update_dpp(0, __float_as_int(t[is]), 0x55, 0xf, 0xf, false);
        else if (qs == 2) tsb = __builtin_amdgcn_update_dpp(0, __float_as_int(t[is]), 0xAA, 0xf, 0xf, false);
        else tsb = __builtin_amdgcn_update_dpp(0, __float_as_int(t[is]), 0xFF, 0xf, 0xf, false);
        (void)ctl; (void)dummy;
        const float ts = __int_as_float(tsb);
#pragma unroll
        for (int i = is; i < 16; ++i) t[i] -= Atq[s2 * 64 + 4 * i] * ts;
        if ((s2 & 7) == 7) asm volatile("" ::: "memory");
      }
#pragma unroll
      for (int i = 0; i < 16; ++i) T[(4 * i + q) * 65 + c] = t[i];
    }
    __syncthreads();
    for (int e = tid; e < 8192; e += 512) {
      int d = e >> 12, rc = e & 4095;
      long ci = (long)((b * 4 + h) * 2 + d) * 36 + oc;
      CL[ci * 8192 + rc] = f2bf(Tm[(d * 64 + (rc >> 6)) * 65 + (rc & 63)]);
    }
    __syncthreads();
  }
}

DI void ph_dnscan(const Prm& p, char* smem) {
  const int tid = mytid(), lane = tid & 63, wid = tid >> 6, fr = lane & 15, fq = lane >> 4;
  u16* Kg = (u16*)smem;
  u16* Qg = Kg + 64 * 144;
  u16* KdT = Qg + 64 * 144;
  u16* Tl = KdT + 128 * 80;
  u16* Il = Tl + 64 * 80;
  u16* ST = Il + 64 * 80;
  u16* RT = ST + 64 * 144;
  u16* VN = RT + 64 * 80;
  const u16* DQ = (const u16*)(p.ws + OFF_Y);
  const u16* DK = DQ + 18874368L;
  const u16* DV = DK + 18874368L;
  const u16* CL = (const u16*)(p.ws + OFF_AR + 3 * U38);
  const float* GC = (const float*)(p.ws + OFF_GC);
  const float* BT = (const float*)(p.ws + OFF_BETA);
  const int vt = wid & 3, rp = wid >> 2;
  for (int it = mybid(); it < 256; it += gridDim.x) {
    const int b = it >> 4, h = (it >> 2) & 3, d = (it >> 1) & 1, vs = it & 1;
    u16* O = (u16*)(p.ws + OFF_AR + (d ? 6 : 5) * U38);
    f32x4 S[4];
#pragma unroll
    for (int i = 0; i < 4; ++i) S[i] = f32x4{0.f, 0.f, 0.f, 0.f};
    for (int e = tid; e < 64 * 144; e += 512) ST[e] = 0;
    const long seqb = (long)(b * 4 + h) * 2304;
    const long cib = (long)((b * 4 + h) * 2 + d) * 36;
    u32x4 rk0, rk1, rq0, rq1, rT, rI;
    float rg0, rg1, rgl;
    uint2 rv0, rv1;
    float rb0, rb1;
    const int lr0 = tid >> 4, lr1 = (tid + 512) >> 4, lch = tid & 15;
    const int lj0 = d ? 63 - lr0 : lr0, lj1 = d ? 63 - lr1 : lr1;
    const int vr0 = (rp * 2) * 16 + fr, vr1 = (rp * 2 + 1) * 16 + fr;
    const int vj0 = d ? 63 - vr0 : vr0, vj1 = d ? 63 - vr1 : vr1;
#define SCAN_LOAD_KQ(ocx)                                                                    \
  {                                                                                          \
    const long ci_ = cib + (ocx);                                                            \
    const long g0_ = (seqb + (ocx) * 64 + lj0) * 128 + lch * 8, g1_ = (seqb + (ocx) * 64 + lj1) * 128 + lch * 8; \
    rk0 = *(const u32x4*)(DK + g0_); rk1 = *(const u32x4*)(DK + g1_);                        \
    rq0 = *(const u32x4*)(DQ + g0_); rq1 = *(const u32x4*)(DQ + g1_);                        \
    rT = *(const u32x4*)(CL + ci_ * 8192 + (tid >> 3) * 64 + (tid & 7) * 8);                 \
    rI = *(const u32x4*)(CL + ci_ * 8192 + 4096 + (tid >> 3) * 64 + (tid & 7) * 8);          \
    rg0 = GC[ci_ * 64 + lr0]; rg1 = GC[ci_ * 64 + lr1]; rgl = GC[ci_ * 64 + 63];             \
  }
#define SCAN_LOAD_V(ocx)                                                                     \
  {                                                                                          \
    const long ci_ = cib + (ocx);                                                            \
    rv0 = *(const uint2*)(DV + (seqb + (ocx) * 64 + vj0) * 128 + vs * 64 + vt * 16 + fq * 4); \
    rv1 = *(const uint2*)(DV + (seqb + (ocx) * 64 + vj1) * 128 + vs * 64 + vt * 16 + fq * 4); \
    rb0 = BT[ci_ * 64 + vr0]; rb1 = BT[ci_ * 64 + vr1];                                      \
  }
    {
      const int oc0 = d ? 3 : 0;
      SCAN_LOAD_KQ(oc0);
      SCAN_LOAD_V(oc0);
    }
    for (int i = 0; i < 36; ++i) {
      const int oc = d ? (i < 4 ? 3 - i : 39 - i) : i;
      const int ocn = d ? (i + 1 < 4 ? 3 - (i + 1) : 39 - (i + 1)) : i + 1;
      const int pos0 = oc * 64;
      const float gl = rgl;
      {
        float eg0 = __expf(rg0), ed0 = __expf(gl - rg0), eg1 = __expf(rg1), ed1 = __expf(gl - rg1);
        u32x4 ko0, qo0, ko1, qo1;
#pragma unroll
        for (int w = 0; w < 4; ++w) {
          float k0l = __uint_as_float(rk0[w] << 16), k0h = __uint_as_float(rk0[w] & 0xffff0000u);
          float q0l = __uint_as_float(rq0[w] << 16), q0h = __uint_as_float(rq0[w] & 0xffff0000u);
          float k1l = __uint_as_float(rk1[w] << 16), k1h = __uint_as_float(rk1[w] & 0xffff0000u);
          float q1l = __uint_as_float(rq1[w] << 16), q1h = __uint_as_float(rq1[w] & 0xffff0000u);
          ko0[w] = (unsigned)f2bf(k0l * eg0) | ((unsigned)f2bf(k0h * eg0) << 16);
          qo0[w] = (unsigned)f2bf(q0l * eg0 * 0.08838834764831845f) | ((unsigned)f2bf(q0h * eg0 * 0.08838834764831845f) << 16);
          ko1[w] = (unsigned)f2bf(k1l * eg1) | ((unsigned)f2bf(k1h * eg1) << 16);
          qo1[w] = (unsigned)f2bf(q1l * eg1 * 0.08838834764831845f) | ((unsigned)f2bf(q1h * eg1 * 0.08838834764831845f) << 16);
          KdT[(lch * 8 + 2 * w) * 80 + lr0] = f2bf(k0l * ed0);
          KdT[(lch * 8 + 2 * w + 1) * 80 + lr0] = f2bf(k0h * ed0);
          KdT[(lch * 8 + 2 * w) * 80 + lr1] = f2bf(k1l * ed1);
          KdT[(lch * 8 + 2 * w + 1) * 80 + lr1] = f2bf(k1h * ed1);
        }
        *(u32x4*)(Kg + lr0 * 144 + lch * 8) = ko0;
        *(u32x4*)(Qg + lr0 * 144 + lch * 8) = qo0;
        *(u32x4*)(Kg + lr1 * 144 + lch * 8) = ko1;
        *(u32x4*)(Qg + lr1 * 144 + lch * 8) = qo1;
        *(u32x4*)(Tl + (tid >> 3) * 80 + (tid & 7) * 8) = rT;
        *(u32x4*)(Il + (tid >> 3) * 80 + (tid & 7) * 8) = rI;
      }
      lds_barrier();
      if (i + 1 < 36) SCAN_LOAD_KQ(ocn);
      f32x4 ks_[2], qs_[2];
#pragma unroll
      for (int u = 0; u < 2; ++u) { ks_[u] = f32x4{0.f, 0.f, 0.f, 0.f}; qs_[u] = f32x4{0.f, 0.f, 0.f, 0.f}; }
#pragma unroll
      for (int kk = 0; kk < 4; ++kk) {
        bf16x8 a = *(const bf16x8*)(ST + (vt * 16 + fr) * 144 + kk * 32 + fq * 8);
#pragma unroll
        for (int u = 0; u < 2; ++u) {
          int rt = rp * 2 + u;
          bf16x8 bk = *(const bf16x8*)(Kg + (rt * 16 + fr) * 144 + kk * 32 + fq * 8);
          bf16x8 bq = *(const bf16x8*)(Qg + (rt * 16 + fr) * 144 + kk * 32 + fq * 8);
          ks_[u] = MFMA(a, bk, ks_[u]);
          qs_[u] = MFMA(a, bq, qs_[u]);
        }
      }
      {
        int v0 = vt * 16 + fq * 4;
        RT[(v0 + 0) * 80 + vr0] = f2bf(rb0 * (__uint_as_float(rv0.x << 16) - ks_[0][0]));
        RT[(v0 + 1) * 80 + vr0] = f2bf(rb0 * (__uint_as_float(rv0.x & 0xffff0000u) - ks_[0][1]));
        RT[(v0 + 2) * 80 + vr0] = f2bf(rb0 * (__uint_as_float(rv0.y << 16) - ks_[0][2]));
        RT[(v0 + 3) * 80 + vr0] = f2bf(rb0 * (__uint_as_float(rv0.y & 0xffff0000u) - ks_[0][3]));
        RT[(v0 + 0) * 80 + vr1] = f2bf(rb1 * (__uint_as_float(rv1.x << 16) - ks_[1][0]));
        RT[(v0 + 1) * 80 + vr1] = f2bf(rb1 * (__uint_as_float(rv1.x & 0xffff0000u) - ks_[1][1]));
        RT[(v0 + 2) * 80 + vr1] = f2bf(rb1 * (__uint_as_float(rv1.y << 16) - ks_[1][2]));
        RT[(v0 + 3) * 80 + vr1] = f2bf(rb1 * (__uint_as_float(rv1.y & 0xffff0000u) - ks_[1][3]));
      }
      if (i + 1 < 36) SCAN_LOAD_V(ocn);
      lds_barrier();
      {
        f32x4 vn[2];
#pragma unroll
        for (int u = 0; u < 2; ++u) vn[u] = f32x4{0.f, 0.f, 0.f, 0.f};
#pragma unroll
        for (int kk = 0; kk < 2; ++kk) {
          bf16x8 a = *(const bf16x8*)(RT + (vt * 16 + fr) * 80 + kk * 32 + fq * 8);
#pragma unroll
          for (int u = 0; u < 2; ++u) {
            bf16x8 bb = *(const bf16x8*)(Tl + ((rp * 2 + u) * 16 + fr) * 80 + kk * 32 + fq * 8);
            vn[u] = MFMA(a, bb, vn[u]);
          }
        }
#pragma unroll
        for (int u = 0; u < 2; ++u) {
          int r = (rp * 2 + u) * 16 + fr, v0 = vt * 16 + fq * 4;
#pragma unroll
          for (int j = 0; j < 4; ++j) VN[(v0 + j) * 80 + r] = f2bf(vn[u][j]);
        }
      }
      lds_barrier();
#pragma unroll
      for (int kk = 0; kk < 2; ++kk) {
        bf16x8 a = *(const bf16x8*)(VN + (vt * 16 + fr) * 80 + kk * 32 + fq * 8);
#pragma unroll
        for (int u = 0; u < 2; ++u) {
          bf16x8 bb = *(const bf16x8*)(Il + ((rp * 2 + u) * 16 + fr) * 80 + kk * 32 + fq * 8);
          qs_[u] = MFMA(a, bb, qs_[u]);
        }
      }
#pragma unroll
      for (int u = 0; u < 2; ++u) {
        int r = (rp * 2 + u) * 16 + fr, j = d ? 63 - r : r;
        u16* op = O + (long)tokof(b, pos0 + j) * 512 + h * 128 + vs * 64 + vt * 16 + fq * 4;
        ushort4 ov4;
        ov4.x = f2bf(qs_[u][0]); ov4.y = f2bf(qs_[u][1]); ov4.z = f2bf(qs_[u][2]); ov4.w = f2bf(qs_[u][3]);
        *(ushort4*)op = ov4;
      }
      {
        float ge = __expf(gl);
#pragma unroll
        for (int u = 0; u < 4; ++u) S[u] *= ge;
#pragma unroll
        for (int kk = 0; kk < 2; ++kk) {
          bf16x8 a = *(const bf16x8*)(VN + (vt * 16 + fr) * 80 + kk * 32 + fq * 8);
#pragma unroll
          for (int u = 0; u < 4; ++u) {
            bf16x8 bb = *(const bf16x8*)(KdT + ((rp * 4 + u) * 16 + fr) * 80 + kk * 32 + fq * 8);
            S[u] = MFMA(a, bb, S[u]);
          }
        }
#pragma unroll
        for (int u = 0; u < 4; ++u) {
          int dd = (rp * 4 + u) * 16 + fr, v0 = vt * 16 + fq * 4;
#pragma unroll
          for (int j = 0; j < 4; ++j) ST[(v0 + j) * 144 + dd] = f2bf(S[u][j]);
        }
      }
      lds_barrier();
    }
#undef SCAN_LOAD_KQ
#undef SCAN_LOAD_V
  }
}

DI void ph_dnfin(const Prm& p, int li) {
  const int lane = mytid() & 63;
  const int gw = mybid() * 8 + (mytid() >> 6), nw = gridDim.x * 8;
  const u16* O = (const u16*)(p.ws + OFF_AR + 5 * U38);
  const u16* O2 = (const u16*)(p.ws + OFF_AR + 6 * U38);
  u16* Z = (u16*)(p.ws + OFF_Y + 3 * U38);
  const float n0 = p.dn_norm[li * 128 + lane * 2], n1 = p.dn_norm[li * 128 + lane * 2 + 1];
#pragma unroll 2
  for (int tok = gw; tok < T_ALL; tok += nw) {
    ushort2 oa[4], ob[4], zz[4];
    float ox[4], oy[4], ss[4];
#pragma unroll
    for (int h = 0; h < 4; ++h) {
      long o = (long)tok * 512 + h * 128 + lane * 2;
      oa[h] = *(const ushort2*)(O + o);
      ob[h] = *(const ushort2*)(O2 + o);
      zz[h] = *(const ushort2*)(Z + o);
    }
#pragma unroll
    for (int h = 0; h < 4; ++h) {
      ox[h] = bf2f(oa[h].x) + bf2f(ob[h].x);
      oy[h] = bf2f(oa[h].y) + bf2f(ob[h].y);
      ss[h] = ox[h] * ox[h] + oy[h] * oy[h];
    }
#pragma unroll
    for (int o = 32; o; o >>= 1)
#pragma unroll
      for (int h = 0; h < 4; ++h) ss[h] += __shfl_xor(ss[h], o);
#pragma unroll
    for (int h = 0; h < 4; ++h) {
      float inv = rsqrtf(ss[h] * (1.f / 128.f) + 1e-6f);
      float z0 = bf2f(zz[h].x), z1 = bf2f(zz[h].y);
      ushort2 y;
      y.x = f2bf(ox[h] * inv * n0 * (z0 / (1.f + __expf(-z0))));
      y.y = f2bf(oy[h] * inv * n1 * (z1 / (1.f + __expf(-z1))));
      *(ushort2*)(Z + (long)tok * 512 + h * 128 + lane * 2) = y;
    }
  }
}

DI void ph_aprep(const Prm& p, int li) {
  const int lane = mytid() & 63;
  const int gw = mybid() * 8 + (mytid() >> 6), nw = gridDim.x * 8;
  const u16* PA = (const u16*)(p.ws + OFF_AR);
  u16* QH = (u16*)(p.ws + OFF_AR + 3 * U38);
  u16* KH = QH + 18874368L;
  const int f = lane & 15;
  const float inv_f = powf(10000.f, -(float)f / 16.f);
  for (int tok = gw; tok < T_ALL; tok += nw) {
    int b, P;
    float cs = 1.f, sn = 0.f;
    if (tok < T_LAT) {
      b = tok >> 11;
      int l = tok & 2047;
      P = 256 + l;
      float pos = (lane < 32) ? (float)(l >> 6) : (float)(l & 63);
      float ang = pos * inv_f;
      cs = cosf(ang);
      sn = sinf(ang);
    } else {
      b = (tok - T_LAT) >> 8;
      P = (tok - T_LAT) & 255;
    }
    float xv[16], ssq[16];
#pragma unroll
    for (int g = 0; g < 16; ++g) {
      xv[g] = bf2f(PA[(long)tok * 1024 + g * 64 + lane]);
      ssq[g] = xv[g] * xv[g];
    }
#pragma unroll
    for (int o = 32; o; o >>= 1)
#pragma unroll
      for (int g = 0; g < 16; ++g) ssq[g] += __shfl_xor(ssq[g], o);
#pragma unroll
    for (int g = 0; g < 16; ++g) {
      int which = g >> 3, h = (g >> 1) & 3, c = g & 1;
      float inv = rsqrtf(ssq[g] * (1.f / 64.f) + 1e-6f);
      float y = xv[g] * inv * p.qk_gain[(li * 2 + which) * 64 + lane];
      float pr = __shfl_xor(y, 16);
      float o = (lane & 16) ? (y * cs + pr * sn) : (y * cs - pr * sn);
      if (which == 0) o *= 0.18033688011112042f;
      u16* dst = (which ? KH : QH) + ((long)((b * 4 + h) * 2 + c) * 2304 + P) * 64 + lane;
      *dst = f2bf(o);
    }
  }
}

DI void ph_attn(const Prm& p, int li, long base, char* smem) {
  const int tid = mytid(), lane = tid & 63, wid = tid >> 6, fr = lane & 15, fq = lane >> 4;
  const u16* QH = (const u16*)(p.ws + OFF_AR + 3 * U38);
  const u16* KH = QH + 18874368L;
  const u16* VT = (const u16*)(p.ws + OFF_AR + 5 * U38);
  u16* YA = (u16*)(p.ws + OFF_Y);
  u16* s = (u16*)smem;
  constexpr int STG = 128 * 80 + 128 * 72;
  const float lambda_init = 0.8f - 0.6f * expf(-0.3f * (float)li);
  float lamv, mshift;
  {
    const float* lv = p.lam + li * 256;
    float a = wsum(lv[lane] * lv[64 + lane]), b2 = wsum(lv[128 + lane] * lv[192 + lane]);
    lamv = expf(a) - expf(b2) + lambda_init;
    float gq = wmax(fabsf(p.qk_gain[(li * 2) * 64 + lane])), gk = wmax(fabsf(p.qk_gain[(li * 2 + 1) * 64 + lane]));
    mshift = 8.f * gq * gk * 1.4426950408889634f;
  }
  for (int it = first_item(base); it < (li == 3 ? 1024 : 1152); it += gridDim.x) {
    int b, h, qp0, nkeys;
    if (it < 1024) { b = it >> 6; h = (it >> 4) & 3; qp0 = 256 + (it & 15) * 128; nkeys = 2304; }
    else { int i2 = it - 1024; b = i2 >> 3; h = (i2 >> 1) & 3; qp0 = (i2 & 1) * 128; nkeys = 256; }
    const long kb0 = (long)((b * 4 + h) * 2) * 2304;
    bf16x8 qf[2][2];
#pragma unroll
    for (int c = 0; c < 2; ++c)
#pragma unroll
      for (int ks = 0; ks < 2; ++ks)
        qf[c][ks] = *(const bf16x8*)(QH + (kb0 + (long)c * 2304 + qp0 + wid * 16 + fr) * 64 + ks * 32 + fq * 8);
    f32x4 O0[8], O1[8];
#pragma unroll
    for (int i = 0; i < 8; ++i) { O0[i] = f32x4{0.f, 0.f, 0.f, 0.f}; O1[i] = f32x4{0.f, 0.f, 0.f, 0.f}; }
    f32x4 L0 = {0.f, 0.f, 0.f, 0.f}, L1 = {0.f, 0.f, 0.f, 0.f};
    const bf16x8 ones = {0x3F80, 0x3F80, 0x3F80, 0x3F80, 0x3F80, 0x3F80, 0x3F80, 0x3F80};
    uint4 rk[2], rv[2];
    const int nt = nkeys >> 6;
#pragma unroll
    for (int u = 0; u < 2; ++u) {
      int id = tid + u * 512;
      int c = id >> 9, key = (id >> 3) & 63, ch = id & 7;
      rk[u] = *(const uint4*)(KH + (kb0 + (long)c * 2304 + key) * 64 + ch * 8);
      int dv = id >> 3;
      rv[u] = *(const uint4*)(VT + ((long)(b * 512 + h * 128 + dv)) * 2304 + ch * 8);
    }
#pragma unroll
    for (int u = 0; u < 2; ++u) {
      int id = tid + u * 512;
      *(uint4*)(s + (id >> 3) * 80 + (id & 7) * 8) = rk[u];
      *(uint4*)(s + 128 * 80 + (id >> 3) * 72 + (id & 7) * 8) = rv[u];
    }
    lds_barrier();
    for (int t = 0; t < nt; ++t) {
      const bool more = t + 1 < nt;
      if (more) {
        int kp0 = (t + 1) * 64;
#pragma unroll
        for (int u = 0; u < 2; ++u) {
          int id = tid + u * 512;
          int c = id >> 9, key = (id >> 3) & 63, ch = id & 7;
          rk[u] = *(const uint4*)(KH + (kb0 + (long)c * 2304 + kp0 + key) * 64 + ch * 8);
          int dv = id >> 3;
          rv[u] = *(const uint4*)(VT + ((long)(b * 512 + h * 128 + dv)) * 2304 + kp0 + ch * 8);
        }
      }
      const u16* ks_ = s + (t & 1) * STG;
      const u16* vs_ = ks_ + 128 * 80;
      bf16x8 pf[2][2];
#pragma unroll
      for (int c = 0; c < 2; ++c) {
#pragma unroll
        for (int kk2 = 0; kk2 < 2; ++kk2) {
          u32x4 pw;
#pragma unroll
          for (int hh = 0; hh < 2; ++hh) {
            const int k4 = kk2 * 2 + hh;
            f32x4 a = {-mshift, -mshift, -mshift, -mshift};
#pragma unroll
            for (int kk = 0; kk < 2; ++kk)
              a = MFMA(*(const bf16x8*)(ks_ + (c * 64 + k4 * 16 + fr) * 80 + kk * 32 + fq * 8), qf[c][kk], a);
            pw[hh * 2 + 0] = pk_bf16(__builtin_amdgcn_exp2f(a[0]), __builtin_amdgcn_exp2f(a[1]));
            pw[hh * 2 + 1] = pk_bf16(__builtin_amdgcn_exp2f(a[2]), __builtin_amdgcn_exp2f(a[3]));
          }
          pf[c][kk2] = *(bf16x8*)&pw;
        }
      }
#pragma unroll
      for (int kk = 0; kk < 2; ++kk) {
        L0 = MFMA(ones, pf[0][kk], L0);
        L1 = MFMA(ones, pf[1][kk], L1);
      }
#pragma unroll
      for (int dt = 0; dt < 8; ++dt) {
#pragma unroll
        for (int kk = 0; kk < 2; ++kk) {
          const u16* vp = vs_ + (dt * 16 + fr) * 72 + kk * 32 + fq * 4;
          uint2 lo = *(const uint2*)vp, hi = *(const uint2*)(vp + 16);
          uint4 av = {lo.x, lo.y, hi.x, hi.y};
          bf16x8 a = *(bf16x8*)&av;
          O0[dt] = MFMA(a, pf[0][kk], O0[dt]);
          O1[dt] = MFMA(a, pf[1][kk], O1[dt]);
        }
      }
      if (more) {
        u16* ns = s + ((t + 1) & 1) * STG;
#pragma unroll
        for (int u = 0; u < 2; ++u) {
          int id = tid + u * 512;
          *(uint4*)(ns + (id >> 3) * 80 + (id & 7) * 8) = rk[u];
          *(uint4*)(ns + 128 * 80 + (id >> 3) * 72 + (id & 7) * 8) = rv[u];
        }
      }
      lds_barrier();
    }
    float i0 = 1.f / L0[0], i1 = lamv / L1[0], ss = 0.f;
#pragma unroll
    for (int dt = 0; dt < 8; ++dt)
#pragma unroll
      for (int j = 0; j < 4; ++j) {
        float o = O0[dt][j] * i0 - O1[dt][j] * i1;
        O0[dt][j] = o;
        ss += o * o;
      }
    ss += __shfl_xor(ss, 16); ss += __shfl_xor(ss, 32);
    float inv = rsqrtf(ss * (1.f / 128.f) + 1e-6f) * (1.f - lambda_init);
    int tok = tokof(b, qp0 + wid * 16 + fr);
#pragma unroll
    for (int dt = 0; dt < 8; ++dt) {
      int dv = dt * 16 + fq * 4;
      const float* sw = p.subln + li * 128 + dv;
      ushort4 o;
      o.x = f2bf(O0[dt][0] * inv * sw[0]);
      o.y = f2bf(O0[dt][1] * inv * sw[1]);
      o.z = f2bf(O0[dt][2] * inv * sw[2]);
      o.w = f2bf(O0[dt][3] * inv * sw[3]);
      *(ushort4*)(YA + (long)tok * 512 + h * 128 + dv) = o;
    }
  }
}

template <int L>
DI void hyena_item(const Prm& p, int li, int ch, char* smem) {
  constexpr int CS = 2 * L + 8;
  constexpr int ZS = L + 8;
  constexpr int MT = L / 128;
  constexpr int MG = MT > 8 ? 8 : MT, NG = MT / MG;
  const int tid = mytid(), lane = tid & 63, wid = tid >> 6, fr = lane & 15, fq = lane >> 4;
  u16* cp = (u16*)smem;
  u16* zr = cp + 8 * CS;
  const u16* PH = (const u16*)(p.ws + OFF_AR) + (L == 2048 ? 0L : 32768L * 1536);
  const u16* G = (const u16*)(p.ws + (L == 2048 ? OFF_TAPL : OFF_TAPC));
  u16* YB = (u16*)(p.ws + OFF_Y + U38);
  const float* cw = p.hy_conv + (long)li * 3 * 1536;
  {
    float w0 = cw[1024 + ch], w1 = cw[1536 + 1024 + ch], w2 = cw[3072 + 1024 + ch];
    constexpr int NCH = (16 * L / 8) / 512;
    u32x4 cv[NCH];
    u16 pv[NCH], nv[NCH];
#pragma unroll
    for (int i = 0; i < NCH; ++i) {
      int id = tid + i * 512, b = id / (L / 8), s0 = (id % (L / 8)) * 8;
      const u16* row = PH + ((long)b * 1536 + 1024 + ch) * L + s0;
      cv[i] = *(const u32x4*)row;
      pv[i] = (s0 > 0) ? row[-1] : (u16)0;
      nv[i] = (s0 + 8 < L) ? row[8] : (u16)0;
    }
#pragma unroll
    for (int i = 0; i < NCH; ++i) {
      int id = tid + i * 512, b = id / (L / 8), s0 = (id % (L / 8)) * 8;
      float x[10];
      x[0] = bf2f(pv[i]);
      x[9] = bf2f(nv[i]);
#pragma unroll
      for (int w = 0; w < 4; ++w) {
        x[1 + 2 * w] = __uint_as_float(cv[i][w] << 16);
        x[2 + 2 * w] = __uint_as_float(cv[i][w] & 0xffff0000u);
      }
      float o[8];
#pragma unroll
      for (int e = 0; e < 8; ++e) o[e] = w0 * x[e] + w1 * x[e + 1] + w2 * x[e + 2];
      u32x4 r;
      r[0] = pk_bf16(o[7], o[6]); r[1] = pk_bf16(o[5], o[4]); r[2] = pk_bf16(o[3], o[2]); r[3] = pk_bf16(o[1], o[0]);
      *(u32x4*)(zr + b * ZS + L - 8 - s0) = r;
    }
  }
#pragma unroll
  for (int order = 0; order < 2; ++order) {
    {
      const u16* g = G + (long)(order * 512 + ch) * (2 * L);
      if (tid < 2 * L / 8) {
        const int i0 = tid * 8;
        u32x4 lo = *(const u32x4*)(g + i0);
        u32x4 hi = (i0 + 8 < 2 * L) ? *(const u32x4*)(g + i0 + 8) : u32x4{0u, 0u, 0u, 0u};
        unsigned D[8] = {lo[0], lo[1], lo[2], lo[3], hi[0], hi[1], hi[2], hi[3]};
#pragma unroll
        for (int c = 0; c < 8; ++c) {
          u32x4 o;
#pragma unroll
          for (int w = 0; w < 4; ++w) {
            if (c & 1) o[w] = (D[w + (c - 1) / 2] >> 16) | (D[w + (c + 1) / 2] << 16);
            else o[w] = D[w + c / 2];
          }
          *(u32x4*)(cp + c * CS + i0) = o;
        }
      }
    }
    __syncthreads();
    const float bias = p.hy_bias[(li * 2 + order) * 512 + ch];
    const int gcol = order * 512 + ch;
    const float w0 = cw[gcol], w1 = cw[1536 + gcol], w2 = cw[3072 + gcol];
    const int tq = wid * (L / 8) + fq * 4;
    const u16* xb = PH + ((long)fr * 1536 + gcol) * L + tq;
    const u16* zb = zr + fr * ZS + L - 1 - tq;
    unsigned zp[NG][MG][2];
#pragma unroll
    for (int grp = 0; grp < NG; ++grp) {
      f32x4 acc[MG];
#pragma unroll
      for (int m = 0; m < MG; ++m) acc[m] = f32x4{0.f, 0.f, 0.f, 0.f};
      const int tb = wid * (L / 8) + grp * MG * 16 + fr;
      if constexpr (MG == 8) {
        const int i00 = tb - fq * 8 - 7 + L, c0 = i00 & 7;
        const u16* ab = cp + c0 * CS + (i00 - c0);
        const u16* zbp = zr + fr * ZS + (L - 8 - fq * 8);
        bf16x8 W[16];
#pragma unroll 1
        for (int s0 = 0; s0 < L; s0 += 256) {
#pragma unroll
          for (int k = 0; k < 8; ++k) {
            const int sk = s0 + 32 * k;
            if (k == 0) {
#pragma unroll
              for (int m = 0; m < 8; ++m) W[m] = *(const bf16x8*)(ab + m * 16 - sk);
            }
            if (k < 7) {
              W[(16 - 2 * k - 2) & 15] = *(const bf16x8*)(ab - sk - 32);
              W[(16 - 2 * k - 1) & 15] = *(const bf16x8*)(ab - sk - 32 + 16);
            }
            bf16x8 bk = *(const bf16x8*)(zbp - sk);
#pragma unroll
            for (int m = 0; m < 8; ++m) acc[m] = MFMA(W[(m + 16 - 2 * k) & 15], bk, acc[m]);
          }
        }
      } else {
#pragma unroll 2
        for (int s0 = 0; s0 < L; s0 += 32) {
          bf16x8 bfr = *(const bf16x8*)(zr + fr * ZS + (L - 8 - s0 - fq * 8));
#pragma unroll
          for (int m = 0; m < MG; ++m) {
            int i0 = tb + m * 16 - s0 - fq * 8 - 7 + L;
            int c = i0 & 7;
            bf16x8 afr = *(const bf16x8*)(cp + c * CS + (i0 - c));
            acc[m] = MFMA(afr, bfr, acc[m]);
          }
        }
      }
#pragma unroll
      for (int m = 0; m < MG; ++m) {
        float r4[4];
#pragma unroll
        for (int j = 0; j < 4; ++j) {
          const int off = (grp * MG + m) * 16 + j;
          const int t = tq + off;
          float xa = bf2f(xb[off - 1]), xc = bf2f(xb[off]), xd = bf2f(xb[off + 1]);
          xa = (t > 0) ? xa : 0.f;
          xd = (t + 1 < L) ? xd : 0.f;
          float xg = w0 * xa + w1 * xc + w2 * xd;
          float zin = bf2f(zb[-off]);
          r4[j] = xg * (acc[m][j] + bias * zin);
        }
        zp[grp][m][0] = (unsigned)f2bf(r4[0]) | ((unsigned)f2bf(r4[1]) << 16);
        zp[grp][m][1] = (unsigned)f2bf(r4[2]) | ((unsigned)f2bf(r4[3]) << 16);
      }
    }
    __syncthreads();
#pragma unroll
    for (int grp = 0; grp < NG; ++grp)
#pragma unroll
      for (int m = 0; m < MG; ++m) {
        int t0 = wid * (L / 8) + (grp * MG + m) * 16 + fq * 4;
        uint2 w;
        w.x = (zp[grp][m][1] >> 16) | (zp[grp][m][1] << 16);
        w.y = (zp[grp][m][0] >> 16) | (zp[grp][m][0] << 16);
        *(uint2*)(zr + fr * ZS + L - 4 - t0) = w;
      }
  }
  __syncthreads();
  {
    u16* YBT = (u16*)(p.ws + OFF_AR + 5 * U38) + (L == 2048 ? 0L : 16L * 512 * 2048);
    constexpr int NCH = (16 * L / 8) / 512;
#pragma unroll
    for (int i = 0; i < NCH; ++i) {
      int id = tid + i * 512, b = id / (L / 8), t0 = (id % (L / 8)) * 8;
      u32x4 r = *(const u32x4*)(zr + b * ZS + L - 8 - t0);
      u32x4 o;
      o[0] = (r[3] >> 16) | (r[3] << 16);
      o[1] = (r[2] >> 16) | (r[2] << 16);
      o[2] = (r[1] >> 16) | (r[1] << 16);
      o[3] = (r[0] >> 16) | (r[0] << 16);
      *(u32x4*)(YBT + ((long)b * 512 + ch) * L + t0) = o;
    }
  }
  __syncthreads();
}

DI long ph_ytrans(const Prm& p, long base, bool lastl, char* smem) {
  u16* tl = (u16*)smem;
  const u16* YBT = (const u16*)(p.ws + OFF_AR + 5 * U38);
  u16* YB = (u16*)(p.ws + OFF_Y + U38);
  const int tid = mytid(), G = gridDim.x;
  const int total = lastl ? 4096 : 4608;
  auto srcp = [&](int it) -> const u16* {
    if (it < 4096) {
      int b = it >> 8, ct = (it >> 5) & 7, lt = it & 31;
      return YBT + ((long)b * 512 + ct * 64 + (tid >> 3)) * 2048 + lt * 64 + (tid & 7) * 8;
    } else {
      int i2 = it - 4096, b = i2 >> 5, ct = (i2 >> 2) & 7, lt = i2 & 3;
      return YBT + 16L * 512 * 2048 + ((long)b * 512 + ct * 64 + (tid >> 3)) * 256 + lt * 64 + (tid & 7) * 8;
    }
  };
  int it = first_item(base);
  u32x4 v = {0u, 0u, 0u, 0u};
  if (it < total) v = *(const u32x4*)srcp(it);
  for (; it < total; it += G) {
    *(u32x4*)(tl + (tid >> 3) * 72 + (tid & 7) * 8) = v;
    __syncthreads();
    if (it + G < total) v = *(const u32x4*)srcp(it + G);
    long tok0;
    int ct;
    if (it < 4096) { int b = it >> 8, lt = it & 31; ct = (it >> 5) & 7; tok0 = (long)b * 2048 + lt * 64; }
    else { int i2 = it - 4096, b = i2 >> 5, lt = i2 & 3; ct = (i2 >> 2) & 7; tok0 = (long)T_LAT + b * 256 + lt * 64; }
    const int lrow = tid >> 3, cc = tid & 7;
    u32x4 o;
#pragma unroll
    for (int w = 0; w < 4; ++w) {
      unsigned lo = tl[(cc * 8 + 2 * w) * 72 + lrow], hi = tl[(cc * 8 + 2 * w + 1) * 72 + lrow];
      o[w] = lo | (hi << 16);
    }
    *(u32x4*)(YB + (tok0 + lrow) * 512 + ct * 64 + cc * 8) = o;
    __syncthreads();
  }
  return base + total;
}

DI void ph_merge(const Prm& p, char* smem, bool lastl) {
  const int tid = mytid(), lane = tid & 63, wid = tid >> 6;
  const int wm = wid >> 1, wn = wid & 1, fr = lane & 15, fq = lane >> 4;
  const u16* H = (const u16*)(p.ws + OFF_HBF);
  const u16* Y = (const u16*)(p.ws + OFF_Y);
  const u16* WG = (const u16*)(p.ws + OFF_WB) + WO_G;
  const u16* WBr = (const u16*)(p.ws + OFF_WB) + WO_B;
  u16* MG = (u16*)(p.ws + OFF_AR);
  const int NT = (lastl ? 256 : 288) * 8, G = gridDim.x;
  Stg r0, r1;
  bool pre = false;
  for (int t = mybid(); t < NT; t += G) {
    const int mt = t >> 3, nt = t & 7;
    const bool hn = t + G < NT;
    const int mt2 = (t + G) >> 3, nt2 = (t + G) & 7;
    f32x4 acc[2][4], g[2][4], y[2][4];
#pragma unroll
    for (int a = 0; a < 2; ++a)
#pragma unroll
      for (int b = 0; b < 4; ++b) acc[a][b] = f32x4{0.f, 0.f, 0.f, 0.f};
    const u16* gA = H + (long)mt * 128 * 1024;
    for (int n = 0; n < 4; ++n) {
      const u16* gB = WG + ((long)n * 1024 + nt * 128) * 1024;
      const u16* yA = Y + (long)n * (T_ALL * 512L) + (long)mt * 128 * 512;
      const u16* yB = WBr + ((long)n * 1024 + nt * 128) * 512;
      gemm_tile<2>(g, gA, 1024, gB, 1024, 1024, smem, r0, r1, pre, yA, 512, yB, 512);
      const u16* nxA = (n < 3) ? gA : (hn ? H + (long)mt2 * 128 * 1024 : nullptr);
      const u16* nxB = (n < 3) ? WG + ((long)(n + 1) * 1024 + nt * 128) * 1024 : WG + ((long)nt2 * 128) * 1024;
      gemm_tile<2>(y, yA, 512, yB, 512, 512, smem, r0, r1, true, nxA, 1024, nxB, 1024);
      pre = true;
#pragma unroll
      for (int a = 0; a < 2; ++a)
#pragma unroll
        for (int b = 0; b < 4; ++b)
#pragma unroll
          for (int j = 0; j < 4; ++j) acc[a][b][j] += y[a][b][j] / (1.f + __expf(-g[a][b][j]));
    }
    pre = hn;
#pragma unroll
    for (int a = 0; a < 2; ++a)
#pragma unroll
      for (int b = 0; b < 4; ++b) {
        int r = wm * 32 + a * 16 + fr, c = wn * 64 + b * 16 + fq * 4;
        uint2 o;
        o.x = pk_bf16(acc[a][b][0], acc[a][b][1]);
        o.y = pk_bf16(acc[a][b][2], acc[a][b][3]);
        *(uint2*)(MG + ((long)mt * 128 + r) * 1024 + nt * 128 + c) = o;
      }
  }
}

DI void run_phase(const Prm& p, int ph, char* smem) {
  if (ph == 0) { ph_init(p, smem); return; }
  const int li = (ph - 1) / 14, k = (ph - 1) % 14;
  const u16* WB = (const u16*)(p.ws + OFF_WB);
  const u16* HB = (const u16*)(p.ws + OFF_HBF);
  const float* MOD = (const float*)(p.ws + OFF_MOD);
  u16* AR = (u16*)(p.ws + OFF_AR);
  u16* Yb = (u16*)(p.ws + OFF_Y);
  const int G = gridDim.x;
  TD d;
  d.split = 0; d.scale = 1.f; d.mode = 0; d.tok0 = 0; d.col0 = 0; d.g = MOD;
  switch (k) {
    case 0: {
      u16* W = (u16*)(p.ws + OFF_WB);
      long base = 0;
      base = tr_job(base, p.w_in + (long)li * 1024 * NIN, 1024, NIN, W + WO_IN, 1, smem);
      base = tr_job(base, p.w_gate + (long)li * 4 * 1048576, 1024, 1024, W + WO_G, 4, smem);
      base = tr_job(base, p.w_branch + (long)li * 4 * 524288, 512, 1024, W + WO_B, 4, smem);
      base = tr_job(base, p.w_o + (long)li * 1048576, 1024, 1024, W + WO_O, 1, smem);
      base = tr_job(base, p.w_mlp1 + (long)li * 4194304, 1024, 4096, W + WO_1, 1, smem);
      base = tr_job(base, p.w_mlp2 + (long)li * 4194304, 4096, 1024, W + WO_2, 1, smem);
      ph_taps1(p, li, base, smem);
      ph_norm(p, li, 0);
    } break;
    case 1: {
      auto dec = [&](int t, TD& o) {
        o.lda = 1024; o.ldb = 1024; o.K = 1024; o.mode = 0;
        if (t < 1728) {
          int mt = t / 12, nt = t % 12;
          o.A = HB + (long)mt * 256 * 1024; o.B = WB + WO_IN + (long)(3584 + nt * 128) * 1024;
          o.C = AR + (long)mt * 256 * 1536 + nt * 128; o.ldc = 1536;
        } else if (t < 2304) {
          int t2 = t - 1728, mt = t2 >> 2, nt = t2 & 3;
          o.A = HB + (long)mt * 256 * 1024; o.B = WB + WO_IN + (long)(5120 + nt * 128) * 1024;
          o.C = Yb + 3 * (U38 / 2) + (long)mt * 256 * 512 + nt * 128; o.ldc = 512;
        } else {
          int mt = t - 2304;
          o.A = HB + (long)mt * 256 * 1024; o.B = WB + WO_IN + (long)5632 * 1024;
          o.C = (u16*)((float*)(p.ws + OFF_PDAB) + (long)mt * 256 * 16); o.ldc = 16; o.mode = 3;
        }
      };
      {
        Stg r0, r1;
        bool pre = false;
        TD dn = d;
        int t = mybid();
        if (t < 2448) dec(t, d);
        for (; t < 2448; t += G) {
          const bool hn = t + G < 2448;
          if (hn) dec(t + G, dn);
          run_tile2<4>(p, d, smem, r0, r1, pre, hn ? dn.A : nullptr, dn.lda, dn.B, dn.ldb);
          pre = hn;
          d = dn;
        }
      }
      ph_taps2(p, 2448, smem);
    } break;
    case 2: ph_dncl(p, li, smem); break;
    case 3: ph_dnscan(p, smem); break;
    case 4: {
      {
        Stg r0, r1;
        bool pre = false;
        for (int t = mybid(); t < 1152; t += G) {
          int mt = t >> 3, nt = t & 7;
          const bool hn = t + G < 1152;
          int mt2 = (t + G) >> 3, nt2 = (t + G) & 7;
          d.lda = 1024; d.ldb = 1024; d.K = 1024;
          d.A = HB + (long)mt * 256 * 1024; d.B = WB + WO_IN + (long)(nt * 128) * 1024;
          d.C = AR + 3 * (U38 / 2); d.ldc = 0; d.mode = 4; d.tok0 = mt * 256; d.col0 = nt;
          d.g = p.qk_gain + li * 128;
          run_tile2<4>(p, d, smem, r0, r1, pre, hn ? HB + (long)mt2 * 256 * 1024 : nullptr, 1024,
                    WB + WO_IN + (long)(nt2 * 128) * 1024, 1024);
          pre = hn;
        }
      }
      ph_dnfin(p, li);
    } break;
    case 5: {
      u16* VT = AR + 5 * (U38 / 2);
      u16* PF = AR + 6 * (U38 / 2);
      auto dec = [&](int t, TD& o) {
        o.lda = 1024; o.ldb = 1024; o.K = 1024;
        if (t < 512) {
          int b = t >> 5, r = t & 31, mt = r >> 4, nt = r & 15;
          o.A = WB + WO_IN + (long)(1024 + mt * 256) * 1024; o.B = HB + ((long)b * 2048 + nt * 128) * 1024;
          o.C = VT + ((long)b * 512 + mt * 256) * 2304 + 256 + nt * 128; o.ldc = 2304;
        } else if (t < 576) {
          int t2 = t - 512, b = t2 >> 2, r = t2 & 3, mt = r >> 1, nt = r & 1;
          o.A = WB + WO_IN + (long)(1024 + mt * 256) * 1024; o.B = HB + ((long)T_LAT + b * 256 + nt * 128) * 1024;
          o.C = VT + ((long)b * 512 + mt * 256) * 2304 + nt * 128; o.ldc = 2304;
        } else {
          int t2 = t - 576, mt = t2 >> 2, nt = t2 & 3;
          o.A = HB + (long)mt * 256 * 1024; o.B = WB + WO_IN + (long)(3072 + nt * 128) * 1024;
          o.C = PF + (long)mt * 256 * 512 + nt * 128; o.ldc = 512;
        }
      };
      {
        Stg r0, r1;
        bool pre = false;
        TD dn = d;
        int t = mybid();
        if (t < 1152) dec(t, d);
        for (; t < 1152; t += G) {
          const bool hn = t + G < 1152;
          if (hn) dec(t + G, dn);
          run_tile2<4>(p, d, smem, r0, r1, pre, hn ? dn.A : nullptr, dn.lda, dn.B, dn.ldb);
          pre = hn;
          d = dn;
        }
      }
    } break;
    case 6: {
      ph_attn(p, li, 0, smem);
      auto dec = [&](int t, TD& o) {
        o.lda = 1024; o.ldb = 1024; o.K = 1024;
        if (t < 1536) {
          int b = t / 96, r = t % 96, mt = r >> 4, nt = r & 15;
          o.A = WB + WO_IN + (long)(1536 + mt * 256) * 1024; o.B = HB + ((long)b * 2048 + nt * 128) * 1024;
          o.C = AR + ((long)b * 1536 + mt * 256) * 2048 + nt * 128; o.ldc = 2048;
        } else {
          int t2 = t - 1536, b = t2 / 12, r = t2 % 12, mt = r >> 1, nt = r & 1;
          o.A = WB + WO_IN + (long)(1536 + mt * 256) * 1024; o.B = HB + ((long)T_LAT + b * 256 + nt * 128) * 1024;
          o.C = AR + 32768L * 1536 + ((long)b * 1536 + mt * 256) * 256 + nt * 128; o.ldc = 256;
        }
      };
      {
        Stg r0, r1;
        bool pre = false;
        TD dn = d;
        int t = first_item(1152);
        if (t < 1728) dec(t, d);
        for (; t < 1728; t += G) {
          const bool hn = t + G < 1728;
          if (hn) dec(t + G, dn);
          run_tile2<4>(p, d, smem, r0, r1, pre, hn ? dn.A : nullptr, dn.lda, dn.B, dn.ldb);
          pre = hn;
          d = dn;
        }
      }
    } break;
    case 7: {
#if !defined(TESTSEL) || TESTSEL == 1
      for (int it = mybid(); it < 512; it += G) hyena_item<2048>(p, li, it, smem);
#endif
#if !defined(TESTSEL) || TESTSEL == 2
      if (li < 3)
        for (int it = mybid(); it < 512; it += G) hyena_item<256>(p, li, it, smem);
#endif
#if !defined(TESTSEL) || TESTSEL == 3
      const u16* PF = AR + 6 * (U38 / 2);
      u16* WF = AR + 3 * (U38 / 2);
      const u16* DCm = (const u16*)(p.ws + OFF_DC);
      auto dec = [&](int t, TD& o) {
        o.A = DCm; o.lda = 128; o.ldb = 512; o.K = 128;
        if (t < 1024) {
          int bg = t >> 4, nt = t & 15, b = bg >> 2, g = bg & 3;
          o.B = PF + ((long)b * 2048 + nt * 128) * 512 + g * 128;
          o.C = WF + ((long)b * 512 + g * 128) * 4096 + nt * 128; o.ldc = 4096; o.split = 2048;
        } else {
          int t2 = t - 1024, bg = t2 >> 1, nt = t2 & 1, b = bg >> 2, g = bg & 3;
          o.B = PF + ((long)T_LAT + b * 256 + nt * 128) * 512 + g * 128;
          o.C = WF + 16L * 512 * 4096 + ((long)b * 512 + g * 128) * 512 + nt * 128; o.ldc = 512; o.split = 256;
        }
      };
      {
        const int NT7 = (li == 3 ? 1024 : 1152);
        Stg r0, r1;
        bool pre = false;
        TD dn = d;
        int t = mybid();
        if (t < NT7) dec(t, d);
        for (; t < NT7; t += G) {
          const bool hn = t + G < NT7;
          if (hn) dec(t + G, dn);
          run_tile2<4>(p, d, smem, r0, r1, pre, hn ? dn.A : nullptr, dn.lda, dn.B, dn.ldb);
          pre = hn;
          d = dn;
        }
      }
#endif
    } break;
    case 8: {
      const u16* WF = AR + 3 * (U38 / 2);
      u16* YF = Yb + 2 * (U38 / 2);
      d.scale = 1.f / 512.f;
      for (int t = mybid(); t < (li == 3 ? 512 : 576); t += G) {
        if (t < 512) {
          int b = t >> 5, r = t & 31, mt = r >> 2, nt = r & 3;
          d.A = (const u16*)(p.ws + OFF_DL) + (long)mt * 256 * 4096; d.lda = 4096;
          d.B = WF + ((long)b * 512 + nt * 128) * 4096; d.ldb = 4096; d.K = 4096;
          d.C = YF + ((long)b * 2048 + mt * 256) * 512 + nt * 128; d.ldc = 512;
        } else {
          int t2 = t - 512, b = t2 >> 2, nt = t2 & 3;
          d.A = (const u16*)(p.ws + OFF_DLC); d.lda = 512;
          d.B = WF + 16L * 512 * 4096 + ((long)b * 512 + nt * 128) * 512; d.ldb = 512; d.K = 512;
          d.C = YF + ((long)T_LAT + b * 256) * 512 + nt * 128; d.ldc = 512;
        }
        run_tile(p, d, smem);
      }
      ph_ytrans(p, 576, li == 3, smem);
    } break;
    case 9: ph_merge(p, smem, li == 3); break;
    case 10: {
      d.mode = 2;
      const int NF = 1024, NTOT = (li == 3) ? 1024 : 1024 + 256;
      auto dec = [&](int t, TD& o) {
        int full = t < NF ? t : NF + ((t - NF) >> 1), half = t < NF ? 0 : ((t - NF) & 1);
        int mt = full >> 3, nt = full & 7;
        o.A = AR + ((long)mt * 256 + half * 128) * 1024; o.lda = 1024;
        o.B = WB + WO_O + (long)nt * 128 * 1024; o.ldb = 1024; o.K = 1024;
        o.tok0 = mt * 256 + half * 128; o.col0 = nt * 128;
        int bb = o.tok0 < T_LAT ? (o.tok0 >> 11) : 16;
        o.g = MOD + ((long)li * 17 + bb) * 6144 + 2 * 1024;
      };
      Stg r0, r1;
      bool pre = false;
      TD dn = d;
      int t = mybid();
      if (t < NTOT) dec(t, d);
      for (; t < NTOT; t += G) {
        const bool hn = t + G < NTOT;
        if (hn) dec(t + G, dn);
        if (t < NF) run_tile2<4>(p, d, smem, r0, r1, pre, hn ? dn.A : nullptr, dn.lda, dn.B, dn.ldb);
        else run_tile2<2>(p, d, smem, r0, r1, pre, hn ? dn.A : nullptr, dn.lda, dn.B, dn.ldb);
        pre = hn;
        d = dn;
      }
    } break;
    case 11: ph_norm(p, li, 1); break;
    case 12: {
      d.mode = 1;
      const int NT12 = (li == 3 ? 4096 : 4608);
      Stg r0, r1;
      bool pre = false;
      for (int t = mybid(); t < NT12; t += G) {
        int mt = t >> 5, nt = t & 31;
        d.A = HB + (long)mt * 256 * 1024; d.lda = 1024; d.B = WB + WO_1 + (long)nt * 128 * 1024; d.ldb = 1024; d.K = 1024;
        d.C = Yb + (long)mt * 256 * 4096 + nt * 128; d.ldc = 4096;
        const bool hn = t + G < NT12;
        int mt2 = (t + G) >> 5, nt2 = (t + G) & 31;
        run_tile2<4>(p, d, smem, r0, r1, pre, hn ? HB + (long)mt2 * 256 * 1024 : nullptr, 1024,
                  WB + WO_1 + (long)nt2 * 128 * 1024, 1024);
        pre = hn;
      }
    } break;
    case 13: {
      d.mode = 2;
      const int NF = 1024, NTOT = (li == 3) ? 1024 : 1024 + 256;
      auto dec = [&](int t, TD& o) {
        int full = t < NF ? t : NF + ((t - NF) >> 1), half = t < NF ? 0 : ((t - NF) & 1);
        int mt = full >> 3, nt = full & 7;
        o.A = Yb + ((long)mt * 256 + half * 128) * 4096; o.lda = 4096;
        o.B = WB + WO_2 + (long)nt * 128 * 4096; o.ldb = 4096; o.K = 4096;
        o.tok0 = mt * 256 + half * 128; o.col0 = nt * 128;
        int bb = o.tok0 < T_LAT ? (o.tok0 >> 11) : 16;
        o.g = MOD + ((long)li * 17 + bb) * 6144 + 5 * 1024;
      };
      Stg r0, r1;
      bool pre = false;
      TD dn = d;
      int t = mybid();
      if (t < NTOT) dec(t, d);
      for (; t < NTOT; t += G) {
        const bool hn = t + G < NTOT;
        if (hn) dec(t + G, dn);
        if (t < NF) run_tile2<4>(p, d, smem, r0, r1, pre, hn ? dn.A : nullptr, dn.lda, dn.B, dn.ldb);
        else run_tile2<2>(p, d, smem, r0, r1, pre, hn ? dn.A : nullptr, dn.lda, dn.B, dn.ldb);
        pre = hn;
        d = dn;
      }
    } break;
  }
}


#define XB_TMO      128
#define XB_XCNT(j)  (256  + 64 * (j))
#define XB_XSUB(j)  (1280 + 64 * (j))
#define XB_XGEN(j)  (2304 + 64 * (j))
#define XB_TOP      3328
#define XB_TOPGEN   3392
#define XCD_BAR_WORDS 3456
#define XB_SPIN_CAP (1u << 20)
#define LAS __attribute__((address_space(3)))
DI unsigned xb_ld(unsigned* p) { return __hip_atomic_load(p, __ATOMIC_RELAXED, __HIP_MEMORY_SCOPE_AGENT); }
DI unsigned xb_add(unsigned* p, unsigned v) { return __hip_atomic_fetch_add(p, v, __ATOMIC_RELAXED, __HIP_MEMORY_SCOPE_AGENT); }
DI unsigned xb_xcc_id() { return (unsigned)__builtin_amdgcn_s_getreg((3 << 11) | 20) & 0xFu; }
#define XB_SPIN(cond, bar) do { unsigned _sp = 0; while (cond) { __builtin_amdgcn_s_sleep(1); \
    if ((++_sp & 255u) == 0u) { if (xb_ld(&(bar)[XB_TMO])) break; if (_sp > XB_SPIN_CAP) { atomicAdd(&(bar)[XB_TMO], 1u); break; } } } } while (0)
struct XcdBarrier { unsigned* bar; unsigned x; volatile LAS unsigned* st; };
DI XcdBarrier xcd_barrier_post(unsigned* bar, volatile LAS unsigned* st) {
  XcdBarrier b; b.bar = bar; b.x = xb_xcc_id(); b.st = st;
  if (threadIdx.x == 0) (void)xb_add(&bar[XB_XCNT(b.x)], 1u);
  return b;
}
DI void xcd_barrier_complete(unsigned* bar, unsigned x, unsigned& nloc, unsigned& nx) {
  const unsigned G = gridDim.x * gridDim.y * gridDim.z;
  unsigned sum, cnt, mine, sp = 0u;
  for (;;) {
    sum = 0u; cnt = 0u; mine = 0u;
#pragma unroll
    for (unsigned j = 0; j < 16; ++j) { const unsigned c = xb_ld(&bar[XB_XCNT(j)]); sum += c; cnt += (c > 0u) ? 1u : 0u; mine = (j == x) ? c : mine; }
    if (sum == G) break;
    __builtin_amdgcn_s_sleep(1);
    if ((++sp & 255u) == 0u) { if (xb_ld(&bar[XB_TMO])) break; if (sp > XB_SPIN_CAP) { atomicAdd(&bar[XB_TMO], 1u); break; } }
  }
  nloc = mine > 0u ? mine : 1u; nx = cnt > 0u ? cnt : 1u;
}
DI void xcd_barrier(const XcdBarrier& b) {
  asm volatile("s_waitcnt vmcnt(0)" ::: "memory");
  __syncthreads();
  if (threadIdx.x == 0) {
    unsigned* bar = b.bar;
    __builtin_amdgcn_s_waitcnt(0);
    unsigned nloc = b.st[0], nx = b.st[1];
    if (nloc == 0u) { xcd_barrier_complete(bar, b.x, nloc, nx); b.st[0] = nloc; b.st[1] = nx; }
    const unsigned old = xb_add(&bar[XB_XSUB(b.x)], 1u);
    const unsigned gen = old / nloc;
    if (old + 1u == (gen + 1u) * nloc) {
      __builtin_amdgcn_fence(__ATOMIC_RELEASE, "agent");
      asm volatile("s_waitcnt vmcnt(0)" ::: "memory");
      const unsigned og = xb_add(&bar[XB_TOP], 1u);
      const unsigned tg = og / nx;
      if (og + 1u == (tg + 1u) * nx) xb_add(&bar[XB_TOPGEN], 1u);
      else XB_SPIN(xb_ld(&bar[XB_TOPGEN]) == tg, bar);
      __builtin_amdgcn_fence(__ATOMIC_ACQUIRE, "agent");
      xb_add(&bar[XB_XGEN(b.x)], 1u);
      asm volatile("s_waitcnt vmcnt(0)" ::: "memory");
    } else {
      XB_SPIN(xb_ld(&bar[XB_XGEN(b.x)]) == gen, bar);
      __builtin_amdgcn_fence(__ATOMIC_ACQUIRE, "agent");
      asm volatile("s_waitcnt vmcnt(0)" ::: "memory");
    }
  }
  __syncthreads();
}

extern __shared__ __attribute__((aligned(16))) char dyn_smem[];

__global__ void __launch_bounds__(512) mega(Prm p, int lo, int hi) {
  __shared__ uint4 xb_words;
  if (threadIdx.x == 0) xb_words = make_uint4(0u, 0u, 0u, 0u);
  __syncthreads();
  XcdBarrier xb = xcd_barrier_post((unsigned*)(p.ws + OFF_BAR), (volatile LAS unsigned*)&xb_words);
#ifdef ONLYK
  run_phase(p, ONLYK, dyn_smem);
#else
  for (int ph = lo; ph <= hi; ++ph) {
    long z = 0;
    asm volatile("" : "+s"(z));
    Prm q;
#define LP(f) q.f = p.f + z
    LP(x); LP(c); LP(ctx); LP(c_ctx); LP(w_ada); LP(b_ada); LP(norm1); LP(norm2); LP(w_in); LP(qk_gain); LP(lam);
    LP(subln); LP(hy_conv); LP(hy_w1); LP(hy_b1); LP(hy_freq); LP(hy_w2); LP(hy_b2); LP(hy_w3); LP(hy_bias);
    LP(dn_conv); LP(dn_a_log); LP(dn_dt_bias); LP(dn_norm); LP(w_gate); LP(w_branch); LP(w_o); LP(w_mlp1); LP(w_mlp2);
    LP(out); LP(ws);
#undef LP
    run_phase(q, ph, dyn_smem);
#ifdef PROBEK
    if (ph > 0 && (ph - 1) % 14 == PROBEK) { cg::this_grid().sync(); run_phase(q, ph, dyn_smem); }
#endif
    if (ph < hi) {
      if (ph == lo) cg::this_grid().sync();
      else xcd_barrier(xb);
    }
  }
#endif
}

extern "C" void kernel_launch(void* const* d_in, const int* in_sizes, int n_in, void* d_out, int out_size, void* d_ws,
                              size_t ws_size, hipStream_t stream) {
  static int grid_blocks = 0;
  if (!grid_blocks) {
    hipFuncSetAttribute((const void*)mega, hipFuncAttributeMaxDynamicSharedMemorySize, LDS_BYTES);
    int dev = 0, cus = 0, per_cu = 0;
    hipGetDevice(&dev);
    hipDeviceGetAttribute(&cus, hipDeviceAttributeMultiprocessorCount, dev);
    hipOccupancyMaxActiveBlocksPerMultiprocessor(&per_cu, mega, 512, LDS_BYTES);
    if (per_cu < 1) per_cu = 1;
    grid_blocks = cus * per_cu;
    if (ws_size < (size_t)WS_TOTAL) fprintf(stderr, "workspace too small: %zu < %ld\n", ws_size, (long)WS_TOTAL);
  }
  Prm p;
  const float** pp = (const float**)&p;
  for (int i = 0; i < 29; ++i) pp[i] = (const float*)d_in[i];
  p.out = (float*)d_out;
  p.ws = (char*)d_ws;
#if MULTI
  for (int ph = 0; ph < NPHASE; ++ph) hipLaunchKernelGGL(mega, dim3(grid_blocks), dim3(512), LDS_BYTES, stream, p, ph, ph);
#else
  int lo = 0, hi = NPHASE - 1;
  hipMemsetAsync((char*)d_ws + OFF_BAR, 0, XCD_BAR_WORDS * 4, stream);
  void* args[] = {&p, &lo, &hi};
  hipError_t e = hipLaunchCooperativeKernel((void*)mega, dim3(grid_blocks), dim3(512), args, LDS_BYTES, stream);
  if (e != hipSuccess) fprintf(stderr, "cooperative launch failed: %s (grid %d)\n", hipGetErrorString(e), grid_blocks);
#endif
}
```

```cpp
#include <hip/hip_runtime.h>
#include <hip/hip_cooperative_groups.h>
#include <stdint.h>
#include <stdio.h>
namespace cg = cooperative_groups;

typedef unsigned short u16;
typedef __attribute__((ext_vector_type(8))) short bf16x8;
typedef __attribute__((ext_vector_type(4))) float f32x4;
#define MFMA(a, b, c) __builtin_amdgcn_mfma_f32_16x16x32_bf16(a, b, c, 0, 0, 0)
#define DI __device__ __forceinline__

#ifndef MULTI
#define MULTI 0
#endif

constexpr int T_LAT = 32768, T_ALL = 36864;
constexpr int NIN = 5648;
constexpr long U38 = 37748736L;
constexpr long OFF_XC = 0;
constexpr long OFF_WB = OFF_XC + 16777216L;
constexpr long OFF_HBF = OFF_WB + 43024384L;
constexpr long OFF_MOD = OFF_HBF + 75497472L;
constexpr long OFF_TAPL = OFF_MOD + 1671168L;
constexpr long OFF_TAPC = OFF_TAPL + 8388608L;
constexpr long OFF_DL = OFF_TAPC + 1048576L;
constexpr long OFF_DLC = OFF_DL + 16777216L;
constexpr long OFF_DC = OFF_DLC + 262144L;
constexpr long OFF_PDAB = OFF_DC + 65536L;
constexpr long OFF_GC = OFF_PDAB + 2359296L;
constexpr long OFF_BETA = OFF_GC + 2359296L;
constexpr long OFF_Y = OFF_BETA + 2359296L;
constexpr long OFF_AR = OFF_Y + 4 * U38;
constexpr long OFF_ROPE = OFF_AR + 7 * U38;
constexpr long OFF_BAR = OFF_ROPE + 2 * 262144L;
constexpr long WS_TOTAL = OFF_BAR + 16384L;
constexpr long WO_IN = 0, WO_G = 5783552L, WO_B = 9977856L, WO_O = 12075008L, WO_1 = 13123584L, WO_2 = 17317888L;
constexpr int LDS_BYTES = 139264;
constexpr int NPHASE = 1 + 4 * 14;

struct Prm {
  const float *x, *c, *ctx, *c_ctx, *w_ada, *b_ada, *norm1, *norm2, *w_in, *qk_gain, *lam, *subln, *hy_conv, *hy_w1,
      *hy_b1, *hy_freq, *hy_w2, *hy_b2, *hy_w3, *hy_bias, *dn_conv, *dn_a_log, *dn_dt_bias, *dn_norm, *w_gate,
      *w_branch, *w_o, *w_mlp1, *w_mlp2;
  float* out;
  char* ws;
};

DI int mytid() {
  int t = threadIdx.x;
  asm volatile("" : "+v"(t));
  return t;
}
DI int mybid() {
  int t = blockIdx.x;
  asm volatile("" : "+s"(t));
  return t;
}
DI void lds_barrier() {
  asm volatile("s_waitcnt lgkmcnt(0)" ::: "memory");
  __builtin_amdgcn_s_barrier();
  asm volatile("" ::: "memory");
}
typedef __bf16 bf16x2_t __attribute__((ext_vector_type(2)));
typedef float f32x2_t __attribute__((ext_vector_type(2)));
DI unsigned pk_bf16(float a, float b) {
  f32x2_t v = {a, b};
  bf16x2_t h = __builtin_convertvector(v, bf16x2_t);
  return *(unsigned*)&h;
}
DI u16 f2bf(float f) {
  __bf16 h = (__bf16)f;
  return *(u16*)&h;
}
DI float bf2f(u16 h) { return __uint_as_float(((unsigned)h) << 16); }
DI float wsum(float v) {
  for (int o = 32; o; o >>= 1) v += __shfl_xor(v, o);
  return v;
}
DI float wmax(float v) {
  for (int o = 32; o; o >>= 1) v = fmaxf(v, __shfl_xor(v, o));
  return v;
}
DI float siluf(float v) { return v / (1.f + __expf(-v)); }
DI float sigmf(float v) { return 1.f / (1.f + __expf(-v)); }
DI float* xrow(const Prm& p, int tok) {
  return tok < T_LAT ? p.out + (long)tok * 1024 : (float*)(p.ws + OFF_XC) + (long)(tok - T_LAT) * 1024;
}
DI int first_item(long base) {
  int G = gridDim.x;
  return (int)(((long)mybid() + G - (base % G)) % G);
}
DI int tokof(int b, int P) { return P < 256 ? T_LAT + b * 256 + P : b * 2048 + (P - 256); }

typedef __attribute__((ext_vector_type(4))) unsigned u32x4;
struct Stg { u32x4 a0, a1, a2, a3, b0, b1; };
template <int NA>
DI void g_load(Stg& r, const u16* Ap, long lda, const u16* Bp, long ldb, int k0) {
  r.a0 = *(const u32x4*)(Ap + k0);
  r.a1 = *(const u32x4*)(Ap + 64 * lda + k0);
  if constexpr (NA == 4) {
    r.a2 = *(const u32x4*)(Ap + 128 * lda + k0);
    r.a3 = *(const u32x4*)(Ap + 192 * lda + k0);
  }
  r.b0 = *(const u32x4*)(Bp + k0);
  r.b1 = *(const u32x4*)(Bp + 64 * ldb + k0);
}
template <int NA, int TM>
DI void s_store(const Stg& r, u16* ns_) {
  *(u32x4*)(ns_) = r.a0;
  *(u32x4*)(ns_ + 64 * 80) = r.a1;
  if constexpr (NA == 4) {
    *(u32x4*)(ns_ + 128 * 80) = r.a2;
    *(u32x4*)(ns_ + 192 * 80) = r.a3;
  }
  *(u32x4*)(ns_ + TM * 80) = r.b0;
  *(u32x4*)(ns_ + TM * 80 + 64 * 80) = r.b1;
}
template <int MI>
DI void t_compute(f32x4 (&acc)[MI][4], const u16* as, const u16* bs, int wm, int wn, int fr, int fq) {
#pragma unroll
  for (int ks = 0; ks < 2; ++ks) {
    bf16x8 a[MI], b[4];
#pragma unroll
    for (int mi = 0; mi < MI; ++mi) a[mi] = *(const bf16x8*)(as + (wm * MI * 16 + mi * 16 + fr) * 80 + ks * 32 + fq * 8);
#pragma unroll
    for (int ni = 0; ni < 4; ++ni) b[ni] = *(const bf16x8*)(bs + (wn * 64 + ni * 16 + fr) * 80 + ks * 32 + fq * 8);
#pragma unroll
    for (int mi = 0; mi < MI; ++mi)
#pragma unroll
      for (int ni = 0; ni < 4; ++ni) acc[mi][ni] = MFMA(b[ni], a[mi], acc[mi][ni]);
  }
}
template <int MI>
DI void gemm_tile(f32x4 (&acc)[MI][4], const u16* __restrict__ A, long lda, const u16* __restrict__ B, long ldb, int K,
                  char* smem, Stg& r0, Stg& r1, bool pre, const u16* nA, long nlda, const u16* nB, long nldb) {
  constexpr int TM = MI * 64;
  constexpr int STAGE = (TM + 128) * 80;
  constexpr int NA = TM * 8 / 512;
  u16* s = (u16*)smem;
  const int tid = mytid(), lane = tid & 63, wid = tid >> 6;
  const int wm = wid >> 1, wn = wid & 1, fr = lane & 15, fq = lane >> 4;
  const long to_a = (long)(tid >> 3), to_c = (tid & 7) * 8;
  const u16* Ap = A + to_a * lda + to_c;
  const u16* Bp = B + to_a * ldb + to_c;
  const u16* nAp = nA + to_a * nlda + to_c;
  const u16* nBp = nB + to_a * nldb + to_c;
  const int so = (tid >> 3) * 80 + (tid & 7) * 8;
#define GLOAD(r, k0) g_load<NA>(r, Ap, lda, Bp, ldb, (k0))
#define NLOAD(r, k0) g_load<NA>(r, nAp, nlda, nBp, nldb, (k0))
#define SSTORE(r, st) s_store<NA, TM>(r, s + (st) * STAGE + so)
#define COMPUTE(st) t_compute<MI>(acc, s + (st) * STAGE, s + (st) * STAGE + TM * 80, wm, wn, fr, fq)
#pragma unroll
  for (int mi = 0; mi < MI; ++mi)
#pragma unroll
    for (int ni = 0; ni < 4; ++ni) acc[mi][ni] = f32x4{0.f, 0.f, 0.f, 0.f};
  const int nk = K >> 6;
  if (!pre) {
    GLOAD(r0, 0);
    GLOAD(r1, 64);
  }
  SSTORE(r0, 0);
  lds_barrier();
  for (int kt = 0; kt < nk; kt += 2) {
    if (kt + 2 < nk) GLOAD(r0, (kt + 2) << 6);
    else if (nA) NLOAD(r0, 0);
    COMPUTE(0);
    SSTORE(r1, 1);
    lds_barrier();
    if (kt + 3 < nk) GLOAD(r1, (kt + 3) << 6);
    else if (nA) NLOAD(r1, 64);
    COMPUTE(1);
    if (kt + 2 < nk) SSTORE(r0, 0);
    lds_barrier();
  }
#undef GLOAD
#undef NLOAD
#undef SSTORE
#undef COMPUTE
}

struct TD {
  const u16* A;
  const u16* B;
  u16* C;
  long lda, ldb, ldc;
  int K;
  int mode;
  int split;
  float scale;
  int tok0, col0;
  const float* g;
};

template <int MI = 4>
DI void run_tile2(const Prm& p, const TD& d, char* smem, Stg& r0, Stg& r1, bool pre, const u16* nA, long nlda,
                 const u16* nB, long nldb);
DI void run_tile(const Prm& p, const TD& d, char* smem) {
  Stg r0, r1;
  run_tile2<4>(p, d, smem, r0, r1, false, nullptr, 0, nullptr, 0);
}
template <int MI>
DI void run_tile2(const Prm& p, const TD& d, char* smem, Stg& r0, Stg& r1, bool pre, const u16* nA, long nlda,
                 const u16* nB, long nldb) {
  f32x4 acc[MI][4];
  gemm_tile<MI>(acc, d.A, d.lda, d.B, d.ldb, d.K, smem, r0, r1, pre, nA, nlda, nB, nldb);
  const int tid = mytid(), lane = tid & 63, wid = tid >> 6;
  const int wm = wid >> 1, wn = wid & 1, fr = lane & 15, fq = lane >> 4;
  if (d.mode == 4) {
    const int which = d.col0 >> 2, h = d.col0 & 3;
    const float* gain = d.g + which * 64 + fq * 4;
    const float* RC = (const float*)(p.ws + OFF_ROPE);
    const float* RS = RC + 65536;
    u16* dstb = d.C + (which ? 18874368L : 0L);
    const float qs = which ? 1.f : 0.18033688011112042f;
#pragma unroll
    for (int mi = 0; mi < MI; ++mi) {
      const int tok = d.tok0 + wm * (MI * 16) + mi * 16 + fr;
      float ss = 0.f;
#pragma unroll
      for (int ni = 0; ni < 4; ++ni)
#pragma unroll
        for (int j = 0; j < 4; ++j) ss += acc[mi][ni][j] * acc[mi][ni][j];
      ss += __shfl_xor(ss, 16);
      ss += __shfl_xor(ss, 32);
      const float inv = rsqrtf(ss * (1.f / 64.f) + 1e-6f) * qs;
      int b, P;
      const bool lat = tok < T_LAT;
      if (lat) { b = tok >> 11; P = 256 + (tok & 2047); }
      else { b = (tok - T_LAT) >> 8; P = (tok - T_LAT) & 255; }
      float y[4][4];
#pragma unroll
      for (int ni = 0; ni < 4; ++ni) {
        float4 g4 = *(const float4*)(gain + ni * 16);
        y[ni][0] = acc[mi][ni][0] * inv * g4.x; y[ni][1] = acc[mi][ni][1] * inv * g4.y;
        y[ni][2] = acc[mi][ni][2] * inv * g4.z; y[ni][3] = acc[mi][ni][3] * inv * g4.w;
      }
      u16* dst = dstb + ((long)((b * 4 + h) * 2 + wn) * 2304 + P) * 64 + fq * 4;
#pragma unroll
      for (int ni = 0; ni < 4; ++ni) {
        float o0 = y[ni][0], o1 = y[ni][1], o2 = y[ni][2], o3 = y[ni][3];
        if (lat) {
          const int l = tok & 2047, a = ni >> 1;
          float4 c4 = *(const float4*)(RC + (l * 2 + a) * 16 + fq * 4);
          float4 s4 = *(const float4*)(RS + (l * 2 + a) * 16 + fq * 4);
          const float sg = (ni & 1) ? 1.f : -1.f;
          o0 = y[ni][0] * c4.x + sg * y[ni ^ 1][0] * s4.x;
          o1 = y[ni][1] * c4.y + sg * y[ni ^ 1][1] * s4.y;
          o2 = y[ni][2] * c4.z + sg * y[ni ^ 1][2] * s4.z;
          o3 = y[ni][3] * c4.w + sg * y[ni ^ 1][3] * s4.w;
        }
        uint2 o;
        o.x = pk_bf16(o0, o1);
        o.y = pk_bf16(o2, o3);
        *(uint2*)(dst + ni * 16) = o;
      }
    }
    return;
  }
#pragma unroll
  for (int mi = 0; mi < MI; ++mi)
#pragma unroll
    for (int ni = 0; ni < 4; ++ni) {
      int r = wm * (MI * 16) + mi * 16 + fr, c = wn * 64 + ni * 16 + fq * 4;
      f32x4 v = acc[mi][ni];
      if (d.mode == 0) {
        long ro = d.split ? ((long)(r & 127) * d.ldc + (long)(r >> 7) * d.split) : (long)r * d.ldc;
        ushort4 o;
        o.x = f2bf(v[0] * d.scale); o.y = f2bf(v[1] * d.scale); o.z = f2bf(v[2] * d.scale); o.w = f2bf(v[3] * d.scale);
        *(ushort4*)(d.C + ro + c) = o;
      } else if (d.mode == 1) {
        ushort4 o;
        float t0 = fmaxf(v[0], 0.f), t1 = fmaxf(v[1], 0.f), t2 = fmaxf(v[2], 0.f), t3 = fmaxf(v[3], 0.f);
        o.x = f2bf(t0 * t0); o.y = f2bf(t1 * t1); o.z = f2bf(t2 * t2); o.w = f2bf(t3 * t3);
        *(ushort4*)(d.C + (long)r * d.ldc + c) = o;
      } else if (d.mode == 3) {
        if (wn == 0 && ni == 0) *(float4*)((float*)d.C + (long)r * 16 + fq * 4) = float4{v[0], v[1], v[2], v[3]};
      } else {
        float4* xp = (float4*)(xrow(p, d.tok0 + r) + d.col0 + c);
        float4 g4 = *(const float4*)(d.g + d.col0 + c);
        float4 x4 = *xp;
        x4.x += g4.x * v[0]; x4.y += g4.y * v[1]; x4.z += g4.z * v[2]; x4.w += g4.w * v[3];
        *xp = x4;
      }
    }
}

DI void ph_init(const Prm& p, char* smem) {
  const long gt = (long)mybid() * 512 + mytid(), gn = (long)gridDim.x * 512;
  {
    const float4* s = (const float4*)p.x;
    float4* d = (float4*)p.out;
    for (long i = gt; i < 32768L * 256; i += gn) d[i] = s[i];
    const float4* s2 = (const float4*)p.ctx;
    float4* d2 = (float4*)(p.ws + OFF_XC);
    for (long i = gt; i < 4096L * 256; i += gn) d2[i] = s2[i];
  }
  {
    u16* DL = (u16*)(p.ws + OFF_DL);
    for (long i = gt; i < 2048L * 4096; i += gn) {
      int l = (int)(i >> 12), kk = (int)(i & 4095), lp = kk & 2047, part = kk >> 11;
      int m = (l * lp) & 2047;
      float ang = (float)m * (6.283185307179586f / 2048.f);
      DL[i] = f2bf(part ? -sinf(ang) : cosf(ang));
    }
    u16* DLC = (u16*)(p.ws + OFF_DLC);
    for (long i = gt; i < 256L * 512; i += gn) {
      int l = (int)(i >> 9), kk = (int)(i & 511), lp = kk & 255, part = kk >> 8;
      int m = (l * lp) & 255;
      float ang = (float)m * (6.283185307179586f / 256.f);
      DLC[i] = f2bf(part ? -sinf(ang) : cosf(ang));
    }
    {
      float* RC = (float*)(p.ws + OFF_ROPE);
      float* RS = RC + 65536;
      for (long i = gt; i < 65536; i += gn) {
        int l = (int)(i >> 5), a = (int)(i >> 4) & 1, f = (int)(i & 15);
        float pos = a ? (float)(l & 63) : (float)(l >> 6);
        float ang = pos * powf(10000.f, -(float)f / 16.f);
        RC[i] = cosf(ang);
        RS[i] = sinf(ang);
      }
    }
    u16* DC = (u16*)(p.ws + OFF_DC);
    for (long i = gt; i < 256L * 128; i += gn) {
      int j2 = (int)(i >> 7), ii = (int)(i & 127), part = j2 >> 7, j = j2 & 127;
      int m = (ii * j) & 127;
      float ang = (float)m * (6.283185307179586f / 128.f);
      DC[i] = f2bf(part ? sinf(ang) : cosf(ang));
    }
  }
  float* sc = (float*)smem;
  float* red = sc + 17 * 1024;
  const int tid = mytid();
  for (int e = tid; e < 17 * 1024; e += 512) {
    int bb = e >> 10, k = e & 1023;
    float v = bb < 16 ? p.c[bb * 1024 + k] : p.c_ctx[k];
    sc[e] = v / (1.f + expf(-v));
  }
  __syncthreads();
  float* MOD = (float*)(p.ws + OFF_MOD);
  for (int it = mybid(); it < 192; it += gridDim.x) {
    int li = it / 48, cgp = it % 48;
    int cl = tid & 127, kq = tid >> 7, n = cgp * 128 + cl;
    float a[17];
#pragma unroll
    for (int b = 0; b < 17; ++b) a[b] = 0.f;
    const float* w = p.w_ada + ((long)li * 1024 + kq * 256) * 6144 + n;
#pragma unroll 2
    for (int k = 0; k < 256; ++k) {
      float wv = w[(long)k * 6144];
#pragma unroll
      for (int b = 0; b < 17; ++b) a[b] += sc[b * 1024 + kq * 256 + k] * wv;
    }
#pragma unroll
    for (int b = 0; b < 17; ++b) red[(kq * 17 + b) * 128 + cl] = a[b];
    __syncthreads();
    for (int e = tid; e < 17 * 128; e += 512) {
      int b = e >> 7, c2 = e & 127, n2 = cgp * 128 + c2;
      float v = p.b_ada[li * 6144 + n2];
      for (int q = 0; q < 4; ++q) v += red[(q * 17 + b) * 128 + c2];
      MOD[((long)li * 17 + b) * 6144 + n2] = v;
    }
    __syncthreads();
  }
}

DI long tr_job(long base, const float* src, int K, int N, u16* dst, int nb, char* smem) {
  float* t = (float*)smem;
  const int tk = K >> 6, tn = (N + 63) >> 6, per = tk * tn, total = per * nb;
  const int tid = mytid();
  const int G = gridDim.x;
  float v[8];
  int it = first_item(base);
  if (it < total) {
    int b = it / per, r = it % per, kt = r / tn, nt = r % tn;
    const float* s = src + (long)b * K * N;
#pragma unroll
    for (int i = 0; i < 8; ++i) {
      int id = tid + i * 512, kk = id >> 6, nn = id & 63;
      v[i] = (nt * 64 + nn < N) ? s[(long)(kt * 64 + kk) * N + nt * 64 + nn] : 0.f;
    }
  }
  for (; it < total; it += G) {
    int b = it / per, r = it % per, kt = r / tn, nt = r % tn;
    u16* d = dst + (long)b * K * N;
    int k0 = kt * 64, n0 = nt * 64;
#pragma unroll
    for (int i = 0; i < 8; ++i) {
      int id = tid + i * 512, kk = id >> 6, nn = id & 63;
      t[kk * 65 + nn] = v[i];
    }
    __syncthreads();
    if (it + G < total) {
      int it2 = it + G, b2 = it2 / per, r2 = it2 % per, kt2 = r2 / tn, nt2 = r2 % tn;
      const float* s2 = src + (long)b2 * K * N;
#pragma unroll
      for (int i = 0; i < 8; ++i) {
        int id = tid + i * 512, kk = id >> 6, nn = id & 63;
        v[i] = (nt2 * 64 + nn < N) ? s2[(long)(kt2 * 64 + kk) * N + nt2 * 64 + nn] : 0.f;
      }
    }
#pragma unroll
    for (int i = 0; i < 8; ++i) {
      int id = tid + i * 512, nn = id >> 6, kk = id & 63;
      if (n0 + nn < N) d[(long)(n0 + nn) * K + k0 + kk] = f2bf(t[kk * 65 + nn]);
    }
    __syncthreads();
  }
  return base + total;
}

DI void ph_norm(const Prm& p, int li, int which) {
  const int lane = mytid() & 63;
  const int gw = mybid() * 8 + (mytid() >> 6), nw = gridDim.x * 8;
  const float* nwt = (which ? p.norm2 : p.norm1) + li * 1024;
  const float* MOD = (const float*)(p.ws + OFF_MOD);
  u16* H = (u16*)(p.ws + OFF_HBF);
  const int nrows = (which && li == 3) ? T_LAT : T_ALL;
  for (int row = gw; row < nrows; row += 2 * nw) {
    const int row2 = row + nw;
    const bool has2 = row2 < nrows;
    const float* xr = xrow(p, row);
    const float* xr2 = xrow(p, has2 ? row2 : row);
    float4 v[4], u[4];
    float ss = 0.f, ss2 = 0.f;
#pragma unroll
    for (int i = 0; i < 4; ++i) {
      v[i] = *(const float4*)(xr + i * 256 + lane * 4);
      u[i] = *(const float4*)(xr2 + i * 256 + lane * 4);
    }
#pragma unroll
    for (int i = 0; i < 4; ++i) {
      ss += v[i].x * v[i].x + v[i].y * v[i].y + v[i].z * v[i].z + v[i].w * v[i].w;
      ss2 += u[i].x * u[i].x + u[i].y * u[i].y + u[i].z * u[i].z + u[i].w * u[i].w;
    }
#pragma unroll
    for (int o = 32; o; o >>= 1) {
      ss += __shfl_xor(ss, o);
      ss2 += __shfl_xor(ss2, o);
    }
    const float inv = rsqrtf(ss * (1.f / 1024.f) + 1e-6f), inv2 = rsqrtf(ss2 * (1.f / 1024.f) + 1e-6f);
    const int bb = row < T_LAT ? (row >> 11) : 16, bb2 = row2 < T_LAT ? (row2 >> 11) : 16;
    const float* sh = MOD + ((long)li * 17 + bb) * 6144 + (which ? 3 : 0) * 1024;
    const float* sh2 = MOD + ((long)li * 17 + (has2 ? bb2 : bb)) * 6144 + (which ? 3 : 0) * 1024;
#pragma unroll
    for (int i = 0; i < 4; ++i) {
      int c = i * 256 + lane * 4;
      float4 w4 = *(const float4*)(nwt + c);
      {
        float4 s4 = *(const float4*)(sh + 1024 + c), h4 = *(const float4*)(sh + c);
        uint2 o;
        o.x = pk_bf16(v[i].x * inv * w4.x * (1.f + s4.x) + h4.x, v[i].y * inv * w4.y * (1.f + s4.y) + h4.y);
        o.y = pk_bf16(v[i].z * inv * w4.z * (1.f + s4.z) + h4.z, v[i].w * inv * w4.w * (1.f + s4.w) + h4.w);
        *(uint2*)(H + (long)row * 1024 + c) = o;
      }
      if (has2) {
        float4 s4 = *(const float4*)(sh2 + 1024 + c), h4 = *(const float4*)(sh2 + c);
        uint2 o;
        o.x = pk_bf16(u[i].x * inv2 * w4.x * (1.f + s4.x) + h4.x, u[i].y * inv2 * w4.y * (1.f + s4.y) + h4.y);
        o.y = pk_bf16(u[i].z * inv2 * w4.z * (1.f + s4.z) + h4.z, u[i].w * inv2 * w4.w * (1.f + s4.w) + h4.w);
        *(uint2*)(H + (long)row2 * 1024 + c) = o;
      }
    }
  }
}

DI void ph_taps1(const Prm& p, int li, long base, char* smem) {
  float* f = (float*)smem;
  float* hraw = (float*)(p.ws + OFF_AR + 5 * U38);
  const int tid = mytid();
  for (int it = first_item(base); it < 288; it += gridDim.x) {
    const int L = it < 256 ? 2048 : 256, j0 = it < 256 ? it * 8 : (it - 256) * 8;
    const int lg = tid >> 6, kk = tid & 63;
    if (tid < 8 * 33) {
      int l2 = tid / 33, e = tid % 33, j = j0 + l2;
      float t = (float)j / (float)(L - 1);
      float w = 6.283185307179586f * (float)j / (float)L;
      float v;
      if (e == 0) v = t;
      else {
        int bi = (e - 1) & 15;
        float band = 1e-4f + (float)bi * ((15.f - 1e-4f) / 15.f);
        v = (e <= 16) ? cosf(band * w) : -sinf(band * w);
      }
      f[l2 * 40 + e] = v;
    }
    __syncthreads();
    {
      float v = p.hy_b1[li * 64 + kk];
#pragma unroll 3
      for (int e = 0; e < 33; ++e) v += f[lg * 40 + e] * p.hy_w1[(li * 33 + e) * 64 + kk];
      f[320 + lg * 64 + kk] = sinf(p.hy_freq[(li * 2 + 0) * 64 + kk] * v);
    }
    __syncthreads();
    {
      float v = p.hy_b2[li * 64 + kk];
#pragma unroll 4
      for (int m = 0; m < 64; ++m) v += f[320 + lg * 64 + m] * p.hy_w2[(li * 64 + m) * 64 + kk];
      f[832 + lg * 64 + kk] = sinf(p.hy_freq[(li * 2 + 1) * 64 + kk] * v);
    }
    __syncthreads();
    {
      float h[4][8];
#pragma unroll
      for (int i = 0; i < 4; ++i)
#pragma unroll
        for (int l2 = 0; l2 < 8; ++l2) h[i][l2] = 0.f;
      const float* w3 = p.hy_w3 + (long)li * 64 * 2048 + tid;
#pragma unroll 2
      for (int k = 0; k < 64; ++k) {
        float wv[4];
#pragma unroll
        for (int i = 0; i < 4; ++i) wv[i] = w3[(long)k * 2048 + i * 512];
#pragma unroll
        for (int l2 = 0; l2 < 8; ++l2) {
          float hv = f[832 + l2 * 64 + k];
#pragma unroll
          for (int i = 0; i < 4; ++i) h[i][l2] += hv * wv[i];
        }
      }
#pragma unroll
      for (int i = 0; i < 4; ++i) {
        int n = tid + i * 512, ch = n & 511;
        float delta = fabsf(-3.0701134573253946f + (float)ch * ((-15.350567286626973f + 3.0701134573253946f) / 511.f));
#pragma unroll
        for (int l2 = 0; l2 < 8; ++l2) {
          int j = j0 + l2;
          float t = (float)j / (float)(L - 1);
          long row = (it < 256) ? j : 2048 + j;
          hraw[row * 2048 + n] = h[i][l2] * expf(-t * delta);
        }
      }
    }
    __syncthreads();
  }
}
DI void ph_taps2(const Prm& p, long base, char* smem) {
  float* vals = (float*)smem;
  float* red = vals + 8 * 2048;
  const float* hraw = (const float*)(p.ws + OFF_AR + 5 * U38);
  const int tid = mytid(), cl = tid & 3, dir = (tid >> 2) & 1, jg = tid >> 3;
  for (int it = first_item(base); it < 512; it += gridDim.x) {
    int ls = it >> 8, order = (it >> 7) & 1, cgp = it & 127;
    int L = ls ? 256 : 2048;
    const float* hr = hraw + (long)(ls ? 2048 : 0) * 2048;
    u16* G = (u16*)(p.ws + (ls ? OFF_TAPC : OFF_TAPL));
    int ch = cgp * 4 + cl, n = order * 1024 + dir * 512 + ch;
    float s = 0.f;
#pragma unroll 8
    for (int j = jg; j < L; j += 64) {
      float v = hr[(long)j * 2048 + n];
      vals[(cl * 2 + dir) * L + j] = v;
      s += (dir == 1 && j == 0) ? 0.f : fabsf(v);
    }
    red[(tid >> 2) * 4 + cl] = s;
    __syncthreads();
    if (tid < 4) {
      float tot = 0.f;
#pragma unroll 8
      for (int r = 0; r < 128; ++r) tot += red[r * 4 + tid];
      red[512 + tid] = 1.f / tot;
    }
    __syncthreads();
    for (int idx = tid; idx < 8 * L; idx += 512) {
      int q = idx / L, j = idx % L, c2 = q >> 1, d2 = q & 1;
      float v = vals[idx] * red[512 + c2];
      u16* g = G + (long)(order * 512 + cgp * 4 + c2) * (2 * L);
      if (d2 == 0) g[L + j] = f2bf(v);
      else if (j > 0) g[L - j] = f2bf(v);
      else g[0] = 0;
    }
    __syncthreads();
  }
}

DI void ph_pdab(const Prm& p, int li, char* smem) {
  float* wl = (float*)smem;
  const int tid = mytid(), lane = tid & 63;
#pragma unroll 8
  for (int e = tid; e < 1024 * 16; e += 512) wl[e] = p.w_in[((long)li * 1024 + (e >> 4)) * NIN + 5632 + (e & 15)];
  __syncthreads();
  const u16* H = (const u16*)(p.ws + OFF_HBF);
  float* out = (float*)(p.ws + OFF_PDAB);
  const int gw = mybid() * 8 + (tid >> 6), nw = gridDim.x * 8;
  for (int tok = gw; tok < T_ALL; tok += nw) {
    float a[16];
#pragma unroll
    for (int j = 0; j < 16; ++j) a[j] = 0.f;
    float hv[16];
#pragma unroll
    for (int i = 0; i < 16; ++i) hv[i] = bf2f(H[(long)tok * 1024 + lane + i * 64]);
#pragma unroll
    for (int i = 0; i < 16; ++i) {
      float h = hv[i];
      const float4* wp = (const float4*)(wl + (lane + i * 64) * 16);
#pragma unroll
      for (int q = 0; q < 4; ++q) {
        float4 w4 = wp[q];
        a[q * 4 + 0] += h * w4.x;
        a[q * 4 + 1] += h * w4.y;
        a[q * 4 + 2] += h * w4.z;
        a[q * 4 + 3] += h * w4.w;
      }
      if ((i & 3) == 3) asm volatile("" ::: "memory");
    }
#pragma unroll
    for (int o = 32; o; o >>= 1)
#pragma unroll
      for (int j = 0; j < 16; ++j) a[j] += __shfl_xor(a[j], o);
    float v = a[0];
#pragma unroll
    for (int j = 1; j < 16; ++j) v = (lane == j) ? a[j] : v;
    if (lane < 16) out[(long)tok * 16 + lane] = v;
  }
  __syncthreads();
}

DI void ph_dncl(const Prm& p, int li, char* smem) {
  const int tid = mytid(), lane = tid & 63, wid = tid >> 6, fr = lane & 15, fq = lane >> 4;
  u16* qn = (u16*)smem;
  u16* kn = qn + 64 * 144;
  float* fb = (float*)(smem + 36864);
  float* KK = fb;
  float* QK = KK + 64 * 65;
  float* Am = QK + 64 * 65;
  float* Tm = Am + 2 * 64 * 65;
  float* gcs = Tm + 2 * 64 * 65;
  float* bts = gcs + 128;
  const u16* PD = (const u16*)(p.ws + OFF_AR);
  const float* AB = (const float*)(p.ws + OFF_PDAB);
  u16* DQ = (u16*)(p.ws + OFF_Y);
  u16* DK = DQ + 18874368L;
  u16* DV = DK + 18874368L;
  u16* CL = (u16*)(p.ws + OFF_AR + 3 * U38);
  float* GC = (float*)(p.ws + OFF_GC);
  float* BT = (float*)(p.ws + OFF_BETA);
  const float* cw = p.dn_conv + (long)li * 3 * 1536;
  for (int it = mybid(); it < 2304; it += gridDim.x) {
    const int b = it / 144, r0 = it % 144, oc = r0 >> 2, h = r0 & 3;
    const int pos0 = oc * 64, s0 = oc < 4 ? 0 : 256, e0 = oc < 4 ? 256 : 2304;
    if (tid < 384) {
      const int cgp = tid % 48, rs = tid / 48;
      const int part = cgp >> 4, d0 = (cgp & 15) * 8, col = part * 512 + h * 128 + d0;
      const u16* basep = PD + (long)tokof(b, pos0) * 1536 + col;
      float wt[3][8];
#pragma unroll
      for (int tp = 0; tp < 3; ++tp) {
        float4 wa = *(const float4*)(cw + tp * 1536 + col), wb = *(const float4*)(cw + tp * 1536 + col + 4);
        wt[tp][0] = wa.x; wt[tp][1] = wa.y; wt[tp][2] = wa.z; wt[tp][3] = wa.w;
        wt[tp][4] = wb.x; wt[tp][5] = wb.y; wt[tp][6] = wb.z; wt[tp][7] = wb.w;
      }
#pragma unroll 1
      for (int hf = 0; hf < 2; ++hf) {
        u32x4 rw[6];
#pragma unroll
        for (int i = 0; i < 6; ++i) {
          int j = rs * 8 + hf * 4 - 1 + i, P = pos0 + j;
          rw[i] = (P >= s0 && P < e0) ? *(const u32x4*)(basep + (long)j * 1536) : u32x4{0u, 0u, 0u, 0u};
        }
#pragma unroll
        for (int r = 0; r < 4; ++r) {
#pragma unroll
          for (int e = 0; e < 8; ++e) {
            unsigned w0_ = rw[r][e >> 1], w1_ = rw[r + 1][e >> 1], w2_ = rw[r + 2][e >> 1];
            float x0 = (e & 1) ? __uint_as_float(w0_ & 0xffff0000u) : __uint_as_float(w0_ << 16);
            float x1 = (e & 1) ? __uint_as_float(w1_ & 0xffff0000u) : __uint_as_float(w1_ << 16);
            float x2 = (e & 1) ? __uint_as_float(w2_ & 0xffff0000u) : __uint_as_float(w2_ << 16);
            float v = wt[0][e] * x0 + wt[1][e] * x1 + wt[2][e] * x2;
            fb[(rs * 8 + hf * 4 + r) * 385 + part * 128 + d0 + e] = v * __builtin_amdgcn_rcpf(1.f + __expf(-v));
          }
        }
      }
    }
    __syncthreads();
    for (int jj = 0; jj < 8; ++jj) {
      int j = wid * 8 + jj, P = pos0 + j;
      long go = ((long)(b * 4 + h) * 2304 + P) * 128;
      float q0 = fb[j * 385 + lane], q1 = fb[j * 385 + 64 + lane];
      float k0 = fb[j * 385 + 128 + lane], k1 = fb[j * 385 + 192 + lane];
      float v0 = fb[j * 385 + 256 + lane], v1 = fb[j * 385 + 320 + lane];
      float iq = rsqrtf(wsum(q0 * q0 + q1 * q1) + 1e-6f), ik = rsqrtf(wsum(k0 * k0 + k1 * k1) + 1e-6f);
      u16 a0 = f2bf(q0 * iq), a1 = f2bf(q1 * iq), c0 = f2bf(k0 * ik), c1 = f2bf(k1 * ik);
      qn[j * 144 + lane] = a0; qn[j * 144 + 64 + lane] = a1;
      kn[j * 144 + lane] = c0; kn[j * 144 + 64 + lane] = c1;
      DQ[go + lane] = a0; DQ[go + 64 + lane] = a1;
      DK[go + lane] = c0; DK[go + 64 + lane] = c1;
      DV[go + lane] = f2bf(v0); DV[go + 64 + lane] = f2bf(v1);
    }
    __syncthreads();
#pragma unroll
    for (int u = 0; u < 4; ++u) {
      int tt = wid * 4 + u, which = tt >> 4, ti = (tt >> 2) & 3, tj = tt & 3;
      const u16* Ap = (which ? qn : kn) + (ti * 16 + fr) * 144 + fq * 8;
      const u16* Bp = kn + (tj * 16 + fr) * 144 + fq * 8;
      f32x4 a = {0.f, 0.f, 0.f, 0.f};
#pragma unroll
      for (int ks = 0; ks < 4; ++ks) a = MFMA(*(const bf16x8*)(Ap + ks * 32), *(const bf16x8*)(Bp + ks * 32), a);
      float* dst = which ? QK : KK;
#pragma unroll
      for (int j = 0; j < 4; ++j) dst[(ti * 16 + fq * 4 + j) * 65 + tj * 16 + fr] = a[j];
    }
    if (tid < 128) {
      int d = tid >> 6, r = tid & 63, j = d ? 63 - r : r;
      int tok = tokof(b, pos0 + j);
      float av = AB[(long)tok * 16 + d * 4 + h], bv = AB[(long)tok * 16 + 8 + d * 4 + h];
      float xx = av + p.dn_dt_bias[li * 8 + d * 4 + h];
      float sp = fmaxf(xx, 0.f) + __logf(1.f + __expf(-fabsf(xx)));
      float g = -expf(p.dn_a_log[li * 8 + d * 4 + h]) * sp;
      for (int o = 1; o < 64; o <<= 1) {
        float t = __shfl_up(g, o);
        if (r >= o) g += t;
      }
      float be = 1.f / (1.f + expf(-bv));
      gcs[d * 64 + r] = g;
      bts[d * 64 + r] = be;
      long ci = ((long)((b * 4 + h) * 2 + d) * 36 + oc) * 64 + r;
      GC[ci] = g;
      BT[ci] = be;
    }
    __syncthreads();
#pragma unroll 4
    for (int e = tid; e < 8192; e += 512) {
      int d = e >> 12, s = (e >> 6) & 63, r = e & 63;
      int j = d ? 63 - r : r, js = d ? 63 - s : s;
      float v = 0.f;
      if (r > s) v = bts[d * 64 + r] * KK[j * 65 + js] * __expf(gcs[d * 64 + r] - gcs[d * 64 + s]);
      Am[(d * 64 + s) * 64 + r] = v;
    }
#pragma unroll 4
    for (int e = tid; e < 8192; e += 512) {
      int d = e >> 12, r = (e >> 6) & 63, s = e & 63;
      int j = d ? 63 - r : r, js = d ? 63 - s : s;
      float dec = (r >= s) ? __expf(gcs[d * 64 + r] - gcs[d * 64 + s]) : 0.f;
      long ci = (long)((b * 4 + h) * 2 + d) * 36 + oc;
      CL[ci * 8192 + 4096 + r * 64 + s] = f2bf(QK[j * 65 + js] * dec * 0.08838834764831845f);
    }
    __syncthreads();
    {
      const int d = tid >> 8, c = (tid >> 2) & 63, q = tid & 3;
      const float* Atq = Am + d * 64 * 64 + q;
      float* T = Tm + d * 64 * 65;
      float t[16];
#pragma unroll
      for (int i = 0; i < 16; ++i) t[i] = (4 * i + q == c) ? 1.f : 0.f;
#pragma unroll
      for (int s2 = 0; s2 < 63; ++s2) {
        constexpr int dummy = 0;
        const int is = s2 >> 2, qs = s2 & 3;
        const int ctl = qs | (qs << 2) | (qs << 4) | (qs << 6);
        int tsb;
        if (qs == 0) tsb = __builtin_amdgcn_update_dpp(0, __float_as_int(t[is]), 0x00, 0xf, 0xf, false);
        else if (qs == 1) tsb = __builtin_amdgcn_update_dpp(0, __float_as_int(t[is]), 0x55, 0xf, 0xf, false);
        else if (qs == 2) tsb = __builtin_amdgcn_update_dpp(0, __float_as_int(t[is]), 0xAA, 0xf, 0xf, false);
        else tsb = __builtin_amdgcn_update_dpp(0, __float_as_int(t[is]), 0xFF, 0xf, 0xf, false);
        (void)ctl; (void)dummy;
        const float ts = __int_as_float(tsb);
#pragma unroll
        for (int i = is; i < 16; ++i) t[i] -= Atq[s2 * 64 + 4 * i] * ts;
        if ((s2 & 7) == 7) asm volatile("" ::: "memory");
      }
#pragma unroll
      for (int i = 0; i < 16; ++i) T[(4 * i + q) * 65 + c] = t[i];
    }
    __syncthreads();
    for (int e = tid; e < 8192; e += 512) {
      int d = e >> 12, rc = e & 4095;
      long ci = (long)((b * 4 + h) * 2 + d) * 36 + oc;
      CL[ci * 8192 + rc] = f2bf(Tm[(d * 64 + (rc >> 6)) * 65 + (rc & 63)]);
    }
    __syncthreads();
  }
}

DI void ph_dnscan(const Prm& p, char* smem) {
  const int tid = mytid(), lane = tid & 63, wid = tid >> 6, fr = lane & 15, fq = lane >> 4;
  u16* Kg = (u16*)smem;
  u16* Qg = Kg + 64 * 144;
  u16* KdT = Qg + 64 * 144;
  u16* Tl = KdT + 128 * 80;
  u16* Il = Tl + 64 * 80;
  u16* ST = Il + 64 * 80;
  u16* RT = ST + 64 * 144;
  u16* VN = RT + 64 * 80;
  const u16* DQ = (const u16*)(p.ws + OFF_Y);
  const u16* DK = DQ + 18874368L;
  const u16* DV = DK + 18874368L;
  const u16* CL = (const u16*)(p.ws + OFF_AR + 3 * U38);
  const float* GC = (const float*)(p.ws + OFF_GC);
  const float* BT = (const float*)(p.ws + OFF_BETA);
  const int vt = wid & 3, rp = wid >> 2;
  for (int it = mybid(); it < 256; it += gridDim.x) {
    const int b = it >> 4, h = (it >> 2) & 3, d = (it >> 1) & 1, vs = it & 1;
    u16* O = (u16*)(p.ws + OFF_AR + (d ? 6 : 5) * U38);
    f32x4 S[4];
#pragma unroll
    for (int i = 0; i < 4; ++i) S[i] = f32x4{0.f, 0.f, 0.f, 0.f};
    for (int e = tid; e < 64 * 144; e += 512) ST[e] = 0;
    const long seqb = (long)(b * 4 + h) * 2304;
    const long cib = (long)((b * 4 + h) * 2 + d) * 36;
    u32x4 rk0, rk1, rq0, rq1, rT, rI;
    float rg0, rg1, rgl;
    uint2 rv0, rv1;
    float rb0, rb1;
    const int lr0 = tid >> 4, lr1 = (tid + 512) >> 4, lch = tid & 15;
    const int lj0 = d ? 63 - lr0 : lr0, lj1 = d ? 63 - lr1 : lr1;
    const int vr0 = (rp * 2) * 16 + fr, vr1 = (rp * 2 + 1) * 16 + fr;
    const int vj0 = d ? 63 - vr0 : vr0, vj1 = d ? 63 - vr1 : vr1;
#define SCAN_LOAD_KQ(ocx)                                                                    \
  {                                                                                          \
    const long ci_ = cib + (ocx);                                                            \
    const long g0_ = (seqb + (ocx) * 64 + lj0) * 128 + lch * 8, g1_ = (seqb + (ocx) * 64 + lj1) * 128 + lch * 8; \
    rk0 = *(const u32x4*)(DK + g0_); rk1 = *(const u32x4*)(DK + g1_);                        \
    rq0 = *(const u32x4*)(DQ + g0_); rq1 = *(const u32x4*)(DQ + g1_);                        \
    rT = *(const u32x4*)(CL + ci_ * 8192 + (tid >> 3) * 64 + (tid & 7) * 8);                 \
    rI = *(const u32x4*)(CL + ci_ * 8192 + 4096 + (tid >> 3) * 64 + (tid & 7) * 8);          \
    rg0 = GC[ci_ * 64 + lr0]; rg1 = GC[ci_ * 64 + lr1]; rgl = GC[ci_ * 64 + 63];             \
  }
#define SCAN_LOAD_V(ocx)                                                                     \
  {                                                                                          \
    const long ci_ = cib + (ocx);                                                            \
    rv0 = *(const uint2*)(DV + (seqb + (ocx) * 64 + vj0) * 128 + vs * 64 + vt * 16 + fq * 4); \
    rv1 = *(const uint2*)(DV + (seqb + (ocx) * 64 + vj1) * 128 + vs * 64 + vt * 16 + fq * 4); \
    rb0 = BT[ci_ * 64 + vr0]; rb1 = BT[ci_ * 64 + vr1];                                      \
  }
    {
      const int oc0 = d ? 3 : 0;
      SCAN_LOAD_KQ(oc0);
      SCAN_LOAD_V(oc0);
    }
    for (int i = 0; i < 36; ++i) {
      const int oc = d ? (i < 4 ? 3 - i : 39 - i) : i;
      const int ocn = d ? (i + 1 < 4 ? 3 - (i + 1) : 39 - (i + 1)) : i + 1;
      const int pos0 = oc * 64;
      const float gl = rgl;
      {
        float eg0 = __expf(rg0), ed0 = __expf(gl - rg0), eg1 = __expf(rg1), ed1 = __expf(gl - rg1);
        u32x4 ko0, qo0, ko1, qo1;
#pragma unroll
        for (int w = 0; w < 4; ++w) {
          float k0l = __uint_as_float(rk0[w] << 16), k0h = __uint_as_float(rk0[w] & 0xffff0000u);
          float q0l = __uint_as_float(rq0[w] << 16), q0h = __uint_as_float(rq0[w] & 0xffff0000u);
          float k1l = __uint_as_float(rk1[w] << 16), k1h = __uint_as_float(rk1[w] & 0xffff0000u);
          float q1l = __uint_as_float(rq1[w] << 16), q1h = __uint_as_float(rq1[w] & 0xffff0000u);
          ko0[w] = (unsigned)f2bf(k0l * eg0) | ((unsigned)f2bf(k0h * eg0) << 16);
          qo0[w] = (unsigned)f2bf(q0l * eg0 * 0.08838834764831845f) | ((unsigned)f2bf(q0h * eg0 * 0.08838834764831845f) << 16);
          ko1[w] = (unsigned)f2bf(k1l * eg1) | ((unsigned)f2bf(k1h * eg1) << 16);
          qo1[w] = (unsigned)f2bf(q1l * eg1 * 0.08838834764831845f) | ((unsigned)f2bf(q1h * eg1 * 0.08838834764831845f) << 16);
          KdT[(lch * 8 + 2 * w) * 80 + lr0] = f2bf(k0l * ed0);
          KdT[(lch * 8 + 2 * w + 1) * 80 + lr0] = f2bf(k0h * ed0);
          KdT[(lch * 8 + 2 * w) * 80 + lr1] = f2bf(k1l * ed1);
          KdT[(lch * 8 + 2 * w + 1) * 80 + lr1] = f2bf(k1h * ed1);
        }
        *(u32x4*)(Kg + lr0 * 144 + lch * 8) = ko0;
        *(u32x4*)(Qg + lr0 * 144 + lch * 8) = qo0;
        *(u32x4*)(Kg + lr1 * 144 + lch * 8) = ko1;
        *(u32x4*)(Qg + lr1 * 144 + lch * 8) = qo1;
        *(u32x4*)(Tl + (tid >> 3) * 80 + (tid & 7) * 8) = rT;
        *(u32x4*)(Il + (tid >> 3) * 80 + (tid & 7) * 8) = rI;
      }
      lds_barrier();
      if (i + 1 < 36) SCAN_LOAD_KQ(ocn);
      f32x4 ks_[2], qs_[2];
#pragma unroll
      for (int u = 0; u < 2; ++u) { ks_[u] = f32x4{0.f, 0.f, 0.f, 0.f}; qs_[u] = f32x4{0.f, 0.f, 0.f, 0.f}; }
#pragma unroll
      for (int kk = 0; kk < 4; ++kk) {
        bf16x8 a = *(const bf16x8*)(ST + (vt * 16 + fr) * 144 + kk * 32 + fq * 8);
#pragma unroll
        for (int u = 0; u < 2; ++u) {
          int rt = rp * 2 + u;
          bf16x8 bk = *(const bf16x8*)(Kg + (rt * 16 + fr) * 144 + kk * 32 + fq * 8);
          bf16x8 bq = *(const bf16x8*)(Qg + (rt * 16 + fr) * 144 + kk * 32 + fq * 8);
          ks_[u] = MFMA(a, bk, ks_[u]);
          qs_[u] = MFMA(a, bq, qs_[u]);
        }
      }
      {
        int v0 = vt * 16 + fq * 4;
        RT[(v0 + 0) * 80 + vr0] = f2bf(rb0 * (__uint_as_float(rv0.x << 16) - ks_[0][0]));
        RT[(v0 + 1) * 80 + vr0] = f2bf(rb0 * (__uint_as_float(rv0.x & 0xffff0000u) - ks_[0][1]));
        RT[(v0 + 2) * 80 + vr0] = f2bf(rb0 * (__uint_as_float(rv0.y << 16) - ks_[0][2]));
        RT[(v0 + 3) * 80 + vr0] = f2bf(rb0 * (__uint_as_float(rv0.y & 0xffff0000u) - ks_[0][3]));
        RT[(v0 + 0) * 80 + vr1] = f2bf(rb1 * (__uint_as_float(rv1.x << 16) - ks_[1][0]));
        RT[(v0 + 1) * 80 + vr1] = f2bf(rb1 * (__uint_as_float(rv1.x & 0xffff0000u) - ks_[1][1]));
        RT[(v0 + 2) * 80 + vr1] = f2bf(rb1 * (__uint_as_float(rv1.y << 16) - ks_[1][2]));
        RT[(v0 + 3) * 80 + vr1] = f2bf(rb1 * (__uint_as_float(rv1.y & 0xffff0000u) - ks_[1][3]));
      }
      if (i + 1 < 36) SCAN_LOAD_V(ocn);
      lds_barrier();
      {
        f32x4 vn[2];
#pragma unroll
        for (int u = 0; u < 2; ++u) vn[u] = f32x4{0.f, 0.f, 0.f, 0.f};
#pragma unroll
        for (int kk = 0; kk < 2; ++kk) {
          bf16x8 a = *(const bf16x8*)(RT + (vt * 16 + fr) * 80 + kk * 32 + fq * 8);
#pragma unroll
          for (int u = 0; u < 2; ++u) {
            bf16x8 bb = *(const bf16x8*)(Tl + ((rp * 2 + u) * 16 + fr) * 80 + kk * 32 + fq * 8);
            vn[u] = MFMA(a, bb, vn[u]);
          }
        }
#pragma unroll
        for (int u = 0; u < 2; ++u) {
          int r = (rp * 2 + u) * 16 + fr, v0 = vt * 16 + fq * 4;
#pragma unroll
          for (int j = 0; j < 4; ++j) VN[(v0 + j) * 80 + r] = f2bf(vn[u][j]);
        }
      }
      lds_barrier();
#pragma unroll
      for (int kk = 0; kk < 2; ++kk) {
        bf16x8 a = *(const bf16x8*)(VN + (vt * 16 + fr) * 80 + kk * 32 + fq * 8);
#pragma unroll
        for (int u = 0; u < 2; ++u) {
          bf16x8 bb = *(const bf16x8*)(Il + ((rp * 2 + u) * 16 + fr) * 80 + kk * 32 + fq * 8);
          qs_[u] = MFMA(a, bb, qs_[u]);
        }
      }
#pragma unroll
      for (int u = 0; u < 2; ++u) {
        int r = (rp * 2 + u) * 16 + fr, j = d ? 63 - r : r;
        u16* op = O + (long)tokof(b, pos0 + j) * 512 + h * 128 + vs * 64 + vt * 16 + fq * 4;
        ushort4 ov4;
        ov4.x = f2bf(qs_[u][0]); ov4.y = f2bf(qs_[u][1]); ov4.z = f2bf(qs_[u][2]); ov4.w = f2bf(qs_[u][3]);
        *(ushort4*)op = ov4;
      }
      {
        float ge = __expf(gl);
#pragma unroll
        for (int u = 0; u < 4; ++u) S[u] *= ge;
#pragma unroll
        for (int kk = 0; kk < 2; ++kk) {
          bf16x8 a = *(const bf16x8*)(VN + (vt * 16 + fr) * 80 + kk * 32 + fq * 8);
#pragma unroll
          for (int u = 0; u < 4; ++u) {
            bf16x8 bb = *(const bf16x8*)(KdT + ((rp * 4 + u) * 16 + fr) * 80 + kk * 32 + fq * 8);
            S[u] = MFMA(a, bb, S[u]);
          }
        }
#pragma unroll
        for (int u = 0; u < 4; ++u) {
          int dd = (rp * 4 + u) * 16 + fr, v0 = vt * 16 + fq * 4;
#pragma unroll
          for (int j = 0; j < 4; ++j) ST[(v0 + j) * 144 + dd] = f2bf(S[u][j]);
        }
      }
      lds_barrier();
    }
#undef SCAN_LOAD_KQ
#undef SCAN_LOAD_V
  }
}

DI void ph_dnfin(const Prm& p, int li) {
  const int lane = mytid() & 63;
  const int gw = mybid() * 8 + (mytid() >> 6), nw = gridDim.x * 8;
  const u16* O = (const u16*)(p.ws + OFF_AR + 5 * U38);
  const u16* O2 = (const u16*)(p.ws + OFF_AR + 6 * U38);
  u16* Z = (u16*)(p.ws + OFF_Y + 3 * U38);
  const float n0 = p.dn_norm[li * 128 + lane * 2], n1 = p.dn_norm[li * 128 + lane * 2 + 1];
#pragma unroll 2
  for (int tok = gw; tok < T_ALL; tok += nw) {
    ushort2 oa[4], ob[4], zz[4];
    float ox[4], oy[4], ss[4];
#pragma unroll
    for (int h = 0; h < 4; ++h) {
      long o = (long)tok * 512 + h * 128 + lane * 2;
      oa[h] = *(const ushort2*)(O + o);
      ob[h] = *(const ushort2*)(O2 + o);
      zz[h] = *(const ushort2*)(Z + o);
    }
#pragma unroll
    for (int h = 0; h < 4; ++h) {
      ox[h] = bf2f(oa[h].x) + bf2f(ob[h].x);
      oy[h] = bf2f(oa[h].y) + bf2f(ob[h].y);
      ss[h] = ox[h] * ox[h] + oy[h] * oy[h];
    }
#pragma unroll
    for (int o = 32; o; o >>= 1)
#pragma unroll
      for (int h = 0; h < 4; ++h) ss[h] += __shfl_xor(ss[h], o);
#pragma unroll
    for (int h = 0; h < 4; ++h) {
      float inv = rsqrtf(ss[h] * (1.f / 128.f) + 1e-6f);
      float z0 = bf2f(zz[h].x), z1 = bf2f(zz[h].y);
      ushort2 y;
      y.x = f2bf(ox[h] * inv * n0 * (z0 * __builtin_amdgcn_rcpf(1.f + __expf(-z0))));
      y.y = f2bf(oy[h] * inv * n1 * (z1 * __builtin_amdgcn_rcpf(1.f + __expf(-z1))));
      *(ushort2*)(Z + (long)tok * 512 + h * 128 + lane * 2) = y;
    }
  }
}

DI void ph_aprep(const Prm& p, int li) {
  const int lane = mytid() & 63;
  const int gw = mybid() * 8 + (mytid() >> 6), nw = gridDim.x * 8;
  const u16* PA = (const u16*)(p.ws + OFF_AR);
  u16* QH = (u16*)(p.ws + OFF_AR + 3 * U38);
  u16* KH = QH + 18874368L;
  const int f = lane & 15;
  const float inv_f = powf(10000.f, -(float)f / 16.f);
  for (int tok = gw; tok < T_ALL; tok += nw) {
    int b, P;
    float cs = 1.f, sn = 0.f;
    if (tok < T_LAT) {
      b = tok >> 11;
      int l = tok & 2047;
      P = 256 + l;
      float pos = (lane < 32) ? (float)(l >> 6) : (float)(l & 63);
      float ang = pos * inv_f;
      cs = cosf(ang);
      sn = sinf(ang);
    } else {
      b = (tok - T_LAT) >> 8;
      P = (tok - T_LAT) & 255;
    }
    float xv[16], ssq[16];
#pragma unroll
    for (int g = 0; g < 16; ++g) {
      xv[g] = bf2f(PA[(long)tok * 1024 + g * 64 + lane]);
      ssq[g] = xv[g] * xv[g];
    }
#pragma unroll
    for (int o = 32; o; o >>= 1)
#pragma unroll
      for (int g = 0; g < 16; ++g) ssq[g] += __shfl_xor(ssq[g], o);
#pragma unroll
    for (int g = 0; g < 16; ++g) {
      int which = g >> 3, h = (g >> 1) & 3, c = g & 1;
      float inv = rsqrtf(ssq[g] * (1.f / 64.f) + 1e-6f);
      float y = xv[g] * inv * p.qk_gain[(li * 2 + which) * 64 + lane];
      float pr = __shfl_xor(y, 16);
      float o = (lane & 16) ? (y * cs + pr * sn) : (y * cs - pr * sn);
      if (which == 0) o *= 0.18033688011112042f;
      u16* dst = (which ? KH : QH) + ((long)((b * 4 + h) * 2 + c) * 2304 + P) * 64 + lane;
      *dst = f2bf(o);
    }
  }
}

DI void ph_attn(const Prm& p, int li, long base, char* smem) {
  const int tid = mytid(), lane = tid & 63, wid = tid >> 6, fr = lane & 15, fq = lane >> 4;
  const u16* QH = (const u16*)(p.ws + OFF_AR + 3 * U38);
  const u16* KH = QH + 18874368L;
  const u16* VT = (const u16*)(p.ws + OFF_AR + 5 * U38);
  u16* YA = (u16*)(p.ws + OFF_Y);
  u16* s = (u16*)smem;
  constexpr int STG = 128 * 80 + 128 * 72;
  const float lambda_init = 0.8f - 0.6f * expf(-0.3f * (float)li);
  float lamv, mshift;
  {
    const float* lv = p.lam + li * 256;
    float a = wsum(lv[lane] * lv[64 + lane]), b2 = wsum(lv[128 + lane] * lv[192 + lane]);
    lamv = expf(a) - expf(b2) + lambda_init;
    float gq = wmax(fabsf(p.qk_gain[(li * 2) * 64 + lane])), gk = wmax(fabsf(p.qk_gain[(li * 2 + 1) * 64 + lane]));
    mshift = 8.f * gq * gk * 1.4426950408889634f;
  }
  for (int it = first_item(base); it < (li == 3 ? 1024 : 1152); it += gridDim.x) {
    int b, h, qp0, nkeys;
    if (it < 1024) { b = it >> 6; h = (it >> 4) & 3; qp0 = 256 + (it & 15) * 128; nkeys = 2304; }
    else { int i2 = it - 1024; b = i2 >> 3; h = (i2 >> 1) & 3; qp0 = (i2 & 1) * 128; nkeys = 256; }
    const long kb0 = (long)((b * 4 + h) * 2) * 2304;
    bf16x8 qf[2][2];
#pragma unroll
    for (int c = 0; c < 2; ++c)
#pragma unroll
      for (int ks = 0; ks < 2; ++ks)
        qf[c][ks] = *(const bf16x8*)(QH + (kb0 + (long)c * 2304 + qp0 + wid * 16 + fr) * 64 + ks * 32 + fq * 8);
    f32x4 O0[8], O1[8];
#pragma unroll
    for (int i = 0; i < 8; ++i) { O0[i] = f32x4{0.f, 0.f, 0.f, 0.f}; O1[i] = f32x4{0.f, 0.f, 0.f, 0.f}; }
    f32x4 L0 = {0.f, 0.f, 0.f, 0.f}, L1 = {0.f, 0.f, 0.f, 0.f};
    const bf16x8 ones = {0x3F80, 0x3F80, 0x3F80, 0x3F80, 0x3F80, 0x3F80, 0x3F80, 0x3F80};
    uint4 rk[2], rv[2];
    const int nt = nkeys >> 6;
#pragma unroll
    for (int u = 0; u < 2; ++u) {
      int id = tid + u * 512;
      int c = id >> 9, key = (id >> 3) & 63, ch = id & 7;
      rk[u] = *(const uint4*)(KH + (kb0 + (long)c * 2304 + key) * 64 + ch * 8);
      int dv = id >> 3;
      rv[u] = *(const uint4*)(VT + ((long)(b * 512 + h * 128 + dv)) * 2304 + ch * 8);
    }
#pragma unroll
    for (int u = 0; u < 2; ++u) {
      int id = tid + u * 512;
      *(uint4*)(s + (id >> 3) * 80 + (id & 7) * 8) = rk[u];
      *(uint4*)(s + 128 * 80 + (id >> 3) * 72 + (id & 7) * 8) = rv[u];
    }
    lds_barrier();
    for (int t = 0; t < nt; ++t) {
      const bool more = t + 1 < nt;
      if (more) {
        int kp0 = (t + 1) * 64;
#pragma unroll
        for (int u = 0; u < 2; ++u) {
          int id = tid + u * 512;
          int c = id >> 9, key = (id >> 3) & 63, ch = id & 7;
          rk[u] = *(const uint4*)(KH + (kb0 + (long)c * 2304 + kp0 + key) * 64 + ch * 8);
          int dv = id >> 3;
          rv[u] = *(const uint4*)(VT + ((long)(b * 512 + h * 128 + dv)) * 2304 + kp0 + ch * 8);
        }
      }
      const u16* ks_ = s + (t & 1) * STG;
      const u16* vs_ = ks_ + 128 * 80;
      bf16x8 pf[2][2];
#pragma unroll
      for (int c = 0; c < 2; ++c) {
#pragma unroll
        for (int kk2 = 0; kk2 < 2; ++kk2) {
          u32x4 pw;
#pragma unroll
          for (int hh = 0; hh < 2; ++hh) {
            const int k4 = kk2 * 2 + hh;
            f32x4 a = {-mshift, -mshift, -mshift, -mshift};
#pragma unroll
            for (int kk = 0; kk < 2; ++kk)
              a = MFMA(*(const bf16x8*)(ks_ + (c * 64 + k4 * 16 + fr) * 80 + kk * 32 + fq * 8), qf[c][kk], a);
            pw[hh * 2 + 0] = pk_bf16(__builtin_amdgcn_exp2f(a[0]), __builtin_amdgcn_exp2f(a[1]));
            pw[hh * 2 + 1] = pk_bf16(__builtin_amdgcn_exp2f(a[2]), __builtin_amdgcn_exp2f(a[3]));
          }
          pf[c][kk2] = *(bf16x8*)&pw;
        }
      }
#pragma unroll
      for (int kk = 0; kk < 2; ++kk) {
        L0 = MFMA(ones, pf[0][kk], L0);
        L1 = MFMA(ones, pf[1][kk], L1);
      }
#pragma unroll
      for (int dt = 0; dt < 8; ++dt) {
#pragma unroll
        for (int kk = 0; kk < 2; ++kk) {
          const u16* vp = vs_ + (dt * 16 + fr) * 72 + kk * 32 + fq * 4;
          uint2 lo = *(const uint2*)vp, hi = *(const uint2*)(vp + 16);
          uint4 av = {lo.x, lo.y, hi.x, hi.y};
          bf16x8 a = *(bf16x8*)&av;
          O0[dt] = MFMA(a, pf[0][kk], O0[dt]);
          O1[dt] = MFMA(a, pf[1][kk], O1[dt]);
        }
      }
      if (more) {
        u16* ns = s + ((t + 1) & 1) * STG;
#pragma unroll
        for (int u = 0; u < 2; ++u) {
          int id = tid + u * 512;
          *(uint4*)(ns + (id >> 3) * 80 + (id & 7) * 8) = rk[u];
          *(uint4*)(ns + 128 * 80 + (id >> 3) * 72 + (id & 7) * 8) = rv[u];
        }
      }
      lds_barrier();
    }
    float i0 = 1.f / L0[0], i1 = lamv / L1[0], ss = 0.f;
#pragma unroll
    for (int dt = 0; dt < 8; ++dt)
#pragma unroll
      for (int j = 0; j < 4; ++j) {
        float o = O0[dt][j] * i0 - O1[dt][j] * i1;
        O0[dt][j] = o;
        ss += o * o;
      }
    ss += __shfl_xor(ss, 16); ss += __shfl_xor(ss, 32);
    float inv = rsqrtf(ss * (1.f / 128.f) + 1e-6f) * (1.f - lambda_init);
    int tok = tokof(b, qp0 + wid * 16 + fr);
#pragma unroll
    for (int dt = 0; dt < 8; ++dt) {
      int dv = dt * 16 + fq * 4;
      const float* sw = p.subln + li * 128 + dv;
      ushort4 o;
      o.x = f2bf(O0[dt][0] * inv * sw[0]);
      o.y = f2bf(O0[dt][1] * inv * sw[1]);
      o.z = f2bf(O0[dt][2] * inv * sw[2]);
      o.w = f2bf(O0[dt][3] * inv * sw[3]);
      *(ushort4*)(YA + (long)tok * 512 + h * 128 + dv) = o;
    }
  }
}

template <int L>
DI void hyena_item(const Prm& p, int li, int ch, char* smem) {
  constexpr int CS = 2 * L + 8;
  constexpr int ZS = L + 8;
  constexpr int MT = L / 128;
  constexpr int MG = MT > 8 ? 8 : MT, NG = MT / MG;
  const int tid = mytid(), lane = tid & 63, wid = tid >> 6, fr = lane & 15, fq = lane >> 4;
  u16* cp = (u16*)smem;
  u16* zr = cp + 8 * CS;
  const u16* PH = (const u16*)(p.ws + OFF_AR) + (L == 2048 ? 0L : 32768L * 1536);
  const u16* G = (const u16*)(p.ws + (L == 2048 ? OFF_TAPL : OFF_TAPC));
  u16* YB = (u16*)(p.ws + OFF_Y + U38);
  const float* cw = p.hy_conv + (long)li * 3 * 1536;
  {
    float w0 = cw[1024 + ch], w1 = cw[1536 + 1024 + ch], w2 = cw[3072 + 1024 + ch];
    constexpr int NCH = (16 * L / 8) / 512;
    u32x4 cv[NCH];
    u16 pv[NCH], nv[NCH];
#pragma unroll
    for (int i = 0; i < NCH; ++i) {
      int id = tid + i * 512, b = id / (L / 8), s0 = (id % (L / 8)) * 8;
      const u16* row = PH + ((long)b * 1536 + 1024 + ch) * L + s0;
      cv[i] = *(const u32x4*)row;
      pv[i] = (s0 > 0) ? row[-1] : (u16)0;
      nv[i] = (s0 + 8 < L) ? row[8] : (u16)0;
    }
#pragma unroll
    for (int i = 0; i < NCH; ++i) {
      int id = tid + i * 512, b = id / (L / 8), s0 = (id % (L / 8)) * 8;
      float x[10];
      x[0] = bf2f(pv[i]);
      x[9] = bf2f(nv[i]);
#pragma unroll
      for (int w = 0; w < 4; ++w) {
        x[1 + 2 * w] = __uint_as_float(cv[i][w] << 16);
        x[2 + 2 * w] = __uint_as_float(cv[i][w] & 0xffff0000u);
      }
      float o[8];
#pragma unroll
      for (int e = 0; e < 8; ++e) o[e] = w0 * x[e] + w1 * x[e + 1] + w2 * x[e + 2];
      u32x4 r;
      r[0] = pk_bf16(o[7], o[6]); r[1] = pk_bf16(o[5], o[4]); r[2] = pk_bf16(o[3], o[2]); r[3] = pk_bf16(o[1], o[0]);
      *(u32x4*)(zr + b * ZS + L - 8 - s0) = r;
    }
  }
#pragma unroll
  for (int order = 0; order < 2; ++order) {
    {
      const u16* g = G + (long)(order * 512 + ch) * (2 * L);
      if (tid < 2 * L / 8) {
        const int i0 = tid * 8;
        u32x4 lo = *(const u32x4*)(g + i0);
        u32x4 hi = (i0 + 8 < 2 * L) ? *(const u32x4*)(g + i0 + 8) : u32x4{0u, 0u, 0u, 0u};
        unsigned D[8] = {lo[0], lo[1], lo[2], lo[3], hi[0], hi[1], hi[2], hi[3]};
#pragma unroll
        for (int c = 0; c < 8; ++c) {
          u32x4 o;
#pragma unroll
          for (int w = 0; w < 4; ++w) {
            if (c & 1) o[w] = (D[w + (c - 1) / 2] >> 16) | (D[w + (c + 1) / 2] << 16);
            else o[w] = D[w + c / 2];
          }
          *(u32x4*)(cp + c * CS + i0) = o;
        }
      }
    }
    __syncthreads();
    const float bias = p.hy_bias[(li * 2 + order) * 512 + ch];
    const int gcol = order * 512 + ch;
    const float w0 = cw[gcol], w1 = cw[1536 + gcol], w2 = cw[3072 + gcol];
    const int tq = wid * (L / 8) + fq * 4;
    const u16* xb = PH + ((long)fr * 1536 + gcol) * L + tq;
    const u16* zb = zr + fr * ZS + L - 1 - tq;
    unsigned zp[NG][MG][2];
#pragma unroll
    for (int grp = 0; grp < NG; ++grp) {
      f32x4 acc[MG];
#pragma unroll
      for (int m = 0; m < MG; ++m) acc[m] = f32x4{0.f, 0.f, 0.f, 0.f};
      const int tb = wid * (L / 8) + grp * MG * 16 + fr;
      if constexpr (MG == 8) {
        const int i00 = tb - fq * 8 - 7 + L, c0 = i00 & 7;
        const u16* ab = cp + c0 * CS + (i00 - c0);
        const u16* zbp = zr + fr * ZS + (L - 8 - fq * 8);
        bf16x8 W[16];
#pragma unroll 1
        for (int s0 = 0; s0 < L; s0 += 256) {
#pragma unroll
          for (int k = 0; k < 8; ++k) {
            const int sk = s0 + 32 * k;
            if (k == 0) {
#pragma unroll
              for (int m = 0; m < 8; ++m) W[m] = *(const bf16x8*)(ab + m * 16 - sk);
            }
            if (k < 7) {
              W[(16 - 2 * k - 2) & 15] = *(const bf16x8*)(ab - sk - 32);
              W[(16 - 2 * k - 1) & 15] = *(const bf16x8*)(ab - sk - 32 + 16);
            }
            bf16x8 bk = *(const bf16x8*)(zbp - sk);
#pragma unroll
            for (int m = 0; m < 8; ++m) acc[m] = MFMA(W[(m + 16 - 2 * k) & 15], bk, acc[m]);
          }
        }
      } else {
#pragma unroll 2
        for (int s0 = 0; s0 < L; s0 += 32) {
          bf16x8 bfr = *(const bf16x8*)(zr + fr * ZS + (L - 8 - s0 - fq * 8));
#pragma unroll
          for (int m = 0; m < MG; ++m) {
            int i0 = tb + m * 16 - s0 - fq * 8 - 7 + L;
            int c = i0 & 7;
            bf16x8 afr = *(const bf16x8*)(cp + c * CS + (i0 - c));
            acc[m] = MFMA(afr, bfr, acc[m]);
          }
        }
      }
#pragma unroll
      for (int m = 0; m < MG; ++m) {
        float r4[4];
#pragma unroll
        for (int j = 0; j < 4; ++j) {
          const int off = (grp * MG + m) * 16 + j;
          const int t = tq + off;
          float xa = bf2f(xb[off - 1]), xc = bf2f(xb[off]), xd = bf2f(xb[off + 1]);
          xa = (t > 0) ? xa : 0.f;
          xd = (t + 1 < L) ? xd : 0.f;
          float xg = w0 * xa + w1 * xc + w2 * xd;
          float zin = bf2f(zb[-off]);
          r4[j] = xg * (acc[m][j] + bias * zin);
        }
        zp[grp][m][0] = (unsigned)f2bf(r4[0]) | ((unsigned)f2bf(r4[1]) << 16);
        zp[grp][m][1] = (unsigned)f2bf(r4[2]) | ((unsigned)f2bf(r4[3]) << 16);
      }
    }
    __syncthreads();
#pragma unroll
    for (int grp = 0; grp < NG; ++grp)
#pragma unroll
      for (int m = 0; m < MG; ++m) {
        int t0 = wid * (L / 8) + (grp * MG + m) * 16 + fq * 4;
        uint2 w;
        w.x = (zp[grp][m][1] >> 16) | (zp[grp][m][1] << 16);
        w.y = (zp[grp][m][0] >> 16) | (zp[grp][m][0] << 16);
        *(uint2*)(zr + fr * ZS + L - 4 - t0) = w;
      }
  }
  __syncthreads();
  {
    u16* YBT = (u16*)(p.ws + OFF_AR + 5 * U38) + (L == 2048 ? 0L : 16L * 512 * 2048);
    constexpr int NCH = (16 * L / 8) / 512;
#pragma unroll
    for (int i = 0; i < NCH; ++i) {
      int id = tid + i * 512, b = id / (L / 8), t0 = (id % (L / 8)) * 8;
      u32x4 r = *(const u32x4*)(zr + b * ZS + L - 8 - t0);
      u32x4 o;
      o[0] = (r[3] >> 16) | (r[3] << 16);
      o[1] = (r[2] >> 16) | (r[2] << 16);
      o[2] = (r[1] >> 16) | (r[1] << 16);
      o[3] = (r[0] >> 16) | (r[0] << 16);
      *(u32x4*)(YBT + ((long)b * 512 + ch) * L + t0) = o;
    }
  }
  __syncthreads();
}

DI long ph_ytrans(const Prm& p, long base, bool lastl, char* smem) {
  u16* tl = (u16*)smem;
  const u16* YBT = (const u16*)(p.ws + OFF_AR + 5 * U38);
  u16* YB = (u16*)(p.ws + OFF_Y + U38);
  const int tid = mytid(), G = gridDim.x;
  const int total = lastl ? 4096 : 4608;
  auto srcp = [&](int it) -> const u16* {
    if (it < 4096) {
      int b = it >> 8, ct = (it >> 5) & 7, lt = it & 31;
      return YBT + ((long)b * 512 + ct * 64 + (tid >> 3)) * 2048 + lt * 64 + (tid & 7) * 8;
    } else {
      int i2 = it - 4096, b = i2 >> 5, ct = (i2 >> 2) & 7, lt = i2 & 3;
      return YBT + 16L * 512 * 2048 + ((long)b * 512 + ct * 64 + (tid >> 3)) * 256 + lt * 64 + (tid & 7) * 8;
    }
  };
  int it = first_item(base);
  u32x4 v = {0u, 0u, 0u, 0u};
  if (it < total) v = *(const u32x4*)srcp(it);
  for (; it < total; it += G) {
    *(u32x4*)(tl + (tid >> 3) * 72 + (tid & 7) * 8) = v;
    __syncthreads();
    if (it + G < total) v = *(const u32x4*)srcp(it + G);
    long tok0;
    int ct;
    if (it < 4096) { int b = it >> 8, lt = it & 31; ct = (it >> 5) & 7; tok0 = (long)b * 2048 + lt * 64; }
    else { int i2 = it - 4096, b = i2 >> 5, lt = i2 & 3; ct = (i2 >> 2) & 7; tok0 = (long)T_LAT + b * 256 + lt * 64; }
    const int lrow = tid >> 3, cc = tid & 7;
    u32x4 o;
#pragma unroll
    for (int w = 0; w < 4; ++w) {
      unsigned lo = tl[(cc * 8 + 2 * w) * 72 + lrow], hi = tl[(cc * 8 + 2 * w + 1) * 72 + lrow];
      o[w] = lo | (hi << 16);
    }
    *(u32x4*)(YB + (tok0 + lrow) * 512 + ct * 64 + cc * 8) = o;
    __syncthreads();
  }
  return base + total;
}

DI void ph_merge(const Prm& p, char* smem, bool lastl) {
  const int tid = mytid(), lane = tid & 63, wid = tid >> 6;
  const int wm = wid >> 1, wn = wid & 1, fr = lane & 15, fq = lane >> 4;
  const u16* H = (const u16*)(p.ws + OFF_HBF);
  const u16* Y = (const u16*)(p.ws + OFF_Y);
  const u16* WG = (const u16*)(p.ws + OFF_WB) + WO_G;
  const u16* WBr = (const u16*)(p.ws + OFF_WB) + WO_B;
  u16* MG = (u16*)(p.ws + OFF_AR);
  const int NT = (lastl ? 256 : 288) * 8, G = gridDim.x;
  Stg r0, r1;
  bool pre = false;
  for (int t = mybid(); t < NT; t += G) {
    const int mt = t >> 3, nt = t & 7;
    const bool hn = t + G < NT;
    const int mt2 = (t + G) >> 3, nt2 = (t + G) & 7;
    f32x4 acc[2][4], g[2][4], y[2][4];
#pragma unroll
    for (int a = 0; a < 2; ++a)
#pragma unroll
      for (int b = 0; b < 4; ++b) acc[a][b] = f32x4{0.f, 0.f, 0.f, 0.f};
    const u16* gA = H + (long)mt * 128 * 1024;
    for (int n = 0; n < 4; ++n) {
      const u16* gB = WG + ((long)n * 1024 + nt * 128) * 1024;
      const u16* yA = Y + (long)n * (T_ALL * 512L) + (long)mt * 128 * 512;
      const u16* yB = WBr + ((long)n * 1024 + nt * 128) * 512;
      gemm_tile<2>(g, gA, 1024, gB, 1024, 1024, smem, r0, r1, pre, yA, 512, yB, 512);
      const u16* nxA = (n < 3) ? gA : (hn ? H + (long)mt2 * 128 * 1024 : nullptr);
      const u16* nxB = (n < 3) ? WG + ((long)(n + 1) * 1024 + nt * 128) * 1024 : WG + ((long)nt2 * 128) * 1024;
      gemm_tile<2>(y, yA, 512, yB, 512, 512, smem, r0, r1, true, nxA, 1024, nxB, 1024);
      pre = true;
#pragma unroll
      for (int a = 0; a < 2; ++a)
#pragma unroll
        for (int b = 0; b < 4; ++b)
#pragma unroll
          for (int j = 0; j < 4; ++j) acc[a][b][j] += y[a][b][j] * __builtin_amdgcn_rcpf(1.f + __expf(-g[a][b][j]));
    }
    pre = hn;
#pragma unroll
    for (int a = 0; a < 2; ++a)
#pragma unroll
      for (int b = 0; b < 4; ++b) {
        int r = wm * 32 + a * 16 + fr, c = wn * 64 + b * 16 + fq * 4;
        uint2 o;
        o.x = pk_bf16(acc[a][b][0], acc[a][b][1]);
        o.y = pk_bf16(acc[a][b][2], acc[a][b][3]);
        *(uint2*)(MG + ((long)mt * 128 + r) * 1024 + nt * 128 + c) = o;
      }
  }
}

DI void run_phase(const Prm& p, int ph, char* smem) {
  if (ph == 0) { ph_init(p, smem); return; }
  const int li = (ph - 1) / 14, k = (ph - 1) % 14;
  const u16* WB = (const u16*)(p.ws + OFF_WB);
  const u16* HB = (const u16*)(p.ws + OFF_HBF);
  const float* MOD = (const float*)(p.ws + OFF_MOD);
  u16* AR = (u16*)(p.ws + OFF_AR);
  u16* Yb = (u16*)(p.ws + OFF_Y);
  const int G = gridDim.x;
  TD d;
  d.split = 0; d.scale = 1.f; d.mode = 0; d.tok0 = 0; d.col0 = 0; d.g = MOD;
  switch (k) {
    case 0: {
      u16* W = (u16*)(p.ws + OFF_WB);
      long base = 0;
      base = tr_job(base, p.w_in + (long)li * 1024 * NIN, 1024, NIN, W + WO_IN, 1, smem);
      base = tr_job(base, p.w_gate + (long)li * 4 * 1048576, 1024, 1024, W + WO_G, 4, smem);
      base = tr_job(base, p.w_branch + (long)li * 4 * 524288, 512, 1024, W + WO_B, 4, smem);
      base = tr_job(base, p.w_o + (long)li * 1048576, 1024, 1024, W + WO_O, 1, smem);
      base = tr_job(base, p.w_mlp1 + (long)li * 4194304, 1024, 4096, W + WO_1, 1, smem);
      base = tr_job(base, p.w_mlp2 + (long)li * 4194304, 4096, 1024, W + WO_2, 1, smem);
      ph_taps1(p, li, base, smem);
      ph_norm(p, li, 0);
    } break;
    case 1: {
      auto dec = [&](int t, TD& o) {
        o.lda = 1024; o.ldb = 1024; o.K = 1024; o.mode = 0;
        if (t < 1728) {
          int mt = t / 12, nt = t % 12;
          o.A = HB + (long)mt * 256 * 1024; o.B = WB + WO_IN + (long)(3584 + nt * 128) * 1024;
          o.C = AR + (long)mt * 256 * 1536 + nt * 128; o.ldc = 1536;
        } else if (t < 2304) {
          int t2 = t - 1728, mt = t2 >> 2, nt = t2 & 3;
          o.A = HB + (long)mt * 256 * 1024; o.B = WB + WO_IN + (long)(5120 + nt * 128) * 1024;
          o.C = Yb + 3 * (U38 / 2) + (long)mt * 256 * 512 + nt * 128; o.ldc = 512;
        } else {
          int mt = t - 2304;
          o.A = HB + (long)mt * 256 * 1024; o.B = WB + WO_IN + (long)5632 * 1024;
          o.C = (u16*)((float*)(p.ws + OFF_PDAB) + (long)mt * 256 * 16); o.ldc = 16; o.mode = 3;
        }
      };
      {
        Stg r0, r1;
        bool pre = false;
        TD dn = d;
        int t = mybid();
        if (t < 2448) dec(t, d);
        for (; t < 2448; t += G) {
          const bool hn = t + G < 2448;
          if (hn) dec(t + G, dn);
          run_tile2<4>(p, d, smem, r0, r1, pre, hn ? dn.A : nullptr, dn.lda, dn.B, dn.ldb);
          pre = hn;
          d = dn;
        }
      }
      ph_taps2(p, 2448, smem);
    } break;
    case 2: ph_dncl(p, li, smem); break;
    case 3: ph_dnscan(p, smem); break;
    case 4: {
      {
        Stg r0, r1;
        bool pre = false;
        for (int t = mybid(); t < 1152; t += G) {
          int mt = t >> 3, nt = t & 7;
          const bool hn = t + G < 1152;
          int mt2 = (t + G) >> 3, nt2 = (t + G) & 7;
          d.lda = 1024; d.ldb = 1024; d.K = 1024;
          d.A = HB + (long)mt * 256 * 1024; d.B = WB + WO_IN + (long)(nt * 128) * 1024;
          d.C = AR + 3 * (U38 / 2); d.ldc = 0; d.mode = 4; d.tok0 = mt * 256; d.col0 = nt;
          d.g = p.qk_gain + li * 128;
          run_tile2<4>(p, d, smem, r0, r1, pre, hn ? HB + (long)mt2 * 256 * 1024 : nullptr, 1024,
                    WB + WO_IN + (long)(nt2 * 128) * 1024, 1024);
          pre = hn;
        }
      }
      ph_dnfin(p, li);
    } break;
    case 5: {
      u16* VT = AR + 5 * (U38 / 2);
      u16* PF = AR + 6 * (U38 / 2);
      auto dec = [&](int t, TD& o) {
        o.lda = 1024; o.ldb = 1024; o.K = 1024;
        if (t < 512) {
          int b = t >> 5, r = t & 31, mt = r >> 4, nt = r & 15;
          o.A = WB + WO_IN + (long)(1024 + mt * 256) * 1024; o.B = HB + ((long)b * 2048 + nt * 128) * 1024;
          o.C = VT + ((long)b * 512 + mt * 256) * 2304 + 256 + nt * 128; o.ldc = 2304;
        } else if (t < 576) {
          int t2 = t - 512, b = t2 >> 2, r = t2 & 3, mt = r >> 1, nt = r & 1;
          o.A = WB + WO_IN + (long)(1024 + mt * 256) * 1024; o.B = HB + ((long)T_LAT + b * 256 + nt * 128) * 1024;
          o.C = VT + ((long)b * 512 + mt * 256) * 2304 + nt * 128; o.ldc = 2304;
        } else {
          int t2 = t - 576, mt = t2 >> 2, nt = t2 & 3;
          o.A = HB + (long)mt * 256 * 1024; o.B = WB + WO_IN + (long)(3072 + nt * 128) * 1024;
          o.C = PF + (long)mt * 256 * 512 + nt * 128; o.ldc = 512;
        }
      };
      {
        Stg r0, r1;
        bool pre = false;
        TD dn = d;
        int t = mybid();
        if (t < 1152) dec(t, d);
        for (; t < 1152; t += G) {
          const bool hn = t + G < 1152;
          if (hn) dec(t + G, dn);
          run_tile2<4>(p, d, smem, r0, r1, pre, hn ? dn.A : nullptr, dn.lda, dn.B, dn.ldb);
          pre = hn;
          d = dn;
        }
      }
    } break;
    case 6: {
      ph_attn(p, li, 0, smem);
      auto dec = [&](int t, TD& o) {
        o.lda = 1024; o.ldb = 1024; o.K = 1024;
        if (t < 1536) {
          int b = t / 96, r = t % 96, mt = r >> 4, nt = r & 15;
          o.A = WB + WO_IN + (long)(1536 + mt * 256) * 1024; o.B = HB + ((long)b * 2048 + nt * 128) * 1024;
          o.C = AR + ((long)b * 1536 + mt * 256) * 2048 + nt * 128; o.ldc = 2048;
        } else {
          int t2 = t - 1536, b = t2 / 12, r = t2 % 12, mt = r >> 1, nt = r & 1;
          o.A = WB + WO_IN + (long)(1536 + mt * 256) * 1024; o.B = HB + ((long)T_LAT + b * 256 + nt * 128) * 1024;
          o.C = AR + 32768L * 1536 + ((long)b * 1536 + mt * 256) * 256 + nt * 128; o.ldc = 256;
        }
      };
      {
        Stg r0, r1;
        bool pre = false;
        TD dn = d;
        int t = first_item(1152);
        if (t < 1728) dec(t, d);
        for (; t < 1728; t += G) {
          const bool hn = t + G < 1728;
          if (hn) dec(t + G, dn);
          run_tile2<4>(p, d, smem, r0, r1, pre, hn ? dn.A : nullptr, dn.lda, dn.B, dn.ldb);
          pre = hn;
          d = dn;
        }
      }
    } break;
    case 7: {
#if !defined(TESTSEL) || TESTSEL == 1
      for (int it = mybid(); it < 512; it += G) hyena_item<2048>(p, li, it, smem);
#endif
#if !defined(TESTSEL) || TESTSEL == 2
      if (li < 3)
        for (int it = mybid(); it < 512; it += G) hyena_item<256>(p, li, it, smem);
#endif
#if !defined(TESTSEL) || TESTSEL == 3
      const u16* PF = AR + 6 * (U38 / 2);
      u16* WF = AR + 3 * (U38 / 2);
      const u16* DCm = (const u16*)(p.ws + OFF_DC);
      auto dec = [&](int t, TD& o) {
        o.A = DCm; o.lda = 128; o.ldb = 512; o.K = 128;
        if (t < 1024) {
          int bg = t >> 4, nt = t & 15, b = bg >> 2, g = bg & 3;
          o.B = PF + ((long)b * 2048 + nt * 128) * 512 + g * 128;
          o.C = WF + ((long)b * 512 + g * 128) * 4096 + nt * 128; o.ldc = 4096; o.split = 2048;
        } else {
          int t2 = t - 1024, bg = t2 >> 1, nt = t2 & 1, b = bg >> 2, g = bg & 3;
          o.B = PF + ((long)T_LAT + b * 256 + nt * 128) * 512 + g * 128;
          o.C = WF + 16L * 512 * 4096 + ((long)b * 512 + g * 128) * 512 + nt * 128; o.ldc = 512; o.split = 256;
        }
      };
      {
        const int NT7 = (li == 3 ? 1024 : 1152);
        Stg r0, r1;
        bool pre = false;
        TD dn = d;
        int t = mybid();
        if (t < NT7) dec(t, d);
        for (; t < NT7; t += G) {
          const bool hn = t + G < NT7;
          if (hn) dec(t + G, dn);
          run_tile2<4>(p, d, smem, r0, r1, pre, hn ? dn.A : nullptr, dn.lda, dn.B, dn.ldb);
          pre = hn;
          d = dn;
        }
      }
#endif
    } break;
    case 8: {
      const u16* WF = AR + 3 * (U38 / 2);
      u16* YF = Yb + 2 * (U38 / 2);
      d.scale = 1.f / 512.f;
      for (int t = mybid(); t < (li == 3 ? 512 : 576); t += G) {
        if (t < 512) {
          int b = t >> 5, r = t & 31, mt = r >> 2, nt = r & 3;
          d.A = (const u16*)(p.ws + OFF_DL) + (long)mt * 256 * 4096; d.lda = 4096;
          d.B = WF + ((long)b * 512 + nt * 128) * 4096; d.ldb = 4096; d.K = 4096;
          d.C = YF + ((long)b * 2048 + mt * 256) * 512 + nt * 128; d.ldc = 512;
        } else {
          int t2 = t - 512, b = t2 >> 2, nt = t2 & 3;
          d.A = (const u16*)(p.ws + OFF_DLC); d.lda = 512;
          d.B = WF + 16L * 512 * 4096 + ((long)b * 512 + nt * 128) * 512; d.ldb = 512; d.K = 512;
          d.C = YF + ((long)T_LAT + b * 256) * 512 + nt * 128; d.ldc = 512;
        }
        run_tile(p, d, smem);
      }
      ph_ytrans(p, 576, li == 3, smem);
    } break;
    case 9: ph_merge(p, smem, li == 3); break;
    case 10: {
      d.mode = 2;
      const int NF = 1024, NTOT = (li == 3) ? 1024 : 1024 + 256;
      auto dec = [&](int t, TD& o) {
        int full = t < NF ? t : NF + ((t - NF) >> 1), half = t < NF ? 0 : ((t - NF) & 1);
        int mt = full >> 3, nt = full & 7;
        o.A = AR + ((long)mt * 256 + half * 128) * 1024; o.lda = 1024;
        o.B = WB + WO_O + (long)nt * 128 * 1024; o.ldb = 1024; o.K = 1024;
        o.tok0 = mt * 256 + half * 128; o.col0 = nt * 128;
        int bb = o.tok0 < T_LAT ? (o.tok0 >> 11) : 16;
        o.g = MOD + ((long)li * 17 + bb) * 6144 + 2 * 1024;
      };
      Stg r0, r1;
      bool pre = false;
      TD dn = d;
      int t = mybid();
      if (t < NTOT) dec(t, d);
      for (; t < NTOT; t += G) {
        const bool hn = t + G < NTOT;
        if (hn) dec(t + G, dn);
        if (t < NF) run_tile2<4>(p, d, smem, r0, r1, pre, hn ? dn.A : nullptr, dn.lda, dn.B, dn.ldb);
        else run_tile2<2>(p, d, smem, r0, r1, pre, hn ? dn.A : nullptr, dn.lda, dn.B, dn.ldb);
        pre = hn;
        d = dn;
      }
    } break;
    case 11: ph_norm(p, li, 1); break;
    case 12: {
      d.mode = 1;
      const int NT12 = (li == 3 ? 4096 : 4608);
      Stg r0, r1;
      bool pre = false;
      for (int t = mybid(); t < NT12; t += G) {
        int mt = t >> 5, nt = t & 31;
        d.A = HB + (long)mt * 256 * 1024; d.lda = 1024; d.B = WB + WO_1 + (long)nt * 128 * 1024; d.ldb = 1024; d.K = 1024;
        d.C = Yb + (long)mt * 256 * 4096 + nt * 128; d.ldc = 4096;
        const bool hn = t + G < NT12;
        int mt2 = (t + G) >> 5, nt2 = (t + G) & 31;
        run_tile2<4>(p, d, smem, r0, r1, pre, hn ? HB + (long)mt2 * 256 * 1024 : nullptr, 1024,
                  WB + WO_1 + (long)nt2 * 128 * 1024, 1024);
        pre = hn;
      }
    } break;
    case 13: {
      d.mode = 2;
      const int NF = 1024, NTOT = (li == 3) ? 1024 : 1024 + 256;
      auto dec = [&](int t, TD& o) {
        int full = t < NF ? t : NF + ((t - NF) >> 1), half = t < NF ? 0 : ((t - NF) & 1);
        int mt = full >> 3, nt = full & 7;
        o.A = Yb + ((long)mt * 256 + half * 128) * 4096; o.lda = 4096;
        o.B = WB + WO_2 + (long)nt * 128 * 4096; o.ldb = 4096; o.K = 4096;
        o.tok0 = mt * 256 + half * 128; o.col0 = nt * 128;
        int bb = o.tok0 < T_LAT ? (o.tok0 >> 11) : 16;
        o.g = MOD + ((long)li * 17 + bb) * 6144 + 5 * 1024;
      };
      Stg r0, r1;
      bool pre = false;
      TD dn = d;
      int t = mybid();
      if (t < NTOT) dec(t, d);
      for (; t < NTOT; t += G) {
        const bool hn = t + G < NTOT;
        if (hn) dec(t + G, dn);
        if (t < NF) run_tile2<4>(p, d, smem, r0, r1, pre, hn ? dn.A : nullptr, dn.lda, dn.B, dn.ldb);
        else run_tile2<2>(p, d, smem, r0, r1, pre, hn ? dn.A : nullptr, dn.lda, dn.B, dn.ldb);
        pre = hn;
        d = dn;
      }
    } break;
  }
}


#define XB_TMO      128
#define XB_XCNT(j)  (256  + 64 * (j))
#define XB_XSUB(j)  (1280 + 64 * (j))
#define XB_XGEN(j)  (2304 + 64 * (j))
#define XB_TOP      3328
#define XB_TOPGEN   3392
#define XCD_BAR_WORDS 3456
#define XB_SPIN_CAP (1u << 20)
#define LAS __attribute__((address_space(3)))
DI unsigned xb_ld(unsigned* p) { return __hip_atomic_load(p, __ATOMIC_RELAXED, __HIP_MEMORY_SCOPE_AGENT); }
DI unsigned xb_add(unsigned* p, unsigned v) { return __hip_atomic_fetch_add(p, v, __ATOMIC_RELAXED, __HIP_MEMORY_SCOPE_AGENT); }
DI unsigned xb_xcc_id() { return (unsigned)__builtin_amdgcn_s_getreg((3 << 11) | 20) & 0xFu; }
#define XB_SPIN(cond, bar) do { unsigned _sp = 0; while (cond) { __builtin_amdgcn_s_sleep(1); \
    if ((++_sp & 255u) == 0u) { if (xb_ld(&(bar)[XB_TMO])) break; if (_sp > XB_SPIN_CAP) { atomicAdd(&(bar)[XB_TMO], 1u); break; } } } } while (0)
struct XcdBarrier { unsigned* bar; unsigned x; volatile LAS unsigned* st; };
DI XcdBarrier xcd_barrier_post(unsigned* bar, volatile LAS unsigned* st) {
  XcdBarrier b; b.bar = bar; b.x = xb_xcc_id(); b.st = st;
  if (threadIdx.x == 0) (void)xb_add(&bar[XB_XCNT(b.x)], 1u);
  return b;
}
DI void xcd_barrier_complete(unsigned* bar, unsigned x, unsigned& nloc, unsigned& nx) {
  const unsigned G = gridDim.x * gridDim.y * gridDim.z;
  unsigned sum, cnt, mine, sp = 0u;
  for (;;) {
    sum = 0u; cnt = 0u; mine = 0u;
#pragma unroll
    for (unsigned j = 0; j < 16; ++j) { const unsigned c = xb_ld(&bar[XB_XCNT(j)]); sum += c; cnt += (c > 0u) ? 1u : 0u; mine = (j == x) ? c : mine; }
    if (sum == G) break;
    __builtin_amdgcn_s_sleep(1);
    if ((++sp & 255u) == 0u) { if (xb_ld(&bar[XB_TMO])) break; if (sp > XB_SPIN_CAP) { atomicAdd(&bar[XB_TMO], 1u); break; } }
  }
  nloc = mine > 0u ? mine : 1u; nx = cnt > 0u ? cnt : 1u;
}
DI void xcd_barrier(const XcdBarrier& b) {
  asm volatile("s_waitcnt vmcnt(0)" ::: "memory");
  __syncthreads();
  if (threadIdx.x == 0) {
    unsigned* bar = b.bar;
    __builtin_amdgcn_s_waitcnt(0);
    unsigned nloc = b.st[0], nx = b.st[1];
    if (nloc == 0u) { xcd_barrier_complete(bar, b.x, nloc, nx); b.st[0] = nloc; b.st[1] = nx; }
    const unsigned old = xb_add(&bar[XB_XSUB(b.x)], 1u);
    const unsigned gen = old / nloc;
    if (old + 1u == (gen + 1u) * nloc) {
      __builtin_amdgcn_fence(__ATOMIC_RELEASE, "agent");
      asm volatile("s_waitcnt vmcnt(0)" ::: "memory");
      const unsigned og = xb_add(&bar[XB_TOP], 1u);
      const unsigned tg = og / nx;
      if (og + 1u == (tg + 1u) * nx) xb_add(&bar[XB_TOPGEN], 1u);
      else XB_SPIN(xb_ld(&bar[XB_TOPGEN]) == tg, bar);
      __builtin_amdgcn_fence(__ATOMIC_ACQUIRE, "agent");
      xb_add(&bar[XB_XGEN(b.x)], 1u);
      asm volatile("s_waitcnt vmcnt(0)" ::: "memory");
    } else {
      XB_SPIN(xb_ld(&bar[XB_XGEN(b.x)]) == gen, bar);
      __builtin_amdgcn_fence(__ATOMIC_ACQUIRE, "agent");
      asm volatile("s_waitcnt vmcnt(0)" ::: "memory");
    }
  }
  __syncthreads();
}

extern __shared__ __attribute__((aligned(16))) char dyn_smem[];

__global__ void __launch_bounds__(512) mega(Prm p, int lo, int hi) {
  __shared__ uint4 xb_words;
  if (threadIdx.x == 0) xb_words = make_uint4(0u, 0u, 0u, 0u);
  __syncthreads();
  XcdBarrier xb = xcd_barrier_post((unsigned*)(p.ws + OFF_BAR), (volatile LAS unsigned*)&xb_words);
#ifdef ONLYK
  run_phase(p, ONLYK, dyn_smem);
#else
  for (int ph = lo; ph <= hi; ++ph) {
    long z = 0;
    asm volatile("" : "+s"(z));
    Prm q;
#define LP(f) q.f = p.f + z
    LP(x); LP(c); LP(ctx); LP(c_ctx); LP(w_ada); LP(b_ada); LP(norm1); LP(norm2); LP(w_in); LP(qk_gain); LP(lam);
    LP(subln); LP(hy_conv); LP(hy_w1); LP(hy_b1); LP(hy_freq); LP(hy_w2); LP(hy_b2); LP(hy_w3); LP(hy_bias);
    LP(dn_conv); LP(dn_a_log); LP(dn_dt_bias); LP(dn_norm); LP(w_gate); LP(w_branch); LP(w_o); LP(w_mlp1); LP(w_mlp2);
    LP(out); LP(ws);
#undef LP
    run_phase(q, ph, dyn_smem);
#ifdef PROBEK
    if (ph > 0 && (ph - 1) % 14 == PROBEK) { cg::this_grid().sync(); run_phase(q, ph, dyn_smem); }
#endif
    if (ph < hi) {
      if (ph == lo) cg::this_grid().sync();
      else xcd_barrier(xb);
    }
  }
#endif
}

extern "C" void kernel_launch(void* const* d_in, const int* in_sizes, int n_in, void* d_out, int out_size, void* d_ws,
                              size_t ws_size, hipStream_t stream) {
  static int grid_blocks = 0;
  if (!grid_blocks) {
    hipFuncSetAttribute((const void*)mega, hipFuncAttributeMaxDynamicSharedMemorySize, LDS_BYTES);
    int dev = 0, cus = 0, per_cu = 0;
    hipGetDevice(&dev);
    hipDeviceGetAttribute(&cus, hipDeviceAttributeMultiprocessorCount, dev);
    hipOccupancyMaxActiveBlocksPerMultiprocessor(&per_cu, mega, 512, LDS_BYTES);
    if (per_cu < 1) per_cu = 1;
    grid_blocks = cus * per_cu;
    if (ws_size < (size_t)WS_TOTAL) fprintf(stderr, "workspace too small: %zu < %ld\n", ws_size, (long)WS_TOTAL);
  }
  Prm p;
  const float** pp = (const float**)&p;
  for (int i = 0; i < 29; ++i) pp[i] = (const float*)d_in[i];
  p.out = (float*)d_out;
  p.ws = (char*)d_ws;
#if MULTI
  for (int ph = 0; ph < NPHASE; ++ph) hipLaunchKernelGGL(mega, dim3(grid_blocks), dim3(512), LDS_BYTES, stream, p, ph, ph);
#else
  int lo = 0, hi = NPHASE - 1;
  hipMemsetAsync((char*)d_ws + OFF_BAR, 0, XCD_BAR_WORDS * 4, stream);
  void* args[] = {&p, &lo, &hi};
  hipError_t e = hipLaunchCooperativeKernel((void*)mega, dim3(grid_blocks), dim3(512), args, LDS_BYTES, stream);
  if (e != hipSuccess) fprintf(stderr, "cooperative launch failed: %s (grid %d)\n", hipGetErrorString(e), grid_blocks);
#endif
}
```

```cpp
#include <hip/hip_runtime.h>
#include <hip/hip_cooperative_groups.h>
#include <stdint.h>
#include <stdio.h>
namespace cg = cooperative_groups;

typedef unsigned short u16;
typedef __attribute__((ext_vector_type(8))) short bf16x8;
typedef __attribute__((ext_vector_type(4))) float f32x4;
#define MFMA(a, b, c) __builtin_amdgcn_mfma_f32_16x16x32_bf16(a, b, c, 0, 0, 0)
#define DI __device__ __forceinline__

#ifndef MULTI
#define MULTI 0
#endif

constexpr int T_LAT = 32768, T_ALL = 36864;
constexpr int NIN = 5648;
constexpr long U38 = 37748736L;
constexpr long OFF_XC = 0;
constexpr long OFF_WB = OFF_XC + 16777216L;
constexpr long OFF_HBF = OFF_WB + 43024384L;
constexpr long OFF_MOD = OFF_HBF + 75497472L;
constexpr long OFF_TAPL = OFF_MOD + 1671168L;
constexpr long OFF_TAPC = OFF_TAPL + 8388608L;
constexpr long OFF_DL = OFF_TAPC + 1048576L;
constexpr long OFF_DLC = OFF_DL + 16777216L;
constexpr long OFF_DC = OFF_DLC + 262144L;
constexpr long OFF_PDAB = OFF_DC + 65536L;
constexpr long OFF_GC = OFF_PDAB + 2359296L;
constexpr long OFF_BETA = OFF_GC + 2359296L;
constexpr long OFF_Y = OFF_BETA + 2359296L;
constexpr long OFF_AR = OFF_Y + 4 * U38;
constexpr long OFF_ROPE = OFF_AR + 7 * U38;
constexpr long OFF_BAR = OFF_ROPE + 2 * 262144L;
constexpr long WS_TOTAL = OFF_BAR + 16384L;
constexpr long WO_IN = 0, WO_G = 5783552L, WO_B = 9977856L, WO_O = 12075008L, WO_1 = 13123584L, WO_2 = 17317888L;
constexpr int LDS_BYTES = 139264;
constexpr int NPHASE = 1 + 4 * 14;

struct Prm {
  const float *x, *c, *ctx, *c_ctx, *w_ada, *b_ada, *norm1, *norm2, *w_in, *qk_gain, *lam, *subln, *hy_conv, *hy_w1,
      *hy_b1, *hy_freq, *hy_w2, *hy_b2, *hy_w3, *hy_bias, *dn_conv, *dn_a_log, *dn_dt_bias, *dn_norm, *w_gate,
      *w_branch, *w_o, *w_mlp1, *w_mlp2;
  float* out;
  char* ws;
};

DI int mytid() {
  int t = threadIdx.x;
  asm volatile("" : "+v"(t));
  return t;
}
DI int mybid() {
  int t = blockIdx.x;
  asm volatile("" : "+s"(t));
  return t;
}
DI void lds_barrier() {
  asm volatile("s_waitcnt lgkmcnt(0)" ::: "memory");
  __builtin_amdgcn_s_barrier();
  asm volatile("" ::: "memory");
}
typedef __bf16 bf16x2_t __attribute__((ext_vector_type(2)));
typedef float f32x2_t __attribute__((ext_vector_type(2)));
DI unsigned pk_bf16(float a, float b) {
  f32x2_t v = {a, b};
  bf16x2_t h = __builtin_convertvector(v, bf16x2_t);
  return *(unsigned*)&h;
}
DI u16 f2bf(float f) {
  __bf16 h = (__bf16)f;
  return *(u16*)&h;
}
DI float bf2f(u16 h) { return __uint_as_float(((unsigned)h) << 16); }
DI float wsum(float v) {
  for (int o = 32; o; o >>= 1) v += __shfl_xor(v, o);
  return v;
}
DI float wmax(float v) {
  for (int o = 32; o; o >>= 1) v = fmaxf(v, __shfl_xor(v, o));
  return v;
}
DI float siluf(float v) { return v / (1.f + __expf(-v)); }
DI float sigmf(float v) { return 1.f / (1.f + __expf(-v)); }
DI float* xrow(const Prm& p, int tok) {
  return tok < T_LAT ? p.out + (long)tok * 1024 : (float*)(p.ws + OFF_XC) + (long)(tok - T_LAT) * 1024;
}
DI int first_item(long base) {
  int G = gridDim.x;
  return (int)(((long)mybid() + G - (base % G)) % G);
}
DI int tokof(int b, int P) { return P < 256 ? T_LAT + b * 256 + P : b * 2048 + (P - 256); }

typedef __attribute__((ext_vector_type(4))) unsigned u32x4;
struct Stg { u32x4 a0, a1, a2, a3, b0, b1; };
template <int NA>
DI void g_load(Stg& r, const u16* Ap, long lda, const u16* Bp, long ldb, int k0) {
  r.a0 = *(const u32x4*)(Ap + k0);
  r.a1 = *(const u32x4*)(Ap + 64 * lda + k0);
  if constexpr (NA == 4) {
    r.a2 = *(const u32x4*)(Ap + 128 * lda + k0);
    r.a3 = *(const u32x4*)(Ap + 192 * lda + k0);
  }
  r.b0 = *(const u32x4*)(Bp + k0);
  r.b1 = *(const u32x4*)(Bp + 64 * ldb + k0);
}
template <int NA, int TM>
DI void s_store(const Stg& r, u16* ns_) {
  *(u32x4*)(ns_) = r.a0;
  *(u32x4*)(ns_ + 64 * 80) = r.a1;
  if constexpr (NA == 4) {
    *(u32x4*)(ns_ + 128 * 80) = r.a2;
    *(u32x4*)(ns_ + 192 * 80) = r.a3;
  }
  *(u32x4*)(ns_ + TM * 80) = r.b0;
  *(u32x4*)(ns_ + TM * 80 + 64 * 80) = r.b1;
}
template <int MI>
DI void t_compute(f32x4 (&acc)[MI][4], const u16* as, const u16* bs, int wm, int wn, int fr, int fq) {
#pragma unroll
  for (int ks = 0; ks < 2; ++ks) {
    bf16x8 a[MI], b[4];
#pragma unroll
    for (int mi = 0; mi < MI; ++mi) a[mi] = *(const bf16x8*)(as + (wm * MI * 16 + mi * 16 + fr) * 80 + ks * 32 + fq * 8);
#pragma unroll
    for (int ni = 0; ni < 4; ++ni) b[ni] = *(const bf16x8*)(bs + (wn * 64 + ni * 16 + fr) * 80 + ks * 32 + fq * 8);
#pragma unroll
    for (int mi = 0; mi < MI; ++mi)
#pragma unroll
      for (int ni = 0; ni < 4; ++ni) acc[mi][ni] = MFMA(b[ni], a[mi], acc[mi][ni]);
  }
}
template <int MI>
DI void gemm_tile(f32x4 (&acc)[MI][4], const u16* __restrict__ A, long lda, const u16* __restrict__ B, long ldb, int K,
                  char* smem, Stg& r0, Stg& r1, bool pre, const u16* nA, long nlda, const u16* nB, long nldb) {
  constexpr int TM = MI * 64;
  constexpr int STAGE = (TM + 128) * 80;
  constexpr int NA = TM * 8 / 512;
  u16* s = (u16*)smem;
  const int tid = mytid(), lane = tid & 63, wid = tid >> 6;
  const int wm = wid >> 1, wn = wid & 1, fr = lane & 15, fq = lane >> 4;
  const long to_a = (long)(tid >> 3), to_c = (tid & 7) * 8;
  const u16* Ap = A + to_a * lda + to_c;
  const u16* Bp = B + to_a * ldb + to_c;
  const u16* nAp = nA + to_a * nlda + to_c;
  const u16* nBp = nB + to_a * nldb + to_c;
  const int so = (tid >> 3) * 80 + (tid & 7) * 8;
#define GLOAD(r, k0) g_load<NA>(r, Ap, lda, Bp, ldb, (k0))
#define NLOAD(r, k0) g_load<NA>(r, nAp, nlda, nBp, nldb, (k0))
#define SSTORE(r, st) s_store<NA, TM>(r, s + (st) * STAGE + so)
#define COMPUTE(st) t_compute<MI>(acc, s + (st) * STAGE, s + (st) * STAGE + TM * 80, wm, wn, fr, fq)
#pragma unroll
  for (int mi = 0; mi < MI; ++mi)
#pragma unroll
    for (int ni = 0; ni < 4; ++ni) acc[mi][ni] = f32x4{0.f, 0.f, 0.f, 0.f};
  const int nk = K >> 6;
  if (!pre) {
    GLOAD(r0, 0);
    GLOAD(r1, 64);
  }
  SSTORE(r0, 0);
  lds_barrier();
  for (int kt = 0; kt < nk; kt += 2) {
    if (kt + 2 < nk) GLOAD(r0, (kt + 2) << 6);
    else if (nA) NLOAD(r0, 0);
    COMPUTE(0);
    SSTORE(r1, 1);
    lds_barrier();
    if (kt + 3 < nk) GLOAD(r1, (kt + 3) << 6);
    else if (nA) NLOAD(r1, 64);
    COMPUTE(1);
    if (kt + 2 < nk) SSTORE(r0, 0);
    lds_barrier();
  }
#undef GLOAD
#undef NLOAD
#undef SSTORE
#undef COMPUTE
}

struct TD {
  const u16* A;
  const u16* B;
  u16* C;
  long lda, ldb, ldc;
  int K;
  int mode;
  int split;
  float scale;
  int tok0, col0;
  const float* g;
};

template <int MI = 4>
DI void run_tile2(const Prm& p, const TD& d, char* smem, Stg& r0, Stg& r1, bool pre, const u16* nA, long nlda,
                 const u16* nB, long nldb);
DI void run_tile(const Prm& p, const TD& d, char* smem) {
  Stg r0, r1;
  run_tile2<4>(p, d, smem, r0, r1, false, nullptr, 0, nullptr, 0);
}
template <int MI>
DI void run_tile2(const Prm& p, const TD& d, char* smem, Stg& r0, Stg& r1, bool pre, const u16* nA, long nlda,
                 const u16* nB, long nldb) {
  f32x4 acc[MI][4];
  gemm_tile<MI>(acc, d.A, d.lda, d.B, d.ldb, d.K, smem, r0, r1, pre, nA, nlda, nB, nldb);
  const int tid = mytid(), lane = tid & 63, wid = tid >> 6;
  const int wm = wid >> 1, wn = wid & 1, fr = lane & 15, fq = lane >> 4;
  if (d.mode == 4) {
    const int which = d.col0 >> 2, h = d.col0 & 3;
    const float* gain = d.g + which * 64 + fq * 4;
    const float* RC = (const float*)(p.ws + OFF_ROPE);
    const float* RS = RC + 65536;
    u16* dstb = d.C + (which ? 18874368L : 0L);
    const float qs = which ? 1.f : 0.18033688011112042f;
#pragma unroll
    for (int mi = 0; mi < MI; ++mi) {
      const int tok = d.tok0 + wm * (MI * 16) + mi * 16 + fr;
      float ss = 0.f;
#pragma unroll
      for (int ni = 0; ni < 4; ++ni)
#pragma unroll
        for (int j = 0; j < 4; ++j) ss += acc[mi][ni][j] * acc[mi][ni][j];
      ss += __shfl_xor(ss, 16);
      ss += __shfl_xor(ss, 32);
      const float inv = rsqrtf(ss * (1.f / 64.f) + 1e-6f) * qs;
      int b, P;
      const bool lat = tok < T_LAT;
      if (lat) { b = tok >> 11; P = 256 + (tok & 2047); }
      else { b = (tok - T_LAT) >> 8; P = (tok - T_LAT) & 255; }
      float y[4][4];
#pragma unroll
      for (int ni = 0; ni < 4; ++ni) {
        float4 g4 = *(const float4*)(gain + ni * 16);
        y[ni][0] = acc[mi][ni][0] * inv * g4.x; y[ni][1] = acc[mi][ni][1] * inv * g4.y;
        y[ni][2] = acc[mi][ni][2] * inv * g4.z; y[ni][3] = acc[mi][ni][3] * inv * g4.w;
      }
      u16* dst = dstb + ((long)((b * 4 + h) * 2 + wn) * 2304 + P) * 64 + fq * 4;
#pragma unroll
      for (int ni = 0; ni < 4; ++ni) {
        float o0 = y[ni][0], o1 = y[ni][1], o2 = y[ni][2], o3 = y[ni][3];
        if (lat) {
          const int l = tok & 2047, a = ni >> 1;
          float4 c4 = *(const float4*)(RC + (l * 2 + a) * 16 + fq * 4);
          float4 s4 = *(const float4*)(RS + (l * 2 + a) * 16 + fq * 4);
          const float sg = (ni & 1) ? 1.f : -1.f;
          o0 = y[ni][0] * c4.x + sg * y[ni ^ 1][0] * s4.x;
          o1 = y[ni][1] * c4.y + sg * y[ni ^ 1][1] * s4.y;
          o2 = y[ni][2] * c4.z + sg * y[ni ^ 1][2] * s4.z;
          o3 = y[ni][3] * c4.w + sg * y[ni ^ 1][3] * s4.w;
        }
        uint2 o;
        o.x = pk_bf16(o0, o1);
        o.y = pk_bf16(o2, o3);
        *(uint2*)(dst + ni * 16) = o;
      }
    }
    return;
  }
#pragma unroll
  for (int mi = 0; mi < MI; ++mi)
#pragma unroll
    for (int ni = 0; ni < 4; ++ni) {
      int r = wm * (MI * 16) + mi * 16 + fr, c = wn * 64 + ni * 16 + fq * 4;
      f32x4 v = acc[mi][ni];
      if (d.mode == 0) {
        long ro = d.split ? ((long)(r & 127) * d.ldc + (long)(r >> 7) * d.split) : (long)r * d.ldc;
        ushort4 o;
        o.x = f2bf(v[0] * d.scale); o.y = f2bf(v[1] * d.scale); o.z = f2bf(v[2] * d.scale); o.w = f2bf(v[3] * d.scale);
        *(ushort4*)(d.C + ro + c) = o;
      } else if (d.mode == 1) {
        ushort4 o;
        float t0 = fmaxf(v[0], 0.f), t1 = fmaxf(v[1], 0.f), t2 = fmaxf(v[2], 0.f), t3 = fmaxf(v[3], 0.f);
        o.x = f2bf(t0 * t0); o.y = f2bf(t1 * t1); o.z = f2bf(t2 * t2); o.w = f2bf(t3 * t3);
        *(ushort4*)(d.C + (long)r * d.ldc + c) = o;
      } else if (d.mode == 3) {
        if (wn == 0 && ni == 0) *(float4*)((float*)d.C + (long)r * 16 + fq * 4) = float4{v[0], v[1], v[2], v[3]};
      } else {
        float4* xp = (float4*)(xrow(p, d.tok0 + r) + d.col0 + c);
        float4 g4 = *(const float4*)(d.g + d.col0 + c);
        float4 x4 = *xp;
        x4.x += g4.x * v[0]; x4.y += g4.y * v[1]; x4.z += g4.z * v[2]; x4.w += g4.w * v[3];
        *xp = x4;
      }
    }
}

DI void ph_init(const Prm& p, char* smem) {
  const long gt = (long)mybid() * 512 + mytid(), gn = (long)gridDim.x * 512;
  {
    const float4* s = (const float4*)p.x;
    float4* d = (float4*)p.out;
#pragma unroll 8
    for (long i = gt; i < 32768L * 256; i += gn) d[i] = s[i];
    const float4* s2 = (const float4*)p.ctx;
    float4* d2 = (float4*)(p.ws + OFF_XC);
#pragma unroll 8
    for (long i = gt; i < 4096L * 256; i += gn) d2[i] = s2[i];
  }
  {
    u16* DL = (u16*)(p.ws + OFF_DL);
    for (long i = gt; i < 2048L * 4096; i += gn) {
      int l = (int)(i >> 12), kk = (int)(i & 4095), lp = kk & 2047, part = kk >> 11;
      int m = (l * lp) & 2047;
      float ang = (float)m * (6.283185307179586f / 2048.f);
      DL[i] = f2bf(part ? -sinf(ang) : cosf(ang));
    }
    u16* DLC = (u16*)(p.ws + OFF_DLC);
    for (long i = gt; i < 256L * 512; i += gn) {
      int l = (int)(i >> 9), kk = (int)(i & 511), lp = kk & 255, part = kk >> 8;
      int m = (l * lp) & 255;
      float ang = (float)m * (6.283185307179586f / 256.f);
      DLC[i] = f2bf(part ? -sinf(ang) : cosf(ang));
    }
    {
      float* RC = (float*)(p.ws + OFF_ROPE);
      float* RS = RC + 65536;
      for (long i = gt; i < 65536; i += gn) {
        int l = (int)(i >> 5), a = (int)(i >> 4) & 1, f = (int)(i & 15);
        float pos = a ? (float)(l & 63) : (float)(l >> 6);
        float ang = pos * powf(10000.f, -(float)f / 16.f);
        RC[i] = cosf(ang);
        RS[i] = sinf(ang);
      }
    }
    u16* DC = (u16*)(p.ws + OFF_DC);
    for (long i = gt; i < 256L * 128; i += gn) {
      int j2 = (int)(i >> 7), ii = (int)(i & 127), part = j2 >> 7, j = j2 & 127;
      int m = (ii * j) & 127;
      float ang = (float)m * (6.283185307179586f / 128.f);
      DC[i] = f2bf(part ? sinf(ang) : cosf(ang));
    }
  }
  float* sc = (float*)smem;
  float* red = sc + 17 * 1024;
  const int tid = mytid();
  for (int e = tid; e < 17 * 1024; e += 512) {
    int bb = e >> 10, k = e & 1023;
    float v = bb < 16 ? p.c[bb * 1024 + k] : p.c_ctx[k];
    sc[e] = v / (1.f + expf(-v));
  }
  __syncthreads();
  float* MOD = (float*)(p.ws + OFF_MOD);
  for (int it = mybid(); it < 192; it += gridDim.x) {
    int li = it / 48, cgp = it % 48;
    int cl = tid & 127, kq = tid >> 7, n = cgp * 128 + cl;
    float a[17];
#pragma unroll
    for (int b = 0; b < 17; ++b) a[b] = 0.f;
    const float* w = p.w_ada + ((long)li * 1024 + kq * 256) * 6144 + n;
#pragma unroll 1
    for (int k = 0; k < 256; k += 8) {
      float wv[8];
#pragma unroll
      for (int u = 0; u < 8; ++u) wv[u] = w[(long)(k + u) * 6144];
#pragma unroll
      for (int u = 0; u < 8; ++u) {
#pragma unroll
        for (int b = 0; b < 17; ++b) a[b] += sc[b * 1024 + kq * 256 + k + u] * wv[u];
        asm volatile("" ::: "memory");
      }
    }
#pragma unroll
    for (int b = 0; b < 17; ++b) red[(kq * 17 + b) * 128 + cl] = a[b];
    __syncthreads();
    for (int e = tid; e < 17 * 128; e += 512) {
      int b = e >> 7, c2 = e & 127, n2 = cgp * 128 + c2;
      float v = p.b_ada[li * 6144 + n2];
      for (int q = 0; q < 4; ++q) v += red[(q * 17 + b) * 128 + c2];
      MOD[((long)li * 17 + b) * 6144 + n2] = v;
    }
    __syncthreads();
  }
}

DI long tr_job(long base, const float* src, int K, int N, u16* dst, int nb, char* smem) {
  float* t = (float*)smem;
  const int tk = K >> 6, tn = (N + 63) >> 6, per = tk * tn, total = per * nb;
  const int tid = mytid();
  const int G = gridDim.x;
  float v[8];
  int it = first_item(base);
  if (it < total) {
    int b = it / per, r = it % per, kt = r / tn, nt = r % tn;
    const float* s = src + (long)b * K * N;
#pragma unroll
    for (int i = 0; i < 8; ++i) {
      int id = tid + i * 512, kk = id >> 6, nn = id & 63;
      v[i] = (nt * 64 + nn < N) ? s[(long)(kt * 64 + kk) * N + nt * 64 + nn] : 0.f;
    }
  }
  for (; it < total; it += G) {
    int b = it / per, r = it % per, kt = r / tn, nt = r % tn;
    u16* d = dst + (long)b * K * N;
    int k0 = kt * 64, n0 = nt * 64;
#pragma unroll
    for (int i = 0; i < 8; ++i) {
      int id = tid + i * 512, kk = id >> 6, nn = id & 63;
      t[kk * 65 + nn] = v[i];
    }
    __syncthreads();
    if (it + G < total) {
      int it2 = it + G, b2 = it2 / per, r2 = it2 % per, kt2 = r2 / tn, nt2 = r2 % tn;
      const float* s2 = src + (long)b2 * K * N;
#pragma unroll
      for (int i = 0; i < 8; ++i) {
        int id = tid + i * 512, kk = id >> 6, nn = id & 63;
        v[i] = (nt2 * 64 + nn < N) ? s2[(long)(kt2 * 64 + kk) * N + nt2 * 64 + nn] : 0.f;
      }
    }
#pragma unroll
    for (int i = 0; i < 8; ++i) {
      int id = tid + i * 512, nn = id >> 6, kk = id & 63;
      if (n0 + nn < N) d[(long)(n0 + nn) * K + k0 + kk] = f2bf(t[kk * 65 + nn]);
    }
    __syncthreads();
  }
  return base + total;
}

DI void ph_norm(const Prm& p, int li, int which) {
  const int lane = mytid() & 63;
  const int gw = mybid() * 8 + (mytid() >> 6), nw = gridDim.x * 8;
  const float* nwt = (which ? p.norm2 : p.norm1) + li * 1024;
  const float* MOD = (const float*)(p.ws + OFF_MOD);
  u16* H = (u16*)(p.ws + OFF_HBF);
  const int nrows = (which && li == 3) ? T_LAT : T_ALL;
  for (int row = gw; row < nrows; row += 2 * nw) {
    const int row2 = row + nw;
    const bool has2 = row2 < nrows;
    const float* xr = xrow(p, row);
    const float* xr2 = xrow(p, has2 ? row2 : row);
    float4 v[4], u[4];
    float ss = 0.f, ss2 = 0.f;
#pragma unroll
    for (int i = 0; i < 4; ++i) {
      v[i] = *(const float4*)(xr + i * 256 + lane * 4);
      u[i] = *(const float4*)(xr2 + i * 256 + lane * 4);
    }
#pragma unroll
    for (int i = 0; i < 4; ++i) {
      ss += v[i].x * v[i].x + v[i].y * v[i].y + v[i].z * v[i].z + v[i].w * v[i].w;
      ss2 += u[i].x * u[i].x + u[i].y * u[i].y + u[i].z * u[i].z + u[i].w * u[i].w;
    }
#pragma unroll
    for (int o = 32; o; o >>= 1) {
      ss += __shfl_xor(ss, o);
      ss2 += __shfl_xor(ss2, o);
    }
    const float inv = rsqrtf(ss * (1.f / 1024.f) + 1e-6f), inv2 = rsqrtf(ss2 * (1.f / 1024.f) + 1e-6f);
    const int bb = row < T_LAT ? (row >> 11) : 16, bb2 = row2 < T_LAT ? (row2 >> 11) : 16;
    const float* sh = MOD + ((long)li * 17 + bb) * 6144 + (which ? 3 : 0) * 1024;
    const float* sh2 = MOD + ((long)li * 17 + (has2 ? bb2 : bb)) * 6144 + (which ? 3 : 0) * 1024;
#pragma unroll
    for (int i = 0; i < 4; ++i) {
      int c = i * 256 + lane * 4;
      float4 w4 = *(const float4*)(nwt + c);
      {
        float4 s4 = *(const float4*)(sh + 1024 + c), h4 = *(const float4*)(sh + c);
        uint2 o;
        o.x = pk_bf16(v[i].x * inv * w4.x * (1.f + s4.x) + h4.x, v[i].y * inv * w4.y * (1.f + s4.y) + h4.y);
        o.y = pk_bf16(v[i].z * inv * w4.z * (1.f + s4.z) + h4.z, v[i].w * inv * w4.w * (1.f + s4.w) + h4.w);
        *(uint2*)(H + (long)row * 1024 + c) = o;
      }
      if (has2) {
        float4 s4 = *(const float4*)(sh2 + 1024 + c), h4 = *(const float4*)(sh2 + c);
        uint2 o;
        o.x = pk_bf16(u[i].x * inv2 * w4.x * (1.f + s4.x) + h4.x, u[i].y * inv2 * w4.y * (1.f + s4.y) + h4.y);
        o.y = pk_bf16(u[i].z * inv2 * w4.z * (1.f + s4.z) + h4.z, u[i].w * inv2 * w4.w * (1.f + s4.w) + h4.w);
        *(uint2*)(H + (long)row2 * 1024 + c) = o;
      }
    }
  }
}

DI void ph_taps1(const Prm& p, int li, long base, char* smem) {
  float* f = (float*)smem;
  float* hraw = (float*)(p.ws + OFF_AR + 5 * U38);
  const int tid = mytid();
  for (int it = first_item(base); it < 288; it += gridDim.x) {
    const int L = it < 256 ? 2048 : 256, j0 = it < 256 ? it * 8 : (it - 256) * 8;
    const int lg = tid >> 6, kk = tid & 63;
    if (tid < 8 * 33) {
      int l2 = tid / 33, e = tid % 33, j = j0 + l2;
      float t = (float)j / (float)(L - 1);
      float w = 6.283185307179586f * (float)j / (float)L;
      float v;
      if (e == 0) v = t;
      else {
        int bi = (e - 1) & 15;
        float band = 1e-4f + (float)bi * ((15.f - 1e-4f) / 15.f);
        v = (e <= 16) ? cosf(band * w) : -sinf(band * w);
      }
      f[l2 * 40 + e] = v;
    }
    __syncthreads();
    {
      float v = p.hy_b1[li * 64 + kk];
#pragma unroll 3
      for (int e = 0; e < 33; ++e) v += f[lg * 40 + e] * p.hy_w1[(li * 33 + e) * 64 + kk];
      f[320 + lg * 64 + kk] = sinf(p.hy_freq[(li * 2 + 0) * 64 + kk] * v);
    }
    __syncthreads();
    {
      float v = p.hy_b2[li * 64 + kk];
#pragma unroll 4
      for (int m = 0; m < 64; ++m) v += f[320 + lg * 64 + m] * p.hy_w2[(li * 64 + m) * 64 + kk];
      f[832 + lg * 64 + kk] = sinf(p.hy_freq[(li * 2 + 1) * 64 + kk] * v);
    }
    __syncthreads();
    {
      float h[4][8];
#pragma unroll
      for (int i = 0; i < 4; ++i)
#pragma unroll
        for (int l2 = 0; l2 < 8; ++l2) h[i][l2] = 0.f;
      const float* w3 = p.hy_w3 + (long)li * 64 * 2048 + tid;
#pragma unroll 2
      for (int k = 0; k < 64; ++k) {
        float wv[4];
#pragma unroll
        for (int i = 0; i < 4; ++i) wv[i] = w3[(long)k * 2048 + i * 512];
#pragma unroll
        for (int l2 = 0; l2 < 8; ++l2) {
          float hv = f[832 + l2 * 64 + k];
#pragma unroll
          for (int i = 0; i < 4; ++i) h[i][l2] += hv * wv[i];
        }
      }
#pragma unroll
      for (int i = 0; i < 4; ++i) {
        int n = tid + i * 512, ch = n & 511;
        float delta = fabsf(-3.0701134573253946f + (float)ch * ((-15.350567286626973f + 3.0701134573253946f) / 511.f));
#pragma unroll
        for (int l2 = 0; l2 < 8; ++l2) {
          int j = j0 + l2;
          float t = (float)j / (float)(L - 1);
          long row = (it < 256) ? j : 2048 + j;
          hraw[row * 2048 + n] = h[i][l2] * expf(-t * delta);
        }
      }
    }
    __syncthreads();
  }
}
DI void ph_taps2(const Prm& p, long base, char* smem) {
  float* vals = (float*)smem;
  float* red = vals + 8 * 2048;
  const float* hraw = (const float*)(p.ws + OFF_AR + 5 * U38);
  const int tid = mytid(), cl = tid & 3, dir = (tid >> 2) & 1, jg = tid >> 3;
  for (int it = first_item(base); it < 512; it += gridDim.x) {
    int ls = it >> 8, order = (it >> 7) & 1, cgp = it & 127;
    int L = ls ? 256 : 2048;
    const float* hr = hraw + (long)(ls ? 2048 : 0) * 2048;
    u16* G = (u16*)(p.ws + (ls ? OFF_TAPC : OFF_TAPL));
    int ch = cgp * 4 + cl, n = order * 1024 + dir * 512 + ch;
    float s = 0.f;
#pragma unroll 8
    for (int j = jg; j < L; j += 64) {
      float v = hr[(long)j * 2048 + n];
      vals[(cl * 2 + dir) * L + j] = v;
      s += (dir == 1 && j == 0) ? 0.f : fabsf(v);
    }
    red[(tid >> 2) * 4 + cl] = s;
    __syncthreads();
    if (tid < 4) {
      float tot = 0.f;
#pragma unroll 8
      for (int r = 0; r < 128; ++r) tot += red[r * 4 + tid];
      red[512 + tid] = 1.f / tot;
    }
    __syncthreads();
    for (int idx = tid; idx < 8 * L; idx += 512) {
      int q = idx / L, j = idx % L, c2 = q >> 1, d2 = q & 1;
      float v = vals[idx] * red[512 + c2];
      u16* g = G + (long)(order * 512 + cgp * 4 + c2) * (2 * L);
      if (d2 == 0) g[L + j] = f2bf(v);
      else if (j > 0) g[L - j] = f2bf(v);
      else g[0] = 0;
    }
    __syncthreads();
  }
}

DI void ph_pdab(const Prm& p, int li, char* smem) {
  float* wl = (float*)smem;
  const int tid = mytid(), lane = tid & 63;
#pragma unroll 8
  for (int e = tid; e < 1024 * 16; e += 512) wl[e] = p.w_in[((long)li * 1024 + (e >> 4)) * NIN + 5632 + (e & 15)];
  __syncthreads();
  const u16* H = (const u16*)(p.ws + OFF_HBF);
  float* out = (float*)(p.ws + OFF_PDAB);
  const int gw = mybid() * 8 + (tid >> 6), nw = gridDim.x * 8;
  for (int tok = gw; tok < T_ALL; tok += nw) {
    float a[16];
#pragma unroll
    for (int j = 0; j < 16; ++j) a[j] = 0.f;
    float hv[16];
#pragma unroll
    for (int i = 0; i < 16; ++i) hv[i] = bf2f(H[(long)tok * 1024 + lane + i * 64]);
#pragma unroll
    for (int i = 0; i < 16; ++i) {
      float h = hv[i];
      const float4* wp = (const float4*)(wl + (lane + i * 64) * 16);
#pragma unroll
      for (int q = 0; q < 4; ++q) {
        float4 w4 = wp[q];
        a[q * 4 + 0] += h * w4.x;
        a[q * 4 + 1] += h * w4.y;
        a[q * 4 + 2] += h * w4.z;
        a[q * 4 + 3] += h * w4.w;
      }
      if ((i & 3) == 3) asm volatile("" ::: "memory");
    }
#pragma unroll
    for (int o = 32; o; o >>= 1)
#pragma unroll
      for (int j = 0; j < 16; ++j) a[j] += __shfl_xor(a[j], o);
    float v = a[0];
#pragma unroll
    for (int j = 1; j < 16; ++j) v = (lane == j) ? a[j] : v;
    if (lane < 16) out[(long)tok * 16 + lane] = v;
  }
  __syncthreads();
}

DI void ph_dncl(const Prm& p, int li, char* smem) {
  const int tid = mytid(), lane = tid & 63, wid = tid >> 6, fr = lane & 15, fq = lane >> 4;
  u16* qn = (u16*)smem;
  u16* kn = qn + 64 * 144;
  float* fb = (float*)(smem + 36864);
  float* KK = fb;
  float* QK = KK + 64 * 65;
  float* Am = QK + 64 * 65;
  float* Tm = Am + 2 * 64 * 65;
  float* gcs = Tm + 2 * 64 * 65;
  float* bts = gcs + 128;
  const u16* PD = (const u16*)(p.ws + OFF_AR);
  const float* AB = (const float*)(p.ws + OFF_PDAB);
  u16* DQ = (u16*)(p.ws + OFF_Y);
  u16* DK = DQ + 18874368L;
  u16* DV = DK + 18874368L;
  u16* CL = (u16*)(p.ws + OFF_AR + 3 * U38);
  float* GC = (float*)(p.ws + OFF_GC);
  float* BT = (float*)(p.ws + OFF_BETA);
  const float* cw = p.dn_conv + (long)li * 3 * 1536;
  for (int it = mybid(); it < 2304; it += gridDim.x) {
    const int b = it / 144, r0 = it % 144, oc = r0 >> 2, h = r0 & 3;
    const int pos0 = oc * 64, s0 = oc < 4 ? 0 : 256, e0 = oc < 4 ? 256 : 2304;
    if (tid < 384) {
      const int cgp = tid % 48, rs = tid / 48;
      const int part = cgp >> 4, d0 = (cgp & 15) * 8, col = part * 512 + h * 128 + d0;
      const u16* basep = PD + (long)tokof(b, pos0) * 1536 + col;
      float wt[3][8];
#pragma unroll
      for (int tp = 0; tp < 3; ++tp) {
        float4 wa = *(const float4*)(cw + tp * 1536 + col), wb = *(const float4*)(cw + tp * 1536 + col + 4);
        wt[tp][0] = wa.x; wt[tp][1] = wa.y; wt[tp][2] = wa.z; wt[tp][3] = wa.w;
        wt[tp][4] = wb.x; wt[tp][5] = wb.y; wt[tp][6] = wb.z; wt[tp][7] = wb.w;
      }
#pragma unroll 1
      for (int hf = 0; hf < 2; ++hf) {
        u32x4 rw[6];
#pragma unroll
        for (int i = 0; i < 6; ++i) {
          int j = rs * 8 + hf * 4 - 1 + i, P = pos0 + j;
          rw[i] = (P >= s0 && P < e0) ? *(const u32x4*)(basep + (long)j * 1536) : u32x4{0u, 0u, 0u, 0u};
        }
#pragma unroll
        for (int r = 0; r < 4; ++r) {
#pragma unroll
          for (int e = 0; e < 8; ++e) {
            unsigned w0_ = rw[r][e >> 1], w1_ = rw[r + 1][e >> 1], w2_ = rw[r + 2][e >> 1];
            float x0 = (e & 1) ? __uint_as_float(w0_ & 0xffff0000u) : __uint_as_float(w0_ << 16);
            float x1 = (e & 1) ? __uint_as_float(w1_ & 0xffff0000u) : __uint_as_float(w1_ << 16);
            float x2 = (e & 1) ? __uint_as_float(w2_ & 0xffff0000u) : __uint_as_float(w2_ << 16);
            float v = wt[0][e] * x0 + wt[1][e] * x1 + wt[2][e] * x2;
            fb[(rs * 8 + hf * 4 + r) * 385 + part * 128 + d0 + e] = v * __builtin_amdgcn_rcpf(1.f + __expf(-v));
          }
        }
      }
    }
    __syncthreads();
    for (int jj = 0; jj < 8; ++jj) {
      int j = wid * 8 + jj, P = pos0 + j;
      long go = ((long)(b * 4 + h) * 2304 + P) * 128;
      float q0 = fb[j * 385 + lane], q1 = fb[j * 385 + 64 + lane];
      float k0 = fb[j * 385 + 128 + lane], k1 = fb[j * 385 + 192 + lane];
      float v0 = fb[j * 385 + 256 + lane], v1 = fb[j * 385 + 320 + lane];
      float iq = rsqrtf(wsum(q0 * q0 + q1 * q1) + 1e-6f), ik = rsqrtf(wsum(k0 * k0 + k1 * k1) + 1e-6f);
      u16 a0 = f2bf(q0 * iq), a1 = f2bf(q1 * iq), c0 = f2bf(k0 * ik), c1 = f2bf(k1 * ik);
      qn[j * 144 + lane] = a0; qn[j * 144 + 64 + lane] = a1;
      kn[j * 144 + lane] = c0; kn[j * 144 + 64 + lane] = c1;
      DQ[go + lane] = a0; DQ[go + 64 + lane] = a1;
      DK[go + lane] = c0; DK[go + 64 + lane] = c1;
      DV[go + lane] = f2bf(v0); DV[go + 64 + lane] = f2bf(v1);
    }
    __syncthreads();
#pragma unroll
    for (int u = 0; u < 4; ++u) {
      int tt = wid * 4 + u, which = tt >> 4, ti = (tt >> 2) & 3, tj = tt & 3;
      const u16* Ap = (which ? qn : kn) + (ti * 16 + fr) * 144 + fq * 8;
      const u16* Bp = kn + (tj * 16 + fr) * 144 + fq * 8;
      f32x4 a = {0.f, 0.f, 0.f, 0.f};
#pragma unroll
      for (int ks = 0; ks < 4; ++ks) a = MFMA(*(const bf16x8*)(Ap + ks * 32), *(const bf16x8*)(Bp + ks * 32), a);
      float* dst = which ? QK : KK;
#pragma unroll
      for (int j = 0; j < 4; ++j) dst[(ti * 16 + fq * 4 + j) * 65 + tj * 16 + fr] = a[j];
    }
    if (tid < 128) {
      int d = tid >> 6, r = tid & 63, j = d ? 63 - r : r;
      int tok = tokof(b, pos0 + j);
      float av = AB[(long)tok * 16 + d * 4 + h], bv = AB[(long)tok * 16 + 8 + d * 4 + h];
      float xx = av + p.dn_dt_bias[li * 8 + d * 4 + h];
      float sp = fmaxf(xx, 0.f) + __logf(1.f + __expf(-fabsf(xx)));
      float g = -expf(p.dn_a_log[li * 8 + d * 4 + h]) * sp;
      for (int o = 1; o < 64; o <<= 1) {
        float t = __shfl_up(g, o);
        if (r >= o) g += t;
      }
      float be = 1.f / (1.f + expf(-bv));
      gcs[d * 64 + r] = g;
      bts[d * 64 + r] = be;
      long ci = ((long)((b * 4 + h) * 2 + d) * 36 + oc) * 64 + r;
      GC[ci] = g;
      BT[ci] = be;
    }
    __syncthreads();
#pragma unroll 4
    for (int e = tid; e < 8192; e += 512) {
      int d = e >> 12, s = (e >> 6) & 63, r = e & 63;
      int j = d ? 63 - r : r, js = d ? 63 - s : s;
      float v = 0.f;
      if (r > s) v = bts[d * 64 + r] * KK[j * 65 + js] * __expf(gcs[d * 64 + r] - gcs[d * 64 + s]);
      Am[(d * 64 + s) * 64 + r] = v;
    }
#pragma unroll 4
    for (int e = tid; e < 8192; e += 512) {
      int d = e >> 12, r = (e >> 6) & 63, s = e & 63;
      int j = d ? 63 - r : r, js = d ? 63 - s : s;
      float dec = (r >= s) ? __expf(gcs[d * 64 + r] - gcs[d * 64 + s]) : 0.f;
      long ci = (long)((b * 4 + h) * 2 + d) * 36 + oc;
      CL[ci * 8192 + 4096 + r * 64 + s] = f2bf(QK[j * 65 + js] * dec * 0.08838834764831845f);
    }
    __syncthreads();
    {
      const int d = tid >> 8, c = (tid >> 2) & 63, q = tid & 3;
      const float* Atq = Am + d * 64 * 64 + q;
      float* T = Tm + d * 64 * 65;
      float t[16];
#pragma unroll
      for (int i = 0; i < 16; ++i) t[i] = (4 * i + q == c) ? 1.f : 0.f;
#pragma unroll
      for (int s2 = 0; s2 < 63; ++s2) {
        constexpr int dummy = 0;
        const int is = s2 >> 2, qs = s2 & 3;
        const int ctl = qs | (qs << 2) | (qs << 4) | (qs << 6);
        int tsb;
        if (qs == 0) tsb = __builtin_amdgcn_update_dpp(0, __float_as_int(t[is]), 0x00, 0xf, 0xf, false);
        else if (qs == 1) tsb = __builtin_amdgcn_update_dpp(0, __float_as_int(t[is]), 0x55, 0xf, 0xf, false);
        else if (qs == 2) tsb = __builtin_amdgcn_update_dpp(0, __float_as_int(t[is]), 0xAA, 0xf, 0xf, false);
        else tsb = __builtin_amdgcn_update_dpp(0, __float_as_int(t[is]), 0xFF, 0xf, 0xf, false);
        (void)ctl; (void)dummy;
        const float ts = __int_as_float(tsb);
#pragma unroll
        for (int i = is; i < 16; ++i) t[i] -= Atq[s2 * 64 + 4 * i] * ts;
        if ((s2 & 7) == 7) asm volatile("" ::: "memory");
      }
#pragma unroll
      for (int i = 0; i < 16; ++i) T[(4 * i + q) * 65 + c] = t[i];
    }
    __syncthreads();
    for (int e = tid; e < 8192; e += 512) {
      int d = e >> 12, rc = e & 4095;
      long ci = (long)((b * 4 + h) * 2 + d) * 36 + oc;
      CL[ci * 8192 + rc] = f2bf(Tm[(d * 64 + (rc >> 6)) * 65 + (rc & 63)]);
    }
    __syncthreads();
  }
}

DI void ph_dnscan(const Prm& p, char* smem) {
  const int tid = mytid(), lane = tid & 63, wid = tid >> 6, fr = lane & 15, fq = lane >> 4;
  u16* Kg = (u16*)smem;
  u16* Qg = Kg + 64 * 144;
  u16* KdT = Qg + 64 * 144;
  u16* Tl = KdT + 128 * 80;
  u16* Il = Tl + 64 * 80;
  u16* ST = Il + 64 * 80;
  u16* RT = ST + 64 * 144;
  u16* VN = RT + 64 * 80;
  const u16* DQ = (const u16*)(p.ws + OFF_Y);
  const u16* DK = DQ + 18874368L;
  const u16* DV = DK + 18874368L;
  const u16* CL = (const u16*)(p.ws + OFF_AR + 3 * U38);
  const float* GC = (const float*)(p.ws + OFF_GC);
  const float* BT = (const float*)(p.ws + OFF_BETA);
  const int vt = wid & 3, rp = wid >> 2;
  for (int it = mybid(); it < 256; it += gridDim.x) {
    const int b = it >> 4, h = (it >> 2) & 3, d = (it >> 1) & 1, vs = it & 1;
    u16* O = (u16*)(p.ws + OFF_AR + (d ? 6 : 5) * U38);
    f32x4 S[4];
#pragma unroll
    for (int i = 0; i < 4; ++i) S[i] = f32x4{0.f, 0.f, 0.f, 0.f};
    for (int e = tid; e < 64 * 144; e += 512) ST[e] = 0;
    const long seqb = (long)(b * 4 + h) * 2304;
    const long cib = (long)((b * 4 + h) * 2 + d) * 36;
    u32x4 rk0, rk1, rq0, rq1, rT, rI;
    float rg0, rg1, rgl;
    uint2 rv0, rv1;
    float rb0, rb1;
    const int lr0 = tid >> 4, lr1 = (tid + 512) >> 4, lch = tid & 15;
    const int lj0 = d ? 63 - lr0 : lr0, lj1 = d ? 63 - lr1 : lr1;
    const int vr0 = (rp * 2) * 16 + fr, vr1 = (rp * 2 + 1) * 16 + fr;
    const int vj0 = d ? 63 - vr0 : vr0, vj1 = d ? 63 - vr1 : vr1;
#define SCAN_LOAD_KQ(ocx)                                                                    \
  {                                                                                          \
    const long ci_ = cib + (ocx);                                                            \
    const long g0_ = (seqb + (ocx) * 64 + lj0) * 128 + lch * 8, g1_ = (seqb + (ocx) * 64 + lj1) * 128 + lch * 8; \
    rk0 = *(const u32x4*)(DK + g0_); rk1 = *(const u32x4*)(DK + g1_);                        \
    rq0 = *(const u32x4*)(DQ + g0_); rq1 = *(const u32x4*)(DQ + g1_);                        \
    rT = *(const u32x4*)(CL + ci_ * 8192 + (tid >> 3) * 64 + (tid & 7) * 8);                 \
    rI = *(const u32x4*)(CL + ci_ * 8192 + 4096 + (tid >> 3) * 64 + (tid & 7) * 8);          \
    rg0 = GC[ci_ * 64 + lr0]; rg1 = GC[ci_ * 64 + lr1]; rgl = GC[ci_ * 64 + 63];             \
  }
#define SCAN_LOAD_V(ocx)                                                                     \
  {                                                                                          \
    const long ci_ = cib + (ocx);                                                            \
    rv0 = *(const uint2*)(DV + (seqb + (ocx) * 64 + vj0) * 128 + vs * 64 + vt * 16 + fq * 4); \
    rv1 = *(const uint2*)(DV + (seqb + (ocx) * 64 + vj1) * 128 + vs * 64 + vt * 16 + fq * 4); \
    rb0 = BT[ci_ * 64 + vr0]; rb1 = BT[ci_ * 64 + vr1];                                      \
  }
    {
      const int oc0 = d ? 3 : 0;
      SCAN_LOAD_KQ(oc0);
      SCAN_LOAD_V(oc0);
    }
    for (int i = 0; i < 36; ++i) {
      const int oc = d ? (i < 4 ? 3 - i : 39 - i) : i;
      const int ocn = d ? (i + 1 < 4 ? 3 - (i + 1) : 39 - (i + 1)) : i + 1;
      const int pos0 = oc * 64;
      const float gl = rgl;
      {
        float eg0 = __expf(rg0), ed0 = __expf(gl - rg0), eg1 = __expf(rg1), ed1 = __expf(gl - rg1);
        u32x4 ko0, qo0, ko1, qo1;
#pragma unroll
        for (int w = 0; w < 4; ++w) {
          float k0l = __uint_as_float(rk0[w] << 16), k0h = __uint_as_float(rk0[w] & 0xffff0000u);
          float q0l = __uint_as_float(rq0[w] << 16), q0h = __uint_as_float(rq0[w] & 0xffff0000u);
          float k1l = __uint_as_float(rk1[w] << 16), k1h = __uint_as_float(rk1[w] & 0xffff0000u);
          float q1l = __uint_as_float(rq1[w] << 16), q1h = __uint_as_float(rq1[w] & 0xffff0000u);
          ko0[w] = (unsigned)f2bf(k0l * eg0) | ((unsigned)f2bf(k0h * eg0) << 16);
          qo0[w] = (unsigned)f2bf(q0l * eg0 * 0.08838834764831845f) | ((unsigned)f2bf(q0h * eg0 * 0.08838834764831845f) << 16);
          ko1[w] = (unsigned)f2bf(k1l * eg1) | ((unsigned)f2bf(k1h * eg1) << 16);
          qo1[w] = (unsigned)f2bf(q1l * eg1 * 0.08838834764831845f) | ((unsigned)f2bf(q1h * eg1 * 0.08838834764831845f) << 16);
          KdT[(lch * 8 + 2 * w) * 80 + lr0] = f2bf(k0l * ed0);
          KdT[(lch * 8 + 2 * w + 1) * 80 + lr0] = f2bf(k0h * ed0);
          KdT[(lch * 8 + 2 * w) * 80 + lr1] = f2bf(k1l * ed1);
          KdT[(lch * 8 + 2 * w + 1) * 80 + lr1] = f2bf(k1h * ed1);
        }
        *(u32x4*)(Kg + lr0 * 144 + lch * 8) = ko0;
        *(u32x4*)(Qg + lr0 * 144 + lch * 8) = qo0;
        *(u32x4*)(Kg + lr1 * 144 + lch * 8) = ko1;
        *(u32x4*)(Qg + lr1 * 144 + lch * 8) = qo1;
        *(u32x4*)(Tl + (tid >> 3) * 80 + (tid & 7) * 8) = rT;
        *(u32x4*)(Il + (tid >> 3) * 80 + (tid & 7) * 8) = rI;
      }
      lds_barrier();
      if (i + 1 < 36) SCAN_LOAD_KQ(ocn);
      f32x4 ks_[2], qs_[2];
#pragma unroll
      for (int u = 0; u < 2; ++u) { ks_[u] = f32x4{0.f, 0.f, 0.f, 0.f}; qs_[u] = f32x4{0.f, 0.f, 0.f, 0.f}; }
#pragma unroll
      for (int kk = 0; kk < 4; ++kk) {
        bf16x8 a = *(const bf16x8*)(ST + (vt * 16 + fr) * 144 + kk * 32 + fq * 8);
#pragma unroll
        for (int u = 0; u < 2; ++u) {
          int rt = rp * 2 + u;
          bf16x8 bk = *(const bf16x8*)(Kg + (rt * 16 + fr) * 144 + kk * 32 + fq * 8);
          bf16x8 bq = *(const bf16x8*)(Qg + (rt * 16 + fr) * 144 + kk * 32 + fq * 8);
          ks_[u] = MFMA(a, bk, ks_[u]);
          qs_[u] = MFMA(a, bq, qs_[u]);
        }
      }
      {
        int v0 = vt * 16 + fq * 4;
        RT[(v0 + 0) * 80 + vr0] = f2bf(rb0 * (__uint_as_float(rv0.x << 16) - ks_[0][0]));
        RT[(v0 + 1) * 80 + vr0] = f2bf(rb0 * (__uint_as_float(rv0.x & 0xffff0000u) - ks_[0][1]));
        RT[(v0 + 2) * 80 + vr0] = f2bf(rb0 * (__uint_as_float(rv0.y << 16) - ks_[0][2]));
        RT[(v0 + 3) * 80 + vr0] = f2bf(rb0 * (__uint_as_float(rv0.y & 0xffff0000u) - ks_[0][3]));
        RT[(v0 + 0) * 80 + vr1] = f2bf(rb1 * (__uint_as_float(rv1.x << 16) - ks_[1][0]));
        RT[(v0 + 1) * 80 + vr1] = f2bf(rb1 * (__uint_as_float(rv1.x & 0xffff0000u) - ks_[1][1]));
        RT[(v0 + 2) * 80 + vr1] = f2bf(rb1 * (__uint_as_float(rv1.y << 16) - ks_[1][2]));
        RT[(v0 + 3) * 80 + vr1] = f2bf(rb1 * (__uint_as_float(rv1.y & 0xffff0000u) - ks_[1][3]));
      }
      if (i + 1 < 36) SCAN_LOAD_V(ocn);
      lds_barrier();
      {
        f32x4 vn[2];
#pragma unroll
        for (int u = 0; u < 2; ++u) vn[u] = f32x4{0.f, 0.f, 0.f, 0.f};
#pragma unroll
        for (int kk = 0; kk < 2; ++kk) {
          bf16x8 a = *(const bf16x8*)(RT + (vt * 16 + fr) * 80 + kk * 32 + fq * 8);
#pragma unroll
          for (int u = 0; u < 2; ++u) {
            bf16x8 bb = *(const bf16x8*)(Tl + ((rp * 2 + u) * 16 + fr) * 80 + kk * 32 + fq * 8);
            vn[u] = MFMA(a, bb, vn[u]);
          }
        }
#pragma unroll
        for (int u = 0; u < 2; ++u) {
          int r = (rp * 2 + u) * 16 + fr, v0 = vt * 16 + fq * 4;
#pragma unroll
          for (int j = 0; j < 4; ++j) VN[(v0 + j) * 80 + r] = f2bf(vn[u][j]);
        }
      }
      lds_barrier();
#pragma unroll
      for (int kk = 0; kk < 2; ++kk) {
        bf16x8 a = *(const bf16x8*)(VN + (vt * 16 + fr) * 80 + kk * 32 + fq * 8);
#pragma unroll
        for (int u = 0; u < 2; ++u) {
          bf16x8 bb = *(const bf16x8*)(Il + ((rp * 2 + u) * 16 + fr) * 80 + kk * 32 + fq * 8);
          qs_[u] = MFMA(a, bb, qs_[u]);
        }
      }
#pragma unroll
      for (int u = 0; u < 2; ++u) {
        int r = (rp * 2 + u) * 16 + fr, j = d ? 63 - r : r;
        u16* op = O + (long)tokof(b, pos0 + j) * 512 + h * 128 + vs * 64 + vt * 16 + fq * 4;
        ushort4 ov4;
        ov4.x = f2bf(qs_[u][0]); ov4.y = f2bf(qs_[u][1]); ov4.z = f2bf(qs_[u][2]); ov4.w = f2bf(qs_[u][3]);
        *(ushort4*)op = ov4;
      }
      {
        float ge = __expf(gl);
#pragma unroll
        for (int u = 0; u < 4; ++u) S[u] *= ge;
#pragma unroll
        for (int kk = 0; kk < 2; ++kk) {
          bf16x8 a = *(const bf16x8*)(VN + (vt * 16 + fr) * 80 + kk * 32 + fq * 8);
#pragma unroll
          for (int u = 0; u < 4; ++u) {
            bf16x8 bb = *(const bf16x8*)(KdT + ((rp * 4 + u) * 16 + fr) * 80 + kk * 32 + fq * 8);
            S[u] = MFMA(a, bb, S[u]);
          }
        }
#pragma unroll
        for (int u = 0; u < 4; ++u) {
          int dd = (rp * 4 + u) * 16 + fr, v0 = vt * 16 + fq * 4;
#pragma unroll
          for (int j = 0; j < 4; ++j) ST[(v0 + j) * 144 + dd] = f2bf(S[u][j]);
        }
      }
      lds_barrier();
    }
#undef SCAN_LOAD_KQ
#undef SCAN_LOAD_V
  }
}

DI void ph_dnfin(const Prm& p, int li) {
  const int lane = mytid() & 63;
  const int gw = mybid() * 8 + (mytid() >> 6), nw = gridDim.x * 8;
  const u16* O = (const u16*)(p.ws + OFF_AR + 5 * U38);
  const u16* O2 = (const u16*)(p.ws + OFF_AR + 6 * U38);
  u16* Z = (u16*)(p.ws + OFF_Y + 3 * U38);
  const float n0 = p.dn_norm[li * 128 + lane * 2], n1 = p.dn_norm[li * 128 + lane * 2 + 1];
#pragma unroll 2
  for (int tok = gw; tok < T_ALL; tok += nw) {
    ushort2 oa[4], ob[4], zz[4];
    float ox[4], oy[4], ss[4];
#pragma unroll
    for (int h = 0; h < 4; ++h) {
      long o = (long)tok * 512 + h * 128 + lane * 2;
      oa[h] = *(const ushort2*)(O + o);
      ob[h] = *(const ushort2*)(O2 + o);
      zz[h] = *(const ushort2*)(Z + o);
    }
#pragma unroll
    for (int h = 0; h < 4; ++h) {
      ox[h] = bf2f(oa[h].x) + bf2f(ob[h].x);
      oy[h] = bf2f(oa[h].y) + bf2f(ob[h].y);
      ss[h] = ox[h] * ox[h] + oy[h] * oy[h];
    }
#pragma unroll
    for (int o = 32; o; o >>= 1)
#pragma unroll
      for (int h = 0; h < 4; ++h) ss[h] += __shfl_xor(ss[h], o);
#pragma unroll
    for (int h = 0; h < 4; ++h) {
      float inv = rsqrtf(ss[h] * (1.f / 128.f) + 1e-6f);
      float z0 = bf2f(zz[h].x), z1 = bf2f(zz[h].y);
      ushort2 y;
      y.x = f2bf(ox[h] * inv * n0 * (z0 * __builtin_amdgcn_rcpf(1.f + __expf(-z0))));
      y.y = f2bf(oy[h] * inv * n1 * (z1 * __builtin_amdgcn_rcpf(1.f + __expf(-z1))));
      *(ushort2*)(Z + (long)tok * 512 + h * 128 + lane * 2) = y;
    }
  }
}

DI void ph_aprep(const Prm& p, int li) {
  const int lane = mytid() & 63;
  const int gw = mybid() * 8 + (mytid() >> 6), nw = gridDim.x * 8;
  const u16* PA = (const u16*)(p.ws + OFF_AR);
  u16* QH = (u16*)(p.ws + OFF_AR + 3 * U38);
  u16* KH = QH + 18874368L;
  const int f = lane & 15;
  const float inv_f = powf(10000.f, -(float)f / 16.f);
  for (int tok = gw; tok < T_ALL; tok += nw) {
    int b, P;
    float cs = 1.f, sn = 0.f;
    if (tok < T_LAT) {
      b = tok >> 11;
      int l = tok & 2047;
      P = 256 + l;
      float pos = (lane < 32) ? (float)(l >> 6) : (float)(l & 63);
      float ang = pos * inv_f;
      cs = cosf(ang);
      sn = sinf(ang);
    } else {
      b = (tok - T_LAT) >> 8;
      P = (tok - T_LAT) & 255;
    }
    float xv[16], ssq[16];
#pragma unroll
    for (int g = 0; g < 16; ++g) {
      xv[g] = bf2f(PA[(long)tok * 1024 + g * 64 + lane]);
      ssq[g] = xv[g] * xv[g];
    }
#pragma unroll
    for (int o = 32; o; o >>= 1)
#pragma unroll
      for (int g = 0; g < 16; ++g) ssq[g] += __shfl_xor(ssq[g], o);
#pragma unroll
    for (int g = 0; g < 16; ++g) {
      int which = g >> 3, h = (g >> 1) & 3, c = g & 1;
      float inv = rsqrtf(ssq[g] * (1.f / 64.f) + 1e-6f);
      float y = xv[g] * inv * p.qk_gain[(li * 2 + which) * 64 + lane];
      float pr = __shfl_xor(y, 16);
      float o = (lane & 16) ? (y * cs + pr * sn) : (y * cs - pr * sn);
      if (which == 0) o *= 0.18033688011112042f;
      u16* dst = (which ? KH : QH) + ((long)((b * 4 + h) * 2 + c) * 2304 + P) * 64 + lane;
      *dst = f2bf(o);
    }
  }
}

DI void ph_attn(const Prm& p, int li, long base, char* smem) {
  const int tid = mytid(), lane = tid & 63, wid = tid >> 6, fr = lane & 15, fq = lane >> 4;
  const u16* QH = (const u16*)(p.ws + OFF_AR + 3 * U38);
  const u16* KH = QH + 18874368L;
  const u16* VT = (const u16*)(p.ws + OFF_AR + 5 * U38);
  u16* YA = (u16*)(p.ws + OFF_Y);
  u16* s = (u16*)smem;
  constexpr int STG = 128 * 80 + 128 * 72;
  const float lambda_init = 0.8f - 0.6f * expf(-0.3f * (float)li);
  float lamv, mshift;
  {
    const float* lv = p.lam + li * 256;
    float a = wsum(lv[lane] * lv[64 + lane]), b2 = wsum(lv[128 + lane] * lv[192 + lane]);
    lamv = expf(a) - expf(b2) + lambda_init;
    float gq = wmax(fabsf(p.qk_gain[(li * 2) * 64 + lane])), gk = wmax(fabsf(p.qk_gain[(li * 2 + 1) * 64 + lane]));
    mshift = 8.f * gq * gk * 1.4426950408889634f;
  }
  for (int it = first_item(base); it < (li == 3 ? 1024 : 1152); it += gridDim.x) {
    int b, h, qp0, nkeys;
    if (it < 1024) { b = it >> 6; h = (it >> 4) & 3; qp0 = 256 + (it & 15) * 128; nkeys = 2304; }
    else { int i2 = it - 1024; b = i2 >> 3; h = (i2 >> 1) & 3; qp0 = (i2 & 1) * 128; nkeys = 256; }
    const long kb0 = (long)((b * 4 + h) * 2) * 2304;
    bf16x8 qf[2][2];
#pragma unroll
    for (int c = 0; c < 2; ++c)
#pragma unroll
      for (int ks = 0; ks < 2; ++ks)
        qf[c][ks] = *(const bf16x8*)(QH + (kb0 + (long)c * 2304 + qp0 + wid * 16 + fr) * 64 + ks * 32 + fq * 8);
    f32x4 O0[8], O1[8];
#pragma unroll
    for (int i = 0; i < 8; ++i) { O0[i] = f32x4{0.f, 0.f, 0.f, 0.f}; O1[i] = f32x4{0.f, 0.f, 0.f, 0.f}; }
    f32x4 L0 = {0.f, 0.f, 0.f, 0.f}, L1 = {0.f, 0.f, 0.f, 0.f};
    const bf16x8 ones = {0x3F80, 0x3F80, 0x3F80, 0x3F80, 0x3F80, 0x3F80, 0x3F80, 0x3F80};
    uint4 rk[2], rv[2];
    const int nt = nkeys >> 6;
#pragma unroll
    for (int u = 0; u < 2; ++u) {
      int id = tid + u * 512;
      int c = id >> 9, key = (id >> 3) & 63, ch = id & 7;
      rk[u] = *(const uint4*)(KH + (kb0 + (long)c * 2304 + key) * 64 + ch * 8);
      int dv = id >> 3;
      rv[u] = *(const uint4*)(VT + ((long)(b * 512 + h * 128 + dv)) * 2304 + ch * 8);
    }
#pragma unroll
    for (int u = 0; u < 2; ++u) {
      int id = tid + u * 512;
      *(uint4*)(s + (id >> 3) * 80 + (id & 7) * 8) = rk[u];
      *(uint4*)(s + 128 * 80 + (id >> 3) * 72 + (id & 7) * 8) = rv[u];
    }
    lds_barrier();
    for (int t = 0; t < nt; ++t) {
      const bool more = t + 1 < nt;
      if (more) {
        int kp0 = (t + 1) * 64;
#pragma unroll
        for (int u = 0; u < 2; ++u) {
          int id = tid + u * 512;
          int c = id >> 9, key = (id >> 3) & 63, ch = id & 7;
          rk[u] = *(const uint4*)(KH + (kb0 + (long)c * 2304 + kp0 + key) * 64 + ch * 8);
          int dv = id >> 3;
          rv[u] = *(const uint4*)(VT + ((long)(b * 512 + h * 128 + dv)) * 2304 + kp0 + ch * 8);
        }
      }
      const u16* ks_ = s + (t & 1) * STG;
      const u16* vs_ = ks_ + 128 * 80;
      bf16x8 pf[2][2];
#pragma unroll
      for (int c = 0; c < 2; ++c) {
#pragma unroll
        for (int kk2 = 0; kk2 < 2; ++kk2) {
          u32x4 pw;
#pragma unroll
          for (int hh = 0; hh < 2; ++hh) {
            const int k4 = kk2 * 2 + hh;
            f32x4 a = {-mshift, -mshift, -mshift, -mshift};
#pragma unroll
            for (int kk = 0; kk < 2; ++kk)
              a = MFMA(*(const bf16x8*)(ks_ + (c * 64 + k4 * 16 + fr) * 80 + kk * 32 + fq * 8), qf[c][kk], a);
            pw[hh * 2 + 0] = pk_bf16(__builtin_amdgcn_exp2f(a[0]), __builtin_amdgcn_exp2f(a[1]));
            pw[hh * 2 + 1] = pk_bf16(__builtin_amdgcn_exp2f(a[2]), __builtin_amdgcn_exp2f(a[3]));
          }
          pf[c][kk2] = *(bf16x8*)&pw;
        }
      }
#pragma unroll
      for (int kk = 0; kk < 2; ++kk) {
        L0 = MFMA(ones, pf[0][kk], L0);
        L1 = MFMA(ones, pf[1][kk], L1);
      }
#pragma unroll
      for (int dt = 0; dt < 8; ++dt) {
#pragma unroll
        for (int kk = 0; kk < 2; ++kk) {
          const u16* vp = vs_ + (dt * 16 + fr) * 72 + kk * 32 + fq * 4;
          uint2 lo = *(const uint2*)vp, hi = *(const uint2*)(vp + 16);
          uint4 av = {lo.x, lo.y, hi.x, hi.y};
          bf16x8 a = *(bf16x8*)&av;
          O0[dt] = MFMA(a, pf[0][kk], O0[dt]);
          O1[dt] = MFMA(a, pf[1][kk], O1[dt]);
        }
      }
      if (more) {
        u16* ns = s + ((t + 1) & 1) * STG;
#pragma unroll
        for (int u = 0; u < 2; ++u) {
          int id = tid + u * 512;
          *(uint4*)(ns + (id >> 3) * 80 + (id & 7) * 8) = rk[u];
          *(uint4*)(ns + 128 * 80 + (id >> 3) * 72 + (id & 7) * 8) = rv[u];
        }
      }
      lds_barrier();
    }
    float i0 = 1.f / L0[0], i1 = lamv / L1[0], ss = 0.f;
#pragma unroll
    for (int dt = 0; dt < 8; ++dt)
#pragma unroll
      for (int j = 0; j < 4; ++j) {
        float o = O0[dt][j] * i0 - O1[dt][j] * i1;
        O0[dt][j] = o;
        ss += o * o;
      }
    ss += __shfl_xor(ss, 16); ss += __shfl_xor(ss, 32);
    float inv = rsqrtf(ss * (1.f / 128.f) + 1e-6f) * (1.f - lambda_init);
    int tok = tokof(b, qp0 + wid * 16 + fr);
#pragma unroll
    for (int dt = 0; dt < 8; ++dt) {
      int dv = dt * 16 + fq * 4;
      const float* sw = p.subln + li * 128 + dv;
      ushort4 o;
      o.x = f2bf(O0[dt][0] * inv * sw[0]);
      o.y = f2bf(O0[dt][1] * inv * sw[1]);
      o.z = f2bf(O0[dt][2] * inv * sw[2]);
      o.w = f2bf(O0[dt][3] * inv * sw[3]);
      *(ushort4*)(YA + (long)tok * 512 + h * 128 + dv) = o;
    }
  }
}

template <int L>
DI void hyena_item(const Prm& p, int li, int ch, char* smem) {
  constexpr int CS = 2 * L + 8;
  constexpr int ZS = L + 8;
  constexpr int MT = L / 128;
  constexpr int MG = MT > 8 ? 8 : MT, NG = MT / MG;
  const int tid = mytid(), lane = tid & 63, wid = tid >> 6, fr = lane & 15, fq = lane >> 4;
  u16* cp = (u16*)smem;
  u16* zr = cp + 8 * CS;
  const u16* PH = (const u16*)(p.ws + OFF_AR) + (L == 2048 ? 0L : 32768L * 1536);
  const u16* G = (const u16*)(p.ws + (L == 2048 ? OFF_TAPL : OFF_TAPC));
  u16* YB = (u16*)(p.ws + OFF_Y + U38);
  const float* cw = p.hy_conv + (long)li * 3 * 1536;
  {
    float w0 = cw[1024 + ch], w1 = cw[1536 + 1024 + ch], w2 = cw[3072 + 1024 + ch];
    constexpr int NCH = (16 * L / 8) / 512;
    u32x4 cv[NCH];
    u16 pv[NCH], nv[NCH];
#pragma unroll
    for (int i = 0; i < NCH; ++i) {
      int id = tid + i * 512, b = id / (L / 8), s0 = (id % (L / 8)) * 8;
      const u16* row = PH + ((long)b * 1536 + 1024 + ch) * L + s0;
      cv[i] = *(const u32x4*)row;
      pv[i] = (s0 > 0) ? row[-1] : (u16)0;
      nv[i] = (s0 + 8 < L) ? row[8] : (u16)0;
    }
#pragma unroll
    for (int i = 0; i < NCH; ++i) {
      int id = tid + i * 512, b = id / (L / 8), s0 = (id % (L / 8)) * 8;
      float x[10];
      x[0] = bf2f(pv[i]);
      x[9] = bf2f(nv[i]);
#pragma unroll
      for (int w = 0; w < 4; ++w) {
        x[1 + 2 * w] = __uint_as_float(cv[i][w] << 16);
        x[2 + 2 * w] = __uint_as_float(cv[i][w] & 0xffff0000u);
      }
      float o[8];
#pragma unroll
      for (int e = 0; e < 8; ++e) o[e] = w0 * x[e] + w1 * x[e + 1] + w2 * x[e + 2];
      u32x4 r;
      r[0] = pk_bf16(o[7], o[6]); r[1] = pk_bf16(o[5], o[4]); r[2] = pk_bf16(o[3], o[2]); r[3] = pk_bf16(o[1], o[0]);
      *(u32x4*)(zr + b * ZS + L - 8 - s0) = r;
    }
  }
#pragma unroll
  for (int order = 0; order < 2; ++order) {
    {
      const u16* g = G + (long)(order * 512 + ch) * (2 * L);
      if (tid < 2 * L / 8) {
        const int i0 = tid * 8;
        u32x4 lo = *(const u32x4*)(g + i0);
        u32x4 hi = (i0 + 8 < 2 * L) ? *(const u32x4*)(g + i0 + 8) : u32x4{0u, 0u, 0u, 0u};
        unsigned D[8] = {lo[0], lo[1], lo[2], lo[3], hi[0], hi[1], hi[2], hi[3]};
#pragma unroll
        for (int c = 0; c < 8; ++c) {
          u32x4 o;
#pragma unroll
          for (int w = 0; w < 4; ++w) {
            if (c & 1) o[w] = (D[w + (c - 1) / 2] >> 16) | (D[w + (c + 1) / 2] << 16);
            else o[w] = D[w + c / 2];
          }
          *(u32x4*)(cp + c * CS + i0) = o;
        }
      }
    }
    __syncthreads();
    const float bias = p.hy_bias[(li * 2 + order) * 512 + ch];
    const int gcol = order * 512 + ch;
    const float w0 = cw[gcol], w1 = cw[1536 + gcol], w2 = cw[3072 + gcol];
    const int tq = wid * (L / 8) + fq * 4;
    const u16* xb = PH + ((long)fr * 1536 + gcol) * L + tq;
    const u16* zb = zr + fr * ZS + L - 1 - tq;
    unsigned zp[NG][MG][2];
#pragma unroll
    for (int grp = 0; grp < NG; ++grp) {
      f32x4 acc[MG];
#pragma unroll
      for (int m = 0; m < MG; ++m) acc[m] = f32x4{0.f, 0.f, 0.f, 0.f};
      const int tb = wid * (L / 8) + grp * MG * 16 + fr;
      if constexpr (MG == 8) {
        const int i00 = tb - fq * 8 - 7 + L, c0 = i00 & 7;
        const u16* ab = cp + c0 * CS + (i00 - c0);
        const u16* zbp = zr + fr * ZS + (L - 8 - fq * 8);
        bf16x8 W[16];
#pragma unroll 1
        for (int s0 = 0; s0 < L; s0 += 256) {
#pragma unroll
          for (int k = 0; k < 8; ++k) {
            const int sk = s0 + 32 * k;
            if (k == 0) {
#pragma unroll
              for (int m = 0; m < 8; ++m) W[m] = *(const bf16x8*)(ab + m * 16 - sk);
            }
            if (k < 7) {
              W[(16 - 2 * k - 2) & 15] = *(const bf16x8*)(ab - sk - 32);
              W[(16 - 2 * k - 1) & 15] = *(const bf16x8*)(ab - sk - 32 + 16);
            }
            bf16x8 bk = *(const bf16x8*)(zbp - sk);
#pragma unroll
            for (int m = 0; m < 8; ++m) acc[m] = MFMA(W[(m + 16 - 2 * k) & 15], bk, acc[m]);
          }
        }
      } else {
#pragma unroll 2
        for (int s0 = 0; s0 < L; s0 += 32) {
          bf16x8 bfr = *(const bf16x8*)(zr + fr * ZS + (L - 8 - s0 - fq * 8));
#pragma unroll
          for (int m = 0; m < MG; ++m) {
            int i0 = tb + m * 16 - s0 - fq * 8 - 7 + L;
            int c = i0 & 7;
            bf16x8 afr = *(const bf16x8*)(cp + c * CS + (i0 - c));
            acc[m] = MFMA(afr, bfr, acc[m]);
          }
        }
      }
#pragma unroll
      for (int m = 0; m < MG; ++m) {
        float r4[4];
#pragma unroll
        for (int j = 0; j < 4; ++j) {
          const int off = (grp * MG + m) * 16 + j;
          const int t = tq + off;
          float xa = bf2f(xb[off - 1]), xc = bf2f(xb[off]), xd = bf2f(xb[off + 1]);
          xa = (t > 0) ? xa : 0.f;
          xd = (t + 1 < L) ? xd : 0.f;
          float xg = w0 * xa + w1 * xc + w2 * xd;
          float zin = bf2f(zb[-off]);
          r4[j] = xg * (acc[m][j] + bias * zin);
        }
        zp[grp][m][0] = (unsigned)f2bf(r4[0]) | ((unsigned)f2bf(r4[1]) << 16);
        zp[grp][m][1] = (unsigned)f2bf(r4[2]) | ((unsigned)f2bf(r4[3]) << 16);
      }
    }
    __syncthreads();
#pragma unroll
    for (int grp = 0; grp < NG; ++grp)
#pragma unroll
      for (int m = 0; m < MG; ++m) {
        int t0 = wid * (L / 8) + (grp * MG + m) * 16 + fq * 4;
        uint2 w;
        w.x = (zp[grp][m][1] >> 16) | (zp[grp][m][1] << 16);
        w.y = (zp[grp][m][0] >> 16) | (zp[grp][m][0] << 16);
        *(uint2*)(zr + fr * ZS + L - 4 - t0) = w;
      }
  }
  __syncthreads();
  {
    u16* YBT = (u16*)(p.ws + OFF_AR + 5 * U38) + (L == 2048 ? 0L : 16L * 512 * 2048);
    constexpr int NCH = (16 * L / 8) / 512;
#pragma unroll
    for (int i = 0; i < NCH; ++i) {
      int id = tid + i * 512, b = id / (L / 8), t0 = (id % (L / 8)) * 8;
      u32x4 r = *(const u32x4*)(zr + b * ZS + L - 8 - t0);
      u32x4 o;
      o[0] = (r[3] >> 16) | (r[3] << 16);
      o[1] = (r[2] >> 16) | (r[2] << 16);
      o[2] = (r[1] >> 16) | (r[1] << 16);
      o[3] = (r[0] >> 16) | (r[0] << 16);
      *(u32x4*)(YBT + ((long)b * 512 + ch) * L + t0) = o;
    }
  }
  __syncthreads();
}

DI long ph_ytrans(const Prm& p, long base, bool lastl, char* smem) {
  u16* tl = (u16*)smem;
  const u16* YBT = (const u16*)(p.ws + OFF_AR + 5 * U38);
  u16* YB = (u16*)(p.ws + OFF_Y + U38);
  const int tid = mytid(), G = gridDim.x;
  const int total = lastl ? 4096 : 4608;
  auto srcp = [&](int it) -> const u16* {
    if (it < 4096) {
      int b = it >> 8, ct = (it >> 5) & 7, lt = it & 31;
      return YBT + ((long)b * 512 + ct * 64 + (tid >> 3)) * 2048 + lt * 64 + (tid & 7) * 8;
    } else {
      int i2 = it - 4096, b = i2 >> 5, ct = (i2 >> 2) & 7, lt = i2 & 3;
      return YBT + 16L * 512 * 2048 + ((long)b * 512 + ct * 64 + (tid >> 3)) * 256 + lt * 64 + (tid & 7) * 8;
    }
  };
  int it = first_item(base);
  u32x4 v = {0u, 0u, 0u, 0u};
  if (it < total) v = *(const u32x4*)srcp(it);
  for (; it < total; it += G) {
    *(u32x4*)(tl + (tid >> 3) * 72 + (tid & 7) * 8) = v;
    __syncthreads();
    if (it + G < total) v = *(const u32x4*)srcp(it + G);
    long tok0;
    int ct;
    if (it < 4096) { int b = it >> 8, lt = it & 31; ct = (it >> 5) & 7; tok0 = (long)b * 2048 + lt * 64; }
    else { int i2 = it - 4096, b = i2 >> 5, lt = i2 & 3; ct = (i2 >> 2) & 7; tok0 = (long)T_LAT + b * 256 + lt * 64; }
    const int lrow = tid >> 3, cc = tid & 7;
    u32x4 o;
#pragma unroll
    for (int w = 0; w < 4; ++w) {
      unsigned lo = tl[(cc * 8 + 2 * w) * 72 + lrow], hi = tl[(cc * 8 + 2 * w + 1) * 72 + lrow];
      o[w] = lo | (hi << 16);
    }
    *(u32x4*)(YB + (tok0 + lrow) * 512 + ct * 64 + cc * 8) = o;
    __syncthreads();
  }
  return base + total;
}

DI void ph_merge(const Prm& p, char* smem, bool lastl) {
  const int tid = mytid(), lane = tid & 63, wid = tid >> 6;
  const int wm = wid >> 1, wn = wid & 1, fr = lane & 15, fq = lane >> 4;
  const u16* H = (const u16*)(p.ws + OFF_HBF);
  const u16* Y = (const u16*)(p.ws + OFF_Y);
  const u16* WG = (const u16*)(p.ws + OFF_WB) + WO_G;
  const u16* WBr = (const u16*)(p.ws + OFF_WB) + WO_B;
  u16* MG = (u16*)(p.ws + OFF_AR);
  const int NT = (lastl ? 256 : 288) * 8, G = gridDim.x;
  Stg r0, r1;
  bool pre = false;
  for (int t = mybid(); t < NT; t += G) {
    const int mt = t >> 3, nt = t & 7;
    const bool hn = t + G < NT;
    const int mt2 = (t + G) >> 3, nt2 = (t + G) & 7;
    f32x4 acc[2][4], g[2][4], y[2][4];
#pragma unroll
    for (int a = 0; a < 2; ++a)
#pragma unroll
      for (int b = 0; b < 4; ++b) acc[a][b] = f32x4{0.f, 0.f, 0.f, 0.f};
    const u16* gA = H + (long)mt * 128 * 1024;
    for (int n = 0; n < 4; ++n) {
      const u16* gB = WG + ((long)n * 1024 + nt * 128) * 1024;
      const u16* yA = Y + (long)n * (T_ALL * 512L) + (long)mt * 128 * 512;
      const u16* yB = WBr + ((long)n * 1024 + nt * 128) * 512;
      gemm_tile<2>(g, gA, 1024, gB, 1024, 1024, smem, r0, r1, pre, yA, 512, yB, 512);
      const u16* nxA = (n < 3) ? gA : (hn ? H + (long)mt2 * 128 * 1024 : nullptr);
      const u16* nxB = (n < 3) ? WG + ((long)(n + 1) * 1024 + nt * 128) * 1024 : WG + ((long)nt2 * 128) * 1024;
      gemm_tile<2>(y, yA, 512, yB, 512, 512, smem, r0, r1, true, nxA, 1024, nxB, 1024);
      pre = true;
#pragma unroll
      for (int a = 0; a < 2; ++a)
#pragma unroll
        for (int b = 0; b < 4; ++b)
#pragma unroll
          for (int j = 0; j < 4; ++j) acc[a][b][j] += y[a][b][j] * __builtin_amdgcn_rcpf(1.f + __expf(-g[a][b][j]));
    }
    pre = hn;
#pragma unroll
    for (int a = 0; a < 2; ++a)
#pragma unroll
      for (int b = 0; b < 4; ++b) {
        int r = wm * 32 + a * 16 + fr, c = wn * 64 + b * 16 + fq * 4;
        uint2 o;
        o.x = pk_bf16(acc[a][b][0], acc[a][b][1]);
        o.y = pk_bf16(acc[a][b][2], acc[a][b][3]);
        *(uint2*)(MG + ((long)mt * 128 + r) * 1024 + nt * 128 + c) = o;
      }
  }
}

DI void run_phase(const Prm& p, int ph, char* smem) {
  if (ph == 0) { ph_init(p, smem); return; }
  const int li = (ph - 1) / 14, k = (ph - 1) % 14;
  const u16* WB = (const u16*)(p.ws + OFF_WB);
  const u16* HB = (const u16*)(p.ws + OFF_HBF);
  const float* MOD = (const float*)(p.ws + OFF_MOD);
  u16* AR = (u16*)(p.ws + OFF_AR);
  u16* Yb = (u16*)(p.ws + OFF_Y);
  const int G = gridDim.x;
  TD d;
  d.split = 0; d.scale = 1.f; d.mode = 0; d.tok0 = 0; d.col0 = 0; d.g = MOD;
  switch (k) {
    case 0: {
      u16* W = (u16*)(p.ws + OFF_WB);
      long base = 0;
      base = tr_job(base, p.w_in + (long)li * 1024 * NIN, 1024, NIN, W + WO_IN, 1, smem);
      base = tr_job(base, p.w_gate + (long)li * 4 * 1048576, 1024, 1024, W + WO_G, 4, smem);
      base = tr_job(base, p.w_branch + (long)li * 4 * 524288, 512, 1024, W + WO_B, 4, smem);
      base = tr_job(base, p.w_o + (long)li * 1048576, 1024, 1024, W + WO_O, 1, smem);
      base = tr_job(base, p.w_mlp1 + (long)li * 4194304, 1024, 4096, W + WO_1, 1, smem);
      base = tr_job(base, p.w_mlp2 + (long)li * 4194304, 4096, 1024, W + WO_2, 1, smem);
      ph_taps1(p, li, base, smem);
      ph_norm(p, li, 0);
    } break;
    case 1: {
      auto dec = [&](int t, TD& o) {
        o.lda = 1024; o.ldb = 1024; o.K = 1024; o.mode = 0;
        if (t < 1728) {
          int mt = t / 12, nt = t % 12;
          o.A = HB + (long)mt * 256 * 1024; o.B = WB + WO_IN + (long)(3584 + nt * 128) * 1024;
          o.C = AR + (long)mt * 256 * 1536 + nt * 128; o.ldc = 1536;
        } else if (t < 2304) {
          int t2 = t - 1728, mt = t2 >> 2, nt = t2 & 3;
          o.A = HB + (long)mt * 256 * 1024; o.B = WB + WO_IN + (long)(5120 + nt * 128) * 1024;
          o.C = Yb + 3 * (U38 / 2) + (long)mt * 256 * 512 + nt * 128; o.ldc = 512;
        } else {
          int mt = t - 2304;
          o.A = HB + (long)mt * 256 * 1024; o.B = WB + WO_IN + (long)5632 * 1024;
          o.C = (u16*)((float*)(p.ws + OFF_PDAB) + (long)mt * 256 * 16); o.ldc = 16; o.mode = 3;
        }
      };
      {
        Stg r0, r1;
        bool pre = false;
        TD dn = d;
        int t = mybid();
        if (t < 2448) dec(t, d);
        for (; t < 2448; t += G) {
          const bool hn = t + G < 2448;
          if (hn) dec(t + G, dn);
          run_tile2<4>(p, d, smem, r0, r1, pre, hn ? dn.A : nullptr, dn.lda, dn.B, dn.ldb);
          pre = hn;
          d = dn;
        }
      }
      ph_taps2(p, 2448, smem);
    } break;
    case 2: ph_dncl(p, li, smem); break;
    case 3: ph_dnscan(p, smem); break;
    case 4: {
      {
        Stg r0, r1;
        bool pre = false;
        for (int t = mybid(); t < 1152; t += G) {
          int mt = t >> 3, nt = t & 7;
          const bool hn = t + G < 1152;
          int mt2 = (t + G) >> 3, nt2 = (t + G) & 7;
          d.lda = 1024; d.ldb = 1024; d.K = 1024;
          d.A = HB + (long)mt * 256 * 1024; d.B = WB + WO_IN + (long)(nt * 128) * 1024;
          d.C = AR + 3 * (U38 / 2); d.ldc = 0; d.mode = 4; d.tok0 = mt * 256; d.col0 = nt;
          d.g = p.qk_gain + li * 128;
          run_tile2<4>(p, d, smem, r0, r1, pre, hn ? HB + (long)mt2 * 256 * 1024 : nullptr, 1024,
                    WB + WO_IN + (long)(nt2 * 128) * 1024, 1024);
          pre = hn;
        }
      }
      ph_dnfin(p, li);
    } break;
    case 5: {
      u16* VT = AR + 5 * (U38 / 2);
      u16* PF = AR + 6 * (U38 / 2);
      auto dec = [&](int t, TD& o) {
        o.lda = 1024; o.ldb = 1024; o.K = 1024;
        if (t < 512) {
          int b = t >> 5, r = t & 31, mt = r >> 4, nt = r & 15;
          o.A = WB + WO_IN + (long)(1024 + mt * 256) * 1024; o.B = HB + ((long)b * 2048 + nt * 128) * 1024;
          o.C = VT + ((long)b * 512 + mt * 256) * 2304 + 256 + nt * 128; o.ldc = 2304;
        } else if (t < 576) {
          int t2 = t - 512, b = t2 >> 2, r = t2 & 3, mt = r >> 1, nt = r & 1;
          o.A = WB + WO_IN + (long)(1024 + mt * 256) * 1024; o.B = HB + ((long)T_LAT + b * 256 + nt * 128) * 1024;
          o.C = VT + ((long)b * 512 + mt * 256) * 2304 + nt * 128; o.ldc = 2304;
        } else {
          int t2 = t - 576, mt = t2 >> 2, nt = t2 & 3;
          o.A = HB + (long)mt * 256 * 1024; o.B = WB + WO_IN + (long)(3072 + nt * 128) * 1024;
          o.C = PF + (long)mt * 256 * 512 + nt * 128; o.ldc = 512;
        }
      };
      {
        Stg r0, r1;
        bool pre = false;
        TD dn = d;
        int t = mybid();
        if (t < 1152) dec(t, d);
        for (; t < 1152; t += G) {
          const bool hn = t + G < 1152;
          if (hn) dec(t + G, dn);
          run_tile2<4>(p, d, smem, r0, r1, pre, hn ? dn.A : nullptr, dn.lda, dn.B, dn.ldb);
          pre = hn;
          d = dn;
        }
      }
    } break;
    case 6: {
      ph_attn(p, li, 0, smem);
      auto dec = [&](int t, TD& o) {
        o.lda = 1024; o.ldb = 1024; o.K = 1024;
        if (t < 1536) {
          int b = t / 96, r = t % 96, mt = r >> 4, nt = r & 15;
          o.A = WB + WO_IN + (long)(1536 + mt * 256) * 1024; o.B = HB + ((long)b * 2048 + nt * 128) * 1024;
          o.C = AR + ((long)b * 1536 + mt * 256) * 2048 + nt * 128; o.ldc = 2048;
        } else {
          int t2 = t - 1536, b = t2 / 12, r = t2 % 12, mt = r >> 1, nt = r & 1;
          o.A = WB + WO_IN + (long)(1536 + mt * 256) * 1024; o.B = HB + ((long)T_LAT + b * 256 + nt * 128) * 1024;
          o.C = AR + 32768L * 1536 + ((long)b * 1536 + mt * 256) * 256 + nt * 128; o.ldc = 256;
        }
      };
      {
        Stg r0, r1;
        bool pre = false;
        TD dn = d;
        int t = first_item(1152);
        if (t < 1728) dec(t, d);
        for (; t < 1728; t += G) {
          const bool hn = t + G < 1728;
          if (hn) dec(t + G, dn);
          run_tile2<4>(p, d, smem, r0, r1, pre, hn ? dn.A : nullptr, dn.lda, dn.B, dn.ldb);
          pre = hn;
          d = dn;
        }
      }
    } break;
    case 7: {
#if !defined(TESTSEL) || TESTSEL == 1
      for (int it = mybid(); it < 512; it += G) hyena_item<2048>(p, li, it, smem);
#endif
#if !defined(TESTSEL) || TESTSEL == 2
      if (li < 3)
        for (int it = mybid(); it < 512; it += G) hyena_item<256>(p, li, it, smem);
#endif
#if !defined(TESTSEL) || TESTSEL == 3
      const u16* PF = AR + 6 * (U38 / 2);
      u16* WF = AR + 3 * (U38 / 2);
      const u16* DCm = (const u16*)(p.ws + OFF_DC);
      auto dec = [&](int t, TD& o) {
        o.A = DCm; o.lda = 128; o.ldb = 512; o.K = 128;
        if (t < 1024) {
          int bg = t >> 4, nt = t & 15, b = bg >> 2, g = bg & 3;
          o.B = PF + ((long)b * 2048 + nt * 128) * 512 + g * 128;
          o.C = WF + ((long)b * 512 + g * 128) * 4096 + nt * 128; o.ldc = 4096; o.split = 2048;
        } else {
          int t2 = t - 1024, bg = t2 >> 1, nt = t2 & 1, b = bg >> 2, g = bg & 3;
          o.B = PF + ((long)T_LAT + b * 256 + nt * 128) * 512 + g * 128;
          o.C = WF + 16L * 512 * 4096 + ((long)b * 512 + g * 128) * 512 + nt * 128; o.ldc = 512; o.split = 256;
        }
      };
      {
        const int NT7 = (li == 3 ? 1024 : 1152);
        Stg r0, r1;
        bool pre = false;
        TD dn = d;
        int t = mybid();
        if (t < NT7) dec(t, d);
        for (; t < NT7; t += G) {
          const bool hn = t + G < NT7;
          if (hn) dec(t + G, dn);
          run_tile2<4>(p, d, smem, r0, r1, pre, hn ? dn.A : nullptr, dn.lda, dn.B, dn.ldb);
          pre = hn;
          d = dn;
        }
      }
#endif
    } break;
    case 8: {
      const u16* WF = AR + 3 * (U38 / 2);
      u16* YF = Yb + 2 * (U38 / 2);
      d.scale = 1.f / 512.f;
      for (int t = mybid(); t < (li == 3 ? 512 : 576); t += G) {
        if (t < 512) {
          int b = t >> 5, r = t & 31, mt = r >> 2, nt = r & 3;
          d.A = (const u16*)(p.ws + OFF_DL) + (long)mt * 256 * 4096; d.lda = 4096;
          d.B = WF + ((long)b * 512 + nt * 128) * 4096; d.ldb = 4096; d.K = 4096;
          d.C = YF + ((long)b * 2048 + mt * 256) * 512 + nt * 128; d.ldc = 512;
        } else {
          int t2 = t - 512, b = t2 >> 2, nt = t2 & 3;
          d.A = (const u16*)(p.ws + OFF_DLC); d.lda = 512;
          d.B = WF + 16L * 512 * 4096 + ((long)b * 512 + nt * 128) * 512; d.ldb = 512; d.K = 512;
          d.C = YF + ((long)T_LAT + b * 256) * 512 + nt * 128; d.ldc = 512;
        }
        run_tile(p, d, smem);
      }
      ph_ytrans(p, 576, li == 3, smem);
    } break;
    case 9: ph_merge(p, smem, li == 3); break;
    case 10: {
      d.mode = 2;
      const int NF = 1024, NTOT = (li == 3) ? 1024 : 1024 + 256;
      auto dec = [&](int t, TD& o) {
        int full = t < NF ? t : NF + ((t - NF) >> 1), half = t < NF ? 0 : ((t - NF) & 1);
        int mt = full >> 3, nt = full & 7;
        o.A = AR + ((long)mt * 256 + half * 128) * 1024; o.lda = 1024;
        o.B = WB + WO_O + (long)nt * 128 * 1024; o.ldb = 1024; o.K = 1024;
        o.tok0 = mt * 256 + half * 128; o.col0 = nt * 128;
        int bb = o.tok0 < T_LAT ? (o.tok0 >> 11) : 16;
        o.g = MOD + ((long)li * 17 + bb) * 6144 + 2 * 1024;
      };
      Stg r0, r1;
      bool pre = false;
      TD dn = d;
      int t = mybid();
      if (t < NTOT) dec(t, d);
      for (; t < NTOT; t += G) {
        const bool hn = t + G < NTOT;
        if (hn) dec(t + G, dn);
        if (t < NF) run_tile2<4>(p, d, smem, r0, r1, pre, hn ? dn.A : nullptr, dn.lda, dn.B, dn.ldb);
        else run_tile2<2>(p, d, smem, r0, r1, pre, hn ? dn.A : nullptr, dn.lda, dn.B, dn.ldb);
        pre = hn;
        d = dn;
      }
    } break;
    case 11: ph_norm(p, li, 1); break;
    case 12: {
      d.mode = 1;
      const int NT12 = (li == 3 ? 4096 : 4608);
      Stg r0, r1;
      bool pre = false;
      for (int t = mybid(); t < NT12; t += G) {
        int mt = t >> 5, nt = t & 31;
        d.A = HB + (long)mt * 256 * 1024; d.lda = 1024; d.B = WB + WO_1 + (long)nt * 128 * 1024; d.ldb = 1024; d.K = 1024;
        d.C = Yb + (long)mt * 256 * 4096 + nt * 128; d.ldc = 4096;
        const bool hn = t + G < NT12;
        int mt2 = (t + G) >> 5, nt2 = (t + G) & 31;
        run_tile2<4>(p, d, smem, r0, r1, pre, hn ? HB + (long)mt2 * 256 * 1024 : nullptr, 1024,
                  WB + WO_1 + (long)nt2 * 128 * 1024, 1024);
        pre = hn;
      }
    } break;
    case 13: {
      d.mode = 2;
      const int NF = 1024, NTOT = (li == 3) ? 1024 : 1024 + 256;
      auto dec = [&](int t, TD& o) {
        int full = t < NF ? t : NF + ((t - NF) >> 1), half = t < NF ? 0 : ((t - NF) & 1);
        int mt = full >> 3, nt = full & 7;
        o.A = Yb + ((long)mt * 256 + half * 128) * 4096; o.lda = 4096;
        o.B = WB + WO_2 + (long)nt * 128 * 4096; o.ldb = 4096; o.K = 4096;
        o.tok0 = mt * 256 + half * 128; o.col0 = nt * 128;
        int bb = o.tok0 < T_LAT ? (o.tok0 >> 11) : 16;
        o.g = MOD + ((long)li * 17 + bb) * 6144 + 5 * 1024;
      };
      Stg r0, r1;
      bool pre = false;
      TD dn = d;
      int t = mybid();
      if (t < NTOT) dec(t, d);
      for (; t < NTOT; t += G) {
        const bool hn = t + G < NTOT;
        if (hn) dec(t + G, dn);
        if (t < NF) run_tile2<4>(p, d, smem, r0, r1, pre, hn ? dn.A : nullptr, dn.lda, dn.B, dn.ldb);
        else run_tile2<2>(p, d, smem, r0, r1, pre, hn ? dn.A : nullptr, dn.lda, dn.B, dn.ldb);
        pre = hn;
        d = dn;
      }
    } break;
  }
}


#define XB_TMO      128
#define XB_XCNT(j)  (256  + 64 * (j))
#define XB_XSUB(j)  (1280 + 64 * (j))
#define XB_XGEN(j)  (2304 + 64 * (j))
#define XB_TOP      3328
#define XB_TOPGEN   3392
#define XCD_BAR_WORDS 3456
#define XB_SPIN_CAP (1u << 20)
#define LAS __attribute__((address_space(3)))
DI unsigned xb_ld(unsigned* p) { return __hip_atomic_load(p, __ATOMIC_RELAXED, __HIP_MEMORY_SCOPE_AGENT); }
DI unsigned xb_add(unsigned* p, unsigned v) { return __hip_atomic_fetch_add(p, v, __ATOMIC_RELAXED, __HIP_MEMORY_SCOPE_AGENT); }
DI unsigned xb_xcc_id() { return (unsigned)__builtin_amdgcn_s_getreg((3 << 11) | 20) & 0xFu; }
#define XB_SPIN(cond, bar) do { unsigned _sp = 0; while (cond) { __builtin_amdgcn_s_sleep(1); \
    if ((++_sp & 255u) == 0u) { if (xb_ld(&(bar)[XB_TMO])) break; if (_sp > XB_SPIN_CAP) { atomicAdd(&(bar)[XB_TMO], 1u); break; } } } } while (0)
struct XcdBarrier { unsigned* bar; unsigned x; volatile LAS unsigned* st; };
DI XcdBarrier xcd_barrier_post(unsigned* bar, volatile LAS unsigned* st) {
  XcdBarrier b; b.bar = bar; b.x = xb_xcc_id(); b.st = st;
  if (threadIdx.x == 0) (void)xb_add(&bar[XB_XCNT(b.x)], 1u);
  return b;
}
DI void xcd_barrier_complete(unsigned* bar, unsigned x, unsigned& nloc, unsigned& nx) {
  const unsigned G = gridDim.x * gridDim.y * gridDim.z;
  unsigned sum, cnt, mine, sp = 0u;
  for (;;) {
    sum = 0u; cnt = 0u; mine = 0u;
#pragma unroll
    for (unsigned j = 0; j < 16; ++j) { const unsigned c = xb_ld(&bar[XB_XCNT(j)]); sum += c; cnt += (c > 0u) ? 1u : 0u; mine = (j == x) ? c : mine; }
    if (sum == G) break;
    __builtin_amdgcn_s_sleep(1);
    if ((++sp & 255u) == 0u) { if (xb_ld(&bar[XB_TMO])) break; if (sp > XB_SPIN_CAP) { atomicAdd(&bar[XB_TMO], 1u); break; } }
  }
  nloc = mine > 0u ? mine : 1u; nx = cnt > 0u ? cnt : 1u;
}
DI void xcd_barrier(const XcdBarrier& b) {
  asm volatile("s_waitcnt vmcnt(0)" ::: "memory");
  __syncthreads();
  if (threadIdx.x == 0) {
    unsigned* bar = b.bar;
    __builtin_amdgcn_s_waitcnt(0);
    unsigned nloc = b.st[0], nx = b.st[1];
    if (nloc == 0u) { xcd_barrier_complete(bar, b.x, nloc, nx); b.st[0] = nloc; b.st[1] = nx; }
    const unsigned old = xb_add(&bar[XB_XSUB(b.x)], 1u);
    const unsigned gen = old / nloc;
    if (old + 1u == (gen + 1u) * nloc) {
      __builtin_amdgcn_fence(__ATOMIC_RELEASE, "agent");
      asm volatile("s_waitcnt vmcnt(0)" ::: "memory");
      const unsigned og = xb_add(&bar[XB_TOP], 1u);
      const unsigned tg = og / nx;
      if (og + 1u == (tg + 1u) * nx) xb_add(&bar[XB_TOPGEN], 1u);
      else XB_SPIN(xb_ld(&bar[XB_TOPGEN]) == tg, bar);
      __builtin_amdgcn_fence(__ATOMIC_ACQUIRE, "agent");
      xb_add(&bar[XB_XGEN(b.x)], 1u);
      asm volatile("s_waitcnt vmcnt(0)" ::: "memory");
    } else {
      XB_SPIN(xb_ld(&bar[XB_XGEN(b.x)]) == gen, bar);
      __builtin_amdgcn_fence(__ATOMIC_ACQUIRE, "agent");
      asm volatile("s_waitcnt vmcnt(0)" ::: "memory");
    }
  }
  __syncthreads();
}

extern __shared__ __attribute__((aligned(16))) char dyn_smem[];

__global__ void __launch_bounds__(512) mega(Prm p, int lo, int hi) {
  __shared__ uint4 xb_words;
  if (threadIdx.x == 0) xb_words = make_uint4(0u, 0u, 0u, 0u);
  __syncthreads();
  XcdBarrier xb = xcd_barrier_post((unsigned*)(p.ws + OFF_BAR), (volatile LAS unsigned*)&xb_words);
#ifdef ONLYK
  run_phase(p, ONLYK, dyn_smem);
#else
  for (int ph = lo; ph <= hi; ++ph) {
    long z = 0;
    asm volatile("" : "+s"(z));
    Prm q;
#define LP(f) q.f = p.f + z
    LP(x); LP(c); LP(ctx); LP(c_ctx); LP(w_ada); LP(b_ada); LP(norm1); LP(norm2); LP(w_in); LP(qk_gain); LP(lam);
    LP(subln); LP(hy_conv); LP(hy_w1); LP(hy_b1); LP(hy_freq); LP(hy_w2); LP(hy_b2); LP(hy_w3); LP(hy_bias);
    LP(dn_conv); LP(dn_a_log); LP(dn_dt_bias); LP(dn_norm); LP(w_gate); LP(w_branch); LP(w_o); LP(w_mlp1); LP(w_mlp2);
    LP(out); LP(ws);
#undef LP
    run_phase(q, ph, dyn_smem);
#ifdef PROBEK
    if (ph > 0 && (ph - 1) % 14 == PROBEK) { cg::this_grid().sync(); run_phase(q, ph, dyn_smem); }
#endif
    if (ph < hi) {
      if (ph == lo) cg::this_grid().sync();
      else xcd_barrier(xb);
    }
  }
#endif
}

extern "C" void kernel_launch(void* const* d_in, const int* in_sizes, int n_in, void* d_out, int out_size, void* d_ws,
                              size_t ws_size, hipStream_t stream) {
  static int grid_blocks = 0;
  if (!grid_blocks) {
    hipFuncSetAttribute((const void*)mega, hipFuncAttributeMaxDynamicSharedMemorySize, LDS_BYTES);
    int dev = 0, cus = 0, per_cu = 0;
    hipGetDevice(&dev);
    hipDeviceGetAttribute(&cus, hipDeviceAttributeMultiprocessorCount, dev);
    hipOccupancyMaxActiveBlocksPerMultiprocessor(&per_cu, mega, 512, LDS_BYTES);
    if (per_cu < 1) per_cu = 1;
    grid_blocks = cus * per_cu;
    if (ws_size < (size_t)WS_TOTAL) fprintf(stderr, "workspace too small: %zu < %ld\n", ws_size, (long)WS_TOTAL);
  }
  Prm p;
  const float** pp = (const float**)&p;
  for (int i = 0; i < 29; ++i) pp[i] = (const float*)d_in[i];
  p.out = (float*)d_out;
  p.ws = (char*)d_ws;
#if MULTI
  for (int ph = 0; ph < NPHASE; ++ph) hipLaunchKernelGGL(mega, dim3(grid_blocks), dim3(512), LDS_BYTES, stream, p, ph, ph);
#else
  int lo = 0, hi = NPHASE - 1;
  hipMemsetAsync((char*)d_ws + OFF_BAR, 0, XCD_BAR_WORDS * 4, stream);
  void* args[] = {&p, &lo, &hi};
  hipError_t e = hipLaunchCooperativeKernel((void*)mega, dim3(grid_blocks), dim3(512), args, LDS_BYTES, stream);
  if (e != hipSuccess) fprintf(stderr, "cooperative launch failed: %s (grid %d)\n", hipGetErrorString(e), grid_blocks);
#endif
}
```

```cpp
#include <hip/hip_runtime.h>
#include <hip/hip_cooperative_groups.h>
#include <stdint.h>
#include <stdio.h>
namespace cg = cooperative_groups;

typedef unsigned short u16;
typedef __attribute__((ext_vector_type(8))) short bf16x8;
typedef __attribute__((ext_vector_type(4))) float f32x4;
#define MFMA(a, b, c) __builtin_amdgcn_mfma_f32_16x16x32_bf16(a, b, c, 0, 0, 0)
#define DI __device__ __forceinline__

#ifndef MULTI
#define MULTI 0
#endif

constexpr int T_LAT = 32768, T_ALL = 36864;
constexpr int NIN = 5648;
constexpr long U38 = 37748736L;
constexpr long OFF_XC = 0;
constexpr long OFF_WB = OFF_XC + 16777216L;
constexpr long OFF_HBF = OFF_WB + 43024384L;
constexpr long OFF_MOD = OFF_HBF + 75497472L;
constexpr long OFF_TAPL = OFF_MOD + 1671168L;
constexpr long OFF_TAPC = OFF_TAPL + 8388608L;
constexpr long OFF_DL = OFF_TAPC + 1048576L;
constexpr long OFF_DLC = OFF_DL + 16777216L;
constexpr long OFF_DC = OFF_DLC + 262144L;
constexpr long OFF_PDAB = OFF_DC + 65536L;
constexpr long OFF_GC = OFF_PDAB + 2359296L;
constexpr long OFF_BETA = OFF_GC + 2359296L;
constexpr long OFF_Y = OFF_BETA + 2359296L;
constexpr long OFF_AR = OFF_Y + 4 * U38;
constexpr long OFF_ROPE = OFF_AR + 7 * U38;
constexpr long OFF_BAR = OFF_ROPE + 2 * 262144L;
constexpr long WS_TOTAL = OFF_BAR + 16384L;
constexpr long WO_IN = 0, WO_G = 5783552L, WO_B = 9977856L, WO_O = 12075008L, WO_1 = 13123584L, WO_2 = 17317888L;
constexpr int LDS_BYTES = 139264;
constexpr int NPHASE = 1 + 4 * 14;

struct Prm {
  const float *x, *c, *ctx, *c_ctx, *w_ada, *b_ada, *norm1, *norm2, *w_in, *qk_gain, *lam, *subln, *hy_conv, *hy_w1,
      *hy_b1, *hy_freq, *hy_w2, *hy_b2, *hy_w3, *hy_bias, *dn_conv, *dn_a_log, *dn_dt_bias, *dn_norm, *w_gate,
      *w_branch, *w_o, *w_mlp1, *w_mlp2;
  float* out;
  char* ws;
};

DI int mytid() {
  int t = threadIdx.x;
  asm volatile("" : "+v"(t));
  return t;
}
DI int mybid() {
  int t = blockIdx.x;
  asm volatile("" : "+s"(t));
  return t;
}
DI void lds_barrier() {
  asm volatile("s_waitcnt lgkmcnt(0)" ::: "memory");
  __builtin_amdgcn_s_barrier();
  asm volatile("" ::: "memory");
}
typedef __bf16 bf16x2_t __attribute__((ext_vector_type(2)));
typedef float f32x2_t __attribute__((ext_vector_type(2)));
DI unsigned pk_bf16(float a, float b) {
  f32x2_t v = {a, b};
  bf16x2_t h = __builtin_convertvector(v, bf16x2_t);
  return *(unsigned*)&h;
}
DI u16 f2bf(float f) {
  __bf16 h = (__bf16)f;
  return *(u16*)&h;
}
DI float bf2f(u16 h) { return __uint_as_float(((unsigned)h) << 16); }
DI float wsum(float v) {
  for (int o = 32; o; o >>= 1) v += __shfl_xor(v, o);
  return v;
}
DI float wmax(float v) {
  for (int o = 32; o; o >>= 1) v = fmaxf(v, __shfl_xor(v, o));
  return v;
}
DI float siluf(float v) { return v / (1.f + __expf(-v)); }
DI float sigmf(float v) { return 1.f / (1.f + __expf(-v)); }
DI float* xrow(const Prm& p, int tok) {
  return tok < T_LAT ? p.out + (long)tok * 1024 : (float*)(p.ws + OFF_XC) + (long)(tok - T_LAT) * 1024;
}
DI int first_item(long base) {
  int G = gridDim.x;
  return (int)(((long)mybid() + G - (base % G)) % G);
}
DI int tokof(int b, int P) { return P < 256 ? T_LAT + b * 256 + P : b * 2048 + (P - 256); }

typedef __attribute__((ext_vector_type(4))) unsigned u32x4;
struct Stg { u32x4 a0, a1, a2, a3, b0, b1; };
template <int NA>
DI void g_load(Stg& r, const u16* Ap, long lda, const u16* Bp, long ldb, int k0) {
  r.a0 = *(const u32x4*)(Ap + k0);
  r.a1 = *(const u32x4*)(Ap + 64 * lda + k0);
  if constexpr (NA == 4) {
    r.a2 = *(const u32x4*)(Ap + 128 * lda + k0);
    r.a3 = *(const u32x4*)(Ap + 192 * lda + k0);
  }
  r.b0 = *(const u32x4*)(Bp + k0);
  r.b1 = *(const u32x4*)(Bp + 64 * ldb + k0);
}
template <int NA, int TM>
DI void s_store(const Stg& r, u16* ns_) {
  *(u32x4*)(ns_) = r.a0;
  *(u32x4*)(ns_ + 64 * 80) = r.a1;
  if constexpr (NA == 4) {
    *(u32x4*)(ns_ + 128 * 80) = r.a2;
    *(u32x4*)(ns_ + 192 * 80) = r.a3;
  }
  *(u32x4*)(ns_ + TM * 80) = r.b0;
  *(u32x4*)(ns_ + TM * 80 + 64 * 80) = r.b1;
}
template <int MI>
DI void t_compute(f32x4 (&acc)[MI][4], const u16* as, const u16* bs, int wm, int wn, int fr, int fq) {
#pragma unroll
  for (int ks = 0; ks < 2; ++ks) {
    bf16x8 a[MI], b[4];
#pragma unroll
    for (int mi = 0; mi < MI; ++mi) a[mi] = *(const bf16x8*)(as + (wm * MI * 16 + mi * 16 + fr) * 80 + ks * 32 + fq * 8);
#pragma unroll
    for (int ni = 0; ni < 4; ++ni) b[ni] = *(const bf16x8*)(bs + (wn * 64 + ni * 16 + fr) * 80 + ks * 32 + fq * 8);
#pragma unroll
    for (int mi = 0; mi < MI; ++mi)
#pragma unroll
      for (int ni = 0; ni < 4; ++ni) acc[mi][ni] = MFMA(b[ni], a[mi], acc[mi][ni]);
  }
}
template <int MI>
DI void gemm_tile(f32x4 (&acc)[MI][4], const u16* __restrict__ A, long lda, const u16* __restrict__ B, long ldb, int K,
                  char* smem, Stg& r0, Stg& r1, bool pre, const u16* nA, long nlda, const u16* nB, long nldb) {
  constexpr int TM = MI * 64;
  constexpr int STAGE = (TM + 128) * 80;
  constexpr int NA = TM * 8 / 512;
  u16* s = (u16*)smem;
  const int tid = mytid(), lane = tid & 63, wid = tid >> 6;
  const int wm = wid >> 1, wn = wid & 1, fr = lane & 15, fq = lane >> 4;
  const long to_a = (long)(tid >> 3), to_c = (tid & 7) * 8;
  const u16* Ap = A + to_a * lda + to_c;
  const u16* Bp = B + to_a * ldb + to_c;
  const u16* nAp = nA + to_a * nlda + to_c;
  const u16* nBp = nB + to_a * nldb + to_c;
  const int so = (tid >> 3) * 80 + (tid & 7) * 8;
#define GLOAD(r, k0) g_load<NA>(r, Ap, lda, Bp, ldb, (k0))
#define NLOAD(r, k0) g_load<NA>(r, nAp, nlda, nBp, nldb, (k0))
#define SSTORE(r, st) s_store<NA, TM>(r, s + (st) * STAGE + so)
#define COMPUTE(st) t_compute<MI>(acc, s + (st) * STAGE, s + (st) * STAGE + TM * 80, wm, wn, fr, fq)
#pragma unroll
  for (int mi = 0; mi < MI; ++mi)
#pragma unroll
    for (int ni = 0; ni < 4; ++ni) acc[mi][ni] = f32x4{0.f, 0.f, 0.f, 0.f};
  const int nk = K >> 6;
  if (!pre) {
    GLOAD(r0, 0);
    GLOAD(r1, 64);
  }
  SSTORE(r0, 0);
  lds_barrier();
  for (int kt = 0; kt < nk; kt += 2) {
    if (kt + 2 < nk) GLOAD(r0, (kt + 2) << 6);
    else if (nA) NLOAD(r0, 0);
    COMPUTE(0);
    SSTORE(r1, 1);
    lds_barrier();
    if (kt + 3 < nk) GLOAD(r1, (kt + 3) << 6);
    else if (nA) NLOAD(r1, 64);
    COMPUTE(1);
    if (kt + 2 < nk) SSTORE(r0, 0);
    lds_barrier();
  }
#undef GLOAD
#undef NLOAD
#undef SSTORE
#undef COMPUTE
}

struct TD {
  const u16* A;
  const u16* B;
  u16* C;
  long lda, ldb, ldc;
  int K;
  int mode;
  int split;
  float scale;
  int tok0, col0;
  const float* g;
};

template <int MI = 4>
DI void run_tile2(const Prm& p, const TD& d, char* smem, Stg& r0, Stg& r1, bool pre, const u16* nA, long nlda,
                 const u16* nB, long nldb);
DI void run_tile(const Prm& p, const TD& d, char* smem) {
  Stg r0, r1;
  run_tile2<4>(p, d, smem, r0, r1, false, nullptr, 0, nullptr, 0);
}
template <int MI>
DI void run_tile2(const Prm& p, const TD& d, char* smem, Stg& r0, Stg& r1, bool pre, const u16* nA, long nlda,
                 const u16* nB, long nldb) {
  f32x4 acc[MI][4];
  gemm_tile<MI>(acc, d.A, d.lda, d.B, d.ldb, d.K, smem, r0, r1, pre, nA, nlda, nB, nldb);
  const int tid = mytid(), lane = tid & 63, wid = tid >> 6;
  const int wm = wid >> 1, wn = wid & 1, fr = lane & 15, fq = lane >> 4;
  if (d.mode == 4) {
    const int which = d.col0 >> 2, h = d.col0 & 3;
    const float* gain = d.g + which * 64 + fq * 4;
    const float* RC = (const float*)(p.ws + OFF_ROPE);
    const float* RS = RC + 65536;
    u16* dstb = d.C + (which ? 18874368L : 0L);
    const float qs = which ? 1.f : 0.18033688011112042f;
#pragma unroll
    for (int mi = 0; mi < MI; ++mi) {
      const int tok = d.tok0 + wm * (MI * 16) + mi * 16 + fr;
      float ss = 0.f;
#pragma unroll
      for (int ni = 0; ni < 4; ++ni)
#pragma unroll
        for (int j = 0; j < 4; ++j) ss += acc[mi][ni][j] * acc[mi][ni][j];
      ss += __shfl_xor(ss, 16);
      ss += __shfl_xor(ss, 32);
      const float inv = rsqrtf(ss * (1.f / 64.f) + 1e-6f) * qs;
      int b, P;
      const bool lat = tok < T_LAT;
      if (lat) { b = tok >> 11; P = 256 + (tok & 2047); }
      else { b = (tok - T_LAT) >> 8; P = (tok - T_LAT) & 255; }
      float y[4][4];
#pragma unroll
      for (int ni = 0; ni < 4; ++ni) {
        float4 g4 = *(const float4*)(gain + ni * 16);
        y[ni][0] = acc[mi][ni][0] * inv * g4.x; y[ni][1] = acc[mi][ni][1] * inv * g4.y;
        y[ni][2] = acc[mi][ni][2] * inv * g4.z; y[ni][3] = acc[mi][ni][3] * inv * g4.w;
      }
      u16* dst = dstb + ((long)((b * 4 + h) * 2 + wn) * 2304 + P) * 64 + fq * 4;
#pragma unroll
      for (int ni = 0; ni < 4; ++ni) {
        float o0 = y[ni][0], o1 = y[ni][1], o2 = y[ni][2], o3 = y[ni][3];
        if (lat) {
          const int l = tok & 2047, a = ni >> 1;
          float4 c4 = *(const float4*)(RC + (l * 2 + a) * 16 + fq * 4);
          float4 s4 = *(const float4*)(RS + (l * 2 + a) * 16 + fq * 4);
          const float sg = (ni & 1) ? 1.f : -1.f;
          o0 = y[ni][0] * c4.x + sg * y[ni ^ 1][0] * s4.x;
          o1 = y[ni][1] * c4.y + sg * y[ni ^ 1][1] * s4.y;
          o2 = y[ni][2] * c4.z + sg * y[ni ^ 1][2] * s4.z;
          o3 = y[ni][3] * c4.w + sg * y[ni ^ 1][3] * s4.w;
        }
        uint2 o;
        o.x = pk_bf16(o0, o1);
        o.y = pk_bf16(o2, o3);
        *(uint2*)(dst + ni * 16) = o;
      }
    }
    return;
  }
#pragma unroll
  for (int mi = 0; mi < MI; ++mi)
#pragma unroll
    for (int ni = 0; ni < 4; ++ni) {
      int r = wm * (MI * 16) + mi * 16 + fr, c = wn * 64 + ni * 16 + fq * 4;
      f32x4 v = acc[mi][ni];
      if (d.mode == 0) {
        long ro = d.split ? ((long)(r & 127) * d.ldc + (long)(r >> 7) * d.split) : (long)r * d.ldc;
        uint2 o;
        o.x = pk_bf16(v[0] * d.scale, v[1] * d.scale); o.y = pk_bf16(v[2] * d.scale, v[3] * d.scale);
        *(uint2*)(d.C + ro + c) = o;
      } else if (d.mode == 1) {
        uint2 o;
        float t0 = fmaxf(v[0], 0.f), t1 = fmaxf(v[1], 0.f), t2 = fmaxf(v[2], 0.f), t3 = fmaxf(v[3], 0.f);
        o.x = pk_bf16(t0 * t0, t1 * t1); o.y = pk_bf16(t2 * t2, t3 * t3);
        *(uint2*)(d.C + (long)r * d.ldc + c) = o;
      } else if (d.mode == 3) {
        if (wn == 0 && ni == 0) *(float4*)((float*)d.C + (long)r * 16 + fq * 4) = float4{v[0], v[1], v[2], v[3]};
      } else {
        float4* xp = (float4*)(xrow(p, d.tok0 + r) + d.col0 + c);
        float4 g4 = *(const float4*)(d.g + d.col0 + c);
        float4 x4 = *xp;
        x4.x += g4.x * v[0]; x4.y += g4.y * v[1]; x4.z += g4.z * v[2]; x4.w += g4.w * v[3];
        *xp = x4;
      }
    }
}

DI void ph_init(const Prm& p, char* smem) {
  const long gt = (long)mybid() * 512 + mytid(), gn = (long)gridDim.x * 512;
  {
    const float4* s = (const float4*)p.x;
    float4* d = (float4*)p.out;
#pragma unroll 8
    for (long i = gt; i < 32768L * 256; i += gn) d[i] = s[i];
    const float4* s2 = (const float4*)p.ctx;
    float4* d2 = (float4*)(p.ws + OFF_XC);
#pragma unroll 8
    for (long i = gt; i < 4096L * 256; i += gn) d2[i] = s2[i];
  }
  {
    u16* DL = (u16*)(p.ws + OFF_DL);
    for (long i = gt; i < 2048L * 4096; i += gn) {
      int l = (int)(i >> 12), kk = (int)(i & 4095), lp = kk & 2047, part = kk >> 11;
      int m = (l * lp) & 2047;
      float ang = (float)m * (6.283185307179586f / 2048.f);
      DL[i] = f2bf(part ? -sinf(ang) : cosf(ang));
    }
    u16* DLC = (u16*)(p.ws + OFF_DLC);
    for (long i = gt; i < 256L * 512; i += gn) {
      int l = (int)(i >> 9), kk = (int)(i & 511), lp = kk & 255, part = kk >> 8;
      int m = (l * lp) & 255;
      float ang = (float)m * (6.283185307179586f / 256.f);
      DLC[i] = f2bf(part ? -sinf(ang) : cosf(ang));
    }
    {
      float* RC = (float*)(p.ws + OFF_ROPE);
      float* RS = RC + 65536;
      for (long i = gt; i < 65536; i += gn) {
        int l = (int)(i >> 5), a = (int)(i >> 4) & 1, f = (int)(i & 15);
        float pos = a ? (float)(l & 63) : (float)(l >> 6);
        float ang = pos * powf(10000.f, -(float)f / 16.f);
        RC[i] = cosf(ang);
        RS[i] = sinf(ang);
      }
    }
    u16* DC = (u16*)(p.ws + OFF_DC);
    for (long i = gt; i < 256L * 128; i += gn) {
      int j2 = (int)(i >> 7), ii = (int)(i & 127), part = j2 >> 7, j = j2 & 127;
      int m = (ii * j) & 127;
      float ang = (float)m * (6.283185307179586f / 128.f);
      DC[i] = f2bf(part ? sinf(ang) : cosf(ang));
    }
  }
  float* sc = (float*)smem;
  float* red = sc + 17 * 1024;
  const int tid = mytid();
  for (int e = tid; e < 17 * 1024; e += 512) {
    int bb = e >> 10, k = e & 1023;
    float v = bb < 16 ? p.c[bb * 1024 + k] : p.c_ctx[k];
    sc[e] = v / (1.f + expf(-v));
  }
  __syncthreads();
  float* MOD = (float*)(p.ws + OFF_MOD);
  for (int it = mybid(); it < 192; it += gridDim.x) {
    int li = it / 48, cgp = it % 48;
    int cl = tid & 127, kq = tid >> 7, n = cgp * 128 + cl;
    float a[17];
#pragma unroll
    for (int b = 0; b < 17; ++b) a[b] = 0.f;
    const float* w = p.w_ada + ((long)li * 1024 + kq * 256) * 6144 + n;
#pragma unroll 1
    for (int k = 0; k < 256; k += 8) {
      float wv[8];
#pragma unroll
      for (int u = 0; u < 8; ++u) wv[u] = w[(long)(k + u) * 6144];
#pragma unroll
      for (int u = 0; u < 8; ++u) {
#pragma unroll
        for (int b = 0; b < 17; ++b) a[b] += sc[b * 1024 + kq * 256 + k + u] * wv[u];
        asm volatile("" ::: "memory");
      }
    }
#pragma unroll
    for (int b = 0; b < 17; ++b) red[(kq * 17 + b) * 128 + cl] = a[b];
    __syncthreads();
    for (int e = tid; e < 17 * 128; e += 512) {
      int b = e >> 7, c2 = e & 127, n2 = cgp * 128 + c2;
      float v = p.b_ada[li * 6144 + n2];
      for (int q = 0; q < 4; ++q) v += red[(q * 17 + b) * 128 + c2];
      MOD[((long)li * 17 + b) * 6144 + n2] = v;
    }
    __syncthreads();
  }
}

DI long tr_job(long base, const float* src, int K, int N, u16* dst, int nb, char* smem) {
  float* t = (float*)smem;
  const int tk = K >> 6, tn = (N + 63) >> 6, per = tk * tn, total = per * nb;
  const int tid = mytid();
  const int G = gridDim.x;
  float v[8];
  int it = first_item(base);
  if (it < total) {
    int b = it / per, r = it % per, kt = r / tn, nt = r % tn;
    const float* s = src + (long)b * K * N;
#pragma unroll
    for (int i = 0; i < 8; ++i) {
      int id = tid + i * 512, kk = id >> 6, nn = id & 63;
      v[i] = (nt * 64 + nn < N) ? s[(long)(kt * 64 + kk) * N + nt * 64 + nn] : 0.f;
    }
  }
  for (; it < total; it += G) {
    int b = it / per, r = it % per, kt = r / tn, nt = r % tn;
    u16* d = dst + (long)b * K * N;
    int k0 = kt * 64, n0 = nt * 64;
#pragma unroll
    for (int i = 0; i < 8; ++i) {
      int id = tid + i * 512, kk = id >> 6, nn = id & 63;
      t[kk * 65 + nn] = v[i];
    }
    __syncthreads();
    if (it + G < total) {
      int it2 = it + G, b2 = it2 / per, r2 = it2 % per, kt2 = r2 / tn, nt2 = r2 % tn;
      const float* s2 = src + (long)b2 * K * N;
#pragma unroll
      for (int i = 0; i < 8; ++i) {
        int id = tid + i * 512, kk = id >> 6, nn = id & 63;
        v[i] = (nt2 * 64 + nn < N) ? s2[(long)(kt2 * 64 + kk) * N + nt2 * 64 + nn] : 0.f;
      }
    }
#pragma unroll
    for (int i = 0; i < 8; ++i) {
      int id = tid + i * 512, nn = id >> 6, kk = id & 63;
      if (n0 + nn < N) d[(long)(n0 + nn) * K + k0 + kk] = f2bf(t[kk * 65 + nn]);
    }
    __syncthreads();
  }
  return base + total;
}

DI void ph_norm(const Prm& p, int li, int which) {
  const int lane = mytid() & 63;
  const int gw = mybid() * 8 + (mytid() >> 6), nw = gridDim.x * 8;
  const float* nwt = (which ? p.norm2 : p.norm1) + li * 1024;
  const float* MOD = (const float*)(p.ws + OFF_MOD);
  u16* H = (u16*)(p.ws + OFF_HBF);
  const int nrows = (which && li == 3) ? T_LAT : T_ALL;
  for (int row = gw; row < nrows; row += 2 * nw) {
    const int row2 = row + nw;
    const bool has2 = row2 < nrows;
    const float* xr = xrow(p, row);
    const float* xr2 = xrow(p, has2 ? row2 : row);
    float4 v[4], u[4];
    float ss = 0.f, ss2 = 0.f;
#pragma unroll
    for (int i = 0; i < 4; ++i) {
      v[i] = *(const float4*)(xr + i * 256 + lane * 4);
      u[i] = *(const float4*)(xr2 + i * 256 + lane * 4);
    }
#pragma unroll
    for (int i = 0; i < 4; ++i) {
      ss += v[i].x * v[i].x + v[i].y * v[i].y + v[i].z * v[i].z + v[i].w * v[i].w;
      ss2 += u[i].x * u[i].x + u[i].y * u[i].y + u[i].z * u[i].z + u[i].w * u[i].w;
    }
#pragma unroll
    for (int o = 32; o; o >>= 1) {
      ss += __shfl_xor(ss, o);
      ss2 += __shfl_xor(ss2, o);
    }
    const float inv = rsqrtf(ss * (1.f / 1024.f) + 1e-6f), inv2 = rsqrtf(ss2 * (1.f / 1024.f) + 1e-6f);
    const int bb = row < T_LAT ? (row >> 11) : 16, bb2 = row2 < T_LAT ? (row2 >> 11) : 16;
    const float* sh = MOD + ((long)li * 17 + bb) * 6144 + (which ? 3 : 0) * 1024;
    const float* sh2 = MOD + ((long)li * 17 + (has2 ? bb2 : bb)) * 6144 + (which ? 3 : 0) * 1024;
#pragma unroll
    for (int i = 0; i < 4; ++i) {
      int c = i * 256 + lane * 4;
      float4 w4 = *(const float4*)(nwt + c);
      {
        float4 s4 = *(const float4*)(sh + 1024 + c), h4 = *(const float4*)(sh + c);
        uint2 o;
        o.x = pk_bf16(v[i].x * inv * w4.x * (1.f + s4.x) + h4.x, v[i].y * inv * w4.y * (1.f + s4.y) + h4.y);
        o.y = pk_bf16(v[i].z * inv * w4.z * (1.f + s4.z) + h4.z, v[i].w * inv * w4.w * (1.f + s4.w) + h4.w);
        *(uint2*)(H + (long)row * 1024 + c) = o;
      }
      if (has2) {
        float4 s4 = *(const float4*)(sh2 + 1024 + c), h4 = *(const float4*)(sh2 + c);
        uint2 o;
        o.x = pk_bf16(u[i].x * inv2 * w4.x * (1.f + s4.x) + h4.x, u[i].y * inv2 * w4.y * (1.f + s4.y) + h4.y);
        o.y = pk_bf16(u[i].z * inv2 * w4.z * (1.f + s4.z) + h4.z, u[i].w * inv2 * w4.w * (1.f + s4.w) + h4.w);
        *(uint2*)(H + (long)row2 * 1024 + c) = o;
      }
    }
  }
}

DI void ph_taps1(const Prm& p, int li, long base, char* smem) {
  float* f = (float*)smem;
  float* hraw = (float*)(p.ws + OFF_AR + 5 * U38);
  const int tid = mytid();
  for (int it = first_item(base); it < 288; it += gridDim.x) {
    const int L = it < 256 ? 2048 : 256, j0 = it < 256 ? it * 8 : (it - 256) * 8;
    const int lg = tid >> 6, kk = tid & 63;
    if (tid < 8 * 33) {
      int l2 = tid / 33, e = tid % 33, j = j0 + l2;
      float t = (float)j / (float)(L - 1);
      float w = 6.283185307179586f * (float)j / (float)L;
      float v;
      if (e == 0) v = t;
      else {
        int bi = (e - 1) & 15;
        float band = 1e-4f + (float)bi * ((15.f - 1e-4f) / 15.f);
        v = (e <= 16) ? cosf(band * w) : -sinf(band * w);
      }
      f[l2 * 40 + e] = v;
    }
    __syncthreads();
    {
      float v = p.hy_b1[li * 64 + kk];
#pragma unroll 3
      for (int e = 0; e < 33; ++e) v += f[lg * 40 + e] * p.hy_w1[(li * 33 + e) * 64 + kk];
      f[320 + lg * 64 + kk] = sinf(p.hy_freq[(li * 2 + 0) * 64 + kk] * v);
    }
    __syncthreads();
    {
      float v = p.hy_b2[li * 64 + kk];
#pragma unroll 4
      for (int m = 0; m < 64; ++m) v += f[320 + lg * 64 + m] * p.hy_w2[(li * 64 + m) * 64 + kk];
      f[832 + lg * 64 + kk] = sinf(p.hy_freq[(li * 2 + 1) * 64 + kk] * v);
    }
    __syncthreads();
    {
      float h[4][8];
#pragma unroll
      for (int i = 0; i < 4; ++i)
#pragma unroll
        for (int l2 = 0; l2 < 8; ++l2) h[i][l2] = 0.f;
      const float* w3 = p.hy_w3 + (long)li * 64 * 2048 + tid;
#pragma unroll 2
      for (int k = 0; k < 64; ++k) {
        float wv[4];
#pragma unroll
        for (int i = 0; i < 4; ++i) wv[i] = w3[(long)k * 2048 + i * 512];
#pragma unroll
        for (int l2 = 0; l2 < 8; ++l2) {
          float hv = f[832 + l2 * 64 + k];
#pragma unroll
          for (int i = 0; i < 4; ++i) h[i][l2] += hv * wv[i];
        }
      }
#pragma unroll
      for (int i = 0; i < 4; ++i) {
        int n = tid + i * 512, ch = n & 511;
        float delta = fabsf(-3.0701134573253946f + (float)ch * ((-15.350567286626973f + 3.0701134573253946f) / 511.f));
#pragma unroll
        for (int l2 = 0; l2 < 8; ++l2) {
          int j = j0 + l2;
          float t = (float)j / (float)(L - 1);
          long row = (it < 256) ? j : 2048 + j;
          hraw[row * 2048 + n] = h[i][l2] * expf(-t * delta);
        }
      }
    }
    __syncthreads();
  }
}
DI void ph_taps2(const Prm& p, long base, char* smem) {
  float* vals = (float*)smem;
  float* red = vals + 8 * 2048;
  const float* hraw = (const float*)(p.ws + OFF_AR + 5 * U38);
  const int tid = mytid(), cl = tid & 3, dir = (tid >> 2) & 1, jg = tid >> 3;
  for (int it = first_item(base); it < 512; it += gridDim.x) {
    int ls = it >> 8, order = (it >> 7) & 1, cgp = it & 127;
    int L = ls ? 256 : 2048;
    const float* hr = hraw + (long)(ls ? 2048 : 0) * 2048;
    u16* G = (u16*)(p.ws + (ls ? OFF_TAPC : OFF_TAPL));
    int ch = cgp * 4 + cl, n = order * 1024 + dir * 512 + ch;
    float s = 0.f;
#pragma unroll 8
    for (int j = jg; j < L; j += 64) {
      float v = hr[(long)j * 2048 + n];
      vals[(cl * 2 + dir) * L + j] = v;
      s += (dir == 1 && j == 0) ? 0.f : fabsf(v);
    }
    red[(tid >> 2) * 4 + cl] = s;
    __syncthreads();
    if (tid < 4) {
      float tot = 0.f;
#pragma unroll 8
      for (int r = 0; r < 128; ++r) tot += red[r * 4 + tid];
      red[512 + tid] = 1.f / tot;
    }
    __syncthreads();
    for (int idx = tid; idx < 8 * L; idx += 512) {
      int q = idx / L, j = idx % L, c2 = q >> 1, d2 = q & 1;
      float v = vals[idx] * red[512 + c2];
      u16* g = G + (long)(order * 512 + cgp * 4 + c2) * (2 * L);
      if (d2 == 0) g[L + j] = f2bf(v);
      else if (j > 0) g[L - j] = f2bf(v);
      else g[0] = 0;
    }
    __syncthreads();
  }
}

DI void ph_pdab(const Prm& p, int li, char* smem) {
  float* wl = (float*)smem;
  const int tid = mytid(), lane = tid & 63;
#pragma unroll 8
  for (int e = tid; e < 1024 * 16; e += 512) wl[e] = p.w_in[((long)li * 1024 + (e >> 4)) * NIN + 5632 + (e & 15)];
  __syncthreads();
  const u16* H = (const u16*)(p.ws + OFF_HBF);
  float* out = (float*)(p.ws + OFF_PDAB);
  const int gw = mybid() * 8 + (tid >> 6), nw = gridDim.x * 8;
  for (int tok = gw; tok < T_ALL; tok += nw) {
    float a[16];
#pragma unroll
    for (int j = 0; j < 16; ++j) a[j] = 0.f;
    float hv[16];
#pragma unroll
    for (int i = 0; i < 16; ++i) hv[i] = bf2f(H[(long)tok * 1024 + lane + i * 64]);
#pragma unroll
    for (int i = 0; i < 16; ++i) {
      float h = hv[i];
      const float4* wp = (const float4*)(wl + (lane + i * 64) * 16);
#pragma unroll
      for (int q = 0; q < 4; ++q) {
        float4 w4 = wp[q];
        a[q * 4 + 0] += h * w4.x;
        a[q * 4 + 1] += h * w4.y;
        a[q * 4 + 2] += h * w4.z;
        a[q * 4 + 3] += h * w4.w;
      }
      if ((i & 3) == 3) asm volatile("" ::: "memory");
    }
#pragma unroll
    for (int o = 32; o; o >>= 1)
#pragma unroll
      for (int j = 0; j < 16; ++j) a[j] += __shfl_xor(a[j], o);
    float v = a[0];
#pragma unroll
    for (int j = 1; j < 16; ++j) v = (lane == j) ? a[j] : v;
    if (lane < 16) out[(long)tok * 16 + lane] = v;
  }
  __syncthreads();
}

DI void ph_dncl(const Prm& p, int li, char* smem) {
  const int tid = mytid(), lane = tid & 63, wid = tid >> 6, fr = lane & 15, fq = lane >> 4;
  u16* qn = (u16*)smem;
  u16* kn = qn + 64 * 144;
  float* fb = (float*)(smem + 36864);
  float* KK = fb;
  float* QK = KK + 64 * 65;
  float* Am = QK + 64 * 65;
  float* Tm = Am + 2 * 64 * 65;
  float* gcs = Tm + 2 * 64 * 65;
  float* bts = gcs + 128;
  const u16* PD = (const u16*)(p.ws + OFF_AR);
  const float* AB = (const float*)(p.ws + OFF_PDAB);
  u16* DQ = (u16*)(p.ws + OFF_Y);
  u16* DK = DQ + 18874368L;
  u16* DV = DK + 18874368L;
  u16* CL = (u16*)(p.ws + OFF_AR + 3 * U38);
  float* GC = (float*)(p.ws + OFF_GC);
  float* BT = (float*)(p.ws + OFF_BETA);
  const float* cw = p.dn_conv + (long)li * 3 * 1536;
  for (int it = mybid(); it < 2304; it += gridDim.x) {
    const int b = it / 144, r0 = it % 144, oc = r0 >> 2, h = r0 & 3;
    const int pos0 = oc * 64, s0 = oc < 4 ? 0 : 256, e0 = oc < 4 ? 256 : 2304;
    if (tid < 384) {
      const int cgp = tid % 48, rs = tid / 48;
      const int part = cgp >> 4, d0 = (cgp & 15) * 8, col = part * 512 + h * 128 + d0;
      const u16* basep = PD + (long)tokof(b, pos0) * 1536 + col;
      float wt[3][8];
#pragma unroll
      for (int tp = 0; tp < 3; ++tp) {
        float4 wa = *(const float4*)(cw + tp * 1536 + col), wb = *(const float4*)(cw + tp * 1536 + col + 4);
        wt[tp][0] = wa.x; wt[tp][1] = wa.y; wt[tp][2] = wa.z; wt[tp][3] = wa.w;
        wt[tp][4] = wb.x; wt[tp][5] = wb.y; wt[tp][6] = wb.z; wt[tp][7] = wb.w;
      }
#pragma unroll 1
      for (int hf = 0; hf < 2; ++hf) {
        u32x4 rw[6];
#pragma unroll
        for (int i = 0; i < 6; ++i) {
          int j = rs * 8 + hf * 4 - 1 + i, P = pos0 + j;
          rw[i] = (P >= s0 && P < e0) ? *(const u32x4*)(basep + (long)j * 1536) : u32x4{0u, 0u, 0u, 0u};
        }
#pragma unroll
        for (int r = 0; r < 4; ++r) {
#pragma unroll
          for (int e = 0; e < 8; ++e) {
            unsigned w0_ = rw[r][e >> 1], w1_ = rw[r + 1][e >> 1], w2_ = rw[r + 2][e >> 1];
            float x0 = (e & 1) ? __uint_as_float(w0_ & 0xffff0000u) : __uint_as_float(w0_ << 16);
            float x1 = (e & 1) ? __uint_as_float(w1_ & 0xffff0000u) : __uint_as_float(w1_ << 16);
            float x2 = (e & 1) ? __uint_as_float(w2_ & 0xffff0000u) : __uint_as_float(w2_ << 16);
            float v = wt[0][e] * x0 + wt[1][e] * x1 + wt[2][e] * x2;
            fb[(rs * 8 + hf * 4 + r) * 385 + part * 128 + d0 + e] = v * __builtin_amdgcn_rcpf(1.f + __expf(-v));
          }
        }
      }
    }
    __syncthreads();
    for (int jj = 0; jj < 8; ++jj) {
      int j = wid * 8 + jj, P = pos0 + j;
      long go = ((long)(b * 4 + h) * 2304 + P) * 128;
      float q0 = fb[j * 385 + lane], q1 = fb[j * 385 + 64 + lane];
      float k0 = fb[j * 385 + 128 + lane], k1 = fb[j * 385 + 192 + lane];
      float v0 = fb[j * 385 + 256 + lane], v1 = fb[j * 385 + 320 + lane];
      float iq = rsqrtf(wsum(q0 * q0 + q1 * q1) + 1e-6f), ik = rsqrtf(wsum(k0 * k0 + k1 * k1) + 1e-6f);
      u16 a0 = f2bf(q0 * iq), a1 = f2bf(q1 * iq), c0 = f2bf(k0 * ik), c1 = f2bf(k1 * ik);
      qn[j * 144 + lane] = a0; qn[j * 144 + 64 + lane] = a1;
      kn[j * 144 + lane] = c0; kn[j * 144 + 64 + lane] = c1;
      DQ[go + lane] = a0; DQ[go + 64 + lane] = a1;
      DK[go + lane] = c0; DK[go + 64 + lane] = c1;
      DV[go + lane] = f2bf(v0); DV[go + 64 + lane] = f2bf(v1);
    }
    __syncthreads();
#pragma unroll
    for (int u = 0; u < 4; ++u) {
      int tt = wid * 4 + u, which = tt >> 4, ti = (tt >> 2) & 3, tj = tt & 3;
      const u16* Ap = (which ? qn : kn) + (ti * 16 + fr) * 144 + fq * 8;
      const u16* Bp = kn + (tj * 16 + fr) * 144 + fq * 8;
      f32x4 a = {0.f, 0.f, 0.f, 0.f};
#pragma unroll
      for (int ks = 0; ks < 4; ++ks) a = MFMA(*(const bf16x8*)(Ap + ks * 32), *(const bf16x8*)(Bp + ks * 32), a);
      float* dst = which ? QK : KK;
#pragma unroll
      for (int j = 0; j < 4; ++j) dst[(ti * 16 + fq * 4 + j) * 65 + tj * 16 + fr] = a[j];
    }
    if (tid < 128) {
      int d = tid >> 6, r = tid & 63, j = d ? 63 - r : r;
      int tok = tokof(b, pos0 + j);
      float av = AB[(long)tok * 16 + d * 4 + h], bv = AB[(long)tok * 16 + 8 + d * 4 + h];
      float xx = av + p.dn_dt_bias[li * 8 + d * 4 + h];
      float sp = fmaxf(xx, 0.f) + __logf(1.f + __expf(-fabsf(xx)));
      float g = -expf(p.dn_a_log[li * 8 + d * 4 + h]) * sp;
      for (int o = 1; o < 64; o <<= 1) {
        float t = __shfl_up(g, o);
        if (r >= o) g += t;
      }
      float be = 1.f / (1.f + expf(-bv));
      gcs[d * 64 + r] = g;
      bts[d * 64 + r] = be;
      long ci = ((long)((b * 4 + h) * 2 + d) * 36 + oc) * 64 + r;
      GC[ci] = g;
      BT[ci] = be;
    }
    __syncthreads();
#pragma unroll 4
    for (int e = tid; e < 8192; e += 512) {
      int d = e >> 12, s = (e >> 6) & 63, r = e & 63;
      int j = d ? 63 - r : r, js = d ? 63 - s : s;
      float v = 0.f;
      if (r > s) v = bts[d * 64 + r] * KK[j * 65 + js] * __expf(gcs[d * 64 + r] - gcs[d * 64 + s]);
      Am[(d * 64 + s) * 64 + r] = v;
    }
#pragma unroll 4
    for (int e = tid; e < 8192; e += 512) {
      int d = e >> 12, r = (e >> 6) & 63, s = e & 63;
      int j = d ? 63 - r : r, js = d ? 63 - s : s;
      float dec = (r >= s) ? __expf(gcs[d * 64 + r] - gcs[d * 64 + s]) : 0.f;
      long ci = (long)((b * 4 + h) * 2 + d) * 36 + oc;
      CL[ci * 8192 + 4096 + r * 64 + s] = f2bf(QK[j * 65 + js] * dec * 0.08838834764831845f);
    }
    __syncthreads();
    {
      const int d = tid >> 8, c = (tid >> 2) & 63, q = tid & 3;
      const float* Atq = Am + d * 64 * 64 + q;
      float* T = Tm + d * 64 * 65;
      float t[16];
#pragma unroll
      for (int i = 0; i < 16; ++i) t[i] = (4 * i + q == c) ? 1.f : 0.f;
#pragma unroll
      for (int s2 = 0; s2 < 63; ++s2) {
        constexpr int dummy = 0;
        const int is = s2 >> 2, qs = s2 & 3;
        const int ctl = qs | (qs << 2) | (qs << 4) | (qs << 6);
        int tsb;
        if (qs == 0) tsb = __builtin_amdgcn_update_dpp(0, __float_as_int(t[is]), 0x00, 0xf, 0xf, false);
        else if (qs == 1) tsb = __builtin_amdgcn_update_dpp(0, __float_as_int(t[is]), 0x55, 0xf, 0xf, false);
        else if (qs == 2) tsb = __builtin_amdgcn_update_dpp(0, __float_as_int(t[is]), 0xAA, 0xf, 0xf, false);
        else tsb = __builtin_amdgcn_update_dpp(0, __float_as_int(t[is]), 0xFF, 0xf, 0xf, false);
        (void)ctl; (void)dummy;
        const float ts = __int_as_float(tsb);
#pragma unroll
        for (int i = is; i < 16; ++i) t[i] -= Atq[s2 * 64 + 4 * i] * ts;
        if ((s2 & 7) == 7) asm volatile("" ::: "memory");
      }
#pragma unroll
      for (int i = 0; i < 16; ++i) T[(4 * i + q) * 65 + c] = t[i];
    }
    __syncthreads();
    for (int e = tid; e < 8192; e += 512) {
      int d = e >> 12, rc = e & 4095;
      long ci = (long)((b * 4 + h) * 2 + d) * 36 + oc;
      CL[ci * 8192 + rc] = f2bf(Tm[(d * 64 + (rc >> 6)) * 65 + (rc & 63)]);
    }
    __syncthreads();
  }
}

DI void ph_dnscan(const Prm& p, char* smem) {
  const int tid = mytid(), lane = tid & 63, wid = tid >> 6, fr = lane & 15, fq = lane >> 4;
  u16* Kg = (u16*)smem;
  u16* Qg = Kg + 64 * 144;
  u16* KdT = Qg + 64 * 144;
  u16* Tl = KdT + 128 * 80;
  u16* Il = Tl + 64 * 80;
  u16* ST = Il + 64 * 80;
  u16* RT = ST + 64 * 144;
  u16* VN = RT + 64 * 80;
  const u16* DQ = (const u16*)(p.ws + OFF_Y);
  const u16* DK = DQ + 18874368L;
  const u16* DV = DK + 18874368L;
  const u16* CL = (const u16*)(p.ws + OFF_AR + 3 * U38);
  const float* GC = (const float*)(p.ws + OFF_GC);
  const float* BT = (const float*)(p.ws + OFF_BETA);
  const int vt = wid & 3, rp = wid >> 2;
  for (int it = mybid(); it < 256; it += gridDim.x) {
    const int b = it >> 4, h = (it >> 2) & 3, d = (it >> 1) & 1, vs = it & 1;
    u16* O = (u16*)(p.ws + OFF_AR + (d ? 6 : 5) * U38);
    f32x4 S[4];
#pragma unroll
    for (int i = 0; i < 4; ++i) S[i] = f32x4{0.f, 0.f, 0.f, 0.f};
    for (int e = tid; e < 64 * 144; e += 512) ST[e] = 0;
    const long seqb = (long)(b * 4 + h) * 2304;
    const long cib = (long)((b * 4 + h) * 2 + d) * 36;
    u32x4 rk0, rk1, rq0, rq1, rT, rI;
    float rg0, rg1, rgl;
    uint2 rv0, rv1;
    float rb0, rb1;
    const int lr0 = tid >> 4, lr1 = (tid + 512) >> 4, lch = tid & 15;
    const int lj0 = d ? 63 - lr0 : lr0, lj1 = d ? 63 - lr1 : lr1;
    const int vr0 = (rp * 2) * 16 + fr, vr1 = (rp * 2 + 1) * 16 + fr;
    const int vj0 = d ? 63 - vr0 : vr0, vj1 = d ? 63 - vr1 : vr1;
#define SCAN_LOAD_KQ(ocx)                                                                    \
  {                                                                                          \
    const long ci_ = cib + (ocx);                                                            \
    const long g0_ = (seqb + (ocx) * 64 + lj0) * 128 + lch * 8, g1_ = (seqb + (ocx) * 64 + lj1) * 128 + lch * 8; \
    rk0 = *(const u32x4*)(DK + g0_); rk1 = *(const u32x4*)(DK + g1_);                        \
    rq0 = *(const u32x4*)(DQ + g0_); rq1 = *(const u32x4*)(DQ + g1_);                        \
    rT = *(const u32x4*)(CL + ci_ * 8192 + (tid >> 3) * 64 + (tid & 7) * 8);                 \
    rI = *(const u32x4*)(CL + ci_ * 8192 + 4096 + (tid >> 3) * 64 + (tid & 7) * 8);          \
    rg0 = GC[ci_ * 64 + lr0]; rg1 = GC[ci_ * 64 + lr1]; rgl = GC[ci_ * 64 + 63];             \
  }
#define SCAN_LOAD_V(ocx)                                                                     \
  {                                                                                          \
    const long ci_ = cib + (ocx);                                                            \
    rv0 = *(const uint2*)(DV + (seqb + (ocx) * 64 + vj0) * 128 + vs * 64 + vt * 16 + fq * 4); \
    rv1 = *(const uint2*)(DV + (seqb + (ocx) * 64 + vj1) * 128 + vs * 64 + vt * 16 + fq * 4); \
    rb0 = BT[ci_ * 64 + vr0]; rb1 = BT[ci_ * 64 + vr1];                                      \
  }
    {
      const int oc0 = d ? 3 : 0;
      SCAN_LOAD_KQ(oc0);
      SCAN_LOAD_V(oc0);
    }
    for (int i = 0; i < 36; ++i) {
      const int oc = d ? (i < 4 ? 3 - i : 39 - i) : i;
      const int ocn = d ? (i + 1 < 4 ? 3 - (i + 1) : 39 - (i + 1)) : i + 1;
      const int pos0 = oc * 64;
      const float gl = rgl;
      {
        float eg0 = __expf(rg0), ed0 = __expf(gl - rg0), eg1 = __expf(rg1), ed1 = __expf(gl - rg1);
        u32x4 ko0, qo0, ko1, qo1;
#pragma unroll
        for (int w = 0; w < 4; ++w) {
          float k0l = __uint_as_float(rk0[w] << 16), k0h = __uint_as_float(rk0[w] & 0xffff0000u);
          float q0l = __uint_as_float(rq0[w] << 16), q0h = __uint_as_float(rq0[w] & 0xffff0000u);
          float k1l = __uint_as_float(rk1[w] << 16), k1h = __uint_as_float(rk1[w] & 0xffff0000u);
          float q1l = __uint_as_float(rq1[w] << 16), q1h = __uint_as_float(rq1[w] & 0xffff0000u);
          ko0[w] = pk_bf16(k0l * eg0, k0h * eg0);
          qo0[w] = pk_bf16(q0l * eg0 * 0.08838834764831845f, q0h * eg0 * 0.08838834764831845f);
          ko1[w] = pk_bf16(k1l * eg1, k1h * eg1);
          qo1[w] = pk_bf16(q1l * eg1 * 0.08838834764831845f, q1h * eg1 * 0.08838834764831845f);
          KdT[(lch * 8 + 2 * w) * 80 + lr0] = f2bf(k0l * ed0);
          KdT[(lch * 8 + 2 * w + 1) * 80 + lr0] = f2bf(k0h * ed0);
          KdT[(lch * 8 + 2 * w) * 80 + lr1] = f2bf(k1l * ed1);
          KdT[(lch * 8 + 2 * w + 1) * 80 + lr1] = f2bf(k1h * ed1);
        }
        *(u32x4*)(Kg + lr0 * 144 + lch * 8) = ko0;
        *(u32x4*)(Qg + lr0 * 144 + lch * 8) = qo0;
        *(u32x4*)(Kg + lr1 * 144 + lch * 8) = ko1;
        *(u32x4*)(Qg + lr1 * 144 + lch * 8) = qo1;
        *(u32x4*)(Tl + (tid >> 3) * 80 + (tid & 7) * 8) = rT;
        *(u32x4*)(Il + (tid >> 3) * 80 + (tid & 7) * 8) = rI;
      }
      lds_barrier();
      if (i + 1 < 36) SCAN_LOAD_KQ(ocn);
      f32x4 ks_[2], qs_[2];
#pragma unroll
      for (int u = 0; u < 2; ++u) { ks_[u] = f32x4{0.f, 0.f, 0.f, 0.f}; qs_[u] = f32x4{0.f, 0.f, 0.f, 0.f}; }
#pragma unroll
      for (int kk = 0; kk < 4; ++kk) {
        bf16x8 a = *(const bf16x8*)(ST + (vt * 16 + fr) * 144 + kk * 32 + fq * 8);
#pragma unroll
        for (int u = 0; u < 2; ++u) {
          int rt = rp * 2 + u;
          bf16x8 bk = *(const bf16x8*)(Kg + (rt * 16 + fr) * 144 + kk * 32 + fq * 8);
          bf16x8 bq = *(const bf16x8*)(Qg + (rt * 16 + fr) * 144 + kk * 32 + fq * 8);
          ks_[u] = MFMA(a, bk, ks_[u]);
          qs_[u] = MFMA(a, bq, qs_[u]);
        }
      }
      {
        int v0 = vt * 16 + fq * 4;
        RT[(v0 + 0) * 80 + vr0] = f2bf(rb0 * (__uint_as_float(rv0.x << 16) - ks_[0][0]));
        RT[(v0 + 1) * 80 + vr0] = f2bf(rb0 * (__uint_as_float(rv0.x & 0xffff0000u) - ks_[0][1]));
        RT[(v0 + 2) * 80 + vr0] = f2bf(rb0 * (__uint_as_float(rv0.y << 16) - ks_[0][2]));
        RT[(v0 + 3) * 80 + vr0] = f2bf(rb0 * (__uint_as_float(rv0.y & 0xffff0000u) - ks_[0][3]));
        RT[(v0 + 0) * 80 + vr1] = f2bf(rb1 * (__uint_as_float(rv1.x << 16) - ks_[1][0]));
        RT[(v0 + 1) * 80 + vr1] = f2bf(rb1 * (__uint_as_float(rv1.x & 0xffff0000u) - ks_[1][1]));
        RT[(v0 + 2) * 80 + vr1] = f2bf(rb1 * (__uint_as_float(rv1.y << 16) - ks_[1][2]));
        RT[(v0 + 3) * 80 + vr1] = f2bf(rb1 * (__uint_as_float(rv1.y & 0xffff0000u) - ks_[1][3]));
      }
      if (i + 1 < 36) SCAN_LOAD_V(ocn);
      lds_barrier();
      {
        f32x4 vn[2];
#pragma unroll
        for (int u = 0; u < 2; ++u) vn[u] = f32x4{0.f, 0.f, 0.f, 0.f};
#pragma unroll
        for (int kk = 0; kk < 2; ++kk) {
          bf16x8 a = *(const bf16x8*)(RT + (vt * 16 + fr) * 80 + kk * 32 + fq * 8);
#pragma unroll
          for (int u = 0; u < 2; ++u) {
            bf16x8 bb = *(const bf16x8*)(Tl + ((rp * 2 + u) * 16 + fr) * 80 + kk * 32 + fq * 8);
            vn[u] = MFMA(a, bb, vn[u]);
          }
        }
#pragma unroll
        for (int u = 0; u < 2; ++u) {
          int r = (rp * 2 + u) * 16 + fr, v0 = vt * 16 + fq * 4;
#pragma unroll
          for (int j = 0; j < 4; ++j) VN[(v0 + j) * 80 + r] = f2bf(vn[u][j]);
        }
      }
      lds_barrier();
#pragma unroll
      for (int kk = 0; kk < 2; ++kk) {
        bf16x8 a = *(const bf16x8*)(VN + (vt * 16 + fr) * 80 + kk * 32 + fq * 8);
#pragma unroll
        for (int u = 0; u < 2; ++u) {
          bf16x8 bb = *(const bf16x8*)(Il + ((rp * 2 + u) * 16 + fr) * 80 + kk * 32 + fq * 8);
          qs_[u] = MFMA(a, bb, qs_[u]);
        }
      }
#pragma unroll
      for (int u = 0; u < 2; ++u) {
        int r = (rp * 2 + u) * 16 + fr, j = d ? 63 - r : r;
        u16* op = O + (long)tokof(b, pos0 + j) * 512 + h * 128 + vs * 64 + vt * 16 + fq * 4;
        ushort4 ov4;
        ov4.x = f2bf(qs_[u][0]); ov4.y = f2bf(qs_[u][1]); ov4.z = f2bf(qs_[u][2]); ov4.w = f2bf(qs_[u][3]);
        *(ushort4*)op = ov4;
      }
      {
        float ge = __expf(gl);
#pragma unroll
        for (int u = 0; u < 4; ++u) S[u] *= ge;
#pragma unroll
        for (int kk = 0; kk < 2; ++kk) {
          bf16x8 a = *(const bf16x8*)(VN + (vt * 16 + fr) * 80 + kk * 32 + fq * 8);
#pragma unroll
          for (int u = 0; u < 4; ++u) {
            bf16x8 bb = *(const bf16x8*)(KdT + ((rp * 4 + u) * 16 + fr) * 80 + kk * 32 + fq * 8);
            S[u] = MFMA(a, bb, S[u]);
          }
        }
#pragma unroll
        for (int u = 0; u < 4; ++u) {
          int dd = (rp * 4 + u) * 16 + fr, v0 = vt * 16 + fq * 4;
#pragma unroll
          for (int j = 0; j < 4; ++j) ST[(v0 + j) * 144 + dd] = f2bf(S[u][j]);
        }
      }
      lds_barrier();
    }
#undef SCAN_LOAD_KQ
#undef SCAN_LOAD_V
  }
}

DI void ph_dnfin(const Prm& p, int li) {
  const int lane = mytid() & 63;
  const int gw = mybid() * 8 + (mytid() >> 6), nw = gridDim.x * 8;
  const u16* O = (const u16*)(p.ws + OFF_AR + 5 * U38);
  const u16* O2 = (const u16*)(p.ws + OFF_AR + 6 * U38);
  u16* Z = (u16*)(p.ws + OFF_Y + 3 * U38);
  const float n0 = p.dn_norm[li * 128 + lane * 2], n1 = p.dn_norm[li * 128 + lane * 2 + 1];
#pragma unroll 2
  for (int tok = gw; tok < T_ALL; tok += nw) {
    ushort2 oa[4], ob[4], zz[4];
    float ox[4], oy[4], ss[4];
#pragma unroll
    for (int h = 0; h < 4; ++h) {
      long o = (long)tok * 512 + h * 128 + lane * 2;
      oa[h] = *(const ushort2*)(O + o);
      ob[h] = *(const ushort2*)(O2 + o);
      zz[h] = *(const ushort2*)(Z + o);
    }
#pragma unroll
    for (int h = 0; h < 4; ++h) {
      ox[h] = bf2f(oa[h].x) + bf2f(ob[h].x);
      oy[h] = bf2f(oa[h].y) + bf2f(ob[h].y);
      ss[h] = ox[h] * ox[h] + oy[h] * oy[h];
    }
#pragma unroll
    for (int o = 32; o; o >>= 1)
#pragma unroll
      for (int h = 0; h < 4; ++h) ss[h] += __shfl_xor(ss[h], o);
#pragma unroll
    for (int h = 0; h < 4; ++h) {
      float inv = rsqrtf(ss[h] * (1.f / 128.f) + 1e-6f);
      float z0 = bf2f(zz[h].x), z1 = bf2f(zz[h].y);
      ushort2 y;
      y.x = f2bf(ox[h] * inv * n0 * (z0 * __builtin_amdgcn_rcpf(1.f + __expf(-z0))));
      y.y = f2bf(oy[h] * inv * n1 * (z1 * __builtin_amdgcn_rcpf(1.f + __expf(-z1))));
      *(ushort2*)(Z + (long)tok * 512 + h * 128 + lane * 2) = y;
    }
  }
}

DI void ph_aprep(const Prm& p, int li) {
  const int lane = mytid() & 63;
  const int gw = mybid() * 8 + (mytid() >> 6), nw = gridDim.x * 8;
  const u16* PA = (const u16*)(p.ws + OFF_AR);
  u16* QH = (u16*)(p.ws + OFF_AR + 3 * U38);
  u16* KH = QH + 18874368L;
  const int f = lane & 15;
  const float inv_f = powf(10000.f, -(float)f / 16.f);
  for (int tok = gw; tok < T_ALL; tok += nw) {
    int b, P;
    float cs = 1.f, sn = 0.f;
    if (tok < T_LAT) {
      b = tok >> 11;
      int l = tok & 2047;
      P = 256 + l;
      float pos = (lane < 32) ? (float)(l >> 6) : (float)(l & 63);
      float ang = pos * inv_f;
      cs = cosf(ang);
      sn = sinf(ang);
    } else {
      b = (tok - T_LAT) >> 8;
      P = (tok - T_LAT) & 255;
    }
    float xv[16], ssq[16];
#pragma unroll
    for (int g = 0; g < 16; ++g) {
      xv[g] = bf2f(PA[(long)tok * 1024 + g * 64 + lane]);
      ssq[g] = xv[g] * xv[g];
    }
#pragma unroll
    for (int o = 32; o; o >>= 1)
#pragma unroll
      for (int g = 0; g < 16; ++g) ssq[g] += __shfl_xor(ssq[g], o);
#pragma unroll
    for (int g = 0; g < 16; ++g) {
      int which = g >> 3, h = (g >> 1) & 3, c = g & 1;
      float inv = rsqrtf(ssq[g] * (1.f / 64.f) + 1e-6f);
      float y = xv[g] * inv * p.qk_gain[(li * 2 + which) * 64 + lane];
      float pr = __shfl_xor(y, 16);
      float o = (lane & 16) ? (y * cs + pr * sn) : (y * cs - pr * sn);
      if (which == 0) o *= 0.18033688011112042f;
      u16* dst = (which ? KH : QH) + ((long)((b * 4 + h) * 2 + c) * 2304 + P) * 64 + lane;
      *dst = f2bf(o);
    }
  }
}

DI void ph_attn(const Prm& p, int li, long base, char* smem) {
  const int tid = mytid(), lane = tid & 63, wid = tid >> 6, fr = lane & 15, fq = lane >> 4;
  const u16* QH = (const u16*)(p.ws + OFF_AR + 3 * U38);
  const u16* KH = QH + 18874368L;
  const u16* VT = (const u16*)(p.ws + OFF_AR + 5 * U38);
  u16* YA = (u16*)(p.ws + OFF_Y);
  u16* s = (u16*)smem;
  constexpr int STG = 128 * 80 + 128 * 72;
  const float lambda_init = 0.8f - 0.6f * expf(-0.3f * (float)li);
  float lamv, mshift;
  {
    const float* lv = p.lam + li * 256;
    float a = wsum(lv[lane] * lv[64 + lane]), b2 = wsum(lv[128 + lane] * lv[192 + lane]);
    lamv = expf(a) - expf(b2) + lambda_init;
    float gq = wmax(fabsf(p.qk_gain[(li * 2) * 64 + lane])), gk = wmax(fabsf(p.qk_gain[(li * 2 + 1) * 64 + lane]));
    mshift = 8.f * gq * gk * 1.4426950408889634f;
  }
  for (int it = first_item(base); it < (li == 3 ? 1024 : 1152); it += gridDim.x) {
    int b, h, qp0, nkeys;
    if (it < 1024) { b = it >> 6; h = (it >> 4) & 3; qp0 = 256 + (it & 15) * 128; nkeys = 2304; }
    else { int i2 = it - 1024; b = i2 >> 3; h = (i2 >> 1) & 3; qp0 = (i2 & 1) * 128; nkeys = 256; }
    const long kb0 = (long)((b * 4 + h) * 2) * 2304;
    bf16x8 qf[2][2];
#pragma unroll
    for (int c = 0; c < 2; ++c)
#pragma unroll
      for (int ks = 0; ks < 2; ++ks)
        qf[c][ks] = *(const bf16x8*)(QH + (kb0 + (long)c * 2304 + qp0 + wid * 16 + fr) * 64 + ks * 32 + fq * 8);
    f32x4 O0[8], O1[8];
#pragma unroll
    for (int i = 0; i < 8; ++i) { O0[i] = f32x4{0.f, 0.f, 0.f, 0.f}; O1[i] = f32x4{0.f, 0.f, 0.f, 0.f}; }
    f32x4 L0 = {0.f, 0.f, 0.f, 0.f}, L1 = {0.f, 0.f, 0.f, 0.f};
    const bf16x8 ones = {0x3F80, 0x3F80, 0x3F80, 0x3F80, 0x3F80, 0x3F80, 0x3F80, 0x3F80};
    uint4 rk[2], rv[2];
    const int nt = nkeys >> 6;
#pragma unroll
    for (int u = 0; u < 2; ++u) {
      int id = tid + u * 512;
      int c = id >> 9, key = (id >> 3) & 63, ch = id & 7;
      rk[u] = *(const uint4*)(KH + (kb0 + (long)c * 2304 + key) * 64 + ch * 8);
      int dv = id >> 3;
      rv[u] = *(const uint4*)(VT + ((long)(b * 512 + h * 128 + dv)) * 2304 + ch * 8);
    }
#pragma unroll
    for (int u = 0; u < 2; ++u) {
      int id = tid + u * 512;
      *(uint4*)(s + (id >> 3) * 80 + (id & 7) * 8) = rk[u];
      *(uint4*)(s + 128 * 80 + (id >> 3) * 72 + (id & 7) * 8) = rv[u];
    }
    lds_barrier();
    for (int t = 0; t < nt; ++t) {
      const bool more = t + 1 < nt;
      if (more) {
        int kp0 = (t + 1) * 64;
#pragma unroll
        for (int u = 0; u < 2; ++u) {
          int id = tid + u * 512;
          int c = id >> 9, key = (id >> 3) & 63, ch = id & 7;
          rk[u] = *(const uint4*)(KH + (kb0 + (long)c * 2304 + kp0 + key) * 64 + ch * 8);
          int dv = id >> 3;
          rv[u] = *(const uint4*)(VT + ((long)(b * 512 + h * 128 + dv)) * 2304 + kp0 + ch * 8);
        }
      }
      const u16* ks_ = s + (t & 1) * STG;
      const u16* vs_ = ks_ + 128 * 80;
      bf16x8 pf[2][2];
#pragma unroll
      for (int c = 0; c < 2; ++c) {
#pragma unroll
        for (int kk2 = 0; kk2 < 2; ++kk2) {
          u32x4 pw;
#pragma unroll
          for (int hh = 0; hh < 2; ++hh) {
            const int k4 = kk2 * 2 + hh;
            f32x4 a = {-mshift, -mshift, -mshift, -mshift};
#pragma unroll
            for (int kk = 0; kk < 2; ++kk)
              a = MFMA(*(const bf16x8*)(ks_ + (c * 64 + k4 * 16 + fr) * 80 + kk * 32 + fq * 8), qf[c][kk], a);
            pw[hh * 2 + 0] = pk_bf16(__builtin_amdgcn_exp2f(a[0]), __builtin_amdgcn_exp2f(a[1]));
            pw[hh * 2 + 1] = pk_bf16(__builtin_amdgcn_exp2f(a[2]), __builtin_amdgcn_exp2f(a[3]));
          }
          pf[c][kk2] = *(bf16x8*)&pw;
        }
      }
#pragma unroll
      for (int kk = 0; kk < 2; ++kk) {
        L0 = MFMA(ones, pf[0][kk], L0);
        L1 = MFMA(ones, pf[1][kk], L1);
      }
#pragma unroll
      for (int dt = 0; dt < 8; ++dt) {
#pragma unroll
        for (int kk = 0; kk < 2; ++kk) {
          const u16* vp = vs_ + (dt * 16 + fr) * 72 + kk * 32 + fq * 4;
          uint2 lo = *(const uint2*)vp, hi = *(const uint2*)(vp + 16);
          uint4 av = {lo.x, lo.y, hi.x, hi.y};
          bf16x8 a = *(bf16x8*)&av;
          O0[dt] = MFMA(a, pf[0][kk], O0[dt]);
          O1[dt] = MFMA(a, pf[1][kk], O1[dt]);
        }
      }
      if (more) {
        u16* ns = s + ((t + 1) & 1) * STG;
#pragma unroll
        for (int u = 0; u < 2; ++u) {
          int id = tid + u * 512;
          *(uint4*)(ns + (id >> 3) * 80 + (id & 7) * 8) = rk[u];
          *(uint4*)(ns + 128 * 80 + (id >> 3) * 72 + (id & 7) * 8) = rv[u];
        }
      }
      lds_barrier();
    }
    float i0 = 1.f / L0[0], i1 = lamv / L1[0], ss = 0.f;
#pragma unroll
    for (int dt = 0; dt < 8; ++dt)
#pragma unroll
      for (int j = 0; j < 4; ++j) {
        float o = O0[dt][j] * i0 - O1[dt][j] * i1;
        O0[dt][j] = o;
        ss += o * o;
      }
    ss += __shfl_xor(ss, 16); ss += __shfl_xor(ss, 32);
    float inv = rsqrtf(ss * (1.f / 128.f) + 1e-6f) * (1.f - lambda_init);
    int tok = tokof(b, qp0 + wid * 16 + fr);
#pragma unroll
    for (int dt = 0; dt < 8; ++dt) {
      int dv = dt * 16 + fq * 4;
      const float* sw = p.subln + li * 128 + dv;
      uint2 o;
      o.x = pk_bf16(O0[dt][0] * inv * sw[0], O0[dt][1] * inv * sw[1]);
      o.y = pk_bf16(O0[dt][2] * inv * sw[2], O0[dt][3] * inv * sw[3]);
      *(uint2*)(YA + (long)tok * 512 + h * 128 + dv) = o;
    }
  }
}

template <int L>
DI void hyena_item(const Prm& p, int li, int ch, char* smem) {
  constexpr int CS = 2 * L + 8;
  constexpr int ZS = L + 8;
  constexpr int MT = L / 128;
  constexpr int MG = MT > 8 ? 8 : MT, NG = MT / MG;
  const int tid = mytid(), lane = tid & 63, wid = tid >> 6, fr = lane & 15, fq = lane >> 4;
  u16* cp = (u16*)smem;
  u16* zr = cp + 8 * CS;
  const u16* PH = (const u16*)(p.ws + OFF_AR) + (L == 2048 ? 0L : 32768L * 1536);
  const u16* G = (const u16*)(p.ws + (L == 2048 ? OFF_TAPL : OFF_TAPC));
  u16* YB = (u16*)(p.ws + OFF_Y + U38);
  const float* cw = p.hy_conv + (long)li * 3 * 1536;
  {
    float w0 = cw[1024 + ch], w1 = cw[1536 + 1024 + ch], w2 = cw[3072 + 1024 + ch];
    constexpr int NCH = (16 * L / 8) / 512;
    u32x4 cv[NCH];
    u16 pv[NCH], nv[NCH];
#pragma unroll
    for (int i = 0; i < NCH; ++i) {
      int id = tid + i * 512, b = id / (L / 8), s0 = (id % (L / 8)) * 8;
      const u16* row = PH + ((long)b * 1536 + 1024 + ch) * L + s0;
      cv[i] = *(const u32x4*)row;
      pv[i] = (s0 > 0) ? row[-1] : (u16)0;
      nv[i] = (s0 + 8 < L) ? row[8] : (u16)0;
    }
#pragma unroll
    for (int i = 0; i < NCH; ++i) {
      int id = tid + i * 512, b = id / (L / 8), s0 = (id % (L / 8)) * 8;
      float x[10];
      x[0] = bf2f(pv[i]);
      x[9] = bf2f(nv[i]);
#pragma unroll
      for (int w = 0; w < 4; ++w) {
        x[1 + 2 * w] = __uint_as_float(cv[i][w] << 16);
        x[2 + 2 * w] = __uint_as_float(cv[i][w] & 0xffff0000u);
      }
      float o[8];
#pragma unroll
      for (int e = 0; e < 8; ++e) o[e] = w0 * x[e] + w1 * x[e + 1] + w2 * x[e + 2];
      u32x4 r;
      r[0] = pk_bf16(o[7], o[6]); r[1] = pk_bf16(o[5], o[4]); r[2] = pk_bf16(o[3], o[2]); r[3] = pk_bf16(o[1], o[0]);
      *(u32x4*)(zr + b * ZS + L - 8 - s0) = r;
    }
  }
#pragma unroll
  for (int order = 0; order < 2; ++order) {
    {
      const u16* g = G + (long)(order * 512 + ch) * (2 * L);
      if (tid < 2 * L / 8) {
        const int i0 = tid * 8;
        u32x4 lo = *(const u32x4*)(g + i0);
        u32x4 hi = (i0 + 8 < 2 * L) ? *(const u32x4*)(g + i0 + 8) : u32x4{0u, 0u, 0u, 0u};
        unsigned D[8] = {lo[0], lo[1], lo[2], lo[3], hi[0], hi[1], hi[2], hi[3]};
#pragma unroll
        for (int c = 0; c < 8; ++c) {
          u32x4 o;
#pragma unroll
          for (int w = 0; w < 4; ++w) {
            if (c & 1) o[w] = (D[w + (c - 1) / 2] >> 16) | (D[w + (c + 1) / 2] << 16);
            else o[w] = D[w + c / 2];
          }
          *(u32x4*)(cp + c * CS + i0) = o;
        }
      }
    }
    __syncthreads();
    const float bias = p.hy_bias[(li * 2 + order) * 512 + ch];
    const int gcol = order * 512 + ch;
    const float w0 = cw[gcol], w1 = cw[1536 + gcol], w2 = cw[3072 + gcol];
    const int tq = wid * (L / 8) + fq * 4;
    const u16* xb = PH + ((long)fr * 1536 + gcol) * L + tq;
    const u16* zb = zr + fr * ZS + L - 1 - tq;
    unsigned zp[NG][MG][2];
#pragma unroll
    for (int grp = 0; grp < NG; ++grp) {
      f32x4 acc[MG];
#pragma unroll
      for (int m = 0; m < MG; ++m) acc[m] = f32x4{0.f, 0.f, 0.f, 0.f};
      const int tb = wid * (L / 8) + grp * MG * 16 + fr;
      if constexpr (MG == 8) {
        const int i00 = tb - fq * 8 - 7 + L, c0 = i00 & 7;
        const u16* ab = cp + c0 * CS + (i00 - c0);
        const u16* zbp = zr + fr * ZS + (L - 8 - fq * 8);
        bf16x8 W[16];
#pragma unroll 1
        for (int s0 = 0; s0 < L; s0 += 256) {
#pragma unroll
          for (int k = 0; k < 8; ++k) {
            const int sk = s0 + 32 * k;
            if (k == 0) {
#pragma unroll
              for (int m = 0; m < 8; ++m) W[m] = *(const bf16x8*)(ab + m * 16 - sk);
            }
            if (k < 7) {
              W[(16 - 2 * k - 2) & 15] = *(const bf16x8*)(ab - sk - 32);
              W[(16 - 2 * k - 1) & 15] = *(const bf16x8*)(ab - sk - 32 + 16);
            }
            bf16x8 bk = *(const bf16x8*)(zbp - sk);
#pragma unroll
            for (int m = 0; m < 8; ++m) acc[m] = MFMA(W[(m + 16 - 2 * k) & 15], bk, acc[m]);
          }
        }
      } else {
#pragma unroll 2
        for (int s0 = 0; s0 < L; s0 += 32) {
          bf16x8 bfr = *(const bf16x8*)(zr + fr * ZS + (L - 8 - s0 - fq * 8));
#pragma unroll
          for (int m = 0; m < MG; ++m) {
            int i0 = tb + m * 16 - s0 - fq * 8 - 7 + L;
            int c = i0 & 7;
            bf16x8 afr = *(const bf16x8*)(cp + c * CS + (i0 - c));
            acc[m] = MFMA(afr, bfr, acc[m]);
          }
        }
      }
#pragma unroll
      for (int m = 0; m < MG; ++m) {
        float r4[4];
#pragma unroll
        for (int j = 0; j < 4; ++j) {
          const int off = (grp * MG + m) * 16 + j;
          const int t = tq + off;
          float xa = bf2f(xb[off - 1]), xc = bf2f(xb[off]), xd = bf2f(xb[off + 1]);
          xa = (t > 0) ? xa : 0.f;
          xd = (t + 1 < L) ? xd : 0.f;
          float xg = w0 * xa + w1 * xc + w2 * xd;
          float zin = bf2f(zb[-off]);
          r4[j] = xg * (acc[m][j] + bias * zin);
        }
        zp[grp][m][0] = pk_bf16(r4[0], r4[1]);
        zp[grp][m][1] = pk_bf16(r4[2], r4[3]);
      }
    }
    __syncthreads();
#pragma unroll
    for (int grp = 0; grp < NG; ++grp)
#pragma unroll
      for (int m = 0; m < MG; ++m) {
        int t0 = wid * (L / 8) + (grp * MG + m) * 16 + fq * 4;
        uint2 w;
        w.x = (zp[grp][m][1] >> 16) | (zp[grp][m][1] << 16);
        w.y = (zp[grp][m][0] >> 16) | (zp[grp][m][0] << 16);
        *(uint2*)(zr + fr * ZS + L - 4 - t0) = w;
      }
  }
  __syncthreads();
  {
    u16* YBT = (u16*)(p.ws + OFF_AR + 5 * U38) + (L == 2048 ? 0L : 16L * 512 * 2048);
    constexpr int NCH = (16 * L / 8) / 512;
#pragma unroll
    for (int i = 0; i < NCH; ++i) {
      int id = tid + i * 512, b = id / (L / 8), t0 = (id % (L / 8)) * 8;
      u32x4 r = *(const u32x4*)(zr + b * ZS + L - 8 - t0);
      u32x4 o;
      o[0] = (r[3] >> 16) | (r[3] << 16);
      o[1] = (r[2] >> 16) | (r[2] << 16);
      o[2] = (r[1] >> 16) | (r[1] << 16);
      o[3] = (r[0] >> 16) | (r[0] << 16);
      *(u32x4*)(YBT + ((long)b * 512 + ch) * L + t0) = o;
    }
  }
  __syncthreads();
}

DI long ph_ytrans(const Prm& p, long base, bool lastl, char* smem) {
  u16* tl = (u16*)smem;
  const u16* YBT = (const u16*)(p.ws + OFF_AR + 5 * U38);
  u16* YB = (u16*)(p.ws + OFF_Y + U38);
  const int tid = mytid(), G = gridDim.x;
  const int total = lastl ? 4096 : 4608;
  auto srcp = [&](int it) -> const u16* {
    if (it < 4096) {
      int b = it >> 8, ct = (it >> 5) & 7, lt = it & 31;
      return YBT + ((long)b * 512 + ct * 64 + (tid >> 3)) * 2048 + lt * 64 + (tid & 7) * 8;
    } else {
      int i2 = it - 4096, b = i2 >> 5, ct = (i2 >> 2) & 7, lt = i2 & 3;
      return YBT + 16L * 512 * 2048 + ((long)b * 512 + ct * 64 + (tid >> 3)) * 256 + lt * 64 + (tid & 7) * 8;
    }
  };
  int it = first_item(base);
  u32x4 v = {0u, 0u, 0u, 0u};
  if (it < total) v = *(const u32x4*)srcp(it);
  for (; it < total; it += G) {
    *(u32x4*)(tl + (tid >> 3) * 72 + (tid & 7) * 8) = v;
    __syncthreads();
    if (it + G < total) v = *(const u32x4*)srcp(it + G);
    long tok0;
    int ct;
    if (it < 4096) { int b = it >> 8, lt = it & 31; ct = (it >> 5) & 7; tok0 = (long)b * 2048 + lt * 64; }
    else { int i2 = it - 4096, b = i2 >> 5, lt = i2 & 3; ct = (i2 >> 2) & 7; tok0 = (long)T_LAT + b * 256 + lt * 64; }
    const int lrow = tid >> 3, cc = tid & 7;
    u32x4 o;
#pragma unroll
    for (int w = 0; w < 4; ++w) {
      unsigned lo = tl[(cc * 8 + 2 * w) * 72 + lrow], hi = tl[(cc * 8 + 2 * w + 1) * 72 + lrow];
      o[w] = lo | (hi << 16);
    }
    *(u32x4*)(YB + (tok0 + lrow) * 512 + ct * 64 + cc * 8) = o;
    __syncthreads();
  }
  return base + total;
}

DI void ph_merge(const Prm& p, char* smem, bool lastl) {
  const int tid = mytid(), lane = tid & 63, wid = tid >> 6;
  const int wm = wid >> 1, wn = wid & 1, fr = lane & 15, fq = lane >> 4;
  const u16* H = (const u16*)(p.ws + OFF_HBF);
  const u16* Y = (const u16*)(p.ws + OFF_Y);
  const u16* WG = (const u16*)(p.ws + OFF_WB) + WO_G;
  const u16* WBr = (const u16*)(p.ws + OFF_WB) + WO_B;
  u16* MG = (u16*)(p.ws + OFF_AR);
  const int NT = (lastl ? 256 : 288) * 8, G = gridDim.x;
  Stg r0, r1;
  bool pre = false;
  for (int t = mybid(); t < NT; t += G) {
    const int mt = t >> 3, nt = t & 7;
    const bool hn = t + G < NT;
    const int mt2 = (t + G) >> 3, nt2 = (t + G) & 7;
    f32x4 acc[2][4], g[2][4], y[2][4];
#pragma unroll
    for (int a = 0; a < 2; ++a)
#pragma unroll
      for (int b = 0; b < 4; ++b) acc[a][b] = f32x4{0.f, 0.f, 0.f, 0.f};
    const u16* gA = H + (long)mt * 128 * 1024;
    for (int n = 0; n < 4; ++n) {
      const u16* gB = WG + ((long)n * 1024 + nt * 128) * 1024;
      const u16* yA = Y + (long)n * (T_ALL * 512L) + (long)mt * 128 * 512;
      const u16* yB = WBr + ((long)n * 1024 + nt * 128) * 512;
      gemm_tile<2>(g, gA, 1024, gB, 1024, 1024, smem, r0, r1, pre, yA, 512, yB, 512);
      const u16* nxA = (n < 3) ? gA : (hn ? H + (long)mt2 * 128 * 1024 : nullptr);
      const u16* nxB = (n < 3) ? WG + ((long)(n + 1) * 1024 + nt * 128) * 1024 : WG + ((long)nt2 * 128) * 1024;
      gemm_tile<2>(y, yA, 512, yB, 512, 512, smem, r0, r1, true, nxA, 1024, nxB, 1024);
      pre = true;
#pragma unroll
      for (int a = 0; a < 2; ++a)
#pragma unroll
        for (int b = 0; b < 4; ++b)
#pragma unroll
          for (int j = 0; j < 4; ++j) acc[a][b][j] += y[a][b][j] * __builtin_amdgcn_rcpf(1.f + __expf(-g[a][b][j]));
    }
    pre = hn;
#pragma unroll
    for (int a = 0; a < 2; ++a)
#pragma unroll
      for (int b = 0; b < 4; ++b) {
        int r = wm * 32 + a * 16 + fr, c = wn * 64 + b * 16 + fq * 4;
        uint2 o;
        o.x = pk_bf16(acc[a][b][0], acc[a][b][1]);
        o.y = pk_bf16(acc[a][b][2], acc[a][b][3]);
        *(uint2*)(MG + ((long)mt * 128 + r) * 1024 + nt * 128 + c) = o;
      }
  }
}

DI void run_phase(const Prm& p, int ph, char* smem) {
  if (ph == 0) { ph_init(p, smem); return; }
  const int li = (ph - 1) / 14, k = (ph - 1) % 14;
  const u16* WB = (const u16*)(p.ws + OFF_WB);
  const u16* HB = (const u16*)(p.ws + OFF_HBF);
  const float* MOD = (const float*)(p.ws + OFF_MOD);
  u16* AR = (u16*)(p.ws + OFF_AR);
  u16* Yb = (u16*)(p.ws + OFF_Y);
  const int G = gridDim.x;
  TD d;
  d.split = 0; d.scale = 1.f; d.mode = 0; d.tok0 = 0; d.col0 = 0; d.g = MOD;
  switch (k) {
    case 0: {
      u16* W = (u16*)(p.ws + OFF_WB);
      long base = 0;
      base = tr_job(base, p.w_in + (long)li * 1024 * NIN, 1024, NIN, W + WO_IN, 1, smem);
      base = tr_job(base, p.w_gate + (long)li * 4 * 1048576, 1024, 1024, W + WO_G, 4, smem);
      base = tr_job(base, p.w_branch + (long)li * 4 * 524288, 512, 1024, W + WO_B, 4, smem);
      base = tr_job(base, p.w_o + (long)li * 1048576, 1024, 1024, W + WO_O, 1, smem);
      base = tr_job(base, p.w_mlp1 + (long)li * 4194304, 1024, 4096, W + WO_1, 1, smem);
      base = tr_job(base, p.w_mlp2 + (long)li * 4194304, 4096, 1024, W + WO_2, 1, smem);
      ph_taps1(p, li, base, smem);
      ph_norm(p, li, 0);
    } break;
    case 1: {
      auto dec = [&](int t, TD& o) {
        o.lda = 1024; o.ldb = 1024; o.K = 1024; o.mode = 0;
        if (t < 1728) {
          int mt = t / 12, nt = t % 12;
          o.A = HB + (long)mt * 256 * 1024; o.B = WB + WO_IN + (long)(3584 + nt * 128) * 1024;
          o.C = AR + (long)mt * 256 * 1536 + nt * 128; o.ldc = 1536;
        } else if (t < 2304) {
          int t2 = t - 1728, mt = t2 >> 2, nt = t2 & 3;
          o.A = HB + (long)mt * 256 * 1024; o.B = WB + WO_IN + (long)(5120 + nt * 128) * 1024;
          o.C = Yb + 3 * (U38 / 2) + (long)mt * 256 * 512 + nt * 128; o.ldc = 512;
        } else {
          int mt = t - 2304;
          o.A = HB + (long)mt * 256 * 1024; o.B = WB + WO_IN + (long)5632 * 1024;
          o.C = (u16*)((float*)(p.ws + OFF_PDAB) + (long)mt * 256 * 16); o.ldc = 16; o.mode = 3;
        }
      };
      {
        Stg r0, r1;
        bool pre = false;
        TD dn = d;
        int t = mybid();
        if (t < 2448) dec(t, d);
        for (; t < 2448; t += G) {
          const bool hn = t + G < 2448;
          if (hn) dec(t + G, dn);
          run_tile2<4>(p, d, smem, r0, r1, pre, hn ? dn.A : nullptr, dn.lda, dn.B, dn.ldb);
          pre = hn;
          d = dn;
        }
      }
      ph_taps2(p, 2448, smem);
    } break;
    case 2: ph_dncl(p, li, smem); break;
    case 3: ph_dnscan(p, smem); break;
    case 4: {
      {
        Stg r0, r1;
        bool pre = false;
        for (int t = mybid(); t < 1152; t += G) {
          int mt = t >> 3, nt = t & 7;
          const bool hn = t + G < 1152;
          int mt2 = (t + G) >> 3, nt2 = (t + G) & 7;
          d.lda = 1024; d.ldb = 1024; d.K = 1024;
          d.A = HB + (long)mt * 256 * 1024; d.B = WB + WO_IN + (long)(nt * 128) * 1024;
          d.C = AR + 3 * (U38 / 2); d.ldc = 0; d.mode = 4; d.tok0 = mt * 256; d.col0 = nt;
          d.g = p.qk_gain + li * 128;
          run_tile2<4>(p, d, smem, r0, r1, pre, hn ? HB + (long)mt2 * 256 * 1024 : nullptr, 1024,
                    WB + WO_IN + (long)(nt2 * 128) * 1024, 1024);
          pre = hn;
        }
      }
      ph_dnfin(p, li);
    } break;
    case 5: {
      u16* VT = AR + 5 * (U38 / 2);
      u16* PF = AR + 6 * (U38 / 2);
      auto dec = [&](int t, TD& o) {
        o.lda = 1024; o.ldb = 1024; o.K = 1024;
        if (t < 512) {
          int b = t >> 5, r = t & 31, mt = r >> 4, nt = r & 15;
          o.A = WB + WO_IN + (long)(1024 + mt * 256) * 1024; o.B = HB + ((long)b * 2048 + nt * 128) * 1024;
          o.C = VT + ((long)b * 512 + mt * 256) * 2304 + 256 + nt * 128; o.ldc = 2304;
        } else if (t < 576) {
          int t2 = t - 512, b = t2 >> 2, r = t2 & 3, mt = r >> 1, nt = r & 1;
          o.A = WB + WO_IN + (long)(1024 + mt * 256) * 1024; o.B = HB + ((long)T_LAT + b * 256 + nt * 128) * 1024;
          o.C = VT + ((long)b * 512 + mt * 256) * 2304 + nt * 128; o.ldc = 2304;
        } else {
          int t2 = t - 576, mt = t2 >> 2, nt = t2 & 3;
          o.A = HB + (long)mt * 256 * 1024; o.B = WB + WO_IN + (long)(3072 + nt * 128) * 1024;
          o.C = PF + (long)mt * 256 * 512 + nt * 128; o.ldc = 512;
        }
      };
      {
        Stg r0, r1;
        bool pre = false;
        TD dn = d;
        int t = mybid();
        if (t < 1152) dec(t, d);
        for (; t < 1152; t += G) {
          const bool hn = t + G < 1152;
          if (hn) dec(t + G, dn);
          run_tile2<4>(p, d, smem, r0, r1, pre, hn ? dn.A : nullptr, dn.lda, dn.B, dn.ldb);
          pre = hn;
          d = dn;
        }
      }
    } break;
    case 6: {
      ph_attn(p, li, 0, smem);
      auto dec = [&](int t, TD& o) {
        o.lda = 1024; o.ldb = 1024; o.K = 1024;
        if (t < 1536) {
          int b = t / 96, r = t % 96, mt = r >> 4, nt = r & 15;
          o.A = WB + WO_IN + (long)(1536 + mt * 256) * 1024; o.B = HB + ((long)b * 2048 + nt * 128) * 1024;
          o.C = AR + ((long)b * 1536 + mt * 256) * 2048 + nt * 128; o.ldc = 2048;
        } else {
          int t2 = t - 1536, b = t2 / 12, r = t2 % 12, mt = r >> 1, nt = r & 1;
          o.A = WB + WO_IN + (long)(1536 + mt * 256) * 1024; o.B = HB + ((long)T_LAT + b * 256 + nt * 128) * 1024;
          o.C = AR + 32768L * 1536 + ((long)b * 1536 + mt * 256) * 256 + nt * 128; o.ldc = 256;
        }
      };
      {
        Stg r0, r1;
        bool pre = false;
        TD dn = d;
        int t = first_item(1152);
        if (t < 1728) dec(t, d);
        for (; t < 1728; t += G) {
          const bool hn = t + G < 1728;
          if (hn) dec(t + G, dn);
          run_tile2<4>(p, d, smem, r0, r1, pre, hn ? dn.A : nullptr, dn.lda, dn.B, dn.ldb);
          pre = hn;
          d = dn;
        }
      }
    } break;
    case 7: {
#if !defined(TESTSEL) || TESTSEL == 1
      for (int it = mybid(); it < 512; it += G) hyena_item<2048>(p, li, it, smem);
#endif
#if !defined(TESTSEL) || TESTSEL == 2
      if (li < 3)
        for (int it = mybid(); it < 512; it += G) hyena_item<256>(p, li, it, smem);
#endif
#if !defined(TESTSEL) || TESTSEL == 3
      const u16* PF = AR + 6 * (U38 / 2);
      u16* WF = AR + 3 * (U38 / 2);
      const u16* DCm = (const u16*)(p.ws + OFF_DC);
      auto dec = [&](int t, TD& o) {
        o.A = DCm; o.lda = 128; o.ldb = 512; o.K = 128;
        if (t < 1024) {
          int bg = t >> 4, nt = t & 15, b = bg >> 2, g = bg & 3;
          o.B = PF + ((long)b * 2048 + nt * 128) * 512 + g * 128;
          o.C = WF + ((long)b * 512 + g * 128) * 4096 + nt * 128; o.ldc = 4096; o.split = 2048;
        } else {
          int t2 = t - 1024, bg = t2 >> 1, nt = t2 & 1, b = bg >> 2, g = bg & 3;
          o.B = PF + ((long)T_LAT + b * 256 + nt * 128) * 512 + g * 128;
          o.C = WF + 16L * 512 * 4096 + ((long)b * 512 + g * 128) * 512 + nt * 128; o.ldc = 512; o.split = 256;
        }
      };
      {
        const int NT7 = (li == 3 ? 1024 : 1152);
        Stg r0, r1;
        bool pre = false;
        TD dn = d;
        int t = mybid();
        if (t < NT7) dec(t, d);
        for (; t < NT7; t += G) {
          const bool hn = t + G < NT7;
          if (hn) dec(t + G, dn);
          run_tile2<4>(p, d, smem, r0, r1, pre, hn ? dn.A : nullptr, dn.lda, dn.B, dn.ldb);
          pre = hn;
          d = dn;
        }
      }
#endif
    } break;
    case 8: {
      const u16* WF = AR + 3 * (U38 / 2);
      u16* YF = Yb + 2 * (U38 / 2);
      d.scale = 1.f / 512.f;
      for (int t = mybid(); t < (li == 3 ? 512 : 576); t += G) {
        if (t < 512) {
          int b = t >> 5, r = t & 31, mt = r >> 2, nt = r & 3;
          d.A = (const u16*)(p.ws + OFF_DL) + (long)mt * 256 * 4096; d.lda = 4096;
          d.B = WF + ((long)b * 512 + nt * 128) * 4096; d.ldb = 4096; d.K = 4096;
          d.C = YF + ((long)b * 2048 + mt * 256) * 512 + nt * 128; d.ldc = 512;
        } else {
          int t2 = t - 512, b = t2 >> 2, nt = t2 & 3;
          d.A = (const u16*)(p.ws + OFF_DLC); d.lda = 512;
          d.B = WF + 16L * 512 * 4096 + ((long)b * 512 + nt * 128) * 512; d.ldb = 512; d.K = 512;
          d.C = YF + ((long)T_LAT + b * 256) * 512 + nt * 128; d.ldc = 512;
        }
        run_tile(p, d, smem);
      }
      ph_ytrans(p, 576, li == 3, smem);
    } break;
    case 9: ph_merge(p, smem, li == 3); break;
    case 10: {
      d.mode = 2;
      const int NF = 1024, NTOT = (li == 3) ? 1024 : 1024 + 256;
      auto dec = [&](int t, TD& o) {
        int full = t < NF ? t : NF + ((t - NF) >> 1), half = t < NF ? 0 : ((t - NF) & 1);
        int mt = full >> 3, nt = full & 7;
        o.A = AR + ((long)mt * 256 + half * 128) * 1024; o.lda = 1024;
        o.B = WB + WO_O + (long)nt * 128 * 1024; o.ldb = 1024; o.K = 1024;
        o.tok0 = mt * 256 + half * 128; o.col0 = nt * 128;
        int bb = o.tok0 < T_LAT ? (o.tok0 >> 11) : 16;
        o.g = MOD + ((long)li * 17 + bb) * 6144 + 2 * 1024;
      };
      Stg r0, r1;
      bool pre = false;
      TD dn = d;
      int t = mybid();
      if (t < NTOT) dec(t, d);
      for (; t < NTOT; t += G) {
        const bool hn = t + G < NTOT;
        if (hn) dec(t + G, dn);
        if (t < NF) run_tile2<4>(p, d, smem, r0, r1, pre, hn ? dn.A : nullptr, dn.lda, dn.B, dn.ldb);
        else run_tile2<2>(p, d, smem, r0, r1, pre, hn ? dn.A : nullptr, dn.lda, dn.B, dn.ldb);
        pre = hn;
        d = dn;
      }
    } break;
    case 11: ph_norm(p, li, 1); break;
    case 12: {
      d.mode = 1;
      const int NT12 = (li == 3 ? 4096 : 4608);
      Stg r0, r1;
      bool pre = false;
      for (int t = mybid(); t < NT12; t += G) {
        int mt = t >> 5, nt = t & 31;
        d.A = HB + (long)mt * 256 * 1024; d.lda = 1024; d.B = WB + WO_1 + (long)nt * 128 * 1024; d.ldb = 1024; d.K = 1024;
        d.C = Yb + (long)mt * 256 * 4096 + nt * 128; d.ldc = 4096;
        const bool hn = t + G < NT12;
        int mt2 = (t + G) >> 5, nt2 = (t + G) & 31;
        run_tile2<4>(p, d, smem, r0, r1, pre, hn ? HB + (long)mt2 * 256 * 1024 : nullptr, 1024,
                  WB + WO_1 + (long)nt2 * 128 * 1024, 1024);
        pre = hn;
      }
    } break;
    case 13: {
      d.mode = 2;
      const int NF = 1024, NTOT = (li == 3) ? 1024 : 1024 + 256;
      auto dec = [&](int t, TD& o) {
        int full = t < NF ? t : NF + ((t - NF) >> 1), half = t < NF ? 0 : ((t - NF) & 1);
        int mt = full >> 3, nt = full & 7;
        o.A = Yb + ((long)mt * 256 + half * 128) * 4096; o.lda = 4096;
        o.B = WB + WO_2 + (long)nt * 128 * 4096; o.ldb = 4096; o.K = 4096;
        o.tok0 = mt * 256 + half * 128; o.col0 = nt * 128;
        int bb = o.tok0 < T_LAT ? (o.tok0 >> 11) : 16;
        o.g = MOD + ((long)li * 17 + bb) * 6144 + 5 * 1024;
      };
      Stg r0, r1;
      bool pre = false;
      TD dn = d;
      int t = mybid();
      if (t < NTOT) dec(t, d);
      for (; t < NTOT; t += G) {
        const bool hn = t + G < NTOT;
        if (hn) dec(t + G, dn);
        if (t < NF) run_tile2<4>(p, d, smem, r0, r1, pre, hn ? dn.A : nullptr, dn.lda, dn.B, dn.ldb);
        else run_tile2<2>(p, d, smem, r0, r1, pre, hn ? dn.A : nullptr, dn.lda, dn.B, dn.ldb);
        pre = hn;
        d = dn;
      }
    } break;
  }
}


#define XB_TMO      128
#define XB_XCNT(j)  (256  + 64 * (j))
#define XB_XSUB(j)  (1280 + 64 * (j))
#define XB_XGEN(j)  (2304 + 64 * (j))
#define XB_TOP      3328
#define XB_TOPGEN   3392
#define XCD_BAR_WORDS 3456
#define XB_SPIN_CAP (1u << 20)
#define LAS __attribute__((address_space(3)))
DI unsigned xb_ld(unsigned* p) { return __hip_atomic_load(p, __ATOMIC_RELAXED, __HIP_MEMORY_SCOPE_AGENT); }
DI unsigned xb_add(unsigned* p, unsigned v) { return __hip_atomic_fetch_add(p, v, __ATOMIC_RELAXED, __HIP_MEMORY_SCOPE_AGENT); }
DI unsigned xb_xcc_id() { return (unsigned)__builtin_amdgcn_s_getreg((3 << 11) | 20) & 0xFu; }
#define XB_SPIN(cond, bar) do { unsigned _sp = 0; while (cond) { __builtin_amdgcn_s_sleep(1); \
    if ((++_sp & 255u) == 0u) { if (xb_ld(&(bar)[XB_TMO])) break; if (_sp > XB_SPIN_CAP) { atomicAdd(&(bar)[XB_TMO], 1u); break; } } } } while (0)
struct XcdBarrier { unsigned* bar; unsigned x; volatile LAS unsigned* st; };
DI XcdBarrier xcd_barrier_post(unsigned* bar, volatile LAS unsigned* st) {
  XcdBarrier b; b.bar = bar; b.x = xb_xcc_id(); b.st = st;
  if (threadIdx.x == 0) (void)xb_add(&bar[XB_XCNT(b.x)], 1u);
  return b;
}
DI void xcd_barrier_complete(unsigned* bar, unsigned x, unsigned& nloc, unsigned& nx) {
  const unsigned G = gridDim.x * gridDim.y * gridDim.z;
  unsigned sum, cnt, mine, sp = 0u;
  for (;;) {
    sum = 0u; cnt = 0u; mine = 0u;
#pragma unroll
    for (unsigned j = 0; j < 16; ++j) { const unsigned c = xb_ld(&bar[XB_XCNT(j)]); sum += c; cnt += (c > 0u) ? 1u : 0u; mine = (j == x) ? c : mine; }
    if (sum == G) break;
    __builtin_amdgcn_s_sleep(1);
    if ((++sp & 255u) == 0u) { if (xb_ld(&bar[XB_TMO])) break; if (sp > XB_SPIN_CAP) { atomicAdd(&bar[XB_TMO], 1u); break; } }
  }
  nloc = mine > 0u ? mine : 1u; nx = cnt > 0u ? cnt : 1u;
}
DI void xcd_barrier(const XcdBarrier& b) {
  asm volatile("s_waitcnt vmcnt(0)" ::: "memory");
  __syncthreads();
  if (threadIdx.x == 0) {
    unsigned* bar = b.bar;
    __builtin_amdgcn_s_waitcnt(0);
    unsigned nloc = b.st[0], nx = b.st[1];
    if (nloc == 0u) { xcd_barrier_complete(bar, b.x, nloc, nx); b.st[0] = nloc; b.st[1] = nx; }
    const unsigned old = xb_add(&bar[XB_XSUB(b.x)], 1u);
    const unsigned gen = old / nloc;
    if (old + 1u == (gen + 1u) * nloc) {
      __builtin_amdgcn_fence(__ATOMIC_RELEASE, "agent");
      asm volatile("s_waitcnt vmcnt(0)" ::: "memory");
      const unsigned og = xb_add(&bar[XB_TOP], 1u);
      const unsigned tg = og / nx;
      if (og + 1u == (tg + 1u) * nx) xb_add(&bar[XB_TOPGEN], 1u);
      else XB_SPIN(xb_ld(&bar[XB_TOPGEN]) == tg, bar);
      __builtin_amdgcn_fence(__ATOMIC_ACQUIRE, "agent");
      xb_add(&bar[XB_XGEN(b.x)], 1u);
      asm volatile("s_waitcnt vmcnt(0)" ::: "memory");
    } else {
      XB_SPIN(xb_ld(&bar[XB_XGEN(b.x)]) == gen, bar);
      __builtin_amdgcn_fence(__ATOMIC_ACQUIRE, "agent");
      asm volatile("s_waitcnt vmcnt(0)" ::: "memory");
    }
  }
  __syncthreads();
}

extern __shared__ __attribute__((aligned(16))) char dyn_smem[];

__global__ void __launch_bounds__(512) mega(Prm p, int lo, int hi) {
  __shared__ uint4 xb_words;
  if (threadIdx.x == 0) xb_words = make_uint4(0u, 0u, 0u, 0u);
  __syncthreads();
  XcdBarrier xb = xcd_barrier_post((unsigned*)(p.ws + OFF_BAR), (volatile LAS unsigned*)&xb_words);
#ifdef ONLYK
  run_phase(p, ONLYK, dyn_smem);
#else
  for (int ph = lo; ph <= hi; ++ph) {
    long z = 0;
    asm volatile("" : "+s"(z));
    Prm q;
#define LP(f) q.f = p.f + z
    LP(x); LP(c); LP(ctx); LP(c_ctx); LP(w_ada); LP(b_ada); LP(norm1); LP(norm2); LP(w_in); LP(qk_gain); LP(lam);
    LP(subln); LP(hy_conv); LP(hy_w1); LP(hy_b1); LP(hy_freq); LP(hy_w2); LP(hy_b2); LP(hy_w3); LP(hy_bias);
    LP(dn_conv); LP(dn_a_log); LP(dn_dt_bias); LP(dn_norm); LP(w_gate); LP(w_branch); LP(w_o); LP(w_mlp1); LP(w_mlp2);
    LP(out); LP(ws);
#undef LP
    run_phase(q, ph, dyn_smem);
#ifdef PROBEK
    if (ph > 0 && (ph - 1) % 14 == PROBEK) { cg::this_grid().sync(); run_phase(q, ph, dyn_smem); }
#endif
    if (ph < hi) {
      if (ph == lo) cg::this_grid().sync();
      else xcd_barrier(xb);
    }
  }
#endif
}

extern "C" void kernel_launch(void* const* d_in, const int* in_sizes, int n_in, void* d_out, int out_size, void* d_ws,
                              size_t ws_size, hipStream_t stream) {
  static int grid_blocks = 0;
  if (!grid_blocks) {
    hipFuncSetAttribute((const void*)mega, hipFuncAttributeMaxDynamicSharedMemorySize, LDS_BYTES);
    int dev = 0, cus = 0, per_cu = 0;
    hipGetDevice(&dev);
    hipDeviceGetAttribute(&cus, hipDeviceAttributeMultiprocessorCount, dev);
    hipOccupancyMaxActiveBlocksPerMultiprocessor(&per_cu, mega, 512, LDS_BYTES);
    if (per_cu < 1) per_cu = 1;
    grid_blocks = cus * per_cu;
    if (ws_size < (size_t)WS_TOTAL) fprintf(stderr, "workspace too small: %zu < %ld\n", ws_size, (long)WS_TOTAL);
  }
  Prm p;
  const float** pp = (const float**)&p;
  for (int i = 0; i < 29; ++i) pp[i] = (const float*)d_in[i];
  p.out = (float*)d_out;
  p.ws = (char*)d_ws;
#if MULTI
  for (int ph = 0; ph < NPHASE; ++ph) hipLaunchKernelGGL(mega, dim3(grid_blocks), dim3(512), LDS_BYTES, stream, p, ph, ph);
#else
  int lo = 0, hi = NPHASE - 1;
  hipMemsetAsync((char*)d_ws + OFF_BAR, 0, XCD_BAR_WORDS * 4, stream);
  void* args[] = {&p, &lo, &hi};
  hipError_t e = hipLaunchCooperativeKernel((void*)mega, dim3(grid_blocks), dim3(512), args, LDS_BYTES, stream);
  if (e != hipSuccess) fprintf(stderr, "cooperative launch failed: %s (grid %d)\n", hipGetErrorString(e), grid_blocks);
#endif
}
```

```cpp
#include <hip/hip_runtime.h>
#include <hip/hip_cooperative_groups.h>
#include <stdint.h>
#include <stdio.h>
namespace cg = cooperative_groups;

typedef unsigned short u16;
typedef __attribute__((ext_vector_type(8))) short bf16x8;
typedef __attribute__((ext_vector_type(4))) float f32x4;
#define MFMA(a, b, c) __builtin_amdgcn_mfma_f32_16x16x32_bf16(a, b, c, 0, 0, 0)
#define DI __device__ __forceinline__

#ifndef MULTI
#define MULTI 0
#endif

constexpr int T_LAT = 32768, T_ALL = 36864;
constexpr int NIN = 5648;
constexpr long U38 = 37748736L;
constexpr long OFF_XC = 0;
constexpr long OFF_WB = OFF_XC + 16777216L;
constexpr long OFF_HBF = OFF_WB + 43024384L;
constexpr long OFF_MOD = OFF_HBF + 75497472L;
constexpr long OFF_TAPL = OFF_MOD + 1671168L;
constexpr long OFF_TAPC = OFF_TAPL + 8388608L;
constexpr long OFF_DL = OFF_TAPC + 1048576L;
constexpr long OFF_DLC = OFF_DL + 16777216L;
constexpr long OFF_DC = OFF_DLC + 262144L;
constexpr long OFF_PDAB = OFF_DC + 65536L;
constexpr long OFF_GC = OFF_PDAB + 2359296L;
constexpr long OFF_BETA = OFF_GC + 2359296L;
constexpr long OFF_Y = OFF_BETA + 2359296L;
constexpr long OFF_AR = OFF_Y + 4 * U38;
constexpr long OFF_ROPE = OFF_AR + 7 * U38;
constexpr long OFF_BAR = OFF_ROPE + 2 * 262144L;
constexpr long WS_TOTAL = OFF_BAR + 16384L;
constexpr long WO_IN = 0, WO_G = 5783552L, WO_B = 9977856L, WO_O = 12075008L, WO_1 = 13123584L, WO_2 = 17317888L;
constexpr int LDS_BYTES = 139264;
constexpr int NPHASE = 1 + 4 * 14;

struct Prm {
  const float *x, *c, *ctx, *c_ctx, *w_ada, *b_ada, *norm1, *norm2, *w_in, *qk_gain, *lam, *subln, *hy_conv, *hy_w1,
      *hy_b1, *hy_freq, *hy_w2, *hy_b2, *hy_w3, *hy_bias, *dn_conv, *dn_a_log, *dn_dt_bias, *dn_norm, *w_gate,
      *w_branch, *w_o, *w_mlp1, *w_mlp2;
  float* out;
  char* ws;
};

DI int mytid() {
  int t = threadIdx.x;
  asm volatile("" : "+v"(t));
  return t;
}
DI int mybid() {
  int t = blockIdx.x;
  const int G = gridDim.x;
  if ((G & 7) == 0) t = (t & 7) * (G >> 3) + (t >> 3);
  asm volatile("" : "+s"(t));
  return t;
}
DI void lds_barrier() {
  asm volatile("s_waitcnt lgkmcnt(0)" ::: "memory");
  __builtin_amdgcn_s_barrier();
  asm volatile("" ::: "memory");
}
typedef __bf16 bf16x2_t __attribute__((ext_vector_type(2)));
typedef float f32x2_t __attribute__((ext_vector_type(2)));
DI unsigned pk_bf16(float a, float b) {
  f32x2_t v = {a, b};
  bf16x2_t h = __builtin_convertvector(v, bf16x2_t);
  return *(unsigned*)&h;
}
DI u16 f2bf(float f) {
  __bf16 h = (__bf16)f;
  return *(u16*)&h;
}
DI float bf2f(u16 h) { return __uint_as_float(((unsigned)h) << 16); }
DI float wsum(float v) {
  for (int o = 32; o; o >>= 1) v += __shfl_xor(v, o);
  return v;
}
DI float wmax(float v) {
  for (int o = 32; o; o >>= 1) v = fmaxf(v, __shfl_xor(v, o));
  return v;
}
DI float siluf(float v) { return v / (1.f + __expf(-v)); }
DI float sigmf(float v) { return 1.f / (1.f + __expf(-v)); }
DI float* xrow(const Prm& p, int tok) {
  return tok < T_LAT ? p.out + (long)tok * 1024 : (float*)(p.ws + OFF_XC) + (long)(tok - T_LAT) * 1024;
}
DI int first_item(long base) {
  int G = gridDim.x;
  return (int)(((long)mybid() + G - (base % G)) % G);
}
DI int tokof(int b, int P) { return P < 256 ? T_LAT + b * 256 + P : b * 2048 + (P - 256); }

typedef __attribute__((ext_vector_type(4))) unsigned u32x4;
struct Stg { u32x4 a0, a1, a2, a3, b0, b1; };
template <int NA>
DI void g_load(Stg& r, const u16* Ap, long lda, const u16* Bp, long ldb, int k0) {
  r.a0 = *(const u32x4*)(Ap + k0);
  r.a1 = *(const u32x4*)(Ap + 64 * lda + k0);
  if constexpr (NA == 4) {
    r.a2 = *(const u32x4*)(Ap + 128 * lda + k0);
    r.a3 = *(const u32x4*)(Ap + 192 * lda + k0);
  }
  r.b0 = *(const u32x4*)(Bp + k0);
  r.b1 = *(const u32x4*)(Bp + 64 * ldb + k0);
}
template <int NA, int TM>
DI void s_store(const Stg& r, u16* ns_) {
  *(u32x4*)(ns_) = r.a0;
  *(u32x4*)(ns_ + 64 * 80) = r.a1;
  if constexpr (NA == 4) {
    *(u32x4*)(ns_ + 128 * 80) = r.a2;
    *(u32x4*)(ns_ + 192 * 80) = r.a3;
  }
  *(u32x4*)(ns_ + TM * 80) = r.b0;
  *(u32x4*)(ns_ + TM * 80 + 64 * 80) = r.b1;
}
template <int MI>
DI void t_compute(f32x4 (&acc)[MI][4], const u16* as, const u16* bs, int wm, int wn, int fr, int fq) {
#pragma unroll
  for (int ks = 0; ks < 2; ++ks) {
    bf16x8 a[MI], b[4];
#pragma unroll
    for (int mi = 0; mi < MI; ++mi) a[mi] = *(const bf16x8*)(as + (wm * MI * 16 + mi * 16 + fr) * 80 + ks * 32 + fq * 8);
#pragma unroll
    for (int ni = 0; ni < 4; ++ni) b[ni] = *(const bf16x8*)(bs + (wn * 64 + ni * 16 + fr) * 80 + ks * 32 + fq * 8);
#pragma unroll
    for (int mi = 0; mi < MI; ++mi)
#pragma unroll
      for (int ni = 0; ni < 4; ++ni) acc[mi][ni] = MFMA(b[ni], a[mi], acc[mi][ni]);
  }
}
template <int MI>
DI void gemm_tile(f32x4 (&acc)[MI][4], const u16* __restrict__ A, long lda, const u16* __restrict__ B, long ldb, int K,
                  char* smem, Stg& r0, Stg& r1, bool pre, const u16* nA, long nlda, const u16* nB, long nldb) {
  constexpr int TM = MI * 64;
  constexpr int STAGE = (TM + 128) * 80;
  constexpr int NA = TM * 8 / 512;
  u16* s = (u16*)smem;
  const int tid = mytid(), lane = tid & 63, wid = tid >> 6;
  const int wm = wid >> 1, wn = wid & 1, fr = lane & 15, fq = lane >> 4;
  const long to_a = (long)(tid >> 3), to_c = (tid & 7) * 8;
  const u16* Ap = A + to_a * lda + to_c;
  const u16* Bp = B + to_a * ldb + to_c;
  const u16* nAp = nA + to_a * nlda + to_c;
  const u16* nBp = nB + to_a * nldb + to_c;
  const int so = (tid >> 3) * 80 + (tid & 7) * 8;
#define GLOAD(r, k0) g_load<NA>(r, Ap, lda, Bp, ldb, (k0))
#define NLOAD(r, k0) g_load<NA>(r, nAp, nlda, nBp, nldb, (k0))
#define SSTORE(r, st) s_store<NA, TM>(r, s + (st) * STAGE + so)
#define COMPUTE(st) t_compute<MI>(acc, s + (st) * STAGE, s + (st) * STAGE + TM * 80, wm, wn, fr, fq)
#pragma unroll
  for (int mi = 0; mi < MI; ++mi)
#pragma unroll
    for (int ni = 0; ni < 4; ++ni) acc[mi][ni] = f32x4{0.f, 0.f, 0.f, 0.f};
  const int nk = K >> 6;
  if (!pre) {
    GLOAD(r0, 0);
    GLOAD(r1, 64);
  }
  SSTORE(r0, 0);
  lds_barrier();
  for (int kt = 0; kt < nk; kt += 2) {
    if (kt + 2 < nk) GLOAD(r0, (kt + 2) << 6);
    else if (nA) NLOAD(r0, 0);
    COMPUTE(0);
    SSTORE(r1, 1);
    lds_barrier();
    if (kt + 3 < nk) GLOAD(r1, (kt + 3) << 6);
    else if (nA) NLOAD(r1, 64);
    COMPUTE(1);
    if (kt + 2 < nk) SSTORE(r0, 0);
    lds_barrier();
  }
#undef GLOAD
#undef NLOAD
#undef SSTORE
#undef COMPUTE
}

struct TD {
  const u16* A;
  const u16* B;
  u16* C;
  long lda, ldb, ldc;
  int K;
  int mode;
  int split;
  float scale;
  int tok0, col0;
  const float* g;
};

template <int MI = 4>
DI void run_tile2(const Prm& p, const TD& d, char* smem, Stg& r0, Stg& r1, bool pre, const u16* nA, long nlda,
                 const u16* nB, long nldb);
DI void run_tile(const Prm& p, const TD& d, char* smem) {
  Stg r0, r1;
  run_tile2<4>(p, d, smem, r0, r1, false, nullptr, 0, nullptr, 0);
}
template <int MI>
DI void run_tile2(const Prm& p, const TD& d, char* smem, Stg& r0, Stg& r1, bool pre, const u16* nA, long nlda,
                 const u16* nB, long nldb) {
  f32x4 acc[MI][4];
  gemm_tile<MI>(acc, d.A, d.lda, d.B, d.ldb, d.K, smem, r0, r1, pre, nA, nlda, nB, nldb);
  const int tid = mytid(), lane = tid & 63, wid = tid >> 6;
  const int wm = wid >> 1, wn = wid & 1, fr = lane & 15, fq = lane >> 4;
  if (d.mode == 4) {
    const int which = d.col0 >> 2, h = d.col0 & 3;
    const float* gain = d.g + which * 64 + fq * 4;
    const float* RC = (const float*)(p.ws + OFF_ROPE);
    const float* RS = RC + 65536;
    u16* dstb = d.C + (which ? 18874368L : 0L);
    const float qs = which ? 1.f : 0.18033688011112042f;
#pragma unroll
    for (int mi = 0; mi < MI; ++mi) {
      const int tok = d.tok0 + wm * (MI * 16) + mi * 16 + fr;
      float ss = 0.f;
#pragma unroll
      for (int ni = 0; ni < 4; ++ni)
#pragma unroll
        for (int j = 0; j < 4; ++j) ss += acc[mi][ni][j] * acc[mi][ni][j];
      ss += __shfl_xor(ss, 16);
      ss += __shfl_xor(ss, 32);
      const float inv = rsqrtf(ss * (1.f / 64.f) + 1e-6f) * qs;
      int b, P;
      const bool lat = tok < T_LAT;
      if (lat) { b = tok >> 11; P = 256 + (tok & 2047); }
      else { b = (tok - T_LAT) >> 8; P = (tok - T_LAT) & 255; }
      float y[4][4];
#pragma unroll
      for (int ni = 0; ni < 4; ++ni) {
        float4 g4 = *(const float4*)(gain + ni * 16);
        y[ni][0] = acc[mi][ni][0] * inv * g4.x; y[ni][1] = acc[mi][ni][1] * inv * g4.y;
        y[ni][2] = acc[mi][ni][2] * inv * g4.z; y[ni][3] = acc[mi][ni][3] * inv * g4.w;
      }
      u16* dst = dstb + ((long)((b * 4 + h) * 2 + wn) * 2304 + P) * 64 + fq * 4;
#pragma unroll
      for (int ni = 0; ni < 4; ++ni) {
        float o0 = y[ni][0], o1 = y[ni][1], o2 = y[ni][2], o3 = y[ni][3];
        if (lat) {
          const int l = tok & 2047, a = ni >> 1;
          float4 c4 = *(const float4*)(RC + (l * 2 + a) * 16 + fq * 4);
          float4 s4 = *(const float4*)(RS + (l * 2 + a) * 16 + fq * 4);
          const float sg = (ni & 1) ? 1.f : -1.f;
          o0 = y[ni][0] * c4.x + sg * y[ni ^ 1][0] * s4.x;
          o1 = y[ni][1] * c4.y + sg * y[ni ^ 1][1] * s4.y;
          o2 = y[ni][2] * c4.z + sg * y[ni ^ 1][2] * s4.z;
          o3 = y[ni][3] * c4.w + sg * y[ni ^ 1][3] * s4.w;
        }
        uint2 o;
        o.x = pk_bf16(o0, o1);
        o.y = pk_bf16(o2, o3);
        *(uint2*)(dst + ni * 16) = o;
      }
    }
    return;
  }
#pragma unroll
  for (int mi = 0; mi < MI; ++mi)
#pragma unroll
    for (int ni = 0; ni < 4; ++ni) {
      int r = wm * (MI * 16) + mi * 16 + fr, c = wn * 64 + ni * 16 + fq * 4;
      f32x4 v = acc[mi][ni];
      if (d.mode == 0) {
        long ro = d.split ? ((long)(r & 127) * d.ldc + (long)(r >> 7) * d.split) : (long)r * d.ldc;
        uint2 o;
        o.x = pk_bf16(v[0] * d.scale, v[1] * d.scale); o.y = pk_bf16(v[2] * d.scale, v[3] * d.scale);
        *(uint2*)(d.C + ro + c) = o;
      } else if (d.mode == 1) {
        uint2 o;
        float t0 = fmaxf(v[0], 0.f), t1 = fmaxf(v[1], 0.f), t2 = fmaxf(v[2], 0.f), t3 = fmaxf(v[3], 0.f);
        o.x = pk_bf16(t0 * t0, t1 * t1); o.y = pk_bf16(t2 * t2, t3 * t3);
        *(uint2*)(d.C + (long)r * d.ldc + c) = o;
      } else if (d.mode == 3) {
        if (wn == 0 && ni == 0) *(float4*)((float*)d.C + (long)r * 16 + fq * 4) = float4{v[0], v[1], v[2], v[3]};
      } else {
        float4* xp = (float4*)(xrow(p, d.tok0 + r) + d.col0 + c);
        float4 g4 = *(const float4*)(d.g + d.col0 + c);
        float4 x4 = *xp;
        x4.x += g4.x * v[0]; x4.y += g4.y * v[1]; x4.z += g4.z * v[2]; x4.w += g4.w * v[3];
        *xp = x4;
      }
    }
}

DI void ph_init(const Prm& p, char* smem) {
  const long gt = (long)mybid() * 512 + mytid(), gn = (long)gridDim.x * 512;
  {
    const float4* s = (const float4*)p.x;
    float4* d = (float4*)p.out;
#pragma unroll 8
    for (long i = gt; i < 32768L * 256; i += gn) d[i] = s[i];
    const float4* s2 = (const float4*)p.ctx;
    float4* d2 = (float4*)(p.ws + OFF_XC);
#pragma unroll 8
    for (long i = gt; i < 4096L * 256; i += gn) d2[i] = s2[i];
  }
  {
    u16* DL = (u16*)(p.ws + OFF_DL);
    for (long i = gt; i < 2048L * 4096; i += gn) {
      int l = (int)(i >> 12), kk = (int)(i & 4095), lp = kk & 2047, part = kk >> 11;
      int m = (l * lp) & 2047;
      float ang = (float)m * (6.283185307179586f / 2048.f);
      DL[i] = f2bf(part ? -sinf(ang) : cosf(ang));
    }
    u16* DLC = (u16*)(p.ws + OFF_DLC);
    for (long i = gt; i < 256L * 512; i += gn) {
      int l = (int)(i >> 9), kk = (int)(i & 511), lp = kk & 255, part = kk >> 8;
      int m = (l * lp) & 255;
      float ang = (float)m * (6.283185307179586f / 256.f);
      DLC[i] = f2bf(part ? -sinf(ang) : cosf(ang));
    }
    {
      float* RC = (float*)(p.ws + OFF_ROPE);
      float* RS = RC + 65536;
      for (long i = gt; i < 65536; i += gn) {
        int l = (int)(i >> 5), a = (int)(i >> 4) & 1, f = (int)(i & 15);
        float pos = a ? (float)(l & 63) : (float)(l >> 6);
        float ang = pos * powf(10000.f, -(float)f / 16.f);
        RC[i] = cosf(ang);
        RS[i] = sinf(ang);
      }
    }
    u16* DC = (u16*)(p.ws + OFF_DC);
    for (long i = gt; i < 256L * 128; i += gn) {
      int j2 = (int)(i >> 7), ii = (int)(i & 127), part = j2 >> 7, j = j2 & 127;
      int m = (ii * j) & 127;
      float ang = (float)m * (6.283185307179586f / 128.f);
      DC[i] = f2bf(part ? sinf(ang) : cosf(ang));
    }
  }
  float* sc = (float*)smem;
  float* red = sc + 17 * 1024;
  const int tid = mytid();
  for (int e = tid; e < 17 * 1024; e += 512) {
    int bb = e >> 10, k = e & 1023;
    float v = bb < 16 ? p.c[bb * 1024 + k] : p.c_ctx[k];
    sc[e] = v / (1.f + expf(-v));
  }
  __syncthreads();
  float* MOD = (float*)(p.ws + OFF_MOD);
  for (int it = mybid(); it < 192; it += gridDim.x) {
    int li = it / 48, cgp = it % 48;
    int cl = tid & 127, kq = tid >> 7, n = cgp * 128 + cl;
    float a[17];
#pragma unroll
    for (int b = 0; b < 17; ++b) a[b] = 0.f;
    const float* w = p.w_ada + ((long)li * 1024 + kq * 256) * 6144 + n;
#pragma unroll 1
    for (int k = 0; k < 256; k += 8) {
      float wv[8];
#pragma unroll
      for (int u = 0; u < 8; ++u) wv[u] = w[(long)(k + u) * 6144];
#pragma unroll
      for (int u = 0; u < 8; ++u) {
#pragma unroll
        for (int b = 0; b < 17; ++b) a[b] += sc[b * 1024 + kq * 256 + k + u] * wv[u];
        asm volatile("" ::: "memory");
      }
    }
#pragma unroll
    for (int b = 0; b < 17; ++b) red[(kq * 17 + b) * 128 + cl] = a[b];
    __syncthreads();
    for (int e = tid; e < 17 * 128; e += 512) {
      int b = e >> 7, c2 = e & 127, n2 = cgp * 128 + c2;
      float v = p.b_ada[li * 6144 + n2];
      for (int q = 0; q < 4; ++q) v += red[(q * 17 + b) * 128 + c2];
      MOD[((long)li * 17 + b) * 6144 + n2] = v;
    }
    __syncthreads();
  }
}

DI long tr_job(long base, const float* src, int K, int N, u16* dst, int nb, char* smem) {
  float* t = (float*)smem;
  const int tk = K >> 6, tn = (N + 63) >> 6, per = tk * tn, total = per * nb;
  const int tid = mytid();
  const int G = gridDim.x;
  float v[8];
  int it = first_item(base);
  if (it < total) {
    int b = it / per, r = it % per, kt = r / tn, nt = r % tn;
    const float* s = src + (long)b * K * N;
#pragma unroll
    for (int i = 0; i < 8; ++i) {
      int id = tid + i * 512, kk = id >> 6, nn = id & 63;
      v[i] = (nt * 64 + nn < N) ? s[(long)(kt * 64 + kk) * N + nt * 64 + nn] : 0.f;
    }
  }
  for (; it < total; it += G) {
    int b = it / per, r = it % per, kt = r / tn, nt = r % tn;
    u16* d = dst + (long)b * K * N;
    int k0 = kt * 64, n0 = nt * 64;
#pragma unroll
    for (int i = 0; i < 8; ++i) {
      int id = tid + i * 512, kk = id >> 6, nn = id & 63;
      t[kk * 65 + nn] = v[i];
    }
    __syncthreads();
    if (it + G < total) {
      int it2 = it + G, b2 = it2 / per, r2 = it2 % per, kt2 = r2 / tn, nt2 = r2 % tn;
      const float* s2 = src + (long)b2 * K * N;
#pragma unroll
      for (int i = 0; i < 8; ++i) {
        int id = tid + i * 512, kk = id >> 6, nn = id & 63;
        v[i] = (nt2 * 64 + nn < N) ? s2[(long)(kt2 * 64 + kk) * N + nt2 * 64 + nn] : 0.f;
      }
    }
#pragma unroll
    for (int i = 0; i < 8; ++i) {
      int id = tid + i * 512, nn = id >> 6, kk = id & 63;
      if (n0 + nn < N) d[(long)(n0 + nn) * K + k0 + kk] = f2bf(t[kk * 65 + nn]);
    }
    __syncthreads();
  }
  return base + total;
}

DI void ph_norm(const Prm& p, int li, int which) {
  const int lane = mytid() & 63;
  const int gw = mybid() * 8 + (mytid() >> 6), nw = gridDim.x * 8;
  const float* nwt = (which ? p.norm2 : p.norm1) + li * 1024;
  const float* MOD = (const float*)(p.ws + OFF_MOD);
  u16* H = (u16*)(p.ws + OFF_HBF);
  const int nrows = (which && li == 3) ? T_LAT : T_ALL;
  for (int row = gw; row < nrows; row += 2 * nw) {
    const int row2 = row + nw;
    const bool has2 = row2 < nrows;
    const float* xr = xrow(p, row);
    const float* xr2 = xrow(p, has2 ? row2 : row);
    float4 v[4], u[4];
    float ss = 0.f, ss2 = 0.f;
#pragma unroll
    for (int i = 0; i < 4; ++i) {
      v[i] = *(const float4*)(xr + i * 256 + lane * 4);
      u[i] = *(const float4*)(xr2 + i * 256 + lane * 4);
    }
#pragma unroll
    for (int i = 0; i < 4; ++i) {
      ss += v[i].x * v[i].x + v[i].y * v[i].y + v[i].z * v[i].z + v[i].w * v[i].w;
      ss2 += u[i].x * u[i].x + u[i].y * u[i].y + u[i].z * u[i].z + u[i].w * u[i].w;
    }
#pragma unroll
    for (int o = 32; o; o >>= 1) {
      ss += __shfl_xor(ss, o);
      ss2 += __shfl_xor(ss2, o);
    }
    const float inv = rsqrtf(ss * (1.f / 1024.f) + 1e-6f), inv2 = rsqrtf(ss2 * (1.f / 1024.f) + 1e-6f);
    const int bb = row < T_LAT ? (row >> 11) : 16, bb2 = row2 < T_LAT ? (row2 >> 11) : 16;
    const float* sh = MOD + ((long)li * 17 + bb) * 6144 + (which ? 3 : 0) * 1024;
    const float* sh2 = MOD + ((long)li * 17 + (has2 ? bb2 : bb)) * 6144 + (which ? 3 : 0) * 1024;
#pragma unroll
    for (int i = 0; i < 4; ++i) {
      int c = i * 256 + lane * 4;
      float4 w4 = *(const float4*)(nwt + c);
      {
        float4 s4 = *(const float4*)(sh + 1024 + c), h4 = *(const float4*)(sh + c);
        uint2 o;
        o.x = pk_bf16(v[i].x * inv * w4.x * (1.f + s4.x) + h4.x, v[i].y * inv * w4.y * (1.f + s4.y) + h4.y);
        o.y = pk_bf16(v[i].z * inv * w4.z * (1.f + s4.z) + h4.z, v[i].w * inv * w4.w * (1.f + s4.w) + h4.w);
        *(uint2*)(H + (long)row * 1024 + c) = o;
      }
      if (has2) {
        float4 s4 = *(const float4*)(sh2 + 1024 + c), h4 = *(const float4*)(sh2 + c);
        uint2 o;
        o.x = pk_bf16(u[i].x * inv2 * w4.x * (1.f + s4.x) + h4.x, u[i].y * inv2 * w4.y * (1.f + s4.y) + h4.y);
        o.y = pk_bf16(u[i].z * inv2 * w4.z * (1.f + s4.z) + h4.z, u[i].w * inv2 * w4.w * (1.f + s4.w) + h4.w);
        *(uint2*)(H + (long)row2 * 1024 + c) = o;
      }
    }
  }
}

DI void ph_taps1(const Prm& p, int li, long base, char* smem) {
  float* f = (float*)smem;
  float* hraw = (float*)(p.ws + OFF_AR + 5 * U38);
  const int tid = mytid();
  for (int it = first_item(base); it < 288; it += gridDim.x) {
    const int L = it < 256 ? 2048 : 256, j0 = it < 256 ? it * 8 : (it - 256) * 8;
    const int lg = tid >> 6, kk = tid & 63;
    if (tid < 8 * 33) {
      int l2 = tid / 33, e = tid % 33, j = j0 + l2;
      float t = (float)j / (float)(L - 1);
      float w = 6.283185307179586f * (float)j / (float)L;
      float v;
      if (e == 0) v = t;
      else {
        int bi = (e - 1) & 15;
        float band = 1e-4f + (float)bi * ((15.f - 1e-4f) / 15.f);
        v = (e <= 16) ? cosf(band * w) : -sinf(band * w);
      }
      f[l2 * 40 + e] = v;
    }
    __syncthreads();
    {
      float v = p.hy_b1[li * 64 + kk];
#pragma unroll 3
      for (int e = 0; e < 33; ++e) v += f[lg * 40 + e] * p.hy_w1[(li * 33 + e) * 64 + kk];
      f[320 + lg * 64 + kk] = sinf(p.hy_freq[(li * 2 + 0) * 64 + kk] * v);
    }
    __syncthreads();
    {
      float v = p.hy_b2[li * 64 + kk];
#pragma unroll 4
      for (int m = 0; m < 64; ++m) v += f[320 + lg * 64 + m] * p.hy_w2[(li * 64 + m) * 64 + kk];
      f[832 + lg * 64 + kk] = sinf(p.hy_freq[(li * 2 + 1) * 64 + kk] * v);
    }
    __syncthreads();
    {
      float h[4][8];
#pragma unroll
      for (int i = 0; i < 4; ++i)
#pragma unroll
        for (int l2 = 0; l2 < 8; ++l2) h[i][l2] = 0.f;
      const float* w3 = p.hy_w3 + (long)li * 64 * 2048 + tid;
#pragma unroll 2
      for (int k = 0; k < 64; ++k) {
        float wv[4];
#pragma unroll
        for (int i = 0; i < 4; ++i) wv[i] = w3[(long)k * 2048 + i * 512];
#pragma unroll
        for (int l2 = 0; l2 < 8; ++l2) {
          float hv = f[832 + l2 * 64 + k];
#pragma unroll
          for (int i = 0; i < 4; ++i) h[i][l2] += hv * wv[i];
        }
      }
#pragma unroll
      for (int i = 0; i < 4; ++i) {
        int n = tid + i * 512, ch = n & 511;
        float delta = fabsf(-3.0701134573253946f + (float)ch * ((-15.350567286626973f + 3.0701134573253946f) / 511.f));
#pragma unroll
        for (int l2 = 0; l2 < 8; ++l2) {
          int j = j0 + l2;
          float t = (float)j / (float)(L - 1);
          long row = (it < 256) ? j : 2048 + j;
          hraw[row * 2048 + n] = h[i][l2] * expf(-t * delta);
        }
      }
    }
    __syncthreads();
  }
}
DI void ph_taps2(const Prm& p, long base, char* smem) {
  float* vals = (float*)smem;
  float* red = vals + 8 * 2048;
  const float* hraw = (const float*)(p.ws + OFF_AR + 5 * U38);
  const int tid = mytid(), cl = tid & 3, dir = (tid >> 2) & 1, jg = tid >> 3;
  for (int it = first_item(base); it < 512; it += gridDim.x) {
    int ls = it >> 8, order = (it >> 7) & 1, cgp = it & 127;
    int L = ls ? 256 : 2048;
    const float* hr = hraw + (long)(ls ? 2048 : 0) * 2048;
    u16* G = (u16*)(p.ws + (ls ? OFF_TAPC : OFF_TAPL));
    int ch = cgp * 4 + cl, n = order * 1024 + dir * 512 + ch;
    float s = 0.f;
#pragma unroll 8
    for (int j = jg; j < L; j += 64) {
      float v = hr[(long)j * 2048 + n];
      vals[(cl * 2 + dir) * L + j] = v;
      s += (dir == 1 && j == 0) ? 0.f : fabsf(v);
    }
    red[(tid >> 2) * 4 + cl] = s;
    __syncthreads();
    if (tid < 4) {
      float tot = 0.f;
#pragma unroll 8
      for (int r = 0; r < 128; ++r) tot += red[r * 4 + tid];
      red[512 + tid] = 1.f / tot;
    }
    __syncthreads();
    for (int idx = tid; idx < 8 * L; idx += 512) {
      int q = idx / L, j = idx % L, c2 = q >> 1, d2 = q & 1;
      float v = vals[idx] * red[512 + c2];
      u16* g = G + (long)(order * 512 + cgp * 4 + c2) * (2 * L);
      if (d2 == 0) g[L + j] = f2bf(v);
      else if (j > 0) g[L - j] = f2bf(v);
      else g[0] = 0;
    }
    __syncthreads();
  }
}

DI void ph_pdab(const Prm& p, int li, char* smem) {
  float* wl = (float*)smem;
  const int tid = mytid(), lane = tid & 63;
#pragma unroll 8
  for (int e = tid; e < 1024 * 16; e += 512) wl[e] = p.w_in[((long)li * 1024 + (e >> 4)) * NIN + 5632 + (e & 15)];
  __syncthreads();
  const u16* H = (const u16*)(p.ws + OFF_HBF);
  float* out = (float*)(p.ws + OFF_PDAB);
  const int gw = mybid() * 8 + (tid >> 6), nw = gridDim.x * 8;
  for (int tok = gw; tok < T_ALL; tok += nw) {
    float a[16];
#pragma unroll
    for (int j = 0; j < 16; ++j) a[j] = 0.f;
    float hv[16];
#pragma unroll
    for (int i = 0; i < 16; ++i) hv[i] = bf2f(H[(long)tok * 1024 + lane + i * 64]);
#pragma unroll
    for (int i = 0; i < 16; ++i) {
      float h = hv[i];
      const float4* wp = (const float4*)(wl + (lane + i * 64) * 16);
#pragma unroll
      for (int q = 0; q < 4; ++q) {
        float4 w4 = wp[q];
        a[q * 4 + 0] += h * w4.x;
        a[q * 4 + 1] += h * w4.y;
        a[q * 4 + 2] += h * w4.z;
        a[q * 4 + 3] += h * w4.w;
      }
      if ((i & 3) == 3) asm volatile("" ::: "memory");
    }
#pragma unroll
    for (int o = 32; o; o >>= 1)
#pragma unroll
      for (int j = 0; j < 16; ++j) a[j] += __shfl_xor(a[j], o);
    float v = a[0];
#pragma unroll
    for (int j = 1; j < 16; ++j) v = (lane == j) ? a[j] : v;
    if (lane < 16) out[(long)tok * 16 + lane] = v;
  }
  __syncthreads();
}

DI void ph_dncl(const Prm& p, int li, char* smem) {
  const int tid = mytid(), lane = tid & 63, wid = tid >> 6, fr = lane & 15, fq = lane >> 4;
  u16* qn = (u16*)smem;
  u16* kn = qn + 64 * 144;
  float* fb = (float*)(smem + 36864);
  float* KK = fb;
  float* QK = KK + 64 * 65;
  float* Am = QK + 64 * 65;
  float* Tm = Am + 2 * 64 * 65;
  float* gcs = Tm + 2 * 64 * 65;
  float* bts = gcs + 128;
  const u16* PD = (const u16*)(p.ws + OFF_AR);
  const float* AB = (const float*)(p.ws + OFF_PDAB);
  u16* DQ = (u16*)(p.ws + OFF_Y);
  u16* DK = DQ + 18874368L;
  u16* DV = DK + 18874368L;
  u16* CL = (u16*)(p.ws + OFF_AR + 3 * U38);
  float* GC = (float*)(p.ws + OFF_GC);
  float* BT = (float*)(p.ws + OFF_BETA);
  const float* cw = p.dn_conv + (long)li * 3 * 1536;
  for (int it = mybid(); it < 2304; it += gridDim.x) {
    const int b = it / 144, r0 = it % 144, oc = r0 >> 2, h = r0 & 3;
    const int pos0 = oc * 64, s0 = oc < 4 ? 0 : 256, e0 = oc < 4 ? 256 : 2304;
    if (tid < 384) {
      const int cgp = tid % 48, rs = tid / 48;
      const int part = cgp >> 4, d0 = (cgp & 15) * 8, col = part * 512 + h * 128 + d0;
      const u16* basep = PD + (long)tokof(b, pos0) * 1536 + col;
      float wt[3][8];
#pragma unroll
      for (int tp = 0; tp < 3; ++tp) {
        float4 wa = *(const float4*)(cw + tp * 1536 + col), wb = *(const float4*)(cw + tp * 1536 + col + 4);
        wt[tp][0] = wa.x; wt[tp][1] = wa.y; wt[tp][2] = wa.z; wt[tp][3] = wa.w;
        wt[tp][4] = wb.x; wt[tp][5] = wb.y; wt[tp][6] = wb.z; wt[tp][7] = wb.w;
      }
#pragma unroll 1
      for (int hf = 0; hf < 2; ++hf) {
        u32x4 rw[6];
#pragma unroll
        for (int i = 0; i < 6; ++i) {
          int j = rs * 8 + hf * 4 - 1 + i, P = pos0 + j;
          rw[i] = (P >= s0 && P < e0) ? *(const u32x4*)(basep + (long)j * 1536) : u32x4{0u, 0u, 0u, 0u};
        }
#pragma unroll
        for (int r = 0; r < 4; ++r) {
#pragma unroll
          for (int e = 0; e < 8; ++e) {
            unsigned w0_ = rw[r][e >> 1], w1_ = rw[r + 1][e >> 1], w2_ = rw[r + 2][e >> 1];
            float x0 = (e & 1) ? __uint_as_float(w0_ & 0xffff0000u) : __uint_as_float(w0_ << 16);
            float x1 = (e & 1) ? __uint_as_float(w1_ & 0xffff0000u) : __uint_as_float(w1_ << 16);
            float x2 = (e & 1) ? __uint_as_float(w2_ & 0xffff0000u) : __uint_as_float(w2_ << 16);
            float v = wt[0][e] * x0 + wt[1][e] * x1 + wt[2][e] * x2;
            fb[(rs * 8 + hf * 4 + r) * 385 + part * 128 + d0 + e] = v * __builtin_amdgcn_rcpf(1.f + __expf(-v));
          }
        }
      }
    }
    __syncthreads();
    for (int jj = 0; jj < 8; ++jj) {
      int j = wid * 8 + jj, P = pos0 + j;
      long go = ((long)(b * 4 + h) * 2304 + P) * 128;
      float q0 = fb[j * 385 + lane], q1 = fb[j * 385 + 64 + lane];
      float k0 = fb[j * 385 + 128 + lane], k1 = fb[j * 385 + 192 + lane];
      float v0 = fb[j * 385 + 256 + lane], v1 = fb[j * 385 + 320 + lane];
      float iq = rsqrtf(wsum(q0 * q0 + q1 * q1) + 1e-6f), ik = rsqrtf(wsum(k0 * k0 + k1 * k1) + 1e-6f);
      u16 a0 = f2bf(q0 * iq), a1 = f2bf(q1 * iq), c0 = f2bf(k0 * ik), c1 = f2bf(k1 * ik);
      qn[j * 144 + lane] = a0; qn[j * 144 + 64 + lane] = a1;
      kn[j * 144 + lane] = c0; kn[j * 144 + 64 + lane] = c1;
      DQ[go + lane] = a0; DQ[go + 64 + lane] = a1;
      DK[go + lane] = c0; DK[go + 64 + lane] = c1;
      DV[go + lane] = f2bf(v0); DV[go + 64 + lane] = f2bf(v1);
    }
    __syncthreads();
#pragma unroll
    for (int u = 0; u < 4; ++u) {
      int tt = wid * 4 + u, which = tt >> 4, ti = (tt >> 2) & 3, tj = tt & 3;
      const u16* Ap = (which ? qn : kn) + (ti * 16 + fr) * 144 + fq * 8;
      const u16* Bp = kn + (tj * 16 + fr) * 144 + fq * 8;
      f32x4 a = {0.f, 0.f, 0.f, 0.f};
#pragma unroll
      for (int ks = 0; ks < 4; ++ks) a = MFMA(*(const bf16x8*)(Ap + ks * 32), *(const bf16x8*)(Bp + ks * 32), a);
      float* dst = which ? QK : KK;
#pragma unroll
      for (int j = 0; j < 4; ++j) dst[(ti * 16 + fq * 4 + j) * 65 + tj * 16 + fr] = a[j];
    }
    if (tid < 128) {
      int d = tid >> 6, r = tid & 63, j = d ? 63 - r : r;
      int tok = tokof(b, pos0 + j);
      float av = AB[(long)tok * 16 + d * 4 + h], bv = AB[(long)tok * 16 + 8 + d * 4 + h];
      float xx = av + p.dn_dt_bias[li * 8 + d * 4 + h];
      float sp = fmaxf(xx, 0.f) + __logf(1.f + __expf(-fabsf(xx)));
      float g = -expf(p.dn_a_log[li * 8 + d * 4 + h]) * sp;
      for (int o = 1; o < 64; o <<= 1) {
        float t = __shfl_up(g, o);
        if (r >= o) g += t;
      }
      float be = 1.f / (1.f + expf(-bv));
      gcs[d * 64 + r] = g;
      bts[d * 64 + r] = be;
      long ci = ((long)((b * 4 + h) * 2 + d) * 36 + oc) * 64 + r;
      GC[ci] = g;
      BT[ci] = be;
    }
    __syncthreads();
#pragma unroll 4
    for (int e = tid; e < 8192; e += 512) {
      int d = e >> 12, s = (e >> 6) & 63, r = e & 63;
      int j = d ? 63 - r : r, js = d ? 63 - s : s;
      float v = 0.f;
      if (r > s) v = bts[d * 64 + r] * KK[j * 65 + js] * __expf(gcs[d * 64 + r] - gcs[d * 64 + s]);
      Am[(d * 64 + s) * 64 + r] = v;
    }
#pragma unroll 4
    for (int e = tid; e < 8192; e += 512) {
      int d = e >> 12, r = (e >> 6) & 63, s = e & 63;
      int j = d ? 63 - r : r, js = d ? 63 - s : s;
      float dec = (r >= s) ? __expf(gcs[d * 64 + r] - gcs[d * 64 + s]) : 0.f;
      long ci = (long)((b * 4 + h) * 2 + d) * 36 + oc;
      CL[ci * 8192 + 4096 + r * 64 + s] = f2bf(QK[j * 65 + js] * dec * 0.08838834764831845f);
    }
    __syncthreads();
    {
      const int d = tid >> 8, c = (tid >> 2) & 63, q = tid & 3;
      const float* Atq = Am + d * 64 * 64 + q;
      float* T = Tm + d * 64 * 65;
      float t[16];
#pragma unroll
      for (int i = 0; i < 16; ++i) t[i] = (4 * i + q == c) ? 1.f : 0.f;
#pragma unroll
      for (int s2 = 0; s2 < 63; ++s2) {
        constexpr int dummy = 0;
        const int is = s2 >> 2, qs = s2 & 3;
        const int ctl = qs | (qs << 2) | (qs << 4) | (qs << 6);
        int tsb;
        if (qs == 0) tsb = __builtin_amdgcn_update_dpp(0, __float_as_int(t[is]), 0x00, 0xf, 0xf, false);
        else if (qs == 1) tsb = __builtin_amdgcn_update_dpp(0, __float_as_int(t[is]), 0x55, 0xf, 0xf, false);
        else if (qs == 2) tsb = __builtin_amdgcn_update_dpp(0, __float_as_int(t[is]), 0xAA, 0xf, 0xf, false);
        else tsb = __builtin_amdgcn_update_dpp(0, __float_as_int(t[is]), 0xFF, 0xf, 0xf, false);
        (void)ctl; (void)dummy;
        const float ts = __int_as_float(tsb);
#pragma unroll
        for (int i = is; i < 16; ++i) t[i] -= Atq[s2 * 64 + 4 * i] * ts;
        if ((s2 & 7) == 7) asm volatile("" ::: "memory");
      }
#pragma unroll
      for (int i = 0; i < 16; ++i) T[(4 * i + q) * 65 + c] = t[i];
    }
    __syncthreads();
    for (int e = tid; e < 8192; e += 512) {
      int d = e >> 12, rc = e & 4095;
      long ci = (long)((b * 4 + h) * 2 + d) * 36 + oc;
      CL[ci * 8192 + rc] = f2bf(Tm[(d * 64 + (rc >> 6)) * 65 + (rc & 63)]);
    }
    __syncthreads();
  }
}

DI void ph_dnscan(const Prm& p, char* smem) {
  const int tid = mytid(), lane = tid & 63, wid = tid >> 6, fr = lane & 15, fq = lane >> 4;
  u16* Kg = (u16*)smem;
  u16* Qg = Kg + 64 * 144;
  u16* KdT = Qg + 64 * 144;
  u16* Tl = KdT + 128 * 80;
  u16* Il = Tl + 64 * 80;
  u16* ST = Il + 64 * 80;
  u16* RT = ST + 64 * 144;
  u16* VN = RT + 64 * 80;
  const u16* DQ = (const u16*)(p.ws + OFF_Y);
  const u16* DK = DQ + 18874368L;
  const u16* DV = DK + 18874368L;
  const u16* CL = (const u16*)(p.ws + OFF_AR + 3 * U38);
  const float* GC = (const float*)(p.ws + OFF_GC);
  const float* BT = (const float*)(p.ws + OFF_BETA);
  const int vt = wid & 3, rp = wid >> 2;
  for (int it = mybid(); it < 256; it += gridDim.x) {
    const int b = it >> 4, h = (it >> 2) & 3, d = (it >> 1) & 1, vs = it & 1;
    u16* O = (u16*)(p.ws + OFF_AR + (d ? 6 : 5) * U38);
    f32x4 S[4];
#pragma unroll
    for (int i = 0; i < 4; ++i) S[i] = f32x4{0.f, 0.f, 0.f, 0.f};
    for (int e = tid; e < 64 * 144; e += 512) ST[e] = 0;
    const long seqb = (long)(b * 4 + h) * 2304;
    const long cib = (long)((b * 4 + h) * 2 + d) * 36;
    u32x4 rk0, rk1, rq0, rq1, rT, rI;
    float rg0, rg1, rgl;
    uint2 rv0, rv1;
    float rb0, rb1;
    const int lr0 = tid >> 4, lr1 = (tid + 512) >> 4, lch = tid & 15;
    const int lj0 = d ? 63 - lr0 : lr0, lj1 = d ? 63 - lr1 : lr1;
    const int vr0 = (rp * 2) * 16 + fr, vr1 = (rp * 2 + 1) * 16 + fr;
    const int vj0 = d ? 63 - vr0 : vr0, vj1 = d ? 63 - vr1 : vr1;
#define SCAN_LOAD_KQ(ocx)                                                                    \
  {                                                                                          \
    const long ci_ = cib + (ocx);                                                            \
    const long g0_ = (seqb + (ocx) * 64 + lj0) * 128 + lch * 8, g1_ = (seqb + (ocx) * 64 + lj1) * 128 + lch * 8; \
    rk0 = *(const u32x4*)(DK + g0_); rk1 = *(const u32x4*)(DK + g1_);                        \
    rq0 = *(const u32x4*)(DQ + g0_); rq1 = *(const u32x4*)(DQ + g1_);                        \
    rT = *(const u32x4*)(CL + ci_ * 8192 + (tid >> 3) * 64 + (tid & 7) * 8);                 \
    rI = *(const u32x4*)(CL + ci_ * 8192 + 4096 + (tid >> 3) * 64 + (tid & 7) * 8);          \
    rg0 = GC[ci_ * 64 + lr0]; rg1 = GC[ci_ * 64 + lr1]; rgl = GC[ci_ * 64 + 63];             \
  }
#define SCAN_LOAD_V(ocx)                                                                     \
  {                                                                                          \
    const long ci_ = cib + (ocx);                                                            \
    rv0 = *(const uint2*)(DV + (seqb + (ocx) * 64 + vj0) * 128 + vs * 64 + vt * 16 + fq * 4); \
    rv1 = *(const uint2*)(DV + (seqb + (ocx) * 64 + vj1) * 128 + vs * 64 + vt * 16 + fq * 4); \
    rb0 = BT[ci_ * 64 + vr0]; rb1 = BT[ci_ * 64 + vr1];                                      \
  }
    {
      const int oc0 = d ? 3 : 0;
      SCAN_LOAD_KQ(oc0);
      SCAN_LOAD_V(oc0);
    }
    for (int i = 0; i < 36; ++i) {
      const int oc = d ? (i < 4 ? 3 - i : 39 - i) : i;
      const int ocn = d ? (i + 1 < 4 ? 3 - (i + 1) : 39 - (i + 1)) : i + 1;
      const int pos0 = oc * 64;
      const float gl = rgl;
      {
        float eg0 = __expf(rg0), ed0 = __expf(gl - rg0), eg1 = __expf(rg1), ed1 = __expf(gl - rg1);
        u32x4 ko0, qo0, ko1, qo1;
#pragma unroll
        for (int w = 0; w < 4; ++w) {
          float k0l = __uint_as_float(rk0[w] << 16), k0h = __uint_as_float(rk0[w] & 0xffff0000u);
          float q0l = __uint_as_float(rq0[w] << 16), q0h = __uint_as_float(rq0[w] & 0xffff0000u);
          float k1l = __uint_as_float(rk1[w] << 16), k1h = __uint_as_float(rk1[w] & 0xffff0000u);
          float q1l = __uint_as_float(rq1[w] << 16), q1h = __uint_as_float(rq1[w] & 0xffff0000u);
          ko0[w] = pk_bf16(k0l * eg0, k0h * eg0);
          qo0[w] = pk_bf16(q0l * eg0 * 0.08838834764831845f, q0h * eg0 * 0.08838834764831845f);
          ko1[w] = pk_bf16(k1l * eg1, k1h * eg1);
          qo1[w] = pk_bf16(q1l * eg1 * 0.08838834764831845f, q1h * eg1 * 0.08838834764831845f);
          KdT[(lch * 8 + 2 * w) * 80 + lr0] = f2bf(k0l * ed0);
          KdT[(lch * 8 + 2 * w + 1) * 80 + lr0] = f2bf(k0h * ed0);
          KdT[(lch * 8 + 2 * w) * 80 + lr1] = f2bf(k1l * ed1);
          KdT[(lch * 8 + 2 * w + 1) * 80 + lr1] = f2bf(k1h * ed1);
        }
        *(u32x4*)(Kg + lr0 * 144 + lch * 8) = ko0;
        *(u32x4*)(Qg + lr0 * 144 + lch * 8) = qo0;
        *(u32x4*)(Kg + lr1 * 144 + lch * 8) = ko1;
        *(u32x4*)(Qg + lr1 * 144 + lch * 8) = qo1;
        *(u32x4*)(Tl + (tid >> 3) * 80 + (tid & 7) * 8) = rT;
        *(u32x4*)(Il + (tid >> 3) * 80 + (tid & 7) * 8) = rI;
      }
      lds_barrier();
      if (i + 1 < 36) SCAN_LOAD_KQ(ocn);
      f32x4 ks_[2], qs_[2];
#pragma unroll
      for (int u = 0; u < 2; ++u) { ks_[u] = f32x4{0.f, 0.f, 0.f, 0.f}; qs_[u] = f32x4{0.f, 0.f, 0.f, 0.f}; }
#pragma unroll
      for (int kk = 0; kk < 4; ++kk) {
        bf16x8 a = *(const bf16x8*)(ST + (vt * 16 + fr) * 144 + kk * 32 + fq * 8);
#pragma unroll
        for (int u = 0; u < 2; ++u) {
          int rt = rp * 2 + u;
          bf16x8 bk = *(const bf16x8*)(Kg + (rt * 16 + fr) * 144 + kk * 32 + fq * 8);
          bf16x8 bq = *(const bf16x8*)(Qg + (rt * 16 + fr) * 144 + kk * 32 + fq * 8);
          ks_[u] = MFMA(a, bk, ks_[u]);
          qs_[u] = MFMA(a, bq, qs_[u]);
        }
      }
      {
        int v0 = vt * 16 + fq * 4;
        RT[(v0 + 0) * 80 + vr0] = f2bf(rb0 * (__uint_as_float(rv0.x << 16) - ks_[0][0]));
        RT[(v0 + 1) * 80 + vr0] = f2bf(rb0 * (__uint_as_float(rv0.x & 0xffff0000u) - ks_[0][1]));
        RT[(v0 + 2) * 80 + vr0] = f2bf(rb0 * (__uint_as_float(rv0.y << 16) - ks_[0][2]));
        RT[(v0 + 3) * 80 + vr0] = f2bf(rb0 * (__uint_as_float(rv0.y & 0xffff0000u) - ks_[0][3]));
        RT[(v0 + 0) * 80 + vr1] = f2bf(rb1 * (__uint_as_float(rv1.x << 16) - ks_[1][0]));
        RT[(v0 + 1) * 80 + vr1] = f2bf(rb1 * (__uint_as_float(rv1.x & 0xffff0000u) - ks_[1][1]));
        RT[(v0 + 2) * 80 + vr1] = f2bf(rb1 * (__uint_as_float(rv1.y << 16) - ks_[1][2]));
        RT[(v0 + 3) * 80 + vr1] = f2bf(rb1 * (__uint_as_float(rv1.y & 0xffff0000u) - ks_[1][3]));
      }
      if (i + 1 < 36) SCAN_LOAD_V(ocn);
      lds_barrier();
      {
        f32x4 vn[2];
#pragma unroll
        for (int u = 0; u < 2; ++u) vn[u] = f32x4{0.f, 0.f, 0.f, 0.f};
#pragma unroll
        for (int kk = 0; kk < 2; ++kk) {
          bf16x8 a = *(const bf16x8*)(RT + (vt * 16 + fr) * 80 + kk * 32 + fq * 8);
#pragma unroll
          for (int u = 0; u < 2; ++u) {
            bf16x8 bb = *(const bf16x8*)(Tl + ((rp * 2 + u) * 16 + fr) * 80 + kk * 32 + fq * 8);
            vn[u] = MFMA(a, bb, vn[u]);
          }
        }
#pragma unroll
        for (int u = 0; u < 2; ++u) {
          int r = (rp * 2 + u) * 16 + fr, v0 = vt * 16 + fq * 4;
#pragma unroll
          for (int j = 0; j < 4; ++j) VN[(v0 + j) * 80 + r] = f2bf(vn[u][j]);
        }
      }
      lds_barrier();
#pragma unroll
      for (int kk = 0; kk < 2; ++kk) {
        bf16x8 a = *(const bf16x8*)(VN + (vt * 16 + fr) * 80 + kk * 32 + fq * 8);
#pragma unroll
        for (int u = 0; u < 2; ++u) {
          bf16x8 bb = *(const bf16x8*)(Il + ((rp * 2 + u) * 16 + fr) * 80 + kk * 32 + fq * 8);
          qs_[u] = MFMA(a, bb, qs_[u]);
        }
      }
#pragma unroll
      for (int u = 0; u < 2; ++u) {
        int r = (rp * 2 + u) * 16 + fr, j = d ? 63 - r : r;
        u16* op = O + (long)tokof(b, pos0 + j) * 512 + h * 128 + vs * 64 + vt * 16 + fq * 4;
        ushort4 ov4;
        ov4.x = f2bf(qs_[u][0]); ov4.y = f2bf(qs_[u][1]); ov4.z = f2bf(qs_[u][2]); ov4.w = f2bf(qs_[u][3]);
        *(ushort4*)op = ov4;
      }
      {
        float ge = __expf(gl);
#pragma unroll
        for (int u = 0; u < 4; ++u) S[u] *= ge;
#pragma unroll
        for (int kk = 0; kk < 2; ++kk) {
          bf16x8 a = *(const bf16x8*)(VN + (vt * 16 + fr) * 80 + kk * 32 + fq * 8);
#pragma unroll
          for (int u = 0; u < 4; ++u) {
            bf16x8 bb = *(const bf16x8*)(KdT + ((rp * 4 + u) * 16 + fr) * 80 + kk * 32 + fq * 8);
            S[u] = MFMA(a, bb, S[u]);
          }
        }
#pragma unroll
        for (int u = 0; u < 4; ++u) {
          int dd = (rp * 4 + u) * 16 + fr, v0 = vt * 16 + fq * 4;
#pragma unroll
          for (int j = 0; j < 4; ++j) ST[(v0 + j) * 144 + dd] = f2bf(S[u][j]);
        }
      }
      lds_barrier();
    }
#undef SCAN_LOAD_KQ
#undef SCAN_LOAD_V
  }
}

DI void ph_dnfin(const Prm& p, int li) {
  const int lane = mytid() & 63;
  const int gw = mybid() * 8 + (mytid() >> 6), nw = gridDim.x * 8;
  const u16* O = (const u16*)(p.ws + OFF_AR + 5 * U38);
  const u16* O2 = (const u16*)(p.ws + OFF_AR + 6 * U38);
  u16* Z = (u16*)(p.ws + OFF_Y + 3 * U38);
  const float n0 = p.dn_norm[li * 128 + lane * 2], n1 = p.dn_norm[li * 128 + lane * 2 + 1];
#pragma unroll 2
  for (int tok = gw; tok < T_ALL; tok += nw) {
    ushort2 oa[4], ob[4], zz[4];
    float ox[4], oy[4], ss[4];
#pragma unroll
    for (int h = 0; h < 4; ++h) {
      long o = (long)tok * 512 + h * 128 + lane * 2;
      oa[h] = *(const ushort2*)(O + o);
      ob[h] = *(const ushort2*)(O2 + o);
      zz[h] = *(const ushort2*)(Z + o);
    }
#pragma unroll
    for (int h = 0; h < 4; ++h) {
      ox[h] = bf2f(oa[h].x) + bf2f(ob[h].x);
      oy[h] = bf2f(oa[h].y) + bf2f(ob[h].y);
      ss[h] = ox[h] * ox[h] + oy[h] * oy[h];
    }
#pragma unroll
    for (int o = 32; o; o >>= 1)
#pragma unroll
      for (int h = 0; h < 4; ++h) ss[h] += __shfl_xor(ss[h], o);
#pragma unroll
    for (int h = 0; h < 4; ++h) {
      float inv = rsqrtf(ss[h] * (1.f / 128.f) + 1e-6f);
      float z0 = bf2f(zz[h].x), z1 = bf2f(zz[h].y);
      ushort2 y;
      y.x = f2bf(ox[h] * inv * n0 * (z0 * __builtin_amdgcn_rcpf(1.f + __expf(-z0))));
      y.y = f2bf(oy[h] * inv * n1 * (z1 * __builtin_amdgcn_rcpf(1.f + __expf(-z1))));
      *(ushort2*)(Z + (long)tok * 512 + h * 128 + lane * 2) = y;
    }
  }
}

DI void ph_aprep(const Prm& p, int li) {
  const int lane = mytid() & 63;
  const int gw = mybid() * 8 + (mytid() >> 6), nw = gridDim.x * 8;
  const u16* PA = (const u16*)(p.ws + OFF_AR);
  u16* QH = (u16*)(p.ws + OFF_AR + 3 * U38);
  u16* KH = QH + 18874368L;
  const int f = lane & 15;
  const float inv_f = powf(10000.f, -(float)f / 16.f);
  for (int tok = gw; tok < T_ALL; tok += nw) {
    int b, P;
    float cs = 1.f, sn = 0.f;
    if (tok < T_LAT) {
      b = tok >> 11;
      int l = tok & 2047;
      P = 256 + l;
      float pos = (lane < 32) ? (float)(l >> 6) : (float)(l & 63);
      float ang = pos * inv_f;
      cs = cosf(ang);
      sn = sinf(ang);
    } else {
      b = (tok - T_LAT) >> 8;
      P = (tok - T_LAT) & 255;
    }
    float xv[16], ssq[16];
#pragma unroll
    for (int g = 0; g < 16; ++g) {
      xv[g] = bf2f(PA[(long)tok * 1024 + g * 64 + lane]);
      ssq[g] = xv[g] * xv[g];
    }
#pragma unroll
    for (int o = 32; o; o >>= 1)
#pragma unroll
      for (int g = 0; g < 16; ++g) ssq[g] += __shfl_xor(ssq[g], o);
#pragma unroll
    for (int g = 0; g < 16; ++g) {
      int which = g >> 3, h = (g >> 1) & 3, c = g & 1;
      float inv = rsqrtf(ssq[g] * (1.f / 64.f) + 1e-6f);
      float y = xv[g] * inv * p.qk_gain[(li * 2 + which) * 64 + lane];
      float pr = __shfl_xor(y, 16);
      float o = (lane & 16) ? (y * cs + pr * sn) : (y * cs - pr * sn);
      if (which == 0) o *= 0.18033688011112042f;
      u16* dst = (which ? KH : QH) + ((long)((b * 4 + h) * 2 + c) * 2304 + P) * 64 + lane;
      *dst = f2bf(o);
    }
  }
}

DI void ph_attn(const Prm& p, int li, long base, char* smem) {
  const int tid = mytid(), lane = tid & 63, wid = tid >> 6, fr = lane & 15, fq = lane >> 4;
  const u16* QH = (const u16*)(p.ws + OFF_AR + 3 * U38);
  const u16* KH = QH + 18874368L;
  const u16* VT = (const u16*)(p.ws + OFF_AR + 5 * U38);
  u16* YA = (u16*)(p.ws + OFF_Y);
  u16* s = (u16*)smem;
  constexpr int STG = 128 * 80 + 128 * 72;
  const float lambda_init = 0.8f - 0.6f * expf(-0.3f * (float)li);
  float lamv, mshift;
  {
    const float* lv = p.lam + li * 256;
    float a = wsum(lv[lane] * lv[64 + lane]), b2 = wsum(lv[128 + lane] * lv[192 + lane]);
    lamv = expf(a) - expf(b2) + lambda_init;
    float gq = wmax(fabsf(p.qk_gain[(li * 2) * 64 + lane])), gk = wmax(fabsf(p.qk_gain[(li * 2 + 1) * 64 + lane]));
    mshift = 8.f * gq * gk * 1.4426950408889634f;
  }
  for (int it = first_item(base); it < (li == 3 ? 1024 : 1152); it += gridDim.x) {
    int b, h, qp0, nkeys;
    if (it < 1024) { b = it >> 6; h = (it >> 4) & 3; qp0 = 256 + (it & 15) * 128; nkeys = 2304; }
    else { int i2 = it - 1024; b = i2 >> 3; h = (i2 >> 1) & 3; qp0 = (i2 & 1) * 128; nkeys = 256; }
    const long kb0 = (long)((b * 4 + h) * 2) * 2304;
    bf16x8 qf[2][2];
#pragma unroll
    for (int c = 0; c < 2; ++c)
#pragma unroll
      for (int ks = 0; ks < 2; ++ks)
        qf[c][ks] = *(const bf16x8*)(QH + (kb0 + (long)c * 2304 + qp0 + wid * 16 + fr) * 64 + ks * 32 + fq * 8);
    f32x4 O0[8], O1[8];
#pragma unroll
    for (int i = 0; i < 8; ++i) { O0[i] = f32x4{0.f, 0.f, 0.f, 0.f}; O1[i] = f32x4{0.f, 0.f, 0.f, 0.f}; }
    f32x4 L0 = {0.f, 0.f, 0.f, 0.f}, L1 = {0.f, 0.f, 0.f, 0.f};
    const bf16x8 ones = {0x3F80, 0x3F80, 0x3F80, 0x3F80, 0x3F80, 0x3F80, 0x3F80, 0x3F80};
    uint4 rk[2], rv[2];
    const int nt = nkeys >> 6;
#pragma unroll
    for (int u = 0; u < 2; ++u) {
      int id = tid + u * 512;
      int c = id >> 9, key = (id >> 3) & 63, ch = id & 7;
      rk[u] = *(const uint4*)(KH + (kb0 + (long)c * 2304 + key) * 64 + ch * 8);
      int dv = id >> 3;
      rv[u] = *(const uint4*)(VT + ((long)(b * 512 + h * 128 + dv)) * 2304 + ch * 8);
    }
#pragma unroll
    for (int u = 0; u < 2; ++u) {
      int id = tid + u * 512;
      *(uint4*)(s + (id >> 3) * 80 + (id & 7) * 8) = rk[u];
      *(uint4*)(s + 128 * 80 + (id >> 3) * 72 + (id & 7) * 8) = rv[u];
    }
    lds_barrier();
    for (int t = 0; t < nt; ++t) {
      const bool more = t + 1 < nt;
      if (more) {
        int kp0 = (t + 1) * 64;
#pragma unroll
        for (int u = 0; u < 2; ++u) {
          int id = tid + u * 512;
          int c = id >> 9, key = (id >> 3) & 63, ch = id & 7;
          rk[u] = *(const uint4*)(KH + (kb0 + (long)c * 2304 + kp0 + key) * 64 + ch * 8);
          int dv = id >> 3;
          rv[u] = *(const uint4*)(VT + ((long)(b * 512 + h * 128 + dv)) * 2304 + kp0 + ch * 8);
        }
      }
      const u16* ks_ = s + (t & 1) * STG;
      const u16* vs_ = ks_ + 128 * 80;
      bf16x8 pf[2][2];
#pragma unroll
      for (int c = 0; c < 2; ++c) {
#pragma unroll
        for (int kk2 = 0; kk2 < 2; ++kk2) {
          u32x4 pw;
#pragma unroll
          for (int hh = 0; hh < 2; ++hh) {
            const int k4 = kk2 * 2 + hh;
            f32x4 a = {-mshift, -mshift, -mshift, -mshift};
#pragma unroll
            for (int kk = 0; kk < 2; ++kk)
              a = MFMA(*(const bf16x8*)(ks_ + (c * 64 + k4 * 16 + fr) * 80 + kk * 32 + fq * 8), qf[c][kk], a);
            pw[hh * 2 + 0] = pk_bf16(__builtin_amdgcn_exp2f(a[0]), __builtin_amdgcn_exp2f(a[1]));
            pw[hh * 2 + 1] = pk_bf16(__builtin_amdgcn_exp2f(a[2]), __builtin_amdgcn_exp2f(a[3]));
          }
          pf[c][kk2] = *(bf16x8*)&pw;
        }
      }
#pragma unroll
      for (int kk = 0; kk < 2; ++kk) {
        L0 = MFMA(ones, pf[0][kk], L0);
        L1 = MFMA(ones, pf[1][kk], L1);
      }
#pragma unroll
      for (int dt = 0; dt < 8; ++dt) {
#pragma unroll
        for (int kk = 0; kk < 2; ++kk) {
          const u16* vp = vs_ + (dt * 16 + fr) * 72 + kk * 32 + fq * 4;
          uint2 lo = *(const uint2*)vp, hi = *(const uint2*)(vp + 16);
          uint4 av = {lo.x, lo.y, hi.x, hi.y};
          bf16x8 a = *(bf16x8*)&av;
          O0[dt] = MFMA(a, pf[0][kk], O0[dt]);
          O1[dt] = MFMA(a, pf[1][kk], O1[dt]);
        }
      }
      if (more) {
        u16* ns = s + ((t + 1) & 1) * STG;
#pragma unroll
        for (int u = 0; u < 2; ++u) {
          int id = tid + u * 512;
          *(uint4*)(ns + (id >> 3) * 80 + (id & 7) * 8) = rk[u];
          *(uint4*)(ns + 128 * 80 + (id >> 3) * 72 + (id & 7) * 8) = rv[u];
        }
      }
      lds_barrier();
    }
    float i0 = 1.f / L0[0], i1 = lamv / L1[0], ss = 0.f;
#pragma unroll
    for (int dt = 0; dt < 8; ++dt)
#pragma unroll
      for (int j = 0; j < 4; ++j) {
        float o = O0[dt][j] * i0 - O1[dt][j] * i1;
        O0[dt][j] = o;
        ss += o * o;
      }
    ss += __shfl_xor(ss, 16); ss += __shfl_xor(ss, 32);
    float inv = rsqrtf(ss * (1.f / 128.f) + 1e-6f) * (1.f - lambda_init);
    int tok = tokof(b, qp0 + wid * 16 + fr);
#pragma unroll
    for (int dt = 0; dt < 8; ++dt) {
      int dv = dt * 16 + fq * 4;
      const float* sw = p.subln + li * 128 + dv;
      uint2 o;
      o.x = pk_bf16(O0[dt][0] * inv * sw[0], O0[dt][1] * inv * sw[1]);
      o.y = pk_bf16(O0[dt][2] * inv * sw[2], O0[dt][3] * inv * sw[3]);
      *(uint2*)(YA + (long)tok * 512 + h * 128 + dv) = o;
    }
  }
}

template <int L>
DI void hyena_item(const Prm& p, int li, int ch, char* smem) {
  constexpr int CS = 2 * L + 8;
  constexpr int ZS = L + 8;
  constexpr int MT = L / 128;
  constexpr int MG = MT > 8 ? 8 : MT, NG = MT / MG;
  const int tid = mytid(), lane = tid & 63, wid = tid >> 6, fr = lane & 15, fq = lane >> 4;
  u16* cp = (u16*)smem;
  u16* zr = cp + 8 * CS;
  const u16* PH = (const u16*)(p.ws + OFF_AR) + (L == 2048 ? 0L : 32768L * 1536);
  const u16* G = (const u16*)(p.ws + (L == 2048 ? OFF_TAPL : OFF_TAPC));
  u16* YB = (u16*)(p.ws + OFF_Y + U38);
  const float* cw = p.hy_conv + (long)li * 3 * 1536;
  {
    float w0 = cw[1024 + ch], w1 = cw[1536 + 1024 + ch], w2 = cw[3072 + 1024 + ch];
    constexpr int NCH = (16 * L / 8) / 512;
    u32x4 cv[NCH];
    u16 pv[NCH], nv[NCH];
#pragma unroll
    for (int i = 0; i < NCH; ++i) {
      int id = tid + i * 512, b = id / (L / 8), s0 = (id % (L / 8)) * 8;
      const u16* row = PH + ((long)b * 1536 + 1024 + ch) * L + s0;
      cv[i] = *(const u32x4*)row;
      pv[i] = (s0 > 0) ? row[-1] : (u16)0;
      nv[i] = (s0 + 8 < L) ? row[8] : (u16)0;
    }
#pragma unroll
    for (int i = 0; i < NCH; ++i) {
      int id = tid + i * 512, b = id / (L / 8), s0 = (id % (L / 8)) * 8;
      float x[10];
      x[0] = bf2f(pv[i]);
      x[9] = bf2f(nv[i]);
#pragma unroll
      for (int w = 0; w < 4; ++w) {
        x[1 + 2 * w] = __uint_as_float(cv[i][w] << 16);
        x[2 + 2 * w] = __uint_as_float(cv[i][w] & 0xffff0000u);
      }
      float o[8];
#pragma unroll
      for (int e = 0; e < 8; ++e) o[e] = w0 * x[e] + w1 * x[e + 1] + w2 * x[e + 2];
      u32x4 r;
      r[0] = pk_bf16(o[7], o[6]); r[1] = pk_bf16(o[5], o[4]); r[2] = pk_bf16(o[3], o[2]); r[3] = pk_bf16(o[1], o[0]);
      *(u32x4*)(zr + b * ZS + L - 8 - s0) = r;
    }
  }
#pragma unroll
  for (int order = 0; order < 2; ++order) {
    {
      const u16* g = G + (long)(order * 512 + ch) * (2 * L);
      if (tid < 2 * L / 8) {
        const int i0 = tid * 8;
        u32x4 lo = *(const u32x4*)(g + i0);
        u32x4 hi = (i0 + 8 < 2 * L) ? *(const u32x4*)(g + i0 + 8) : u32x4{0u, 0u, 0u, 0u};
        unsigned D[8] = {lo[0], lo[1], lo[2], lo[3], hi[0], hi[1], hi[2], hi[3]};
#pragma unroll
        for (int c = 0; c < 8; ++c) {
          u32x4 o;
#pragma unroll
          for (int w = 0; w < 4; ++w) {
            if (c & 1) o[w] = (D[w + (c - 1) / 2] >> 16) | (D[w + (c + 1) / 2] << 16);
            else o[w] = D[w + c / 2];
          }
          *(u32x4*)(cp + c * CS + i0) = o;
        }
      }
    }
    __syncthreads();
    const float bias = p.hy_bias[(li * 2 + order) * 512 + ch];
    const int gcol = order * 512 + ch;
    const float w0 = cw[gcol], w1 = cw[1536 + gcol], w2 = cw[3072 + gcol];
    const int tq = wid * (L / 8) + fq * 4;
    const u16* xb = PH + ((long)fr * 1536 + gcol) * L + tq;
    const u16* zb = zr + fr * ZS + L - 1 - tq;
    unsigned zp[NG][MG][2];
#pragma unroll
    for (int grp = 0; grp < NG; ++grp) {
      f32x4 acc[MG];
#pragma unroll
      for (int m = 0; m < MG; ++m) acc[m] = f32x4{0.f, 0.f, 0.f, 0.f};
      const int tb = wid * (L / 8) + grp * MG * 16 + fr;
      if constexpr (MG == 8) {
        const int i00 = tb - fq * 8 - 7 + L, c0 = i00 & 7;
        const u16* ab = cp + c0 * CS + (i00 - c0);
        const u16* zbp = zr + fr * ZS + (L - 8 - fq * 8);
        bf16x8 W[16];
#pragma unroll 1
        for (int s0 = 0; s0 < L; s0 += 256) {
#pragma unroll
          for (int k = 0; k < 8; ++k) {
            const int sk = s0 + 32 * k;
            if (k == 0) {
#pragma unroll
              for (int m = 0; m < 8; ++m) W[m] = *(const bf16x8*)(ab + m * 16 - sk);
            }
            if (k < 7) {
              W[(16 - 2 * k - 2) & 15] = *(const bf16x8*)(ab - sk - 32);
              W[(16 - 2 * k - 1) & 15] = *(const bf16x8*)(ab - sk - 32 + 16);
            }
            bf16x8 bk = *(const bf16x8*)(zbp - sk);
#pragma unroll
            for (int m = 0; m < 8; ++m) acc[m] = MFMA(W[(m + 16 - 2 * k) & 15], bk, acc[m]);
          }
        }
      } else {
#pragma unroll 2
        for (int s0 = 0; s0 < L; s0 += 32) {
          bf16x8 bfr = *(const bf16x8*)(zr + fr * ZS + (L - 8 - s0 - fq * 8));
#pragma unroll
          for (int m = 0; m < MG; ++m) {
            int i0 = tb + m * 16 - s0 - fq * 8 - 7 + L;
            int c = i0 & 7;
            bf16x8 afr = *(const bf16x8*)(cp + c * CS + (i0 - c));
            acc[m] = MFMA(afr, bfr, acc[m]);
          }
        }
      }
#pragma unroll
      for (int m = 0; m < MG; ++m) {
        float r4[4];
#pragma unroll
        for (int j = 0; j < 4; ++j) {
          const int off = (grp * MG + m) * 16 + j;
          const int t = tq + off;
          float xa = bf2f(xb[off - 1]), xc = bf2f(xb[off]), xd = bf2f(xb[off + 1]);
          xa = (t > 0) ? xa : 0.f;
          xd = (t + 1 < L) ? xd : 0.f;
          float xg = w0 * xa + w1 * xc + w2 * xd;
          float zin = bf2f(zb[-off]);
          r4[j] = xg * (acc[m][j] + bias * zin);
        }
        zp[grp][m][0] = pk_bf16(r4[0], r4[1]);
        zp[grp][m][1] = pk_bf16(r4[2], r4[3]);
      }
    }
    __syncthreads();
#pragma unroll
    for (int grp = 0; grp < NG; ++grp)
#pragma unroll
      for (int m = 0; m < MG; ++m) {
        int t0 = wid * (L / 8) + (grp * MG + m) * 16 + fq * 4;
        uint2 w;
        w.x = (zp[grp][m][1] >> 16) | (zp[grp][m][1] << 16);
        w.y = (zp[grp][m][0] >> 16) | (zp[grp][m][0] << 16);
        *(uint2*)(zr + fr * ZS + L - 4 - t0) = w;
      }
  }
  __syncthreads();
  {
    u16* YBT = (u16*)(p.ws + OFF_AR + 5 * U38) + (L == 2048 ? 0L : 16L * 512 * 2048);
    constexpr int NCH = (16 * L / 8) / 512;
#pragma unroll
    for (int i = 0; i < NCH; ++i) {
      int id = tid + i * 512, b = id / (L / 8), t0 = (id % (L / 8)) * 8;
      u32x4 r = *(const u32x4*)(zr + b * ZS + L - 8 - t0);
      u32x4 o;
      o[0] = (r[3] >> 16) | (r[3] << 16);
      o[1] = (r[2] >> 16) | (r[2] << 16);
      o[2] = (r[1] >> 16) | (r[1] << 16);
      o[3] = (r[0] >> 16) | (r[0] << 16);
      *(u32x4*)(YBT + ((long)b * 512 + ch) * L + t0) = o;
    }
  }
  __syncthreads();
}

DI long ph_ytrans(const Prm& p, long base, bool lastl, char* smem) {
  u16* tl = (u16*)smem;
  const u16* YBT = (const u16*)(p.ws + OFF_AR + 5 * U38);
  u16* YB = (u16*)(p.ws + OFF_Y + U38);
  const int tid = mytid(), G = gridDim.x;
  const int total = lastl ? 4096 : 4608;
  auto srcp = [&](int it) -> const u16* {
    if (it < 4096) {
      int b = it >> 8, ct = (it >> 5) & 7, lt = it & 31;
      return YBT + ((long)b * 512 + ct * 64 + (tid >> 3)) * 2048 + lt * 64 + (tid & 7) * 8;
    } else {
      int i2 = it - 4096, b = i2 >> 5, ct = (i2 >> 2) & 7, lt = i2 & 3;
      return YBT + 16L * 512 * 2048 + ((long)b * 512 + ct * 64 + (tid >> 3)) * 256 + lt * 64 + (tid & 7) * 8;
    }
  };
  int it = first_item(base);
  u32x4 v = {0u, 0u, 0u, 0u};
  if (it < total) v = *(const u32x4*)srcp(it);
  for (; it < total; it += G) {
    *(u32x4*)(tl + (tid >> 3) * 72 + (tid & 7) * 8) = v;
    __syncthreads();
    if (it + G < total) v = *(const u32x4*)srcp(it + G);
    long tok0;
    int ct;
    if (it < 4096) { int b = it >> 8, lt = it & 31; ct = (it >> 5) & 7; tok0 = (long)b * 2048 + lt * 64; }
    else { int i2 = it - 4096, b = i2 >> 5, lt = i2 & 3; ct = (i2 >> 2) & 7; tok0 = (long)T_LAT + b * 256 + lt * 64; }
    const int lrow = tid >> 3, cc = tid & 7;
    u32x4 o;
#pragma unroll
    for (int w = 0; w < 4; ++w) {
      unsigned lo = tl[(cc * 8 + 2 * w) * 72 + lrow], hi = tl[(cc * 8 + 2 * w + 1) * 72 + lrow];
      o[w] = lo | (hi << 16);
    }
    *(u32x4*)(YB + (tok0 + lrow) * 512 + ct * 64 + cc * 8) = o;
    __syncthreads();
  }
  return base + total;
}

DI void ph_merge(const Prm& p, char* smem, bool lastl) {
  const int tid = mytid(), lane = tid & 63, wid = tid >> 6;
  const int wm = wid >> 1, wn = wid & 1, fr = lane & 15, fq = lane >> 4;
  const u16* H = (const u16*)(p.ws + OFF_HBF);
  const u16* Y = (const u16*)(p.ws + OFF_Y);
  const u16* WG = (const u16*)(p.ws + OFF_WB) + WO_G;
  const u16* WBr = (const u16*)(p.ws + OFF_WB) + WO_B;
  u16* MG = (u16*)(p.ws + OFF_AR);
  const int NT = (lastl ? 256 : 288) * 8, G = gridDim.x;
  Stg r0, r1;
  bool pre = false;
  for (int t = mybid(); t < NT; t += G) {
    const int mt = t >> 3, nt = t & 7;
    const bool hn = t + G < NT;
    const int mt2 = (t + G) >> 3, nt2 = (t + G) & 7;
    f32x4 acc[2][4], g[2][4], y[2][4];
#pragma unroll
    for (int a = 0; a < 2; ++a)
#pragma unroll
      for (int b = 0; b < 4; ++b) acc[a][b] = f32x4{0.f, 0.f, 0.f, 0.f};
    const u16* gA = H + (long)mt * 128 * 1024;
    for (int n = 0; n < 4; ++n) {
      const u16* gB = WG + ((long)n * 1024 + nt * 128) * 1024;
      const u16* yA = Y + (long)n * (T_ALL * 512L) + (long)mt * 128 * 512;
      const u16* yB = WBr + ((long)n * 1024 + nt * 128) * 512;
      gemm_tile<2>(g, gA, 1024, gB, 1024, 1024, smem, r0, r1, pre, yA, 512, yB, 512);
      const u16* nxA = (n < 3) ? gA : (hn ? H + (long)mt2 * 128 * 1024 : nullptr);
      const u16* nxB = (n < 3) ? WG + ((long)(n + 1) * 1024 + nt * 128) * 1024 : WG + ((long)nt2 * 128) * 1024;
      gemm_tile<2>(y, yA, 512, yB, 512, 512, smem, r0, r1, true, nxA, 1024, nxB, 1024);
      pre = true;
#pragma unroll
      for (int a = 0; a < 2; ++a)
#pragma unroll
        for (int b = 0; b < 4; ++b)
#pragma unroll
          for (int j = 0; j < 4; ++j) acc[a][b][j] += y[a][b][j] * __builtin_amdgcn_rcpf(1.f + __expf(-g[a][b][j]));
    }
    pre = hn;
#pragma unroll
    for (int a = 0; a < 2; ++a)
#pragma unroll
      for (int b = 0; b < 4; ++b) {
        int r = wm * 32 + a * 16 + fr, c = wn * 64 + b * 16 + fq * 4;
        uint2 o;
        o.x = pk_bf16(acc[a][b][0], acc[a][b][1]);
        o.y = pk_bf16(acc[a][b][2], acc[a][b][3]);
        *(uint2*)(MG + ((long)mt * 128 + r) * 1024 + nt * 128 + c) = o;
      }
  }
}

DI void run_phase(const Prm& p, int ph, char* smem) {
  if (ph == 0) { ph_init(p, smem); return; }
  const int li = (ph - 1) / 14, k = (ph - 1) % 14;
  const u16* WB = (const u16*)(p.ws + OFF_WB);
  const u16* HB = (const u16*)(p.ws + OFF_HBF);
  const float* MOD = (const float*)(p.ws + OFF_MOD);
  u16* AR = (u16*)(p.ws + OFF_AR);
  u16* Yb = (u16*)(p.ws + OFF_Y);
  const int G = gridDim.x;
  TD d;
  d.split = 0; d.scale = 1.f; d.mode = 0; d.tok0 = 0; d.col0 = 0; d.g = MOD;
  switch (k) {
    case 0: {
      u16* W = (u16*)(p.ws + OFF_WB);
      long base = 0;
      base = tr_job(base, p.w_in + (long)li * 1024 * NIN, 1024, NIN, W + WO_IN, 1, smem);
      base = tr_job(base, p.w_gate + (long)li * 4 * 1048576, 1024, 1024, W + WO_G, 4, smem);
      base = tr_job(base, p.w_branch + (long)li * 4 * 524288, 512, 1024, W + WO_B, 4, smem);
      base = tr_job(base, p.w_o + (long)li * 1048576, 1024, 1024, W + WO_O, 1, smem);
      base = tr_job(base, p.w_mlp1 + (long)li * 4194304, 1024, 4096, W + WO_1, 1, smem);
      base = tr_job(base, p.w_mlp2 + (long)li * 4194304, 4096, 1024, W + WO_2, 1, smem);
      ph_taps1(p, li, base, smem);
      ph_norm(p, li, 0);
    } break;
    case 1: {
      auto dec = [&](int t, TD& o) {
        o.lda = 1024; o.ldb = 1024; o.K = 1024; o.mode = 0;
        if (t < 1728) {
          int mt = t / 12, nt = t % 12;
          o.A = HB + (long)mt * 256 * 1024; o.B = WB + WO_IN + (long)(3584 + nt * 128) * 1024;
          o.C = AR + (long)mt * 256 * 1536 + nt * 128; o.ldc = 1536;
        } else if (t < 2304) {
          int t2 = t - 1728, mt = t2 >> 2, nt = t2 & 3;
          o.A = HB + (long)mt * 256 * 1024; o.B = WB + WO_IN + (long)(5120 + nt * 128) * 1024;
          o.C = Yb + 3 * (U38 / 2) + (long)mt * 256 * 512 + nt * 128; o.ldc = 512;
        } else {
          int mt = t - 2304;
          o.A = HB + (long)mt * 256 * 1024; o.B = WB + WO_IN + (long)5632 * 1024;
          o.C = (u16*)((float*)(p.ws + OFF_PDAB) + (long)mt * 256 * 16); o.ldc = 16; o.mode = 3;
        }
      };
      {
        Stg r0, r1;
        bool pre = false;
        TD dn = d;
        int t = mybid();
        if (t < 2448) dec(t, d);
        for (; t < 2448; t += G) {
          const bool hn = t + G < 2448;
          if (hn) dec(t + G, dn);
          run_tile2<4>(p, d, smem, r0, r1, pre, hn ? dn.A : nullptr, dn.lda, dn.B, dn.ldb);
          pre = hn;
          d = dn;
        }
      }
      ph_taps2(p, 2448, smem);
    } break;
    case 2: ph_dncl(p, li, smem); break;
    case 3: ph_dnscan(p, smem); break;
    case 4: {
      {
        Stg r0, r1;
        bool pre = false;
        for (int t = mybid(); t < 1152; t += G) {
          int mt = t >> 3, nt = t & 7;
          const bool hn = t + G < 1152;
          int mt2 = (t + G) >> 3, nt2 = (t + G) & 7;
          d.lda = 1024; d.ldb = 1024; d.K = 1024;
          d.A = HB + (long)mt * 256 * 1024; d.B = WB + WO_IN + (long)(nt * 128) * 1024;
          d.C = AR + 3 * (U38 / 2); d.ldc = 0; d.mode = 4; d.tok0 = mt * 256; d.col0 = nt;
          d.g = p.qk_gain + li * 128;
          run_tile2<4>(p, d, smem, r0, r1, pre, hn ? HB + (long)mt2 * 256 * 1024 : nullptr, 1024,
                    WB + WO_IN + (long)(nt2 * 128) * 1024, 1024);
          pre = hn;
        }
      }
      ph_dnfin(p, li);
    } break;
    case 5: {
      u16* VT = AR + 5 * (U38 / 2);
      u16* PF = AR + 6 * (U38 / 2);
      auto dec = [&](int t, TD& o) {
        o.lda = 1024; o.ldb = 1024; o.K = 1024;
        if (t < 512) {
          int b = t >> 5, r = t & 31, mt = r >> 4, nt = r & 15;
          o.A = WB + WO_IN + (long)(1024 + mt * 256) * 1024; o.B = HB + ((long)b * 2048 + nt * 128) * 1024;
          o.C = VT + ((long)b * 512 + mt * 256) * 2304 + 256 + nt * 128; o.ldc = 2304;
        } else if (t < 576) {
          int t2 = t - 512, b = t2 >> 2, r = t2 & 3, mt = r >> 1, nt = r & 1;
          o.A = WB + WO_IN + (long)(1024 + mt * 256) * 1024; o.B = HB + ((long)T_LAT + b * 256 + nt * 128) * 1024;
          o.C = VT + ((long)b * 512 + mt * 256) * 2304 + nt * 128; o.ldc = 2304;
        } else {
          int t2 = t - 576, mt = t2 >> 2, nt = t2 & 3;
          o.A = HB + (long)mt * 256 * 1024; o.B = WB + WO_IN + (long)(3072 + nt * 128) * 1024;
          o.C = PF + (long)mt * 256 * 512 + nt * 128; o.ldc = 512;
        }
      };
      {
        Stg r0, r1;
        bool pre = false;
        TD dn = d;
        int t = mybid();
        if (t < 1152) dec(t, d);
        for (; t < 1152; t += G) {
          const bool hn = t + G < 1152;
          if (hn) dec(t + G, dn);
          run_tile2<4>(p, d, smem, r0, r1, pre, hn ? dn.A : nullptr, dn.lda, dn.B, dn.ldb);
          pre = hn;
          d = dn;
        }
      }
    } break;
    case 6: {
      ph_attn(p, li, 0, smem);
      auto dec = [&](int t, TD& o) {
        o.lda = 1024; o.ldb = 1024; o.K = 1024;
        if (t < 1536) {
          int b = t / 96, r = t % 96, mt = r >> 4, nt = r & 15;
          o.A = WB + WO_IN + (long)(1536 + mt * 256) * 1024; o.B = HB + ((long)b * 2048 + nt * 128) * 1024;
          o.C = AR + ((long)b * 1536 + mt * 256) * 2048 + nt * 128; o.ldc = 2048;
        } else {
          int t2 = t - 1536, b = t2 / 12, r = t2 % 12, mt = r >> 1, nt = r & 1;
          o.A = WB + WO_IN + (long)(1536 + mt * 256) * 1024; o.B = HB + ((long)T_LAT + b * 256 + nt * 128) * 1024;
          o.C = AR + 32768L * 1536 + ((long)b * 1536 + mt * 256) * 256 + nt * 128; o.ldc = 256;
        }
      };
      {
        Stg r0, r1;
        bool pre = false;
        TD dn = d;
        int t = first_item(1152);
        if (t < 1728) dec(t, d);
        for (; t < 1728; t += G) {
          const bool hn = t + G < 1728;
          if (hn) dec(t + G, dn);
          run_tile2<4>(p, d, smem, r0, r1, pre, hn ? dn.A : nullptr, dn.lda, dn.B, dn.ldb);
          pre = hn;
          d = dn;
        }
      }
    } break;
    case 7: {
#if !defined(TESTSEL) || TESTSEL == 1
      for (int it = mybid(); it < 512; it += G) hyena_item<2048>(p, li, it, smem);
#endif
#if !defined(TESTSEL) || TESTSEL == 2
      if (li < 3)
        for (int it = mybid(); it < 512; it += G) hyena_item<256>(p, li, it, smem);
#endif
#if !defined(TESTSEL) || TESTSEL == 3
      const u16* PF = AR + 6 * (U38 / 2);
      u16* WF = AR + 3 * (U38 / 2);
      const u16* DCm = (const u16*)(p.ws + OFF_DC);
      auto dec = [&](int t, TD& o) {
        o.A = DCm; o.lda = 128; o.ldb = 512; o.K = 128;
        if (t < 1024) {
          int bg = t >> 4, nt = t & 15, b = bg >> 2, g = bg & 3;
          o.B = PF + ((long)b * 2048 + nt * 128) * 512 + g * 128;
          o.C = WF + ((long)b * 512 + g * 128) * 4096 + nt * 128; o.ldc = 4096; o.split = 2048;
        } else {
          int t2 = t - 1024, bg = t2 >> 1, nt = t2 & 1, b = bg >> 2, g = bg & 3;
          o.B = PF + ((long)T_LAT + b * 256 + nt * 128) * 512 + g * 128;
          o.C = WF + 16L * 512 * 4096 + ((long)b * 512 + g * 128) * 512 + nt * 128; o.ldc = 512; o.split = 256;
        }
      };
      {
        const int NT7 = (li == 3 ? 1024 : 1152);
        Stg r0, r1;
        bool pre = false;
        TD dn = d;
        int t = mybid();
        if (t < NT7) dec(t, d);
        for (; t < NT7; t += G) {
          const bool hn = t + G < NT7;
          if (hn) dec(t + G, dn);
          run_tile2<4>(p, d, smem, r0, r1, pre, hn ? dn.A : nullptr, dn.lda, dn.B, dn.ldb);
          pre = hn;
          d = dn;
        }
      }
#endif
    } break;
    case 8: {
      const u16* WF = AR + 3 * (U38 / 2);
      u16* YF = Yb + 2 * (U38 / 2);
      d.scale = 1.f / 512.f;
      for (int t = mybid(); t < (li == 3 ? 512 : 576); t += G) {
        if (t < 512) {
          int b = t >> 5, r = t & 31, mt = r >> 2, nt = r & 3;
          d.A = (const u16*)(p.ws + OFF_DL) + (long)mt * 256 * 4096; d.lda = 4096;
          d.B = WF + ((long)b * 512 + nt * 128) * 4096; d.ldb = 4096; d.K = 4096;
          d.C = YF + ((long)b * 2048 + mt * 256) * 512 + nt * 128; d.ldc = 512;
        } else {
          int t2 = t - 512, b = t2 >> 2, nt = t2 & 3;
          d.A = (const u16*)(p.ws + OFF_DLC); d.lda = 512;
          d.B = WF + 16L * 512 * 4096 + ((long)b * 512 + nt * 128) * 512; d.ldb = 512; d.K = 512;
          d.C = YF + ((long)T_LAT + b * 256) * 512 + nt * 128; d.ldc = 512;
        }
        run_tile(p, d, smem);
      }
      ph_ytrans(p, 576, li == 3, smem);
    } break;
    case 9: ph_merge(p, smem, li == 3); break;
    case 10: {
      d.mode = 2;
      const int NF = 1024, NTOT = (li == 3) ? 1024 : 1024 + 256;
      auto dec = [&](int t, TD& o) {
        int full = t < NF ? t : NF + ((t - NF) >> 1), half = t < NF ? 0 : ((t - NF) & 1);
        int mt = full >> 3, nt = full & 7;
        o.A = AR + ((long)mt * 256 + half * 128) * 1024; o.lda = 1024;
        o.B = WB + WO_O + (long)nt * 128 * 1024; o.ldb = 1024; o.K = 1024;
        o.tok0 = mt * 256 + half * 128; o.col0 = nt * 128;
        int bb = o.tok0 < T_LAT ? (o.tok0 >> 11) : 16;
        o.g = MOD + ((long)li * 17 + bb) * 6144 + 2 * 1024;
      };
      Stg r0, r1;
      bool pre = false;
      TD dn = d;
      int t = mybid();
      if (t < NTOT) dec(t, d);
      for (; t < NTOT; t += G) {
        const bool hn = t + G < NTOT;
        if (hn) dec(t + G, dn);
        if (t < NF) run_tile2<4>(p, d, smem, r0, r1, pre, hn ? dn.A : nullptr, dn.lda, dn.B, dn.ldb);
        else run_tile2<2>(p, d, smem, r0, r1, pre, hn ? dn.A : nullptr, dn.lda, dn.B, dn.ldb);
        pre = hn;
        d = dn;
      }
    } break;
    case 11: ph_norm(p, li, 1); break;
    case 12: {
      d.mode = 1;
      const int NT12 = (li == 3 ? 4096 : 4608);
      Stg r0, r1;
      bool pre = false;
      for (int t = mybid(); t < NT12; t += G) {
        int mt = ((t >> 7) << 2) + ((t & 31) >> 3), nt = (((t >> 5) & 3) << 3) + (t & 7);
        d.A = HB + (long)mt * 256 * 1024; d.lda = 1024; d.B = WB + WO_1 + (long)nt * 128 * 1024; d.ldb = 1024; d.K = 1024;
        d.C = Yb + (long)mt * 256 * 4096 + nt * 128; d.ldc = 4096;
        const bool hn = t + G < NT12;
        int mt2 = (((t + G) >> 7) << 2) + (((t + G) & 31) >> 3), nt2 = ((((t + G) >> 5) & 3) << 3) + ((t + G) & 7);
        run_tile2<4>(p, d, smem, r0, r1, pre, hn ? HB + (long)mt2 * 256 * 1024 : nullptr, 1024,
                  WB + WO_1 + (long)nt2 * 128 * 1024, 1024);
        pre = hn;
      }
    } break;
    case 13: {
      d.mode = 2;
      const int NF = 1024, NTOT = (li == 3) ? 1024 : 1024 + 256;
      auto dec = [&](int t, TD& o) {
        int full = t < NF ? t : NF + ((t - NF) >> 1), half = t < NF ? 0 : ((t - NF) & 1);
        int mt = full >> 3, nt = full & 7;
        o.A = Yb + ((long)mt * 256 + half * 128) * 4096; o.lda = 4096;
        o.B = WB + WO_2 + (long)nt * 128 * 4096; o.ldb = 4096; o.K = 4096;
        o.tok0 = mt * 256 + half * 128; o.col0 = nt * 128;
        int bb = o.tok0 < T_LAT ? (o.tok0 >> 11) : 16;
        o.g = MOD + ((long)li * 17 + bb) * 6144 + 5 * 1024;
      };
      Stg r0, r1;
      bool pre = false;
      TD dn = d;
      int t = mybid();
      if (t < NTOT) dec(t, d);
      for (; t < NTOT; t += G) {
        const bool hn = t + G < NTOT;
        if (hn) dec(t + G, dn);
        if (t < NF) run_tile2<4>(p, d, smem, r0, r1, pre, hn ? dn.A : nullptr, dn.lda, dn.B, dn.ldb);
        else run_tile2<2>(p, d, smem, r0, r1, pre, hn ? dn.A : nullptr, dn.lda, dn.B, dn.ldb);
        pre = hn;
        d = dn;
      }
    } break;
  }
}


#define XB_TMO      128
#define XB_XCNT(j)  (256  + 64 * (j))
#define XB_XSUB(j)  (1280 + 64 * (j))
#define XB_XGEN(j)  (2304 + 64 * (j))
#define XB_TOP      3328
#define XB_TOPGEN   3392
#define XCD_BAR_WORDS 3456
#define XB_SPIN_CAP (1u << 20)
#define LAS __attribute__((address_space(3)))
DI unsigned xb_ld(unsigned* p) { return __hip_atomic_load(p, __ATOMIC_RELAXED, __HIP_MEMORY_SCOPE_AGENT); }
DI unsigned xb_add(unsigned* p, unsigned v) { return __hip_atomic_fetch_add(p, v, __ATOMIC_RELAXED, __HIP_MEMORY_SCOPE_AGENT); }
DI unsigned xb_xcc_id() { return (unsigned)__builtin_amdgcn_s_getreg((3 << 11) | 20) & 0xFu; }
#define XB_SPIN(cond, bar) do { unsigned _sp = 0; while (cond) { __builtin_amdgcn_s_sleep(1); \
    if ((++_sp & 255u) == 0u) { if (xb_ld(&(bar)[XB_TMO])) break; if (_sp > XB_SPIN_CAP) { atomicAdd(&(bar)[XB_TMO], 1u); break; } } } } while (0)
struct XcdBarrier { unsigned* bar; unsigned x; volatile LAS unsigned* st; };
DI XcdBarrier xcd_barrier_post(unsigned* bar, volatile LAS unsigned* st) {
  XcdBarrier b; b.bar = bar; b.x = xb_xcc_id(); b.st = st;
  if (threadIdx.x == 0) (void)xb_add(&bar[XB_XCNT(b.x)], 1u);
  return b;
}
DI void xcd_barrier_complete(unsigned* bar, unsigned x, unsigned& nloc, unsigned& nx) {
  const unsigned G = gridDim.x * gridDim.y * gridDim.z;
  unsigned sum, cnt, mine, sp = 0u;
  for (;;) {
    sum = 0u; cnt = 0u; mine = 0u;
#pragma unroll
    for (unsigned j = 0; j < 16; ++j) { const unsigned c = xb_ld(&bar[XB_XCNT(j)]); sum += c; cnt += (c > 0u) ? 1u : 0u; mine = (j == x) ? c : mine; }
    if (sum == G) break;
    __builtin_amdgcn_s_sleep(1);
    if ((++sp & 255u) == 0u) { if (xb_ld(&bar[XB_TMO])) break; if (sp > XB_SPIN_CAP) { atomicAdd(&bar[XB_TMO], 1u); break; } }
  }
  nloc = mine > 0u ? mine : 1u; nx = cnt > 0u ? cnt : 1u;
}
DI void xcd_barrier(const XcdBarrier& b) {
  asm volatile("s_waitcnt vmcnt(0)" ::: "memory");
  __syncthreads();
  if (threadIdx.x == 0) {
    unsigned* bar = b.bar;
    __builtin_amdgcn_s_waitcnt(0);
    unsigned nloc = b.st[0], nx = b.st[1];
    if (nloc == 0u) { xcd_barrier_complete(bar, b.x, nloc, nx); b.st[0] = nloc; b.st[1] = nx; }
    const unsigned old = xb_add(&bar[XB_XSUB(b.x)], 1u);
    const unsigned gen = old / nloc;
    if (old + 1u == (gen + 1u) * nloc) {
      __builtin_amdgcn_fence(__ATOMIC_RELEASE, "agent");
      asm volatile("s_waitcnt vmcnt(0)" ::: "memory");
      const unsigned og = xb_add(&bar[XB_TOP], 1u);
      const unsigned tg = og / nx;
      if (og + 1u == (tg + 1u) * nx) xb_add(&bar[XB_TOPGEN], 1u);
      else XB_SPIN(xb_ld(&bar[XB_TOPGEN]) == tg, bar);
      __builtin_amdgcn_fence(__ATOMIC_ACQUIRE, "agent");
      xb_add(&bar[XB_XGEN(b.x)], 1u);
      asm volatile("s_waitcnt vmcnt(0)" ::: "memory");
    } else {
      XB_SPIN(xb_ld(&bar[XB_XGEN(b.x)]) == gen, bar);
      __builtin_amdgcn_fence(__ATOMIC_ACQUIRE, "agent");
      asm volatile("s_waitcnt vmcnt(0)" ::: "memory");
    }
  }
  __syncthreads();
}

extern __shared__ __attribute__((aligned(16))) char dyn_smem[];

__global__ void __launch_bounds__(512) mega(Prm p, int lo, int hi) {
  __shared__ uint4 xb_words;
  if (threadIdx.x == 0) xb_words = make_uint4(0u, 0u, 0u, 0u);
  __syncthreads();
  XcdBarrier xb = xcd_barrier_post((unsigned*)(p.ws + OFF_BAR), (volatile LAS unsigned*)&xb_words);
#ifdef ONLYK
  run_phase(p, ONLYK, dyn_smem);
#else
  for (int ph = lo; ph <= hi; ++ph) {
    long z = 0;
    asm volatile("" : "+s"(z));
    Prm q;
#define LP(f) q.f = p.f + z
    LP(x); LP(c); LP(ctx); LP(c_ctx); LP(w_ada); LP(b_ada); LP(norm1); LP(norm2); LP(w_in); LP(qk_gain); LP(lam);
    LP(subln); LP(hy_conv); LP(hy_w1); LP(hy_b1); LP(hy_freq); LP(hy_w2); LP(hy_b2); LP(hy_w3); LP(hy_bias);
    LP(dn_conv); LP(dn_a_log); LP(dn_dt_bias); LP(dn_norm); LP(w_gate); LP(w_branch); LP(w_o); LP(w_mlp1); LP(w_mlp2);
    LP(out); LP(ws);
#undef LP
    run_phase(q, ph, dyn_smem);
#ifdef PROBEK
    if (ph > 0 && (ph - 1) % 14 == PROBEK) { cg::this_grid().sync(); run_phase(q, ph, dyn_smem); }
#endif
    if (ph < hi) {
      if (ph == lo) cg::this_grid().sync();
      else xcd_barrier(xb);
    }
  }
#endif
}

extern "C" void kernel_launch(void* const* d_in, const int* in_sizes, int n_in, void* d_out, int out_size, void* d_ws,
                              size_t ws_size, hipStream_t stream) {
  static int grid_blocks = 0;
  if (!grid_blocks) {
    hipFuncSetAttribute((const void*)mega, hipFuncAttributeMaxDynamicSharedMemorySize, LDS_BYTES);
    int dev = 0, cus = 0, per_cu = 0;
    hipGetDevice(&dev);
    hipDeviceGetAttribute(&cus, hipDeviceAttributeMultiprocessorCount, dev);
    hipOccupancyMaxActiveBlocksPerMultiprocessor(&per_cu, mega, 512, LDS_BYTES);
    if (per_cu < 1) per_cu = 1;
    grid_blocks = cus * per_cu;
    if (ws_size < (size_t)WS_TOTAL) fprintf(stderr, "workspace too small: %zu < %ld\n", ws_size, (long)WS_TOTAL);
  }
  Prm p;
  const float** pp = (const float**)&p;
  for (int i = 0; i < 29; ++i) pp[i] = (const float*)d_in[i];
  p.out = (float*)d_out;
  p.ws = (char*)d_ws;
#if MULTI
  for (int ph = 0; ph < NPHASE; ++ph) hipLaunchKernelGGL(mega, dim3(grid_blocks), dim3(512), LDS_BYTES, stream, p, ph, ph);
#else
  int lo = 0, hi = NPHASE - 1;
  hipMemsetAsync((char*)d_ws + OFF_BAR, 0, XCD_BAR_WORDS * 4, stream);
  void* args[] = {&p, &lo, &hi};
  hipError_t e = hipLaunchCooperativeKernel((void*)mega, dim3(grid_blocks), dim3(512), args, LDS_BYTES, stream);
  if (e != hipSuccess) fprintf(stderr, "cooperative launch failed: %s (grid %d)\n", hipGetErrorString(e), grid_blocks);
#endif
}
```

```cpp
#include <hip/hip_runtime.h>
#include <hip/hip_cooperative_groups.h>
#include <stdint.h>
#include <stdio.h>
namespace cg = cooperative_groups;

typedef unsigned short u16;
typedef __attribute__((ext_vector_type(8))) short bf16x8;
typedef __attribute__((ext_vector_type(4))) float f32x4;
#define MFMA(a, b, c) __builtin_amdgcn_mfma_f32_16x16x32_bf16(a, b, c, 0, 0, 0)
#define DI __device__ __forceinline__

#ifndef MULTI
#define MULTI 0
#endif

constexpr int T_LAT = 32768, T_ALL = 36864;
constexpr int NIN = 5648;
constexpr long U38 = 37748736L;
constexpr long OFF_XC = 0;
constexpr long OFF_WB = OFF_XC + 16777216L;
constexpr long OFF_HBF = OFF_WB + 43024384L;
constexpr long OFF_MOD = OFF_HBF + 75497472L;
constexpr long OFF_TAPL = OFF_MOD + 1671168L;
constexpr long OFF_TAPC = OFF_TAPL + 8388608L;
constexpr long OFF_DL = OFF_TAPC + 1048576L;
constexpr long OFF_DLC = OFF_DL + 16777216L;
constexpr long OFF_DC = OFF_DLC + 262144L;
constexpr long OFF_PDAB = OFF_DC + 65536L;
constexpr long OFF_GC = OFF_PDAB + 2359296L;
constexpr long OFF_BETA = OFF_GC + 2359296L;
constexpr long OFF_Y = OFF_BETA + 2359296L;
constexpr long OFF_AR = OFF_Y + 4 * U38;
constexpr long OFF_ROPE = OFF_AR + 7 * U38;
constexpr long OFF_BAR = OFF_ROPE + 2 * 262144L;
constexpr long WS_TOTAL = OFF_BAR + 16384L;
constexpr long WO_IN = 0, WO_G = 5783552L, WO_B = 9977856L, WO_O = 12075008L, WO_1 = 13123584L, WO_2 = 17317888L;
constexpr int LDS_BYTES = 139264;
constexpr int NPHASE = 1 + 4 * 14;

struct Prm {
  const float *x, *c, *ctx, *c_ctx, *w_ada, *b_ada, *norm1, *norm2, *w_in, *qk_gain, *lam, *subln, *hy_conv, *hy_w1,
      *hy_b1, *hy_freq, *hy_w2, *hy_b2, *hy_w3, *hy_bias, *dn_conv, *dn_a_log, *dn_dt_bias, *dn_norm, *w_gate,
      *w_branch, *w_o, *w_mlp1, *w_mlp2;
  float* out;
  char* ws;
};

DI int mytid() {
  int t = threadIdx.x;
  asm volatile("" : "+v"(t));
  return t;
}
DI int mybid() {
  int t = blockIdx.x;
  const int G = gridDim.x;
  if ((G & 7) == 0) t = (t & 7) * (G >> 3) + (t >> 3);
  asm volatile("" : "+s"(t));
  return t;
}
DI void lds_barrier() {
  asm volatile("s_waitcnt lgkmcnt(0)" ::: "memory");
  __builtin_amdgcn_s_barrier();
  asm volatile("" ::: "memory");
}
typedef __bf16 bf16x2_t __attribute__((ext_vector_type(2)));
typedef float f32x2_t __attribute__((ext_vector_type(2)));
DI unsigned pk_bf16(float a, float b) {
  f32x2_t v = {a, b};
  bf16x2_t h = __builtin_convertvector(v, bf16x2_t);
  return *(unsigned*)&h;
}
DI u16 f2bf(float f) {
  __bf16 h = (__bf16)f;
  return *(u16*)&h;
}
DI float bf2f(u16 h) { return __uint_as_float(((unsigned)h) << 16); }
DI float wsum(float v) {
  for (int o = 32; o; o >>= 1) v += __shfl_xor(v, o);
  return v;
}
DI float wmax(float v) {
  for (int o = 32; o; o >>= 1) v = fmaxf(v, __shfl_xor(v, o));
  return v;
}
DI float siluf(float v) { return v / (1.f + __expf(-v)); }
DI float sigmf(float v) { return 1.f / (1.f + __expf(-v)); }
DI float* xrow(const Prm& p, int tok) {
  return tok < T_LAT ? p.out + (long)tok * 1024 : (float*)(p.ws + OFF_XC) + (long)(tok - T_LAT) * 1024;
}
DI int first_item(long base) {
  int G = gridDim.x;
  return (int)(((long)mybid() + G - (base % G)) % G);
}
DI int tokof(int b, int P) { return P < 256 ? T_LAT + b * 256 + P : b * 2048 + (P - 256); }

typedef __attribute__((ext_vector_type(4))) unsigned u32x4;
struct Stg { u32x4 a0, a1, a2, a3, b0, b1; };
template <int NA>
DI void g_load(Stg& r, const u16* Ap, long lda, const u16* Bp, long ldb, int k0) {
  r.a0 = *(const u32x4*)(Ap + k0);
  r.a1 = *(const u32x4*)(Ap + 64 * lda + k0);
  if constexpr (NA == 4) {
    r.a2 = *(const u32x4*)(Ap + 128 * lda + k0);
    r.a3 = *(const u32x4*)(Ap + 192 * lda + k0);
  }
  r.b0 = *(const u32x4*)(Bp + k0);
  r.b1 = *(const u32x4*)(Bp + 64 * ldb + k0);
}
template <int NA, int TM>
DI void s_store(const Stg& r, u16* ns_) {
  *(u32x4*)(ns_) = r.a0;
  *(u32x4*)(ns_ + 64 * 80) = r.a1;
  if constexpr (NA == 4) {
    *(u32x4*)(ns_ + 128 * 80) = r.a2;
    *(u32x4*)(ns_ + 192 * 80) = r.a3;
  }
  *(u32x4*)(ns_ + TM * 80) = r.b0;
  *(u32x4*)(ns_ + TM * 80 + 64 * 80) = r.b1;
}
template <int MI>
DI void t_compute(f32x4 (&acc)[MI][4], const u16* as, const u16* bs, int wm, int wn, int fr, int fq) {
#pragma unroll
  for (int ks = 0; ks < 2; ++ks) {
    bf16x8 a[MI], b[4];
#pragma unroll
    for (int mi = 0; mi < MI; ++mi) a[mi] = *(const bf16x8*)(as + (wm * MI * 16 + mi * 16 + fr) * 80 + ks * 32 + fq * 8);
#pragma unroll
    for (int ni = 0; ni < 4; ++ni) b[ni] = *(const bf16x8*)(bs + (wn * 64 + ni * 16 + fr) * 80 + ks * 32 + fq * 8);
#pragma unroll
    for (int mi = 0; mi < MI; ++mi)
#pragma unroll
      for (int ni = 0; ni < 4; ++ni) acc[mi][ni] = MFMA(b[ni], a[mi], acc[mi][ni]);
  }
}
template <int MI>
DI void gemm_tile(f32x4 (&acc)[MI][4], const u16* __restrict__ A, long lda, const u16* __restrict__ B, long ldb, int K,
                  char* smem, Stg& r0, Stg& r1, bool pre, const u16* nA, long nlda, const u16* nB, long nldb) {
  constexpr int TM = MI * 64;
  constexpr int STAGE = (TM + 128) * 80;
  constexpr int NA = TM * 8 / 512;
  u16* s = (u16*)smem;
  const int tid = mytid(), lane = tid & 63, wid = tid >> 6;
  const int wm = wid >> 1, wn = wid & 1, fr = lane & 15, fq = lane >> 4;
  const long to_a = (long)(tid >> 3), to_c = (tid & 7) * 8;
  const u16* Ap = A + to_a * lda + to_c;
  const u16* Bp = B + to_a * ldb + to_c;
  const u16* nAp = nA + to_a * nlda + to_c;
  const u16* nBp = nB + to_a * nldb + to_c;
  const int so = (tid >> 3) * 80 + (tid & 7) * 8;
#define GLOAD(r, k0) g_load<NA>(r, Ap, lda, Bp, ldb, (k0))
#define NLOAD(r, k0) g_load<NA>(r, nAp, nlda, nBp, nldb, (k0))
#define SSTORE(r, st) s_store<NA, TM>(r, s + (st) * STAGE + so)
#define COMPUTE(st) t_compute<MI>(acc, s + (st) * STAGE, s + (st) * STAGE + TM * 80, wm, wn, fr, fq)
#pragma unroll
  for (int mi = 0; mi < MI; ++mi)
#pragma unroll
    for (int ni = 0; ni < 4; ++ni) acc[mi][ni] = f32x4{0.f, 0.f, 0.f, 0.f};
  const int nk = K >> 6;
  if (!pre) {
    GLOAD(r0, 0);
    GLOAD(r1, 64);
  }
  SSTORE(r0, 0);
  lds_barrier();
  for (int kt = 0; kt < nk; kt += 2) {
    if (kt + 2 < nk) GLOAD(r0, (kt + 2) << 6);
    else if (nA) NLOAD(r0, 0);
    COMPUTE(0);
    SSTORE(r1, 1);
    lds_barrier();
    if (kt + 3 < nk) GLOAD(r1, (kt + 3) << 6);
    else if (nA) NLOAD(r1, 64);
    COMPUTE(1);
    if (kt + 2 < nk) SSTORE(r0, 0);
    lds_barrier();
  }
#undef GLOAD
#undef NLOAD
#undef SSTORE
#undef COMPUTE
}

struct TD {
  const u16* A;
  const u16* B;
  u16* C;
  long lda, ldb, ldc;
  int K;
  int mode;
  int split;
  float scale;
  int tok0, col0;
  const float* g;
};

template <int MI = 4>
DI void run_tile2(const Prm& p, const TD& d, char* smem, Stg& r0, Stg& r1, bool pre, const u16* nA, long nlda,
                 const u16* nB, long nldb);
DI void run_tile(const Prm& p, const TD& d, char* smem) {
  Stg r0, r1;
  run_tile2<4>(p, d, smem, r0, r1, false, nullptr, 0, nullptr, 0);
}
template <int MI>
DI void run_tile2(const Prm& p, const TD& d, char* smem, Stg& r0, Stg& r1, bool pre, const u16* nA, long nlda,
                 const u16* nB, long nldb) {
  f32x4 acc[MI][4];
  gemm_tile<MI>(acc, d.A, d.lda, d.B, d.ldb, d.K, smem, r0, r1, pre, nA, nlda, nB, nldb);
  const int tid = mytid(), lane = tid & 63, wid = tid >> 6;
  const int wm = wid >> 1, wn = wid & 1, fr = lane & 15, fq = lane >> 4;
  if (d.mode == 4) {
    const int which = d.col0 >> 2, h = d.col0 & 3;
    const float* gain = d.g + which * 64 + fq * 4;
    const float* RC = (const float*)(p.ws + OFF_ROPE);
    const float* RS = RC + 65536;
    u16* dstb = d.C + (which ? 18874368L : 0L);
    const float qs = which ? 1.f : 0.18033688011112042f;
#pragma unroll
    for (int mi = 0; mi < MI; ++mi) {
      const int tok = d.tok0 + wm * (MI * 16) + mi * 16 + fr;
      float ss = 0.f;
#pragma unroll
      for (int ni = 0; ni < 4; ++ni)
#pragma unroll
        for (int j = 0; j < 4; ++j) ss += acc[mi][ni][j] * acc[mi][ni][j];
      ss += __shfl_xor(ss, 16);
      ss += __shfl_xor(ss, 32);
      const float inv = rsqrtf(ss * (1.f / 64.f) + 1e-6f) * qs;
      int b, P;
      const bool lat = tok < T_LAT;
      if (lat) { b = tok >> 11; P = 256 + (tok & 2047); }
      else { b = (tok - T_LAT) >> 8; P = (tok - T_LAT) & 255; }
      float y[4][4];
#pragma unroll
      for (int ni = 0; ni < 4; ++ni) {
        float4 g4 = *(const float4*)(gain + ni * 16);
        y[ni][0] = acc[mi][ni][0] * inv * g4.x; y[ni][1] = acc[mi][ni][1] * inv * g4.y;
        y[ni][2] = acc[mi][ni][2] * inv * g4.z; y[ni][3] = acc[mi][ni][3] * inv * g4.w;
      }
      u16* dst = dstb + ((long)((b * 4 + h) * 2 + wn) * 2304 + P) * 64 + fq * 4;
#pragma unroll
      for (int ni = 0; ni < 4; ++ni) {
        float o0 = y[ni][0], o1 = y[ni][1], o2 = y[ni][2], o3 = y[ni][3];
        if (lat) {
          const int l = tok & 2047, a = ni >> 1;
          float4 c4 = *(const float4*)(RC + (l * 2 + a) * 16 + fq * 4);
          float4 s4 = *(const float4*)(RS + (l * 2 + a) * 16 + fq * 4);
          const float sg = (ni & 1) ? 1.f : -1.f;
          o0 = y[ni][0] * c4.x + sg * y[ni ^ 1][0] * s4.x;
          o1 = y[ni][1] * c4.y + sg * y[ni ^ 1][1] * s4.y;
          o2 = y[ni][2] * c4.z + sg * y[ni ^ 1][2] * s4.z;
          o3 = y[ni][3] * c4.w + sg * y[ni ^ 1][3] * s4.w;
        }
        uint2 o;
        o.x = pk_bf16(o0, o1);
        o.y = pk_bf16(o2, o3);
        *(uint2*)(dst + ni * 16) = o;
      }
    }
    return;
  }
#pragma unroll
  for (int mi = 0; mi < MI; ++mi)
#pragma unroll
    for (int ni = 0; ni < 4; ++ni) {
      int r = wm * (MI * 16) + mi * 16 + fr, c = wn * 64 + ni * 16 + fq * 4;
      f32x4 v = acc[mi][ni];
      if (d.mode == 0) {
        long ro = d.split ? ((long)(r & 127) * d.ldc + (long)(r >> 7) * d.split) : (long)r * d.ldc;
        uint2 o;
        o.x = pk_bf16(v[0] * d.scale, v[1] * d.scale); o.y = pk_bf16(v[2] * d.scale, v[3] * d.scale);
        *(uint2*)(d.C + ro + c) = o;
      } else if (d.mode == 1) {
        uint2 o;
        float t0 = fmaxf(v[0], 0.f), t1 = fmaxf(v[1], 0.f), t2 = fmaxf(v[2], 0.f), t3 = fmaxf(v[3], 0.f);
        o.x = pk_bf16(t0 * t0, t1 * t1); o.y = pk_bf16(t2 * t2, t3 * t3);
        *(uint2*)(d.C + (long)r * d.ldc + c) = o;
      } else if (d.mode == 3) {
        if (wn == 0 && ni == 0) *(float4*)((float*)d.C + (long)r * 16 + fq * 4) = float4{v[0], v[1], v[2], v[3]};
      } else {
        float4* xp = (float4*)(xrow(p, d.tok0 + r) + d.col0 + c);
        float4 g4 = *(const float4*)(d.g + d.col0 + c);
        float4 x4 = *xp;
        x4.x += g4.x * v[0]; x4.y += g4.y * v[1]; x4.z += g4.z * v[2]; x4.w += g4.w * v[3];
        *xp = x4;
      }
    }
}

DI void ph_init(const Prm& p, char* smem) {
  const long gt = (long)mybid() * 512 + mytid(), gn = (long)gridDim.x * 512;
  {
    const float4* s = (const float4*)p.x;
    float4* d = (float4*)p.out;
#pragma unroll 8
    for (long i = gt; i < 32768L * 256; i += gn) d[i] = s[i];
    const float4* s2 = (const float4*)p.ctx;
    float4* d2 = (float4*)(p.ws + OFF_XC);
#pragma unroll 8
    for (long i = gt; i < 4096L * 256; i += gn) d2[i] = s2[i];
  }
  {
    u16* DL = (u16*)(p.ws + OFF_DL);
    for (long i = gt; i < 2048L * 4096; i += gn) {
      int l = (int)(i >> 12), kk = (int)(i & 4095), lp = kk & 2047, part = kk >> 11;
      int m = (l * lp) & 2047;
      float ang = (float)m * (6.283185307179586f / 2048.f);
      DL[i] = f2bf(part ? -sinf(ang) : cosf(ang));
    }
    u16* DLC = (u16*)(p.ws + OFF_DLC);
    for (long i = gt; i < 256L * 512; i += gn) {
      int l = (int)(i >> 9), kk = (int)(i & 511), lp = kk & 255, part = kk >> 8;
      int m = (l * lp) & 255;
      float ang = (float)m * (6.283185307179586f / 256.f);
      DLC[i] = f2bf(part ? -sinf(ang) : cosf(ang));
    }
    {
      float* RC = (float*)(p.ws + OFF_ROPE);
      float* RS = RC + 65536;
      for (long i = gt; i < 65536; i += gn) {
        int l = (int)(i >> 5), a = (int)(i >> 4) & 1, f = (int)(i & 15);
        float pos = a ? (float)(l & 63) : (float)(l >> 6);
        float ang = pos * powf(10000.f, -(float)f / 16.f);
        RC[i] = cosf(ang);
        RS[i] = sinf(ang);
      }
    }
    u16* DC = (u16*)(p.ws + OFF_DC);
    for (long i = gt; i < 256L * 128; i += gn) {
      int j2 = (int)(i >> 7), ii = (int)(i & 127), part = j2 >> 7, j = j2 & 127;
      int m = (ii * j) & 127;
      float ang = (float)m * (6.283185307179586f / 128.f);
      DC[i] = f2bf(part ? sinf(ang) : cosf(ang));
    }
  }
  float* sc = (float*)smem;
  float* red = sc + 17 * 1024;
  const int tid = mytid();
  for (int e = tid; e < 17 * 1024; e += 512) {
    int bb = e >> 10, k = e & 1023;
    float v = bb < 16 ? p.c[bb * 1024 + k] : p.c_ctx[k];
    sc[e] = v / (1.f + expf(-v));
  }
  __syncthreads();
  float* MOD = (float*)(p.ws + OFF_MOD);
  for (int it = mybid(); it < 192; it += gridDim.x) {
    int li = it / 48, cgp = it % 48;
    int cl = tid & 127, kq = tid >> 7, n = cgp * 128 + cl;
    float a[17];
#pragma unroll
    for (int b = 0; b < 17; ++b) a[b] = 0.f;
    const float* w = p.w_ada + ((long)li * 1024 + kq * 256) * 6144 + n;
#pragma unroll 1
    for (int k = 0; k < 256; k += 8) {
      float wv[8];
#pragma unroll
      for (int u = 0; u < 8; ++u) wv[u] = w[(long)(k + u) * 6144];
#pragma unroll
      for (int u = 0; u < 8; ++u) {
#pragma unroll
        for (int b = 0; b < 17; ++b) a[b] += sc[b * 1024 + kq * 256 + k + u] * wv[u];
        asm volatile("" ::: "memory");
      }
    }
#pragma unroll
    for (int b = 0; b < 17; ++b) red[(kq * 17 + b) * 128 + cl] = a[b];
    __syncthreads();
    for (int e = tid; e < 17 * 128; e += 512) {
      int b = e >> 7, c2 = e & 127, n2 = cgp * 128 + c2;
      float v = p.b_ada[li * 6144 + n2];
      for (int q = 0; q < 4; ++q) v += red[(q * 17 + b) * 128 + c2];
      MOD[((long)li * 17 + b) * 6144 + n2] = v;
    }
    __syncthreads();
  }
}

DI long tr_job(long base, const float* src, int K, int N, u16* dst, int nb, char* smem) {
  float* t = (float*)smem;
  const int tk = K >> 6, tn = (N + 63) >> 6, per = tk * tn, total = per * nb;
  const int tid = mytid();
  const int G = gridDim.x;
  float v[8];
  int it = first_item(base);
  if (it < total) {
    int b = it / per, r = it % per, kt = r / tn, nt = r % tn;
    const float* s = src + (long)b * K * N;
#pragma unroll
    for (int i = 0; i < 8; ++i) {
      int id = tid + i * 512, kk = id >> 6, nn = id & 63;
      v[i] = (nt * 64 + nn < N) ? __builtin_nontemporal_load(&s[(long)(kt * 64 + kk) * N + nt * 64 + nn]) : 0.f;
    }
  }
  for (; it < total; it += G) {
    int b = it / per, r = it % per, kt = r / tn, nt = r % tn;
    u16* d = dst + (long)b * K * N;
    int k0 = kt * 64, n0 = nt * 64;
#pragma unroll
    for (int i = 0; i < 8; ++i) {
      int id = tid + i * 512, kk = id >> 6, nn = id & 63;
      t[kk * 65 + nn] = v[i];
    }
    __syncthreads();
    if (it + G < total) {
      int it2 = it + G, b2 = it2 / per, r2 = it2 % per, kt2 = r2 / tn, nt2 = r2 % tn;
      const float* s2 = src + (long)b2 * K * N;
#pragma unroll
      for (int i = 0; i < 8; ++i) {
        int id = tid + i * 512, kk = id >> 6, nn = id & 63;
        v[i] = (nt2 * 64 + nn < N) ? __builtin_nontemporal_load(&s2[(long)(kt2 * 64 + kk) * N + nt2 * 64 + nn]) : 0.f;
      }
    }
#pragma unroll
    for (int i = 0; i < 8; ++i) {
      int id = tid + i * 512, nn = id >> 6, kk = id & 63;
      if (n0 + nn < N) d[(long)(n0 + nn) * K + k0 + kk] = f2bf(t[kk * 65 + nn]);
    }
    __syncthreads();
  }
  return base + total;
}

DI void ph_norm(const Prm& p, int li, int which) {
  const int lane = mytid() & 63;
  const int gw = mybid() * 8 + (mytid() >> 6), nw = gridDim.x * 8;
  const float* nwt = (which ? p.norm2 : p.norm1) + li * 1024;
  const float* MOD = (const float*)(p.ws + OFF_MOD);
  u16* H = (u16*)(p.ws + OFF_HBF);
  const int nrows = (which && li == 3) ? T_LAT : T_ALL;
  for (int row = gw; row < nrows; row += 2 * nw) {
    const int row2 = row + nw;
    const bool has2 = row2 < nrows;
    const float* xr = xrow(p, row);
    const float* xr2 = xrow(p, has2 ? row2 : row);
    float4 v[4], u[4];
    float ss = 0.f, ss2 = 0.f;
#pragma unroll
    for (int i = 0; i < 4; ++i) {
      v[i] = *(const float4*)(xr + i * 256 + lane * 4);
      u[i] = *(const float4*)(xr2 + i * 256 + lane * 4);
    }
#pragma unroll
    for (int i = 0; i < 4; ++i) {
      ss += v[i].x * v[i].x + v[i].y * v[i].y + v[i].z * v[i].z + v[i].w * v[i].w;
      ss2 += u[i].x * u[i].x + u[i].y * u[i].y + u[i].z * u[i].z + u[i].w * u[i].w;
    }
#pragma unroll
    for (int o = 32; o; o >>= 1) {
      ss += __shfl_xor(ss, o);
      ss2 += __shfl_xor(ss2, o);
    }
    const float inv = rsqrtf(ss * (1.f / 1024.f) + 1e-6f), inv2 = rsqrtf(ss2 * (1.f / 1024.f) + 1e-6f);
    const int bb = row < T_LAT ? (row >> 11) : 16, bb2 = row2 < T_LAT ? (row2 >> 11) : 16;
    const float* sh = MOD + ((long)li * 17 + bb) * 6144 + (which ? 3 : 0) * 1024;
    const float* sh2 = MOD + ((long)li * 17 + (has2 ? bb2 : bb)) * 6144 + (which ? 3 : 0) * 1024;
#pragma unroll
    for (int i = 0; i < 4; ++i) {
      int c = i * 256 + lane * 4;
      float4 w4 = *(const float4*)(nwt + c);
      {
        float4 s4 = *(const float4*)(sh + 1024 + c), h4 = *(const float4*)(sh + c);
        uint2 o;
        o.x = pk_bf16(v[i].x * inv * w4.x * (1.f + s4.x) + h4.x, v[i].y * inv * w4.y * (1.f + s4.y) + h4.y);
        o.y = pk_bf16(v[i].z * inv * w4.z * (1.f + s4.z) + h4.z, v[i].w * inv * w4.w * (1.f + s4.w) + h4.w);
        *(uint2*)(H + (long)row * 1024 + c) = o;
      }
      if (has2) {
        float4 s4 = *(const float4*)(sh2 + 1024 + c), h4 = *(const float4*)(sh2 + c);
        uint2 o;
        o.x = pk_bf16(u[i].x * inv2 * w4.x * (1.f + s4.x) + h4.x, u[i].y * inv2 * w4.y * (1.f + s4.y) + h4.y);
        o.y = pk_bf16(u[i].z * inv2 * w4.z * (1.f + s4.z) + h4.z, u[i].w * inv2 * w4.w * (1.f + s4.w) + h4.w);
        *(uint2*)(H + (long)row2 * 1024 + c) = o;
      }
    }
  }
}

DI void ph_taps1(const Prm& p, int li, long base, char* smem) {
  float* f = (float*)smem;
  float* hraw = (float*)(p.ws + OFF_AR + 5 * U38);
  const int tid = mytid();
  for (int it = first_item(base); it < 288; it += gridDim.x) {
    const int L = it < 256 ? 2048 : 256, j0 = it < 256 ? it * 8 : (it - 256) * 8;
    const int lg = tid >> 6, kk = tid & 63;
    if (tid < 8 * 33) {
      int l2 = tid / 33, e = tid % 33, j = j0 + l2;
      float t = (float)j / (float)(L - 1);
      float w = 6.283185307179586f * (float)j / (float)L;
      float v;
      if (e == 0) v = t;
      else {
        int bi = (e - 1) & 15;
        float band = 1e-4f + (float)bi * ((15.f - 1e-4f) / 15.f);
        v = (e <= 16) ? cosf(band * w) : -sinf(band * w);
      }
      f[l2 * 40 + e] = v;
    }
    __syncthreads();
    {
      float v = p.hy_b1[li * 64 + kk];
#pragma unroll 3
      for (int e = 0; e < 33; ++e) v += f[lg * 40 + e] * p.hy_w1[(li * 33 + e) * 64 + kk];
      f[320 + lg * 64 + kk] = sinf(p.hy_freq[(li * 2 + 0) * 64 + kk] * v);
    }
    __syncthreads();
    {
      float v = p.hy_b2[li * 64 + kk];
#pragma unroll 4
      for (int m = 0; m < 64; ++m) v += f[320 + lg * 64 + m] * p.hy_w2[(li * 64 + m) * 64 + kk];
      f[832 + lg * 64 + kk] = sinf(p.hy_freq[(li * 2 + 1) * 64 + kk] * v);
    }
    __syncthreads();
    {
      float h[4][8];
#pragma unroll
      for (int i = 0; i < 4; ++i)
#pragma unroll
        for (int l2 = 0; l2 < 8; ++l2) h[i][l2] = 0.f;
      const float* w3 = p.hy_w3 + (long)li * 64 * 2048 + tid;
#pragma unroll 2
      for (int k = 0; k < 64; ++k) {
        float wv[4];
#pragma unroll
        for (int i = 0; i < 4; ++i) wv[i] = w3[(long)k * 2048 + i * 512];
#pragma unroll
        for (int l2 = 0; l2 < 8; ++l2) {
          float hv = f[832 + l2 * 64 + k];
#pragma unroll
          for (int i = 0; i < 4; ++i) h[i][l2] += hv * wv[i];
        }
      }
#pragma unroll
      for (int i = 0; i < 4; ++i) {
        int n = tid + i * 512, ch = n & 511;
        float delta = fabsf(-3.0701134573253946f + (float)ch * ((-15.350567286626973f + 3.0701134573253946f) / 511.f));
#pragma unroll
        for (int l2 = 0; l2 < 8; ++l2) {
          int j = j0 + l2;
          float t = (float)j / (float)(L - 1);
          long row = (it < 256) ? j : 2048 + j;
          hraw[row * 2048 + n] = h[i][l2] * expf(-t * delta);
        }
      }
    }
    __syncthreads();
  }
}
DI void ph_taps2(const Prm& p, long base, char* smem) {
  float* vals = (float*)smem;
  float* red = vals + 8 * 2048;
  const float* hraw = (const float*)(p.ws + OFF_AR + 5 * U38);
  const int tid = mytid(), cl = tid & 3, dir = (tid >> 2) & 1, jg = tid >> 3;
  for (int it = first_item(base); it < 512; it += gridDim.x) {
    int ls = it >> 8, order = (it >> 7) & 1, cgp = it & 127;
    int L = ls ? 256 : 2048;
    const float* hr = hraw + (long)(ls ? 2048 : 0) * 2048;
    u16* G = (u16*)(p.ws + (ls ? OFF_TAPC : OFF_TAPL));
    int ch = cgp * 4 + cl, n = order * 1024 + dir * 512 + ch;
    float s = 0.f;
#pragma unroll 8
    for (int j = jg; j < L; j += 64) {
      float v = hr[(long)j * 2048 + n];
      vals[(cl * 2 + dir) * L + j] = v;
      s += (dir == 1 && j == 0) ? 0.f : fabsf(v);
    }
    red[(tid >> 2) * 4 + cl] = s;
    __syncthreads();
    if (tid < 4) {
      float tot = 0.f;
#pragma unroll 8
      for (int r = 0; r < 128; ++r) tot += red[r * 4 + tid];
      red[512 + tid] = 1.f / tot;
    }
    __syncthreads();
    for (int idx = tid; idx < 8 * L; idx += 512) {
      int q = idx / L, j = idx % L, c2 = q >> 1, d2 = q & 1;
      float v = vals[idx] * red[512 + c2];
      u16* g = G + (long)(order * 512 + cgp * 4 + c2) * (2 * L);
      if (d2 == 0) g[L + j] = f2bf(v);
      else if (j > 0) g[L - j] = f2bf(v);
      else g[0] = 0;
    }
    __syncthreads();
  }
}

DI void ph_pdab(const Prm& p, int li, char* smem) {
  float* wl = (float*)smem;
  const int tid = mytid(), lane = tid & 63;
#pragma unroll 8
  for (int e = tid; e < 1024 * 16; e += 512) wl[e] = p.w_in[((long)li * 1024 + (e >> 4)) * NIN + 5632 + (e & 15)];
  __syncthreads();
  const u16* H = (const u16*)(p.ws + OFF_HBF);
  float* out = (float*)(p.ws + OFF_PDAB);
  const int gw = mybid() * 8 + (tid >> 6), nw = gridDim.x * 8;
  for (int tok = gw; tok < T_ALL; tok += nw) {
    float a[16];
#pragma unroll
    for (int j = 0; j < 16; ++j) a[j] = 0.f;
    float hv[16];
#pragma unroll
    for (int i = 0; i < 16; ++i) hv[i] = bf2f(H[(long)tok * 1024 + lane + i * 64]);
#pragma unroll
    for (int i = 0; i < 16; ++i) {
      float h = hv[i];
      const float4* wp = (const float4*)(wl + (lane + i * 64) * 16);
#pragma unroll
      for (int q = 0; q < 4; ++q) {
        float4 w4 = wp[q];
        a[q * 4 + 0] += h * w4.x;
        a[q * 4 + 1] += h * w4.y;
        a[q * 4 + 2] += h * w4.z;
        a[q * 4 + 3] += h * w4.w;
      }
      if ((i & 3) == 3) asm volatile("" ::: "memory");
    }
#pragma unroll
    for (int o = 32; o; o >>= 1)
#pragma unroll
      for (int j = 0; j < 16; ++j) a[j] += __shfl_xor(a[j], o);
    float v = a[0];
#pragma unroll
    for (int j = 1; j < 16; ++j) v = (lane == j) ? a[j] : v;
    if (lane < 16) out[(long)tok * 16 + lane] = v;
  }
  __syncthreads();
}

DI void ph_dncl(const Prm& p, int li, char* smem) {
  const int tid = mytid(), lane = tid & 63, wid = tid >> 6, fr = lane & 15, fq = lane >> 4;
  u16* qn = (u16*)smem;
  u16* kn = qn + 64 * 144;
  float* fb = (float*)(smem + 36864);
  float* KK = fb;
  float* QK = KK + 64 * 65;
  float* Am = QK + 64 * 65;
  float* Tm = Am + 2 * 64 * 65;
  float* gcs = Tm + 2 * 64 * 65;
  float* bts = gcs + 128;
  const u16* PD = (const u16*)(p.ws + OFF_AR);
  const float* AB = (const float*)(p.ws + OFF_PDAB);
  u16* DQ = (u16*)(p.ws + OFF_Y);
  u16* DK = DQ + 18874368L;
  u16* DV = DK + 18874368L;
  u16* CL = (u16*)(p.ws + OFF_AR + 3 * U38);
  float* GC = (float*)(p.ws + OFF_GC);
  float* BT = (float*)(p.ws + OFF_BETA);
  const float* cw = p.dn_conv + (long)li * 3 * 1536;
  for (int it = mybid(); it < 2304; it += gridDim.x) {
    const int b = it / 144, r0 = it % 144, oc = r0 >> 2, h = r0 & 3;
    const int pos0 = oc * 64, s0 = oc < 4 ? 0 : 256, e0 = oc < 4 ? 256 : 2304;
    if (tid < 384) {
      const int cgp = tid % 48, rs = tid / 48;
      const int part = cgp >> 4, d0 = (cgp & 15) * 8, col = part * 512 + h * 128 + d0;
      const u16* basep = PD + (long)tokof(b, pos0) * 1536 + col;
      float wt[3][8];
#pragma unroll
      for (int tp = 0; tp < 3; ++tp) {
        float4 wa = *(const float4*)(cw + tp * 1536 + col), wb = *(const float4*)(cw + tp * 1536 + col + 4);
        wt[tp][0] = wa.x; wt[tp][1] = wa.y; wt[tp][2] = wa.z; wt[tp][3] = wa.w;
        wt[tp][4] = wb.x; wt[tp][5] = wb.y; wt[tp][6] = wb.z; wt[tp][7] = wb.w;
      }
#pragma unroll 1
      for (int hf = 0; hf < 2; ++hf) {
        u32x4 rw[6];
#pragma unroll
        for (int i = 0; i < 6; ++i) {
          int j = rs * 8 + hf * 4 - 1 + i, P = pos0 + j;
          rw[i] = (P >= s0 && P < e0) ? *(const u32x4*)(basep + (long)j * 1536) : u32x4{0u, 0u, 0u, 0u};
        }
#pragma unroll
        for (int r = 0; r < 4; ++r) {
#pragma unroll
          for (int e = 0; e < 8; ++e) {
            unsigned w0_ = rw[r][e >> 1], w1_ = rw[r + 1][e >> 1], w2_ = rw[r + 2][e >> 1];
            float x0 = (e & 1) ? __uint_as_float(w0_ & 0xffff0000u) : __uint_as_float(w0_ << 16);
            float x1 = (e & 1) ? __uint_as_float(w1_ & 0xffff0000u) : __uint_as_float(w1_ << 16);
            float x2 = (e & 1) ? __uint_as_float(w2_ & 0xffff0000u) : __uint_as_float(w2_ << 16);
            float v = wt[0][e] * x0 + wt[1][e] * x1 + wt[2][e] * x2;
            fb[(rs * 8 + hf * 4 + r) * 385 + part * 128 + d0 + e] = v * __builtin_amdgcn_rcpf(1.f + __expf(-v));
          }
        }
      }
    }
    __syncthreads();
    for (int jj = 0; jj < 8; ++jj) {
      int j = wid * 8 + jj, P = pos0 + j;
      long go = ((long)(b * 4 + h) * 2304 + P) * 128;
      float q0 = fb[j * 385 + lane], q1 = fb[j * 385 + 64 + lane];
      float k0 = fb[j * 385 + 128 + lane], k1 = fb[j * 385 + 192 + lane];
      float v0 = fb[j * 385 + 256 + lane], v1 = fb[j * 385 + 320 + lane];
      float iq = rsqrtf(wsum(q0 * q0 + q1 * q1) + 1e-6f), ik = rsqrtf(wsum(k0 * k0 + k1 * k1) + 1e-6f);
      u16 a0 = f2bf(q0 * iq), a1 = f2bf(q1 * iq), c0 = f2bf(k0 * ik), c1 = f2bf(k1 * ik);
      qn[j * 144 + lane] = a0; qn[j * 144 + 64 + lane] = a1;
      kn[j * 144 + lane] = c0; kn[j * 144 + 64 + lane] = c1;
      DQ[go + lane] = a0; DQ[go + 64 + lane] = a1;
      DK[go + lane] = c0; DK[go + 64 + lane] = c1;
      DV[go + lane] = f2bf(v0); DV[go + 64 + lane] = f2bf(v1);
    }
    __syncthreads();
#pragma unroll
    for (int u = 0; u < 4; ++u) {
      int tt = wid * 4 + u, which = tt >> 4, ti = (tt >> 2) & 3, tj = tt & 3;
      const u16* Ap = (which ? qn : kn) + (ti * 16 + fr) * 144 + fq * 8;
      const u16* Bp = kn + (tj * 16 + fr) * 144 + fq * 8;
      f32x4 a = {0.f, 0.f, 0.f, 0.f};
#pragma unroll
      for (int ks = 0; ks < 4; ++ks) a = MFMA(*(const bf16x8*)(Ap + ks * 32), *(const bf16x8*)(Bp + ks * 32), a);
      float* dst = which ? QK : KK;
#pragma unroll
      for (int j = 0; j < 4; ++j) dst[(ti * 16 + fq * 4 + j) * 65 + tj * 16 + fr] = a[j];
    }
    if (tid < 128) {
      int d = tid >> 6, r = tid & 63, j = d ? 63 - r : r;
      int tok = tokof(b, pos0 + j);
      float av = AB[(long)tok * 16 + d * 4 + h], bv = AB[(long)tok * 16 + 8 + d * 4 + h];
      float xx = av + p.dn_dt_bias[li * 8 + d * 4 + h];
      float sp = fmaxf(xx, 0.f) + __logf(1.f + __expf(-fabsf(xx)));
      float g = -expf(p.dn_a_log[li * 8 + d * 4 + h]) * sp;
      for (int o = 1; o < 64; o <<= 1) {
        float t = __shfl_up(g, o);
        if (r >= o) g += t;
      }
      float be = 1.f / (1.f + expf(-bv));
      gcs[d * 64 + r] = g;
      bts[d * 64 + r] = be;
      long ci = ((long)((b * 4 + h) * 2 + d) * 36 + oc) * 64 + r;
      GC[ci] = g;
      BT[ci] = be;
    }
    __syncthreads();
#pragma unroll 4
    for (int e = tid; e < 8192; e += 512) {
      int d = e >> 12, s = (e >> 6) & 63, r = e & 63;
      int j = d ? 63 - r : r, js = d ? 63 - s : s;
      float v = 0.f;
      if (r > s) v = bts[d * 64 + r] * KK[j * 65 + js] * __expf(gcs[d * 64 + r] - gcs[d * 64 + s]);
      Am[(d * 64 + s) * 64 + r] = v;
    }
#pragma unroll 4
    for (int e = tid; e < 8192; e += 512) {
      int d = e >> 12, r = (e >> 6) & 63, s = e & 63;
      int j = d ? 63 - r : r, js = d ? 63 - s : s;
      float dec = (r >= s) ? __expf(gcs[d * 64 + r] - gcs[d * 64 + s]) : 0.f;
      long ci = (long)((b * 4 + h) * 2 + d) * 36 + oc;
      CL[ci * 8192 + 4096 + r * 64 + s] = f2bf(QK[j * 65 + js] * dec * 0.08838834764831845f);
    }
    __syncthreads();
    {
      const int d = tid >> 8, c = (tid >> 2) & 63, q = tid & 3;
      const float* Atq = Am + d * 64 * 64 + q;
      float* T = Tm + d * 64 * 65;
      float t[16];
#pragma unroll
      for (int i = 0; i < 16; ++i) t[i] = (4 * i + q == c) ? 1.f : 0.f;
#pragma unroll
      for (int s2 = 0; s2 < 63; ++s2) {
        constexpr int dummy = 0;
        const int is = s2 >> 2, qs = s2 & 3;
        const int ctl = qs | (qs << 2) | (qs << 4) | (qs << 6);
        int tsb;
        if (qs == 0) tsb = __builtin_amdgcn_update_dpp(0, __float_as_int(t[is]), 0x00, 0xf, 0xf, false);
        else if (qs == 1) tsb = __builtin_amdgcn_update_dpp(0, __float_as_int(t[is]), 0x55, 0xf, 0xf, false);
        else if (qs == 2) tsb = __builtin_amdgcn_update_dpp(0, __float_as_int(t[is]), 0xAA, 0xf, 0xf, false);
        else tsb = __builtin_amdgcn_update_dpp(0, __float_as_int(t[is]), 0xFF, 0xf, 0xf, false);
        (void)ctl; (void)dummy;
        const float ts = __int_as_float(tsb);
#pragma unroll
        for (int i = is; i < 16; ++i) t[i] -= Atq[s2 * 64 + 4 * i] * ts;
        if ((s2 & 7) == 7) asm volatile("" ::: "memory");
      }
#pragma unroll
      for (int i = 0; i < 16; ++i) T[(4 * i + q) * 65 + c] = t[i];
    }
    __syncthreads();
    for (int e = tid; e < 8192; e += 512) {
      int d = e >> 12, rc = e & 4095;
      long ci = (long)((b * 4 + h) * 2 + d) * 36 + oc;
      CL[ci * 8192 + rc] = f2bf(Tm[(d * 64 + (rc >> 6)) * 65 + (rc & 63)]);
    }
    __syncthreads();
  }
}

DI void ph_dnscan(const Prm& p, char* smem) {
  const int tid = mytid(), lane = tid & 63, wid = tid >> 6, fr = lane & 15, fq = lane >> 4;
  u16* Kg = (u16*)smem;
  u16* Qg = Kg + 64 * 144;
  u16* KdT = Qg + 64 * 144;
  u16* Tl = KdT + 128 * 80;
  u16* Il = Tl + 64 * 80;
  u16* ST = Il + 64 * 80;
  u16* RT = ST + 64 * 144;
  u16* VN = RT + 64 * 80;
  const u16* DQ = (const u16*)(p.ws + OFF_Y);
  const u16* DK = DQ + 18874368L;
  const u16* DV = DK + 18874368L;
  const u16* CL = (const u16*)(p.ws + OFF_AR + 3 * U38);
  const float* GC = (const float*)(p.ws + OFF_GC);
  const float* BT = (const float*)(p.ws + OFF_BETA);
  const int vt = wid & 3, rp = wid >> 2;
  for (int it = mybid(); it < 256; it += gridDim.x) {
    const int b = it >> 4, h = (it >> 2) & 3, d = (it >> 1) & 1, vs = it & 1;
    u16* O = (u16*)(p.ws + OFF_AR + (d ? 6 : 5) * U38);
    f32x4 S[4];
#pragma unroll
    for (int i = 0; i < 4; ++i) S[i] = f32x4{0.f, 0.f, 0.f, 0.f};
    for (int e = tid; e < 64 * 144; e += 512) ST[e] = 0;
    const long seqb = (long)(b * 4 + h) * 2304;
    const long cib = (long)((b * 4 + h) * 2 + d) * 36;
    u32x4 rk0, rk1, rq0, rq1, rT, rI;
    float rg0, rg1, rgl;
    uint2 rv0, rv1;
    float rb0, rb1;
    const int lr0 = tid >> 4, lr1 = (tid + 512) >> 4, lch = tid & 15;
    const int lj0 = d ? 63 - lr0 : lr0, lj1 = d ? 63 - lr1 : lr1;
    const int vr0 = (rp * 2) * 16 + fr, vr1 = (rp * 2 + 1) * 16 + fr;
    const int vj0 = d ? 63 - vr0 : vr0, vj1 = d ? 63 - vr1 : vr1;
#define SCAN_LOAD_KQ(ocx)                                                                    \
  {                                                                                          \
    const long ci_ = cib + (ocx);                                                            \
    const long g0_ = (seqb + (ocx) * 64 + lj0) * 128 + lch * 8, g1_ = (seqb + (ocx) * 64 + lj1) * 128 + lch * 8; \
    rk0 = *(const u32x4*)(DK + g0_); rk1 = *(const u32x4*)(DK + g1_);                        \
    rq0 = *(const u32x4*)(DQ + g0_); rq1 = *(const u32x4*)(DQ + g1_);                        \
    rT = *(const u32x4*)(CL + ci_ * 8192 + (tid >> 3) * 64 + (tid & 7) * 8);                 \
    rI = *(const u32x4*)(CL + ci_ * 8192 + 4096 + (tid >> 3) * 64 + (tid & 7) * 8);          \
    rg0 = GC[ci_ * 64 + lr0]; rg1 = GC[ci_ * 64 + lr1]; rgl = GC[ci_ * 64 + 63];             \
  }
#define SCAN_LOAD_V(ocx)                                                                     \
  {                                                                                          \
    const long ci_ = cib + (ocx);                                                            \
    rv0 = *(const uint2*)(DV + (seqb + (ocx) * 64 + vj0) * 128 + vs * 64 + vt * 16 + fq * 4); \
    rv1 = *(const uint2*)(DV + (seqb + (ocx) * 64 + vj1) * 128 + vs * 64 + vt * 16 + fq * 4); \
    rb0 = BT[ci_ * 64 + vr0]; rb1 = BT[ci_ * 64 + vr1];                                      \
  }
    {
      const int oc0 = d ? 3 : 0;
      SCAN_LOAD_KQ(oc0);
      SCAN_LOAD_V(oc0);
    }
    for (int i = 0; i < 36; ++i) {
      const int oc = d ? (i < 4 ? 3 - i : 39 - i) : i;
      const int ocn = d ? (i + 1 < 4 ? 3 - (i + 1) : 39 - (i + 1)) : i + 1;
      const int pos0 = oc * 64;
      const float gl = rgl;
      {
        float eg0 = __expf(rg0), ed0 = __expf(gl - rg0), eg1 = __expf(rg1), ed1 = __expf(gl - rg1);
        u32x4 ko0, qo0, ko1, qo1;
#pragma unroll
        for (int w = 0; w < 4; ++w) {
          float k0l = __uint_as_float(rk0[w] << 16), k0h = __uint_as_float(rk0[w] & 0xffff0000u);
          float q0l = __uint_as_float(rq0[w] << 16), q0h = __uint_as_float(rq0[w] & 0xffff0000u);
          float k1l = __uint_as_float(rk1[w] << 16), k1h = __uint_as_float(rk1[w] & 0xffff0000u);
          float q1l = __uint_as_float(rq1[w] << 16), q1h = __uint_as_float(rq1[w] & 0xffff0000u);
          ko0[w] = pk_bf16(k0l * eg0, k0h * eg0);
          qo0[w] = pk_bf16(q0l * eg0 * 0.08838834764831845f, q0h * eg0 * 0.08838834764831845f);
          ko1[w] = pk_bf16(k1l * eg1, k1h * eg1);
          qo1[w] = pk_bf16(q1l * eg1 * 0.08838834764831845f, q1h * eg1 * 0.08838834764831845f);
          KdT[(lch * 8 + 2 * w) * 80 + lr0] = f2bf(k0l * ed0);
          KdT[(lch * 8 + 2 * w + 1) * 80 + lr0] = f2bf(k0h * ed0);
          KdT[(lch * 8 + 2 * w) * 80 + lr1] = f2bf(k1l * ed1);
          KdT[(lch * 8 + 2 * w + 1) * 80 + lr1] = f2bf(k1h * ed1);
        }
        *(u32x4*)(Kg + lr0 * 144 + lch * 8) = ko0;
        *(u32x4*)(Qg + lr0 * 144 + lch * 8) = qo0;
        *(u32x4*)(Kg + lr1 * 144 + lch * 8) = ko1;
        *(u32x4*)(Qg + lr1 * 144 + lch * 8) = qo1;
        *(u32x4*)(Tl + (tid >> 3) * 80 + (tid & 7) * 8) = rT;
        *(u32x4*)(Il + (tid >> 3) * 80 + (tid & 7) * 8) = rI;
      }
      lds_barrier();
      if (i + 1 < 36) SCAN_LOAD_KQ(ocn);
      f32x4 ks_[2], qs_[2];
#pragma unroll
      for (int u = 0; u < 2; ++u) { ks_[u] = f32x4{0.f, 0.f, 0.f, 0.f}; qs_[u] = f32x4{0.f, 0.f, 0.f, 0.f}; }
#pragma unroll
      for (int kk = 0; kk < 4; ++kk) {
        bf16x8 a = *(const bf16x8*)(ST + (vt * 16 + fr) * 144 + kk * 32 + fq * 8);
#pragma unroll
        for (int u = 0; u < 2; ++u) {
          int rt = rp * 2 + u;
          bf16x8 bk = *(const bf16x8*)(Kg + (rt * 16 + fr) * 144 + kk * 32 + fq * 8);
          bf16x8 bq = *(const bf16x8*)(Qg + (rt * 16 + fr) * 144 + kk * 32 + fq * 8);
          ks_[u] = MFMA(a, bk, ks_[u]);
          qs_[u] = MFMA(a, bq, qs_[u]);
        }
      }
      {
        int v0 = vt * 16 + fq * 4;
        RT[(v0 + 0) * 80 + vr0] = f2bf(rb0 * (__uint_as_float(rv0.x << 16) - ks_[0][0]));
        RT[(v0 + 1) * 80 + vr0] = f2bf(rb0 * (__uint_as_float(rv0.x & 0xffff0000u) - ks_[0][1]));
        RT[(v0 + 2) * 80 + vr0] = f2bf(rb0 * (__uint_as_float(rv0.y << 16) - ks_[0][2]));
        RT[(v0 + 3) * 80 + vr0] = f2bf(rb0 * (__uint_as_float(rv0.y & 0xffff0000u) - ks_[0][3]));
        RT[(v0 + 0) * 80 + vr1] = f2bf(rb1 * (__uint_as_float(rv1.x << 16) - ks_[1][0]));
        RT[(v0 + 1) * 80 + vr1] = f2bf(rb1 * (__uint_as_float(rv1.x & 0xffff0000u) - ks_[1][1]));
        RT[(v0 + 2) * 80 + vr1] = f2bf(rb1 * (__uint_as_float(rv1.y << 16) - ks_[1][2]));
        RT[(v0 + 3) * 80 + vr1] = f2bf(rb1 * (__uint_as_float(rv1.y & 0xffff0000u) - ks_[1][3]));
      }
      if (i + 1 < 36) SCAN_LOAD_V(ocn);
      lds_barrier();
      {
        f32x4 vn[2];
#pragma unroll
        for (int u = 0; u < 2; ++u) vn[u] = f32x4{0.f, 0.f, 0.f, 0.f};
#pragma unroll
        for (int kk = 0; kk < 2; ++kk) {
          bf16x8 a = *(const bf16x8*)(RT + (vt * 16 + fr) * 80 + kk * 32 + fq * 8);
#pragma unroll
          for (int u = 0; u < 2; ++u) {
            bf16x8 bb = *(const bf16x8*)(Tl + ((rp * 2 + u) * 16 + fr) * 80 + kk * 32 + fq * 8);
            vn[u] = MFMA(a, bb, vn[u]);
          }
        }
#pragma unroll
        for (int u = 0; u < 2; ++u) {
          int r = (rp * 2 + u) * 16 + fr, v0 = vt * 16 + fq * 4;
#pragma unroll
          for (int j = 0; j < 4; ++j) VN[(v0 + j) * 80 + r] = f2bf(vn[u][j]);
        }
      }
      lds_barrier();
#pragma unroll
      for (int kk = 0; kk < 2; ++kk) {
        bf16x8 a = *(const bf16x8*)(VN + (vt * 16 + fr) * 80 + kk * 32 + fq * 8);
#pragma unroll
        for (int u = 0; u < 2; ++u) {
          bf16x8 bb = *(const bf16x8*)(Il + ((rp * 2 + u) * 16 + fr) * 80 + kk * 32 + fq * 8);
          qs_[u] = MFMA(a, bb, qs_[u]);
        }
      }
#pragma unroll
      for (int u = 0; u < 2; ++u) {
        int r = (rp * 2 + u) * 16 + fr, j = d ? 63 - r : r;
        u16* op = O + (long)tokof(b, pos0 + j) * 512 + h * 128 + vs * 64 + vt * 16 + fq * 4;
        ushort4 ov4;
        ov4.x = f2bf(qs_[u][0]); ov4.y = f2bf(qs_[u][1]); ov4.z = f2bf(qs_[u][2]); ov4.w = f2bf(qs_[u][3]);
        *(ushort4*)op = ov4;
      }
      {
        float ge = __expf(gl);
#pragma unroll
        for (int u = 0; u < 4; ++u) S[u] *= ge;
#pragma unroll
        for (int kk = 0; kk < 2; ++kk) {
          bf16x8 a = *(const bf16x8*)(VN + (vt * 16 + fr) * 80 + kk * 32 + fq * 8);
#pragma unroll
          for (int u = 0; u < 4; ++u) {
            bf16x8 bb = *(const bf16x8*)(KdT + ((rp * 4 + u) * 16 + fr) * 80 + kk * 32 + fq * 8);
            S[u] = MFMA(a, bb, S[u]);
          }
        }
#pragma unroll
        for (int u = 0; u < 4; ++u) {
          int dd = (rp * 4 + u) * 16 + fr, v0 = vt * 16 + fq * 4;
#pragma unroll
          for (int j = 0; j < 4; ++j) ST[(v0 + j) * 144 + dd] = f2bf(S[u][j]);
        }
      }
      lds_barrier();
    }
#undef SCAN_LOAD_KQ
#undef SCAN_LOAD_V
  }
}

DI void ph_dnfin(const Prm& p, int li) {
  const int lane = mytid() & 63;
  const int gw = mybid() * 8 + (mytid() >> 6), nw = gridDim.x * 8;
  const u16* O = (const u16*)(p.ws + OFF_AR + 5 * U38);
  const u16* O2 = (const u16*)(p.ws + OFF_AR + 6 * U38);
  u16* Z = (u16*)(p.ws + OFF_Y + 3 * U38);
  const float n0 = p.dn_norm[li * 128 + lane * 2], n1 = p.dn_norm[li * 128 + lane * 2 + 1];
#pragma unroll 2
  for (int tok = gw; tok < T_ALL; tok += nw) {
    ushort2 oa[4], ob[4], zz[4];
    float ox[4], oy[4], ss[4];
#pragma unroll
    for (int h = 0; h < 4; ++h) {
      long o = (long)tok * 512 + h * 128 + lane * 2;
      oa[h] = *(const ushort2*)(O + o);
      ob[h] = *(const ushort2*)(O2 + o);
      zz[h] = *(const ushort2*)(Z + o);
    }
#pragma unroll
    for (int h = 0; h < 4; ++h) {
      ox[h] = bf2f(oa[h].x) + bf2f(ob[h].x);
      oy[h] = bf2f(oa[h].y) + bf2f(ob[h].y);
      ss[h] = ox[h] * ox[h] + oy[h] * oy[h];
    }
#pragma unroll
    for (int o = 32; o; o >>= 1)
#pragma unroll
      for (int h = 0; h < 4; ++h) ss[h] += __shfl_xor(ss[h], o);
#pragma unroll
    for (int h = 0; h < 4; ++h) {
      float inv = rsqrtf(ss[h] * (1.f / 128.f) + 1e-6f);
      float z0 = bf2f(zz[h].x), z1 = bf2f(zz[h].y);
      ushort2 y;
      y.x = f2bf(ox[h] * inv * n0 * (z0 * __builtin_amdgcn_rcpf(1.f + __expf(-z0))));
      y.y = f2bf(oy[h] * inv * n1 * (z1 * __builtin_amdgcn_rcpf(1.f + __expf(-z1))));
      *(ushort2*)(Z + (long)tok * 512 + h * 128 + lane * 2) = y;
    }
  }
}

DI void ph_aprep(const Prm& p, int li) {
  const int lane = mytid() & 63;
  const int gw = mybid() * 8 + (mytid() >> 6), nw = gridDim.x * 8;
  const u16* PA = (const u16*)(p.ws + OFF_AR);
  u16* QH = (u16*)(p.ws + OFF_AR + 3 * U38);
  u16* KH = QH + 18874368L;
  const int f = lane & 15;
  const float inv_f = powf(10000.f, -(float)f / 16.f);
  for (int tok = gw; tok < T_ALL; tok += nw) {
    int b, P;
    float cs = 1.f, sn = 0.f;
    if (tok < T_LAT) {
      b = tok >> 11;
      int l = tok & 2047;
      P = 256 + l;
      float pos = (lane < 32) ? (float)(l >> 6) : (float)(l & 63);
      float ang = pos * inv_f;
      cs = cosf(ang);
      sn = sinf(ang);
    } else {
      b = (tok - T_LAT) >> 8;
      P = (tok - T_LAT) & 255;
    }
    float xv[16], ssq[16];
#pragma unroll
    for (int g = 0; g < 16; ++g) {
      xv[g] = bf2f(PA[(long)tok * 1024 + g * 64 + lane]);
      ssq[g] = xv[g] * xv[g];
    }
#pragma unroll
    for (int o = 32; o; o >>= 1)
#pragma unroll
      for (int g = 0; g < 16; ++g) ssq[g] += __shfl_xor(ssq[g], o);
#pragma unroll
    for (int g = 0; g < 16; ++g) {
      int which = g >> 3, h = (g >> 1) & 3, c = g & 1;
      float inv = rsqrtf(ssq[g] * (1.f / 64.f) + 1e-6f);
      float y = xv[g] * inv * p.qk_gain[(li * 2 + which) * 64 + lane];
      float pr = __shfl_xor(y, 16);
      float o = (lane & 16) ? (y * cs + pr * sn) : (y * cs - pr * sn);
      if (which == 0) o *= 0.18033688011112042f;
      u16* dst = (which ? KH : QH) + ((long)((b * 4 + h) * 2 + c) * 2304 + P) * 64 + lane;
      *dst = f2bf(o);
    }
  }
}

DI void ph_attn(const Prm& p, int li, long base, char* smem) {
  const int tid = mytid(), lane = tid & 63, wid = tid >> 6, fr = lane & 15, fq = lane >> 4;
  const u16* QH = (const u16*)(p.ws + OFF_AR + 3 * U38);
  const u16* KH = QH + 18874368L;
  const u16* VT = (const u16*)(p.ws + OFF_AR + 5 * U38);
  u16* YA = (u16*)(p.ws + OFF_Y);
  u16* s = (u16*)smem;
  constexpr int STG = 128 * 80 + 128 * 72;
  const float lambda_init = 0.8f - 0.6f * expf(-0.3f * (float)li);
  float lamv, mshift;
  {
    const float* lv = p.lam + li * 256;
    float a = wsum(lv[lane] * lv[64 + lane]), b2 = wsum(lv[128 + lane] * lv[192 + lane]);
    lamv = expf(a) - expf(b2) + lambda_init;
    float gq = wmax(fabsf(p.qk_gain[(li * 2) * 64 + lane])), gk = wmax(fabsf(p.qk_gain[(li * 2 + 1) * 64 + lane]));
    mshift = 8.f * gq * gk * 1.4426950408889634f;
  }
  for (int it = first_item(base); it < (li == 3 ? 1024 : 1152); it += gridDim.x) {
    int b, h, qp0, nkeys;
    if (it < 1024) { b = it >> 6; h = (it >> 4) & 3; qp0 = 256 + (it & 15) * 128; nkeys = 2304; }
    else { int i2 = it - 1024; b = i2 >> 3; h = (i2 >> 1) & 3; qp0 = (i2 & 1) * 128; nkeys = 256; }
    const long kb0 = (long)((b * 4 + h) * 2) * 2304;
    bf16x8 qf[2][2];
#pragma unroll
    for (int c = 0; c < 2; ++c)
#pragma unroll
      for (int ks = 0; ks < 2; ++ks)
        qf[c][ks] = *(const bf16x8*)(QH + (kb0 + (long)c * 2304 + qp0 + wid * 16 + fr) * 64 + ks * 32 + fq * 8);
    f32x4 O0[8], O1[8];
#pragma unroll
    for (int i = 0; i < 8; ++i) { O0[i] = f32x4{0.f, 0.f, 0.f, 0.f}; O1[i] = f32x4{0.f, 0.f, 0.f, 0.f}; }
    f32x4 L0 = {0.f, 0.f, 0.f, 0.f}, L1 = {0.f, 0.f, 0.f, 0.f};
    const bf16x8 ones = {0x3F80, 0x3F80, 0x3F80, 0x3F80, 0x3F80, 0x3F80, 0x3F80, 0x3F80};
    uint4 rk[2], rv[2];
    const int nt = nkeys >> 6;
#pragma unroll
    for (int u = 0; u < 2; ++u) {
      int id = tid + u * 512;
      int c = id >> 9, key = (id >> 3) & 63, ch = id & 7;
      rk[u] = *(const uint4*)(KH + (kb0 + (long)c * 2304 + key) * 64 + ch * 8);
      int dv = id >> 3;
      rv[u] = *(const uint4*)(VT + ((long)(b * 512 + h * 128 + dv)) * 2304 + ch * 8);
    }
#pragma unroll
    for (int u = 0; u < 2; ++u) {
      int id = tid + u * 512;
      *(uint4*)(s + (id >> 3) * 80 + (id & 7) * 8) = rk[u];
      *(uint4*)(s + 128 * 80 + (id >> 3) * 72 + (id & 7) * 8) = rv[u];
    }
    lds_barrier();
    for (int t = 0; t < nt; ++t) {
      const bool more = t + 1 < nt;
      if (more) {
        int kp0 = (t + 1) * 64;
#pragma unroll
        for (int u = 0; u < 2; ++u) {
          int id = tid + u * 512;
          int c = id >> 9, key = (id >> 3) & 63, ch = id & 7;
          rk[u] = *(const uint4*)(KH + (kb0 + (long)c * 2304 + kp0 + key) * 64 + ch * 8);
          int dv = id >> 3;
          rv[u] = *(const uint4*)(VT + ((long)(b * 512 + h * 128 + dv)) * 2304 + kp0 + ch * 8);
        }
      }
      const u16* ks_ = s + (t & 1) * STG;
      const u16* vs_ = ks_ + 128 * 80;
      bf16x8 pf[2][2];
#pragma unroll
      for (int c = 0; c < 2; ++c) {
#pragma unroll
        for (int kk2 = 0; kk2 < 2; ++kk2) {
          u32x4 pw;
#pragma unroll
          for (int hh = 0; hh < 2; ++hh) {
            const int k4 = kk2 * 2 + hh;
            f32x4 a = {-mshift, -mshift, -mshift, -mshift};
#pragma unroll
            for (int kk = 0; kk < 2; ++kk)
              a = MFMA(*(const bf16x8*)(ks_ + (c * 64 + k4 * 16 + fr) * 80 + kk * 32 + fq * 8), qf[c][kk], a);
            pw[hh * 2 + 0] = pk_bf16(__builtin_amdgcn_exp2f(a[0]), __builtin_amdgcn_exp2f(a[1]));
            pw[hh * 2 + 1] = pk_bf16(__builtin_amdgcn_exp2f(a[2]), __builtin_amdgcn_exp2f(a[3]));
          }
          pf[c][kk2] = *(bf16x8*)&pw;
        }
      }
#pragma unroll
      for (int kk = 0; kk < 2; ++kk) {
        L0 = MFMA(ones, pf[0][kk], L0);
        L1 = MFMA(ones, pf[1][kk], L1);
      }
#pragma unroll
      for (int dt = 0; dt < 8; ++dt) {
#pragma unroll
        for (int kk = 0; kk < 2; ++kk) {
          const u16* vp = vs_ + (dt * 16 + fr) * 72 + kk * 32 + fq * 4;
          uint2 lo = *(const uint2*)vp, hi = *(const uint2*)(vp + 16);
          uint4 av = {lo.x, lo.y, hi.x, hi.y};
          bf16x8 a = *(bf16x8*)&av;
          O0[dt] = MFMA(a, pf[0][kk], O0[dt]);
          O1[dt] = MFMA(a, pf[1][kk], O1[dt]);
        }
      }
      if (more) {
        u16* ns = s + ((t + 1) & 1) * STG;
#pragma unroll
        for (int u = 0; u < 2; ++u) {
          int id = tid + u * 512;
          *(uint4*)(ns + (id >> 3) * 80 + (id & 7) * 8) = rk[u];
          *(uint4*)(ns + 128 * 80 + (id >> 3) * 72 + (id & 7) * 8) = rv[u];
        }
      }
      lds_barrier();
    }
    float i0 = 1.f / L0[0], i1 = lamv / L1[0], ss = 0.f;
#pragma unroll
    for (int dt = 0; dt < 8; ++dt)
#pragma unroll
      for (int j = 0; j < 4; ++j) {
        float o = O0[dt][j] * i0 - O1[dt][j] * i1;
        O0[dt][j] = o;
        ss += o * o;
      }
    ss += __shfl_xor(ss, 16); ss += __shfl_xor(ss, 32);
    float inv = rsqrtf(ss * (1.f / 128.f) + 1e-6f) * (1.f - lambda_init);
    int tok = tokof(b, qp0 + wid * 16 + fr);
#pragma unroll
    for (int dt = 0; dt < 8; ++dt) {
      int dv = dt * 16 + fq * 4;
      const float* sw = p.subln + li * 128 + dv;
      uint2 o;
      o.x = pk_bf16(O0[dt][0] * inv * sw[0], O0[dt][1] * inv * sw[1]);
      o.y = pk_bf16(O0[dt][2] * inv * sw[2], O0[dt][3] * inv * sw[3]);
      *(uint2*)(YA + (long)tok * 512 + h * 128 + dv) = o;
    }
  }
}

template <int L>
DI void hyena_item(const Prm& p, int li, int ch, char* smem) {
  constexpr int CS = 2 * L + 8;
  constexpr int ZS = L + 8;
  constexpr int MT = L / 128;
  constexpr int MG = MT > 8 ? 8 : MT, NG = MT / MG;
  const int tid = mytid(), lane = tid & 63, wid = tid >> 6, fr = lane & 15, fq = lane >> 4;
  u16* cp = (u16*)smem;
  u16* zr = cp + 8 * CS;
  const u16* PH = (const u16*)(p.ws + OFF_AR) + (L == 2048 ? 0L : 32768L * 1536);
  const u16* G = (const u16*)(p.ws + (L == 2048 ? OFF_TAPL : OFF_TAPC));
  u16* YB = (u16*)(p.ws + OFF_Y + U38);
  const float* cw = p.hy_conv + (long)li * 3 * 1536;
  {
    float w0 = cw[1024 + ch], w1 = cw[1536 + 1024 + ch], w2 = cw[3072 + 1024 + ch];
    constexpr int NCH = (16 * L / 8) / 512;
    u32x4 cv[NCH];
    u16 pv[NCH], nv[NCH];
#pragma unroll
    for (int i = 0; i < NCH; ++i) {
      int id = tid + i * 512, b = id / (L / 8), s0 = (id % (L / 8)) * 8;
      const u16* row = PH + ((long)b * 1536 + 1024 + ch) * L + s0;
      cv[i] = *(const u32x4*)row;
      pv[i] = (s0 > 0) ? row[-1] : (u16)0;
      nv[i] = (s0 + 8 < L) ? row[8] : (u16)0;
    }
#pragma unroll
    for (int i = 0; i < NCH; ++i) {
      int id = tid + i * 512, b = id / (L / 8), s0 = (id % (L / 8)) * 8;
      float x[10];
      x[0] = bf2f(pv[i]);
      x[9] = bf2f(nv[i]);
#pragma unroll
      for (int w = 0; w < 4; ++w) {
        x[1 + 2 * w] = __uint_as_float(cv[i][w] << 16);
        x[2 + 2 * w] = __uint_as_float(cv[i][w] & 0xffff0000u);
      }
      float o[8];
#pragma unroll
      for (int e = 0; e < 8; ++e) o[e] = w0 * x[e] + w1 * x[e + 1] + w2 * x[e + 2];
      u32x4 r;
      r[0] = pk_bf16(o[7], o[6]); r[1] = pk_bf16(o[5], o[4]); r[2] = pk_bf16(o[3], o[2]); r[3] = pk_bf16(o[1], o[0]);
      *(u32x4*)(zr + b * ZS + L - 8 - s0) = r;
    }
  }
#pragma unroll
  for (int order = 0; order < 2; ++order) {
    {
      const u16* g = G + (long)(order * 512 + ch) * (2 * L);
      if (tid < 2 * L / 8) {
        const int i0 = tid * 8;
        u32x4 lo = *(const u32x4*)(g + i0);
        u32x4 hi = (i0 + 8 < 2 * L) ? *(const u32x4*)(g + i0 + 8) : u32x4{0u, 0u, 0u, 0u};
        unsigned D[8] = {lo[0], lo[1], lo[2], lo[3], hi[0], hi[1], hi[2], hi[3]};
#pragma unroll
        for (int c = 0; c < 8; ++c) {
          u32x4 o;
#pragma unroll
          for (int w = 0; w < 4; ++w) {
            if (c & 1) o[w] = (D[w + (c - 1) / 2] >> 16) | (D[w + (c + 1) / 2] << 16);
            else o[w] = D[w + c / 2];
          }
          *(u32x4*)(cp + c * CS + i0) = o;
        }
      }
    }
    __syncthreads();
    const float bias = p.hy_bias[(li * 2 + order) * 512 + ch];
    const int gcol = order * 512 + ch;
    const float w0 = cw[gcol], w1 = cw[1536 + gcol], w2 = cw[3072 + gcol];
    const int tq = wid * (L / 8) + fq * 4;
    const u16* xb = PH + ((long)fr * 1536 + gcol) * L + tq;
    const u16* zb = zr + fr * ZS + L - 1 - tq;
    unsigned zp[NG][MG][2];
#pragma unroll
    for (int grp = 0; grp < NG; ++grp) {
      f32x4 acc[MG];
#pragma unroll
      for (int m = 0; m < MG; ++m) acc[m] = f32x4{0.f, 0.f, 0.f, 0.f};
      const int tb = wid * (L / 8) + grp * MG * 16 + fr;
      if constexpr (MG == 8) {
        const int i00 = tb - fq * 8 - 7 + L, c0 = i00 & 7;
        const u16* ab = cp + c0 * CS + (i00 - c0);
        const u16* zbp = zr + fr * ZS + (L - 8 - fq * 8);
        bf16x8 W[16];
#pragma unroll 1
        for (int s0 = 0; s0 < L; s0 += 256) {
#pragma unroll
          for (int k = 0; k < 8; ++k) {
            const int sk = s0 + 32 * k;
            if (k == 0) {
#pragma unroll
              for (int m = 0; m < 8; ++m) W[m] = *(const bf16x8*)(ab + m * 16 - sk);
            }
            if (k < 7) {
              W[(16 - 2 * k - 2) & 15] = *(const bf16x8*)(ab - sk - 32);
              W[(16 - 2 * k - 1) & 15] = *(const bf16x8*)(ab - sk - 32 + 16);
            }
            bf16x8 bk = *(const bf16x8*)(zbp - sk);
#pragma unroll
            for (int m = 0; m < 8; ++m) acc[m] = MFMA(W[(m + 16 - 2 * k) & 15], bk, acc[m]);
          }
        }
      } else {
#pragma unroll 2
        for (int s0 = 0; s0 < L; s0 += 32) {
          bf16x8 bfr = *(const bf16x8*)(zr + fr * ZS + (L - 8 - s0 - fq * 8));
#pragma unroll
          for (int m = 0; m < MG; ++m) {
            int i0 = tb + m * 16 - s0 - fq * 8 - 7 + L;
            int c = i0 & 7;
            bf16x8 afr = *(const bf16x8*)(cp + c * CS + (i0 - c));
            acc[m] = MFMA(afr, bfr, acc[m]);
          }
        }
      }
#pragma unroll
      for (int m = 0; m < MG; ++m) {
        float r4[4];
#pragma unroll
        for (int j = 0; j < 4; ++j) {
          const int off = (grp * MG + m) * 16 + j;
          const int t = tq + off;
          float xa = bf2f(xb[off - 1]), xc = bf2f(xb[off]), xd = bf2f(xb[off + 1]);
          xa = (t > 0) ? xa : 0.f;
          xd = (t + 1 < L) ? xd : 0.f;
          float xg = w0 * xa + w1 * xc + w2 * xd;
          float zin = bf2f(zb[-off]);
          r4[j] = xg * (acc[m][j] + bias * zin);
        }
        zp[grp][m][0] = pk_bf16(r4[0], r4[1]);
        zp[grp][m][1] = pk_bf16(r4[2], r4[3]);
      }
    }
    __syncthreads();
#pragma unroll
    for (int grp = 0; grp < NG; ++grp)
#pragma unroll
      for (int m = 0; m < MG; ++m) {
        int t0 = wid * (L / 8) + (grp * MG + m) * 16 + fq * 4;
        uint2 w;
        w.x = (zp[grp][m][1] >> 16) | (zp[grp][m][1] << 16);
        w.y = (zp[grp][m][0] >> 16) | (zp[grp][m][0] << 16);
        *(uint2*)(zr + fr * ZS + L - 4 - t0) = w;
      }
  }
  __syncthreads();
  {
    u16* YBT = (u16*)(p.ws + OFF_AR + 5 * U38) + (L == 2048 ? 0L : 16L * 512 * 2048);
    constexpr int NCH = (16 * L / 8) / 512;
#pragma unroll
    for (int i = 0; i < NCH; ++i) {
      int id = tid + i * 512, b = id / (L / 8), t0 = (id % (L / 8)) * 8;
      u32x4 r = *(const u32x4*)(zr + b * ZS + L - 8 - t0);
      u32x4 o;
      o[0] = (r[3] >> 16) | (r[3] << 16);
      o[1] = (r[2] >> 16) | (r[2] << 16);
      o[2] = (r[1] >> 16) | (r[1] << 16);
      o[3] = (r[0] >> 16) | (r[0] << 16);
      *(u32x4*)(YBT + ((long)b * 512 + ch) * L + t0) = o;
    }
  }
  __syncthreads();
}

DI long ph_ytrans(const Prm& p, long base, bool lastl, char* smem) {
  u16* tl = (u16*)smem;
  const u16* YBT = (const u16*)(p.ws + OFF_AR + 5 * U38);
  u16* YB = (u16*)(p.ws + OFF_Y + U38);
  const int tid = mytid(), G = gridDim.x;
  const int total = lastl ? 4096 : 4608;
  auto srcp = [&](int it) -> const u16* {
    if (it < 4096) {
      int b = it >> 8, ct = (it >> 5) & 7, lt = it & 31;
      return YBT + ((long)b * 512 + ct * 64 + (tid >> 3)) * 2048 + lt * 64 + (tid & 7) * 8;
    } else {
      int i2 = it - 4096, b = i2 >> 5, ct = (i2 >> 2) & 7, lt = i2 & 3;
      return YBT + 16L * 512 * 2048 + ((long)b * 512 + ct * 64 + (tid >> 3)) * 256 + lt * 64 + (tid & 7) * 8;
    }
  };
  int it = first_item(base);
  u32x4 v = {0u, 0u, 0u, 0u};
  if (it < total) v = *(const u32x4*)srcp(it);
  for (; it < total; it += G) {
    *(u32x4*)(tl + (tid >> 3) * 72 + (tid & 7) * 8) = v;
    __syncthreads();
    if (it + G < total) v = *(const u32x4*)srcp(it + G);
    long tok0;
    int ct;
    if (it < 4096) { int b = it >> 8, lt = it & 31; ct = (it >> 5) & 7; tok0 = (long)b * 2048 + lt * 64; }
    else { int i2 = it - 4096, b = i2 >> 5, lt = i2 & 3; ct = (i2 >> 2) & 7; tok0 = (long)T_LAT + b * 256 + lt * 64; }
    const int lrow = tid >> 3, cc = tid & 7;
    u32x4 o;
#pragma unroll
    for (int w = 0; w < 4; ++w) {
      unsigned lo = tl[(cc * 8 + 2 * w) * 72 + lrow], hi = tl[(cc * 8 + 2 * w + 1) * 72 + lrow];
      o[w] = lo | (hi << 16);
    }
    *(u32x4*)(YB + (tok0 + lrow) * 512 + ct * 64 + cc * 8) = o;
    __syncthreads();
  }
  return base + total;
}

DI void ph_merge(const Prm& p, char* smem, bool lastl) {
  const int tid = mytid(), lane = tid & 63, wid = tid >> 6;
  const int wm = wid >> 1, wn = wid & 1, fr = lane & 15, fq = lane >> 4;
  const u16* H = (const u16*)(p.ws + OFF_HBF);
  const u16* Y = (const u16*)(p.ws + OFF_Y);
  const u16* WG = (const u16*)(p.ws + OFF_WB) + WO_G;
  const u16* WBr = (const u16*)(p.ws + OFF_WB) + WO_B;
  u16* MG = (u16*)(p.ws + OFF_AR);
  const int NT = (lastl ? 256 : 288) * 8, G = gridDim.x;
  Stg r0, r1;
  bool pre = false;
  for (int t = mybid(); t < NT; t += G) {
    const int mt = t >> 3, nt = t & 7;
    const bool hn = t + G < NT;
    const int mt2 = (t + G) >> 3, nt2 = (t + G) & 7;
    f32x4 acc[2][4], g[2][4], y[2][4];
#pragma unroll
    for (int a = 0; a < 2; ++a)
#pragma unroll
      for (int b = 0; b < 4; ++b) acc[a][b] = f32x4{0.f, 0.f, 0.f, 0.f};
    const u16* gA = H + (long)mt * 128 * 1024;
    for (int n = 0; n < 4; ++n) {
      const u16* gB = WG + ((long)n * 1024 + nt * 128) * 1024;
      const u16* yA = Y + (long)n * (T_ALL * 512L) + (long)mt * 128 * 512;
      const u16* yB = WBr + ((long)n * 1024 + nt * 128) * 512;
      gemm_tile<2>(g, gA, 1024, gB, 1024, 1024, smem, r0, r1, pre, yA, 512, yB, 512);
      const u16* nxA = (n < 3) ? gA : (hn ? H + (long)mt2 * 128 * 1024 : nullptr);
      const u16* nxB = (n < 3) ? WG + ((long)(n + 1) * 1024 + nt * 128) * 1024 : WG + ((long)nt2 * 128) * 1024;
      gemm_tile<2>(y, yA, 512, yB, 512, 512, smem, r0, r1, true, nxA, 1024, nxB, 1024);
      pre = true;
#pragma unroll
      for (int a = 0; a < 2; ++a)
#pragma unroll
        for (int b = 0; b < 4; ++b)
#pragma unroll
          for (int j = 0; j < 4; ++j) acc[a][b][j] += y[a][b][j] * __builtin_amdgcn_rcpf(1.f + __expf(-g[a][b][j]));
    }
    pre = hn;
#pragma unroll
    for (int a = 0; a < 2; ++a)
#pragma unroll
      for (int b = 0; b < 4; ++b) {
        int r = wm * 32 + a * 16 + fr, c = wn * 64 + b * 16 + fq * 4;
        uint2 o;
        o.x = pk_bf16(acc[a][b][0], acc[a][b][1]);
        o.y = pk_bf16(acc[a][b][2], acc[a][b][3]);
        *(uint2*)(MG + ((long)mt * 128 + r) * 1024 + nt * 128 + c) = o;
      }
  }
}

DI void run_phase(const Prm& p, int ph, char* smem) {
  if (ph == 0) { ph_init(p, smem); return; }
  const int li = (ph - 1) / 14, k = (ph - 1) % 14;
  const u16* WB = (const u16*)(p.ws + OFF_WB);
  const u16* HB = (const u16*)(p.ws + OFF_HBF);
  const float* MOD = (const float*)(p.ws + OFF_MOD);
  u16* AR = (u16*)(p.ws + OFF_AR);
  u16* Yb = (u16*)(p.ws + OFF_Y);
  const int G = gridDim.x;
  TD d;
  d.split = 0; d.scale = 1.f; d.mode = 0; d.tok0 = 0; d.col0 = 0; d.g = MOD;
  switch (k) {
    case 0: {
      u16* W = (u16*)(p.ws + OFF_WB);
      long base = 0;
      base = tr_job(base, p.w_in + (long)li * 1024 * NIN, 1024, NIN, W + WO_IN, 1, smem);
      base = tr_job(base, p.w_gate + (long)li * 4 * 1048576, 1024, 1024, W + WO_G, 4, smem);
      base = tr_job(base, p.w_branch + (long)li * 4 * 524288, 512, 1024, W + WO_B, 4, smem);
      base = tr_job(base, p.w_o + (long)li * 1048576, 1024, 1024, W + WO_O, 1, smem);
      base = tr_job(base, p.w_mlp1 + (long)li * 4194304, 1024, 4096, W + WO_1, 1, smem);
      base = tr_job(base, p.w_mlp2 + (long)li * 4194304, 4096, 1024, W + WO_2, 1, smem);
      ph_taps1(p, li, base, smem);
      ph_norm(p, li, 0);
    } break;
    case 1: {
      auto dec = [&](int t, TD& o) {
        o.lda = 1024; o.ldb = 1024; o.K = 1024; o.mode = 0;
        if (t < 1728) {
          int mt = t / 12, nt = t % 12;
          o.A = HB + (long)mt * 256 * 1024; o.B = WB + WO_IN + (long)(3584 + nt * 128) * 1024;
          o.C = AR + (long)mt * 256 * 1536 + nt * 128; o.ldc = 1536;
        } else if (t < 2304) {
          int t2 = t - 1728, mt = t2 >> 2, nt = t2 & 3;
          o.A = HB + (long)mt * 256 * 1024; o.B = WB + WO_IN + (long)(5120 + nt * 128) * 1024;
          o.C = Yb + 3 * (U38 / 2) + (long)mt * 256 * 512 + nt * 128; o.ldc = 512;
        } else {
          int mt = t - 2304;
          o.A = HB + (long)mt * 256 * 1024; o.B = WB + WO_IN + (long)5632 * 1024;
          o.C = (u16*)((float*)(p.ws + OFF_PDAB) + (long)mt * 256 * 16); o.ldc = 16; o.mode = 3;
        }
      };
      {
        Stg r0, r1;
        bool pre = false;
        TD dn = d;
        int t = mybid();
        if (t < 2448) dec(t, d);
        for (; t < 2448; t += G) {
          const bool hn = t + G < 2448;
          if (hn) dec(t + G, dn);
          run_tile2<4>(p, d, smem, r0, r1, pre, hn ? dn.A : nullptr, dn.lda, dn.B, dn.ldb);
          pre = hn;
          d = dn;
        }
      }
      ph_taps2(p, 2448, smem);
    } break;
    case 2: ph_dncl(p, li, smem); break;
    case 3: ph_dnscan(p, smem); break;
    case 4: {
      {
        Stg r0, r1;
        bool pre = false;
        for (int t = mybid(); t < 1152; t += G) {
          int mt = t >> 3, nt = t & 7;
          const bool hn = t + G < 1152;
          int mt2 = (t + G) >> 3, nt2 = (t + G) & 7;
          d.lda = 1024; d.ldb = 1024; d.K = 1024;
          d.A = HB + (long)mt * 256 * 1024; d.B = WB + WO_IN + (long)(nt * 128) * 1024;
          d.C = AR + 3 * (U38 / 2); d.ldc = 0; d.mode = 4; d.tok0 = mt * 256; d.col0 = nt;
          d.g = p.qk_gain + li * 128;
          run_tile2<4>(p, d, smem, r0, r1, pre, hn ? HB + (long)mt2 * 256 * 1024 : nullptr, 1024,
                    WB + WO_IN + (long)(nt2 * 128) * 1024, 1024);
          pre = hn;
        }
      }
      ph_dnfin(p, li);
    } break;
    case 5: {
      u16* VT = AR + 5 * (U38 / 2);
      u16* PF = AR + 6 * (U38 / 2);
      auto dec = [&](int t, TD& o) {
        o.lda = 1024; o.ldb = 1024; o.K = 1024;
        if (t < 512) {
          int b = t >> 5, r = t & 31, mt = r >> 4, nt = r & 15;
          o.A = WB + WO_IN + (long)(1024 + mt * 256) * 1024; o.B = HB + ((long)b * 2048 + nt * 128) * 1024;
          o.C = VT + ((long)b * 512 + mt * 256) * 2304 + 256 + nt * 128; o.ldc = 2304;
        } else if (t < 576) {
          int t2 = t - 512, b = t2 >> 2, r = t2 & 3, mt = r >> 1, nt = r & 1;
          o.A = WB + WO_IN + (long)(1024 + mt * 256) * 1024; o.B = HB + ((long)T_LAT + b * 256 + nt * 128) * 1024;
          o.C = VT + ((long)b * 512 + mt * 256) * 2304 + nt * 128; o.ldc = 2304;
        } else {
          int t2 = t - 576, mt = t2 >> 2, nt = t2 & 3;
          o.A = HB + (long)mt * 256 * 1024; o.B = WB + WO_IN + (long)(3072 + nt * 128) * 1024;
          o.C = PF + (long)mt * 256 * 512 + nt * 128; o.ldc = 512;
        }
      };
      {
        Stg r0, r1;
        bool pre = false;
        TD dn = d;
        int t = mybid();
        if (t < 1152) dec(t, d);
        for (; t < 1152; t += G) {
          const bool hn = t + G < 1152;
          if (hn) dec(t + G, dn);
          run_tile2<4>(p, d, smem, r0, r1, pre, hn ? dn.A : nullptr, dn.lda, dn.B, dn.ldb);
          pre = hn;
          d = dn;
        }
      }
    } break;
    case 6: {
      ph_attn(p, li, 0, smem);
      auto dec = [&](int t, TD& o) {
        o.lda = 1024; o.ldb = 1024; o.K = 1024;
        if (t < 1536) {
          int b = t / 96, r = t % 96, mt = r >> 4, nt = r & 15;
          o.A = WB + WO_IN + (long)(1536 + mt * 256) * 1024; o.B = HB + ((long)b * 2048 + nt * 128) * 1024;
          o.C = AR + ((long)b * 1536 + mt * 256) * 2048 + nt * 128; o.ldc = 2048;
        } else {
          int t2 = t - 1536, b = t2 / 12, r = t2 % 12, mt = r >> 1, nt = r & 1;
          o.A = WB + WO_IN + (long)(1536 + mt * 256) * 1024; o.B = HB + ((long)T_LAT + b * 256 + nt * 128) * 1024;
          o.C = AR + 32768L * 1536 + ((long)b * 1536 + mt * 256) * 256 + nt * 128; o.ldc = 256;
        }
      };
      {
        Stg r0, r1;
        bool pre = false;
        TD dn = d;
        int t = first_item(1152);
        if (t < 1728) dec(t, d);
        for (; t < 1728; t += G) {
          const bool hn = t + G < 1728;
          if (hn) dec(t + G, dn);
          run_tile2<4>(p, d, smem, r0, r1, pre, hn ? dn.A : nullptr, dn.lda, dn.B, dn.ldb);
          pre = hn;
          d = dn;
        }
      }
    } break;
    case 7: {
#if !defined(TESTSEL) || TESTSEL == 1
      for (int it = mybid(); it < 512; it += G) hyena_item<2048>(p, li, it, smem);
#endif
#if !defined(TESTSEL) || TESTSEL == 2
      if (li < 3)
        for (int it = mybid(); it < 512; it += G) hyena_item<256>(p, li, it, smem);
#endif
#if !defined(TESTSEL) || TESTSEL == 3
      const u16* PF = AR + 6 * (U38 / 2);
      u16* WF = AR + 3 * (U38 / 2);
      const u16* DCm = (const u16*)(p.ws + OFF_DC);
      auto dec = [&](int t, TD& o) {
        o.A = DCm; o.lda = 128; o.ldb = 512; o.K = 128;
        if (t < 1024) {
          int bg = t >> 4, nt = t & 15, b = bg >> 2, g = bg & 3;
          o.B = PF + ((long)b * 2048 + nt * 128) * 512 + g * 128;
          o.C = WF + ((long)b * 512 + g * 128) * 4096 + nt * 128; o.ldc = 4096; o.split = 2048;
        } else {
          int t2 = t - 1024, bg = t2 >> 1, nt = t2 & 1, b = bg >> 2, g = bg & 3;
          o.B = PF + ((long)T_LAT + b * 256 + nt * 128) * 512 + g * 128;
          o.C = WF + 16L * 512 * 4096 + ((long)b * 512 + g * 128) * 512 + nt * 128; o.ldc = 512; o.split = 256;
        }
      };
      {
        const int NT7 = (li == 3 ? 1024 : 1152);
        Stg r0, r1;
        bool pre = false;
        TD dn = d;
        int t = mybid();
        if (t < NT7) dec(t, d);
        for (; t < NT7; t += G) {
          const bool hn = t + G < NT7;
          if (hn) dec(t + G, dn);
          run_tile2<4>(p, d, smem, r0, r1, pre, hn ? dn.A : nullptr, dn.lda, dn.B, dn.ldb);
          pre = hn;
          d = dn;
        }
      }
#endif
    } break;
    case 8: {
      const u16* WF = AR + 3 * (U38 / 2);
      u16* YF = Yb + 2 * (U38 / 2);
      d.scale = 1.f / 512.f;
      for (int t = mybid(); t < (li == 3 ? 512 : 576); t += G) {
        if (t < 512) {
          int b = t >> 5, r = t & 31, mt = r >> 2, nt = r & 3;
          d.A = (const u16*)(p.ws + OFF_DL) + (long)mt * 256 * 4096; d.lda = 4096;
          d.B = WF + ((long)b * 512 + nt * 128) * 4096; d.ldb = 4096; d.K = 4096;
          d.C = YF + ((long)b * 2048 + mt * 256) * 512 + nt * 128; d.ldc = 512;
        } else {
          int t2 = t - 512, b = t2 >> 2, nt = t2 & 3;
          d.A = (const u16*)(p.ws + OFF_DLC); d.lda = 512;
          d.B = WF + 16L * 512 * 4096 + ((long)b * 512 + nt * 128) * 512; d.ldb = 512; d.K = 512;
          d.C = YF + ((long)T_LAT + b * 256) * 512 + nt * 128; d.ldc = 512;
        }
        run_tile(p, d, smem);
      }
      ph_ytrans(p, 576, li == 3, smem);
    } break;
    case 9: ph_merge(p, smem, li == 3); break;
    case 10: {
      d.mode = 2;
      const int NF = 1024, NTOT = (li == 3) ? 1024 : 1024 + 256;
      auto dec = [&](int t, TD& o) {
        int full = t < NF ? t : NF + ((t - NF) >> 1), half = t < NF ? 0 : ((t - NF) & 1);
        int mt = full >> 3, nt = full & 7;
        o.A = AR + ((long)mt * 256 + half * 128) * 1024; o.lda = 1024;
        o.B = WB + WO_O + (long)nt * 128 * 1024; o.ldb = 1024; o.K = 1024;
        o.tok0 = mt * 256 + half * 128; o.col0 = nt * 128;
        int bb = o.tok0 < T_LAT ? (o.tok0 >> 11) : 16;
        o.g = MOD + ((long)li * 17 + bb) * 6144 + 2 * 1024;
      };
      Stg r0, r1;
      bool pre = false;
      TD dn = d;
      int t = mybid();
      if (t < NTOT) dec(t, d);
      for (; t < NTOT; t += G) {
        const bool hn = t + G < NTOT;
        if (hn) dec(t + G, dn);
        if (t < NF) run_tile2<4>(p, d, smem, r0, r1, pre, hn ? dn.A : nullptr, dn.lda, dn.B, dn.ldb);
        else run_tile2<2>(p, d, smem, r0, r1, pre, hn ? dn.A : nullptr, dn.lda, dn.B, dn.ldb);
        pre = hn;
        d = dn;
      }
    } break;
    case 11: ph_norm(p, li, 1); break;
    case 12: {
      d.mode = 1;
      const int NT12 = (li == 3 ? 4096 : 4608);
      Stg r0, r1;
      bool pre = false;
      for (int t = mybid(); t < NT12; t += G) {
        int mt = ((t >> 7) << 2) + ((t & 31) >> 3), nt = (((t >> 5) & 3) << 3) + (t & 7);
        d.A = HB + (long)mt * 256 * 1024; d.lda = 1024; d.B = WB + WO_1 + (long)nt * 128 * 1024; d.ldb = 1024; d.K = 1024;
        d.C = Yb + (long)mt * 256 * 4096 + nt * 128; d.ldc = 4096;
        const bool hn = t + G < NT12;
        int mt2 = (((t + G) >> 7) << 2) + (((t + G) & 31) >> 3), nt2 = ((((t + G) >> 5) & 3) << 3) + ((t + G) & 7);
        run_tile2<4>(p, d, smem, r0, r1, pre, hn ? HB + (long)mt2 * 256 * 1024 : nullptr, 1024,
                  WB + WO_1 + (long)nt2 * 128 * 1024, 1024);
        pre = hn;
      }
    } break;
    case 13: {
      d.mode = 2;
      const int NF = 1024, NTOT = (li == 3) ? 1024 : 1024 + 256;
      auto dec = [&](int t, TD& o) {
        int full = t < NF ? t : NF + ((t - NF) >> 1), half = t < NF ? 0 : ((t - NF) & 1);
        int mt = full >> 3, nt = full & 7;
        o.A = Yb + ((long)mt * 256 + half * 128) * 4096; o.lda = 4096;
        o.B = WB + WO_2 + (long)nt * 128 * 4096; o.ldb = 4096; o.K = 4096;
        o.tok0 = mt * 256 + half * 128; o.col0 = nt * 128;
        int bb = o.tok0 < T_LAT ? (o.tok0 >> 11) : 16;
        o.g = MOD + ((long)li * 17 + bb) * 6144 + 5 * 1024;
      };
      Stg r0, r1;
      bool pre = false;
      TD dn = d;
      int t = mybid();
      if (t < NTOT) dec(t, d);
      for (; t < NTOT; t += G) {
        const bool hn = t + G < NTOT;
        if (hn) dec(t + G, dn);
        if (t < NF) run_tile2<4>(p, d, smem, r0, r1, pre, hn ? dn.A : nullptr, dn.lda, dn.B, dn.ldb);
        else run_tile2<2>(p, d, smem, r0, r1, pre, hn ? dn.A : nullptr, dn.lda, dn.B, dn.ldb);
        pre = hn;
        d = dn;
      }
    } break;
  }
}


#define XB_TMO      128
#define XB_XCNT(j)  (256  + 64 * (j))
#define XB_XSUB(j)  (1280 + 64 * (j))
#define XB_XGEN(j)  (2304 + 64 * (j))
#define XB_TOP      3328
#define XB_TOPGEN   3392
#define XCD_BAR_WORDS 3456
#define XB_SPIN_CAP (1u << 20)
#define LAS __attribute__((address_space(3)))
DI unsigned xb_ld(unsigned* p) { return __hip_atomic_load(p, __ATOMIC_RELAXED, __HIP_MEMORY_SCOPE_AGENT); }
DI unsigned xb_add(unsigned* p, unsigned v) { return __hip_atomic_fetch_add(p, v, __ATOMIC_RELAXED, __HIP_MEMORY_SCOPE_AGENT); }
DI unsigned xb_xcc_id() { return (unsigned)__builtin_amdgcn_s_getreg((3 << 11) | 20) & 0xFu; }
#define XB_SPIN(cond, bar) do { unsigned _sp = 0; while (cond) { __builtin_amdgcn_s_sleep(1); \
    if ((++_sp & 255u) == 0u) { if (xb_ld(&(bar)[XB_TMO])) break; if (_sp > XB_SPIN_CAP) { atomicAdd(&(bar)[XB_TMO], 1u); break; } } } } while (0)
struct XcdBarrier { unsigned* bar; unsigned x; volatile LAS unsigned* st; };
DI XcdBarrier xcd_barrier_post(unsigned* bar, volatile LAS unsigned* st) {
  XcdBarrier b; b.bar = bar; b.x = xb_xcc_id(); b.st = st;
  if (threadIdx.x == 0) (void)xb_add(&bar[XB_XCNT(b.x)], 1u);
  return b;
}
DI void xcd_barrier_complete(unsigned* bar, unsigned x, unsigned& nloc, unsigned& nx) {
  const unsigned G = gridDim.x * gridDim.y * gridDim.z;
  unsigned sum, cnt, mine, sp = 0u;
  for (;;) {
    sum = 0u; cnt = 0u; mine = 0u;
#pragma unroll
    for (unsigned j = 0; j < 16; ++j) { const unsigned c = xb_ld(&bar[XB_XCNT(j)]); sum += c; cnt += (c > 0u) ? 1u : 0u; mine = (j == x) ? c : mine; }
    if (sum == G) break;
    __builtin_amdgcn_s_sleep(1);
    if ((++sp & 255u) == 0u) { if (xb_ld(&bar[XB_TMO])) break; if (sp > XB_SPIN_CAP) { atomicAdd(&bar[XB_TMO], 1u); break; } }
  }
  nloc = mine > 0u ? mine : 1u; nx = cnt > 0u ? cnt : 1u;
}
DI void xcd_barrier(const XcdBarrier& b) {
  asm volatile("s_waitcnt vmcnt(0)" ::: "memory");
  __syncthreads();
  if (threadIdx.x == 0) {
    unsigned* bar = b.bar;
    __builtin_amdgcn_s_waitcnt(0);
    unsigned nloc = b.st[0], nx = b.st[1];
    if (nloc == 0u) { xcd_barrier_complete(bar, b.x, nloc, nx); b.st[0] = nloc; b.st[1] = nx; }
    const unsigned old = xb_add(&bar[XB_XSUB(b.x)], 1u);
    const unsigned gen = old / nloc;
    if (old + 1u == (gen + 1u) * nloc) {
      __builtin_amdgcn_fence(__ATOMIC_RELEASE, "agent");
      asm volatile("s_waitcnt vmcnt(0)" ::: "memory");
      const unsigned og = xb_add(&bar[XB_TOP], 1u);
      const unsigned tg = og / nx;
      if (og + 1u == (tg + 1u) * nx) xb_add(&bar[XB_TOPGEN], 1u);
      else XB_SPIN(xb_ld(&bar[XB_TOPGEN]) == tg, bar);
      __builtin_amdgcn_fence(__ATOMIC_ACQUIRE, "agent");
      xb_add(&bar[XB_XGEN(b.x)], 1u);
      asm volatile("s_waitcnt vmcnt(0)" ::: "memory");
    } else {
      XB_SPIN(xb_ld(&bar[XB_XGEN(b.x)]) == gen, bar);
      __builtin_amdgcn_fence(__ATOMIC_ACQUIRE, "agent");
      asm volatile("s_waitcnt vmcnt(0)" ::: "memory");
    }
  }
  __syncthreads();
}

extern __shared__ __attribute__((aligned(16))) char dyn_smem[];

__global__ void __launch_bounds__(512) mega(Prm p, int lo, int hi) {
  __shared__ uint4 xb_words;
  if (threadIdx.x == 0) xb_words = make_uint4(0u, 0u, 0u, 0u);
  __syncthreads();
  XcdBarrier xb = xcd_barrier_post((unsigned*)(p.ws + OFF_BAR), (volatile LAS unsigned*)&xb_words);
#ifdef ONLYK
  run_phase(p, ONLYK, dyn_smem);
#else
  for (int ph = lo; ph <= hi; ++ph) {
    long z = 0;
    asm volatile("" : "+s"(z));
    Prm q;
#define LP(f) q.f = p.f + z
    LP(x); LP(c); LP(ctx); LP(c_ctx); LP(w_ada); LP(b_ada); LP(norm1); LP(norm2); LP(w_in); LP(qk_gain); LP(lam);
    LP(subln); LP(hy_conv); LP(hy_w1); LP(hy_b1); LP(hy_freq); LP(hy_w2); LP(hy_b2); LP(hy_w3); LP(hy_bias);
    LP(dn_conv); LP(dn_a_log); LP(dn_dt_bias); LP(dn_norm); LP(w_gate); LP(w_branch); LP(w_o); LP(w_mlp1); LP(w_mlp2);
    LP(out); LP(ws);
#undef LP
    run_phase(q, ph, dyn_smem);
#ifdef PROBEK
    if (ph > 0 && (ph - 1) % 14 == PROBEK) { cg::this_grid().sync(); run_phase(q, ph, dyn_smem); }
#endif
    if (ph < hi) {
      if (ph == lo) cg::this_grid().sync();
      else xcd_barrier(xb);
    }
  }
#endif
}

extern "C" void kernel_launch(void* const* d_in, const int* in_sizes, int n_in, void* d_out, int out_size, void* d_ws,
                              size_t ws_size, hipStream_t stream) {
  static int grid_blocks = 0;
  if (!grid_blocks) {
    hipFuncSetAttribute((const void*)mega, hipFuncAttributeMaxDynamicSharedMemorySize, LDS_BYTES);
    int dev = 0, cus = 0, per_cu = 0;
    hipGetDevice(&dev);
    hipDeviceGetAttribute(&cus, hipDeviceAttributeMultiprocessorCount, dev);
    hipOccupancyMaxActiveBlocksPerMultiprocessor(&per_cu, mega, 512, LDS_BYTES);
    if (per_cu < 1) per_cu = 1;
    grid_blocks = cus * per_cu;
    if (ws_size < (size_t)WS_TOTAL) fprintf(stderr, "workspace too small: %zu < %ld\n", ws_size, (long)WS_TOTAL);
  }
  Prm p;
  const float** pp = (const float**)&p;
  for (int i = 0; i < 29; ++i) pp[i] = (const float*)d_in[i];
  p.out = (float*)d_out;
  p.ws = (char*)d_ws;
#if MULTI
  for (int ph = 0; ph < NPHASE; ++ph) hipLaunchKernelGGL(mega, dim3(grid_blocks), dim3(512), LDS_BYTES, stream, p, ph, ph);
#else
  int lo = 0, hi = NPHASE - 1;
  hipMemsetAsync((char*)d_ws + OFF_BAR, 0, XCD_BAR_WORDS * 4, stream);
  void* args[] = {&p, &lo, &hi};
  hipError_t e = hipLaunchCooperativeKernel((void*)mega, dim3(grid_blocks), dim3(512), args, LDS_BYTES, stream);
  if (e != hipSuccess) fprintf(stderr, "cooperative launch failed: %s (grid %d)\n", hipGetErrorString(e), grid_blocks);
#endif
}
```

```cpp
#include <hip/hip_runtime.h>
#include <hip/hip_cooperative_groups.h>
#include <stdint.h>
#include <stdio.h>
namespace cg = cooperative_groups;

typedef unsigned short u16;
typedef __attribute__((ext_vector_type(8))) short bf16x8;
typedef __attribute__((ext_vector_type(4))) float f32x4;
#define MFMA(a, b, c) __builtin_amdgcn_mfma_f32_16x16x32_bf16(a, b, c, 0, 0, 0)
#define DI __device__ __forceinline__

#ifndef MULTI
#define MULTI 0
#endif

constexpr int T_LAT = 32768, T_ALL = 36864;
constexpr int NIN = 5648;
constexpr long U38 = 37748736L;
constexpr long OFF_XC = 0;
constexpr long OFF_WB = OFF_XC + 16777216L;
constexpr long OFF_HBF = OFF_WB + 43024384L;
constexpr long OFF_MOD = OFF_HBF + 75497472L;
constexpr long OFF_TAPL = OFF_MOD + 1671168L;
constexpr long OFF_TAPC = OFF_TAPL + 8388608L;
constexpr long OFF_DL = OFF_TAPC + 1048576L;
constexpr long OFF_DLC = OFF_DL + 16777216L;
constexpr long OFF_DC = OFF_DLC + 262144L;
constexpr long OFF_PDAB = OFF_DC + 65536L;
constexpr long OFF_GC = OFF_PDAB + 2359296L;
constexpr long OFF_BETA = OFF_GC + 2359296L;
constexpr long OFF_Y = OFF_BETA + 2359296L;
constexpr long OFF_AR = OFF_Y + 4 * U38;
constexpr long OFF_ROPE = OFF_AR + 7 * U38;
constexpr long OFF_BAR = OFF_ROPE + 2 * 262144L;
constexpr long WS_TOTAL = OFF_BAR + 16384L;
constexpr long WO_IN = 0, WO_G = 5783552L, WO_B = 9977856L, WO_O = 12075008L, WO_1 = 13123584L, WO_2 = 17317888L;
constexpr int LDS_BYTES = 139264;
constexpr int NPHASE = 1 + 4 * 14;

struct Prm {
  const float *x, *c, *ctx, *c_ctx, *w_ada, *b_ada, *norm1, *norm2, *w_in, *qk_gain, *lam, *subln, *hy_conv, *hy_w1,
      *hy_b1, *hy_freq, *hy_w2, *hy_b2, *hy_w3, *hy_bias, *dn_conv, *dn_a_log, *dn_dt_bias, *dn_norm, *w_gate,
      *w_branch, *w_o, *w_mlp1, *w_mlp2;
  float* out;
  char* ws;
};

DI int mytid() {
  int t = threadIdx.x;
  asm volatile("" : "+v"(t));
  return t;
}
DI int mybid() {
  int t = blockIdx.x;
  const int G = gridDim.x;
  if ((G & 7) == 0) t = (t & 7) * (G >> 3) + (t >> 3);
  asm volatile("" : "+s"(t));
  return t;
}
DI void lds_barrier() {
  asm volatile("s_waitcnt lgkmcnt(0)" ::: "memory");
  __builtin_amdgcn_s_barrier();
  asm volatile("" ::: "memory");
}
typedef __bf16 bf16x2_t __attribute__((ext_vector_type(2)));
typedef float f32x2_t __attribute__((ext_vector_type(2)));
DI unsigned pk_bf16(float a, float b) {
  f32x2_t v = {a, b};
  bf16x2_t h = __builtin_convertvector(v, bf16x2_t);
  return *(unsigned*)&h;
}
DI u16 f2bf(float f) {
  __bf16 h = (__bf16)f;
  return *(u16*)&h;
}
DI float bf2f(u16 h) { return __uint_as_float(((unsigned)h) << 16); }
DI float wsum(float v) {
  for (int o = 32; o; o >>= 1) v += __shfl_xor(v, o);
  return v;
}
DI float wmax(float v) {
  for (int o = 32; o; o >>= 1) v = fmaxf(v, __shfl_xor(v, o));
  return v;
}
DI float siluf(float v) { return v / (1.f + __expf(-v)); }
DI float sigmf(float v) { return 1.f / (1.f + __expf(-v)); }
DI float* xrow(const Prm& p, int tok) {
  return tok < T_LAT ? p.out + (long)tok * 1024 : (float*)(p.ws + OFF_XC) + (long)(tok - T_LAT) * 1024;
}
DI int first_item(long base) {
  int G = gridDim.x;
  return (int)(((long)mybid() + G - (base % G)) % G);
}
DI int tokof(int b, int P) { return P < 256 ? T_LAT + b * 256 + P : b * 2048 + (P - 256); }

typedef __attribute__((ext_vector_type(4))) unsigned u32x4;
struct Stg { u32x4 a0, a1, a2, a3, b0, b1; };
template <int NA>
DI void g_load(Stg& r, const u16* Ap, long lda, const u16* Bp, long ldb, int k0) {
  r.a0 = *(const u32x4*)(Ap + k0);
  r.a1 = *(const u32x4*)(Ap + 64 * lda + k0);
  if constexpr (NA == 4) {
    r.a2 = *(const u32x4*)(Ap + 128 * lda + k0);
    r.a3 = *(const u32x4*)(Ap + 192 * lda + k0);
  }
  r.b0 = *(const u32x4*)(Bp + k0);
  r.b1 = *(const u32x4*)(Bp + 64 * ldb + k0);
}
template <int NA, int TM>
DI void s_store(const Stg& r, u16* ns_) {
  *(u32x4*)(ns_) = r.a0;
  *(u32x4*)(ns_ + 64 * 80) = r.a1;
  if constexpr (NA == 4) {
    *(u32x4*)(ns_ + 128 * 80) = r.a2;
    *(u32x4*)(ns_ + 192 * 80) = r.a3;
  }
  *(u32x4*)(ns_ + TM * 80) = r.b0;
  *(u32x4*)(ns_ + TM * 80 + 64 * 80) = r.b1;
}
template <int MI>
DI void t_compute(f32x4 (&acc)[MI][4], const u16* as, const u16* bs, int wm, int wn, int fr, int fq) {
#pragma unroll
  for (int ks = 0; ks < 2; ++ks) {
    bf16x8 a[MI], b[4];
#pragma unroll
    for (int mi = 0; mi < MI; ++mi) a[mi] = *(const bf16x8*)(as + (wm * MI * 16 + mi * 16 + fr) * 80 + ks * 32 + fq * 8);
#pragma unroll
    for (int ni = 0; ni < 4; ++ni) b[ni] = *(const bf16x8*)(bs + (wn * 64 + ni * 16 + fr) * 80 + ks * 32 + fq * 8);
#pragma unroll
    for (int mi = 0; mi < MI; ++mi)
#pragma unroll
      for (int ni = 0; ni < 4; ++ni) acc[mi][ni] = MFMA(b[ni], a[mi], acc[mi][ni]);
  }
}
template <int MI>
DI void gemm_tile(f32x4 (&acc)[MI][4], const u16* __restrict__ A, long lda, const u16* __restrict__ B, long ldb, int K,
                  char* smem, Stg& r0, Stg& r1, bool pre, const u16* nA, long nlda, const u16* nB, long nldb) {
  constexpr int TM = MI * 64;
  constexpr int STAGE = (TM + 128) * 80;
  constexpr int NA = TM * 8 / 512;
  u16* s = (u16*)smem;
  const int tid = mytid(), lane = tid & 63, wid = tid >> 6;
  const int wm = wid >> 1, wn = wid & 1, fr = lane & 15, fq = lane >> 4;
  const long to_a = (long)(tid >> 3), to_c = (tid & 7) * 8;
  const u16* Ap = A + to_a * lda + to_c;
  const u16* Bp = B + to_a * ldb + to_c;
  const u16* nAp = nA + to_a * nlda + to_c;
  const u16* nBp = nB + to_a * nldb + to_c;
  const int so = (tid >> 3) * 80 + (tid & 7) * 8;
#define GLOAD(r, k0) g_load<NA>(r, Ap, lda, Bp, ldb, (k0))
#define NLOAD(r, k0) g_load<NA>(r, nAp, nlda, nBp, nldb, (k0))
#define SSTORE(r, st) s_store<NA, TM>(r, s + (st) * STAGE + so)
#define COMPUTE(st) t_compute<MI>(acc, s + (st) * STAGE, s + (st) * STAGE + TM * 80, wm, wn, fr, fq)
#pragma unroll
  for (int mi = 0; mi < MI; ++mi)
#pragma unroll
    for (int ni = 0; ni < 4; ++ni) acc[mi][ni] = f32x4{0.f, 0.f, 0.f, 0.f};
  const int nk = K >> 6;
  if (!pre) {
    GLOAD(r0, 0);
    GLOAD(r1, 64);
  }
  SSTORE(r0, 0);
  lds_barrier();
  for (int kt = 0; kt < nk; kt += 2) {
    if (kt + 2 < nk) GLOAD(r0, (kt + 2) << 6);
    else if (nA) NLOAD(r0, 0);
    COMPUTE(0);
    SSTORE(r1, 1);
    lds_barrier();
    if (kt + 3 < nk) GLOAD(r1, (kt + 3) << 6);
    else if (nA) NLOAD(r1, 64);
    COMPUTE(1);
    if (kt + 2 < nk) SSTORE(r0, 0);
    lds_barrier();
  }
#undef GLOAD
#undef NLOAD
#undef SSTORE
#undef COMPUTE
}

struct TD {
  const u16* A;
  const u16* B;
  u16* C;
  long lda, ldb, ldc;
  int K;
  int mode;
  int split;
  float scale;
  int tok0, col0;
  const float* g;
};

template <int MI = 4>
DI void run_tile2(const Prm& p, const TD& d, char* smem, Stg& r0, Stg& r1, bool pre, const u16* nA, long nlda,
                 const u16* nB, long nldb);
DI void run_tile(const Prm& p, const TD& d, char* smem) {
  Stg r0, r1;
  run_tile2<4>(p, d, smem, r0, r1, false, nullptr, 0, nullptr, 0);
}
template <int MI>
DI void run_tile2(const Prm& p, const TD& d, char* smem, Stg& r0, Stg& r1, bool pre, const u16* nA, long nlda,
                 const u16* nB, long nldb) {
  f32x4 acc[MI][4];
  gemm_tile<MI>(acc, d.A, d.lda, d.B, d.ldb, d.K, smem, r0, r1, pre, nA, nlda, nB, nldb);
  const int tid = mytid(), lane = tid & 63, wid = tid >> 6;
  const int wm = wid >> 1, wn = wid & 1, fr = lane & 15, fq = lane >> 4;
  if (d.mode == 4) {
    const int which = d.col0 >> 2, h = d.col0 & 3;
    const float* gain = d.g + which * 64 + fq * 4;
    const float* RC = (const float*)(p.ws + OFF_ROPE);
    const float* RS = RC + 65536;
    u16* dstb = d.C + (which ? 18874368L : 0L);
    const float qs = which ? 1.f : 0.18033688011112042f;
#pragma unroll
    for (int mi = 0; mi < MI; ++mi) {
      const int tok = d.tok0 + wm * (MI * 16) + mi * 16 + fr;
      float ss = 0.f;
#pragma unroll
      for (int ni = 0; ni < 4; ++ni)
#pragma unroll
        for (int j = 0; j < 4; ++j) ss += acc[mi][ni][j] * acc[mi][ni][j];
      ss += __shfl_xor(ss, 16);
      ss += __shfl_xor(ss, 32);
      const float inv = rsqrtf(ss * (1.f / 64.f) + 1e-6f) * qs;
      int b, P;
      const bool lat = tok < T_LAT;
      if (lat) { b = tok >> 11; P = 256 + (tok & 2047); }
      else { b = (tok - T_LAT) >> 8; P = (tok - T_LAT) & 255; }
      float y[4][4];
#pragma unroll
      for (int ni = 0; ni < 4; ++ni) {
        float4 g4 = *(const float4*)(gain + ni * 16);
        y[ni][0] = acc[mi][ni][0] * inv * g4.x; y[ni][1] = acc[mi][ni][1] * inv * g4.y;
        y[ni][2] = acc[mi][ni][2] * inv * g4.z; y[ni][3] = acc[mi][ni][3] * inv * g4.w;
      }
      u16* dst = dstb + ((long)((b * 4 + h) * 2 + wn) * 2304 + P) * 64 + fq * 4;
#pragma unroll
      for (int ni = 0; ni < 4; ++ni) {
        float o0 = y[ni][0], o1 = y[ni][1], o2 = y[ni][2], o3 = y[ni][3];
        if (lat) {
          const int l = tok & 2047, a = ni >> 1;
          float4 c4 = *(const float4*)(RC + (l * 2 + a) * 16 + fq * 4);
          float4 s4 = *(const float4*)(RS + (l * 2 + a) * 16 + fq * 4);
          const float sg = (ni & 1) ? 1.f : -1.f;
          o0 = y[ni][0] * c4.x + sg * y[ni ^ 1][0] * s4.x;
          o1 = y[ni][1] * c4.y + sg * y[ni ^ 1][1] * s4.y;
          o2 = y[ni][2] * c4.z + sg * y[ni ^ 1][2] * s4.z;
          o3 = y[ni][3] * c4.w + sg * y[ni ^ 1][3] * s4.w;
        }
        uint2 o;
        o.x = pk_bf16(o0, o1);
        o.y = pk_bf16(o2, o3);
        *(uint2*)(dst + ni * 16) = o;
      }
    }
    return;
  }
#pragma unroll
  for (int mi = 0; mi < MI; ++mi)
#pragma unroll
    for (int ni = 0; ni < 4; ++ni) {
      int r = wm * (MI * 16) + mi * 16 + fr, c = wn * 64 + ni * 16 + fq * 4;
      f32x4 v = acc[mi][ni];
      if (d.mode == 0) {
        long ro = d.split ? ((long)(r & 127) * d.ldc + (long)(r >> 7) * d.split) : (long)r * d.ldc;
        uint2 o;
        o.x = pk_bf16(v[0] * d.scale, v[1] * d.scale); o.y = pk_bf16(v[2] * d.scale, v[3] * d.scale);
        *(uint2*)(d.C + ro + c) = o;
      } else if (d.mode == 1) {
        uint2 o;
        float t0 = fmaxf(v[0], 0.f), t1 = fmaxf(v[1], 0.f), t2 = fmaxf(v[2], 0.f), t3 = fmaxf(v[3], 0.f);
        o.x = pk_bf16(t0 * t0, t1 * t1); o.y = pk_bf16(t2 * t2, t3 * t3);
        *(uint2*)(d.C + (long)r * d.ldc + c) = o;
      } else if (d.mode == 3) {
        if (wn == 0 && ni == 0) *(float4*)((float*)d.C + (long)r * 16 + fq * 4) = float4{v[0], v[1], v[2], v[3]};
      } else {
        float4* xp = (float4*)(xrow(p, d.tok0 + r) + d.col0 + c);
        float4 g4 = *(const float4*)(d.g + d.col0 + c);
        float4 x4 = *xp;
        x4.x += g4.x * v[0]; x4.y += g4.y * v[1]; x4.z += g4.z * v[2]; x4.w += g4.w * v[3];
        *xp = x4;
      }
    }
}

DI void ph_init(const Prm& p, char* smem) {
  const long gt = (long)mybid() * 512 + mytid(), gn = (long)gridDim.x * 512;
  {
    const float4* s = (const float4*)p.x;
    float4* d = (float4*)p.out;
#pragma unroll 8
    for (long i = gt; i < 32768L * 256; i += gn) d[i] = s[i];
    const float4* s2 = (const float4*)p.ctx;
    float4* d2 = (float4*)(p.ws + OFF_XC);
#pragma unroll 8
    for (long i = gt; i < 4096L * 256; i += gn) d2[i] = s2[i];
  }
  {
    u16* DL = (u16*)(p.ws + OFF_DL);
    for (long i = gt; i < 2048L * 4096; i += gn) {
      int l = (int)(i >> 12), kk = (int)(i & 4095), lp = kk & 2047, part = kk >> 11;
      int m = (l * lp) & 2047;
      float ang = (float)m * (6.283185307179586f / 2048.f);
      DL[i] = f2bf(part ? -sinf(ang) : cosf(ang));
    }
    u16* DLC = (u16*)(p.ws + OFF_DLC);
    for (long i = gt; i < 256L * 512; i += gn) {
      int l = (int)(i >> 9), kk = (int)(i & 511), lp = kk & 255, part = kk >> 8;
      int m = (l * lp) & 255;
      float ang = (float)m * (6.283185307179586f / 256.f);
      DLC[i] = f2bf(part ? -sinf(ang) : cosf(ang));
    }
    {
      float* RC = (float*)(p.ws + OFF_ROPE);
      float* RS = RC + 65536;
      for (long i = gt; i < 65536; i += gn) {
        int l = (int)(i >> 5), a = (int)(i >> 4) & 1, f = (int)(i & 15);
        float pos = a ? (float)(l & 63) : (float)(l >> 6);
        float ang = pos * powf(10000.f, -(float)f / 16.f);
        RC[i] = cosf(ang);
        RS[i] = sinf(ang);
      }
    }
    u16* DC = (u16*)(p.ws + OFF_DC);
    for (long i = gt; i < 256L * 128; i += gn) {
      int j2 = (int)(i >> 7), ii = (int)(i & 127), part = j2 >> 7, j = j2 & 127;
      int m = (ii * j) & 127;
      float ang = (float)m * (6.283185307179586f / 128.f);
      DC[i] = f2bf(part ? sinf(ang) : cosf(ang));
    }
  }
  float* sc = (float*)smem;
  float* red = sc + 17 * 1024;
  const int tid = mytid();
  for (int e = tid; e < 17 * 1024; e += 512) {
    int bb = e >> 10, k = e & 1023;
    float v = bb < 16 ? p.c[bb * 1024 + k] : p.c_ctx[k];
    sc[e] = v / (1.f + expf(-v));
  }
  __syncthreads();
  float* MOD = (float*)(p.ws + OFF_MOD);
  for (int it = mybid(); it < 192; it += gridDim.x) {
    int li = it / 48, cgp = it % 48;
    int cl = tid & 127, kq = tid >> 7, n = cgp * 128 + cl;
    float a[17];
#pragma unroll
    for (int b = 0; b < 17; ++b) a[b] = 0.f;
    const float* w = p.w_ada + ((long)li * 1024 + kq * 256) * 6144 + n;
#pragma unroll 1
    for (int k = 0; k < 256; k += 8) {
      float wv[8];
#pragma unroll
      for (int u = 0; u < 8; ++u) wv[u] = w[(long)(k + u) * 6144];
#pragma unroll
      for (int u = 0; u < 8; ++u) {
#pragma unroll
        for (int b = 0; b < 17; ++b) a[b] += sc[b * 1024 + kq * 256 + k + u] * wv[u];
        asm volatile("" ::: "memory");
      }
    }
#pragma unroll
    for (int b = 0; b < 17; ++b) red[(kq * 17 + b) * 128 + cl] = a[b];
    __syncthreads();
    for (int e = tid; e < 17 * 128; e += 512) {
      int b = e >> 7, c2 = e & 127, n2 = cgp * 128 + c2;
      float v = p.b_ada[li * 6144 + n2];
      for (int q = 0; q < 4; ++q) v += red[(q * 17 + b) * 128 + c2];
      MOD[((long)li * 17 + b) * 6144 + n2] = v;
    }
    __syncthreads();
  }
}

DI long tr_job(long base, const float* src, int K, int N, u16* dst, int nb, char* smem) {
  float* t = (float*)smem;
  const int tk = K >> 6, tn = (N + 63) >> 6, per = tk * tn, total = per * nb;
  const int tid = mytid();
  const int G = gridDim.x;
  float v[8];
  int it = first_item(base);
  if (it < total) {
    int b = it / per, r = it % per, kt = r / tn, nt = r % tn;
    const float* s = src + (long)b * K * N;
#pragma unroll
    for (int i = 0; i < 8; ++i) {
      int id = tid + i * 512, kk = id >> 6, nn = id & 63;
      v[i] = (nt * 64 + nn < N) ? __builtin_nontemporal_load(&s[(long)(kt * 64 + kk) * N + nt * 64 + nn]) : 0.f;
    }
  }
  for (; it < total; it += G) {
    int b = it / per, r = it % per, kt = r / tn, nt = r % tn;
    u16* d = dst + (long)b * K * N;
    int k0 = kt * 64, n0 = nt * 64;
#pragma unroll
    for (int i = 0; i < 8; ++i) {
      int id = tid + i * 512, kk = id >> 6, nn = id & 63;
      t[kk * 65 + nn] = v[i];
    }
    __syncthreads();
    if (it + G < total) {
      int it2 = it + G, b2 = it2 / per, r2 = it2 % per, kt2 = r2 / tn, nt2 = r2 % tn;
      const float* s2 = src + (long)b2 * K * N;
#pragma unroll
      for (int i = 0; i < 8; ++i) {
        int id = tid + i * 512, kk = id >> 6, nn = id & 63;
        v[i] = (nt2 * 64 + nn < N) ? __builtin_nontemporal_load(&s2[(long)(kt2 * 64 + kk) * N + nt2 * 64 + nn]) : 0.f;
      }
    }
#pragma unroll
    for (int i = 0; i < 8; ++i) {
      int id = tid + i * 512, nn = id >> 6, kk = id & 63;
      if (n0 + nn < N) d[(long)(n0 + nn) * K + k0 + kk] = f2bf(t[kk * 65 + nn]);
    }
    __syncthreads();
  }
  return base + total;
}

DI void ph_norm(const Prm& p, int li, int which) {
  const int lane = mytid() & 63;
  const int gw = mybid() * 8 + (mytid() >> 6), nw = gridDim.x * 8;
  const float* nwt = (which ? p.norm2 : p.norm1) + li * 1024;
  const float* MOD = (const float*)(p.ws + OFF_MOD);
  u16* H = (u16*)(p.ws + OFF_HBF);
  const int nrows = (which && li == 3) ? T_LAT : T_ALL;
  for (int row = gw; row < nrows; row += 2 * nw) {
    const int row2 = row + nw;
    const bool has2 = row2 < nrows;
    const float* xr = xrow(p, row);
    const float* xr2 = xrow(p, has2 ? row2 : row);
    float4 v[4], u[4];
    float ss = 0.f, ss2 = 0.f;
#pragma unroll
    for (int i = 0; i < 4; ++i) {
      v[i] = *(const float4*)(xr + i * 256 + lane * 4);
      u[i] = *(const float4*)(xr2 + i * 256 + lane * 4);
    }
#pragma unroll
    for (int i = 0; i < 4; ++i) {
      ss += v[i].x * v[i].x + v[i].y * v[i].y + v[i].z * v[i].z + v[i].w * v[i].w;
      ss2 += u[i].x * u[i].x + u[i].y * u[i].y + u[i].z * u[i].z + u[i].w * u[i].w;
    }
#pragma unroll
    for (int o = 32; o; o >>= 1) {
      ss += __shfl_xor(ss, o);
      ss2 += __shfl_xor(ss2, o);
    }
    const float inv = rsqrtf(ss * (1.f / 1024.f) + 1e-6f), inv2 = rsqrtf(ss2 * (1.f / 1024.f) + 1e-6f);
    const int bb = row < T_LAT ? (row >> 11) : 16, bb2 = row2 < T_LAT ? (row2 >> 11) : 16;
    const float* sh = MOD + ((long)li * 17 + bb) * 6144 + (which ? 3 : 0) * 1024;
    const float* sh2 = MOD + ((long)li * 17 + (has2 ? bb2 : bb)) * 6144 + (which ? 3 : 0) * 1024;
#pragma unroll
    for (int i = 0; i < 4; ++i) {
      int c = i * 256 + lane * 4;
      float4 w4 = *(const float4*)(nwt + c);
      {
        float4 s4 = *(const float4*)(sh + 1024 + c), h4 = *(const float4*)(sh + c);
        uint2 o;
        o.x = pk_bf16(v[i].x * inv * w4.x * (1.f + s4.x) + h4.x, v[i].y * inv * w4.y * (1.f + s4.y) + h4.y);
        o.y = pk_bf16(v[i].z * inv * w4.z * (1.f + s4.z) + h4.z, v[i].w * inv * w4.w * (1.f + s4.w) + h4.w);
        *(uint2*)(H + (long)row * 1024 + c) = o;
      }
      if (has2) {
        float4 s4 = *(const float4*)(sh2 + 1024 + c), h4 = *(const float4*)(sh2 + c);
        uint2 o;
        o.x = pk_bf16(u[i].x * inv2 * w4.x * (1.f + s4.x) + h4.x, u[i].y * inv2 * w4.y * (1.f + s4.y) + h4.y);
        o.y = pk_bf16(u[i].z * inv2 * w4.z * (1.f + s4.z) + h4.z, u[i].w * inv2 * w4.w * (1.f + s4.w) + h4.w);
        *(uint2*)(H + (long)row2 * 1024 + c) = o;
      }
    }
  }
}

DI void ph_taps1(const Prm& p, int li, long base, char* smem) {
  float* f = (float*)smem;
  float* hraw = (float*)(p.ws + OFF_AR + 5 * U38);
  const int tid = mytid();
  for (int it = first_item(base); it < 288; it += gridDim.x) {
    const int L = it < 256 ? 2048 : 256, j0 = it < 256 ? it * 8 : (it - 256) * 8;
    const int lg = tid >> 6, kk = tid & 63;
    if (tid < 8 * 33) {
      int l2 = tid / 33, e = tid % 33, j = j0 + l2;
      float t = (float)j / (float)(L - 1);
      float w = 6.283185307179586f * (float)j / (float)L;
      float v;
      if (e == 0) v = t;
      else {
        int bi = (e - 1) & 15;
        float band = 1e-4f + (float)bi * ((15.f - 1e-4f) / 15.f);
        v = (e <= 16) ? cosf(band * w) : -sinf(band * w);
      }
      f[l2 * 40 + e] = v;
    }
    __syncthreads();
    {
      float v = p.hy_b1[li * 64 + kk];
#pragma unroll 3
      for (int e = 0; e < 33; ++e) v += f[lg * 40 + e] * p.hy_w1[(li * 33 + e) * 64 + kk];
      f[320 + lg * 64 + kk] = sinf(p.hy_freq[(li * 2 + 0) * 64 + kk] * v);
    }
    __syncthreads();
    {
      float v = p.hy_b2[li * 64 + kk];
#pragma unroll 4
      for (int m = 0; m < 64; ++m) v += f[320 + lg * 64 + m] * p.hy_w2[(li * 64 + m) * 64 + kk];
      f[832 + lg * 64 + kk] = sinf(p.hy_freq[(li * 2 + 1) * 64 + kk] * v);
    }
    __syncthreads();
    {
      float h[4][8];
#pragma unroll
      for (int i = 0; i < 4; ++i)
#pragma unroll
        for (int l2 = 0; l2 < 8; ++l2) h[i][l2] = 0.f;
      const float* w3 = p.hy_w3 + (long)li * 64 * 2048 + tid;
#pragma unroll 2
      for (int k = 0; k < 64; ++k) {
        float wv[4];
#pragma unroll
        for (int i = 0; i < 4; ++i) wv[i] = w3[(long)k * 2048 + i * 512];
#pragma unroll
        for (int l2 = 0; l2 < 8; ++l2) {
          float hv = f[832 + l2 * 64 + k];
#pragma unroll
          for (int i = 0; i < 4; ++i) h[i][l2] += hv * wv[i];
        }
      }
#pragma unroll
      for (int i = 0; i < 4; ++i) {
        int n = tid + i * 512, ch = n & 511;
        float delta = fabsf(-3.0701134573253946f + (float)ch * ((-15.350567286626973f + 3.0701134573253946f) / 511.f));
#pragma unroll
        for (int l2 = 0; l2 < 8; ++l2) {
          int j = j0 + l2;
          float t = (float)j / (float)(L - 1);
          long row = (it < 256) ? j : 2048 + j;
          hraw[row * 2048 + n] = h[i][l2] * expf(-t * delta);
        }
      }
    }
    __syncthreads();
  }
}
DI void ph_taps2(const Prm& p, long base, char* smem) {
  float* vals = (float*)smem;
  float* red = vals + 8 * 2048;
  const float* hraw = (const float*)(p.ws + OFF_AR + 5 * U38);
  const int tid = mytid(), cl = tid & 3, dir = (tid >> 2) & 1, jg = tid >> 3;
  for (int it = first_item(base); it < 512; it += gridDim.x) {
    int ls = it >> 8, order = (it >> 7) & 1, cgp = it & 127;
    int L = ls ? 256 : 2048;
    const float* hr = hraw + (long)(ls ? 2048 : 0) * 2048;
    u16* G = (u16*)(p.ws + (ls ? OFF_TAPC : OFF_TAPL));
    int ch = cgp * 4 + cl, n = order * 1024 + dir * 512 + ch;
    float s = 0.f;
#pragma unroll 8
    for (int j = jg; j < L; j += 64) {
      float v = hr[(long)j * 2048 + n];
      vals[(cl * 2 + dir) * L + j] = v;
      s += (dir == 1 && j == 0) ? 0.f : fabsf(v);
    }
    red[(tid >> 2) * 4 + cl] = s;
    __syncthreads();
    if (tid < 4) {
      float tot = 0.f;
#pragma unroll 8
      for (int r = 0; r < 128; ++r) tot += red[r * 4 + tid];
      red[512 + tid] = 1.f / tot;
    }
    __syncthreads();
    for (int idx = tid; idx < 8 * L; idx += 512) {
      int q = idx / L, j = idx % L, c2 = q >> 1, d2 = q & 1;
      float v = vals[idx] * red[512 + c2];
      u16* g = G + (long)(order * 512 + cgp * 4 + c2) * (2 * L);
      if (d2 == 0) g[L + j] = f2bf(v);
      else if (j > 0) g[L - j] = f2bf(v);
      else g[0] = 0;
    }
    __syncthreads();
  }
}

DI void ph_pdab(const Prm& p, int li, char* smem) {
  float* wl = (float*)smem;
  const int tid = mytid(), lane = tid & 63;
#pragma unroll 8
  for (int e = tid; e < 1024 * 16; e += 512) wl[e] = p.w_in[((long)li * 1024 + (e >> 4)) * NIN + 5632 + (e & 15)];
  __syncthreads();
  const u16* H = (const u16*)(p.ws + OFF_HBF);
  float* out = (float*)(p.ws + OFF_PDAB);
  const int gw = mybid() * 8 + (tid >> 6), nw = gridDim.x * 8;
  for (int tok = gw; tok < T_ALL; tok += nw) {
    float a[16];
#pragma unroll
    for (int j = 0; j < 16; ++j) a[j] = 0.f;
    float hv[16];
#pragma unroll
    for (int i = 0; i < 16; ++i) hv[i] = bf2f(H[(long)tok * 1024 + lane + i * 64]);
#pragma unroll
    for (int i = 0; i < 16; ++i) {
      float h = hv[i];
      const float4* wp = (const float4*)(wl + (lane + i * 64) * 16);
#pragma unroll
      for (int q = 0; q < 4; ++q) {
        float4 w4 = wp[q];
        a[q * 4 + 0] += h * w4.x;
        a[q * 4 + 1] += h * w4.y;
        a[q * 4 + 2] += h * w4.z;
        a[q * 4 + 3] += h * w4.w;
      }
      if ((i & 3) == 3) asm volatile("" ::: "memory");
    }
#pragma unroll
    for (int o = 32; o; o >>= 1)
#pragma unroll
      for (int j = 0; j < 16; ++j) a[j] += __shfl_xor(a[j], o);
    float v = a[0];
#pragma unroll
    for (int j = 1; j < 16; ++j) v = (lane == j) ? a[j] : v;
    if (lane < 16) out[(long)tok * 16 + lane] = v;
  }
  __syncthreads();
}

DI void ph_dncl(const Prm& p, int li, char* smem) {
  const int tid = mytid(), lane = tid & 63, wid = tid >> 6, fr = lane & 15, fq = lane >> 4;
  u16* qn = (u16*)smem;
  u16* kn = qn + 64 * 144;
  float* fb = (float*)(smem + 36864);
  float* KK = fb;
  float* QK = KK + 64 * 65;
  float* Am = QK + 64 * 65;
  float* Tm = Am + 2 * 64 * 65;
  float* gcs = Tm + 2 * 64 * 65;
  float* bts = gcs + 128;
  const u16* PD = (const u16*)(p.ws + OFF_AR);
  const float* AB = (const float*)(p.ws + OFF_PDAB);
  u16* DQ = (u16*)(p.ws + OFF_Y);
  u16* DK = DQ + 18874368L;
  u16* DV = DK + 18874368L;
  u16* CL = (u16*)(p.ws + OFF_AR + 3 * U38);
  float* GC = (float*)(p.ws + OFF_GC);
  float* BT = (float*)(p.ws + OFF_BETA);
  const float* cw = p.dn_conv + (long)li * 3 * 1536;
  for (int it = mybid(); it < 2304; it += gridDim.x) {
    const int b = it / 144, r0 = it % 144, oc = r0 >> 2, h = r0 & 3;
    const int pos0 = oc * 64, s0 = oc < 4 ? 0 : 256, e0 = oc < 4 ? 256 : 2304;
    if (tid < 384) {
      const int cgp = tid % 48, rs = tid / 48;
      const int part = cgp >> 4, d0 = (cgp & 15) * 8, col = part * 512 + h * 128 + d0;
      const u16* basep = PD + (long)tokof(b, pos0) * 1536 + col;
      float wt[3][8];
#pragma unroll
      for (int tp = 0; tp < 3; ++tp) {
        float4 wa = *(const float4*)(cw + tp * 1536 + col), wb = *(const float4*)(cw + tp * 1536 + col + 4);
        wt[tp][0] = wa.x; wt[tp][1] = wa.y; wt[tp][2] = wa.z; wt[tp][3] = wa.w;
        wt[tp][4] = wb.x; wt[tp][5] = wb.y; wt[tp][6] = wb.z; wt[tp][7] = wb.w;
      }
#pragma unroll 1
      for (int hf = 0; hf < 2; ++hf) {
        u32x4 rw[6];
#pragma unroll
        for (int i = 0; i < 6; ++i) {
          int j = rs * 8 + hf * 4 - 1 + i, P = pos0 + j;
          rw[i] = (P >= s0 && P < e0) ? *(const u32x4*)(basep + (long)j * 1536) : u32x4{0u, 0u, 0u, 0u};
        }
#pragma unroll
        for (int r = 0; r < 4; ++r) {
#pragma unroll
          for (int e = 0; e < 8; ++e) {
            unsigned w0_ = rw[r][e >> 1], w1_ = rw[r + 1][e >> 1], w2_ = rw[r + 2][e >> 1];
            float x0 = (e & 1) ? __uint_as_float(w0_ & 0xffff0000u) : __uint_as_float(w0_ << 16);
            float x1 = (e & 1) ? __uint_as_float(w1_ & 0xffff0000u) : __uint_as_float(w1_ << 16);
            float x2 = (e & 1) ? __uint_as_float(w2_ & 0xffff0000u) : __uint_as_float(w2_ << 16);
            float v = wt[0][e] * x0 + wt[1][e] * x1 + wt[2][e] * x2;
            fb[(rs * 8 + hf * 4 + r) * 385 + part * 128 + d0 + e] = v * __builtin_amdgcn_rcpf(1.f + __expf(-v));
          }
        }
      }
    }
    __syncthreads();
    for (int jj = 0; jj < 8; ++jj) {
      int j = wid * 8 + jj, P = pos0 + j;
      long go = ((long)(b * 4 + h) * 2304 + P) * 128;
      float q0 = fb[j * 385 + lane], q1 = fb[j * 385 + 64 + lane];
      float k0 = fb[j * 385 + 128 + lane], k1 = fb[j * 385 + 192 + lane];
      float v0 = fb[j * 385 + 256 + lane], v1 = fb[j * 385 + 320 + lane];
      float iq = rsqrtf(wsum(q0 * q0 + q1 * q1) + 1e-6f), ik = rsqrtf(wsum(k0 * k0 + k1 * k1) + 1e-6f);
      u16 a0 = f2bf(q0 * iq), a1 = f2bf(q1 * iq), c0 = f2bf(k0 * ik), c1 = f2bf(k1 * ik);
      qn[j * 144 + lane] = a0; qn[j * 144 + 64 + lane] = a1;
      kn[j * 144 + lane] = c0; kn[j * 144 + 64 + lane] = c1;
      DQ[go + lane] = a0; DQ[go + 64 + lane] = a1;
      DK[go + lane] = c0; DK[go + 64 + lane] = c1;
      DV[go + lane] = f2bf(v0); DV[go + 64 + lane] = f2bf(v1);
    }
    __syncthreads();
#pragma unroll
    for (int u = 0; u < 4; ++u) {
      int tt = wid * 4 + u, which = tt >> 4, ti = (tt >> 2) & 3, tj = tt & 3;
      const u16* Ap = (which ? qn : kn) + (ti * 16 + fr) * 144 + fq * 8;
      const u16* Bp = kn + (tj * 16 + fr) * 144 + fq * 8;
      f32x4 a = {0.f, 0.f, 0.f, 0.f};
#pragma unroll
      for (int ks = 0; ks < 4; ++ks) a = MFMA(*(const bf16x8*)(Ap + ks * 32), *(const bf16x8*)(Bp + ks * 32), a);
      float* dst = which ? QK : KK;
#pragma unroll
      for (int j = 0; j < 4; ++j) dst[(ti * 16 + fq * 4 + j) * 65 + tj * 16 + fr] = a[j];
    }
    if (tid < 128) {
      int d = tid >> 6, r = tid & 63, j = d ? 63 - r : r;
      int tok = tokof(b, pos0 + j);
      float av = AB[(long)tok * 16 + d * 4 + h], bv = AB[(long)tok * 16 + 8 + d * 4 + h];
      float xx = av + p.dn_dt_bias[li * 8 + d * 4 + h];
      float sp = fmaxf(xx, 0.f) + __logf(1.f + __expf(-fabsf(xx)));
      float g = -expf(p.dn_a_log[li * 8 + d * 4 + h]) * sp;
      for (int o = 1; o < 64; o <<= 1) {
        float t = __shfl_up(g, o);
        if (r >= o) g += t;
      }
      float be = 1.f / (1.f + expf(-bv));
      gcs[d * 64 + r] = g;
      bts[d * 64 + r] = be;
      long ci = ((long)((b * 4 + h) * 2 + d) * 36 + oc) * 64 + r;
      GC[ci] = g;
      BT[ci] = be;
    }
    __syncthreads();
#pragma unroll 4
    for (int e = tid; e < 8192; e += 512) {
      int d = e >> 12, s = (e >> 6) & 63, r = e & 63;
      int j = d ? 63 - r : r, js = d ? 63 - s : s;
      float v = 0.f;
      if (r > s) v = bts[d * 64 + r] * KK[j * 65 + js] * __expf(gcs[d * 64 + r] - gcs[d * 64 + s]);
      Am[(d * 64 + s) * 64 + r] = v;
    }
#pragma unroll 4
    for (int e = tid; e < 8192; e += 512) {
      int d = e >> 12, r = (e >> 6) & 63, s = e & 63;
      int j = d ? 63 - r : r, js = d ? 63 - s : s;
      float dec = (r >= s) ? __expf(gcs[d * 64 + r] - gcs[d * 64 + s]) : 0.f;
      long ci = (long)((b * 4 + h) * 2 + d) * 36 + oc;
      CL[ci * 8192 + 4096 + r * 64 + s] = f2bf(QK[j * 65 + js] * dec * 0.08838834764831845f);
    }
    __syncthreads();
    {
      const int d = tid >> 8, c = (tid >> 2) & 63, q = tid & 3;
      const float* Atq = Am + d * 64 * 64 + q;
      float* T = Tm + d * 64 * 65;
      float t[16];
#pragma unroll
      for (int i = 0; i < 16; ++i) t[i] = (4 * i + q == c) ? 1.f : 0.f;
#pragma unroll
      for (int s2 = 0; s2 < 63; ++s2) {
        constexpr int dummy = 0;
        const int is = s2 >> 2, qs = s2 & 3;
        const int ctl = qs | (qs << 2) | (qs << 4) | (qs << 6);
        int tsb;
        if (qs == 0) tsb = __builtin_amdgcn_update_dpp(0, __float_as_int(t[is]), 0x00, 0xf, 0xf, false);
        else if (qs == 1) tsb = __builtin_amdgcn_update_dpp(0, __float_as_int(t[is]), 0x55, 0xf, 0xf, false);
        else if (qs == 2) tsb = __builtin_amdgcn_update_dpp(0, __float_as_int(t[is]), 0xAA, 0xf, 0xf, false);
        else tsb = __builtin_amdgcn_update_dpp(0, __float_as_int(t[is]), 0xFF, 0xf, 0xf, false);
        (void)ctl; (void)dummy;
        const float ts = __int_as_float(tsb);
#pragma unroll
        for (int i = is; i < 16; ++i) t[i] -= Atq[s2 * 64 + 4 * i] * ts;
        if ((s2 & 7) == 7) asm volatile("" ::: "memory");
      }
#pragma unroll
      for (int i = 0; i < 16; ++i) T[(4 * i + q) * 65 + c] = t[i];
    }
    __syncthreads();
    for (int e = tid; e < 8192; e += 512) {
      int d = e >> 12, rc = e & 4095;
      long ci = (long)((b * 4 + h) * 2 + d) * 36 + oc;
      CL[ci * 8192 + rc] = f2bf(Tm[(d * 64 + (rc >> 6)) * 65 + (rc & 63)]);
    }
    __syncthreads();
  }
}

DI void ph_dnscan(const Prm& p, char* smem) {
  const int tid = mytid(), lane = tid & 63, wid = tid >> 6, fr = lane & 15, fq = lane >> 4;
  u16* Kg = (u16*)smem;
  u16* Qg = Kg + 64 * 144;
  u16* KdT = Qg + 64 * 144;
  u16* Tl = KdT + 128 * 80;
  u16* Il = Tl + 64 * 80;
  u16* ST = Il + 64 * 80;
  u16* RT = ST + 64 * 144;
  u16* VN = RT + 64 * 80;
  const u16* DQ = (const u16*)(p.ws + OFF_Y);
  const u16* DK = DQ + 18874368L;
  const u16* DV = DK + 18874368L;
  const u16* CL = (const u16*)(p.ws + OFF_AR + 3 * U38);
  const float* GC = (const float*)(p.ws + OFF_GC);
  const float* BT = (const float*)(p.ws + OFF_BETA);
  const int vt = wid & 3, rp = wid >> 2;
  for (int it = mybid(); it < 256; it += gridDim.x) {
    const int b = it >> 4, h = (it >> 2) & 3, d = (it >> 1) & 1, vs = it & 1;
    u16* O = (u16*)(p.ws + OFF_AR + (d ? 6 : 5) * U38);
    f32x4 S[4];
#pragma unroll
    for (int i = 0; i < 4; ++i) S[i] = f32x4{0.f, 0.f, 0.f, 0.f};
    for (int e = tid; e < 64 * 144; e += 512) ST[e] = 0;
    const long seqb = (long)(b * 4 + h) * 2304;
    const long cib = (long)((b * 4 + h) * 2 + d) * 36;
    u32x4 rk0, rk1, rq0, rq1, rT, rI;
    float rg0, rg1, rgl;
    uint2 rv0, rv1;
    float rb0, rb1;
    const int lr0 = tid >> 4, lr1 = (tid + 512) >> 4, lch = tid & 15;
    const int lj0 = d ? 63 - lr0 : lr0, lj1 = d ? 63 - lr1 : lr1;
    const int vr0 = (rp * 2) * 16 + fr, vr1 = (rp * 2 + 1) * 16 + fr;
    const int vj0 = d ? 63 - vr0 : vr0, vj1 = d ? 63 - vr1 : vr1;
#define SCAN_LOAD_KQ(ocx)                                                                    \
  {                                                                                          \
    const long ci_ = cib + (ocx);                                                            \
    const long g0_ = (seqb + (ocx) * 64 + lj0) * 128 + lch * 8, g1_ = (seqb + (ocx) * 64 + lj1) * 128 + lch * 8; \
    rk0 = *(const u32x4*)(DK + g0_); rk1 = *(const u32x4*)(DK + g1_);                        \
    rq0 = *(const u32x4*)(DQ + g0_); rq1 = *(const u32x4*)(DQ + g1_);                        \
    rT = *(const u32x4*)(CL + ci_ * 8192 + (tid >> 3) * 64 + (tid & 7) * 8);                 \
    rI = *(const u32x4*)(CL + ci_ * 8192 + 4096 + (tid >> 3) * 64 + (tid & 7) * 8);          \
    rg0 = GC[ci_ * 64 + lr0]; rg1 = GC[ci_ * 64 + lr1]; rgl = GC[ci_ * 64 + 63];             \
  }
#define SCAN_LOAD_V(ocx)                                                                     \
  {                                                                                          \
    const long ci_ = cib + (ocx);                                                            \
    rv0 = *(const uint2*)(DV + (seqb + (ocx) * 64 + vj0) * 128 + vs * 64 + vt * 16 + fq * 4); \
    rv1 = *(const uint2*)(DV + (seqb + (ocx) * 64 + vj1) * 128 + vs * 64 + vt * 16 + fq * 4); \
    rb0 = BT[ci_ * 64 + vr0]; rb1 = BT[ci_ * 64 + vr1];                                      \
  }
    {
      const int oc0 = d ? 3 : 0;
      SCAN_LOAD_KQ(oc0);
      SCAN_LOAD_V(oc0);
    }
    for (int i = 0; i < 36; ++i) {
      const int oc = d ? (i < 4 ? 3 - i : 39 - i) : i;
      const int ocn = d ? (i + 1 < 4 ? 3 - (i + 1) : 39 - (i + 1)) : i + 1;
      const int pos0 = oc * 64;
      const float gl = rgl;
      {
        float eg0 = __expf(rg0), ed0 = __expf(gl - rg0), eg1 = __expf(rg1), ed1 = __expf(gl - rg1);
        u32x4 ko0, qo0, ko1, qo1;
#pragma unroll
        for (int w = 0; w < 4; ++w) {
          float k0l = __uint_as_float(rk0[w] << 16), k0h = __uint_as_float(rk0[w] & 0xffff0000u);
          float q0l = __uint_as_float(rq0[w] << 16), q0h = __uint_as_float(rq0[w] & 0xffff0000u);
          float k1l = __uint_as_float(rk1[w] << 16), k1h = __uint_as_float(rk1[w] & 0xffff0000u);
          float q1l = __uint_as_float(rq1[w] << 16), q1h = __uint_as_float(rq1[w] & 0xffff0000u);
          ko0[w] = pk_bf16(k0l * eg0, k0h * eg0);
          qo0[w] = pk_bf16(q0l * eg0 * 0.08838834764831845f, q0h * eg0 * 0.08838834764831845f);
          ko1[w] = pk_bf16(k1l * eg1, k1h * eg1);
          qo1[w] = pk_bf16(q1l * eg1 * 0.08838834764831845f, q1h * eg1 * 0.08838834764831845f);
          KdT[(lch * 8 + 2 * w) * 80 + lr0] = f2bf(k0l * ed0);
          KdT[(lch * 8 + 2 * w + 1) * 80 + lr0] = f2bf(k0h * ed0);
          KdT[(lch * 8 + 2 * w) * 80 + lr1] = f2bf(k1l * ed1);
          KdT[(lch * 8 + 2 * w + 1) * 80 + lr1] = f2bf(k1h * ed1);
        }
        *(u32x4*)(Kg + lr0 * 144 + lch * 8) = ko0;
        *(u32x4*)(Qg + lr0 * 144 + lch * 8) = qo0;
        *(u32x4*)(Kg + lr1 * 144 + lch * 8) = ko1;
        *(u32x4*)(Qg + lr1 * 144 + lch * 8) = qo1;
        *(u32x4*)(Tl + (tid >> 3) * 80 + (tid & 7) * 8) = rT;
        *(u32x4*)(Il + (tid >> 3) * 80 + (tid & 7) * 8) = rI;
      }
      lds_barrier();
      if (i + 1 < 36) SCAN_LOAD_KQ(ocn);
      f32x4 ks_[2], qs_[2];
#pragma unroll
      for (int u = 0; u < 2; ++u) { ks_[u] = f32x4{0.f, 0.f, 0.f, 0.f}; qs_[u] = f32x4{0.f, 0.f, 0.f, 0.f}; }
#pragma unroll
      for (int kk = 0; kk < 4; ++kk) {
        bf16x8 a = *(const bf16x8*)(ST + (vt * 16 + fr) * 144 + kk * 32 + fq * 8);
#pragma unroll
        for (int u = 0; u < 2; ++u) {
          int rt = rp * 2 + u;
          bf16x8 bk = *(const bf16x8*)(Kg + (rt * 16 + fr) * 144 + kk * 32 + fq * 8);
          bf16x8 bq = *(const bf16x8*)(Qg + (rt * 16 + fr) * 144 + kk * 32 + fq * 8);
          ks_[u] = MFMA(a, bk, ks_[u]);
          qs_[u] = MFMA(a, bq, qs_[u]);
        }
      }
      {
        int v0 = vt * 16 + fq * 4;
        RT[(v0 + 0) * 80 + vr0] = f2bf(rb0 * (__uint_as_float(rv0.x << 16) - ks_[0][0]));
        RT[(v0 + 1) * 80 + vr0] = f2bf(rb0 * (__uint_as_float(rv0.x & 0xffff0000u) - ks_[0][1]));
        RT[(v0 + 2) * 80 + vr0] = f2bf(rb0 * (__uint_as_float(rv0.y << 16) - ks_[0][2]));
        RT[(v0 + 3) * 80 + vr0] = f2bf(rb0 * (__uint_as_float(rv0.y & 0xffff0000u) - ks_[0][3]));
        RT[(v0 + 0) * 80 + vr1] = f2bf(rb1 * (__uint_as_float(rv1.x << 16) - ks_[1][0]));
        RT[(v0 + 1) * 80 + vr1] = f2bf(rb1 * (__uint_as_float(rv1.x & 0xffff0000u) - ks_[1][1]));
        RT[(v0 + 2) * 80 + vr1] = f2bf(rb1 * (__uint_as_float(rv1.y << 16) - ks_[1][2]));
        RT[(v0 + 3) * 80 + vr1] = f2bf(rb1 * (__uint_as_float(rv1.y & 0xffff0000u) - ks_[1][3]));
      }
      if (i + 1 < 36) SCAN_LOAD_V(ocn);
      lds_barrier();
      {
        f32x4 vn[2];
#pragma unroll
        for (int u = 0; u < 2; ++u) vn[u] = f32x4{0.f, 0.f, 0.f, 0.f};
#pragma unroll
        for (int kk = 0; kk < 2; ++kk) {
          bf16x8 a = *(const bf16x8*)(RT + (vt * 16 + fr) * 80 + kk * 32 + fq * 8);
#pragma unroll
          for (int u = 0; u < 2; ++u) {
            bf16x8 bb = *(const bf16x8*)(Tl + ((rp * 2 + u) * 16 + fr) * 80 + kk * 32 + fq * 8);
            vn[u] = MFMA(a, bb, vn[u]);
          }
        }
#pragma unroll
        for (int u = 0; u < 2; ++u) {
          int r = (rp * 2 + u) * 16 + fr, v0 = vt * 16 + fq * 4;
#pragma unroll
          for (int j = 0; j < 4; ++j) VN[(v0 + j) * 80 + r] = f2bf(vn[u][j]);
        }
      }
      lds_barrier();
#pragma unroll
      for (int kk = 0; kk < 2; ++kk) {
        bf16x8 a = *(const bf16x8*)(VN + (vt * 16 + fr) * 80 + kk * 32 + fq * 8);
#pragma unroll
        for (int u = 0; u < 2; ++u) {
          bf16x8 bb = *(const bf16x8*)(Il + ((rp * 2 + u) * 16 + fr) * 80 + kk * 32 + fq * 8);
          qs_[u] = MFMA(a, bb, qs_[u]);
        }
      }
#pragma unroll
      for (int u = 0; u < 2; ++u) {
        int r = (rp * 2 + u) * 16 + fr, j = d ? 63 - r : r;
        u16* op = O + (long)tokof(b, pos0 + j) * 512 + h * 128 + vs * 64 + vt * 16 + fq * 4;
        ushort4 ov4;
        ov4.x = f2bf(qs_[u][0]); ov4.y = f2bf(qs_[u][1]); ov4.z = f2bf(qs_[u][2]); ov4.w = f2bf(qs_[u][3]);
        *(ushort4*)op = ov4;
      }
      {
        float ge = __expf(gl);
#pragma unroll
        for (int u = 0; u < 4; ++u) S[u] *= ge;
#pragma unroll
        for (int kk = 0; kk < 2; ++kk) {
          bf16x8 a = *(const bf16x8*)(VN + (vt * 16 + fr) * 80 + kk * 32 + fq * 8);
#pragma unroll
          for (int u = 0; u < 4; ++u) {
            bf16x8 bb = *(const bf16x8*)(KdT + ((rp * 4 + u) * 16 + fr) * 80 + kk * 32 + fq * 8);
            S[u] = MFMA(a, bb, S[u]);
          }
        }
#pragma unroll
        for (int u = 0; u < 4; ++u) {
          int dd = (rp * 4 + u) * 16 + fr, v0 = vt * 16 + fq * 4;
#pragma unroll
          for (int j = 0; j < 4; ++j) ST[(v0 + j) * 144 + dd] = f2bf(S[u][j]);
        }
      }
      lds_barrier();
    }
#undef SCAN_LOAD_KQ
#undef SCAN_LOAD_V
  }
}

DI void ph_dnfin(const Prm& p, int li) {
  const int lane = mytid() & 63;
  const int gw = mybid() * 8 + (mytid() >> 6), nw = gridDim.x * 8;
  const u16* O = (const u16*)(p.ws + OFF_AR + 5 * U38);
  const u16* O2 = (const u16*)(p.ws + OFF_AR + 6 * U38);
  u16* Z = (u16*)(p.ws + OFF_Y + 3 * U38);
  const float n0 = p.dn_norm[li * 128 + lane * 2], n1 = p.dn_norm[li * 128 + lane * 2 + 1];
  const int ntok = (li == 3) ? T_LAT : T_ALL;
#pragma unroll 2
  for (int tok = gw; tok < ntok; tok += nw) {
    ushort2 oa[4], ob[4], zz[4];
    float ox[4], oy[4], ss[4];
#pragma unroll
    for (int h = 0; h < 4; ++h) {
      long o = (long)tok * 512 + h * 128 + lane * 2;
      oa[h] = *(const ushort2*)(O + o);
      ob[h] = *(const ushort2*)(O2 + o);
      zz[h] = *(const ushort2*)(Z + o);
    }
#pragma unroll
    for (int h = 0; h < 4; ++h) {
      ox[h] = bf2f(oa[h].x) + bf2f(ob[h].x);
      oy[h] = bf2f(oa[h].y) + bf2f(ob[h].y);
      ss[h] = ox[h] * ox[h] + oy[h] * oy[h];
    }
#pragma unroll
    for (int o = 32; o; o >>= 1)
#pragma unroll
      for (int h = 0; h < 4; ++h) ss[h] += __shfl_xor(ss[h], o);
#pragma unroll
    for (int h = 0; h < 4; ++h) {
      float inv = rsqrtf(ss[h] * (1.f / 128.f) + 1e-6f);
      float z0 = bf2f(zz[h].x), z1 = bf2f(zz[h].y);
      ushort2 y;
      y.x = f2bf(ox[h] * inv * n0 * (z0 * __builtin_amdgcn_rcpf(1.f + __expf(-z0))));
      y.y = f2bf(oy[h] * inv * n1 * (z1 * __builtin_amdgcn_rcpf(1.f + __expf(-z1))));
      *(ushort2*)(Z + (long)tok * 512 + h * 128 + lane * 2) = y;
    }
  }
}

DI void ph_aprep(const Prm& p, int li) {
  const int lane = mytid() & 63;
  const int gw = mybid() * 8 + (mytid() >> 6), nw = gridDim.x * 8;
  const u16* PA = (const u16*)(p.ws + OFF_AR);
  u16* QH = (u16*)(p.ws + OFF_AR + 3 * U38);
  u16* KH = QH + 18874368L;
  const int f = lane & 15;
  const float inv_f = powf(10000.f, -(float)f / 16.f);
  for (int tok = gw; tok < T_ALL; tok += nw) {
    int b, P;
    float cs = 1.f, sn = 0.f;
    if (tok < T_LAT) {
      b = tok >> 11;
      int l = tok & 2047;
      P = 256 + l;
      float pos = (lane < 32) ? (float)(l >> 6) : (float)(l & 63);
      float ang = pos * inv_f;
      cs = cosf(ang);
      sn = sinf(ang);
    } else {
      b = (tok - T_LAT) >> 8;
      P = (tok - T_LAT) & 255;
    }
    float xv[16], ssq[16];
#pragma unroll
    for (int g = 0; g < 16; ++g) {
      xv[g] = bf2f(PA[(long)tok * 1024 + g * 64 + lane]);
      ssq[g] = xv[g] * xv[g];
    }
#pragma unroll
    for (int o = 32; o; o >>= 1)
#pragma unroll
      for (int g = 0; g < 16; ++g) ssq[g] += __shfl_xor(ssq[g], o);
#pragma unroll
    for (int g = 0; g < 16; ++g) {
      int which = g >> 3, h = (g >> 1) & 3, c = g & 1;
      float inv = rsqrtf(ssq[g] * (1.f / 64.f) + 1e-6f);
      float y = xv[g] * inv * p.qk_gain[(li * 2 + which) * 64 + lane];
      float pr = __shfl_xor(y, 16);
      float o = (lane & 16) ? (y * cs + pr * sn) : (y * cs - pr * sn);
      if (which == 0) o *= 0.18033688011112042f;
      u16* dst = (which ? KH : QH) + ((long)((b * 4 + h) * 2 + c) * 2304 + P) * 64 + lane;
      *dst = f2bf(o);
    }
  }
}

DI void ph_attn(const Prm& p, int li, long base, char* smem) {
  const int tid = mytid(), lane = tid & 63, wid = tid >> 6, fr = lane & 15, fq = lane >> 4;
  const u16* QH = (const u16*)(p.ws + OFF_AR + 3 * U38);
  const u16* KH = QH + 18874368L;
  const u16* VT = (const u16*)(p.ws + OFF_AR + 5 * U38);
  u16* YA = (u16*)(p.ws + OFF_Y);
  u16* s = (u16*)smem;
  constexpr int STG = 128 * 80 + 128 * 72;
  const float lambda_init = 0.8f - 0.6f * expf(-0.3f * (float)li);
  float lamv, mshift;
  {
    const float* lv = p.lam + li * 256;
    float a = wsum(lv[lane] * lv[64 + lane]), b2 = wsum(lv[128 + lane] * lv[192 + lane]);
    lamv = expf(a) - expf(b2) + lambda_init;
    float gq = wmax(fabsf(p.qk_gain[(li * 2) * 64 + lane])), gk = wmax(fabsf(p.qk_gain[(li * 2 + 1) * 64 + lane]));
    mshift = 8.f * gq * gk * 1.4426950408889634f;
  }
  for (int it = first_item(base); it < (li == 3 ? 1024 : 1152); it += gridDim.x) {
    int b, h, qp0, nkeys;
    if (it < 1024) { b = it >> 6; h = (it >> 4) & 3; qp0 = 256 + (it & 15) * 128; nkeys = 2304; }
    else { int i2 = it - 1024; b = i2 >> 3; h = (i2 >> 1) & 3; qp0 = (i2 & 1) * 128; nkeys = 256; }
    const long kb0 = (long)((b * 4 + h) * 2) * 2304;
    bf16x8 qf[2][2];
#pragma unroll
    for (int c = 0; c < 2; ++c)
#pragma unroll
      for (int ks = 0; ks < 2; ++ks)
        qf[c][ks] = *(const bf16x8*)(QH + (kb0 + (long)c * 2304 + qp0 + wid * 16 + fr) * 64 + ks * 32 + fq * 8);
    f32x4 O0[8], O1[8];
#pragma unroll
    for (int i = 0; i < 8; ++i) { O0[i] = f32x4{0.f, 0.f, 0.f, 0.f}; O1[i] = f32x4{0.f, 0.f, 0.f, 0.f}; }
    f32x4 L0 = {0.f, 0.f, 0.f, 0.f}, L1 = {0.f, 0.f, 0.f, 0.f};
    const bf16x8 ones = {0x3F80, 0x3F80, 0x3F80, 0x3F80, 0x3F80, 0x3F80, 0x3F80, 0x3F80};
    uint4 rk[2], rv[2];
    const int nt = nkeys >> 6;
#pragma unroll
    for (int u = 0; u < 2; ++u) {
      int id = tid + u * 512;
      int c = id >> 9, key = (id >> 3) & 63, ch = id & 7;
      rk[u] = *(const uint4*)(KH + (kb0 + (long)c * 2304 + key) * 64 + ch * 8);
      int dv = id >> 3;
      rv[u] = *(const uint4*)(VT + ((long)(b * 512 + h * 128 + dv)) * 2304 + ch * 8);
    }
#pragma unroll
    for (int u = 0; u < 2; ++u) {
      int id = tid + u * 512;
      *(uint4*)(s + (id >> 3) * 80 + (id & 7) * 8) = rk[u];
      *(uint4*)(s + 128 * 80 + (id >> 3) * 72 + (id & 7) * 8) = rv[u];
    }
    lds_barrier();
    for (int t = 0; t < nt; ++t) {
      const bool more = t + 1 < nt;
      if (more) {
        int kp0 = (t + 1) * 64;
#pragma unroll
        for (int u = 0; u < 2; ++u) {
          int id = tid + u * 512;
          int c = id >> 9, key = (id >> 3) & 63, ch = id & 7;
          rk[u] = *(const uint4*)(KH + (kb0 + (long)c * 2304 + kp0 + key) * 64 + ch * 8);
          int dv = id >> 3;
          rv[u] = *(const uint4*)(VT + ((long)(b * 512 + h * 128 + dv)) * 2304 + kp0 + ch * 8);
        }
      }
      const u16* ks_ = s + (t & 1) * STG;
      const u16* vs_ = ks_ + 128 * 80;
      bf16x8 pf[2][2];
#pragma unroll
      for (int c = 0; c < 2; ++c) {
#pragma unroll
        for (int kk2 = 0; kk2 < 2; ++kk2) {
          u32x4 pw;
#pragma unroll
          for (int hh = 0; hh < 2; ++hh) {
            const int k4 = kk2 * 2 + hh;
            f32x4 a = {-mshift, -mshift, -mshift, -mshift};
#pragma unroll
            for (int kk = 0; kk < 2; ++kk)
              a = MFMA(*(const bf16x8*)(ks_ + (c * 64 + k4 * 16 + fr) * 80 + kk * 32 + fq * 8), qf[c][kk], a);
            pw[hh * 2 + 0] = pk_bf16(__builtin_amdgcn_exp2f(a[0]), __builtin_amdgcn_exp2f(a[1]));
            pw[hh * 2 + 1] = pk_bf16(__builtin_amdgcn_exp2f(a[2]), __builtin_amdgcn_exp2f(a[3]));
          }
          pf[c][kk2] = *(bf16x8*)&pw;
        }
      }
#pragma unroll
      for (int kk = 0; kk < 2; ++kk) {
        L0 = MFMA(ones, pf[0][kk], L0);
        L1 = MFMA(ones, pf[1][kk], L1);
      }
#pragma unroll
      for (int dt = 0; dt < 8; ++dt) {
#pragma unroll
        for (int kk = 0; kk < 2; ++kk) {
          const u16* vp = vs_ + (dt * 16 + fr) * 72 + kk * 32 + fq * 4;
          uint2 lo = *(const uint2*)vp, hi = *(const uint2*)(vp + 16);
          uint4 av = {lo.x, lo.y, hi.x, hi.y};
          bf16x8 a = *(bf16x8*)&av;
          O0[dt] = MFMA(a, pf[0][kk], O0[dt]);
          O1[dt] = MFMA(a, pf[1][kk], O1[dt]);
        }
      }
      if (more) {
        u16* ns = s + ((t + 1) & 1) * STG;
#pragma unroll
        for (int u = 0; u < 2; ++u) {
          int id = tid + u * 512;
          *(uint4*)(ns + (id >> 3) * 80 + (id & 7) * 8) = rk[u];
          *(uint4*)(ns + 128 * 80 + (id >> 3) * 72 + (id & 7) * 8) = rv[u];
        }
      }
      lds_barrier();
    }
    float i0 = 1.f / L0[0], i1 = lamv / L1[0], ss = 0.f;
#pragma unroll
    for (int dt = 0; dt < 8; ++dt)
#pragma unroll
      for (int j = 0; j < 4; ++j) {
        float o = O0[dt][j] * i0 - O1[dt][j] * i1;
        O0[dt][j] = o;
        ss += o * o;
      }
    ss += __shfl_xor(ss, 16); ss += __shfl_xor(ss, 32);
    float inv = rsqrtf(ss * (1.f / 128.f) + 1e-6f) * (1.f - lambda_init);
    int tok = tokof(b, qp0 + wid * 16 + fr);
#pragma unroll
    for (int dt = 0; dt < 8; ++dt) {
      int dv = dt * 16 + fq * 4;
      const float* sw = p.subln + li * 128 + dv;
      uint2 o;
      o.x = pk_bf16(O0[dt][0] * inv * sw[0], O0[dt][1] * inv * sw[1]);
      o.y = pk_bf16(O0[dt][2] * inv * sw[2], O0[dt][3] * inv * sw[3]);
      *(uint2*)(YA + (long)tok * 512 + h * 128 + dv) = o;
    }
  }
}

template <int L>
DI void hyena_item(const Prm& p, int li, int ch, char* smem) {
  constexpr int CS = 2 * L + 8;
  constexpr int ZS = L + 8;
  constexpr int MT = L / 128;
  constexpr int MG = MT > 8 ? 8 : MT, NG = MT / MG;
  const int tid = mytid(), lane = tid & 63, wid = tid >> 6, fr = lane & 15, fq = lane >> 4;
  u16* cp = (u16*)smem;
  u16* zr = cp + 8 * CS;
  const u16* PH = (const u16*)(p.ws + OFF_AR) + (L == 2048 ? 0L : 32768L * 1536);
  const u16* G = (const u16*)(p.ws + (L == 2048 ? OFF_TAPL : OFF_TAPC));
  u16* YB = (u16*)(p.ws + OFF_Y + U38);
  const float* cw = p.hy_conv + (long)li * 3 * 1536;
  {
    float w0 = cw[1024 + ch], w1 = cw[1536 + 1024 + ch], w2 = cw[3072 + 1024 + ch];
    constexpr int NCH = (16 * L / 8) / 512;
    u32x4 cv[NCH];
    u16 pv[NCH], nv[NCH];
#pragma unroll
    for (int i = 0; i < NCH; ++i) {
      int id = tid + i * 512, b = id / (L / 8), s0 = (id % (L / 8)) * 8;
      const u16* row = PH + ((long)b * 1536 + 1024 + ch) * L + s0;
      cv[i] = *(const u32x4*)row;
      pv[i] = (s0 > 0) ? row[-1] : (u16)0;
      nv[i] = (s0 + 8 < L) ? row[8] : (u16)0;
    }
#pragma unroll
    for (int i = 0; i < NCH; ++i) {
      int id = tid + i * 512, b = id / (L / 8), s0 = (id % (L / 8)) * 8;
      float x[10];
      x[0] = bf2f(pv[i]);
      x[9] = bf2f(nv[i]);
#pragma unroll
      for (int w = 0; w < 4; ++w) {
        x[1 + 2 * w] = __uint_as_float(cv[i][w] << 16);
        x[2 + 2 * w] = __uint_as_float(cv[i][w] & 0xffff0000u);
      }
      float o[8];
#pragma unroll
      for (int e = 0; e < 8; ++e) o[e] = w0 * x[e] + w1 * x[e + 1] + w2 * x[e + 2];
      u32x4 r;
      r[0] = pk_bf16(o[7], o[6]); r[1] = pk_bf16(o[5], o[4]); r[2] = pk_bf16(o[3], o[2]); r[3] = pk_bf16(o[1], o[0]);
      *(u32x4*)(zr + b * ZS + L - 8 - s0) = r;
    }
  }
#pragma unroll
  for (int order = 0; order < 2; ++order) {
    {
      const u16* g = G + (long)(order * 512 + ch) * (2 * L);
      if (tid < 2 * L / 8) {
        const int i0 = tid * 8;
        u32x4 lo = *(const u32x4*)(g + i0);
        u32x4 hi = (i0 + 8 < 2 * L) ? *(const u32x4*)(g + i0 + 8) : u32x4{0u, 0u, 0u, 0u};
        unsigned D[8] = {lo[0], lo[1], lo[2], lo[3], hi[0], hi[1], hi[2], hi[3]};
#pragma unroll
        for (int c = 0; c < 8; ++c) {
          u32x4 o;
#pragma unroll
          for (int w = 0; w < 4; ++w) {
            if (c & 1) o[w] = (D[w + (c - 1) / 2] >> 16) | (D[w + (c + 1) / 2] << 16);
            else o[w] = D[w + c / 2];
          }
          *(u32x4*)(cp + c * CS + i0) = o;
        }
      }
    }
    __syncthreads();
    const float bias = p.hy_bias[(li * 2 + order) * 512 + ch];
    const int gcol = order * 512 + ch;
    const float w0 = cw[gcol], w1 = cw[1536 + gcol], w2 = cw[3072 + gcol];
    const int tq = wid * (L / 8) + fq * 4;
    const u16* xb = PH + ((long)fr * 1536 + gcol) * L + tq;
    const u16* zb = zr + fr * ZS + L - 1 - tq;
    unsigned zp[NG][MG][2];
#pragma unroll
    for (int grp = 0; grp < NG; ++grp) {
      f32x4 acc[MG];
#pragma unroll
      for (int m = 0; m < MG; ++m) acc[m] = f32x4{0.f, 0.f, 0.f, 0.f};
      const int tb = wid * (L / 8) + grp * MG * 16 + fr;
      if constexpr (MG == 8) {
        const int i00 = tb - fq * 8 - 7 + L, c0 = i00 & 7;
        const u16* ab = cp + c0 * CS + (i00 - c0);
        const u16* zbp = zr + fr * ZS + (L - 8 - fq * 8);
        bf16x8 W[16];
#pragma unroll 1
        for (int s0 = 0; s0 < L; s0 += 256) {
#pragma unroll
          for (int k = 0; k < 8; ++k) {
            const int sk = s0 + 32 * k;
            if (k == 0) {
#pragma unroll
              for (int m = 0; m < 8; ++m) W[m] = *(const bf16x8*)(ab + m * 16 - sk);
            }
            if (k < 7) {
              W[(16 - 2 * k - 2) & 15] = *(const bf16x8*)(ab - sk - 32);
              W[(16 - 2 * k - 1) & 15] = *(const bf16x8*)(ab - sk - 32 + 16);
            }
            bf16x8 bk = *(const bf16x8*)(zbp - sk);
#pragma unroll
            for (int m = 0; m < 8; ++m) acc[m] = MFMA(W[(m + 16 - 2 * k) & 15], bk, acc[m]);
          }
        }
      } else {
#pragma unroll 2
        for (int s0 = 0; s0 < L; s0 += 32) {
          bf16x8 bfr = *(const bf16x8*)(zr + fr * ZS + (L - 8 - s0 - fq * 8));
#pragma unroll
          for (int m = 0; m < MG; ++m) {
            int i0 = tb + m * 16 - s0 - fq * 8 - 7 + L;
            int c = i0 & 7;
            bf16x8 afr = *(const bf16x8*)(cp + c * CS + (i0 - c));
            acc[m] = MFMA(afr, bfr, acc[m]);
          }
        }
      }
#pragma unroll
      for (int m = 0; m < MG; ++m) {
        float r4[4];
#pragma unroll
        for (int j = 0; j < 4; ++j) {
          const int off = (grp * MG + m) * 16 + j;
          const int t = tq + off;
          float xa = bf2f(xb[off - 1]), xc = bf2f(xb[off]), xd = bf2f(xb[off + 1]);
          xa = (t > 0) ? xa : 0.f;
          xd = (t + 1 < L) ? xd : 0.f;
          float xg = w0 * xa + w1 * xc + w2 * xd;
          float zin = bf2f(zb[-off]);
          r4[j] = xg * (acc[m][j] + bias * zin);
        }
        zp[grp][m][0] = pk_bf16(r4[0], r4[1]);
        zp[grp][m][1] = pk_bf16(r4[2], r4[3]);
      }
    }
    __syncthreads();
#pragma unroll
    for (int grp = 0; grp < NG; ++grp)
#pragma unroll
      for (int m = 0; m < MG; ++m) {
        int t0 = wid * (L / 8) + (grp * MG + m) * 16 + fq * 4;
        uint2 w;
        w.x = (zp[grp][m][1] >> 16) | (zp[grp][m][1] << 16);
        w.y = (zp[grp][m][0] >> 16) | (zp[grp][m][0] << 16);
        *(uint2*)(zr + fr * ZS + L - 4 - t0) = w;
      }
  }
  __syncthreads();
  {
    u16* YBT = (u16*)(p.ws + OFF_AR + 5 * U38) + (L == 2048 ? 0L : 16L * 512 * 2048);
    constexpr int NCH = (16 * L / 8) / 512;
#pragma unroll
    for (int i = 0; i < NCH; ++i) {
      int id = tid + i * 512, b = id / (L / 8), t0 = (id % (L / 8)) * 8;
      u32x4 r = *(const u32x4*)(zr + b * ZS + L - 8 - t0);
      u32x4 o;
      o[0] = (r[3] >> 16) | (r[3] << 16);
      o[1] = (r[2] >> 16) | (r[2] << 16);
      o[2] = (r[1] >> 16) | (r[1] << 16);
      o[3] = (r[0] >> 16) | (r[0] << 16);
      *(u32x4*)(YBT + ((long)b * 512 + ch) * L + t0) = o;
    }
  }
  __syncthreads();
}

DI long ph_ytrans(const Prm& p, long base, bool lastl, char* smem) {
  u16* tl = (u16*)smem;
  const u16* YBT = (const u16*)(p.ws + OFF_AR + 5 * U38);
  u16* YB = (u16*)(p.ws + OFF_Y + U38);
  const int tid = mytid(), G = gridDim.x;
  const int total = lastl ? 4096 : 4608;
  auto srcp = [&](int it) -> const u16* {
    if (it < 4096) {
      int b = it >> 8, ct = (it >> 5) & 7, lt = it & 31;
      return YBT + ((long)b * 512 + ct * 64 + (tid >> 3)) * 2048 + lt * 64 + (tid & 7) * 8;
    } else {
      int i2 = it - 4096, b = i2 >> 5, ct = (i2 >> 2) & 7, lt = i2 & 3;
      return YBT + 16L * 512 * 2048 + ((long)b * 512 + ct * 64 + (tid >> 3)) * 256 + lt * 64 + (tid & 7) * 8;
    }
  };
  int it = first_item(base);
  u32x4 v = {0u, 0u, 0u, 0u};
  if (it < total) v = *(const u32x4*)srcp(it);
  for (; it < total; it += G) {
    *(u32x4*)(tl + (tid >> 3) * 72 + (tid & 7) * 8) = v;
    __syncthreads();
    if (it + G < total) v = *(const u32x4*)srcp(it + G);
    long tok0;
    int ct;
    if (it < 4096) { int b = it >> 8, lt = it & 31; ct = (it >> 5) & 7; tok0 = (long)b * 2048 + lt * 64; }
    else { int i2 = it - 4096, b = i2 >> 5, lt = i2 & 3; ct = (i2 >> 2) & 7; tok0 = (long)T_LAT + b * 256 + lt * 64; }
    const int lrow = tid >> 3, cc = tid & 7;
    u32x4 o;
#pragma unroll
    for (int w = 0; w < 4; ++w) {
      unsigned lo = tl[(cc * 8 + 2 * w) * 72 + lrow], hi = tl[(cc * 8 + 2 * w + 1) * 72 + lrow];
      o[w] = lo | (hi << 16);
    }
    *(u32x4*)(YB + (tok0 + lrow) * 512 + ct * 64 + cc * 8) = o;
    __syncthreads();
  }
  return base + total;
}

DI void ph_merge(const Prm& p, char* smem, bool lastl) {
  const int tid = mytid(), lane = tid & 63, wid = tid >> 6;
  const int wm = wid >> 1, wn = wid & 1, fr = lane & 15, fq = lane >> 4;
  const u16* H = (const u16*)(p.ws + OFF_HBF);
  const u16* Y = (const u16*)(p.ws + OFF_Y);
  const u16* WG = (const u16*)(p.ws + OFF_WB) + WO_G;
  const u16* WBr = (const u16*)(p.ws + OFF_WB) + WO_B;
  u16* MG = (u16*)(p.ws + OFF_AR);
  const int NT = (lastl ? 256 : 288) * 8, G = gridDim.x;
  Stg r0, r1;
  bool pre = false;
  for (int t = mybid(); t < NT; t += G) {
    const int mt = t >> 3, nt = t & 7;
    const bool hn = t + G < NT;
    const int mt2 = (t + G) >> 3, nt2 = (t + G) & 7;
    f32x4 acc[2][4], g[2][4], y[2][4];
#pragma unroll
    for (int a = 0; a < 2; ++a)
#pragma unroll
      for (int b = 0; b < 4; ++b) acc[a][b] = f32x4{0.f, 0.f, 0.f, 0.f};
    const u16* gA = H + (long)mt * 128 * 1024;
    for (int n = 0; n < 4; ++n) {
      const u16* gB = WG + ((long)n * 1024 + nt * 128) * 1024;
      const u16* yA = Y + (long)n * (T_ALL * 512L) + (long)mt * 128 * 512;
      const u16* yB = WBr + ((long)n * 1024 + nt * 128) * 512;
      gemm_tile<2>(g, gA, 1024, gB, 1024, 1024, smem, r0, r1, pre, yA, 512, yB, 512);
      const u16* nxA = (n < 3) ? gA : (hn ? H + (long)mt2 * 128 * 1024 : nullptr);
      const u16* nxB = (n < 3) ? WG + ((long)(n + 1) * 1024 + nt * 128) * 1024 : WG + ((long)nt2 * 128) * 1024;
      gemm_tile<2>(y, yA, 512, yB, 512, 512, smem, r0, r1, true, nxA, 1024, nxB, 1024);
      pre = true;
#pragma unroll
      for (int a = 0; a < 2; ++a)
#pragma unroll
        for (int b = 0; b < 4; ++b)
#pragma unroll
          for (int j = 0; j < 4; ++j) acc[a][b][j] += y[a][b][j] * __builtin_amdgcn_rcpf(1.f + __expf(-g[a][b][j]));
    }
    pre = hn;
#pragma unroll
    for (int a = 0; a < 2; ++a)
#pragma unroll
      for (int b = 0; b < 4; ++b) {
        int r = wm * 32 + a * 16 + fr, c = wn * 64 + b * 16 + fq * 4;
        uint2 o;
        o.x = pk_bf16(acc[a][b][0], acc[a][b][1]);
        o.y = pk_bf16(acc[a][b][2], acc[a][b][3]);
        *(uint2*)(MG + ((long)mt * 128 + r) * 1024 + nt * 128 + c) = o;
      }
  }
}

DI void run_phase(const Prm& p, int ph, char* smem) {
  if (ph == 0) { ph_init(p, smem); return; }
  const int li = (ph - 1) / 14, k = (ph - 1) % 14;
  const u16* WB = (const u16*)(p.ws + OFF_WB);
  const u16* HB = (const u16*)(p.ws + OFF_HBF);
  const float* MOD = (const float*)(p.ws + OFF_MOD);
  u16* AR = (u16*)(p.ws + OFF_AR);
  u16* Yb = (u16*)(p.ws + OFF_Y);
  const int G = gridDim.x;
  TD d;
  d.split = 0; d.scale = 1.f; d.mode = 0; d.tok0 = 0; d.col0 = 0; d.g = MOD;
  switch (k) {
    case 0: {
      u16* W = (u16*)(p.ws + OFF_WB);
      long base = 0;
      base = tr_job(base, p.w_in + (long)li * 1024 * NIN, 1024, NIN, W + WO_IN, 1, smem);
      base = tr_job(base, p.w_gate + (long)li * 4 * 1048576, 1024, 1024, W + WO_G, 4, smem);
      base = tr_job(base, p.w_branch + (long)li * 4 * 524288, 512, 1024, W + WO_B, 4, smem);
      base = tr_job(base, p.w_o + (long)li * 1048576, 1024, 1024, W + WO_O, 1, smem);
      base = tr_job(base, p.w_mlp1 + (long)li * 4194304, 1024, 4096, W + WO_1, 1, smem);
      base = tr_job(base, p.w_mlp2 + (long)li * 4194304, 4096, 1024, W + WO_2, 1, smem);
      ph_taps1(p, li, base, smem);
      ph_norm(p, li, 0);
    } break;
    case 1: {
      auto dec = [&](int t, TD& o) {
        o.lda = 1024; o.ldb = 1024; o.K = 1024; o.mode = 0;
        if (t < 1728) {
          int mt = t / 12, nt = t % 12;
          o.A = HB + (long)mt * 256 * 1024; o.B = WB + WO_IN + (long)(3584 + nt * 128) * 1024;
          o.C = AR + (long)mt * 256 * 1536 + nt * 128; o.ldc = 1536;
        } else if (t < 2304) {
          int t2 = t - 1728, mt = t2 >> 2, nt = t2 & 3;
          o.A = HB + (long)mt * 256 * 1024; o.B = WB + WO_IN + (long)(5120 + nt * 128) * 1024;
          o.C = Yb + 3 * (U38 / 2) + (long)mt * 256 * 512 + nt * 128; o.ldc = 512;
        } else {
          int mt = t - 2304;
          o.A = HB + (long)mt * 256 * 1024; o.B = WB + WO_IN + (long)5632 * 1024;
          o.C = (u16*)((float*)(p.ws + OFF_PDAB) + (long)mt * 256 * 16); o.ldc = 16; o.mode = 3;
        }
      };
      {
        Stg r0, r1;
        bool pre = false;
        TD dn = d;
        int t = mybid();
        if (t < 2448) dec(t, d);
        for (; t < 2448; t += G) {
          const bool hn = t + G < 2448;
          if (hn) dec(t + G, dn);
          run_tile2<4>(p, d, smem, r0, r1, pre, hn ? dn.A : nullptr, dn.lda, dn.B, dn.ldb);
          pre = hn;
          d = dn;
        }
      }
      ph_taps2(p, 2448, smem);
    } break;
    case 2: ph_dncl(p, li, smem); break;
    case 3: ph_dnscan(p, smem); break;
    case 4: {
      {
        Stg r0, r1;
        bool pre = false;
        for (int t = mybid(); t < 1152; t += G) {
          int mt = t >> 3, nt = t & 7;
          const bool hn = t + G < 1152;
          int mt2 = (t + G) >> 3, nt2 = (t + G) & 7;
          d.lda = 1024; d.ldb = 1024; d.K = 1024;
          d.A = HB + (long)mt * 256 * 1024; d.B = WB + WO_IN + (long)(nt * 128) * 1024;
          d.C = AR + 3 * (U38 / 2); d.ldc = 0; d.mode = 4; d.tok0 = mt * 256; d.col0 = nt;
          d.g = p.qk_gain + li * 128;
          run_tile2<4>(p, d, smem, r0, r1, pre, hn ? HB + (long)mt2 * 256 * 1024 : nullptr, 1024,
                    WB + WO_IN + (long)(nt2 * 128) * 1024, 1024);
          pre = hn;
        }
      }
      ph_dnfin(p, li);
    } break;
    case 5: {
      const int NT5 = (li == 3) ? 1088 : 1152;
      u16* VT = AR + 5 * (U38 / 2);
      u16* PF = AR + 6 * (U38 / 2);
      auto dec = [&](int t, TD& o) {
        o.lda = 1024; o.ldb = 1024; o.K = 1024;
        if (t < 512) {
          int b = t >> 5, r = t & 31, mt = r >> 4, nt = r & 15;
          o.A = WB + WO_IN + (long)(1024 + mt * 256) * 1024; o.B = HB + ((long)b * 2048 + nt * 128) * 1024;
          o.C = VT + ((long)b * 512 + mt * 256) * 2304 + 256 + nt * 128; o.ldc = 2304;
        } else if (t < 576) {
          int t2 = t - 512, b = t2 >> 2, r = t2 & 3, mt = r >> 1, nt = r & 1;
          o.A = WB + WO_IN + (long)(1024 + mt * 256) * 1024; o.B = HB + ((long)T_LAT + b * 256 + nt * 128) * 1024;
          o.C = VT + ((long)b * 512 + mt * 256) * 2304 + nt * 128; o.ldc = 2304;
        } else {
          int t2 = t - 576, mt = t2 >> 2, nt = t2 & 3;
          o.A = HB + (long)mt * 256 * 1024; o.B = WB + WO_IN + (long)(3072 + nt * 128) * 1024;
          o.C = PF + (long)mt * 256 * 512 + nt * 128; o.ldc = 512;
        }
      };
      {
        Stg r0, r1;
        bool pre = false;
        TD dn = d;
        int t = mybid();
        if (t < NT5) dec(t, d);
        for (; t < NT5; t += G) {
          const bool hn = t + G < NT5;
          if (hn) dec(t + G, dn);
          run_tile2<4>(p, d, smem, r0, r1, pre, hn ? dn.A : nullptr, dn.lda, dn.B, dn.ldb);
          pre = hn;
          d = dn;
        }
      }
    } break;
    case 6: {
      const int NT6 = (li == 3) ? 1536 : 1728;
      ph_attn(p, li, 0, smem);
      auto dec = [&](int t, TD& o) {
        o.lda = 1024; o.ldb = 1024; o.K = 1024;
        if (t < 1536) {
          int b = t / 96, r = t % 96, mt = r >> 4, nt = r & 15;
          o.A = WB + WO_IN + (long)(1536 + mt * 256) * 1024; o.B = HB + ((long)b * 2048 + nt * 128) * 1024;
          o.C = AR + ((long)b * 1536 + mt * 256) * 2048 + nt * 128; o.ldc = 2048;
        } else {
          int t2 = t - 1536, b = t2 / 12, r = t2 % 12, mt = r >> 1, nt = r & 1;
          o.A = WB + WO_IN + (long)(1536 + mt * 256) * 1024; o.B = HB + ((long)T_LAT + b * 256 + nt * 128) * 1024;
          o.C = AR + 32768L * 1536 + ((long)b * 1536 + mt * 256) * 256 + nt * 128; o.ldc = 256;
        }
      };
      {
        Stg r0, r1;
        bool pre = false;
        TD dn = d;
        int t = first_item(1152);
        if (t < NT6) dec(t, d);
        for (; t < NT6; t += G) {
          const bool hn = t + G < NT6;
          if (hn) dec(t + G, dn);
          run_tile2<4>(p, d, smem, r0, r1, pre, hn ? dn.A : nullptr, dn.lda, dn.B, dn.ldb);
          pre = hn;
          d = dn;
        }
      }
    } break;
    case 7: {
#if !defined(TESTSEL) || TESTSEL == 1
      for (int it = mybid(); it < 512; it += G) hyena_item<2048>(p, li, it, smem);
#endif
#if !defined(TESTSEL) || TESTSEL == 2
      if (li < 3)
        for (int it = mybid(); it < 512; it += G) hyena_item<256>(p, li, it, smem);
#endif
#if !defined(TESTSEL) || TESTSEL == 3
      const u16* PF = AR + 6 * (U38 / 2);
      u16* WF = AR + 3 * (U38 / 2);
      const u16* DCm = (const u16*)(p.ws + OFF_DC);
      auto dec = [&](int t, TD& o) {
        o.A = DCm; o.lda = 128; o.ldb = 512; o.K = 128;
        if (t < 1024) {
          int bg = t >> 4, nt = t & 15, b = bg >> 2, g = bg & 3;
          o.B = PF + ((long)b * 2048 + nt * 128) * 512 + g * 128;
          o.C = WF + ((long)b * 512 + g * 128) * 4096 + nt * 128; o.ldc = 4096; o.split = 2048;
        } else {
          int t2 = t - 1024, bg = t2 >> 1, nt = t2 & 1, b = bg >> 2, g = bg & 3;
          o.B = PF + ((long)T_LAT + b * 256 + nt * 128) * 512 + g * 128;
          o.C = WF + 16L * 512 * 4096 + ((long)b * 512 + g * 128) * 512 + nt * 128; o.ldc = 512; o.split = 256;
        }
      };
      {
        const int NT7 = (li == 3 ? 1024 : 1152);
        Stg r0, r1;
        bool pre = false;
        TD dn = d;
        int t = mybid();
        if (t < NT7) dec(t, d);
        for (; t < NT7; t += G) {
          const bool hn = t + G < NT7;
          if (hn) dec(t + G, dn);
          run_tile2<4>(p, d, smem, r0, r1, pre, hn ? dn.A : nullptr, dn.lda, dn.B, dn.ldb);
          pre = hn;
          d = dn;
        }
      }
#endif
    } break;
    case 8: {
      const u16* WF = AR + 3 * (U38 / 2);
      u16* YF = Yb + 2 * (U38 / 2);
      d.scale = 1.f / 512.f;
      for (int t = mybid(); t < (li == 3 ? 512 : 576); t += G) {
        if (t < 512) {
          int b = t >> 5, r = t & 31, mt = r >> 2, nt = r & 3;
          d.A = (const u16*)(p.ws + OFF_DL) + (long)mt * 256 * 4096; d.lda = 4096;
          d.B = WF + ((long)b * 512 + nt * 128) * 4096; d.ldb = 4096; d.K = 4096;
          d.C = YF + ((long)b * 2048 + mt * 256) * 512 + nt * 128; d.ldc = 512;
        } else {
          int t2 = t - 512, b = t2 >> 2, nt = t2 & 3;
          d.A = (const u16*)(p.ws + OFF_DLC); d.lda = 512;
          d.B = WF + 16L * 512 * 4096 + ((long)b * 512 + nt * 128) * 512; d.ldb = 512; d.K = 512;
          d.C = YF + ((long)T_LAT + b * 256) * 512 + nt * 128; d.ldc = 512;
        }
        run_tile(p, d, smem);
      }
      ph_ytrans(p, 576, li == 3, smem);
    } break;
    case 9: ph_merge(p, smem, li == 3); break;
    case 10: {
      d.mode = 2;
      const int NF = 1024, NTOT = (li == 3) ? 1024 : 1024 + 256;
      auto dec = [&](int t, TD& o) {
        int full = t < NF ? t : NF + ((t - NF) >> 1), half = t < NF ? 0 : ((t - NF) & 1);
        int mt = full >> 3, nt = full & 7;
        o.A = AR + ((long)mt * 256 + half * 128) * 1024; o.lda = 1024;
        o.B = WB + WO_O + (long)nt * 128 * 1024; o.ldb = 1024; o.K = 1024;
        o.tok0 = mt * 256 + half * 128; o.col0 = nt * 128;
        int bb = o.tok0 < T_LAT ? (o.tok0 >> 11) : 16;
        o.g = MOD + ((long)li * 17 + bb) * 6144 + 2 * 1024;
      };
      Stg r0, r1;
      bool pre = false;
      TD dn = d;
      int t = mybid();
      if (t < NTOT) dec(t, d);
      for (; t < NTOT; t += G) {
        const bool hn = t + G < NTOT;
        if (hn) dec(t + G, dn);
        if (t < NF) run_tile2<4>(p, d, smem, r0, r1, pre, hn ? dn.A : nullptr, dn.lda, dn.B, dn.ldb);
        else run_tile2<2>(p, d, smem, r0, r1, pre, hn ? dn.A : nullptr, dn.lda, dn.B, dn.ldb);
        pre = hn;
        d = dn;
      }
    } break;
    case 11: ph_norm(p, li, 1); break;
    case 12: {
      d.mode = 1;
      const int NT12 = (li == 3 ? 4096 : 4608);
      Stg r0, r1;
      bool pre = false;
      for (int t = mybid(); t < NT12; t += G) {
        int mt = ((t >> 7) << 2) + ((t & 31) >> 3), nt = (((t >> 5) & 3) << 3) + (t & 7);
        d.A = HB + (long)mt * 256 * 1024; d.lda = 1024; d.B = WB + WO_1 + (long)nt * 128 * 1024; d.ldb = 1024; d.K = 1024;
        d.C = Yb + (long)mt * 256 * 4096 + nt * 128; d.ldc = 4096;
        const bool hn = t + G < NT12;
        int mt2 = (((t + G) >> 7) << 2) + (((t + G) & 31) >> 3), nt2 = ((((t + G) >> 5) & 3) << 3) + ((t + G) & 7);
        run_tile2<4>(p, d, smem, r0, r1, pre, hn ? HB + (long)mt2 * 256 * 1024 : nullptr, 1024,
                  WB + WO_1 + (long)nt2 * 128 * 1024, 1024);
        pre = hn;
      }
    } break;
    case 13: {
      d.mode = 2;
      const int NF = 1024, NTOT = (li == 3) ? 1024 : 1024 + 256;
      auto dec = [&](int t, TD& o) {
        int full = t < NF ? t : NF + ((t - NF) >> 1), half = t < NF ? 0 : ((t - NF) & 1);
        int mt = full >> 3, nt = full & 7;
        o.A = Yb + ((long)mt * 256 + half * 128) * 4096; o.lda = 4096;
        o.B = WB + WO_2 + (long)nt * 128 * 4096; o.ldb = 4096; o.K = 4096;
        o.tok0 = mt * 256 + half * 128; o.col0 = nt * 128;
        int bb = o.tok0 < T_LAT ? (o.tok0 >> 11) : 16;
        o.g = MOD + ((long)li * 17 + bb) * 6144 + 5 * 1024;
      };
      Stg r0, r1;
      bool pre = false;
      TD dn = d;
      int t = mybid();
      if (t < NTOT) dec(t, d);
      for (; t < NTOT; t += G) {
        const bool hn = t + G < NTOT;
        if (hn) dec(t + G, dn);
        if (t < NF) run_tile2<4>(p, d, smem, r0, r1, pre, hn ? dn.A : nullptr, dn.lda, dn.B, dn.ldb);
        else run_tile2<2>(p, d, smem, r0, r1, pre, hn ? dn.A : nullptr, dn.lda, dn.B, dn.ldb);
        pre = hn;
        d = dn;
      }
    } break;
  }
}


#define XB_TMO      128
#define XB_XCNT(j)  (256  + 64 * (j))
#define XB_XSUB(j)  (1280 + 64 * (j))
#define XB_XGEN(j)  (2304 + 64 * (j))
#define XB_TOP      3328
#define XB_TOPGEN   3392
#define XCD_BAR_WORDS 3456
#define XB_SPIN_CAP (1u << 20)
#define LAS __attribute__((address_space(3)))
DI unsigned xb_ld(unsigned* p) { return __hip_atomic_load(p, __ATOMIC_RELAXED, __HIP_MEMORY_SCOPE_AGENT); }
DI unsigned xb_add(unsigned* p, unsigned v) { return __hip_atomic_fetch_add(p, v, __ATOMIC_RELAXED, __HIP_MEMORY_SCOPE_AGENT); }
DI unsigned xb_xcc_id() { return (unsigned)__builtin_amdgcn_s_getreg((3 << 11) | 20) & 0xFu; }
#define XB_SPIN(cond, bar) do { unsigned _sp = 0; while (cond) { __builtin_amdgcn_s_sleep(1); \
    if ((++_sp & 255u) == 0u) { if (xb_ld(&(bar)[XB_TMO])) break; if (_sp > XB_SPIN_CAP) { atomicAdd(&(bar)[XB_TMO], 1u); break; } } } } while (0)
struct XcdBarrier { unsigned* bar; unsigned x; volatile LAS unsigned* st; };
DI XcdBarrier xcd_barrier_post(unsigned* bar, volatile LAS unsigned* st) {
  XcdBarrier b; b.bar = bar; b.x = xb_xcc_id(); b.st = st;
  if (threadIdx.x == 0) (void)xb_add(&bar[XB_XCNT(b.x)], 1u);
  return b;
}
DI void xcd_barrier_complete(unsigned* bar, unsigned x, unsigned& nloc, unsigned& nx) {
  const unsigned G = gridDim.x * gridDim.y * gridDim.z;
  unsigned sum, cnt, mine, sp = 0u;
  for (;;) {
    sum = 0u; cnt = 0u; mine = 0u;
#pragma unroll
    for (unsigned j = 0; j < 16; ++j) { const unsigned c = xb_ld(&bar[XB_XCNT(j)]); sum += c; cnt += (c > 0u) ? 1u : 0u; mine = (j == x) ? c : mine; }
    if (sum == G) break;
    __builtin_amdgcn_s_sleep(1);
    if ((++sp & 255u) == 0u) { if (xb_ld(&bar[XB_TMO])) break; if (sp > XB_SPIN_CAP) { atomicAdd(&bar[XB_TMO], 1u); break; } }
  }
  nloc = mine > 0u ? mine : 1u; nx = cnt > 0u ? cnt : 1u;
}
DI void xcd_barrier(const XcdBarrier& b) {
  asm volatile("s_waitcnt vmcnt(0)" ::: "memory");
  __syncthreads();
  if (threadIdx.x == 0) {
    unsigned* bar = b.bar;
    __builtin_amdgcn_s_waitcnt(0);
    unsigned nloc = b.st[0], nx = b.st[1];
    if (nloc == 0u) { xcd_barrier_complete(bar, b.x, nloc, nx); b.st[0] = nloc; b.st[1] = nx; }
    const unsigned old = xb_add(&bar[XB_XSUB(b.x)], 1u);
    const unsigned gen = old / nloc;
    if (old + 1u == (gen + 1u) * nloc) {
      __builtin_amdgcn_fence(__ATOMIC_RELEASE, "agent");
      asm volatile("s_waitcnt vmcnt(0)" ::: "memory");
      const unsigned og = xb_add(&bar[XB_TOP], 1u);
      const unsigned tg = og / nx;
      if (og + 1u == (tg + 1u) * nx) xb_add(&bar[XB_TOPGEN], 1u);
      else XB_SPIN(xb_ld(&bar[XB_TOPGEN]) == tg, bar);
      __builtin_amdgcn_fence(__ATOMIC_ACQUIRE, "agent");
      xb_add(&bar[XB_XGEN(b.x)], 1u);
      asm volatile("s_waitcnt vmcnt(0)" ::: "memory");
    } else {
      XB_SPIN(xb_ld(&bar[XB_XGEN(b.x)]) == gen, bar);
      __builtin_amdgcn_fence(__ATOMIC_ACQUIRE, "agent");
      asm volatile("s_waitcnt vmcnt(0)" ::: "memory");
    }
  }
  __syncthreads();
}

extern __shared__ __attribute__((aligned(16))) char dyn_smem[];

__global__ void __launch_bounds__(512) mega(Prm p, int lo, int hi) {
  __shared__ uint4 xb_words;
  if (threadIdx.x == 0) xb_words = make_uint4(0u, 0u, 0u, 0u);
  __syncthreads();
  XcdBarrier xb = xcd_barrier_post((unsigned*)(p.ws + OFF_BAR), (volatile LAS unsigned*)&xb_words);
#ifdef ONLYK
  run_phase(p, ONLYK, dyn_smem);
#else
  for (int ph = lo; ph <= hi; ++ph) {
    long z = 0;
    asm volatile("" : "+s"(z));
    Prm q;
#define LP(f) q.f = p.f + z
    LP(x); LP(c); LP(ctx); LP(c_ctx); LP(w_ada); LP(b_ada); LP(norm1); LP(norm2); LP(w_in); LP(qk_gain); LP(lam);
    LP(subln); LP(hy_conv); LP(hy_w1); LP(hy_b1); LP(hy_freq); LP(hy_w2); LP(hy_b2); LP(hy_w3); LP(hy_bias);
    LP(dn_conv); LP(dn_a_log); LP(dn_dt_bias); LP(dn_norm); LP(w_gate); LP(w_branch); LP(w_o); LP(w_mlp1); LP(w_mlp2);
    LP(out); LP(ws);
#undef LP
    run_phase(q, ph, dyn_smem);
#ifdef PROBEK
    if (ph > 0 && (ph - 1) % 14 == PROBEK) { cg::this_grid().sync(); run_phase(q, ph, dyn_smem); }
#endif
    if (ph < hi) {
      if (ph == lo) cg::this_grid().sync();
      else xcd_barrier(xb);
    }
  }
#endif
}

extern "C" void kernel_launch(void* const* d_in, const int* in_sizes, int n_in, void* d_out, int out_size, void* d_ws,
                              size_t ws_size, hipStream_t stream) {
  static int grid_blocks = 0;
  if (!grid_blocks) {
    hipFuncSetAttribute((const void*)mega, hipFuncAttributeMaxDynamicSharedMemorySize, LDS_BYTES);
    int dev = 0, cus = 0, per_cu = 0;
    hipGetDevice(&dev);
    hipDeviceGetAttribute(&cus, hipDeviceAttributeMultiprocessorCount, dev);
    hipOccupancyMaxActiveBlocksPerMultiprocessor(&per_cu, mega, 512, LDS_BYTES);
    if (per_cu < 1) per_cu = 1;
    grid_blocks = cus * per_cu;
    if (ws_size < (size_t)WS_TOTAL) fprintf(stderr, "workspace too small: %zu < %ld\n", ws_size, (long)WS_TOTAL);
  }
  Prm p;
  const float** pp = (const float**)&p;
  for (int i = 0; i < 29; ++i) pp[i] = (const float*)d_in[i];
  p.out = (float*)d_out;
  p.ws = (char*)d_ws;
#if MULTI
  for (int ph = 0; ph < NPHASE; ++ph) hipLaunchKernelGGL(mega, dim3(grid_blocks), dim3(512), LDS_BYTES, stream, p, ph, ph);
#else
  int lo = 0, hi = NPHASE - 1;
  hipMemsetAsync((char*)d_ws + OFF_BAR, 0, XCD_BAR_WORDS * 4, stream);
  void* args[] = {&p, &lo, &hi};
  hipError_t e = hipLaunchCooperativeKernel((void*)mega, dim3(grid_blocks), dim3(512), args, LDS_BYTES, stream);
  if (e != hipSuccess) fprintf(stderr, "cooperative launch failed: %s (grid %d)\n", hipGetErrorString(e), grid_blocks);
#endif
}
```
